# Optimizing an MI355X kernel written in HIP

```python
import math
import jax
import jax.numpy as jnp
from jax import lax
import numpy as np

D_MODEL = 1024
BATCH = 4
SEQ = 8192
DEPTH = 2

GRID_W = 64
CTX_LEN = 256
N_MIXERS = 2
N_HY_LAYERS = (DEPTH + N_MIXERS - 1) // N_MIXERS
N_ML_LAYERS = DEPTH // N_MIXERS
EPS = 1e-6
SHORT_W = 3

HY_EMB_BANDS = 16
HY_EMB_DIM = 1 + 2 * HY_EMB_BANDS
HY_FILTER_WIDTH = 64
HY_MAX_DECAY = math.log(1e-2) / 0.3
HY_MIN_DECAY = math.log(1e-2) / 1.5

ML_INNER = 2 * D_MODEL
ML_HEADS = 4
ML_HEAD_DIM = ML_INNER // ML_HEADS
ML_QKV_BLOCK = 4
ML_N_BLOCKS = ML_INNER // ML_QKV_BLOCK
ML_CHUNK = 128
ML_NORM_EPS = 1e-5

FFN_HIDDEN = 2816

kernel_name = 'hyena_mlstm_prefix_dit'


def _f32(a):
    return a.astype(jnp.float32)


def rmsnorm(x, g):
    x32 = _f32(x)
    y = x32 * lax.rsqrt(jnp.mean(x32 * x32, axis=-1, keepdims=True) + EPS)
    return (y * _f32(g)).astype(x.dtype)


def modulate(h, shift, scale):
    return h * (1.0 + scale) + shift


def adaln_params(cond, w, b):
    mod = jax.nn.silu(cond) @ w + b
    return jnp.split(mod[..., None, :], 6, axis=-1)


def short_conv(x, w, b):
    xp = jnp.pad(x, ((0, 0), (1, 1), (0, 0)))
    return w[0] * xp[:, :-2] + w[1] * xp[:, 1:-1] + w[2] * xp[:, 2:] + b


def grid_dwconv(x, w, b, rows, cols):
    B, L, C = x.shape
    img = x.reshape(B, rows, cols, C)
    y = lax.conv_general_dilated(img, w.astype(x.dtype)[:, :, None, :], window_strides=(1, 1),
                                 padding='SAME', dimension_numbers=('NHWC', 'HWIO', 'NHWC'),
                                 feature_group_count=C)
    return y.reshape(B, L, C) + b


def conv_ffn(u, w_up, conv_w, conv_b, w_down, rows, cols):
    a, g = jnp.split(u @ w_up, 2, axis=-1)
    g = grid_dwconv(g, conv_w, conv_b, rows, cols)
    return (jax.nn.silu(g) * a) @ w_down


def hyena_filters(L, f_w1, f_b1, f_w2, f_b2, f_w3, f_b3, f_wout, freq):
    t = jnp.linspace(0.0, 1.0, L, dtype=jnp.float32)[:, None]
    w = 2.0 * math.pi * jnp.arange(L, dtype=jnp.float32)[:, None] / L
    bands = jnp.linspace(1e-4, HY_EMB_BANDS - 1, HY_EMB_BANDS, dtype=jnp.float32)[None, :]
    pos = jnp.concatenate([t, jnp.cos(bands * w), -jnp.sin(bands * w)], axis=-1)
    fr = _f32(freq)
    h = jnp.sin(fr * (pos @ _f32(f_w1) + _f32(f_b1)))
    h = jnp.sin(fr * (h @ _f32(f_w2) + _f32(f_b2)))
    h = jnp.sin(fr * (h @ _f32(f_w3) + _f32(f_b3)))
    h = (h @ _f32(f_wout)).reshape(L, 2, D_MODEL)
    deltas = jnp.linspace(HY_MIN_DECAY, HY_MAX_DECAY, D_MODEL, dtype=jnp.float32)
    h = h * jnp.exp(-t * jnp.abs(deltas))[:, None, :]
    kern = jnp.concatenate([h[:, 0], jnp.zeros((1, D_MODEL), jnp.float32), h[:0:-1, 1]], axis=0)
    return kern / jnp.sum(jnp.abs(kern), axis=0, keepdims=True)


def hyena_mix(u, p):
    (w_in, b_in, sc_w, sc_b, f_w1, f_b1, f_w2, f_b2, f_w3, f_b3, f_wout, freq,
     bias, w_out, b_out) = p
    L = u.shape[1]
    proj = short_conv(u @ w_in + b_in, sc_w, sc_b)
    x0, x1, v = jnp.split(proj, 3, axis=-1)
    kern = hyena_filters(L, f_w1, f_b1, f_w2, f_b2, f_w3, f_b3, f_wout, freq)
    z = _f32(x1 * v)
    y = jnp.fft.irfft(jnp.fft.rfft(z, n=2 * L, axis=1) * jnp.fft.rfft(kern, n=2 * L, axis=0)[None],
                      n=2 * L, axis=1)[:, :L]
    y = (y + z * _f32(bias)).astype(u.dtype)
    return (x0 * y) @ w_out + b_out


def headwise(a, w):
    B, L, _ = a.shape
    out = jnp.einsum('blnc,nce->blne', a.reshape(B, L, ML_N_BLOCKS, ML_QKV_BLOCK), w)
    return out.reshape(B, L, ML_INNER)


def to_heads(a):
    B, L, _ = a.shape
    return _f32(a).reshape(B, L, ML_HEADS, ML_HEAD_DIM).transpose(0, 2, 1, 3)


def mlstm_chunkwise(q, k, v, ig, lf, state):
    B, H, L, dh = q.shape
    nc = L // ML_CHUNK

    def chunks(a):
        return jnp.moveaxis(a.reshape(B, H, nc, ML_CHUNK, *a.shape[3:]), 2, 0)

    lower = jnp.tril(jnp.ones((ML_CHUNK, ML_CHUNK), dtype=bool))

    def step(carry, xs):
        C, n, m = carry
        qc, kc, vc, igc, lfc = xs
        b = jnp.cumsum(lfc, axis=-1)
        a_inter = b + m[..., None]
        d = jnp.where(lower, b[..., :, None] - b[..., None, :] + igc[..., None, :], -jnp.inf)
        m_row = jnp.maximum(a_inter, jnp.max(d, axis=-1))
        w_inter = jnp.exp(a_inter - m_row)
        s = jnp.einsum('bhid,bhjd->bhij', qc, kc) * jnp.exp(d - m_row[..., None])
        num = (w_inter[..., None] * jnp.einsum('bhed,bhid->bhie', C, qc)
               + jnp.einsum('bhij,bhje->bhie', s, vc))
        den = w_inter * jnp.einsum('bhd,bhid->bhi', n, qc) + jnp.sum(s, axis=-1)
        h = num / jnp.maximum(jnp.abs(den), jnp.exp(-m_row))[..., None]
        b_last = b[..., -1]
        e = b_last[..., None] - b + igc
        m_new = jnp.maximum(b_last + m, jnp.max(e, axis=-1))
        g_old = jnp.exp(b_last + m - m_new)
        w_new = jnp.exp(e - m_new[..., None])
        C_new = g_old[..., None, None] * C + jnp.einsum('bhje,bhjd->bhed', vc * w_new[..., None], kc)
        n_new = g_old[..., None] * n + jnp.einsum('bhj,bhjd->bhd', w_new, kc)
        return (C_new, n_new, m_new), h

    state, h = lax.scan(step, state, (chunks(q), chunks(k), chunks(v), chunks(ig), chunks(lf)))
    return jnp.moveaxis(h, 0, 2).reshape(B, H, L, dh), state


def mlstm_final_state(k, v, ig, lf):
    b = jnp.cumsum(lf, axis=-1)
    b_last = b[..., -1]
    e = b_last[..., None] - b + ig
    m = jnp.maximum(b_last, jnp.max(e, axis=-1))
    w = jnp.exp(e - m[..., None])
    return (jnp.einsum('bhje,bhjd->bhed', v * w[..., None], k),
            jnp.einsum('bhj,bhjd->bhd', w, k), m)


def mlstm_prep(u, w_in, conv_w, conv_b, wq, wk, wv, w_gate, b_gate):
    B, L, _ = u.shape
    xm, z = jnp.split(u @ w_in, 2, axis=-1)
    xc = jax.nn.silu(short_conv(xm, conv_w, conv_b))
    q = headwise(xc, wq)
    k = headwise(xc, wk)
    v = headwise(xm, wv)
    gates = (q @ w_gate[:ML_INNER] + k @ w_gate[ML_INNER:2 * ML_INNER]
             + v @ w_gate[2 * ML_INNER:] + b_gate)
    gates = jnp.transpose(_f32(gates).reshape(B, L, 2, 2, ML_HEADS), (2, 3, 0, 4, 1))
    ig = gates[:, 0]
    lf = jax.nn.log_sigmoid(gates[:, 1])
    return to_heads(q), to_heads(k) * (ML_HEAD_DIM ** -0.5), to_heads(v), ig, lf, xc, z


def mlstm_out(h, xc, z, norm_w, skip, w_down):
    B, H, L, dh = h.shape
    mu = jnp.mean(h, axis=-1, keepdims=True)
    var = jnp.mean(jnp.square(h - mu), axis=-1, keepdims=True)
    hn = ((h - mu) * lax.rsqrt(var + ML_NORM_EPS)).transpose(0, 2, 1, 3).reshape(B, L, H * dh)
    hs = (hn * _f32(norm_w)).astype(xc.dtype) + skip * xc
    return (hs * jax.nn.silu(z)) @ w_down


def mlstm_mix(u_lat, u_ctx, p, need_ctx):
    w_in, conv_w, conv_b, wq, wk, wv, w_gate, b_gate, norm_w, skip, w_down = p

    def prep(u):
        return mlstm_prep(u, w_in, conv_w, conv_b, wq, wk, wv, w_gate, b_gate)

    def flip(a):
        return jnp.flip(a, axis=2)

    q, k, v, ig, lf, xc, z = prep(u_lat)
    qc, kc, vc, igc, lfc, xcc, zc = prep(u_ctx)
    if need_ctx:
        B = u_ctx.shape[0]
        zero = (jnp.zeros((B, ML_HEADS, ML_HEAD_DIM, ML_HEAD_DIM), jnp.float32),
                jnp.zeros((B, ML_HEADS, ML_HEAD_DIM), jnp.float32),
                jnp.zeros((B, ML_HEADS), jnp.float32))
        hcf, st_f = mlstm_chunkwise(qc, kc, vc, igc[0], lfc[0], zero)
        hcb, st_b = mlstm_chunkwise(flip(qc), flip(kc), flip(vc), flip(igc[1]), flip(lfc[1]), zero)
        y_ctx = mlstm_out(hcf + flip(hcb), xcc, zc, norm_w, skip, w_down)
    else:
        st_f = mlstm_final_state(kc, vc, igc[0], lfc[0])
        st_b = mlstm_final_state(flip(kc), flip(vc), flip(igc[1]), flip(lfc[1]))
        y_ctx = None
    hf, _ = mlstm_chunkwise(q, k, v, ig[0], lf[0], st_f)
    hb, _ = mlstm_chunkwise(flip(q), flip(k), flip(v), flip(ig[1]), flip(lf[1]), st_b)
    y_lat = mlstm_out(hf + flip(hb), xc, z, norm_w, skip, w_down)
    return y_lat, y_ctx


def setup_inputs(seed: int = 0) -> dict:
    key = jax.random.key(seed)
    keys = iter(jax.random.split(key, 48))

    def nrm(shape, scale):
        return jax.random.normal(next(keys), shape, dtype=jnp.float32) * scale

    D, NH, NM = D_MODEL, N_HY_LAYERS, N_ML_LAYERS
    fb = jnp.linspace(3.0, 6.0, ML_HEADS, dtype=jnp.float32)
    ml_b_gate = jnp.stack([nrm((NM, 2, ML_HEADS), 0.1), fb + nrm((NM, 2, ML_HEADS), 0.1)],
                          axis=2).reshape(NM, 4 * ML_HEADS)
    return {
        'x': nrm((BATCH, SEQ, D), 1.0),
        'c': nrm((BATCH, D), 1.0),
        'ctx': nrm((BATCH, CTX_LEN, D), 1.0),
        'c_ctx': nrm((D,), 1.0),
        'mod_w': nrm((DEPTH, D, 6 * D), 0.5 * D ** -0.5),
        'mod_b': nrm((DEPTH, 6 * D), 0.02),
        'norm_g': 1.0 + nrm((DEPTH, 2, D), 0.02),
        'final_g': 1.0 + nrm((D,), 0.02),
        'hy_w_in': nrm((NH, D, 3 * D), D ** -0.5),
        'hy_b_in': nrm((NH, 3 * D), 0.02),
        'hy_sc_w': nrm((NH, SHORT_W, 3 * D), SHORT_W ** -0.5),
        'hy_sc_b': nrm((NH, 3 * D), 0.02),
        'hy_f_w1': nrm((NH, HY_EMB_DIM, HY_FILTER_WIDTH), HY_EMB_DIM ** -0.5),
        'hy_f_b1': nrm((NH, HY_FILTER_WIDTH), 0.1),
        'hy_f_w2': nrm((NH, HY_FILTER_WIDTH, HY_FILTER_WIDTH), HY_FILTER_WIDTH ** -0.5),
        'hy_f_b2': nrm((NH, HY_FILTER_WIDTH), 0.1),
        'hy_f_w3': nrm((NH, HY_FILTER_WIDTH, HY_FILTER_WIDTH), HY_FILTER_WIDTH ** -0.5),
        'hy_f_b3': nrm((NH, HY_FILTER_WIDTH), 0.1),
        'hy_f_wout': nrm((NH, HY_FILTER_WIDTH, 2 * D), HY_FILTER_WIDTH ** -0.5),
        'hy_freq': 1.0 + nrm((NH, HY_FILTER_WIDTH), 0.1),
        'hy_bias': nrm((NH, D), 0.2),
        'hy_w_out': nrm((NH, D, D), D ** -0.5),
        'hy_b_out': nrm((NH, D), 0.02),
        'ml_w_in': nrm((NM, D, 2 * ML_INNER), D ** -0.5),
        'ml_conv_w': nrm((NM, SHORT_W, ML_INNER), SHORT_W ** -0.5),
        'ml_conv_b': nrm((NM, ML_INNER), 0.02),
        'ml_wq': nrm((NM, ML_N_BLOCKS, ML_QKV_BLOCK, ML_QKV_BLOCK), ML_QKV_BLOCK ** -0.5),
        'ml_wk': nrm((NM, ML_N_BLOCKS, ML_QKV_BLOCK, ML_QKV_BLOCK), ML_QKV_BLOCK ** -0.5),
        'ml_wv': nrm((NM, ML_N_BLOCKS, ML_QKV_BLOCK, ML_QKV_BLOCK), ML_QKV_BLOCK ** -0.5),
        'ml_w_gate': nrm((NM, 3 * ML_INNER, 4 * ML_HEADS), 0.1 * (3 * ML_INNER) ** -0.5),
        'ml_b_gate': ml_b_gate,
        'ml_norm_w': 1.0 + nrm((NM, ML_INNER), 0.02),
        'ml_skip': 1.0 + nrm((NM, ML_INNER), 0.02),
        'ml_w_down': nrm((NM, ML_INNER, D), ML_INNER ** -0.5),
        'ffn_w_up': nrm((DEPTH, D, 2 * FFN_HIDDEN), D ** -0.5),
        'ffn_conv_w': nrm((DEPTH, 3, 3, FFN_HIDDEN), 1.0 / 3.0),
        'ffn_conv_b': nrm((DEPTH, FFN_HIDDEN), 0.02),
        'ffn_w_down': nrm((DEPTH, FFN_HIDDEN, D), FFN_HIDDEN ** -0.5),
    }


def reference(x, c, ctx, c_ctx, mod_w, mod_b, norm_g, final_g,
              hy_w_in, hy_b_in, hy_sc_w, hy_sc_b, hy_f_w1, hy_f_b1, hy_f_w2, hy_f_b2,
              hy_f_w3, hy_f_b3, hy_f_wout, hy_freq, hy_bias, hy_w_out, hy_b_out,
              ml_w_in, ml_conv_w, ml_conv_b, ml_wq, ml_wk, ml_wv, ml_w_gate, ml_b_gate,
              ml_norm_w, ml_skip, ml_w_down,
              ffn_w_up, ffn_conv_w, ffn_conv_b, ffn_w_down):
    rows = x.shape[1] // GRID_W
    ctx_len = ctx.shape[1]
    hy_params = (hy_w_in, hy_b_in, hy_sc_w, hy_sc_b, hy_f_w1, hy_f_b1, hy_f_w2, hy_f_b2,
                 hy_f_w3, hy_f_b3, hy_f_wout, hy_freq, hy_bias, hy_w_out, hy_b_out)
    ml_params = (ml_w_in, ml_conv_w, ml_conv_b, ml_wq, ml_wk, ml_wv, ml_w_gate, ml_b_gate,
                 ml_norm_w, ml_skip, ml_w_down)
    for i in range(DEPTH):
        last = i == DEPTH - 1
        sh1, sc1, g1, sh2, sc2, g2 = adaln_params(c, mod_w[i], mod_b[i])
        csh1, csc1, cg1, csh2, csc2, cg2 = adaln_params(c_ctx, mod_w[i], mod_b[i])
        h_lat = modulate(rmsnorm(x, norm_g[i, 0]), sh1, sc1)
        h_ctx = modulate(rmsnorm(ctx, norm_g[i, 0]), csh1, csc1)
        j = i // N_MIXERS
        if i % N_MIXERS == 0:
            p = tuple(a[j] for a in hy_params)
            y_lat = hyena_mix(h_lat, p)
            y_ctx = None if last else hyena_mix(h_ctx, p)
        else:
            p = tuple(a[j] for a in ml_params)
            y_lat, y_ctx = mlstm_mix(h_lat, h_ctx, p, not last)
        x = x + g1 * y_lat
        ffn_p = (ffn_w_up[i], ffn_conv_w[i], ffn_conv_b[i], ffn_w_down[i])
        x = x + g2 * conv_ffn(modulate(rmsnorm(x, norm_g[i, 1]), sh2, sc2), *ffn_p, rows, GRID_W)
        if not last:
            ctx = ctx + cg1 * y_ctx
            ctx = ctx + cg2 * conv_ffn(modulate(rmsnorm(ctx, norm_g[i, 1]), csh2, csc2),
                                       *ffn_p, 1, ctx_len)
    return rmsnorm(x, final_g)
```

```cpp
#include <hip/hip_runtime.h>
#include <hip/hip_cooperative_groups.h>
#include <cstdio>
#include <cstdint>
#include <cstddef>
#include <utility>
namespace cg = cooperative_groups;

#define LAS __attribute__((address_space(3)))
typedef unsigned short bf16;
typedef short bf16x8 __attribute__((ext_vector_type(8)));
typedef float f32x4 __attribute__((ext_vector_type(4)));
typedef float f32x2 __attribute__((ext_vector_type(2)));
typedef unsigned u32x4 __attribute__((ext_vector_type(4)));
typedef unsigned u32x2 __attribute__((ext_vector_type(2)));

namespace pg8 {
#define PG8_LAS __attribute__((address_space(3)))
typedef unsigned short bf16_t;
constexpr int BM = 256, BK = 64, HALF = 128, HTB = HALF * BK * 2, STAGE_BYTES = 8 * HTB, NXCD = 8, WGM = 8;
__host__ __device__ __forceinline__ int lds_byte(int r, int c) { const int st = (r >> 4) * 2 + (c >> 5), rr = r & 15, cc = c & 31, ob = rr * 64 + cc * 2; return st * 1024 + (ob ^ (((ob >> 9) & 1) << 5)); }
__host__ __device__ __forceinline__ void stage_rc(int b, int& R, int& C) { const int st = b / 1024, sb = b % 1024, swz = sb ^ (((sb >> 9) & 1) << 5); R = (st >> 1) * 16 + swz / 64; C = (st & 1) * 32 + (swz % 64) / 2; }
__host__ __device__ __forceinline__ int perm32(int rho) { const int n = rho >> 4, i = rho & 15; return 8 * (i >> 2) + 4 * n + (i & 3); }
struct Unit { int pm, pn; };
struct Gemm { const bf16_t* A; const bf16_t* Bt; int M, N, K; };
struct StaticOrder {
    int nM, nN, nwg, G, c;
    __host__ __device__ void init(int M, int N, int G_, int c_) { nM = M / BM; nN = N / BM; nwg = nM * nN; G = G_; c = c_; }
    __host__ __device__ bool next(int i, Unit& u) const {
        const long L = (long)i * G + c; if (L >= nwg) return false;
        int wgid = (int)L; { const int q = nwg / NXCD, r = nwg % NXCD, xcd = wgid % NXCD, off = wgid / NXCD; wgid = (xcd < r ? xcd * (q + 1) : r * (q + 1) + (xcd - r) * q) + off; }
        const int nig = WGM * nN, gid = wgid / nig, fm = gid * WGM, gsz = (nM - fm) < WGM ? (nM - fm) : WGM;
        u.pm = fm + ((wgid % nig) % gsz); u.pn = (wgid % nig) / gsz; return true;
    }
    __device__ __forceinline__ void a_ready(const Unit&) const {}
    __device__ __forceinline__ void done(const Unit&) const {}
};
__device__ __forceinline__ unsigned cvt_pk_bf16(float lo, float hi) { unsigned r; asm volatile("v_cvt_pk_bf16_f32 %0, %1, %2" : "=v"(r) : "v"(lo), "v"(hi)); return r; }

struct EpiBf16 {
    static constexpr bool PERM = true, AFTER_DRAIN = false;
    bf16_t* O; int ldc; const float* bias; int split_cols; size_t split_stride;
    __device__ __forceinline__ void operator()(const f32x4 (&acc)[2][2][4][2], const Unit& u, int wr, int wc, int fr, int fq) const {
        const int row0 = u.pm * BM + wr * 64 + fr; int colt = u.pn * BM; bf16_t* base = O;
        if (split_cols) { const int t = colt / split_cols; base += (size_t)t * split_stride; colt -= t * split_cols; }
        const int col0 = colt + wc * 32 + 8 * fq, bcol0 = u.pn * BM + wc * 32 + 8 * fq;
        f32x4 bv[2][2];
#pragma unroll
        for (int bj = 0; bj < 2; ++bj)
#pragma unroll
            for (int n = 0; n < 2; ++n) bv[bj][n] = bias ? *(const f32x4*)(bias + bcol0 + bj * HALF + 4 * n) : (f32x4){0.f, 0.f, 0.f, 0.f};
#pragma unroll
        for (int ai = 0; ai < 2; ++ai)
#pragma unroll
            for (int m = 0; m < 4; ++m) { bf16_t* rowp = base + (size_t)(row0 + ai * HALF + m * 16) * ldc + col0;
#pragma unroll
                for (int bj = 0; bj < 2; ++bj) { f32x4 v0 = acc[ai][bj][m][0] + bv[bj][0], v1 = acc[ai][bj][m][1] + bv[bj][1];
                    u32x4 w; w.x = cvt_pk_bf16(v0[0], v0[1]); w.y = cvt_pk_bf16(v0[2], v0[3]); w.z = cvt_pk_bf16(v1[0], v1[1]); w.w = cvt_pk_bf16(v1[2], v1[3]);
                    *(u32x4*)(rowp + bj * HALF) = w; } }
    }
};
struct EpiRes {
    static constexpr bool PERM = false, AFTER_DRAIN = false;
    const float* res_lat; float* out_lat; const float* res_ctx; float* out_ctx; int rows_lat; const float* gate; int b0; const float* bias;
    __device__ __forceinline__ void operator()(const f32x4 (&acc)[2][2][4][2], const Unit& u, int wr, int wc, int fr, int fq) const {
        const int trow = u.pm * BM; const float* res; float* out; int modrow;
        if (trow < rows_lat) { res = res_lat + (size_t)trow * 1024; out = out_lat + (size_t)trow * 1024; modrow = b0 + trow / 8192; }
        else { const int rc = trow - rows_lat; res = res_ctx + (size_t)rc * 1024; out = out_ctx + (size_t)rc * 1024; modrow = 4; }
        const int col0 = u.pn * BM + wc * 32 + 4 * fq; const float* gp = gate + (size_t)modrow * 6144 + col0;
#pragma unroll
        for (int bj = 0; bj < 2; ++bj)
#pragma unroll
            for (int n = 0; n < 2; ++n) {
                const f32x4 bv = bias ? *(const f32x4*)(bias + col0 + bj * HALF + n * 16) : (f32x4){0.f, 0.f, 0.f, 0.f}; const f32x4 gv = *(const f32x4*)(gp + bj * HALF + n * 16);
#pragma unroll
                for (int ai = 0; ai < 2; ++ai) {
#pragma unroll
                    for (int m = 0; m < 4; ++m) { const size_t off = (size_t)(wr * 64 + fr + ai * HALF + m * 16) * 1024 + col0 + bj * HALF + n * 16;
                        const f32x4 rs = *(const f32x4*)(res + off); *(f32x4*)(out + off) = rs + gv * (acc[ai][bj][m][n] + bv); }
                    asm volatile("" ::: "memory"); }
            }
    }
};

template <class Epi, class Sched, bool ALIGN_EPI = false, bool SP2 = false>
__device__ __forceinline__ void gemm_phase(PG8_LAS unsigned char* lds, const Gemm g, const Sched& S, const Epi& E, const int tid) {
    const int wid = __builtin_amdgcn_readfirstlane(tid >> 6), lane = tid & 63, wr = wid >> 2, wc = wid & 3, fr = lane & 15, fq = lane >> 4;
    const int K = g.K, nt = K / BK;
    unsigned voffA[2], voffB[2];
#pragma unroll
    for (int i = 0; i < 2; ++i) { int R, C; stage_rc(tid * 16 + i * 8192, R, C); const int Rb = Epi::PERM ? ((R & ~31) + perm32(R & 31)) : R;
        voffA[i] = (unsigned)(R * K + C) * 2u; voffB[i] = (unsigned)(Rb * K + C) * 2u; }
    const size_t kstep = (size_t)(BK * 2);
    const size_t hstep = (size_t)HALF * K * 2;
    const size_t tstep = 2 * hstep;
    const unsigned ldsw = (unsigned)wid * 1024u;
    const int aoff = lds_byte(wr * 64 + fr, fq * 8), boff = lds_byte(wc * 32 + fr, fq * 8);
#define PG8_SA(b, h) (((b) * 2 + (h)) * HTB)
#define PG8_SB(b, h) ((4 + (b) * 2 + (h)) * HTB)
#define PG8_STAGE(bufoff, gbase, voff) do { _Pragma("unroll") for (int _i = 0; _i < 2; ++_i) \
        __builtin_amdgcn_global_load_lds((const unsigned*)((const char*)(gbase) + (voff)[_i]), (PG8_LAS unsigned*)(lds + (bufoff) + ldsw + _i * 8192), 16, 0, 0); } while (0)
#define PG8_LDA(dst, b, h) do { _Pragma("unroll") for (int m = 0; m < 4; ++m) _Pragma("unroll") for (int k = 0; k < 2; ++k) dst[m][k] = *(const PG8_LAS bf16x8*)(lds + PG8_SA(b, h) + aoff + m * 2048 + k * 1024); } while (0)
#define PG8_LDB(dst, b, h) do { _Pragma("unroll") for (int n = 0; n < 2; ++n) _Pragma("unroll") for (int k = 0; k < 2; ++k) dst[n][k] = *(const PG8_LAS bf16x8*)(lds + PG8_SB(b, h) + boff + n * 2048 + k * 1024); } while (0)
#define PG8_MMA(ai, bj, At, Bt) do { __builtin_amdgcn_s_setprio(1); _Pragma("unroll") for (int m = 0; m < 4; ++m) _Pragma("unroll") for (int n = 0; n < 2; ++n) _Pragma("unroll") for (int k = 0; k < 2; ++k) \
        acc[ai][bj][m][n] = __builtin_amdgcn_mfma_f32_16x16x32_bf16(Bt[n][k], At[m][k], acc[ai][bj][m][n], 0, 0, 0); __builtin_amdgcn_s_setprio(0); } while (0)
#define PG8_WAIT_V(n) asm volatile("s_waitcnt vmcnt(" #n ")" ::: "memory")
#define PG8_WAIT_L(n) asm volatile("s_waitcnt lgkmcnt(" #n ")" ::: "memory")
#define PG8_BAR __builtin_amdgcn_s_barrier()
#define PG8_SCHED __builtin_amdgcn_sched_barrier(0)
    Unit cur, nxt; int ui = 0;
    if (!S.next(0, cur)) return;
    f32x4 acc[2][2][4][2];
#pragma unroll
    for (int a = 0; a < 2; ++a)
#pragma unroll
        for (int b = 0; b < 2; ++b)
#pragma unroll
            for (int m = 0; m < 4; ++m)
#pragma unroll
                for (int n = 0; n < 2; ++n) acc[a][b][m][n] = (f32x4){0.f, 0.f, 0.f, 0.f};
    bf16x8 At[4][2], B0[2][2], B1[2][2];
    const char* cA = (const char*)g.A + (size_t)cur.pm * tstep; const char* cB = (const char*)g.Bt + (size_t)cur.pn * tstep;
    S.a_ready(cur);
    if constexpr (SP2) {
        PG8_STAGE(PG8_SB(0, 0), cB, voffB); PG8_STAGE(PG8_SB(0, 1), cB + hstep, voffB); PG8_STAGE(PG8_SA(0, 0), cA, voffA); PG8_STAGE(PG8_SA(0, 1), cA + hstep, voffA);
        if (wr == 1) PG8_BAR;
        PG8_WAIT_V(2); PG8_BAR;
        PG8_STAGE(PG8_SB(1, 0), cB + kstep, voffB); PG8_STAGE(PG8_SA(1, 0), cA + kstep, voffA); PG8_STAGE(PG8_SB(1, 1), cB + hstep + kstep, voffB);
        PG8_WAIT_V(6); PG8_BAR;
    } else {
        PG8_STAGE(PG8_SB(0, 0), cB, voffB); PG8_STAGE(PG8_SA(0, 0), cA, voffA); PG8_STAGE(PG8_SB(0, 1), cB + hstep, voffB); PG8_STAGE(PG8_SA(0, 1), cA + hstep, voffA);
        if (wr == 1) PG8_BAR;
        PG8_WAIT_V(4); PG8_BAR;
        PG8_STAGE(PG8_SB(1, 0), cB + kstep, voffB); PG8_STAGE(PG8_SA(1, 0), cA + kstep, voffA); PG8_STAGE(PG8_SB(1, 1), cB + hstep + kstep, voffB);
        PG8_WAIT_V(6); PG8_BAR;
    }
    for (;;) {
        const bool has_next = S.next(ui + 1, nxt);
        const char* nA = has_next ? (const char*)g.A + (size_t)nxt.pm * tstep : cA; const char* nB = has_next ? (const char*)g.Bt + (size_t)nxt.pn * tstep : cB;
        for (int t = 0; t < nt; t += 2) {
            const bool last = (t == nt - 2);
            const char* a1 = cA + (size_t)(t + 1) * kstep;
            const char* a2 = last ? nA : cA + (size_t)(t + 2) * kstep; const char* b2 = last ? nB : cB + (size_t)(t + 2) * kstep;
            const char* a3 = a2 + kstep; const char* b3 = b2 + kstep;
            if (last && has_next) S.a_ready(nxt);
            if constexpr (SP2) {
            PG8_LDB(B0, 0, 0); PG8_LDB(B1, 0, 1); PG8_SCHED; PG8_LDA(At, 0, 0); PG8_STAGE(PG8_SA(1, 1), a1 + hstep, voffA);
            PG8_WAIT_V(8); PG8_WAIT_L(0); PG8_BAR; PG8_MMA(0, 0, At, B0); PG8_MMA(0, 1, At, B1); PG8_BAR; PG8_SCHED;
            PG8_LDA(At, 0, 1); PG8_STAGE(PG8_SB(0, 0), b2, voffB); PG8_STAGE(PG8_SB(0, 1), b2 + hstep, voffB); PG8_STAGE(PG8_SA(0, 0), a2, voffA);
            PG8_WAIT_V(8); PG8_WAIT_L(0); PG8_BAR; PG8_MMA(1, 0, At, B0); PG8_MMA(1, 1, At, B1); PG8_BAR; PG8_SCHED;
            PG8_LDB(B0, 1, 0); PG8_LDB(B1, 1, 1); PG8_SCHED; PG8_LDA(At, 1, 0); PG8_STAGE(PG8_SA(0, 1), a2 + hstep, voffA);
            PG8_WAIT_V(8); PG8_WAIT_L(0); PG8_BAR; PG8_MMA(0, 0, At, B0); PG8_MMA(0, 1, At, B1); PG8_BAR; PG8_SCHED;
            PG8_LDA(At, 1, 1); PG8_STAGE(PG8_SB(1, 0), b3, voffB); PG8_STAGE(PG8_SB(1, 1), b3 + hstep, voffB); PG8_STAGE(PG8_SA(1, 0), a3, voffA);
            PG8_WAIT_V(8); PG8_WAIT_L(0); PG8_BAR; PG8_MMA(1, 0, At, B0); PG8_MMA(1, 1, At, B1); PG8_BAR; PG8_SCHED;
            } else {
            PG8_LDB(B0, 0, 0); PG8_SCHED; PG8_LDA(At, 0, 0); PG8_STAGE(PG8_SA(1, 1), a1 + hstep, voffA);
            PG8_WAIT_L(8); PG8_BAR; PG8_WAIT_L(0); PG8_MMA(0, 0, At, B0); PG8_BAR; PG8_SCHED;
            PG8_LDB(B1, 0, 1); PG8_STAGE(PG8_SB(0, 0), b2, voffB);
            PG8_BAR; PG8_WAIT_L(0); PG8_MMA(0, 1, At, B1); PG8_BAR;
            PG8_LDA(At, 0, 1); PG8_STAGE(PG8_SA(0, 0), a2, voffA);
            PG8_BAR; PG8_WAIT_L(0); PG8_MMA(1, 0, At, B0); PG8_BAR; PG8_SCHED;
            PG8_STAGE(PG8_SB(0, 1), b2 + hstep, voffB);
            PG8_WAIT_V(6); PG8_BAR; PG8_MMA(1, 1, At, B1); PG8_BAR;
            PG8_LDB(B0, 1, 0); PG8_SCHED; PG8_LDA(At, 1, 0); PG8_STAGE(PG8_SA(0, 1), a2 + hstep, voffA);
            PG8_WAIT_L(8); PG8_BAR; PG8_WAIT_L(0); PG8_MMA(0, 0, At, B0); PG8_BAR; PG8_SCHED;
            PG8_LDB(B1, 1, 1); PG8_STAGE(PG8_SB(1, 0), b3, voffB);
            PG8_BAR; PG8_WAIT_L(0); PG8_MMA(0, 1, At, B1); PG8_BAR;
            PG8_LDA(At, 1, 1); PG8_STAGE(PG8_SA(1, 0), a3, voffA);
            PG8_BAR; PG8_WAIT_L(0); PG8_MMA(1, 0, At, B0); PG8_BAR; PG8_SCHED;
            PG8_STAGE(PG8_SB(1, 1), b3 + hstep, voffB);
            PG8_WAIT_V(6); PG8_BAR; PG8_MMA(1, 1, At, B1); PG8_BAR;
            }
        }
        if constexpr (ALIGN_EPI) { if (wr == 0) PG8_BAR; }
        if constexpr (!Epi::AFTER_DRAIN) { E(acc, cur, wr, wc, fr, fq); S.done(cur); }
        if (!has_next) break;
#pragma unroll
        for (int a = 0; a < 2; ++a)
#pragma unroll
            for (int b = 0; b < 2; ++b)
#pragma unroll
                for (int m = 0; m < 4; ++m)
#pragma unroll
                    for (int n = 0; n < 2; ++n) acc[a][b][m][n] = (f32x4){0.f, 0.f, 0.f, 0.f};
        cur = nxt; cA = nA; cB = nB; ++ui;
        if constexpr (ALIGN_EPI) { if (wr == 1) PG8_BAR; }
    }
    PG8_WAIT_V(0);
    if constexpr (!ALIGN_EPI) { if (wr == 0) PG8_BAR; }
    PG8_BAR;
#undef PG8_SA
#undef PG8_SB
#undef PG8_STAGE
#undef PG8_LDA
#undef PG8_LDB
#undef PG8_MMA
#undef PG8_WAIT_V
#undef PG8_WAIT_L
#undef PG8_BAR
#undef PG8_SCHED
}
}

constexpr int D = 1024, NB = 4, SEQ = 8192, CTXL = 256, ML = NB * SEQ, MC = NB * CTXL, MALL = ML + MC;
constexpr int FF = 2816, MI = 2048, NH = 4, DH = 512, HROWS = 2 * SEQ;
constexpr float EPS = 1e-6f, ML_NORM_EPS = 1e-5f;
constexpr float HY_MAX_DECAY = -15.350567286626973f, HY_MIN_DECAY = -3.0701134573253945f;
constexpr int NWAVES = 8, NTHR = 512;
constexpr int LDS_BYTES = 147456;

constexpr size_t MiB = 1u << 20;
constexpr size_t WS_MOD = 1 * MiB;
constexpr size_t WS_CTXX = 2 * MiB;
constexpr size_t WS_H3 = 6 * MiB;
constexpr size_t WS_KTC = 9 * MiB;
constexpr size_t WS_GWT = 11 * MiB;
constexpr size_t WS_WKQ = 11 * MiB + 256 * 1024;
constexpr size_t WS_WHIN = 16 * MiB, WS_WHOUT = 22 * MiB, WS_WMIN = 24 * MiB, WS_WMDN = 32 * MiB, WS_WUP0 = 36 * MiB, WS_WUP1 = 47 * MiB, WS_WDN0 = 58 * MiB, WS_WDN1 = 58 * MiB + 5767168;
constexpr size_t WS_GATES_L = 69 * MiB;
constexpr size_t WS_GATES_C = 70 * MiB;
constexpr size_t WS_GT_L = 71 * MiB;
constexpr size_t WS_GT_C = 73 * MiB;
constexpr size_t WS_GC = 73 * MiB + 512 * 1024;
constexpr size_t WS_DN = 74 * MiB;
constexpr size_t WS_RS = 79 * MiB;
constexpr size_t WS_INV = 79 * MiB + 512 * 1024;
constexpr size_t BIG = 80 * MiB;
constexpr size_t HY_H = BIG, HY_P = BIG + 66 * MiB, HY_KT = BIG + 264 * MiB, HY_ZT = BIG + 328 * MiB, HY_ZTC = BIG + 392 * MiB, HY_KS = BIG + 394 * MiB;
constexpr size_t FF_H = BIG, FF_A = BIG + 66 * MiB, FF_G = BIG + 248 * MiB;
constexpr size_t MS_H = BIG, MS_XM = BIG + 32 * MiB, MS_XC = BIG + 96 * MiB, MS_KT = BIG + 160 * MiB, MS_VT = BIG + 224 * MiB, MS_NF = BIG + 288 * MiB, MS_NB = BIG + 352 * MiB,
                 MS_KTC = BIG + 416 * MiB, MS_VTC = BIG + 420 * MiB;
constexpr size_t MS_S = MS_XM, MS_Z = MS_KT, MS_KN = MS_NF, MS_XCC = MS_NB, MS_XMC = MS_NB + 4 * MiB, MS_HC = MS_NB + 8 * MiB;
constexpr size_t WS_END = BIG + 424 * MiB;
static_assert(WS_END <= 512 * MiB, "workspace map");
static_assert(FF_G + (size_t)MALL * FF * 2 <= 512 * MiB && FF_A + (size_t)MALL * FF * 2 <= FF_G, "ffn map");
static_assert(HY_P + (size_t)MALL * 3072 * 2 <= HY_KT && HY_ZTC + (size_t)NB * D * CTXL * 2 <= HY_KS && HY_KS + 32 * MiB <= 512 * MiB, "hyena map");

__device__ __forceinline__ unsigned f2bf(float f) { unsigned u = __float_as_uint(f); return (u + 0x7fffu + ((u >> 16) & 1u)) >> 16; }
__device__ __forceinline__ unsigned pk2(float lo, float hi) { return f2bf(lo) | (f2bf(hi) << 16); }
__device__ __forceinline__ float bf2f(unsigned short b) { return __uint_as_float(((unsigned)b) << 16); }
__device__ __forceinline__ float bflo(unsigned w) { return __uint_as_float(w << 16); }
__device__ __forceinline__ float bfhi(unsigned w) { return __uint_as_float(w & 0xffff0000u); }
__device__ __forceinline__ void unpack8(const u32x4 v, float (&o)[8]) { o[0] = bflo(v.x); o[1] = bfhi(v.x); o[2] = bflo(v.y); o[3] = bfhi(v.y); o[4] = bflo(v.z); o[5] = bfhi(v.z); o[6] = bflo(v.w); o[7] = bfhi(v.w); }
__device__ __forceinline__ u32x4 pack8(const float (&o)[8]) { u32x4 v; v.x = pk2(o[0], o[1]); v.y = pk2(o[2], o[3]); v.z = pk2(o[4], o[5]); v.w = pk2(o[6], o[7]); return v; }
__device__ __forceinline__ float wave_sum(float v) {
#pragma unroll
    for (int o = 1; o < 64; o <<= 1) v += __shfl_xor(v, o);
    return v;
}
__device__ __forceinline__ float silu_f(float x) { return x / (1.0f + __expf(-x)); }

typedef const float* cfptr_t;
struct Fr {
    LAS unsigned char* lds; int tid, lane, wave, gw, ngw, G, bid;
    const __attribute__((address_space(4))) cfptr_t* in; float* out; unsigned char* ws;
};
#define IN(i) (F.in[i])
enum { I_X = 0, I_C, I_CTX, I_CCTX, I_MODW, I_MODB, I_NORMG, I_FINALG, I_HWIN, I_HBIN, I_HSCW, I_HSCB, I_FW1, I_FB1, I_FW2, I_FB2, I_FW3, I_FB3, I_FWOUT, I_FREQ, I_HBIAS, I_HWOUT, I_HBOUT,
       I_MWIN, I_MCW, I_MCB, I_MWQ, I_MWK, I_MWV, I_MWG, I_MBG, I_MNW, I_MSKIP, I_MWDN, I_FWUP, I_FCW, I_FCB, I_FWDN };

__device__ __forceinline__ void transpose_item(const float* W, int K, int N, bf16* WT, LAS float* scr, int item, int lane) {
    const int nblk = N / 32, kb = item / nblk, nb = item % nblk, k0 = 64 * kb, n0 = 32 * nb;
#pragma unroll 8
    for (int i = 0; i < 32; ++i) { const int kk = 2 * i + (lane >> 5); scr[kk * 33 + (lane & 31)] = W[(size_t)(k0 + kk) * N + n0 + (lane & 31)]; }
    asm volatile("s_waitcnt lgkmcnt(0)" ::: "memory");
    const int c = lane & 7;
#pragma unroll
    for (int j = 0; j < 4; ++j) { const int n = (lane >> 3) + 8 * j; const LAS float* s = scr + (8 * c) * 33 + n;
        u32x4 o; o.x = pk2(s[0 * 33], s[1 * 33]); o.y = pk2(s[2 * 33], s[3 * 33]); o.z = pk2(s[4 * 33], s[5 * 33]); o.w = pk2(s[6 * 33], s[7 * 33]);
        *(u32x4*)(WT + (size_t)(n0 + n) * K + k0 + 8 * c) = o; }
    asm volatile("s_waitcnt lgkmcnt(0)" ::: "memory");
}
__device__ __forceinline__ void transpose_matrix(Fr& F, const float* W, int K, int N, bf16* WT) {
    LAS float* scr = (LAS float*)(F.lds + F.wave * 16384);
    const int nitems = (K / 64) * (N / 32);
    for (int it = F.gw; it < nitems; it += F.ngw) transpose_item(W, K, N, WT, scr, it, F.lane);
}

__device__ __forceinline__ void ph_prologue(Fr& F) {
    unsigned char* ws = F.ws;
    transpose_matrix(F, IN(I_HWIN), D, 3 * D, (bf16*)(ws + WS_WHIN));
    transpose_matrix(F, IN(I_HWOUT), D, D, (bf16*)(ws + WS_WHOUT));
    transpose_matrix(F, IN(I_MWIN), D, 2 * MI, (bf16*)(ws + WS_WMIN));
    transpose_matrix(F, IN(I_MWDN), MI, D, (bf16*)(ws + WS_WMDN));
    transpose_matrix(F, IN(I_FWUP), D, 2 * FF, (bf16*)(ws + WS_WUP0));
    transpose_matrix(F, IN(I_FWUP) + (size_t)D * 2 * FF, D, 2 * FF, (bf16*)(ws + WS_WUP1));
    transpose_matrix(F, IN(I_FWDN), FF, D, (bf16*)(ws + WS_WDN0));
    transpose_matrix(F, IN(I_FWDN) + (size_t)FF * D, FF, D, (bf16*)(ws + WS_WDN1));
    __syncthreads();
    {
        LAS float* sc = (LAS float*)F.lds;
        LAS float* red = (LAS float*)(F.lds + 32768);
        for (int i = F.tid; i < 5 * 1024; i += NTHR) { const int r = i >> 10, k = i & 1023; const float v = r < 4 ? IN(I_C)[r * 1024 + k] : IN(I_CCTX)[k]; sc[i] = silu_f(v); }
        __syncthreads();
        float* mod = (float*)(ws + WS_MOD);
        for (int it = F.bid; it < 192; it += F.G) {
            const int l = it / 96, n0 = (it % 96) * 64;
            const float* w = IN(I_MODW) + (size_t)l * 1024 * 6144 + n0 + F.lane;
            float a0 = 0.f, a1 = 0.f, a2 = 0.f, a3 = 0.f, a4 = 0.f;
            const int kb = F.wave * 128;
#pragma unroll 8
            for (int k = 0; k < 128; ++k) { const float wv = w[(size_t)(kb + k) * 6144];
                a0 += sc[kb + k] * wv; a1 += sc[1024 + kb + k] * wv; a2 += sc[2048 + kb + k] * wv; a3 += sc[3072 + kb + k] * wv; a4 += sc[4096 + kb + k] * wv; }
            red[(F.wave * 5 + 0) * 64 + F.lane] = a0; red[(F.wave * 5 + 1) * 64 + F.lane] = a1; red[(F.wave * 5 + 2) * 64 + F.lane] = a2; red[(F.wave * 5 + 3) * 64 + F.lane] = a3; red[(F.wave * 5 + 4) * 64 + F.lane] = a4;
            __syncthreads();
            if (F.tid < 320) { const int r = F.tid >> 6, ln = F.tid & 63; float s = 0.f;
#pragma unroll
                for (int w8 = 0; w8 < 8; ++w8) s += red[(w8 * 5 + r) * 64 + ln];
                mod[((size_t)l * 5 + r) * 6144 + n0 + ln] = s + IN(I_MODB)[l * 6144 + n0 + ln]; }
            __syncthreads();
        }
    }
    {
        float* h3 = (float*)(ws + WS_H3);
        const float* w1 = IN(I_FW1); const float* w2 = IN(I_FW2); const float* w3 = IN(I_FW3);
        const float fr = IN(I_FREQ)[F.lane], b1 = IN(I_FB1)[F.lane], b2 = IN(I_FB2)[F.lane], b3 = IN(I_FB3)[F.lane];
        for (int row = F.gw; row < SEQ + CTXL; row += F.ngw) {
            const int L = row < SEQ ? SEQ : CTXL, i = row < SEQ ? row : row - SEQ;
            const float tl = (float)i / (float)(L - 1), w = 6.283185307179586f * (float)i / (float)L;
            float pos = 0.f; const int k = F.lane;
            if (k == 0) pos = tl;
            else if (k <= 16) { const float band = 1e-4f + (float)(k - 1) * ((15.0f - 1e-4f) / 15.0f); pos = cosf(band * w); }
            else if (k <= 32) { const float band = 1e-4f + (float)(k - 17) * ((15.0f - 1e-4f) / 15.0f); pos = -sinf(band * w); }
            float s = b1;
#pragma unroll
            for (int kk = 0; kk < 33; ++kk) s += __shfl(pos, kk) * w1[kk * 64 + F.lane];
            float h = sinf(fr * s);
            s = b2;
#pragma unroll 16
            for (int kk = 0; kk < 64; ++kk) s += __shfl(h, kk) * w2[kk * 64 + F.lane];
            h = sinf(fr * s);
            s = b3;
#pragma unroll 16
            for (int kk = 0; kk < 64; ++kk) s += __shfl(h, kk) * w3[kk * 64 + F.lane];
            h = sinf(fr * s);
            h3[(size_t)row * 64 + F.lane] = h;
        }
    }
    {
        bf16* gwt = (bf16*)(ws + WS_GWT); float* wkq = (float*)(ws + WS_WKQ);
        const float* wq = IN(I_MWQ); const float* wk = IN(I_MWK); const float* wv = IN(I_MWV); const float* wg = IN(I_MWG);
        const int gt = F.bid * NTHR + F.tid, nt = F.G * NTHR;
        for (int i = gt; i < MI * 16; i += nt) { const int ch = i >> 4, g = i & 15, n = ch >> 2, c = ch & 3; float sa = 0.f, sb = 0.f;
#pragma unroll
            for (int e = 0; e < 4; ++e) { sa += wq[n * 16 + c * 4 + e] * wg[(size_t)(n * 4 + e) * 16 + g] + wk[n * 16 + c * 4 + e] * wg[(size_t)(MI + n * 4 + e) * 16 + g];
                sb += wv[n * 16 + c * 4 + e] * wg[(size_t)(2 * MI + n * 4 + e) * 16 + g]; }
            gwt[(size_t)g * 4096 + ch] = (bf16)f2bf(sa); gwt[(size_t)g * 4096 + MI + ch] = (bf16)f2bf(sb); }
        const float sc = 0.044194173824159216f;
        for (int i = gt; i < 512 * 16; i += nt) { const int n = i >> 4, c = (i >> 2) & 3, c2 = i & 3; float s = 0.f;
#pragma unroll
            for (int e = 0; e < 4; ++e) s += wk[n * 16 + c * 4 + e] * wq[n * 16 + c2 * 4 + e];
            wkq[i] = s * sc; }
    }
}

__device__ __forceinline__ void kt_items(Fr& F, const float* h3rows, int L, float* KT) {
    const float* wout = IN(I_FWOUT);
    const int nitems = (L / 64) * 64;
    for (int it = F.gw; it < nitems; it += F.ngw) {
        const int tb = it >> 6, nc = it & 63, t = tb * 64 + F.lane;
        float h[64];
        const f32x4* hp = (const f32x4*)(h3rows + (size_t)t * 64);
#pragma unroll
        for (int q = 0; q < 16; ++q) { const f32x4 v = hp[q]; h[4 * q] = v[0]; h[4 * q + 1] = v[1]; h[4 * q + 2] = v[2]; h[4 * q + 3] = v[3]; }
        const float tl = (float)t / (float)(L - 1);
#pragma unroll 1
        for (int nn = 0; nn < 32; ++nn) {
            const int n = nc * 32 + nn; float acc = 0.f;
#pragma unroll
            for (int k = 0; k < 64; ++k) acc += h[k] * wout[k * 2048 + n];
            const int dirn = n >> 10, c = n & 1023;
            const float delta = fabsf(HY_MIN_DECAY + (float)c * ((HY_MAX_DECAY - HY_MIN_DECAY) / 1023.0f));
            KT[((size_t)c * 2 + dirn) * L + t] = acc * __expf(-tl * delta);
        }
    }
}

__device__ __forceinline__ void modnorm_row(const float* xrow, const float* g, const float* sh, const float* sc, bf16* orow, int lane) {
    const f32x4* xr = (const f32x4*)xrow + lane; f32x4 v[4]; float s = 0.f;
#pragma unroll
    for (int j = 0; j < 4; ++j) { v[j] = xr[64 * j]; s += (v[j][0] * v[j][0] + v[j][1] * v[j][1]) + (v[j][2] * v[j][2] + v[j][3] * v[j][3]); }
    const float rinv = 1.0f / sqrtf(wave_sum(s) * (1.0f / 1024.0f) + EPS);
    u32x2* o8 = (u32x2*)orow + lane;
#pragma unroll
    for (int j = 0; j < 4; ++j) { const int c = 4 * lane + 256 * j; const f32x4 gg = *(const f32x4*)(g + c), s1 = *(const f32x4*)(sc + c), s0 = *(const f32x4*)(sh + c);
        const f32x4 y = (v[j] * rinv * gg) * (1.0f + s1) + s0; u32x2 w; w.x = pk2(y[0], y[1]); w.y = pk2(y[2], y[3]); o8[64 * j] = w; }
}
__device__ __forceinline__ void ph_modnorm(Fr& F, const float* xlat, int nlat, int b0, const float* xctx, int nctx, const float* g, const float* modl, int shoff, bf16* H) {
    for (int r = F.gw; r < nlat + nctx; r += F.ngw) {
        const bool isl = r < nlat; const float* xr = isl ? xlat + (size_t)r * 1024 : xctx + (size_t)(r - nlat) * 1024; const int mr = isl ? b0 + r / SEQ : 4;
        modnorm_row(xr, g, modl + (size_t)mr * 6144 + shoff, modl + (size_t)mr * 6144 + shoff + 1024, H + (size_t)r * 1024, F.lane);
    }
}

__device__ __forceinline__ void zt_items(Fr& F, const bf16* P, int rowbase, int nb, int Ls, bf16* ZT) {
    LAS unsigned char* tile = F.lds + F.wave * 16384;
    const float* scw = IN(I_HSCW); const float* scb = IN(I_HSCB);
    const int ntt = Ls / 64, nitems = nb * ntt * 16;
    for (int it = F.gw; it < nitems; it += F.ngw) {
        const int ct = it & 15, tt = (it >> 4) % ntt, b = (it >> 4) / ntt, t0 = tt * 64, c = ct * 64 + F.lane;
        const float w10 = scw[1024 + c], w11 = scw[3072 + 1024 + c], w12 = scw[6144 + 1024 + c], bb1 = scb[1024 + c];
        const float w20 = scw[2048 + c], w21 = scw[3072 + 2048 + c], w22 = scw[6144 + 2048 + c], bb2 = scb[2048 + c];
        const bf16* pb = P + (size_t)(rowbase + b * Ls) * 3072;
        float x1p = 0.f, x1c = 0.f, vp = 0.f, vc = 0.f;
        if (t0 > 0) { x1p = bf2f(pb[(size_t)(t0 - 1) * 3072 + 1024 + c]); vp = bf2f(pb[(size_t)(t0 - 1) * 3072 + 2048 + c]); }
        x1c = bf2f(pb[(size_t)t0 * 3072 + 1024 + c]); vc = bf2f(pb[(size_t)t0 * 3072 + 2048 + c]);
#pragma unroll 4
        for (int j = 0; j < 64; ++j) {
            const int tn = t0 + j + 1; float x1n = 0.f, vn = 0.f;
            if (tn < Ls) { x1n = bf2f(pb[(size_t)tn * 3072 + 1024 + c]); vn = bf2f(pb[(size_t)tn * 3072 + 2048 + c]); }
            const float a = w10 * x1p + w11 * x1c + w12 * x1n + bb1, d = w20 * vp + w21 * vc + w22 * vn + bb2;
            *(LAS bf16*)(tile + F.lane * 136 + j * 2) = (bf16)f2bf(a * d);
            x1p = x1c; x1c = x1n; vp = vc; vc = vn;
        }
#pragma unroll
        for (int q = 0; q < 8; ++q) { const int cc = q * 8 + (F.lane >> 3), ch = F.lane & 7;
            const u32x2 lo = *(const LAS u32x2*)(tile + cc * 136 + ch * 16), hi = *(const LAS u32x2*)(tile + cc * 136 + ch * 16 + 8);
            u32x4 o; o.x = lo.x; o.y = lo.y; o.z = hi.x; o.w = hi.y;
            *(u32x4*)(ZT + ((size_t)b * 1024 + ct * 64 + cc) * Ls + t0 + ch * 8) = o; }
    }
}

__device__ __forceinline__ f32x2 cmul(f32x2 a, f32x2 b) { return (f32x2){a.x * b.x - a.y * b.y, a.x * b.y + a.y * b.x}; }
__device__ __forceinline__ f32x2 twid(float f) { return (f32x2){__builtin_amdgcn_cosf(f), __builtin_amdgcn_sinf(f)}; }
__device__ __forceinline__ void fft_fwd(LAS f32x2* buf, int tid) {
#pragma unroll 1
    for (int p = 0; p < 7; ++p) {
        const int lq = 12 - 2 * p, q = 1 << lq; const float invN = 1.0f / (float)(4 * q);
#pragma unroll 1
        for (int m = 0; m < 8; ++m) {
            const int g = tid + 512 * m, i = g & (q - 1), i0 = ((g >> lq) << (lq + 2)) + i;
            const f32x2 a0 = buf[i0], a1 = buf[i0 + q], a2 = buf[i0 + 2 * q], a3 = buf[i0 + 3 * q];
            const f32x2 t0 = a0 + a2, t1 = a0 - a2, t2 = a1 + a3, d = a1 - a3, t3 = (f32x2){d.y, -d.x};
            const float f = -(float)i * invN;
            buf[i0] = t0 + t2; buf[i0 + q] = cmul(t1 + t3, twid(f)); buf[i0 + 2 * q] = cmul(t0 - t2, twid(2.f * f)); buf[i0 + 3 * q] = cmul(t1 - t3, twid(3.f * f));
        }
        __syncthreads();
    }
}
__device__ __forceinline__ void fft_inv(LAS f32x2* buf, int tid) {
#pragma unroll 1
    for (int p = 6; p >= 0; --p) {
        const int lq = 12 - 2 * p, q = 1 << lq; const float invN = 1.0f / (float)(4 * q);
#pragma unroll 1
        for (int m = 0; m < 8; ++m) {
            const int g = tid + 512 * m, i = g & (q - 1), i0 = ((g >> lq) << (lq + 2)) + i;
            const float f = (float)i * invN;
            const f32x2 b0 = buf[i0], b1 = cmul(buf[i0 + q], twid(f)), b2 = cmul(buf[i0 + 2 * q], twid(2.f * f)), b3 = cmul(buf[i0 + 3 * q], twid(3.f * f));
            const f32x2 t0 = b0 + b2, t1 = b0 - b2, t2 = b1 + b3, d = b1 - b3, t3 = (f32x2){-d.y, d.x};
            buf[i0] = t0 + t2; buf[i0 + q] = t1 + t3; buf[i0 + 2 * q] = t0 - t2; buf[i0 + 3 * q] = t1 - t3;
        }
        __syncthreads();
    }
}
__device__ __forceinline__ float block_sum(Fr& F, float v, LAS float* red) {
    v = wave_sum(v);
    __syncthreads();
    if (F.lane == 0) red[F.wave] = v;
    __syncthreads();
    float s = 0.f;
#pragma unroll
    for (int w = 0; w < 8; ++w) s += red[w];
    return s;
}
__device__ __forceinline__ void ph_fftconv(Fr& F) {
    LAS f32x2* buf = (LAS f32x2*)F.lds; LAS float* red = (LAS float*)(F.lds + 131072);
    const float* KT = (const float*)(F.ws + HY_KT); const float* KTC = (const float*)(F.ws + WS_KTC);
    bf16* ZT = (bf16*)(F.ws + HY_ZT); bf16* ZTC = (bf16*)(F.ws + HY_ZTC);
    const int tid = F.tid;
    for (int c = F.bid; c < 1024; c += F.G) {
        const float bias = IN(I_HBIAS)[c];
        __syncthreads();
        float asum = 0.f;
        const f32x4* kf = (const f32x4*)(KT + (size_t)c * 2 * SEQ); const f32x4* kb = kf + SEQ / 4;
#pragma unroll
        for (int q = 0; q < 4; ++q) { const int i4 = tid + 512 * q; const f32x4 v = kf[i4];
            asum += fabsf(v[0]) + fabsf(v[1]) + fabsf(v[2]) + fabsf(v[3]);
            buf[4 * i4] = (f32x2){v[0], 0.f}; buf[4 * i4 + 1] = (f32x2){v[1], 0.f}; buf[4 * i4 + 2] = (f32x2){v[2], 0.f}; buf[4 * i4 + 3] = (f32x2){v[3], 0.f};
            const f32x4 u = kb[i4]; const int m = 4 * i4;
            if (m > 0) { buf[16384 - m] = (f32x2){u[0], 0.f}; asum += fabsf(u[0]); } else buf[8192] = (f32x2){0.f, 0.f};
            buf[16384 - m - 1] = (f32x2){u[1], 0.f}; buf[16384 - m - 2] = (f32x2){u[2], 0.f}; buf[16384 - m - 3] = (f32x2){u[3], 0.f};
            asum += fabsf(u[1]) + fabsf(u[2]) + fabsf(u[3]); }
        const float S = block_sum(F, asum, red);
        __syncthreads();
        fft_fwd(buf, tid);
        f32x2* Ks = (f32x2*)(F.ws + HY_KS) + (size_t)(F.bid & 255) * 16384 + tid; const float ksc = 1.0f / (S * 16384.0f);
#pragma unroll 8
        for (int j = 0; j < 32; ++j) Ks[512 * j] = buf[tid + 512 * j] * ksc;
#pragma unroll 1
        for (int pr = 0; pr < 2; ++pr) {
            bf16* z0 = ZT + ((size_t)(2 * pr) * 1024 + c) * SEQ; bf16* z1 = ZT + ((size_t)(2 * pr + 1) * 1024 + c) * SEQ;
            __syncthreads();
#pragma unroll
            for (int q = 0; q < 2; ++q) { const int t8 = (tid + 512 * q) * 8; float a[8], b[8];
                unpack8(*(const u32x4*)(z0 + t8), a); unpack8(*(const u32x4*)(z1 + t8), b);
#pragma unroll
                for (int e = 0; e < 8; ++e) { buf[t8 + e] = (f32x2){a[e], b[e]}; buf[8192 + t8 + e] = (f32x2){0.f, 0.f}; } }
            __syncthreads();
            fft_fwd(buf, tid);
#pragma unroll 8
            for (int j = 0; j < 32; ++j) buf[tid + 512 * j] = cmul(buf[tid + 512 * j], Ks[512 * j]);
            __syncthreads();
            fft_inv(buf, tid);
#pragma unroll
            for (int q = 0; q < 2; ++q) { const int t8 = (tid + 512 * q) * 8; float a[8], b[8];
                unpack8(*(const u32x4*)(z0 + t8), a); unpack8(*(const u32x4*)(z1 + t8), b);
#pragma unroll
                for (int e = 0; e < 8; ++e) { const f32x2 y = buf[t8 + e]; a[e] = y.x + a[e] * bias; b[e] = y.y + b[e] * bias; }
                *(u32x4*)(z0 + t8) = pack8(a); *(u32x4*)(z1 + t8) = pack8(b); }
        }
        __syncthreads();
        {
            LAS float* kc = (LAS float*)F.lds; LAS float* zc = kc + 512;
            const float* kfc = KTC + (size_t)c * 2 * CTXL; float v = 0.f;
            { const int n = tid; if (n < 256) v = kfc[n]; else if (n == 256) v = 0.f; else v = kfc[CTXL + (512 - n)]; kc[n] = v; }
            const float Sc = block_sum(F, fabsf(v), red);
            for (int i = tid; i < 1024; i += NTHR) { const int b = i >> 8, t = i & 255; zc[i] = bf2f(ZTC[((size_t)b * 1024 + c) * CTXL + t]); }
            __syncthreads();
            const int b = tid >> 7, t2 = tid & 127; const float isc = 1.0f / Sc;
#pragma unroll
            for (int hh = 0; hh < 2; ++hh) { const int t = t2 + 128 * hh; float acc = 0.f;
#pragma unroll 8
                for (int s = 0; s < 256; ++s) acc += zc[b * 256 + s] * kc[(t - s) & 511];
                ZTC[((size_t)b * 1024 + c) * CTXL + t] = (bf16)f2bf(acc * isc + zc[b * 256 + t] * bias); }
        }
    }
}

__device__ __forceinline__ void u2_items(Fr& F, const bf16* P, int rowbase, int nb, int Ls, const bf16* YT, bf16* U2) {
    LAS unsigned char* tile = F.lds + F.wave * 16384;
    const float* scw = IN(I_HSCW); const float* scb = IN(I_HSCB);
    const int ntt = Ls / 64, nitems = nb * ntt * 16;
    for (int it = F.gw; it < nitems; it += F.ngw) {
        const int ct = it & 15, tt = (it >> 4) % ntt, b = (it >> 4) / ntt, t0 = tt * 64, c = ct * 64 + F.lane;
#pragma unroll
        for (int q = 0; q < 8; ++q) { const int cc = q * 8 + (F.lane >> 3), ch = F.lane & 7;
            const u32x4 v = *(const u32x4*)(YT + ((size_t)b * 1024 + ct * 64 + cc) * Ls + t0 + ch * 8);
            *(LAS u32x2*)(tile + cc * 136 + ch * 16) = (u32x2){v.x, v.y}; *(LAS u32x2*)(tile + cc * 136 + ch * 16 + 8) = (u32x2){v.z, v.w}; }
        const float w0 = scw[c], w1 = scw[3072 + c], w2 = scw[6144 + c], bb = scb[c];
        const bf16* pb = P + (size_t)(rowbase + b * Ls) * 3072; bf16* ub = U2 + (size_t)(rowbase + b * Ls) * 1024;
        float xp = 0.f, xc = bf2f(pb[(size_t)t0 * 3072 + c]);
        if (t0 > 0) xp = bf2f(pb[(size_t)(t0 - 1) * 3072 + c]);
#pragma unroll 4
        for (int j = 0; j < 64; ++j) {
            const int tn = t0 + j + 1; float xn = 0.f; if (tn < Ls) xn = bf2f(pb[(size_t)tn * 3072 + c]);
            const float x0 = w0 * xp + w1 * xc + w2 * xn + bb, y = bf2f(*(const LAS bf16*)(tile + F.lane * 136 + j * 2));
            ub[(size_t)(t0 + j) * 1024 + c] = (bf16)f2bf(x0 * y);
            xp = xc; xc = xn;
        }
    }
}

__device__ __forceinline__ void ph_dwconv(Fr& F, int layer, int nlat, int nctx) {
    bf16* A = (bf16*)(F.ws + FF_A); const bf16* G = (const bf16*)(F.ws + FF_G);
    const float* cw = IN(I_FCW) + (size_t)layer * 9 * FF; const float* cb = IN(I_FCB) + (size_t)layer * FF;
    const size_t total = (size_t)(nlat + nctx) * 352, gt = (size_t)F.bid * NTHR + F.tid, nt = (size_t)F.G * NTHR;
    for (size_t i = gt; i < total; i += nt) {
        const int r = (int)(i / 352), f8 = (int)(i % 352) * 8;
        float acc[8];
        { const f32x4 b0 = *(const f32x4*)(cb + f8), b1 = *(const f32x4*)(cb + f8 + 4); acc[0] = b0[0]; acc[1] = b0[1]; acc[2] = b0[2]; acc[3] = b0[3]; acc[4] = b1[0]; acc[5] = b1[1]; acc[6] = b1[2]; acc[7] = b1[3]; }
        if (r < nlat) {
            const int t = r & (SEQ - 1), gy = t >> 6, gx = t & 63;
#pragma unroll
            for (int dy = -1; dy <= 1; ++dy)
#pragma unroll
                for (int dx = -1; dx <= 1; ++dx) {
                    if (gy + dy < 0 || gy + dy > 127 || gx + dx < 0 || gx + dx > 63) continue;
                    float v[8]; unpack8(*(const u32x4*)(G + (size_t)(r + dy * 64 + dx) * FF + f8), v);
                    const float* wp = cw + (size_t)((dy + 1) * 3 + (dx + 1)) * FF + f8; const f32x4 w0 = *(const f32x4*)wp, w1 = *(const f32x4*)(wp + 4);
                    acc[0] += v[0] * w0[0]; acc[1] += v[1] * w0[1]; acc[2] += v[2] * w0[2]; acc[3] += v[3] * w0[3]; acc[4] += v[4] * w1[0]; acc[5] += v[5] * w1[1]; acc[6] += v[6] * w1[2]; acc[7] += v[7] * w1[3];
                }
        } else {
            const int t = (r - nlat) & (CTXL - 1);
#pragma unroll
            for (int dx = -1; dx <= 1; ++dx) {
                if (t + dx < 0 || t + dx > CTXL - 1) continue;
                float v[8]; unpack8(*(const u32x4*)(G + (size_t)(r + dx) * FF + f8), v);
                const float* wp = cw + (size_t)(3 + (dx + 1)) * FF + f8; const f32x4 w0 = *(const f32x4*)wp, w1 = *(const f32x4*)(wp + 4);
                acc[0] += v[0] * w0[0]; acc[1] += v[1] * w0[1]; acc[2] += v[2] * w0[2]; acc[3] += v[3] * w0[3]; acc[4] += v[4] * w1[0]; acc[5] += v[5] * w1[1]; acc[6] += v[6] * w1[2]; acc[7] += v[7] * w1[3];
            }
        }
        float a[8]; unpack8(*(const u32x4*)(A + (size_t)r * FF + f8), a);
#pragma unroll
        for (int e = 0; e < 8; ++e) a[e] = silu_f(acc[e]) * a[e];
        *(u32x4*)(A + (size_t)r * FF + f8) = pack8(a);
    }
}

__device__ __forceinline__ void prep_items(Fr& F, const bf16* XM, int nb, int Ls, bf16* XC, bf16* KN, bf16* KT, bf16* VT) {
    LAS unsigned char* tk = F.lds + F.wave * 17408; LAS unsigned char* tv = tk + 8704;
    const int ntt = Ls / 64, nitems = nb * ntt * 32;
    const int tl = F.lane >> 3, c8 = F.lane & 7;
    for (int it = F.gw; it < nitems; it += F.ngw) {
        const int cg = it & 31, tt = (it >> 5) % ntt, b = (it >> 5) / ntt, t0 = tt * 64, ch0 = cg * 64 + c8 * 8, h = cg >> 3;
        float cw0[8], cw1[8], cw2[8], cbb[8], wkq[32], wv[32];
        { const float* p = IN(I_MCW) + ch0; const float* pb = IN(I_MCB) + ch0;
#pragma unroll
            for (int e = 0; e < 8; ++e) { cw0[e] = p[e]; cw1[e] = p[MI + e]; cw2[e] = p[2 * MI + e]; cbb[e] = pb[e]; }
            const float* q = (const float*)(F.ws + WS_WKQ) + (ch0 >> 2) * 16; const float* v = IN(I_MWV) + (ch0 >> 2) * 16;
#pragma unroll
            for (int e = 0; e < 32; ++e) { wkq[e] = q[e]; wv[e] = v[e]; } }
#pragma unroll 1
        for (int i8 = 0; i8 < 8; ++i8) {
            const int tloc = i8 * 8 + tl, t = t0 + tloc; const size_t row = (size_t)b * Ls + t;
            float xp[8], xm[8], xn[8];
            unpack8(*(const u32x4*)(XM + row * MI + ch0), xm);
            if (t > 0) unpack8(*(const u32x4*)(XM + (row - 1) * MI + ch0), xp); else {
#pragma unroll
                for (int e = 0; e < 8; ++e) xp[e] = 0.f; }
            if (t + 1 < Ls) unpack8(*(const u32x4*)(XM + (row + 1) * MI + ch0), xn); else {
#pragma unroll
                for (int e = 0; e < 8; ++e) xn[e] = 0.f; }
            float xc[8], kp[8], vv[8];
#pragma unroll
            for (int e = 0; e < 8; ++e) xc[e] = silu_f(cw0[e] * xp[e] + cw1[e] * xm[e] + cw2[e] * xn[e] + cbb[e]);
#pragma unroll
            for (int n = 0; n < 2; ++n)
#pragma unroll
                for (int o = 0; o < 4; ++o) { float sk = 0.f, sv = 0.f;
#pragma unroll
                    for (int c = 0; c < 4; ++c) { sk += xc[n * 4 + c] * wkq[n * 16 + c * 4 + o]; sv += xm[n * 4 + c] * wv[n * 16 + c * 4 + o]; }
                    kp[n * 4 + o] = sk; vv[n * 4 + o] = sv; }
            *(u32x4*)(XC + row * MI + ch0) = pack8(xc);
            *(u32x4*)(KN + row * MI + ch0) = pack8(kp);
#pragma unroll
            for (int e = 0; e < 8; ++e) { *(LAS bf16*)(tk + (c8 * 8 + e) * 136 + tloc * 2) = (bf16)f2bf(kp[e]); *(LAS bf16*)(tv + (c8 * 8 + e) * 136 + tloc * 2) = (bf16)f2bf(vv[e]); }
        }
#pragma unroll
        for (int q = 0; q < 8; ++q) { const int cc = q * 8 + (F.lane >> 3), chk = F.lane & 7;
            const size_t o = ((size_t)(b * 4 + h) * 512 + (cg & 7) * 64 + cc) * Ls + t0 + chk * 8;
            { const u32x2 lo = *(const LAS u32x2*)(tk + cc * 136 + chk * 16), hi = *(const LAS u32x2*)(tk + cc * 136 + chk * 16 + 8); *(u32x4*)(KT + o) = (u32x4){lo.x, lo.y, hi.x, hi.y}; }
            { const u32x2 lo = *(const LAS u32x2*)(tv + cc * 136 + chk * 16), hi = *(const LAS u32x2*)(tv + cc * 136 + chk * 16 + 8); *(u32x4*)(VT + o) = (u32x4){lo.x, lo.y, hi.x, hi.y}; }
        }
    }
}

__device__ __forceinline__ void gate_items(Fr& F, const bf16* XC, const bf16* XM, int R, float* GATES) {
    const bf16* gwt = (const bf16*)(F.ws + WS_GWT);
    const int fr = F.lane & 15, fq = F.lane >> 4;
    for (int tile = F.gw; tile < R / 16; tile += F.ngw) {
        const int r0 = tile * 16; f32x4 acc = (f32x4){0.f, 0.f, 0.f, 0.f};
        const bf16* ap = XC + (size_t)(r0 + fr) * MI + 8 * fq; const bf16* bp = gwt + (size_t)fr * 4096 + 8 * fq;
#pragma unroll 8
        for (int ks = 0; ks < 64; ++ks) acc = __builtin_amdgcn_mfma_f32_16x16x32_bf16(*(const bf16x8*)(ap + ks * 32), *(const bf16x8*)(bp + ks * 32), acc, 0, 0, 0);
        ap = XM + (size_t)(r0 + fr) * MI + 8 * fq; bp += MI;
#pragma unroll 8
        for (int ks = 0; ks < 64; ++ks) acc = __builtin_amdgcn_mfma_f32_16x16x32_bf16(*(const bf16x8*)(ap + ks * 32), *(const bf16x8*)(bp + ks * 32), acc, 0, 0, 0);
        const float bg = IN(I_MBG)[fr]; const bool isf = (fr >> 2) & 1;
#pragma unroll
        for (int r = 0; r < 4; ++r) { float x = acc[r] + bg; if (isf) x = fminf(x, 0.f) - log1pf(__expf(-fabsf(x))); GATES[(size_t)(r0 + 4 * fq + r) * 16 + fr] = x; }
    }
}

__device__ __forceinline__ void cum_items(Fr& F, const float* GATES, int nb, int Ls, int gb0, int ctau0, f32x4* GT, float* GC) {
    const int R = nb * Ls, nch = Ls / 128, nitems = 2 * nb * 4 * nch;
    for (int it = F.gw; it < nitems; it += F.ngw) {
        const int c = it % nch, h = (it / nch) & 3, b = (it / nch / 4) % nb, dir = it / nch / 4 / nb;
        const int row0 = b * Ls + c * 128 + 2 * F.lane;
        const float lf0 = GATES[(size_t)row0 * 16 + dir * 8 + 4 + h], lf1 = GATES[(size_t)(row0 + 1) * 16 + dir * 8 + 4 + h];
        const float ig0 = GATES[(size_t)row0 * 16 + dir * 8 + h], ig1 = GATES[(size_t)(row0 + 1) * 16 + dir * 8 + h];
        float inc = lf0 + lf1;
#pragma unroll
        for (int o = 1; o < 64; o <<= 1) { const float t = __shfl_up(inc, o); if (F.lane >= o) inc += t; }
        const float tot = __shfl(inc, 63), exc = inc - (lf0 + lf1);
        float b0, b1;
        if (dir == 0) { b0 = exc + lf0; b1 = inc; } else { b0 = tot - exc; b1 = tot - exc - lf0; }
        GT[(size_t)(dir * 4 + h) * R + row0] = (f32x4){b0, ig0 - b0, __expf(b0), __expf(tot - b0 + ig0)};
        GT[(size_t)(dir * 4 + h) * R + row0 + 1] = (f32x4){b1, ig1 - b1, __expf(b1), __expf(tot - b1 + ig1)};
        if (F.lane == 0) GC[((size_t)(dir * 4 + gb0 + b) * 4 + h) * 66 + ctau0 + c] = __expf(tot);
    }
}

__device__ __forceinline__ void dn_item(Fr& F, const bf16* KTrow0, int Ls, int j0, const f32x4* GTd0, const f32x4* GTd1, int row0, float* DN0, float* DN1) {
    LAS float* wl = (LAS float*)(F.lds + 1024);
    __syncthreads();
    if (F.tid < 128) wl[F.tid] = GTd0[row0 + F.tid][3]; else if (F.tid < 256) wl[F.tid] = GTd1[row0 + F.tid - 128][3];
    __syncthreads();
    const bf16* kr = KTrow0 + (size_t)F.tid * Ls + j0; float s0 = 0.f, s1 = 0.f;
#pragma unroll 4
    for (int q = 0; q < 16; ++q) { float v[8]; unpack8(*(const u32x4*)(kr + q * 8), v);
#pragma unroll
        for (int e = 0; e < 8; ++e) { s0 += v[e] * wl[q * 8 + e]; s1 += v[e] * wl[128 + q * 8 + e]; } }
    DN0[F.tid] = s0; DN1[F.tid] = s1;
}
__device__ __forceinline__ void ph_sphase(Fr& F, int hb, bool with_ctx) {
    const bf16* XC = (const bf16*)(F.ws + MS_XC); const bf16* KN = (const bf16*)(F.ws + MS_KN); const bf16* KT = (const bf16*)(F.ws + MS_KT);
    const f32x4* GT = (const f32x4*)(F.ws + WS_GT_L); float* DN = (float*)(F.ws + WS_DN); float* RS = (float*)(F.ws + WS_RS);
    bf16* S = (bf16*)(F.ws + MS_S);
    const int fr = F.lane & 15, fq = F.lane >> 4, w = F.wave;
    for (int it = F.bid; it < 512; it += F.G) {
        const int c = it & 63, h = (it >> 6) & 3, bl = it >> 8, gb = 2 * hb + bl;
        const int row0 = bl * SEQ + c * 128;
        dn_item(F, KT + (size_t)(bl * 4 + h) * 512 * SEQ, SEQ, c * 128, GT + (size_t)(0 * 4 + h) * HROWS, GT + (size_t)(1 * 4 + h) * HROWS, row0,
                DN + (((size_t)(0 * 4 + gb) * 4 + h) * 66 + 2 + c) * 512, DN + (((size_t)(1 * 4 + gb) * 4 + h) * 66 + 2 + c) * 512);
        const int irow = row0 + 16 * w + fr;
        bf16x8 bq[16];
        { const bf16* p = XC + (size_t)irow * MI + h * 512 + 8 * fq;
#pragma unroll
            for (int ks = 0; ks < 16; ++ks) bq[ks] = *(const bf16x8*)(p + ks * 32); }
        const f32x4 gf = GT[(size_t)(0 * 4 + h) * HROWS + irow], gbk = GT[(size_t)(1 * 4 + h) * HROWS + irow];
        float rsf = 0.f, rsb = 0.f;
        bf16* sf = S + ((size_t)(0 * 8 + bl * 4 + h) * 64 + c) * 16384 + (size_t)(16 * w + fr) * 128;
        bf16* sb = S + ((size_t)(1 * 8 + bl * 4 + h) * 64 + c) * 16384 + (size_t)(16 * w + fr) * 128;
#pragma unroll 1
        for (int jt = 0; jt < 8; ++jt) {
            f32x4 acc = (f32x4){0.f, 0.f, 0.f, 0.f};
            const bf16* ap = KN + (size_t)(row0 + jt * 16 + fr) * MI + h * 512 + 8 * fq;
#pragma unroll
            for (int ks = 0; ks < 16; ++ks) acc = __builtin_amdgcn_mfma_f32_16x16x32_bf16(*(const bf16x8*)(ap + ks * 32), bq[ks], acc, 0, 0, 0);
            float vf[4], vb[4];
#pragma unroll
            for (int r = 0; r < 4; ++r) { const int j = jt * 16 + 4 * fq + r, i = 16 * w + fr;
                const float af = GT[(size_t)(0 * 4 + h) * HROWS + row0 + j][1], ab = GT[(size_t)(1 * 4 + h) * HROWS + row0 + j][1];
                vf[r] = (j <= i) ? acc[r] * __expf(gf[0] + af) : 0.f; vb[r] = (j >= i) ? acc[r] * __expf(gbk[0] + ab) : 0.f;
                rsf += vf[r]; rsb += vb[r]; }
            *(u32x2*)(sf + jt * 16 + 4 * fq) = (u32x2){pk2(vf[0], vf[1]), pk2(vf[2], vf[3])};
            *(u32x2*)(sb + jt * 16 + 4 * fq) = (u32x2){pk2(vb[0], vb[1]), pk2(vb[2], vb[3])};
        }
        rsf += __shfl_xor(rsf, 16); rsf += __shfl_xor(rsf, 32); rsb += __shfl_xor(rsb, 16); rsb += __shfl_xor(rsb, 32);
        if (fq == 0) { RS[(size_t)(0 * 4 + h) * HROWS + irow] = rsf; RS[(size_t)(1 * 4 + h) * HROWS + irow] = rsb; }
    }
    if (with_ctx) {
        const bf16* KTC2 = (const bf16*)(F.ws + MS_KTC); const f32x4* GTC = (const f32x4*)(F.ws + WS_GT_C);
        for (int it = F.bid; it < 32; it += F.G) {
            const int cc = it & 1, h = (it >> 1) & 3, gb = it >> 3;
            dn_item(F, KTC2 + (size_t)(gb * 4 + h) * 512 * CTXL, CTXL, cc * 128, GTC + (size_t)(0 * 4 + h) * MC, GTC + (size_t)(1 * 4 + h) * MC, gb * CTXL + cc * 128,
                    DN + (((size_t)(0 * 4 + gb) * 4 + h) * 66 + cc) * 512, DN + (((size_t)(1 * 4 + gb) * 4 + h) * 66 + cc) * 512);
        }
    }
}

__device__ __forceinline__ void ph_scan(Fr& F, int hb) {
    const bf16* XC = (const bf16*)(F.ws + MS_XC); const bf16* KT = (const bf16*)(F.ws + MS_KT); const bf16* VT = (const bf16*)(F.ws + MS_VT);
    const bf16* KTC2 = (const bf16*)(F.ws + MS_KTC); const bf16* VTC2 = (const bf16*)(F.ws + MS_VTC);
    const bf16* S = (const bf16*)(F.ws + MS_S);
    const f32x4* GTL = (const f32x4*)(F.ws + WS_GT_L); const f32x4* GTC = (const f32x4*)(F.ws + WS_GT_C);
    const float* GC = (const float*)(F.ws + WS_GC); const float* DN = (const float*)(F.ws + WS_DN); const float* RS = (const float*)(F.ws + WS_RS);
    float* INV = (float*)(F.ws + WS_INV);
    LAS unsigned char* cbf = F.lds;
    LAS float* wl = (LAS float*)(F.lds + 33280);
    const int fr = F.lane & 15, fq = F.lane >> 4, w = F.wave;
    for (int wi = F.bid; wi < 256; wi += F.G) {
        const int chain = wi & 15, slice = wi >> 4, dir = chain >> 3, bl = (chain >> 2) & 1, h = chain & 3, gb = 2 * hb + bl, e0 = slice * 32;
        bf16* NUM = (bf16*)(F.ws + (dir ? MS_NB : MS_NF));
        f32x4 acc[4][2];
#pragma unroll
        for (int a = 0; a < 4; ++a)
#pragma unroll
            for (int b = 0; b < 2; ++b) acc[a][b] = (f32x4){0.f, 0.f, 0.f, 0.f};
        float nreg[8];
#pragma unroll
        for (int e = 0; e < 8; ++e) nreg[e] = 0.f;
        __syncthreads();
        for (int i = F.tid; i < 33280 / 4; i += NTHR) ((LAS unsigned*)cbf)[i] = 0u;
        __syncthreads();
#pragma unroll 1
        for (int s = 0; s < 66; ++s) {
            const int ctau = dir == 0 ? s : (s < 2 ? 1 - s : 67 - s);
            const bool isctx = ctau < 2; const int c = isctx ? ctau : ctau - 2;
            const int Ls = isctx ? CTXL : SEQ, j0 = c * 128;
            const bf16* kt = isctx ? KTC2 + (size_t)(gb * 4 + h) * 512 * CTXL : KT + (size_t)(bl * 4 + h) * 512 * SEQ;
            const bf16* vt = isctx ? VTC2 + (size_t)(gb * 4 + h) * 512 * CTXL : VT + (size_t)(bl * 4 + h) * 512 * SEQ;
            const int row0 = isctx ? gb * CTXL + j0 : bl * SEQ + j0;
            const f32x4* gt = isctx ? GTC + (size_t)(dir * 4 + h) * MC : GTL + (size_t)(dir * 4 + h) * HROWS;
            const float Gd = GC[((size_t)(dir * 4 + gb) * 4 + h) * 66 + ctau];
            const float* dn = DN + (((size_t)(dir * 4 + gb) * 4 + h) * 66 + ctau) * 512;
            if (F.tid < 128) wl[F.tid] = gt[row0 + F.tid][3];
            if (!isctx) {
                const int irow = row0 + 16 * w + fr;
                f32x4 a2[2] = {(f32x4){0.f, 0.f, 0.f, 0.f}, (f32x4){0.f, 0.f, 0.f, 0.f}};
                const bf16* xp = XC + (size_t)irow * MI + h * 512 + 8 * fq;
#pragma unroll 4
                for (int ks = 0; ks < 16; ++ks) { const bf16x8 bx = *(const bf16x8*)(xp + ks * 32);
#pragma unroll
                    for (int et = 0; et < 2; ++et) a2[et] = __builtin_amdgcn_mfma_f32_16x16x32_bf16(*(const LAS bf16x8*)(cbf + (16 * et + fr) * 1040 + ks * 64 + fq * 16), bx, a2[et], 0, 0, 0); }
                const float Ei = gt[irow][2];
                a2[0] = a2[0] * Ei; a2[1] = a2[1] * Ei;
                const bf16* sp = S + ((size_t)(dir * 8 + bl * 4 + h) * 64 + c) * 16384 + (size_t)(16 * w + fr) * 128 + 8 * fq;
#pragma unroll
                for (int ks = 0; ks < 4; ++ks) { const bf16x8 bs = *(const bf16x8*)(sp + ks * 32);
#pragma unroll
                    for (int et = 0; et < 2; ++et) a2[et] = __builtin_amdgcn_mfma_f32_16x16x32_bf16(*(const bf16x8*)(vt + (size_t)(e0 + 16 * et + fr) * Ls + j0 + ks * 32 + 8 * fq), bs, a2[et], 0, 0, 0); }
#pragma unroll
                for (int et = 0; et < 2; ++et) *(u32x2*)(NUM + (size_t)irow * MI + h * 512 + e0 + 16 * et + 4 * fq) = (u32x2){pk2(a2[et][0], a2[et][1]), pk2(a2[et][2], a2[et][3])};
                { const int drow = row0 + slice * 8 + w; float xv[8]; unpack8(*(const u32x4*)(XC + (size_t)drow * MI + h * 512 + 8 * F.lane), xv);
                    float dt = 0.f;
#pragma unroll
                    for (int e = 0; e < 8; ++e) dt += xv[e] * nreg[e];
                    dt = wave_sum(dt);
                    if (F.lane == 0) { const float den = gt[drow][2] * dt + RS[(size_t)(dir * 4 + h) * HROWS + drow]; INV[(size_t)(dir * 4 + h) * HROWS + drow] = 1.0f / fmaxf(fabsf(den), 1.0f); } }
            }
            __syncthreads();
#pragma unroll
            for (int a = 0; a < 4; ++a)
#pragma unroll
                for (int b = 0; b < 2; ++b) acc[a][b] = acc[a][b] * Gd;
#pragma unroll
            for (int ks = 0; ks < 4; ++ks) {
                bf16x8 bv[2];
#pragma unroll
                for (int et = 0; et < 2; ++et) { float v[8]; unpack8(*(const u32x4*)(vt + (size_t)(e0 + 16 * et + fr) * Ls + j0 + ks * 32 + 8 * fq), v);
#pragma unroll
                    for (int e = 0; e < 8; ++e) v[e] *= wl[ks * 32 + 8 * fq + e];
                    const u32x4 pv = pack8(v); bv[et] = __builtin_bit_cast(bf16x8, pv); }
#pragma unroll
                for (int dt = 0; dt < 4; ++dt) { const bf16x8 ak = *(const bf16x8*)(kt + (size_t)(64 * w + 16 * dt + fr) * Ls + j0 + ks * 32 + 8 * fq);
#pragma unroll
                    for (int et = 0; et < 2; ++et) acc[dt][et] = __builtin_amdgcn_mfma_f32_16x16x32_bf16(ak, bv[et], acc[dt][et], 0, 0, 0); }
            }
            { const f32x4 d0 = *(const f32x4*)(dn + 8 * F.lane), d1 = *(const f32x4*)(dn + 8 * F.lane + 4);
                nreg[0] = Gd * nreg[0] + d0[0]; nreg[1] = Gd * nreg[1] + d0[1]; nreg[2] = Gd * nreg[2] + d0[2]; nreg[3] = Gd * nreg[3] + d0[3];
                nreg[4] = Gd * nreg[4] + d1[0]; nreg[5] = Gd * nreg[5] + d1[1]; nreg[6] = Gd * nreg[6] + d1[2]; nreg[7] = Gd * nreg[7] + d1[3]; }
#pragma unroll
            for (int dt = 0; dt < 4; ++dt)
#pragma unroll
                for (int et = 0; et < 2; ++et) *(LAS u32x2*)(cbf + (16 * et + fr) * 1040 + (64 * w + 16 * dt + 4 * fq) * 2) = (u32x2){pk2(acc[dt][et][0], acc[dt][et][1]), pk2(acc[dt][et][2], acc[dt][et][3])};
            __syncthreads();
        }
    }
}

__device__ __forceinline__ void ph_mout(Fr& F) {
    bf16* NF = (bf16*)(F.ws + MS_NF); const bf16* NBk = (const bf16*)(F.ws + MS_NB); const bf16* XC = (const bf16*)(F.ws + MS_XC); const bf16* Z = (const bf16*)(F.ws + MS_Z);
    const float* INV = (const float*)(F.ws + WS_INV);
    for (int it = F.gw; it < HROWS * 4; it += F.ngw) {
        const int row = it >> 2, h = it & 3; const size_t o = (size_t)row * MI + h * 512 + 8 * F.lane;
        float nf[8], nb[8], xc[8], z[8];
        unpack8(*(const u32x4*)(NF + o), nf); unpack8(*(const u32x4*)(NBk + o), nb); unpack8(*(const u32x4*)(XC + o), xc); unpack8(*(const u32x4*)(Z + o), z);
        const float i0 = INV[(size_t)(0 * 4 + h) * HROWS + row], i1 = INV[(size_t)(1 * 4 + h) * HROWS + row];
        float s = 0.f;
#pragma unroll
        for (int e = 0; e < 8; ++e) { nf[e] = nf[e] * i0 + nb[e] * i1; s += nf[e]; }
        const float mu = wave_sum(s) * (1.0f / 512.0f); float q = 0.f;
#pragma unroll
        for (int e = 0; e < 8; ++e) { nf[e] -= mu; q += nf[e] * nf[e]; }
        const float rstd = 1.0f / sqrtf(wave_sum(q) * (1.0f / 512.0f) + ML_NORM_EPS);
        const float* nw = IN(I_MNW) + h * 512 + 8 * F.lane; const float* sk = IN(I_MSKIP) + h * 512 + 8 * F.lane;
#pragma unroll
        for (int e = 0; e < 8; ++e) nf[e] = (nf[e] * rstd * nw[e] + sk[e] * xc[e]) * silu_f(z[e]);
        *(u32x4*)(NF + o) = pack8(nf);
    }
}

__device__ __forceinline__ void ph_final(Fr& F) {
    const float* g = IN(I_FINALG);
    for (int r = F.gw; r < ML; r += F.ngw) {
        f32x4* xr = (f32x4*)(F.out + (size_t)r * 1024) + F.lane; f32x4 v[4]; float s = 0.f;
#pragma unroll
        for (int j = 0; j < 4; ++j) { v[j] = xr[64 * j]; s += (v[j][0] * v[j][0] + v[j][1] * v[j][1]) + (v[j][2] * v[j][2] + v[j][3] * v[j][3]); }
        const float rinv = 1.0f / sqrtf(wave_sum(s) * (1.0f / 1024.0f) + EPS);
#pragma unroll
        for (int j = 0; j < 4; ++j) xr[64 * j] = v[j] * rinv * *(const f32x4*)(g + 4 * F.lane + 256 * j);
    }
}

template <class Epi>
__device__ __forceinline__ void run_gemm(Fr& F, const bf16* A, const bf16* Bt, int M, int N, int K, const Epi& E) {
    pg8::Gemm g{A, Bt, M, N, K}; pg8::StaticOrder S; S.init(M, N, F.G, F.bid);
    pg8::gemm_phase<Epi, pg8::StaticOrder, true, true>(F.lds, g, S, E, F.tid);
}

struct Args { const float* in[38]; float* out; unsigned char* ws; int ph_lo, ph_hi; };
static_assert(sizeof(Args) == 328 && offsetof(Args, out) == 304 && offsetof(Args, ws) == 312 && offsetof(Args, ph_lo) == 320, "Args layout");
constexpr int N_PHASES = 36;

template <int ph>
__device__ __forceinline__ void run_phase(Fr& F) {
    unsigned char* ws = F.ws;
    float* mod = (float*)(ws + WS_MOD); float* ctxx = (float*)(ws + WS_CTXX);
    if constexpr (ph == 0) ph_prologue(F);
    else if constexpr (ph == 1) {
            kt_items(F, (const float*)(ws + WS_H3), SEQ, (float*)(ws + HY_KT));
            kt_items(F, (const float*)(ws + WS_H3) + (size_t)SEQ * 64, CTXL, (float*)(ws + WS_KTC));
            ph_modnorm(F, IN(I_X), ML, 0, IN(I_CTX), MC, IN(I_NORMG), mod, 0, (bf16*)(ws + HY_H));
        }
    else if constexpr (ph == 2) { pg8::EpiBf16 E{(bf16*)(ws + HY_P), 3072, IN(I_HBIN), 0, 0}; run_gemm(F, (const bf16*)(ws + HY_H), (const bf16*)(ws + WS_WHIN), MALL, 3072, 1024, E); }
    else if constexpr (ph == 3) { zt_items(F, (const bf16*)(ws + HY_P), 0, NB, SEQ, (bf16*)(ws + HY_ZT)); zt_items(F, (const bf16*)(ws + HY_P), ML, NB, CTXL, (bf16*)(ws + HY_ZTC)); }
    else if constexpr (ph == 4) ph_fftconv(F);
    else if constexpr (ph == 5) { u2_items(F, (const bf16*)(ws + HY_P), 0, NB, SEQ, (const bf16*)(ws + HY_ZT), (bf16*)(ws + HY_H)); u2_items(F, (const bf16*)(ws + HY_P), ML, NB, CTXL, (const bf16*)(ws + HY_ZTC), (bf16*)(ws + HY_H)); }
    else if constexpr (ph == 6) { pg8::EpiRes E{IN(I_X), F.out, IN(I_CTX), ctxx, ML, mod + 2048, 0, IN(I_HBOUT)}; run_gemm(F, (const bf16*)(ws + HY_H), (const bf16*)(ws + WS_WHOUT), MALL, 1024, 1024, E); }
    else if constexpr (ph == 7) ph_modnorm(F, F.out, ML, 0, ctxx, MC, IN(I_NORMG) + 1024, mod, 3072, (bf16*)(ws + FF_H));
    else if constexpr (ph == 8) { pg8::EpiBf16 E{(bf16*)(ws + FF_A), FF, nullptr, FF, (FF_G - FF_A) / 2}; run_gemm(F, (const bf16*)(ws + FF_H), (const bf16*)(ws + WS_WUP0), MALL, 2 * FF, 1024, E); }
    else if constexpr (ph == 9) ph_dwconv(F, 0, ML, MC);
    else if constexpr (ph == 10) { pg8::EpiRes E{F.out, F.out, ctxx, ctxx, ML, mod + 5120, 0, nullptr}; run_gemm(F, (const bf16*)(ws + FF_A), (const bf16*)(ws + WS_WDN0), MALL, 1024, FF, E); }
    else if constexpr (ph < 31) {
            constexpr int hb = (ph - 11) / 10, k = (ph - 11) % 10; const float* mod1 = mod + 5 * 6144;
            float* xh = F.out + (size_t)hb * HROWS * 1024;
            if constexpr (k == 0) { ph_modnorm(F, xh, HROWS, 2 * hb, ctxx, 0, IN(I_NORMG) + 2048, mod1, 0, (bf16*)(ws + MS_H));
                          if (hb == 0) ph_modnorm(F, xh, 0, 0, ctxx, MC, IN(I_NORMG) + 2048, mod1, 0, (bf16*)(ws + MS_HC)); }
            else if constexpr (k == 1) { { pg8::EpiBf16 E{(bf16*)(ws + MS_XM), MI, nullptr, 0, 0}; run_gemm(F, (const bf16*)(ws + MS_H), (const bf16*)(ws + WS_WMIN), HROWS, MI, 1024, E); }
                               if (hb == 0) { pg8::EpiBf16 E{(bf16*)(ws + MS_XMC), MI, nullptr, 0, 0}; run_gemm(F, (const bf16*)(ws + MS_HC), (const bf16*)(ws + WS_WMIN), MC, MI, 1024, E); } }
            else if constexpr (k == 2) { prep_items(F, (const bf16*)(ws + MS_XM), 2, SEQ, (bf16*)(ws + MS_XC), (bf16*)(ws + MS_KN), (bf16*)(ws + MS_KT), (bf16*)(ws + MS_VT));
                               if (hb == 0) prep_items(F, (const bf16*)(ws + MS_XMC), NB, CTXL, (bf16*)(ws + MS_XCC), (bf16*)(ws + MS_XCC + 16 * MiB), (bf16*)(ws + MS_KTC), (bf16*)(ws + MS_VTC)); }
            else if constexpr (k == 3) { gate_items(F, (const bf16*)(ws + MS_XC), (const bf16*)(ws + MS_XM), HROWS, (float*)(ws + WS_GATES_L));
                               if (hb == 0) gate_items(F, (const bf16*)(ws + MS_XCC), (const bf16*)(ws + MS_XMC), MC, (float*)(ws + WS_GATES_C)); }
            else if constexpr (k == 4) { cum_items(F, (const float*)(ws + WS_GATES_L), 2, SEQ, 2 * hb, 2, (f32x4*)(ws + WS_GT_L), (float*)(ws + WS_GC));
                               if (hb == 0) cum_items(F, (const float*)(ws + WS_GATES_C), NB, CTXL, 0, 0, (f32x4*)(ws + WS_GT_C), (float*)(ws + WS_GC)); }
            else if constexpr (k == 5) ph_sphase(F, hb, hb == 0);
            else if constexpr (k == 6) ph_scan(F, hb);
            else if constexpr (k == 7) { pg8::EpiBf16 E{(bf16*)(ws + MS_Z), MI, nullptr, 0, 0}; run_gemm(F, (const bf16*)(ws + MS_H), (const bf16*)(ws + WS_WMIN) + (size_t)MI * 1024, HROWS, MI, 1024, E); }
            else if constexpr (k == 8) ph_mout(F);
            else { pg8::EpiRes E{xh, xh, ctxx, ctxx, HROWS, mod1 + 2048, 2 * hb, nullptr}; run_gemm(F, (const bf16*)(ws + MS_NF), (const bf16*)(ws + WS_WMDN), HROWS, 1024, MI, E); }
        }
    else if constexpr (ph == 31) ph_modnorm(F, F.out, ML, 0, ctxx, 0, IN(I_NORMG) + 3072, mod + 5 * 6144, 3072, (bf16*)(ws + FF_H));
    else if constexpr (ph == 32) { pg8::EpiBf16 E{(bf16*)(ws + FF_A), FF, nullptr, FF, (FF_G - FF_A) / 2}; run_gemm(F, (const bf16*)(ws + FF_H), (const bf16*)(ws + WS_WUP1), ML, 2 * FF, 1024, E); }
    else if constexpr (ph == 33) ph_dwconv(F, 1, ML, 0);
    else if constexpr (ph == 34) { pg8::EpiRes E{F.out, F.out, ctxx, ctxx, ML, mod + 5 * 6144 + 5120, 0, nullptr}; run_gemm(F, (const bf16*)(ws + FF_A), (const bf16*)(ws + WS_WDN1), ML, 1024, FF, E); }
    else ph_final(F);
}

template <int ph>
__device__ __forceinline__ void phase_step(int ph_lo, int ph_hi, unsigned char* lds_raw) {
    if (ph_lo <= ph && ph < ph_hi) {
        const __attribute__((address_space(4))) unsigned char* kp = (const __attribute__((address_space(4))) unsigned char*)__builtin_amdgcn_kernarg_segment_ptr();
        asm volatile("" : "+s"(kp));
        Fr F;
        { int t_ = threadIdx.x, g_ = gridDim.x, b_ = blockIdx.x; asm volatile("" : "+v"(t_), "+s"(g_), "+s"(b_)); F.tid = t_; F.G = g_; F.bid = b_; }
        F.lds = (LAS unsigned char*)lds_raw; F.lane = F.tid & 63; F.wave = __builtin_amdgcn_readfirstlane(F.tid >> 6);
        F.gw = F.bid * NWAVES + F.wave; F.ngw = F.G * NWAVES;
        F.in = (const __attribute__((address_space(4))) cfptr_t*)kp;
        typedef float* fptr_t; typedef unsigned char* ucptr_t;
        F.out = *(const __attribute__((address_space(4))) fptr_t*)(kp + 304); F.ws = *(const __attribute__((address_space(4))) ucptr_t*)(kp + 312);
        run_phase<ph>(F);
        if (ph + 1 < ph_hi) { __syncthreads(); cg::this_grid().sync(); }
    }
}
template <int... I>
__device__ __forceinline__ void all_phases(int ph_lo, int ph_hi, unsigned char* lds_raw, std::integer_sequence<int, I...>) { (phase_step<I>(ph_lo, ph_hi, lds_raw), ...); }

__global__ void __launch_bounds__(NTHR, 2) fwd_kernel(Args args) {
    extern __shared__ __attribute__((aligned(16))) unsigned char lds_raw[];
    int ph_lo, ph_hi;
    { const __attribute__((address_space(4))) unsigned char* kp0 = (const __attribute__((address_space(4))) unsigned char*)__builtin_amdgcn_kernarg_segment_ptr();
      ph_lo = *(const __attribute__((address_space(4))) int*)(kp0 + 320); ph_hi = *(const __attribute__((address_space(4))) int*)(kp0 + 324); }
    all_phases(ph_lo, ph_hi, lds_raw, std::make_integer_sequence<int, N_PHASES>{});
}

extern "C" void kernel_launch(void* const* d_in, const int* in_sizes, int n_in, void* d_out, int out_size, void* d_ws, size_t ws_size, hipStream_t stream) {
    static int grid = 0;
    if (grid == 0) {
        int dev = 0, cus = 0, per_cu = 0;
        hipGetDevice(&dev);
        hipDeviceGetAttribute(&cus, hipDeviceAttributeMultiprocessorCount, dev);
        hipFuncSetAttribute((const void*)fwd_kernel, hipFuncAttributeMaxDynamicSharedMemorySize, LDS_BYTES);
        hipOccupancyMaxActiveBlocksPerMultiprocessor(&per_cu, (const void*)fwd_kernel, NTHR, LDS_BYTES);
        if (per_cu < 1) { fprintf(stderr, "kernel_launch: occupancy query says %d blocks per CU\n", per_cu); per_cu = 1; }
        grid = cus < 256 ? cus : 256;
        if (n_in != 38 || ws_size < WS_END) fprintf(stderr, "kernel_launch: unexpected n_in %d / ws_size %zu (need %zu)\n", n_in, ws_size, (size_t)WS_END);
        (void)hipGetLastError();
    }
    Args a{};
    for (int i = 0; i < 38; ++i) a.in[i] = (const float*)d_in[i];
    a.out = (float*)d_out; a.ws = (unsigned char*)d_ws; a.ph_lo = 0; a.ph_hi = N_PHASES;
    void* kargs[] = {&a};
    hipError_t e = hipLaunchCooperativeKernel((const void*)fwd_kernel, dim3(grid), dim3(NTHR), kargs, LDS_BYTES, stream);
    if (e != hipSuccess) fprintf(stderr, "cooperative launch failed: %s (grid %d)\n", hipGetErrorString(e), grid);
}
```

```cpp
#include <hip/hip_runtime.h>
#include <hip/hip_cooperative_groups.h>
#include <cstdio>
#include <cstdint>
#include <cstddef>
#include <utility>
namespace cg = cooperative_groups;

#define LAS __attribute__((address_space(3)))
typedef unsigned short bf16;
typedef short bf16x8 __attribute__((ext_vector_type(8)));
typedef float f32x4 __attribute__((ext_vector_type(4)));
typedef float f32x2 __attribute__((ext_vector_type(2)));
typedef unsigned u32x4 __attribute__((ext_vector_type(4)));
typedef unsigned u32x2 __attribute__((ext_vector_type(2)));

namespace pg8 {
#define PG8_LAS __attribute__((address_space(3)))
typedef unsigned short bf16_t;
constexpr int BM = 256, BK = 64, HALF = 128, HTB = HALF * BK * 2, STAGE_BYTES = 8 * HTB, NXCD = 8, WGM = 8;
__host__ __device__ __forceinline__ int lds_byte(int r, int c) { const int st = (r >> 4) * 2 + (c >> 5), rr = r & 15, cc = c & 31, ob = rr * 64 + cc * 2; return st * 1024 + (ob ^ (((ob >> 9) & 1) << 5)); }
__host__ __device__ __forceinline__ void stage_rc(int b, int& R, int& C) { const int st = b / 1024, sb = b % 1024, swz = sb ^ (((sb >> 9) & 1) << 5); R = (st >> 1) * 16 + swz / 64; C = (st & 1) * 32 + (swz % 64) / 2; }
__host__ __device__ __forceinline__ int perm32(int rho) { const int n = rho >> 4, i = rho & 15; return 8 * (i >> 2) + 4 * n + (i & 3); }
struct Unit { int pm, pn; };
struct Gemm { const bf16_t* A; const bf16_t* Bt; int M, N, K; };
struct StaticOrder {
    int nM, nN, nwg, G, c;
    __host__ __device__ void init(int M, int N, int G_, int c_) { nM = M / BM; nN = N / BM; nwg = nM * nN; G = G_; c = c_; }
    __host__ __device__ bool next(int i, Unit& u) const {
        const long L = (long)i * G + c; if (L >= nwg) return false;
        int wgid = (int)L; { const int q = nwg / NXCD, r = nwg % NXCD, xcd = wgid % NXCD, off = wgid / NXCD; wgid = (xcd < r ? xcd * (q + 1) : r * (q + 1) + (xcd - r) * q) + off; }
        const int nig = WGM * nN, gid = wgid / nig, fm = gid * WGM, gsz = (nM - fm) < WGM ? (nM - fm) : WGM;
        u.pm = fm + ((wgid % nig) % gsz); u.pn = (wgid % nig) / gsz; return true;
    }
    __device__ __forceinline__ void a_ready(const Unit&) const {}
    __device__ __forceinline__ void done(const Unit&) const {}
};
__device__ __forceinline__ unsigned cvt_pk_bf16(float lo, float hi) { unsigned r; asm volatile("v_cvt_pk_bf16_f32 %0, %1, %2" : "=v"(r) : "v"(lo), "v"(hi)); return r; }

struct EpiBf16 {
    static constexpr bool PERM = true, AFTER_DRAIN = false;
    bf16_t* O; int ldc; const float* bias; int split_cols; size_t split_stride;
    __device__ __forceinline__ void operator()(const f32x4 (&acc)[2][2][4][2], const Unit& u, int wr, int wc, int fr, int fq) const {
        const int row0 = u.pm * BM + wr * 64 + fr; int colt = u.pn * BM; bf16_t* base = O;
        if (split_cols) { const int t = colt / split_cols; base += (size_t)t * split_stride; colt -= t * split_cols; }
        const int col0 = colt + wc * 32 + 8 * fq, bcol0 = u.pn * BM + wc * 32 + 8 * fq;
        f32x4 bv[2][2];
#pragma unroll
        for (int bj = 0; bj < 2; ++bj)
#pragma unroll
            for (int n = 0; n < 2; ++n) bv[bj][n] = bias ? *(const f32x4*)(bias + bcol0 + bj * HALF + 4 * n) : (f32x4){0.f, 0.f, 0.f, 0.f};
#pragma unroll
        for (int ai = 0; ai < 2; ++ai)
#pragma unroll
            for (int m = 0; m < 4; ++m) { bf16_t* rowp = base + (size_t)(row0 + ai * HALF + m * 16) * ldc + col0;
#pragma unroll
                for (int bj = 0; bj < 2; ++bj) { f32x4 v0 = acc[ai][bj][m][0] + bv[bj][0], v1 = acc[ai][bj][m][1] + bv[bj][1];
                    u32x4 w; w.x = cvt_pk_bf16(v0[0], v0[1]); w.y = cvt_pk_bf16(v0[2], v0[3]); w.z = cvt_pk_bf16(v1[0], v1[1]); w.w = cvt_pk_bf16(v1[2], v1[3]);
                    *(u32x4*)(rowp + bj * HALF) = w; } }
    }
};
struct EpiRes {
    static constexpr bool PERM = false, AFTER_DRAIN = false;
    const float* res_lat; float* out_lat; const float* res_ctx; float* out_ctx; int rows_lat; const float* gate; int b0; const float* bias;
    __device__ __forceinline__ void operator()(const f32x4 (&acc)[2][2][4][2], const Unit& u, int wr, int wc, int fr, int fq) const {
        const int trow = u.pm * BM; const float* res; float* out; int modrow;
        if (trow < rows_lat) { res = res_lat + (size_t)trow * 1024; out = out_lat + (size_t)trow * 1024; modrow = b0 + trow / 8192; }
        else { const int rc = trow - rows_lat; res = res_ctx + (size_t)rc * 1024; out = out_ctx + (size_t)rc * 1024; modrow = 4; }
        const int col0 = u.pn * BM + wc * 32 + 4 * fq; const float* gp = gate + (size_t)modrow * 6144 + col0;
#pragma unroll
        for (int bj = 0; bj < 2; ++bj)
#pragma unroll
            for (int n = 0; n < 2; ++n) {
                const f32x4 bv = bias ? *(const f32x4*)(bias + col0 + bj * HALF + n * 16) : (f32x4){0.f, 0.f, 0.f, 0.f}; const f32x4 gv = *(const f32x4*)(gp + bj * HALF + n * 16);
#pragma unroll
                for (int ai = 0; ai < 2; ++ai) {
#pragma unroll
                    for (int m = 0; m < 4; ++m) { const size_t off = (size_t)(wr * 64 + fr + ai * HALF + m * 16) * 1024 + col0 + bj * HALF + n * 16;
                        const f32x4 rs = *(const f32x4*)(res + off); *(f32x4*)(out + off) = rs + gv * (acc[ai][bj][m][n] + bv); }
                    asm volatile("" ::: "memory"); }
            }
    }
};

template <class Epi, class Sched, bool ALIGN_EPI = false, bool SP2 = false>
__device__ __forceinline__ void gemm_phase(PG8_LAS unsigned char* lds, const Gemm g, const Sched& S, const Epi& E, const int tid) {
    const int wid = __builtin_amdgcn_readfirstlane(tid >> 6), lane = tid & 63, wr = wid >> 2, wc = wid & 3, fr = lane & 15, fq = lane >> 4;
    const int K = g.K, nt = K / BK;
    unsigned voffA[2], voffB[2];
#pragma unroll
    for (int i = 0; i < 2; ++i) { int R, C; stage_rc(tid * 16 + i * 8192, R, C); const int Rb = Epi::PERM ? ((R & ~31) + perm32(R & 31)) : R;
        voffA[i] = (unsigned)(R * K + C) * 2u; voffB[i] = (unsigned)(Rb * K + C) * 2u; }
    const size_t kstep = (size_t)(BK * 2);
    const size_t hstep = (size_t)HALF * K * 2;
    const size_t tstep = 2 * hstep;
    const unsigned ldsw = (unsigned)wid * 1024u;
    const int aoff = lds_byte(wr * 64 + fr, fq * 8), boff = lds_byte(wc * 32 + fr, fq * 8);
#define PG8_SA(b, h) (((b) * 2 + (h)) * HTB)
#define PG8_SB(b, h) ((4 + (b) * 2 + (h)) * HTB)
#define PG8_STAGE(bufoff, gbase, voff) do { _Pragma("unroll") for (int _i = 0; _i < 2; ++_i) \
        __builtin_amdgcn_global_load_lds((const unsigned*)((const char*)(gbase) + (voff)[_i]), (PG8_LAS unsigned*)(lds + (bufoff) + ldsw + _i * 8192), 16, 0, 0); } while (0)
#define PG8_LDA(dst, b, h) do { _Pragma("unroll") for (int m = 0; m < 4; ++m) _Pragma("unroll") for (int k = 0; k < 2; ++k) dst[m][k] = *(const PG8_LAS bf16x8*)(lds + PG8_SA(b, h) + aoff + m * 2048 + k * 1024); } while (0)
#define PG8_LDB(dst, b, h) do { _Pragma("unroll") for (int n = 0; n < 2; ++n) _Pragma("unroll") for (int k = 0; k < 2; ++k) dst[n][k] = *(const PG8_LAS bf16x8*)(lds + PG8_SB(b, h) + boff + n * 2048 + k * 1024); } while (0)
#define PG8_MMA(ai, bj, At, Bt) do { __builtin_amdgcn_s_setprio(1); _Pragma("unroll") for (int m = 0; m < 4; ++m) _Pragma("unroll") for (int n = 0; n < 2; ++n) _Pragma("unroll") for (int k = 0; k < 2; ++k) \
        acc[ai][bj][m][n] = __builtin_amdgcn_mfma_f32_16x16x32_bf16(Bt[n][k], At[m][k], acc[ai][bj][m][n], 0, 0, 0); __builtin_amdgcn_s_setprio(0); } while (0)
#define PG8_WAIT_V(n) asm volatile("s_waitcnt vmcnt(" #n ")" ::: "memory")
#define PG8_WAIT_L(n) asm volatile("s_waitcnt lgkmcnt(" #n ")" ::: "memory")
#define PG8_BAR __builtin_amdgcn_s_barrier()
#define PG8_SCHED __builtin_amdgcn_sched_barrier(0)
    Unit cur, nxt; int ui = 0;
    if (!S.next(0, cur)) return;
    f32x4 acc[2][2][4][2];
#pragma unroll
    for (int a = 0; a < 2; ++a)
#pragma unroll
        for (int b = 0; b < 2; ++b)
#pragma unroll
            for (int m = 0; m < 4; ++m)
#pragma unroll
                for (int n = 0; n < 2; ++n) acc[a][b][m][n] = (f32x4){0.f, 0.f, 0.f, 0.f};
    bf16x8 At[4][2], B0[2][2], B1[2][2];
    const char* cA = (const char*)g.A + (size_t)cur.pm * tstep; const char* cB = (const char*)g.Bt + (size_t)cur.pn * tstep;
    S.a_ready(cur);
    if constexpr (SP2) {
        PG8_STAGE(PG8_SB(0, 0), cB, voffB); PG8_STAGE(PG8_SB(0, 1), cB + hstep, voffB); PG8_STAGE(PG8_SA(0, 0), cA, voffA); PG8_STAGE(PG8_SA(0, 1), cA + hstep, voffA);
        if (wr == 1) PG8_BAR;
        PG8_WAIT_V(2); PG8_BAR;
        PG8_STAGE(PG8_SB(1, 0), cB + kstep, voffB); PG8_STAGE(PG8_SA(1, 0), cA + kstep, voffA); PG8_STAGE(PG8_SB(1, 1), cB + hstep + kstep, voffB);
        PG8_WAIT_V(6); PG8_BAR;
    } else {
        PG8_STAGE(PG8_SB(0, 0), cB, voffB); PG8_STAGE(PG8_SA(0, 0), cA, voffA); PG8_STAGE(PG8_SB(0, 1), cB + hstep, voffB); PG8_STAGE(PG8_SA(0, 1), cA + hstep, voffA);
        if (wr == 1) PG8_BAR;
        PG8_WAIT_V(4); PG8_BAR;
        PG8_STAGE(PG8_SB(1, 0), cB + kstep, voffB); PG8_STAGE(PG8_SA(1, 0), cA + kstep, voffA); PG8_STAGE(PG8_SB(1, 1), cB + hstep + kstep, voffB);
        PG8_WAIT_V(6); PG8_BAR;
    }
    for (;;) {
        const bool has_next = S.next(ui + 1, nxt);
        const char* nA = has_next ? (const char*)g.A + (size_t)nxt.pm * tstep : cA; const char* nB = has_next ? (const char*)g.Bt + (size_t)nxt.pn * tstep : cB;
        for (int t = 0; t < nt; t += 2) {
            const bool last = (t == nt - 2);
            const char* a1 = cA + (size_t)(t + 1) * kstep;
            const char* a2 = last ? nA : cA + (size_t)(t + 2) * kstep; const char* b2 = last ? nB : cB + (size_t)(t + 2) * kstep;
            const char* a3 = a2 + kstep; const char* b3 = b2 + kstep;
            if (last && has_next) S.a_ready(nxt);
            if constexpr (SP2) {
            PG8_LDB(B0, 0, 0); PG8_LDB(B1, 0, 1); PG8_SCHED; PG8_LDA(At, 0, 0); PG8_STAGE(PG8_SA(1, 1), a1 + hstep, voffA);
            PG8_WAIT_V(8); PG8_WAIT_L(0); PG8_BAR; PG8_MMA(0, 0, At, B0); PG8_MMA(0, 1, At, B1); PG8_BAR; PG8_SCHED;
            PG8_LDA(At, 0, 1); PG8_STAGE(PG8_SB(0, 0), b2, voffB); PG8_STAGE(PG8_SB(0, 1), b2 + hstep, voffB); PG8_STAGE(PG8_SA(0, 0), a2, voffA);
            PG8_WAIT_V(8); PG8_WAIT_L(0); PG8_BAR; PG8_MMA(1, 0, At, B0); PG8_MMA(1, 1, At, B1); PG8_BAR; PG8_SCHED;
            PG8_LDB(B0, 1, 0); PG8_LDB(B1, 1, 1); PG8_SCHED; PG8_LDA(At, 1, 0); PG8_STAGE(PG8_SA(0, 1), a2 + hstep, voffA);
            PG8_WAIT_V(8); PG8_WAIT_L(0); PG8_BAR; PG8_MMA(0, 0, At, B0); PG8_MMA(0, 1, At, B1); PG8_BAR; PG8_SCHED;
            PG8_LDA(At, 1, 1); PG8_STAGE(PG8_SB(1, 0), b3, voffB); PG8_STAGE(PG8_SB(1, 1), b3 + hstep, voffB); PG8_STAGE(PG8_SA(1, 0), a3, voffA);
            PG8_WAIT_V(8); PG8_WAIT_L(0); PG8_BAR; PG8_MMA(1, 0, At, B0); PG8_MMA(1, 1, At, B1); PG8_BAR; PG8_SCHED;
            } else {
            PG8_LDB(B0, 0, 0); PG8_SCHED; PG8_LDA(At, 0, 0); PG8_STAGE(PG8_SA(1, 1), a1 + hstep, voffA);
            PG8_WAIT_L(8); PG8_BAR; PG8_WAIT_L(0); PG8_MMA(0, 0, At, B0); PG8_BAR; PG8_SCHED;
            PG8_LDB(B1, 0, 1); PG8_STAGE(PG8_SB(0, 0), b2, voffB);
            PG8_BAR; PG8_WAIT_L(0); PG8_MMA(0, 1, At, B1); PG8_BAR;
            PG8_LDA(At, 0, 1); PG8_STAGE(PG8_SA(0, 0), a2, voffA);
            PG8_BAR; PG8_WAIT_L(0); PG8_MMA(1, 0, At, B0); PG8_BAR; PG8_SCHED;
            PG8_STAGE(PG8_SB(0, 1), b2 + hstep, voffB);
            PG8_WAIT_V(6); PG8_BAR; PG8_MMA(1, 1, At, B1); PG8_BAR;
            PG8_LDB(B0, 1, 0); PG8_SCHED; PG8_LDA(At, 1, 0); PG8_STAGE(PG8_SA(0, 1), a2 + hstep, voffA);
            PG8_WAIT_L(8); PG8_BAR; PG8_WAIT_L(0); PG8_MMA(0, 0, At, B0); PG8_BAR; PG8_SCHED;
            PG8_LDB(B1, 1, 1); PG8_STAGE(PG8_SB(1, 0), b3, voffB);
            PG8_BAR; PG8_WAIT_L(0); PG8_MMA(0, 1, At, B1); PG8_BAR;
            PG8_LDA(At, 1, 1); PG8_STAGE(PG8_SA(1, 0), a3, voffA);
            PG8_BAR; PG8_WAIT_L(0); PG8_MMA(1, 0, At, B0); PG8_BAR; PG8_SCHED;
            PG8_STAGE(PG8_SB(1, 1), b3 + hstep, voffB);
            PG8_WAIT_V(6); PG8_BAR; PG8_MMA(1, 1, At, B1); PG8_BAR;
            }
        }
        if constexpr (ALIGN_EPI) { if (wr == 0) PG8_BAR; }
        if constexpr (!Epi::AFTER_DRAIN) { E(acc, cur, wr, wc, fr, fq); S.done(cur); }
        if (!has_next) break;
#pragma unroll
        for (int a = 0; a < 2; ++a)
#pragma unroll
            for (int b = 0; b < 2; ++b)
#pragma unroll
                for (int m = 0; m < 4; ++m)
#pragma unroll
                    for (int n = 0; n < 2; ++n) acc[a][b][m][n] = (f32x4){0.f, 0.f, 0.f, 0.f};
        cur = nxt; cA = nA; cB = nB; ++ui;
        if constexpr (ALIGN_EPI) { if (wr == 1) PG8_BAR; }
    }
    PG8_WAIT_V(0);
    if constexpr (!ALIGN_EPI) { if (wr == 0) PG8_BAR; }
    PG8_BAR;
#undef PG8_SA
#undef PG8_SB
#undef PG8_STAGE
#undef PG8_LDA
#undef PG8_LDB
#undef PG8_MMA
#undef PG8_WAIT_V
#undef PG8_WAIT_L
#undef PG8_BAR
#undef PG8_SCHED
}
}

constexpr int D = 1024, NB = 4, SEQ = 8192, CTXL = 256, ML = NB * SEQ, MC = NB * CTXL, MALL = ML + MC;
constexpr int FF = 2816, MI = 2048, NH = 4, DH = 512, HROWS = 2 * SEQ;
constexpr float EPS = 1e-6f, ML_NORM_EPS = 1e-5f;
constexpr float HY_MAX_DECAY = -15.350567286626973f, HY_MIN_DECAY = -3.0701134573253945f;
constexpr int NWAVES = 8, NTHR = 512;
constexpr int LDS_BYTES = 147456;

constexpr size_t MiB = 1u << 20;
constexpr size_t WS_MOD = 1 * MiB;
constexpr size_t WS_CTXX = 2 * MiB;
constexpr size_t WS_H3 = 6 * MiB;
constexpr size_t WS_KTC = 9 * MiB;
constexpr size_t WS_GWT = 11 * MiB;
constexpr size_t WS_WKQ = 11 * MiB + 256 * 1024;
constexpr size_t WS_NC = 12 * MiB;
constexpr size_t WS_WHIN = 16 * MiB, WS_WHOUT = 22 * MiB, WS_WMIN = 24 * MiB, WS_WMDN = 32 * MiB, WS_WUP0 = 36 * MiB, WS_WUP1 = 47 * MiB, WS_WDN0 = 58 * MiB, WS_WDN1 = 58 * MiB + 5767168;
constexpr size_t WS_GATES_L = 69 * MiB;
constexpr size_t WS_GATES_C = 70 * MiB;
constexpr size_t WS_GT_L = 71 * MiB;
constexpr size_t WS_GT_C = 73 * MiB;
constexpr size_t WS_GC = 73 * MiB + 512 * 1024;
constexpr size_t WS_DN = 74 * MiB;
constexpr size_t WS_RS = 79 * MiB;
constexpr size_t WS_INV = 79 * MiB + 512 * 1024;
constexpr size_t BIG = 80 * MiB;
constexpr size_t HY_H = BIG, HY_P = BIG + 66 * MiB, HY_KT = BIG + 264 * MiB, HY_ZT = BIG + 328 * MiB, HY_ZTC = BIG + 392 * MiB, HY_KS = BIG + 394 * MiB;
constexpr size_t FF_H = BIG, FF_A = BIG + 66 * MiB, FF_G = BIG + 248 * MiB;
constexpr size_t MS_H = BIG, MS_XM = BIG + 32 * MiB, MS_XC = BIG + 96 * MiB, MS_KT = BIG + 160 * MiB, MS_VT = BIG + 224 * MiB, MS_NF = BIG + 288 * MiB, MS_NB = BIG + 352 * MiB,
                 MS_KTC = BIG + 416 * MiB, MS_VTC = BIG + 420 * MiB;
constexpr size_t MS_S = MS_XM, MS_Z = MS_KT, MS_KN = MS_NF, MS_XCC = MS_NB, MS_XMC = MS_NB + 4 * MiB, MS_HC = MS_NB + 8 * MiB;
constexpr size_t WS_END = BIG + 424 * MiB;
static_assert(WS_END <= 512 * MiB, "workspace map");
static_assert(FF_G + (size_t)MALL * FF * 2 <= 512 * MiB && FF_A + (size_t)MALL * FF * 2 <= FF_G, "ffn map");
static_assert(HY_P + (size_t)MALL * 3072 * 2 <= HY_KT && HY_ZTC + (size_t)NB * D * CTXL * 2 <= HY_KS && HY_KS + 32 * MiB <= 512 * MiB, "hyena map");

__device__ __forceinline__ unsigned f2bf(float f) { unsigned u = __float_as_uint(f); return (u + 0x7fffu + ((u >> 16) & 1u)) >> 16; }
__device__ __forceinline__ unsigned pk2(float lo, float hi) { return f2bf(lo) | (f2bf(hi) << 16); }
__device__ __forceinline__ float bf2f(unsigned short b) { return __uint_as_float(((unsigned)b) << 16); }
__device__ __forceinline__ float bflo(unsigned w) { return __uint_as_float(w << 16); }
__device__ __forceinline__ float bfhi(unsigned w) { return __uint_as_float(w & 0xffff0000u); }
__device__ __forceinline__ void unpack8(const u32x4 v, float (&o)[8]) { o[0] = bflo(v.x); o[1] = bfhi(v.x); o[2] = bflo(v.y); o[3] = bfhi(v.y); o[4] = bflo(v.z); o[5] = bfhi(v.z); o[6] = bflo(v.w); o[7] = bfhi(v.w); }
__device__ __forceinline__ u32x4 pack8(const float (&o)[8]) { u32x4 v; v.x = pk2(o[0], o[1]); v.y = pk2(o[2], o[3]); v.z = pk2(o[4], o[5]); v.w = pk2(o[6], o[7]); return v; }
__device__ __forceinline__ float wave_sum(float v) {
#pragma unroll
    for (int o = 1; o < 64; o <<= 1) v += __shfl_xor(v, o);
    return v;
}
__device__ __forceinline__ float silu_f(float x) { return x / (1.0f + __expf(-x)); }

typedef const float* cfptr_t;
struct Fr {
    LAS unsigned char* lds; int tid, lane, wave, gw, ngw, G, bid;
    const __attribute__((address_space(4))) cfptr_t* in; float* out; unsigned char* ws;
};
#define IN(i) (F.in[i])
enum { I_X = 0, I_C, I_CTX, I_CCTX, I_MODW, I_MODB, I_NORMG, I_FINALG, I_HWIN, I_HBIN, I_HSCW, I_HSCB, I_FW1, I_FB1, I_FW2, I_FB2, I_FW3, I_FB3, I_FWOUT, I_FREQ, I_HBIAS, I_HWOUT, I_HBOUT,
       I_MWIN, I_MCW, I_MCB, I_MWQ, I_MWK, I_MWV, I_MWG, I_MBG, I_MNW, I_MSKIP, I_MWDN, I_FWUP, I_FCW, I_FCB, I_FWDN };

__device__ __forceinline__ void transpose_item(const float* W, int K, int N, bf16* WT, LAS float* scr, int item, int lane) {
    const int nblk = N / 32, kb = item / nblk, nb = item % nblk, k0 = 64 * kb, n0 = 32 * nb;
#pragma unroll 8
    for (int i = 0; i < 32; ++i) { const int kk = 2 * i + (lane >> 5); scr[kk * 33 + (lane & 31)] = W[(size_t)(k0 + kk) * N + n0 + (lane & 31)]; }
    asm volatile("s_waitcnt lgkmcnt(0)" ::: "memory");
    const int c = lane & 7;
#pragma unroll
    for (int j = 0; j < 4; ++j) { const int n = (lane >> 3) + 8 * j; const LAS float* s = scr + (8 * c) * 33 + n;
        u32x4 o; o.x = pk2(s[0 * 33], s[1 * 33]); o.y = pk2(s[2 * 33], s[3 * 33]); o.z = pk2(s[4 * 33], s[5 * 33]); o.w = pk2(s[6 * 33], s[7 * 33]);
        *(u32x4*)(WT + (size_t)(n0 + n) * K + k0 + 8 * c) = o; }
    asm volatile("s_waitcnt lgkmcnt(0)" ::: "memory");
}
__device__ __forceinline__ void transpose_matrix(Fr& F, const float* W, int K, int N, bf16* WT) {
    LAS float* scr = (LAS float*)(F.lds + F.wave * 16384);
    const int nitems = (K / 64) * (N / 32);
    for (int it = F.gw; it < nitems; it += F.ngw) transpose_item(W, K, N, WT, scr, it, F.lane);
}

__device__ __forceinline__ void ph_prologue(Fr& F) {
    unsigned char* ws = F.ws;
    transpose_matrix(F, IN(I_HWIN), D, 3 * D, (bf16*)(ws + WS_WHIN));
    transpose_matrix(F, IN(I_HWOUT), D, D, (bf16*)(ws + WS_WHOUT));
    transpose_matrix(F, IN(I_MWIN), D, 2 * MI, (bf16*)(ws + WS_WMIN));
    transpose_matrix(F, IN(I_MWDN), MI, D, (bf16*)(ws + WS_WMDN));
    transpose_matrix(F, IN(I_FWUP), D, 2 * FF, (bf16*)(ws + WS_WUP0));
    transpose_matrix(F, IN(I_FWUP) + (size_t)D * 2 * FF, D, 2 * FF, (bf16*)(ws + WS_WUP1));
    transpose_matrix(F, IN(I_FWDN), FF, D, (bf16*)(ws + WS_WDN0));
    transpose_matrix(F, IN(I_FWDN) + (size_t)FF * D, FF, D, (bf16*)(ws + WS_WDN1));
    __syncthreads();
    {
        LAS float* sc = (LAS float*)F.lds;
        LAS float* red = (LAS float*)(F.lds + 32768);
        for (int i = F.tid; i < 5 * 1024; i += NTHR) { const int r = i >> 10, k = i & 1023; const float v = r < 4 ? IN(I_C)[r * 1024 + k] : IN(I_CCTX)[k]; sc[i] = silu_f(v); }
        __syncthreads();
        float* mod = (float*)(ws + WS_MOD);
        for (int it = F.bid; it < 192; it += F.G) {
            const int l = it / 96, n0 = (it % 96) * 64;
            const float* w = IN(I_MODW) + (size_t)l * 1024 * 6144 + n0 + F.lane;
            float a0 = 0.f, a1 = 0.f, a2 = 0.f, a3 = 0.f, a4 = 0.f;
            const int kb = F.wave * 128;
#pragma unroll 8
            for (int k = 0; k < 128; ++k) { const float wv = w[(size_t)(kb + k) * 6144];
                a0 += sc[kb + k] * wv; a1 += sc[1024 + kb + k] * wv; a2 += sc[2048 + kb + k] * wv; a3 += sc[3072 + kb + k] * wv; a4 += sc[4096 + kb + k] * wv; }
            red[(F.wave * 5 + 0) * 64 + F.lane] = a0; red[(F.wave * 5 + 1) * 64 + F.lane] = a1; red[(F.wave * 5 + 2) * 64 + F.lane] = a2; red[(F.wave * 5 + 3) * 64 + F.lane] = a3; red[(F.wave * 5 + 4) * 64 + F.lane] = a4;
            __syncthreads();
            if (F.tid < 320) { const int r = F.tid >> 6, ln = F.tid & 63; float s = 0.f;
#pragma unroll
                for (int w8 = 0; w8 < 8; ++w8) s += red[(w8 * 5 + r) * 64 + ln];
                mod[((size_t)l * 5 + r) * 6144 + n0 + ln] = s + IN(I_MODB)[l * 6144 + n0 + ln]; }
            __syncthreads();
        }
    }
    {
        float* h3 = (float*)(ws + WS_H3);
        const float* w1 = IN(I_FW1); const float* w2 = IN(I_FW2); const float* w3 = IN(I_FW3);
        const float fr = IN(I_FREQ)[F.lane], b1 = IN(I_FB1)[F.lane], b2 = IN(I_FB2)[F.lane], b3 = IN(I_FB3)[F.lane];
        for (int row = F.gw; row < SEQ + CTXL; row += F.ngw) {
            const int L = row < SEQ ? SEQ : CTXL, i = row < SEQ ? row : row - SEQ;
            const float tl = (float)i / (float)(L - 1), w = 6.283185307179586f * (float)i / (float)L;
            float pos = 0.f; const int k = F.lane;
            if (k == 0) pos = tl;
            else if (k <= 16) { const float band = 1e-4f + (float)(k - 1) * ((15.0f - 1e-4f) / 15.0f); pos = cosf(band * w); }
            else if (k <= 32) { const float band = 1e-4f + (float)(k - 17) * ((15.0f - 1e-4f) / 15.0f); pos = -sinf(band * w); }
            float s = b1;
#pragma unroll
            for (int kk = 0; kk < 33; ++kk) s += __shfl(pos, kk) * w1[kk * 64 + F.lane];
            float h = sinf(fr * s);
            s = b2;
#pragma unroll 16
            for (int kk = 0; kk < 64; ++kk) s += __shfl(h, kk) * w2[kk * 64 + F.lane];
            h = sinf(fr * s);
            s = b3;
#pragma unroll 16
            for (int kk = 0; kk < 64; ++kk) s += __shfl(h, kk) * w3[kk * 64 + F.lane];
            h = sinf(fr * s);
            h3[(size_t)row * 64 + F.lane] = h;
        }
    }
    {
        bf16* gwt = (bf16*)(ws + WS_GWT); float* wkq = (float*)(ws + WS_WKQ);
        const float* wq = IN(I_MWQ); const float* wk = IN(I_MWK); const float* wv = IN(I_MWV); const float* wg = IN(I_MWG);
        const int gt = F.bid * NTHR + F.tid, nt = F.G * NTHR;
        for (int i = gt; i < MI * 16; i += nt) { const int ch = i >> 4, g = i & 15, n = ch >> 2, c = ch & 3; float sa = 0.f, sb = 0.f;
#pragma unroll
            for (int e = 0; e < 4; ++e) { sa += wq[n * 16 + c * 4 + e] * wg[(size_t)(n * 4 + e) * 16 + g] + wk[n * 16 + c * 4 + e] * wg[(size_t)(MI + n * 4 + e) * 16 + g];
                sb += wv[n * 16 + c * 4 + e] * wg[(size_t)(2 * MI + n * 4 + e) * 16 + g]; }
            gwt[(size_t)g * 4096 + ch] = (bf16)f2bf(sa); gwt[(size_t)g * 4096 + MI + ch] = (bf16)f2bf(sb); }
        const float sc = 0.044194173824159216f;
        for (int i = gt; i < 512 * 16; i += nt) { const int n = i >> 4, c = (i >> 2) & 3, c2 = i & 3; float s = 0.f;
#pragma unroll
            for (int e = 0; e < 4; ++e) s += wk[n * 16 + c * 4 + e] * wq[n * 16 + c2 * 4 + e];
            wkq[i] = s * sc; }
    }
}

__device__ __forceinline__ void kt_items(Fr& F, const float* h3rows, int L, float* KT) {
    const float* wout = IN(I_FWOUT);
    const int nitems = (L / 64) * 64;
    for (int it = F.gw; it < nitems; it += F.ngw) {
        const int tb = it >> 6, nc = it & 63, t = tb * 64 + F.lane;
        float h[64];
        const f32x4* hp = (const f32x4*)(h3rows + (size_t)t * 64);
#pragma unroll
        for (int q = 0; q < 16; ++q) { const f32x4 v = hp[q]; h[4 * q] = v[0]; h[4 * q + 1] = v[1]; h[4 * q + 2] = v[2]; h[4 * q + 3] = v[3]; }
        const float tl = (float)t / (float)(L - 1);
#pragma unroll 1
        for (int nn = 0; nn < 32; ++nn) {
            const int n = nc * 32 + nn; float acc = 0.f;
#pragma unroll
            for (int k = 0; k < 64; ++k) acc += h[k] * wout[k * 2048 + n];
            const int dirn = n >> 10, c = n & 1023;
            const float delta = fabsf(HY_MIN_DECAY + (float)c * ((HY_MAX_DECAY - HY_MIN_DECAY) / 1023.0f));
            KT[((size_t)c * 2 + dirn) * L + t] = acc * __expf(-tl * delta);
        }
    }
}

__device__ __forceinline__ void modnorm_row(const float* xrow, const float* g, const float* sh, const float* sc, bf16* orow, int lane) {
    const f32x4* xr = (const f32x4*)xrow + lane; f32x4 v[4]; float s = 0.f;
#pragma unroll
    for (int j = 0; j < 4; ++j) { v[j] = xr[64 * j]; s += (v[j][0] * v[j][0] + v[j][1] * v[j][1]) + (v[j][2] * v[j][2] + v[j][3] * v[j][3]); }
    const float rinv = 1.0f / sqrtf(wave_sum(s) * (1.0f / 1024.0f) + EPS);
    u32x2* o8 = (u32x2*)orow + lane;
#pragma unroll
    for (int j = 0; j < 4; ++j) { const int c = 4 * lane + 256 * j; const f32x4 gg = *(const f32x4*)(g + c), s1 = *(const f32x4*)(sc + c), s0 = *(const f32x4*)(sh + c);
        const f32x4 y = (v[j] * rinv * gg) * (1.0f + s1) + s0; u32x2 w; w.x = pk2(y[0], y[1]); w.y = pk2(y[2], y[3]); o8[64 * j] = w; }
}
__device__ __forceinline__ void ph_modnorm(Fr& F, const float* xlat, int nlat, int b0, const float* xctx, int nctx, const float* g, const float* modl, int shoff, bf16* H) {
    for (int r = F.gw; r < nlat + nctx; r += F.ngw) {
        const bool isl = r < nlat; const float* xr = isl ? xlat + (size_t)r * 1024 : xctx + (size_t)(r - nlat) * 1024; const int mr = isl ? b0 + r / SEQ : 4;
        modnorm_row(xr, g, modl + (size_t)mr * 6144 + shoff, modl + (size_t)mr * 6144 + shoff + 1024, H + (size_t)r * 1024, F.lane);
    }
}

__device__ __forceinline__ void zt_items(Fr& F, const bf16* P, int rowbase, int nb, int Ls, bf16* ZT) {
    LAS unsigned char* tile = F.lds + F.wave * 16384;
    const float* scw = IN(I_HSCW); const float* scb = IN(I_HSCB);
    const int ntt = Ls / 64, nitems = nb * ntt * 16;
    for (int it = F.gw; it < nitems; it += F.ngw) {
        const int ct = it & 15, tt = (it >> 4) % ntt, b = (it >> 4) / ntt, t0 = tt * 64, c = ct * 64 + F.lane;
        const float w10 = scw[1024 + c], w11 = scw[3072 + 1024 + c], w12 = scw[6144 + 1024 + c], bb1 = scb[1024 + c];
        const float w20 = scw[2048 + c], w21 = scw[3072 + 2048 + c], w22 = scw[6144 + 2048 + c], bb2 = scb[2048 + c];
        const bf16* pb = P + (size_t)(rowbase + b * Ls) * 3072;
        float x1p = 0.f, x1c = 0.f, vp = 0.f, vc = 0.f;
        if (t0 > 0) { x1p = bf2f(pb[(size_t)(t0 - 1) * 3072 + 1024 + c]); vp = bf2f(pb[(size_t)(t0 - 1) * 3072 + 2048 + c]); }
        x1c = bf2f(pb[(size_t)t0 * 3072 + 1024 + c]); vc = bf2f(pb[(size_t)t0 * 3072 + 2048 + c]);
#pragma unroll 4
        for (int j = 0; j < 64; ++j) {
            const int tn = t0 + j + 1; float x1n = 0.f, vn = 0.f;
            if (tn < Ls) { x1n = bf2f(pb[(size_t)tn * 3072 + 1024 + c]); vn = bf2f(pb[(size_t)tn * 3072 + 2048 + c]); }
            const float a = w10 * x1p + w11 * x1c + w12 * x1n + bb1, d = w20 * vp + w21 * vc + w22 * vn + bb2;
            *(LAS bf16*)(tile + F.lane * 136 + j * 2) = (bf16)f2bf(a * d);
            x1p = x1c; x1c = x1n; vp = vc; vc = vn;
        }
#pragma unroll
        for (int q = 0; q < 8; ++q) { const int cc = q * 8 + (F.lane >> 3), ch = F.lane & 7;
            const u32x2 lo = *(const LAS u32x2*)(tile + cc * 136 + ch * 16), hi = *(const LAS u32x2*)(tile + cc * 136 + ch * 16 + 8);
            u32x4 o; o.x = lo.x; o.y = lo.y; o.z = hi.x; o.w = hi.y;
            *(u32x4*)(ZT + ((size_t)b * 1024 + ct * 64 + cc) * Ls + t0 + ch * 8) = o; }
    }
}

__device__ __forceinline__ f32x2 cmul(f32x2 a, f32x2 b) { return (f32x2){a.x * b.x - a.y * b.y, a.x * b.y + a.y * b.x}; }
__device__ __forceinline__ f32x2 twid(float f) { return (f32x2){__builtin_amdgcn_cosf(f), __builtin_amdgcn_sinf(f)}; }
__device__ __forceinline__ void fft_fwd(LAS f32x2* buf, int tid) {
#pragma unroll 1
    for (int p = 0; p < 7; ++p) {
        const int lq = 12 - 2 * p, q = 1 << lq; const float invN = 1.0f / (float)(4 * q);
#pragma unroll 1
        for (int m = 0; m < 8; ++m) {
            const int g = tid + 512 * m, i = g & (q - 1), i0 = ((g >> lq) << (lq + 2)) + i;
            const f32x2 a0 = buf[i0], a1 = buf[i0 + q], a2 = buf[i0 + 2 * q], a3 = buf[i0 + 3 * q];
            const f32x2 t0 = a0 + a2, t1 = a0 - a2, t2 = a1 + a3, d = a1 - a3, t3 = (f32x2){d.y, -d.x};
            const float f = -(float)i * invN;
            buf[i0] = t0 + t2; buf[i0 + q] = cmul(t1 + t3, twid(f)); buf[i0 + 2 * q] = cmul(t0 - t2, twid(2.f * f)); buf[i0 + 3 * q] = cmul(t1 - t3, twid(3.f * f));
        }
        __syncthreads();
    }
}
__device__ __forceinline__ void fft_inv(LAS f32x2* buf, int tid) {
#pragma unroll 1
    for (int p = 6; p >= 0; --p) {
        const int lq = 12 - 2 * p, q = 1 << lq; const float invN = 1.0f / (float)(4 * q);
#pragma unroll 1
        for (int m = 0; m < 8; ++m) {
            const int g = tid + 512 * m, i = g & (q - 1), i0 = ((g >> lq) << (lq + 2)) + i;
            const float f = (float)i * invN;
            const f32x2 b0 = buf[i0], b1 = cmul(buf[i0 + q], twid(f)), b2 = cmul(buf[i0 + 2 * q], twid(2.f * f)), b3 = cmul(buf[i0 + 3 * q], twid(3.f * f));
            const f32x2 t0 = b0 + b2, t1 = b0 - b2, t2 = b1 + b3, d = b1 - b3, t3 = (f32x2){-d.y, d.x};
            buf[i0] = t0 + t2; buf[i0 + q] = t1 + t3; buf[i0 + 2 * q] = t0 - t2; buf[i0 + 3 * q] = t1 - t3;
        }
        __syncthreads();
    }
}
__device__ __forceinline__ float block_sum(Fr& F, float v, LAS float* red) {
    v = wave_sum(v);
    __syncthreads();
    if (F.lane == 0) red[F.wave] = v;
    __syncthreads();
    float s = 0.f;
#pragma unroll
    for (int w = 0; w < 8; ++w) s += red[w];
    return s;
}
__device__ __forceinline__ void ph_fftconv(Fr& F) {
    LAS f32x2* buf = (LAS f32x2*)F.lds; LAS float* red = (LAS float*)(F.lds + 131072);
    const float* KT = (const float*)(F.ws + HY_KT); const float* KTC = (const float*)(F.ws + WS_KTC);
    bf16* ZT = (bf16*)(F.ws + HY_ZT); bf16* ZTC = (bf16*)(F.ws + HY_ZTC);
    const int tid = F.tid;
    for (int c = F.bid; c < 1024; c += F.G) {
        const float bias = IN(I_HBIAS)[c];
        __syncthreads();
        float asum = 0.f;
        const f32x4* kf = (const f32x4*)(KT + (size_t)c * 2 * SEQ); const f32x4* kb = kf + SEQ / 4;
#pragma unroll
        for (int q = 0; q < 4; ++q) { const int i4 = tid + 512 * q; const f32x4 v = kf[i4];
            asum += fabsf(v[0]) + fabsf(v[1]) + fabsf(v[2]) + fabsf(v[3]);
            buf[4 * i4] = (f32x2){v[0], 0.f}; buf[4 * i4 + 1] = (f32x2){v[1], 0.f}; buf[4 * i4 + 2] = (f32x2){v[2], 0.f}; buf[4 * i4 + 3] = (f32x2){v[3], 0.f};
            const f32x4 u = kb[i4]; const int m = 4 * i4;
            if (m > 0) { buf[16384 - m] = (f32x2){u[0], 0.f}; asum += fabsf(u[0]); } else buf[8192] = (f32x2){0.f, 0.f};
            buf[16384 - m - 1] = (f32x2){u[1], 0.f}; buf[16384 - m - 2] = (f32x2){u[2], 0.f}; buf[16384 - m - 3] = (f32x2){u[3], 0.f};
            asum += fabsf(u[1]) + fabsf(u[2]) + fabsf(u[3]); }
        const float S = block_sum(F, asum, red);
        __syncthreads();
        fft_fwd(buf, tid);
        f32x2* Ks = (f32x2*)(F.ws + HY_KS) + (size_t)(F.bid & 255) * 16384 + tid; const float ksc = 1.0f / (S * 16384.0f);
#pragma unroll 8
        for (int j = 0; j < 32; ++j) Ks[512 * j] = buf[tid + 512 * j] * ksc;
#pragma unroll 1
        for (int pr = 0; pr < 2; ++pr) {
            bf16* z0 = ZT + ((size_t)(2 * pr) * 1024 + c) * SEQ; bf16* z1 = ZT + ((size_t)(2 * pr + 1) * 1024 + c) * SEQ;
            __syncthreads();
#pragma unroll
            for (int q = 0; q < 2; ++q) { const int t8 = (tid + 512 * q) * 8; float a[8], b[8];
                unpack8(*(const u32x4*)(z0 + t8), a); unpack8(*(const u32x4*)(z1 + t8), b);
#pragma unroll
                for (int e = 0; e < 8; ++e) { buf[t8 + e] = (f32x2){a[e], b[e]}; buf[8192 + t8 + e] = (f32x2){0.f, 0.f}; } }
            __syncthreads();
            fft_fwd(buf, tid);
#pragma unroll 8
            for (int j = 0; j < 32; ++j) buf[tid + 512 * j] = cmul(buf[tid + 512 * j], Ks[512 * j]);
            __syncthreads();
            fft_inv(buf, tid);
#pragma unroll
            for (int q = 0; q < 2; ++q) { const int t8 = (tid + 512 * q) * 8; float a[8], b[8];
                unpack8(*(const u32x4*)(z0 + t8), a); unpack8(*(const u32x4*)(z1 + t8), b);
#pragma unroll
                for (int e = 0; e < 8; ++e) { const f32x2 y = buf[t8 + e]; a[e] = y.x + a[e] * bias; b[e] = y.y + b[e] * bias; }
                *(u32x4*)(z0 + t8) = pack8(a); *(u32x4*)(z1 + t8) = pack8(b); }
        }
        __syncthreads();
        {
            LAS float* kc = (LAS float*)F.lds; LAS float* zc = kc + 512;
            const float* kfc = KTC + (size_t)c * 2 * CTXL; float v = 0.f;
            { const int n = tid; if (n < 256) v = kfc[n]; else if (n == 256) v = 0.f; else v = kfc[CTXL + (512 - n)]; kc[n] = v; }
            const float Sc = block_sum(F, fabsf(v), red);
            for (int i = tid; i < 1024; i += NTHR) { const int b = i >> 8, t = i & 255; zc[i] = bf2f(ZTC[((size_t)b * 1024 + c) * CTXL + t]); }
            __syncthreads();
            const int b = tid >> 7, t2 = tid & 127; const float isc = 1.0f / Sc;
#pragma unroll
            for (int hh = 0; hh < 2; ++hh) { const int t = t2 + 128 * hh; float acc = 0.f;
#pragma unroll 8
                for (int s = 0; s < 256; ++s) acc += zc[b * 256 + s] * kc[(t - s) & 511];
                ZTC[((size_t)b * 1024 + c) * CTXL + t] = (bf16)f2bf(acc * isc + zc[b * 256 + t] * bias); }
        }
    }
}

__device__ __forceinline__ void u2_items(Fr& F, const bf16* P, int rowbase, int nb, int Ls, const bf16* YT, bf16* U2) {
    LAS unsigned char* tile = F.lds + F.wave * 16384;
    const float* scw = IN(I_HSCW); const float* scb = IN(I_HSCB);
    const int ntt = Ls / 64, nitems = nb * ntt * 16;
    for (int it = F.gw; it < nitems; it += F.ngw) {
        const int ct = it & 15, tt = (it >> 4) % ntt, b = (it >> 4) / ntt, t0 = tt * 64, c = ct * 64 + F.lane;
#pragma unroll
        for (int q = 0; q < 8; ++q) { const int cc = q * 8 + (F.lane >> 3), ch = F.lane & 7;
            const u32x4 v = *(const u32x4*)(YT + ((size_t)b * 1024 + ct * 64 + cc) * Ls + t0 + ch * 8);
            *(LAS u32x2*)(tile + cc * 136 + ch * 16) = (u32x2){v.x, v.y}; *(LAS u32x2*)(tile + cc * 136 + ch * 16 + 8) = (u32x2){v.z, v.w}; }
        const float w0 = scw[c], w1 = scw[3072 + c], w2 = scw[6144 + c], bb = scb[c];
        const bf16* pb = P + (size_t)(rowbase + b * Ls) * 3072; bf16* ub = U2 + (size_t)(rowbase + b * Ls) * 1024;
        float xp = 0.f, xc = bf2f(pb[(size_t)t0 * 3072 + c]);
        if (t0 > 0) xp = bf2f(pb[(size_t)(t0 - 1) * 3072 + c]);
#pragma unroll 4
        for (int j = 0; j < 64; ++j) {
            const int tn = t0 + j + 1; float xn = 0.f; if (tn < Ls) xn = bf2f(pb[(size_t)tn * 3072 + c]);
            const float x0 = w0 * xp + w1 * xc + w2 * xn + bb, y = bf2f(*(const LAS bf16*)(tile + F.lane * 136 + j * 2));
            ub[(size_t)(t0 + j) * 1024 + c] = (bf16)f2bf(x0 * y);
            xp = xc; xc = xn;
        }
    }
}

__device__ __forceinline__ void ph_dwconv(Fr& F, int layer, int nlat, int nctx) {
    bf16* A = (bf16*)(F.ws + FF_A); const bf16* G = (const bf16*)(F.ws + FF_G);
    const float* cw = IN(I_FCW) + (size_t)layer * 9 * FF; const float* cb = IN(I_FCB) + (size_t)layer * FF;
    const int ngrp = (F.G % 8 == 0) ? 8 : 1, xg = F.bid % ngrp, lb = F.bid / ngrp, nlb = F.G / ngrp;
    const int latb = nlat / ngrp, ctxb = nctx / ngrp, bandrows = latb + ctxb;
    const int total = bandrows * 352;
    for (int i = lb * NTHR + F.tid; i < total; i += nlb * NTHR) {
        const int rr = i / 352, f8 = (i - rr * 352) * 8;
        const int r = rr < latb ? xg * latb + rr : nlat + xg * ctxb + (rr - latb);
        float acc[8];
        { const f32x4 b0 = *(const f32x4*)(cb + f8), b1 = *(const f32x4*)(cb + f8 + 4); acc[0] = b0[0]; acc[1] = b0[1]; acc[2] = b0[2]; acc[3] = b0[3]; acc[4] = b1[0]; acc[5] = b1[1]; acc[6] = b1[2]; acc[7] = b1[3]; }
        const bool islat = r < nlat; const int t = islat ? (r & (SEQ - 1)) : ((r - nlat) & (CTXL - 1));
        const int gy = islat ? (t >> 6) : 0, gx = islat ? (t & 63) : t, ny = islat ? 128 : 1, nx = islat ? 64 : CTXL, rbase = r - t;
        u32x4 gv[9]; float msk[9];
#pragma unroll
        for (int dy = -1; dy <= 1; ++dy)
#pragma unroll
            for (int dx = -1; dx <= 1; ++dx) {
                const int yy = gy + dy, xx = gx + dx; const bool ok = (yy >= 0) && (yy < ny) && (xx >= 0) && (xx < nx);
                const int yc = yy < 0 ? 0 : (yy >= ny ? ny - 1 : yy), xc_ = xx < 0 ? 0 : (xx >= nx ? nx - 1 : xx);
                gv[(dy + 1) * 3 + dx + 1] = *(const u32x4*)(G + (size_t)(rbase + yc * nx + xc_) * FF + f8); msk[(dy + 1) * 3 + dx + 1] = ok ? 1.0f : 0.0f; }
#pragma unroll
        for (int k = 0; k < 9; ++k) { float v[8]; unpack8(gv[k], v); const float* wp = cw + (size_t)k * FF + f8; const f32x4 w0 = *(const f32x4*)wp * msk[k], w1 = *(const f32x4*)(wp + 4) * msk[k];
            acc[0] += v[0] * w0[0]; acc[1] += v[1] * w0[1]; acc[2] += v[2] * w0[2]; acc[3] += v[3] * w0[3]; acc[4] += v[4] * w1[0]; acc[5] += v[5] * w1[1]; acc[6] += v[6] * w1[2]; acc[7] += v[7] * w1[3]; }
        float a[8]; unpack8(*(const u32x4*)(A + (size_t)r * FF + f8), a);
#pragma unroll
        for (int e = 0; e < 8; ++e) a[e] = silu_f(acc[e]) * a[e];
        *(u32x4*)(A + (size_t)r * FF + f8) = pack8(a);
    }
}

__device__ __forceinline__ void prep_items(Fr& F, const bf16* XM, int nb, int Ls, bf16* XC, bf16* KN, bf16* KT, bf16* VT) {
    LAS unsigned char* tk = F.lds + F.wave * 17408; LAS unsigned char* tv = tk + 8704;
    const int ntt = Ls / 64, nitems = nb * ntt * 32;
    const int tl = F.lane >> 3, c8 = F.lane & 7;
    for (int it = F.gw; it < nitems; it += F.ngw) {
        const int cg = it & 31, tt = (it >> 5) % ntt, b = (it >> 5) / ntt, t0 = tt * 64, ch0 = cg * 64 + c8 * 8, h = cg >> 3;
        float cw0[8], cw1[8], cw2[8], cbb[8], wkq[32], wv[32];
        { const float* p = IN(I_MCW) + ch0; const float* pb = IN(I_MCB) + ch0;
#pragma unroll
            for (int e = 0; e < 8; ++e) { cw0[e] = p[e]; cw1[e] = p[MI + e]; cw2[e] = p[2 * MI + e]; cbb[e] = pb[e]; }
            const float* q = (const float*)(F.ws + WS_WKQ) + (ch0 >> 2) * 16; const float* v = IN(I_MWV) + (ch0 >> 2) * 16;
#pragma unroll
            for (int e = 0; e < 32; ++e) { wkq[e] = q[e]; wv[e] = v[e]; } }
#pragma unroll 1
        for (int i8 = 0; i8 < 8; ++i8) {
            const int tloc = i8 * 8 + tl, t = t0 + tloc; const size_t row = (size_t)b * Ls + t;
            float xp[8], xm[8], xn[8];
            const u32x4 rm = *(const u32x4*)(XM + row * MI + ch0), rp = *(const u32x4*)(XM + (row - (t > 0 ? 1 : 0)) * MI + ch0), rn = *(const u32x4*)(XM + (row + (t + 1 < Ls ? 1 : 0)) * MI + ch0);
            unpack8(rm, xm); unpack8(rp, xp); unpack8(rn, xn);
            { const float mp = t > 0 ? 1.f : 0.f, mn = t + 1 < Ls ? 1.f : 0.f;
#pragma unroll
                for (int e = 0; e < 8; ++e) { xp[e] *= mp; xn[e] *= mn; } }
            float xc[8], kp[8], vv[8];
#pragma unroll
            for (int e = 0; e < 8; ++e) xc[e] = silu_f(cw0[e] * xp[e] + cw1[e] * xm[e] + cw2[e] * xn[e] + cbb[e]);
#pragma unroll
            for (int n = 0; n < 2; ++n)
#pragma unroll
                for (int o = 0; o < 4; ++o) { float sk = 0.f, sv = 0.f;
#pragma unroll
                    for (int c = 0; c < 4; ++c) { sk += xc[n * 4 + c] * wkq[n * 16 + c * 4 + o]; sv += xm[n * 4 + c] * wv[n * 16 + c * 4 + o]; }
                    kp[n * 4 + o] = sk; vv[n * 4 + o] = sv; }
            { const size_t to = ((size_t)(row >> 4) * 64 + (ch0 >> 5)) * 512 + (((unsigned)row & 15u) + 16u * ((ch0 & 31) >> 3)) * 8u;
              *(u32x4*)(XC + to) = pack8(xc); *(u32x4*)(KN + to) = pack8(kp); }
#pragma unroll
            for (int e = 0; e < 8; ++e) { *(LAS bf16*)(tk + (c8 * 8 + e) * 136 + tloc * 2) = (bf16)f2bf(kp[e]); *(LAS bf16*)(tv + (c8 * 8 + e) * 136 + tloc * 2) = (bf16)f2bf(vv[e]); }
        }
#pragma unroll
        for (int q = 0; q < 8; ++q) { const int dt = q >> 1, kq = q & 1, r = F.lane & 15, q4 = F.lane >> 4;
            const size_t tile = ((size_t)(t0 >> 7) * 32 + (cg & 7) * 4 + dt) * 4 + ((t0 & 127) >> 5) + kq;
            const size_t o = (size_t)(b * 4 + h) * 512 * Ls + tile * 512 + F.lane * 8;
            { const u32x2 lo = *(const LAS u32x2*)(tk + (dt * 16 + r) * 136 + kq * 64 + q4 * 16), hi = *(const LAS u32x2*)(tk + (dt * 16 + r) * 136 + kq * 64 + q4 * 16 + 8); *(u32x4*)(KT + o) = (u32x4){lo.x, lo.y, hi.x, hi.y}; }
            { const u32x2 lo = *(const LAS u32x2*)(tv + (dt * 16 + r) * 136 + kq * 64 + q4 * 16), hi = *(const LAS u32x2*)(tv + (dt * 16 + r) * 136 + kq * 64 + q4 * 16 + 8); *(u32x4*)(VT + o) = (u32x4){lo.x, lo.y, hi.x, hi.y}; }
        }
    }
}

__device__ __forceinline__ void gate_items(Fr& F, const bf16* XC, const bf16* XM, int R, float* GATES) {
    const bf16* gwt = (const bf16*)(F.ws + WS_GWT);
    const int fr = F.lane & 15, fq = F.lane >> 4;
    for (int tile = F.gw; tile < R / 16; tile += F.ngw) {
        const int r0 = tile * 16; f32x4 acc = (f32x4){0.f, 0.f, 0.f, 0.f};
        const bf16* ap = XC + (size_t)(r0 >> 4) * 64 * 512 + F.lane * 8; const bf16* bp = gwt + (size_t)fr * 4096 + 8 * fq;
#pragma unroll 8
        for (int ks = 0; ks < 64; ++ks) acc = __builtin_amdgcn_mfma_f32_16x16x32_bf16(*(const bf16x8*)(ap + ks * 512), *(const bf16x8*)(bp + ks * 32), acc, 0, 0, 0);
        ap = XM + (size_t)(r0 + fr) * MI + 8 * fq; bp += MI;
#pragma unroll 8
        for (int ks = 0; ks < 64; ++ks) acc = __builtin_amdgcn_mfma_f32_16x16x32_bf16(*(const bf16x8*)(ap + ks * 32), *(const bf16x8*)(bp + ks * 32), acc, 0, 0, 0);
        const float bg = IN(I_MBG)[fr]; const bool isf = (fr >> 2) & 1;
#pragma unroll
        for (int r = 0; r < 4; ++r) { float x = acc[r] + bg; if (isf) x = fminf(x, 0.f) - log1pf(__expf(-fabsf(x))); GATES[(size_t)(r0 + 4 * fq + r) * 16 + fr] = x; }
    }
}

__device__ __forceinline__ void cum_items(Fr& F, const float* GATES, int nb, int Ls, int gb0, int ctau0, f32x4* GT, float* GC) {
    const int R = nb * Ls, nch = Ls / 128, nitems = 2 * nb * 4 * nch;
    for (int it = F.gw; it < nitems; it += F.ngw) {
        const int c = it % nch, h = (it / nch) & 3, b = (it / nch / 4) % nb, dir = it / nch / 4 / nb;
        const int row0 = b * Ls + c * 128 + 2 * F.lane;
        const float lf0 = GATES[(size_t)row0 * 16 + dir * 8 + 4 + h], lf1 = GATES[(size_t)(row0 + 1) * 16 + dir * 8 + 4 + h];
        const float ig0 = GATES[(size_t)row0 * 16 + dir * 8 + h], ig1 = GATES[(size_t)(row0 + 1) * 16 + dir * 8 + h];
        float inc = lf0 + lf1;
#pragma unroll
        for (int o = 1; o < 64; o <<= 1) { const float t = __shfl_up(inc, o); if (F.lane >= o) inc += t; }
        const float tot = __shfl(inc, 63), exc = inc - (lf0 + lf1);
        float b0, b1;
        if (dir == 0) { b0 = exc + lf0; b1 = inc; } else { b0 = tot - exc; b1 = tot - exc - lf0; }
        GT[(size_t)(dir * 4 + h) * R + row0] = (f32x4){b0, ig0 - b0, __expf(b0), __expf(tot - b0 + ig0)};
        GT[(size_t)(dir * 4 + h) * R + row0 + 1] = (f32x4){b1, ig1 - b1, __expf(b1), __expf(tot - b1 + ig1)};
        if (F.lane == 0) GC[((size_t)(dir * 4 + gb0 + b) * 4 + h) * 66 + ctau0 + c] = __expf(tot);
    }
}

__device__ __forceinline__ void dn_item(Fr& F, const bf16* KTchunk, const f32x4* GTd0, const f32x4* GTd1, int row0, float* DN0, float* DN1) {
    LAS float* wl = (LAS float*)(F.lds + 1024);
    __syncthreads();
    if (F.tid < 128) wl[F.tid] = GTd0[row0 + F.tid][3]; else if (F.tid < 256) wl[F.tid] = GTd1[row0 + F.tid - 128][3];
    __syncthreads();
    const bf16* kr = KTchunk + (size_t)(F.tid >> 4) * 4 * 512 + (F.tid & 15) * 8; float s0 = 0.f, s1 = 0.f;
#pragma unroll 4
    for (int q = 0; q < 16; ++q) { const int ks = q >> 2, q4 = q & 3; float v[8]; unpack8(*(const u32x4*)(kr + ks * 512 + q4 * 128), v);
#pragma unroll
        for (int e = 0; e < 8; ++e) { s0 += v[e] * wl[q * 8 + e]; s1 += v[e] * wl[128 + q * 8 + e]; } }
    DN0[F.tid] = s0; DN1[F.tid] = s1;
}
__device__ __forceinline__ void ph_sphase(Fr& F, int hb, bool with_ctx) {
    const bf16* XC = (const bf16*)(F.ws + MS_XC); const bf16* KN = (const bf16*)(F.ws + MS_KN); const bf16* KT = (const bf16*)(F.ws + MS_KT);
    const f32x4* GT = (const f32x4*)(F.ws + WS_GT_L); float* DN = (float*)(F.ws + WS_DN); float* RS = (float*)(F.ws + WS_RS);
    bf16* S = (bf16*)(F.ws + MS_S);
    const int fr = F.lane & 15, fq = F.lane >> 4, w = F.wave;
    for (int it = F.bid; it < 512; it += F.G) {
        const int c = it & 63, h = (it >> 6) & 3, bl = it >> 8, gb = 2 * hb + bl;
        const int row0 = bl * SEQ + c * 128;
        dn_item(F, KT + (size_t)(bl * 4 + h) * 512 * SEQ + (size_t)c * 65536, GT + (size_t)(0 * 4 + h) * HROWS, GT + (size_t)(1 * 4 + h) * HROWS, row0,
                DN + (((size_t)(0 * 4 + gb) * 4 + h) * 66 + 2 + c) * 512, DN + (((size_t)(1 * 4 + gb) * 4 + h) * 66 + 2 + c) * 512);
        const int irow = row0 + 16 * w + fr;
        bf16x8 bq[16];
        { const bf16* p = XC + ((size_t)((row0 >> 4) + w) * 64 + h * 16) * 512 + F.lane * 8;
#pragma unroll
            for (int ks = 0; ks < 16; ++ks) bq[ks] = *(const bf16x8*)(p + ks * 512); }
        const f32x4 gf = GT[(size_t)(0 * 4 + h) * HROWS + irow], gbk = GT[(size_t)(1 * 4 + h) * HROWS + irow];
        float rsf = 0.f, rsb = 0.f;
        bf16* sf = S + ((size_t)(0 * 8 + bl * 4 + h) * 64 + c) * 16384; bf16* sb = S + ((size_t)(1 * 8 + bl * 4 + h) * 64 + c) * 16384;
#pragma unroll 1
        for (int jt = 0; jt < 8; ++jt) {
            f32x4 acc = (f32x4){0.f, 0.f, 0.f, 0.f};
            const bf16* ap = KN + ((size_t)((row0 >> 4) + jt) * 64 + h * 16) * 512 + F.lane * 8;
#pragma unroll
            for (int ks = 0; ks < 16; ++ks) acc = __builtin_amdgcn_mfma_f32_16x16x32_bf16(*(const bf16x8*)(ap + ks * 512), bq[ks], acc, 0, 0, 0);
            float vf[4], vb[4];
            const f32x4* gj0 = GT + (size_t)(0 * 4 + h) * HROWS + row0 + jt * 16 + 4 * fq; const f32x4* gj1 = GT + (size_t)(1 * 4 + h) * HROWS + row0 + jt * 16 + 4 * fq;
#pragma unroll
            for (int r = 0; r < 4; ++r) { const int j = jt * 16 + 4 * fq + r, i = 16 * w + fr;
                const float af = gj0[r][1], ab = gj1[r][1];
                vf[r] = (j <= i) ? acc[r] * __expf(gf[0] + af) : 0.f; vb[r] = (j >= i) ? acc[r] * __expf(gbk[0] + ab) : 0.f;
                rsf += vf[r]; rsb += vb[r]; }
            const size_t so = (size_t)(w * 4 + (jt >> 1)) * 512 + (fr + 16 * ((jt & 1) * 2 + (fq >> 1))) * 8 + (fq & 1) * 4;
            *(u32x2*)(sf + so) = (u32x2){pk2(vf[0], vf[1]), pk2(vf[2], vf[3])};
            *(u32x2*)(sb + so) = (u32x2){pk2(vb[0], vb[1]), pk2(vb[2], vb[3])};
        }
        rsf += __shfl_xor(rsf, 16); rsf += __shfl_xor(rsf, 32); rsb += __shfl_xor(rsb, 16); rsb += __shfl_xor(rsb, 32);
        if (fq == 0) { RS[(size_t)(0 * 4 + h) * HROWS + irow] = rsf; RS[(size_t)(1 * 4 + h) * HROWS + irow] = rsb; }
    }
    if (with_ctx) {
        const bf16* KTC2 = (const bf16*)(F.ws + MS_KTC); const f32x4* GTC = (const f32x4*)(F.ws + WS_GT_C);
        for (int it = F.bid; it < 32; it += F.G) {
            const int cc = it & 1, h = (it >> 1) & 3, gb = it >> 3;
            dn_item(F, KTC2 + (size_t)(gb * 4 + h) * 512 * CTXL + (size_t)cc * 65536, GTC + (size_t)(0 * 4 + h) * MC, GTC + (size_t)(1 * 4 + h) * MC, gb * CTXL + cc * 128,
                    DN + (((size_t)(0 * 4 + gb) * 4 + h) * 66 + cc) * 512, DN + (((size_t)(1 * 4 + gb) * 4 + h) * 66 + cc) * 512);
        }
    }
}

__device__ __forceinline__ bf16x8 ldg16(const char* ub, unsigned off) { return *(const bf16x8*)(ub + off); }
__device__ __forceinline__ void ph_scan(Fr& F, int hb) {
    const char* XC = (const char*)(F.ws + MS_XC); const char* KT = (const char*)(F.ws + MS_KT); const char* VT = (const char*)(F.ws + MS_VT);
    const char* KTC2 = (const char*)(F.ws + MS_KTC); const char* VTC2 = (const char*)(F.ws + MS_VTC);
    const char* S = (const char*)(F.ws + MS_S);
    const f32x4* GTL = (const f32x4*)(F.ws + WS_GT_L); const f32x4* GTC = (const f32x4*)(F.ws + WS_GT_C);
    const float* GC = (const float*)(F.ws + WS_GC); const float* DN = (const float*)(F.ws + WS_DN);
    float* NC = (float*)(F.ws + WS_NC);
    LAS unsigned char* cbf = F.lds;
    LAS float* wl = (LAS float*)(F.lds + 2 * 33280);
    const int fr = F.lane & 15, fq = F.lane >> 4, w = F.wave;
    for (int wi = F.bid; wi < 256; wi += F.G) {
        const int chain = wi & 15, slice = wi >> 4, dir = chain >> 3, bl = (chain >> 2) & 1, h = chain & 3, gb = 2 * hb + bl, e0 = slice * 32;
        char* NUM = (char*)(F.ws + (dir ? MS_NB : MS_NF));
        const bool nwriter = (slice == 0) && (w == 0);
        f32x4 acc[4][2];
#pragma unroll
        for (int a = 0; a < 4; ++a)
#pragma unroll
            for (int b = 0; b < 2; ++b) acc[a][b] = (f32x4){0.f, 0.f, 0.f, 0.f};
        float nreg[8];
#pragma unroll
        for (int e = 0; e < 8; ++e) nreg[e] = 0.f;
        __syncthreads();
        { const int ctau = dir == 0 ? 0 : 1; const f32x4* gt = GTC + (size_t)(dir * 4 + h) * MC; if (F.tid < 128) wl[F.tid] = gt[gb * CTXL + ctau * 128 + F.tid][3]; }
        __syncthreads();
#pragma unroll 1
        for (int s = 0; s < 66; ++s) {
            const int ctau = dir == 0 ? s : (s < 2 ? 1 - s : 67 - s);
            const bool isctx = ctau < 2; const int c = isctx ? ctau : ctau - 2;
            const unsigned Ls = isctx ? CTXL : SEQ, j0 = c * 128;
            const char* ktu = (isctx ? KTC2 + (size_t)(gb * 4 + h) * 512 * CTXL * 2 : KT + (size_t)(bl * 4 + h) * 512 * SEQ * 2) + (size_t)c * 131072;
            const char* vtu = (isctx ? VTC2 + (size_t)(gb * 4 + h) * 512 * CTXL * 2 : VT + (size_t)(bl * 4 + h) * 512 * SEQ * 2) + (size_t)c * 131072;
            const int row0 = isctx ? gb * CTXL + j0 : bl * SEQ + j0;
            const f32x4* gt = isctx ? GTC + (size_t)(dir * 4 + h) * MC : GTL + (size_t)(dir * 4 + h) * HROWS;
            const float Gd = GC[((size_t)(dir * 4 + gb) * 4 + h) * 66 + ctau];
            const float* dn = DN + (((size_t)(dir * 4 + gb) * 4 + h) * 66 + ctau) * 512;
            LAS unsigned char* cb_rd = cbf + (s & 1) * 33280; LAS unsigned char* cb_wr = cbf + ((s + 1) & 1) * 33280;
            const LAS float* wl_rd = wl + (s & 1) * 128; LAS float* wl_wr = wl + ((s + 1) & 1) * 128;
            const unsigned l16 = F.lane * 16u;
            bf16x8 vf[2][4], kf[4][4];
#pragma unroll
            for (int et = 0; et < 2; ++et)
#pragma unroll
                for (int ks = 0; ks < 4; ++ks) vf[et][ks] = ldg16(vtu + ((e0 >> 4) + et) * 4096 + ks * 1024, l16);
            unsigned pf = 0u; const int s2 = s + 1;
            if (s2 < 66) {
                const int ct2 = dir == 0 ? s2 : (s2 < 2 ? 1 - s2 : 67 - s2); const bool ic2 = ct2 < 2; const int c2 = ic2 ? ct2 : ct2 - 2;
                const char* kt2 = (ic2 ? KTC2 + (size_t)(gb * 4 + h) * 512 * CTXL * 2 : KT + (size_t)(bl * 4 + h) * 512 * SEQ * 2) + (size_t)c2 * 131072;
                const char* vt2 = (ic2 ? VTC2 + (size_t)(gb * 4 + h) * 512 * CTXL * 2 : VT + (size_t)(bl * 4 + h) * 512 * SEQ * 2) + (size_t)c2 * 131072;
                const char* xc2 = XC + ((size_t)((bl * SEQ + c2 * 128) >> 4) * 64 + h * 16) * 1024; const char* s2p = S + ((size_t)(dir * 8 + bl * 4 + h) * 64 + c2) * 32768;
                const unsigned t = F.tid; const char* ub = kt2; unsigned off = 0u;
                if (t < 64) { off = (slice * 64 + t) * 128u; }
                else if (t < 128) { ub = vt2; off = (e0 >> 4) * 4096u + (t - 64) * 128u; }
                else if (t < 192) { if (!ic2) { const unsigned ln = slice * 64 + (t - 128); ub = xc2; off = (ln >> 7) * 65536u + (ln & 127) * 128u; } }
                else if (t < 208) { if (!ic2) { ub = s2p; off = (slice * 16 + (t - 192)) * 128u; } }
                if (t < 208) pf = *(const volatile unsigned*)(ub + off);
            }
            if (!isctx) {
                const char* xcu = XC + ((size_t)((row0 >> 4) + w) * 64 + h * 16) * 1024; const char* su = S + ((size_t)(dir * 8 + bl * 4 + h) * 64 + c) * 32768 + w * 4096;
                bf16x8 xf[16], sfr[4];
#pragma unroll
                for (int ks = 0; ks < 16; ++ks) xf[ks] = ldg16(xcu + ks * 1024, l16);
#pragma unroll
                for (int ks = 0; ks < 4; ++ks) sfr[ks] = ldg16(su + ks * 1024, l16);
                const float Ei = gt[row0 + 16 * w + fr][2];
                if (nwriter) { float* np = NC + (((size_t)(dir * 2 + bl) * 4 + h) * 64 + c) * 512 + 8 * F.lane;
                    *(f32x4*)np = (f32x4){nreg[0], nreg[1], nreg[2], nreg[3]}; *(f32x4*)(np + 4) = (f32x4){nreg[4], nreg[5], nreg[6], nreg[7]}; }
                f32x4 a2[2] = {(f32x4){0.f, 0.f, 0.f, 0.f}, (f32x4){0.f, 0.f, 0.f, 0.f}};
#pragma unroll
                for (int ks = 0; ks < 16; ++ks)
#pragma unroll
                    for (int et = 0; et < 2; ++et) a2[et] = __builtin_amdgcn_mfma_f32_16x16x32_bf16(*(const LAS bf16x8*)(cb_rd + (16 * et + fr) * 1040 + ks * 64 + fq * 16), xf[ks], a2[et], 0, 0, 0);
                asm volatile("" ::: "memory");
#pragma unroll
                for (int ks = 0; ks < 4; ++ks)
#pragma unroll
                    for (int dt = 0; dt < 4; ++dt) kf[ks][dt] = ldg16(ktu + (4 * w + dt) * 4096 + ks * 1024, l16);
                a2[0] = a2[0] * Ei; a2[1] = a2[1] * Ei;
#pragma unroll
                for (int ks = 0; ks < 4; ++ks)
#pragma unroll
                    for (int et = 0; et < 2; ++et) a2[et] = __builtin_amdgcn_mfma_f32_16x16x32_bf16(vf[et][ks], sfr[ks], a2[et], 0, 0, 0);
                char* nu = NUM + ((size_t)row0 * MI + h * 512 + e0) * 2; const unsigned ln = ((16u * w + fr) * MI + 4u * fq) * 2u;
#pragma unroll
                for (int et = 0; et < 2; ++et) *(u32x2*)(nu + et * 32 + ln) = (u32x2){pk2(a2[et][0], a2[et][1]), pk2(a2[et][2], a2[et][3])};
            } else {
#pragma unroll
                for (int ks = 0; ks < 4; ++ks)
#pragma unroll
                    for (int dt = 0; dt < 4; ++dt) kf[ks][dt] = ldg16(ktu + (4 * w + dt) * 4096 + ks * 1024, l16);
            }
            if (s + 1 < 66 && F.tid < 128) {
                const int ct2 = dir == 0 ? s + 1 : (s + 1 < 2 ? 1 - (s + 1) : 67 - (s + 1)); const bool ic2 = ct2 < 2; const int c2 = ic2 ? ct2 : ct2 - 2;
                const f32x4* gt2 = ic2 ? GTC + (size_t)(dir * 4 + h) * MC : GTL + (size_t)(dir * 4 + h) * HROWS;
                wl_wr[F.tid] = gt2[(ic2 ? gb * CTXL : bl * SEQ) + c2 * 128 + F.tid][3]; }
#pragma unroll
            for (int a = 0; a < 4; ++a)
#pragma unroll
                for (int b = 0; b < 2; ++b) acc[a][b] = acc[a][b] * Gd;
#pragma unroll
            for (int ks = 0; ks < 4; ++ks) {
                bf16x8 bv[2];
#pragma unroll
                for (int et = 0; et < 2; ++et) { float v[8]; unpack8(__builtin_bit_cast(u32x4, vf[et][ks]), v);
#pragma unroll
                    for (int e = 0; e < 8; ++e) v[e] *= wl_rd[ks * 32 + 8 * fq + e];
                    const u32x4 pv = pack8(v); bv[et] = __builtin_bit_cast(bf16x8, pv); }
#pragma unroll
                for (int dt = 0; dt < 4; ++dt)
#pragma unroll
                    for (int et = 0; et < 2; ++et) acc[dt][et] = __builtin_amdgcn_mfma_f32_16x16x32_bf16(kf[ks][dt], bv[et], acc[dt][et], 0, 0, 0);
            }
            if (nwriter) { const f32x4 d0 = *(const f32x4*)(dn + 8 * F.lane), d1 = *(const f32x4*)(dn + 8 * F.lane + 4);
                nreg[0] = Gd * nreg[0] + d0[0]; nreg[1] = Gd * nreg[1] + d0[1]; nreg[2] = Gd * nreg[2] + d0[2]; nreg[3] = Gd * nreg[3] + d0[3];
                nreg[4] = Gd * nreg[4] + d1[0]; nreg[5] = Gd * nreg[5] + d1[1]; nreg[6] = Gd * nreg[6] + d1[2]; nreg[7] = Gd * nreg[7] + d1[3]; }
#pragma unroll
            for (int dt = 0; dt < 4; ++dt)
#pragma unroll
                for (int et = 0; et < 2; ++et) *(LAS u32x2*)(cb_wr + (16 * et + fr) * 1040 + (64 * w + 16 * dt + 4 * fq) * 2) = (u32x2){pk2(acc[dt][et][0], acc[dt][et][1]), pk2(acc[dt][et][2], acc[dt][et][3])};
            asm volatile("" :: "v"(pf));
            __syncthreads();
        }
    }
}

__device__ __forceinline__ void ph_mout(Fr& F) {
    bf16* NF = (bf16*)(F.ws + MS_NF); const bf16* NBk = (const bf16*)(F.ws + MS_NB); const bf16* XC = (const bf16*)(F.ws + MS_XC); const bf16* Z = (const bf16*)(F.ws + MS_Z);
    const float* NC = (const float*)(F.ws + WS_NC); const float* RS = (const float*)(F.ws + WS_RS); const f32x4* GTL = (const f32x4*)(F.ws + WS_GT_L);
    for (int it = F.gw; it < HROWS * 4; it += F.ngw) {
        const int row = it >> 2, h = it & 3, bl = row >> 13, c = (row >> 7) & 63; const size_t o = (size_t)row * MI + h * 512 + 8 * F.lane;
        float nf[8], nb[8], xc[8], z[8];
        const size_t xo = ((size_t)(row >> 4) * 64 + h * 16 + (F.lane >> 2)) * 512 + ((row & 15) + 16 * (F.lane & 3)) * 8;
        unpack8(*(const u32x4*)(NF + o), nf); unpack8(*(const u32x4*)(NBk + o), nb); unpack8(*(const u32x4*)(XC + xo), xc); unpack8(*(const u32x4*)(Z + o), z);
        const float* n0 = NC + (((size_t)(0 * 2 + bl) * 4 + h) * 64 + c) * 512 + 8 * F.lane; const float* n1 = NC + (((size_t)(1 * 2 + bl) * 4 + h) * 64 + c) * 512 + 8 * F.lane;
        const f32x4 n00 = *(const f32x4*)n0, n01 = *(const f32x4*)(n0 + 4), n10 = *(const f32x4*)n1, n11 = *(const f32x4*)(n1 + 4);
        float d0 = xc[0] * n00[0] + xc[1] * n00[1] + xc[2] * n00[2] + xc[3] * n00[3] + xc[4] * n01[0] + xc[5] * n01[1] + xc[6] * n01[2] + xc[7] * n01[3];
        float d1 = xc[0] * n10[0] + xc[1] * n10[1] + xc[2] * n10[2] + xc[3] * n10[3] + xc[4] * n11[0] + xc[5] * n11[1] + xc[6] * n11[2] + xc[7] * n11[3];
        d0 = wave_sum(d0); d1 = wave_sum(d1);
        const float den0 = GTL[(size_t)(0 * 4 + h) * HROWS + row][2] * d0 + RS[(size_t)(0 * 4 + h) * HROWS + row], den1 = GTL[(size_t)(1 * 4 + h) * HROWS + row][2] * d1 + RS[(size_t)(1 * 4 + h) * HROWS + row];
        const float i0 = 1.0f / fmaxf(fabsf(den0), 1.0f), i1 = 1.0f / fmaxf(fabsf(den1), 1.0f);
        float s = 0.f;
#pragma unroll
        for (int e = 0; e < 8; ++e) { nf[e] = nf[e] * i0 + nb[e] * i1; s += nf[e]; }
        const float mu = wave_sum(s) * (1.0f / 512.0f); float q = 0.f;
#pragma unroll
        for (int e = 0; e < 8; ++e) { nf[e] -= mu; q += nf[e] * nf[e]; }
        const float rstd = 1.0f / sqrtf(wave_sum(q) * (1.0f / 512.0f) + ML_NORM_EPS);
        const float* nw = IN(I_MNW) + h * 512 + 8 * F.lane; const float* sk = IN(I_MSKIP) + h * 512 + 8 * F.lane;
#pragma unroll
        for (int e = 0; e < 8; ++e) nf[e] = (nf[e] * rstd * nw[e] + sk[e] * xc[e]) * silu_f(z[e]);
        *(u32x4*)(NF + o) = pack8(nf);
    }
}

__device__ __forceinline__ void ph_final(Fr& F) {
    const float* g = IN(I_FINALG);
    for (int r = F.gw; r < ML; r += F.ngw) {
        f32x4* xr = (f32x4*)(F.out + (size_t)r * 1024) + F.lane; f32x4 v[4]; float s = 0.f;
#pragma unroll
        for (int j = 0; j < 4; ++j) { v[j] = xr[64 * j]; s += (v[j][0] * v[j][0] + v[j][1] * v[j][1]) + (v[j][2] * v[j][2] + v[j][3] * v[j][3]); }
        const float rinv = 1.0f / sqrtf(wave_sum(s) * (1.0f / 1024.0f) + EPS);
#pragma unroll
        for (int j = 0; j < 4; ++j) xr[64 * j] = v[j] * rinv * *(const f32x4*)(g + 4 * F.lane + 256 * j);
    }
}

template <class Epi>
__device__ __forceinline__ void run_gemm(Fr& F, const bf16* A, const bf16* Bt, int M, int N, int K, const Epi& E) {
    pg8::Gemm g{A, Bt, M, N, K}; pg8::StaticOrder S; S.init(M, N, F.G, F.bid);
    pg8::gemm_phase<Epi, pg8::StaticOrder, true, true>(F.lds, g, S, E, F.tid);
}

struct Args { const float* in[38]; float* out; unsigned char* ws; int ph_lo, ph_hi; };
static_assert(sizeof(Args) == 328 && offsetof(Args, out) == 304 && offsetof(Args, ws) == 312 && offsetof(Args, ph_lo) == 320, "Args layout");
constexpr int N_PHASES = 36;


#define XB_TMO      128
#define XB_XCNT(j)  (256  + 64 * (j))
#define XB_XSUB(j)  (1280 + 64 * (j))
#define XB_XGEN(j)  (2304 + 64 * (j))
#define XB_TOP      3328
#define XB_TOPGEN   3392
#define XCD_BAR_WORDS 3456
#define XB_SPIN_CAP (1u << 22)
__device__ __forceinline__ unsigned xb_ld(unsigned* p)              { return __hip_atomic_load(p, __ATOMIC_RELAXED, __HIP_MEMORY_SCOPE_AGENT); }
__device__ __forceinline__ unsigned xb_add(unsigned* p, unsigned v) { return __hip_atomic_fetch_add(p, v, __ATOMIC_RELAXED, __HIP_MEMORY_SCOPE_AGENT); }
__device__ __forceinline__ unsigned xb_xcc_id() { return (unsigned)__builtin_amdgcn_s_getreg((3 << 11) | 20) & 0xFu; }
#define XB_SPIN(cond, bar) do { unsigned _sp = 0; while (cond) { __builtin_amdgcn_s_sleep(1); \
    if ((++_sp & 255u) == 0u) { if (xb_ld(&(bar)[XB_TMO])) break; if (_sp > XB_SPIN_CAP) { atomicAdd(&(bar)[XB_TMO], 1u); break; } } } } while (0)
__device__ __forceinline__ void xcd_barrier_complete(unsigned* bar, unsigned x, unsigned& nloc, unsigned& nx) {
    const unsigned G = gridDim.x * gridDim.y * gridDim.z;
    unsigned sum, cnt, mine, sp = 0u;
    for (;;) {
        sum = 0u; cnt = 0u; mine = 0u;
#pragma unroll
        for (unsigned j = 0; j < 16; ++j) { const unsigned c = xb_ld(&bar[XB_XCNT(j)]); sum += c; cnt += (c > 0u) ? 1u : 0u; mine = (j == x) ? c : mine; }
        if (sum == G) break;
        __builtin_amdgcn_s_sleep(1);
        if ((++sp & 255u) == 0u) { if (xb_ld(&bar[XB_TMO])) break; if (sp > XB_SPIN_CAP) { atomicAdd(&bar[XB_TMO], 1u); break; } }
    }
    nloc = mine > 0u ? mine : 1u; nx = cnt > 0u ? cnt : 1u;
}
__device__ __forceinline__ void xcd_barrier(unsigned* bar, volatile LAS unsigned* st) {
    asm volatile("s_waitcnt vmcnt(0)" ::: "memory");
    __syncthreads();
    if (threadIdx.x == 0) {
        const unsigned x = xb_xcc_id();
        __builtin_amdgcn_s_waitcnt(0);
        unsigned nloc = st[0], nx = st[1];
        if (nloc == 0u) { xcd_barrier_complete(bar, x, nloc, nx); st[0] = nloc; st[1] = nx; }
        const unsigned old = xb_add(&bar[XB_XSUB(x)], 1u);
        const unsigned gen = old / nloc;
        if (old + 1u == (gen + 1u) * nloc) {
            __builtin_amdgcn_fence(__ATOMIC_RELEASE, "agent");
            asm volatile("s_waitcnt vmcnt(0)" ::: "memory");
            const unsigned og = xb_add(&bar[XB_TOP], 1u);
            const unsigned tg = og / nx;
            if (og + 1u == (tg + 1u) * nx) xb_add(&bar[XB_TOPGEN], 1u);
            else XB_SPIN(xb_ld(&bar[XB_TOPGEN]) == tg, bar);
            __builtin_amdgcn_fence(__ATOMIC_ACQUIRE, "agent");
            xb_add(&bar[XB_XGEN(x)], 1u);
            asm volatile("s_waitcnt vmcnt(0)" ::: "memory");
        } else {
            XB_SPIN(xb_ld(&bar[XB_XGEN(x)]) == gen, bar);
            __builtin_amdgcn_fence(__ATOMIC_ACQUIRE, "agent");
            asm volatile("s_waitcnt vmcnt(0)" ::: "memory");
        }
    }
    __syncthreads();
}
#ifndef PROBE_MASK
#define PROBE_MASK 0ull
#endif
constexpr int BAR_LDS_OFF = LDS_BYTES - 64;
constexpr size_t WS_BAR = 0;
constexpr size_t WS_TS = 64 * 1024;

template <int ph>
__device__ __forceinline__ void run_phase(Fr& F) {
    unsigned char* ws = F.ws;
    float* mod = (float*)(ws + WS_MOD); float* ctxx = (float*)(ws + WS_CTXX);
    if constexpr (ph == 0) ph_prologue(F);
    else if constexpr (ph == 1) {
            kt_items(F, (const float*)(ws + WS_H3), SEQ, (float*)(ws + HY_KT));
            kt_items(F, (const float*)(ws + WS_H3) + (size_t)SEQ * 64, CTXL, (float*)(ws + WS_KTC));
            ph_modnorm(F, IN(I_X), ML, 0, IN(I_CTX), MC, IN(I_NORMG), mod, 0, (bf16*)(ws + HY_H));
        }
    else if constexpr (ph == 2) { pg8::EpiBf16 E{(bf16*)(ws + HY_P), 3072, IN(I_HBIN), 0, 0}; run_gemm(F, (const bf16*)(ws + HY_H), (const bf16*)(ws + WS_WHIN), MALL, 3072, 1024, E); }
    else if constexpr (ph == 3) { zt_items(F, (const bf16*)(ws + HY_P), 0, NB, SEQ, (bf16*)(ws + HY_ZT)); zt_items(F, (const bf16*)(ws + HY_P), ML, NB, CTXL, (bf16*)(ws + HY_ZTC)); }
    else if constexpr (ph == 4) ph_fftconv(F);
    else if constexpr (ph == 5) { u2_items(F, (const bf16*)(ws + HY_P), 0, NB, SEQ, (const bf16*)(ws + HY_ZT), (bf16*)(ws + HY_H)); u2_items(F, (const bf16*)(ws + HY_P), ML, NB, CTXL, (const bf16*)(ws + HY_ZTC), (bf16*)(ws + HY_H)); }
    else if constexpr (ph == 6) { pg8::EpiRes E{IN(I_X), F.out, IN(I_CTX), ctxx, ML, mod + 2048, 0, IN(I_HBOUT)}; run_gemm(F, (const bf16*)(ws + HY_H), (const bf16*)(ws + WS_WHOUT), MALL, 1024, 1024, E); }
    else if constexpr (ph == 7) ph_modnorm(F, F.out, ML, 0, ctxx, MC, IN(I_NORMG) + 1024, mod, 3072, (bf16*)(ws + FF_H));
    else if constexpr (ph == 8) { pg8::EpiBf16 E{(bf16*)(ws + FF_A), FF, nullptr, FF, (FF_G - FF_A) / 2}; run_gemm(F, (const bf16*)(ws + FF_H), (const bf16*)(ws + WS_WUP0), MALL, 2 * FF, 1024, E); }
    else if constexpr (ph == 9) ph_dwconv(F, 0, ML, MC);
    else if constexpr (ph == 10) { pg8::EpiRes E{F.out, F.out, ctxx, ctxx, ML, mod + 5120, 0, nullptr}; run_gemm(F, (const bf16*)(ws + FF_A), (const bf16*)(ws + WS_WDN0), MALL, 1024, FF, E); }
    else if constexpr (ph < 31) {
            constexpr int hb = (ph - 11) / 10, k = (ph - 11) % 10; const float* mod1 = mod + 5 * 6144;
            float* xh = F.out + (size_t)hb * HROWS * 1024;
            if constexpr (k == 0) { ph_modnorm(F, xh, HROWS, 2 * hb, ctxx, 0, IN(I_NORMG) + 2048, mod1, 0, (bf16*)(ws + MS_H));
                          if (hb == 0) ph_modnorm(F, xh, 0, 0, ctxx, MC, IN(I_NORMG) + 2048, mod1, 0, (bf16*)(ws + MS_HC)); }
            else if constexpr (k == 1) { { pg8::EpiBf16 E{(bf16*)(ws + MS_XM), MI, nullptr, 0, 0}; run_gemm(F, (const bf16*)(ws + MS_H), (const bf16*)(ws + WS_WMIN), HROWS, MI, 1024, E); }
                               if (hb == 0) { pg8::EpiBf16 E{(bf16*)(ws + MS_XMC), MI, nullptr, 0, 0}; run_gemm(F, (const bf16*)(ws + MS_HC), (const bf16*)(ws + WS_WMIN), MC, MI, 1024, E); } }
            else if constexpr (k == 2) { prep_items(F, (const bf16*)(ws + MS_XM), 2, SEQ, (bf16*)(ws + MS_XC), (bf16*)(ws + MS_KN), (bf16*)(ws + MS_KT), (bf16*)(ws + MS_VT));
                               if (hb == 0) prep_items(F, (const bf16*)(ws + MS_XMC), NB, CTXL, (bf16*)(ws + MS_XCC), (bf16*)(ws + MS_XCC + 16 * MiB), (bf16*)(ws + MS_KTC), (bf16*)(ws + MS_VTC)); }
            else if constexpr (k == 3) { gate_items(F, (const bf16*)(ws + MS_XC), (const bf16*)(ws + MS_XM), HROWS, (float*)(ws + WS_GATES_L));
                               if (hb == 0) gate_items(F, (const bf16*)(ws + MS_XCC), (const bf16*)(ws + MS_XMC), MC, (float*)(ws + WS_GATES_C)); }
            else if constexpr (k == 4) { cum_items(F, (const float*)(ws + WS_GATES_L), 2, SEQ, 2 * hb, 2, (f32x4*)(ws + WS_GT_L), (float*)(ws + WS_GC));
                               if (hb == 0) cum_items(F, (const float*)(ws + WS_GATES_C), NB, CTXL, 0, 0, (f32x4*)(ws + WS_GT_C), (float*)(ws + WS_GC)); }
            else if constexpr (k == 5) ph_sphase(F, hb, hb == 0);
            else if constexpr (k == 6) ph_scan(F, hb);
            else if constexpr (k == 7) { pg8::EpiBf16 E{(bf16*)(ws + MS_Z), MI, nullptr, 0, 0}; run_gemm(F, (const bf16*)(ws + MS_H), (const bf16*)(ws + WS_WMIN) + (size_t)MI * 1024, HROWS, MI, 1024, E); }
            else if constexpr (k == 8) ph_mout(F);
            else { pg8::EpiRes E{xh, xh, ctxx, ctxx, HROWS, mod1 + 2048, 2 * hb, nullptr}; run_gemm(F, (const bf16*)(ws + MS_NF), (const bf16*)(ws + WS_WMDN), HROWS, 1024, MI, E); }
        }
    else if constexpr (ph == 31) ph_modnorm(F, F.out, ML, 0, ctxx, 0, IN(I_NORMG) + 3072, mod + 5 * 6144, 3072, (bf16*)(ws + FF_H));
    else if constexpr (ph == 32) { pg8::EpiBf16 E{(bf16*)(ws + FF_A), FF, nullptr, FF, (FF_G - FF_A) / 2}; run_gemm(F, (const bf16*)(ws + FF_H), (const bf16*)(ws + WS_WUP1), ML, 2 * FF, 1024, E); }
    else if constexpr (ph == 33) ph_dwconv(F, 1, ML, 0);
    else if constexpr (ph == 34) { pg8::EpiRes E{F.out, F.out, ctxx, ctxx, ML, mod + 5 * 6144 + 5120, 0, nullptr}; run_gemm(F, (const bf16*)(ws + FF_A), (const bf16*)(ws + WS_WDN1), ML, 1024, FF, E); }
    else ph_final(F);
}

template <int ph>
__device__ __forceinline__ void phase_step(int ph_lo, int ph_hi, unsigned char* lds_raw) {
    if (ph_lo <= ph && ph < ph_hi) {
        const __attribute__((address_space(4))) unsigned char* kp = (const __attribute__((address_space(4))) unsigned char*)__builtin_amdgcn_kernarg_segment_ptr();
        asm volatile("" : "+s"(kp));
        Fr F;
        { int t_ = threadIdx.x, g_ = gridDim.x, b_ = blockIdx.x; asm volatile("" : "+v"(t_), "+s"(g_), "+s"(b_)); F.tid = t_; F.G = g_; F.bid = b_; }
        F.lds = (LAS unsigned char*)lds_raw; F.lane = F.tid & 63; F.wave = __builtin_amdgcn_readfirstlane(F.tid >> 6);
        F.gw = F.bid * NWAVES + F.wave; F.ngw = F.G * NWAVES;
        F.in = (const __attribute__((address_space(4))) cfptr_t*)kp;
        typedef float* fptr_t; typedef unsigned char* ucptr_t;
        F.out = *(const __attribute__((address_space(4))) fptr_t*)(kp + 304); F.ws = *(const __attribute__((address_space(4))) ucptr_t*)(kp + 312);
        if (PROBE_MASK != 0ull && F.bid == 0 && F.tid == 0) ((unsigned long long*)(F.ws + WS_TS))[ph] = __builtin_amdgcn_s_memrealtime();
        run_phase<ph>(F);
        if (ph + 1 < ph_hi) {
            if (ph == 0) {
                if (F.bid == 0) for (int i = F.tid; i < XCD_BAR_WORDS; i += NTHR) __hip_atomic_store((unsigned*)(F.ws + WS_BAR) + i, 0u, __ATOMIC_RELAXED, __HIP_MEMORY_SCOPE_AGENT);
                __syncthreads(); cg::this_grid().sync();
                if (F.tid == 0) (void)xb_add((unsigned*)(F.ws + WS_BAR) + XB_XCNT(xb_xcc_id()), 1u);
            }
            else xcd_barrier((unsigned*)(F.ws + WS_BAR), (volatile LAS unsigned*)(F.lds + BAR_LDS_OFF));
        }
        if (PROBE_MASK != 0ull && ph == N_PHASES - 1 && F.bid == 0) {
            if (F.tid == 0) { unsigned long long* ts = (unsigned long long*)(F.ws + WS_TS); const unsigned long long tend = __builtin_amdgcn_s_memrealtime(); unsigned long long tot = 0ull;
                for (int k = 0; k < N_PHASES; ++k) if ((PROBE_MASK >> k) & 1ull) tot += (k + 1 < N_PHASES ? ts[k + 1] : tend) - ts[k];
                while (__builtin_amdgcn_s_memrealtime() - tend < tot) __builtin_amdgcn_s_sleep(8); }
            __syncthreads();
        }
    }
}
template <int... I>
__device__ __forceinline__ void all_phases(int ph_lo, int ph_hi, unsigned char* lds_raw, std::integer_sequence<int, I...>) { (phase_step<I>(ph_lo, ph_hi, lds_raw), ...); }

__global__ void __launch_bounds__(NTHR, 2) fwd_kernel(Args args) {
    extern __shared__ __attribute__((aligned(16))) unsigned char lds_raw[];
    int ph_lo, ph_hi;
    { const __attribute__((address_space(4))) unsigned char* kp0 = (const __attribute__((address_space(4))) unsigned char*)__builtin_amdgcn_kernarg_segment_ptr();
      ph_lo = *(const __attribute__((address_space(4))) int*)(kp0 + 320); ph_hi = *(const __attribute__((address_space(4))) int*)(kp0 + 324); }
    if (threadIdx.x < 16) ((LAS unsigned*)((LAS unsigned char*)lds_raw + BAR_LDS_OFF))[threadIdx.x] = 0u;
    __syncthreads();
    all_phases(ph_lo, ph_hi, lds_raw, std::make_integer_sequence<int, N_PHASES>{});
}

extern "C" void kernel_launch(void* const* d_in, const int* in_sizes, int n_in, void* d_out, int out_size, void* d_ws, size_t ws_size, hipStream_t stream) {
    static int grid = 0;
    if (grid == 0) {
        int dev = 0, cus = 0, per_cu = 0;
        hipGetDevice(&dev);
        hipDeviceGetAttribute(&cus, hipDeviceAttributeMultiprocessorCount, dev);
        hipFuncSetAttribute((const void*)fwd_kernel, hipFuncAttributeMaxDynamicSharedMemorySize, LDS_BYTES);
        hipOccupancyMaxActiveBlocksPerMultiprocessor(&per_cu, (const void*)fwd_kernel, NTHR, LDS_BYTES);
        if (per_cu < 1) { fprintf(stderr, "kernel_launch: occupancy query says %d blocks per CU\n", per_cu); per_cu = 1; }
        grid = cus < 256 ? cus : 256;
        if (n_in != 38 || ws_size < WS_END) fprintf(stderr, "kernel_launch: unexpected n_in %d / ws_size %zu (need %zu)\n", n_in, ws_size, (size_t)WS_END);
        (void)hipGetLastError();
    }
    (void)hipMemsetAsync(d_ws, 0, 128 * 1024, stream);
    Args a{};
    for (int i = 0; i < 38; ++i) a.in[i] = (const float*)d_in[i];
    a.out = (float*)d_out; a.ws = (unsigned char*)d_ws; a.ph_lo = 0; a.ph_hi = N_PHASES;
    void* kargs[] = {&a};
    hipError_t e = hipLaunchCooperativeKernel((const void*)fwd_kernel, dim3(grid), dim3(NTHR), kargs, LDS_BYTES, stream);
    if (e != hipSuccess) fprintf(stderr, "cooperative launch failed: %s (grid %d)\n", hipGetErrorString(e), grid);
}
```

```cpp
#include <hip/hip_runtime.h>
#include <hip/hip_cooperative_groups.h>
#include <cstdio>
#include <cstdint>
#include <cstddef>
#include <utility>
namespace cg = cooperative_groups;

#define LAS __attribute__((address_space(3)))
typedef unsigned short bf16;
typedef short bf16x8 __attribute__((ext_vector_type(8)));
typedef float f32x4 __attribute__((ext_vector_type(4)));
typedef float f32x2 __attribute__((ext_vector_type(2)));
typedef unsigned u32x4 __attribute__((ext_vector_type(4)));
typedef unsigned u32x2 __attribute__((ext_vector_type(2)));

namespace pg8 {
#define PG8_LAS __attribute__((address_space(3)))
typedef unsigned short bf16_t;
constexpr int BM = 256, BK = 64, HALF = 128, HTB = HALF * BK * 2, STAGE_BYTES = 8 * HTB, NXCD = 8, WGM = 8;
__host__ __device__ __forceinline__ int lds_byte(int r, int c) { const int st = (r >> 4) * 2 + (c >> 5), rr = r & 15, cc = c & 31, ob = rr * 64 + cc * 2; return st * 1024 + (ob ^ (((ob >> 9) & 1) << 5)); }
__host__ __device__ __forceinline__ void stage_rc(int b, int& R, int& C) { const int st = b / 1024, sb = b % 1024, swz = sb ^ (((sb >> 9) & 1) << 5); R = (st >> 1) * 16 + swz / 64; C = (st & 1) * 32 + (swz % 64) / 2; }
__host__ __device__ __forceinline__ int perm32(int rho) { const int n = rho >> 4, i = rho & 15; return 8 * (i >> 2) + 4 * n + (i & 3); }
struct Unit { int pm, pn; };
struct Gemm { const bf16_t* A; const bf16_t* Bt; int M, N, K; };
struct StaticOrder {
    int nM, nN, nwg, G, c;
    __host__ __device__ void init(int M, int N, int G_, int c_) { nM = M / BM; nN = N / BM; nwg = nM * nN; G = G_; c = c_; }
    __host__ __device__ bool next(int i, Unit& u) const {
        const long L = (long)i * G + c; if (L >= nwg) return false;
        int wgid = (int)L; { const int q = nwg / NXCD, r = nwg % NXCD, xcd = wgid % NXCD, off = wgid / NXCD; wgid = (xcd < r ? xcd * (q + 1) : r * (q + 1) + (xcd - r) * q) + off; }
        const int nig = WGM * nN, gid = wgid / nig, fm = gid * WGM, gsz = (nM - fm) < WGM ? (nM - fm) : WGM;
        u.pm = fm + ((wgid % nig) % gsz); u.pn = (wgid % nig) / gsz; return true;
    }
    __device__ __forceinline__ void a_ready(const Unit&) const {}
    __device__ __forceinline__ void done(const Unit&) const {}
};
__device__ __forceinline__ unsigned cvt_pk_bf16(float lo, float hi) { unsigned r; asm volatile("v_cvt_pk_bf16_f32 %0, %1, %2" : "=v"(r) : "v"(lo), "v"(hi)); return r; }

struct EpiBf16 {
    static constexpr bool PERM = true, AFTER_DRAIN = false;
    bf16_t* O; int ldc; const float* bias; int split_cols; size_t split_stride;
    __device__ __forceinline__ void operator()(const f32x4 (&acc)[2][2][4][2], const Unit& u, int wr, int wc, int fr, int fq) const {
        const int row0 = u.pm * BM + wr * 64 + fr; int colt = u.pn * BM; bf16_t* base = O;
        if (split_cols) { const int t = colt / split_cols; base += (size_t)t * split_stride; colt -= t * split_cols; }
        const int col0 = colt + wc * 32 + 8 * fq, bcol0 = u.pn * BM + wc * 32 + 8 * fq;
        f32x4 bv[2][2];
#pragma unroll
        for (int bj = 0; bj < 2; ++bj)
#pragma unroll
            for (int n = 0; n < 2; ++n) bv[bj][n] = bias ? *(const f32x4*)(bias + bcol0 + bj * HALF + 4 * n) : (f32x4){0.f, 0.f, 0.f, 0.f};
#pragma unroll
        for (int ai = 0; ai < 2; ++ai)
#pragma unroll
            for (int m = 0; m < 4; ++m) { bf16_t* rowp = base + (size_t)(row0 + ai * HALF + m * 16) * ldc + col0;
#pragma unroll
                for (int bj = 0; bj < 2; ++bj) { f32x4 v0 = acc[ai][bj][m][0] + bv[bj][0], v1 = acc[ai][bj][m][1] + bv[bj][1];
                    u32x4 w; w.x = cvt_pk_bf16(v0[0], v0[1]); w.y = cvt_pk_bf16(v0[2], v0[3]); w.z = cvt_pk_bf16(v1[0], v1[1]); w.w = cvt_pk_bf16(v1[2], v1[3]);
                    *(u32x4*)(rowp + bj * HALF) = w; } }
    }
};
struct EpiBf16T {
    static constexpr bool PERM = true, AFTER_DRAIN = false;
    bf16_t* O; int ntc;
    __device__ __forceinline__ void operator()(const f32x4 (&acc)[2][2][4][2], const Unit& u, int wr, int wc, int fr, int fq) const {
        bf16_t* base = O + (size_t)(fr + 16 * fq) * 8;
#pragma unroll
        for (int ai = 0; ai < 2; ++ai)
#pragma unroll
            for (int m = 0; m < 4; ++m)
#pragma unroll
                for (int bj = 0; bj < 2; ++bj) { const f32x4 v0 = acc[ai][bj][m][0], v1 = acc[ai][bj][m][1];
                    u32x4 w; w.x = cvt_pk_bf16(v0[0], v0[1]); w.y = cvt_pk_bf16(v0[2], v0[3]); w.z = cvt_pk_bf16(v1[0], v1[1]); w.w = cvt_pk_bf16(v1[2], v1[3]);
                    *(u32x4*)(base + ((size_t)(u.pm * 16 + ai * 8 + wr * 4 + m) * ntc + u.pn * 8 + bj * 4 + wc) * 512) = w; }
    }
};
struct EpiRes {
    static constexpr bool PERM = false, AFTER_DRAIN = false;
    const float* res_lat; float* out_lat; const float* res_ctx; float* out_ctx; int rows_lat; const float* gate; int b0; const float* bias;
    __device__ __forceinline__ void operator()(const f32x4 (&acc)[2][2][4][2], const Unit& u, int wr, int wc, int fr, int fq) const {
        const int trow = u.pm * BM; const float* res; float* out; int modrow;
        if (trow < rows_lat) { res = res_lat + (size_t)trow * 1024; out = out_lat + (size_t)trow * 1024; modrow = b0 + trow / 8192; }
        else { const int rc = trow - rows_lat; res = res_ctx + (size_t)rc * 1024; out = out_ctx + (size_t)rc * 1024; modrow = 4; }
        const int col0 = u.pn * BM + wc * 32 + 4 * fq; const float* gp = gate + (size_t)modrow * 6144 + col0;
#pragma unroll
        for (int bj = 0; bj < 2; ++bj)
#pragma unroll
            for (int n = 0; n < 2; ++n) {
                const f32x4 bv = bias ? *(const f32x4*)(bias + col0 + bj * HALF + n * 16) : (f32x4){0.f, 0.f, 0.f, 0.f}; const f32x4 gv = *(const f32x4*)(gp + bj * HALF + n * 16);
#pragma unroll
                for (int ai = 0; ai < 2; ++ai) {
#pragma unroll
                    for (int m = 0; m < 4; ++m) { const size_t off = (size_t)(wr * 64 + fr + ai * HALF + m * 16) * 1024 + col0 + bj * HALF + n * 16;
                        const f32x4 rs = *(const f32x4*)(res + off); *(f32x4*)(out + off) = rs + gv * (acc[ai][bj][m][n] + bv); }
                    asm volatile("" ::: "memory"); }
            }
    }
};

template <class Epi, class Sched, bool ALIGN_EPI = false, bool SP2 = false>
__device__ __forceinline__ void gemm_phase(PG8_LAS unsigned char* lds, const Gemm g, const Sched& S, const Epi& E, const int tid) {
    const int wid = __builtin_amdgcn_readfirstlane(tid >> 6), lane = tid & 63, wr = wid >> 2, wc = wid & 3, fr = lane & 15, fq = lane >> 4;
    const int K = g.K, nt = K / BK;
    unsigned voffA[2], voffB[2];
#pragma unroll
    for (int i = 0; i < 2; ++i) { int R, C; stage_rc(tid * 16 + i * 8192, R, C); const int Rb = Epi::PERM ? ((R & ~31) + perm32(R & 31)) : R;
        voffA[i] = (unsigned)(R * K + C) * 2u; voffB[i] = (unsigned)(Rb * K + C) * 2u; }
    const size_t kstep = (size_t)(BK * 2);
    const size_t hstep = (size_t)HALF * K * 2;
    const size_t tstep = 2 * hstep;
    const unsigned ldsw = (unsigned)wid * 1024u;
    const int aoff = lds_byte(wr * 64 + fr, fq * 8), boff = lds_byte(wc * 32 + fr, fq * 8);
#define PG8_SA(b, h) (((b) * 2 + (h)) * HTB)
#define PG8_SB(b, h) ((4 + (b) * 2 + (h)) * HTB)
#define PG8_STAGE(bufoff, gbase, voff) do { _Pragma("unroll") for (int _i = 0; _i < 2; ++_i) \
        __builtin_amdgcn_global_load_lds((const unsigned*)((const char*)(gbase) + (voff)[_i]), (PG8_LAS unsigned*)(lds + (bufoff) + ldsw + _i * 8192), 16, 0, 0); } while (0)
#define PG8_LDA(dst, b, h) do { _Pragma("unroll") for (int m = 0; m < 4; ++m) _Pragma("unroll") for (int k = 0; k < 2; ++k) dst[m][k] = *(const PG8_LAS bf16x8*)(lds + PG8_SA(b, h) + aoff + m * 2048 + k * 1024); } while (0)
#define PG8_LDB(dst, b, h) do { _Pragma("unroll") for (int n = 0; n < 2; ++n) _Pragma("unroll") for (int k = 0; k < 2; ++k) dst[n][k] = *(const PG8_LAS bf16x8*)(lds + PG8_SB(b, h) + boff + n * 2048 + k * 1024); } while (0)
#define PG8_MMA(ai, bj, At, Bt) do { __builtin_amdgcn_s_setprio(1); _Pragma("unroll") for (int m = 0; m < 4; ++m) _Pragma("unroll") for (int n = 0; n < 2; ++n) _Pragma("unroll") for (int k = 0; k < 2; ++k) \
        acc[ai][bj][m][n] = __builtin_amdgcn_mfma_f32_16x16x32_bf16(Bt[n][k], At[m][k], acc[ai][bj][m][n], 0, 0, 0); __builtin_amdgcn_s_setprio(0); } while (0)
#define PG8_WAIT_V(n) asm volatile("s_waitcnt vmcnt(" #n ")" ::: "memory")
#define PG8_WAIT_L(n) asm volatile("s_waitcnt lgkmcnt(" #n ")" ::: "memory")
#define PG8_BAR __builtin_amdgcn_s_barrier()
#define PG8_SCHED __builtin_amdgcn_sched_barrier(0)
    Unit cur, nxt; int ui = 0;
    if (!S.next(0, cur)) return;
    f32x4 acc[2][2][4][2];
#pragma unroll
    for (int a = 0; a < 2; ++a)
#pragma unroll
        for (int b = 0; b < 2; ++b)
#pragma unroll
            for (int m = 0; m < 4; ++m)
#pragma unroll
                for (int n = 0; n < 2; ++n) acc[a][b][m][n] = (f32x4){0.f, 0.f, 0.f, 0.f};
    bf16x8 At[4][2], B0[2][2], B1[2][2];
    const char* cA = (const char*)g.A + (size_t)cur.pm * tstep; const char* cB = (const char*)g.Bt + (size_t)cur.pn * tstep;
    S.a_ready(cur);
    if constexpr (SP2) {
        PG8_STAGE(PG8_SB(0, 0), cB, voffB); PG8_STAGE(PG8_SB(0, 1), cB + hstep, voffB); PG8_STAGE(PG8_SA(0, 0), cA, voffA); PG8_STAGE(PG8_SA(0, 1), cA + hstep, voffA);
        if (wr == 1) PG8_BAR;
        PG8_WAIT_V(2); PG8_BAR;
        PG8_STAGE(PG8_SB(1, 0), cB + kstep, voffB); PG8_STAGE(PG8_SA(1, 0), cA + kstep, voffA); PG8_STAGE(PG8_SB(1, 1), cB + hstep + kstep, voffB);
        PG8_WAIT_V(6); PG8_BAR;
    } else {
        PG8_STAGE(PG8_SB(0, 0), cB, voffB); PG8_STAGE(PG8_SA(0, 0), cA, voffA); PG8_STAGE(PG8_SB(0, 1), cB + hstep, voffB); PG8_STAGE(PG8_SA(0, 1), cA + hstep, voffA);
        if (wr == 1) PG8_BAR;
        PG8_WAIT_V(4); PG8_BAR;
        PG8_STAGE(PG8_SB(1, 0), cB + kstep, voffB); PG8_STAGE(PG8_SA(1, 0), cA + kstep, voffA); PG8_STAGE(PG8_SB(1, 1), cB + hstep + kstep, voffB);
        PG8_WAIT_V(6); PG8_BAR;
    }
    for (;;) {
        const bool has_next = S.next(ui + 1, nxt);
        const char* nA = has_next ? (const char*)g.A + (size_t)nxt.pm * tstep : cA; const char* nB = has_next ? (const char*)g.Bt + (size_t)nxt.pn * tstep : cB;
        for (int t = 0; t < nt; t += 2) {
            const bool last = (t == nt - 2);
            const char* a1 = cA + (size_t)(t + 1) * kstep;
            const char* a2 = last ? nA : cA + (size_t)(t + 2) * kstep; const char* b2 = last ? nB : cB + (size_t)(t + 2) * kstep;
            const char* a3 = a2 + kstep; const char* b3 = b2 + kstep;
            if (last && has_next) S.a_ready(nxt);
            if constexpr (SP2) {
            PG8_LDB(B0, 0, 0); PG8_LDB(B1, 0, 1); PG8_SCHED; PG8_LDA(At, 0, 0); PG8_STAGE(PG8_SA(1, 1), a1 + hstep, voffA);
            PG8_WAIT_V(8); PG8_WAIT_L(0); PG8_BAR; PG8_MMA(0, 0, At, B0); PG8_MMA(0, 1, At, B1); PG8_BAR; PG8_SCHED;
            PG8_LDA(At, 0, 1); PG8_STAGE(PG8_SB(0, 0), b2, voffB); PG8_STAGE(PG8_SB(0, 1), b2 + hstep, voffB); PG8_STAGE(PG8_SA(0, 0), a2, voffA);
            PG8_WAIT_V(8); PG8_WAIT_L(0); PG8_BAR; PG8_MMA(1, 0, At, B0); PG8_MMA(1, 1, At, B1); PG8_BAR; PG8_SCHED;
            PG8_LDB(B0, 1, 0); PG8_LDB(B1, 1, 1); PG8_SCHED; PG8_LDA(At, 1, 0); PG8_STAGE(PG8_SA(0, 1), a2 + hstep, voffA);
            PG8_WAIT_V(8); PG8_WAIT_L(0); PG8_BAR; PG8_MMA(0, 0, At, B0); PG8_MMA(0, 1, At, B1); PG8_BAR; PG8_SCHED;
            PG8_LDA(At, 1, 1); PG8_STAGE(PG8_SB(1, 0), b3, voffB); PG8_STAGE(PG8_SB(1, 1), b3 + hstep, voffB); PG8_STAGE(PG8_SA(1, 0), a3, voffA);
            PG8_WAIT_V(8); PG8_WAIT_L(0); PG8_BAR; PG8_MMA(1, 0, At, B0); PG8_MMA(1, 1, At, B1); PG8_BAR; PG8_SCHED;
            } else {
            PG8_LDB(B0, 0, 0); PG8_SCHED; PG8_LDA(At, 0, 0); PG8_STAGE(PG8_SA(1, 1), a1 + hstep, voffA);
            PG8_WAIT_L(8); PG8_BAR; PG8_WAIT_L(0); PG8_MMA(0, 0, At, B0); PG8_BAR; PG8_SCHED;
            PG8_LDB(B1, 0, 1); PG8_STAGE(PG8_SB(0, 0), b2, voffB);
            PG8_BAR; PG8_WAIT_L(0); PG8_MMA(0, 1, At, B1); PG8_BAR;
            PG8_LDA(At, 0, 1); PG8_STAGE(PG8_SA(0, 0), a2, voffA);
            PG8_BAR; PG8_WAIT_L(0); PG8_MMA(1, 0, At, B0); PG8_BAR; PG8_SCHED;
            PG8_STAGE(PG8_SB(0, 1), b2 + hstep, voffB);
            PG8_WAIT_V(6); PG8_BAR; PG8_MMA(1, 1, At, B1); PG8_BAR;
            PG8_LDB(B0, 1, 0); PG8_SCHED; PG8_LDA(At, 1, 0); PG8_STAGE(PG8_SA(0, 1), a2 + hstep, voffA);
            PG8_WAIT_L(8); PG8_BAR; PG8_WAIT_L(0); PG8_MMA(0, 0, At, B0); PG8_BAR; PG8_SCHED;
            PG8_LDB(B1, 1, 1); PG8_STAGE(PG8_SB(1, 0), b3, voffB);
            PG8_BAR; PG8_WAIT_L(0); PG8_MMA(0, 1, At, B1); PG8_BAR;
            PG8_LDA(At, 1, 1); PG8_STAGE(PG8_SA(1, 0), a3, voffA);
            PG8_BAR; PG8_WAIT_L(0); PG8_MMA(1, 0, At, B0); PG8_BAR; PG8_SCHED;
            PG8_STAGE(PG8_SB(1, 1), b3 + hstep, voffB);
            PG8_WAIT_V(6); PG8_BAR; PG8_MMA(1, 1, At, B1); PG8_BAR;
            }
        }
        if constexpr (ALIGN_EPI) { if (wr == 0) PG8_BAR; }
        if constexpr (!Epi::AFTER_DRAIN) { E(acc, cur, wr, wc, fr, fq); S.done(cur); }
        if (!has_next) break;
#pragma unroll
        for (int a = 0; a < 2; ++a)
#pragma unroll
            for (int b = 0; b < 2; ++b)
#pragma unroll
                for (int m = 0; m < 4; ++m)
#pragma unroll
                    for (int n = 0; n < 2; ++n) acc[a][b][m][n] = (f32x4){0.f, 0.f, 0.f, 0.f};
        cur = nxt; cA = nA; cB = nB; ++ui;
        if constexpr (ALIGN_EPI) { if (wr == 1) PG8_BAR; }
    }
    PG8_WAIT_V(0);
    if constexpr (!ALIGN_EPI) { if (wr == 0) PG8_BAR; }
    PG8_BAR;
#undef PG8_SA
#undef PG8_SB
#undef PG8_STAGE
#undef PG8_LDA
#undef PG8_LDB
#undef PG8_MMA
#undef PG8_WAIT_V
#undef PG8_WAIT_L
#undef PG8_BAR
#undef PG8_SCHED
}
}

constexpr int D = 1024, NB = 4, SEQ = 8192, CTXL = 256, ML = NB * SEQ, MC = NB * CTXL, MALL = ML + MC;
constexpr int FF = 2816, MI = 2048, NH = 4, DH = 512, HROWS = 2 * SEQ;
constexpr float EPS = 1e-6f, ML_NORM_EPS = 1e-5f;
constexpr float HY_MAX_DECAY = -15.350567286626973f, HY_MIN_DECAY = -3.0701134573253945f;
constexpr int NWAVES = 8, NTHR = 512;
constexpr int LDS_BYTES = 147456;

constexpr size_t MiB = 1u << 20;
constexpr size_t WS_MOD = 1 * MiB;
constexpr size_t WS_CTXX = 2 * MiB;
constexpr size_t WS_H3 = 6 * MiB;
constexpr size_t WS_KTC = 9 * MiB;
constexpr size_t WS_GWT = 11 * MiB;
constexpr size_t WS_WKQ = 11 * MiB + 256 * 1024;
constexpr size_t WS_NC = 12 * MiB;
constexpr size_t WS_WHIN = 16 * MiB, WS_WHOUT = 22 * MiB, WS_WMIN = 24 * MiB, WS_WMDN = 32 * MiB, WS_WUP0 = 36 * MiB, WS_WUP1 = 47 * MiB, WS_WDN0 = 58 * MiB, WS_WDN1 = 58 * MiB + 5767168;
constexpr size_t WS_GATES_L = 69 * MiB;
constexpr size_t WS_GATES_C = 70 * MiB;
constexpr size_t WS_GT_L = 71 * MiB;
constexpr size_t WS_GT_C = 73 * MiB;
constexpr size_t WS_GC = 73 * MiB + 512 * 1024;
constexpr size_t WS_DN = 74 * MiB;
constexpr size_t WS_RS = 79 * MiB;
constexpr size_t WS_INV = 79 * MiB + 512 * 1024;
constexpr size_t BIG = 80 * MiB;
constexpr size_t HY_H = BIG, HY_P = BIG + 66 * MiB, HY_KT = BIG + 264 * MiB, HY_ZT = BIG + 328 * MiB, HY_ZTC = BIG + 392 * MiB, HY_KS = BIG + 394 * MiB;
constexpr size_t FF_H = BIG, FF_A = BIG + 66 * MiB, FF_G = BIG + 248 * MiB;
constexpr size_t MS_H = BIG, MS_XM = BIG + 32 * MiB, MS_XC = BIG + 96 * MiB, MS_KT = BIG + 160 * MiB, MS_VT = BIG + 224 * MiB, MS_NF = BIG + 288 * MiB, MS_NB = BIG + 352 * MiB,
                 MS_KTC = BIG + 416 * MiB, MS_VTC = BIG + 420 * MiB;
constexpr size_t MS_S = MS_XM, MS_Z = MS_KT, MS_KN = MS_NF, MS_XCC = MS_NB, MS_XMC = MS_NB + 4 * MiB, MS_HC = MS_NB + 8 * MiB;
constexpr size_t WS_END = BIG + 424 * MiB;
static_assert(WS_END <= 512 * MiB, "workspace map");
static_assert(FF_G + (size_t)MALL * FF * 2 <= 512 * MiB && FF_A + (size_t)MALL * FF * 2 <= FF_G, "ffn map");
static_assert(HY_P + (size_t)MALL * 3072 * 2 <= HY_KT && HY_ZTC + (size_t)NB * D * CTXL * 2 <= HY_KS && HY_KS + 32 * MiB <= 512 * MiB, "hyena map");

__device__ __forceinline__ unsigned f2bf(float f) { unsigned u = __float_as_uint(f); return (u + 0x7fffu + ((u >> 16) & 1u)) >> 16; }
typedef __bf16 bf16x2_t __attribute__((ext_vector_type(2)));
__device__ __forceinline__ unsigned pk2(float lo, float hi) { const f32x2 v = {lo, hi}; const bf16x2_t b = __builtin_convertvector(v, bf16x2_t); return __builtin_bit_cast(unsigned, b); }
__device__ __forceinline__ float bf2f(unsigned short b) { return __uint_as_float(((unsigned)b) << 16); }
__device__ __forceinline__ float bflo(unsigned w) { return __uint_as_float(w << 16); }
__device__ __forceinline__ float bfhi(unsigned w) { return __uint_as_float(w & 0xffff0000u); }
__device__ __forceinline__ void unpack8(const u32x4 v, float (&o)[8]) { o[0] = bflo(v.x); o[1] = bfhi(v.x); o[2] = bflo(v.y); o[3] = bfhi(v.y); o[4] = bflo(v.z); o[5] = bfhi(v.z); o[6] = bflo(v.w); o[7] = bfhi(v.w); }
__device__ __forceinline__ u32x4 pack8(const float (&o)[8]) { u32x4 v; v.x = pk2(o[0], o[1]); v.y = pk2(o[2], o[3]); v.z = pk2(o[4], o[5]); v.w = pk2(o[6], o[7]); return v; }
__device__ __forceinline__ float wave_sum(float v) {
#pragma unroll
    for (int o = 1; o < 64; o <<= 1) v += __shfl_xor(v, o);
    return v;
}
__device__ __forceinline__ float silu_f(float x) { return x / (1.0f + __expf(-x)); }

typedef const float* cfptr_t;
struct Fr {
    LAS unsigned char* lds; int tid, lane, wave, gw, ngw, G, bid;
    const __attribute__((address_space(4))) cfptr_t* in; float* out; unsigned char* ws;
};
#define IN(i) (F.in[i])
enum { I_X = 0, I_C, I_CTX, I_CCTX, I_MODW, I_MODB, I_NORMG, I_FINALG, I_HWIN, I_HBIN, I_HSCW, I_HSCB, I_FW1, I_FB1, I_FW2, I_FB2, I_FW3, I_FB3, I_FWOUT, I_FREQ, I_HBIAS, I_HWOUT, I_HBOUT,
       I_MWIN, I_MCW, I_MCB, I_MWQ, I_MWK, I_MWV, I_MWG, I_MBG, I_MNW, I_MSKIP, I_MWDN, I_FWUP, I_FCW, I_FCB, I_FWDN };

__device__ __forceinline__ void transpose_item(const float* W, int K, int N, bf16* WT, LAS float* scr, int item, int lane) {
    const int nblk = N / 32, kb = item / nblk, nb = item % nblk, k0 = 64 * kb, n0 = 32 * nb;
#pragma unroll 8
    for (int i = 0; i < 32; ++i) { const int kk = 2 * i + (lane >> 5); scr[kk * 33 + (lane & 31)] = W[(size_t)(k0 + kk) * N + n0 + (lane & 31)]; }
    asm volatile("s_waitcnt lgkmcnt(0)" ::: "memory");
    const int c = lane & 7;
#pragma unroll
    for (int j = 0; j < 4; ++j) { const int n = (lane >> 3) + 8 * j; const LAS float* s = scr + (8 * c) * 33 + n;
        u32x4 o; o.x = pk2(s[0 * 33], s[1 * 33]); o.y = pk2(s[2 * 33], s[3 * 33]); o.z = pk2(s[4 * 33], s[5 * 33]); o.w = pk2(s[6 * 33], s[7 * 33]);
        *(u32x4*)(WT + (size_t)(n0 + n) * K + k0 + 8 * c) = o; }
    asm volatile("s_waitcnt lgkmcnt(0)" ::: "memory");
}
__device__ __forceinline__ void transpose_matrix(Fr& F, const float* W, int K, int N, bf16* WT) {
    LAS float* scr = (LAS float*)(F.lds + F.wave * 16384);
    const int nitems = (K / 64) * (N / 32);
    for (int it = F.gw; it < nitems; it += F.ngw) transpose_item(W, K, N, WT, scr, it, F.lane);
}

__device__ __forceinline__ void ph_prologue(Fr& F) {
    unsigned char* ws = F.ws;
    transpose_matrix(F, IN(I_HWIN), D, 3 * D, (bf16*)(ws + WS_WHIN));
    transpose_matrix(F, IN(I_HWOUT), D, D, (bf16*)(ws + WS_WHOUT));
    transpose_matrix(F, IN(I_MWIN), D, 2 * MI, (bf16*)(ws + WS_WMIN));
    transpose_matrix(F, IN(I_MWDN), MI, D, (bf16*)(ws + WS_WMDN));
    transpose_matrix(F, IN(I_FWUP), D, 2 * FF, (bf16*)(ws + WS_WUP0));
    transpose_matrix(F, IN(I_FWUP) + (size_t)D * 2 * FF, D, 2 * FF, (bf16*)(ws + WS_WUP1));
    transpose_matrix(F, IN(I_FWDN), FF, D, (bf16*)(ws + WS_WDN0));
    transpose_matrix(F, IN(I_FWDN) + (size_t)FF * D, FF, D, (bf16*)(ws + WS_WDN1));
    __syncthreads();
    {
        LAS float* sc = (LAS float*)F.lds;
        LAS float* red = (LAS float*)(F.lds + 32768);
        for (int i = F.tid; i < 5 * 1024; i += NTHR) { const int r = i >> 10, k = i & 1023; const float v = r < 4 ? IN(I_C)[r * 1024 + k] : IN(I_CCTX)[k]; sc[i] = silu_f(v); }
        __syncthreads();
        float* mod = (float*)(ws + WS_MOD);
        for (int it = F.bid; it < 192; it += F.G) {
            const int l = it / 96, n0 = (it % 96) * 64;
            const float* w = IN(I_MODW) + (size_t)l * 1024 * 6144 + n0 + F.lane;
            float a0 = 0.f, a1 = 0.f, a2 = 0.f, a3 = 0.f, a4 = 0.f;
            const int kb = F.wave * 128;
#pragma unroll 8
            for (int k = 0; k < 128; ++k) { const float wv = w[(size_t)(kb + k) * 6144];
                a0 += sc[kb + k] * wv; a1 += sc[1024 + kb + k] * wv; a2 += sc[2048 + kb + k] * wv; a3 += sc[3072 + kb + k] * wv; a4 += sc[4096 + kb + k] * wv; }
            red[(F.wave * 5 + 0) * 64 + F.lane] = a0; red[(F.wave * 5 + 1) * 64 + F.lane] = a1; red[(F.wave * 5 + 2) * 64 + F.lane] = a2; red[(F.wave * 5 + 3) * 64 + F.lane] = a3; red[(F.wave * 5 + 4) * 64 + F.lane] = a4;
            __syncthreads();
            if (F.tid < 320) { const int r = F.tid >> 6, ln = F.tid & 63; float s = 0.f;
#pragma unroll
                for (int w8 = 0; w8 < 8; ++w8) s += red[(w8 * 5 + r) * 64 + ln];
                mod[((size_t)l * 5 + r) * 6144 + n0 + ln] = s + IN(I_MODB)[l * 6144 + n0 + ln]; }
            __syncthreads();
        }
    }
    {
        float* h3 = (float*)(ws + WS_H3);
        const float* w1 = IN(I_FW1); const float* w2 = IN(I_FW2); const float* w3 = IN(I_FW3);
        const float fr = IN(I_FREQ)[F.lane], b1 = IN(I_FB1)[F.lane], b2 = IN(I_FB2)[F.lane], b3 = IN(I_FB3)[F.lane];
        for (int row = F.gw; row < SEQ + CTXL; row += F.ngw) {
            const int L = row < SEQ ? SEQ : CTXL, i = row < SEQ ? row : row - SEQ;
            const float tl = (float)i / (float)(L - 1), w = 6.283185307179586f * (float)i / (float)L;
            float pos = 0.f; const int k = F.lane;
            if (k == 0) pos = tl;
            else if (k <= 16) { const float band = 1e-4f + (float)(k - 1) * ((15.0f - 1e-4f) / 15.0f); pos = cosf(band * w); }
            else if (k <= 32) { const float band = 1e-4f + (float)(k - 17) * ((15.0f - 1e-4f) / 15.0f); pos = -sinf(band * w); }
            float s = b1;
#pragma unroll
            for (int kk = 0; kk < 33; ++kk) s += __shfl(pos, kk) * w1[kk * 64 + F.lane];
            float h = sinf(fr * s);
            s = b2;
#pragma unroll 16
            for (int kk = 0; kk < 64; ++kk) s += __shfl(h, kk) * w2[kk * 64 + F.lane];
            h = sinf(fr * s);
            s = b3;
#pragma unroll 16
            for (int kk = 0; kk < 64; ++kk) s += __shfl(h, kk) * w3[kk * 64 + F.lane];
            h = sinf(fr * s);
            h3[(size_t)row * 64 + F.lane] = h;
        }
    }
    {
        bf16* gwt = (bf16*)(ws + WS_GWT); float* wkq = (float*)(ws + WS_WKQ);
        const float* wq = IN(I_MWQ); const float* wk = IN(I_MWK); const float* wv = IN(I_MWV); const float* wg = IN(I_MWG);
        const int gt = F.bid * NTHR + F.tid, nt = F.G * NTHR;
        for (int i = gt; i < MI * 16; i += nt) { const int ch = i >> 4, g = i & 15, n = ch >> 2, c = ch & 3; float sa = 0.f, sb = 0.f;
#pragma unroll
            for (int e = 0; e < 4; ++e) { sa += wq[n * 16 + c * 4 + e] * wg[(size_t)(n * 4 + e) * 16 + g] + wk[n * 16 + c * 4 + e] * wg[(size_t)(MI + n * 4 + e) * 16 + g];
                sb += wv[n * 16 + c * 4 + e] * wg[(size_t)(2 * MI + n * 4 + e) * 16 + g]; }
            const size_t go = ((size_t)(ch >> 5) * 64 + g + 16 * ((ch & 31) >> 3)) * 8 + (ch & 7);
            gwt[go] = (bf16)f2bf(sa); gwt[go + 64 * 512] = (bf16)f2bf(sb); }
        const float sc = 0.044194173824159216f;
        for (int i = gt; i < 512 * 16; i += nt) { const int n = i >> 4, c = (i >> 2) & 3, c2 = i & 3; float s = 0.f;
#pragma unroll
            for (int e = 0; e < 4; ++e) s += wk[n * 16 + c * 4 + e] * wq[n * 16 + c2 * 4 + e];
            wkq[i] = s * sc; }
    }
}

__device__ __forceinline__ void kt_items(Fr& F, const float* h3rows, int L, float* KT) {
    const float* wout = IN(I_FWOUT);
    const int nitems = (L / 16) * 32, fr = F.lane & 15, fq = F.lane >> 4;
    for (int it = F.gw; it < nitems; it += F.ngw) {
        const int t0 = (it >> 5) * 16, n0 = (it & 31) * 64;
        float a[16];
#pragma unroll
        for (int ks = 0; ks < 16; ++ks) a[ks] = h3rows[(size_t)(t0 + fr) * 64 + 4 * ks + fq];
#pragma unroll
        for (int nt = 0; nt < 4; ++nt) {
            f32x4 acc = (f32x4){0.f, 0.f, 0.f, 0.f};
#pragma unroll
            for (int ks = 0; ks < 16; ++ks) acc = __builtin_amdgcn_mfma_f32_16x16x4f32(a[ks], wout[(size_t)(4 * ks + fq) * 2048 + n0 + nt * 16 + fr], acc, 0, 0, 0);
            const int n = n0 + nt * 16 + fr, dirn = n >> 10, c = n & 1023;
            const float delta = fabsf(HY_MIN_DECAY + (float)c * ((HY_MAX_DECAY - HY_MIN_DECAY) / 1023.0f)), il = 1.0f / (float)(L - 1);
            f32x4 o;
#pragma unroll
            for (int r = 0; r < 4; ++r) o[r] = acc[r] * __expf(-(float)(t0 + 4 * fq + r) * il * delta);
            *(f32x4*)(KT + ((size_t)c * 2 + dirn) * L + t0 + 4 * fq) = o;
        }
    }
}

__device__ __forceinline__ void modnorm_row(const float* xrow, const float* g, const float* sh, const float* sc, bf16* orow, int lane) {
    const f32x4* xr = (const f32x4*)xrow + lane; f32x4 v[4]; float s = 0.f;
#pragma unroll
    for (int j = 0; j < 4; ++j) { v[j] = xr[64 * j]; s += (v[j][0] * v[j][0] + v[j][1] * v[j][1]) + (v[j][2] * v[j][2] + v[j][3] * v[j][3]); }
    const float rinv = 1.0f / sqrtf(wave_sum(s) * (1.0f / 1024.0f) + EPS);
    u32x2* o8 = (u32x2*)orow + lane;
#pragma unroll
    for (int j = 0; j < 4; ++j) { const int c = 4 * lane + 256 * j; const f32x4 gg = *(const f32x4*)(g + c), s1 = *(const f32x4*)(sc + c), s0 = *(const f32x4*)(sh + c);
        const f32x4 y = (v[j] * rinv * gg) * (1.0f + s1) + s0; u32x2 w; w.x = pk2(y[0], y[1]); w.y = pk2(y[2], y[3]); o8[64 * j] = w; }
}
__device__ __forceinline__ void ph_modnorm(Fr& F, const float* xlat, int nlat, int b0, const float* xctx, int nctx, const float* g, const float* modl, int shoff, bf16* H) {
    for (int r = F.gw; r < nlat + nctx; r += F.ngw) {
        const bool isl = r < nlat; const float* xr = isl ? xlat + (size_t)r * 1024 : xctx + (size_t)(r - nlat) * 1024; const int mr = isl ? b0 + r / SEQ : 4;
        modnorm_row(xr, g, modl + (size_t)mr * 6144 + shoff, modl + (size_t)mr * 6144 + shoff + 1024, H + (size_t)r * 1024, F.lane);
    }
}

__device__ __forceinline__ void zt_items(Fr& F, const bf16* P, int rowbase, int nb, int Ls, bf16* ZT) {
    LAS unsigned char* tile = F.lds + F.wave * 16384;
    const float* scw = IN(I_HSCW); const float* scb = IN(I_HSCB);
    const int ntt = Ls / 64, nitems = nb * ntt * 16;
    for (int it = F.gw; it < nitems; it += F.ngw) {
        const int ct = it & 15, tt = (it >> 4) % ntt, b = (it >> 4) / ntt, t0 = tt * 64, c = ct * 64 + F.lane;
        const float w10 = scw[1024 + c], w11 = scw[3072 + 1024 + c], w12 = scw[6144 + 1024 + c], bb1 = scb[1024 + c];
        const float w20 = scw[2048 + c], w21 = scw[3072 + 2048 + c], w22 = scw[6144 + 2048 + c], bb2 = scb[2048 + c];
        const bf16* pb = P + (size_t)(rowbase + b * Ls) * 3072;
        float x1p = 0.f, x1c = 0.f, vp = 0.f, vc = 0.f;
        if (t0 > 0) { x1p = bf2f(pb[(size_t)(t0 - 1) * 3072 + 1024 + c]); vp = bf2f(pb[(size_t)(t0 - 1) * 3072 + 2048 + c]); }
        x1c = bf2f(pb[(size_t)t0 * 3072 + 1024 + c]); vc = bf2f(pb[(size_t)t0 * 3072 + 2048 + c]);
#pragma unroll 4
        for (int j = 0; j < 64; ++j) {
            const int tn = t0 + j + 1; float x1n = 0.f, vn = 0.f;
            if (tn < Ls) { x1n = bf2f(pb[(size_t)tn * 3072 + 1024 + c]); vn = bf2f(pb[(size_t)tn * 3072 + 2048 + c]); }
            const float a = w10 * x1p + w11 * x1c + w12 * x1n + bb1, d = w20 * vp + w21 * vc + w22 * vn + bb2;
            *(LAS bf16*)(tile + F.lane * 136 + j * 2) = (bf16)f2bf(a * d);
            x1p = x1c; x1c = x1n; vp = vc; vc = vn;
        }
#pragma unroll
        for (int q = 0; q < 8; ++q) { const int cc = q * 8 + (F.lane >> 3), ch = F.lane & 7;
            const u32x2 lo = *(const LAS u32x2*)(tile + cc * 136 + ch * 16), hi = *(const LAS u32x2*)(tile + cc * 136 + ch * 16 + 8);
            u32x4 o; o.x = lo.x; o.y = lo.y; o.z = hi.x; o.w = hi.y;
            *(u32x4*)(ZT + ((size_t)b * 1024 + ct * 64 + cc) * Ls + t0 + ch * 8) = o; }
    }
}

__device__ __forceinline__ f32x2 cmul(f32x2 a, f32x2 b) { return (f32x2){a.x * b.x - a.y * b.y, a.x * b.y + a.y * b.x}; }
__device__ __forceinline__ f32x2 twid(float f) { return (f32x2){__builtin_amdgcn_cosf(f), __builtin_amdgcn_sinf(f)}; }
__device__ __forceinline__ void fft_fwd(LAS f32x2* buf, int tid) {
#pragma unroll 1
    for (int p = 0; p < 7; ++p) {
        const int lq = 12 - 2 * p, q = 1 << lq; const float invN = 1.0f / (float)(4 * q);
#pragma unroll 1
        for (int m = 0; m < 8; ++m) {
            const int g = tid + 512 * m, i = g & (q - 1), i0 = ((g >> lq) << (lq + 2)) + i;
            const f32x2 a0 = buf[i0], a1 = buf[i0 + q], a2 = buf[i0 + 2 * q], a3 = buf[i0 + 3 * q];
            const f32x2 t0 = a0 + a2, t1 = a0 - a2, t2 = a1 + a3, d = a1 - a3, t3 = (f32x2){d.y, -d.x};
            const float f = -(float)i * invN;
            buf[i0] = t0 + t2; buf[i0 + q] = cmul(t1 + t3, twid(f)); buf[i0 + 2 * q] = cmul(t0 - t2, twid(2.f * f)); buf[i0 + 3 * q] = cmul(t1 - t3, twid(3.f * f));
        }
        __syncthreads();
    }
}
__device__ __forceinline__ void fft_inv(LAS f32x2* buf, int tid) {
#pragma unroll 1
    for (int p = 6; p >= 0; --p) {
        const int lq = 12 - 2 * p, q = 1 << lq; const float invN = 1.0f / (float)(4 * q);
#pragma unroll 1
        for (int m = 0; m < 8; ++m) {
            const int g = tid + 512 * m, i = g & (q - 1), i0 = ((g >> lq) << (lq + 2)) + i;
            const float f = (float)i * invN;
            const f32x2 b0 = buf[i0], b1 = cmul(buf[i0 + q], twid(f)), b2 = cmul(buf[i0 + 2 * q], twid(2.f * f)), b3 = cmul(buf[i0 + 3 * q], twid(3.f * f));
            const f32x2 t0 = b0 + b2, t1 = b0 - b2, t2 = b1 + b3, d = b1 - b3, t3 = (f32x2){-d.y, d.x};
            buf[i0] = t0 + t2; buf[i0 + q] = t1 + t3; buf[i0 + 2 * q] = t0 - t2; buf[i0 + 3 * q] = t1 - t3;
        }
        __syncthreads();
    }
}
__device__ __forceinline__ float block_sum(Fr& F, float v, LAS float* red) {
    v = wave_sum(v);
    __syncthreads();
    if (F.lane == 0) red[F.wave] = v;
    __syncthreads();
    float s = 0.f;
#pragma unroll
    for (int w = 0; w < 8; ++w) s += red[w];
    return s;
}
__device__ __forceinline__ void ph_fftconv(Fr& F) {
    LAS f32x2* buf = (LAS f32x2*)F.lds; LAS float* red = (LAS float*)(F.lds + 131072);
    const float* KT = (const float*)(F.ws + HY_KT); const float* KTC = (const float*)(F.ws + WS_KTC);
    bf16* ZT = (bf16*)(F.ws + HY_ZT); bf16* ZTC = (bf16*)(F.ws + HY_ZTC);
    const int tid = F.tid;
    for (int c = F.bid; c < 1024; c += F.G) {
        const float bias = IN(I_HBIAS)[c];
        __syncthreads();
        float asum = 0.f;
        const f32x4* kf = (const f32x4*)(KT + (size_t)c * 2 * SEQ); const f32x4* kb = kf + SEQ / 4;
#pragma unroll
        for (int q = 0; q < 4; ++q) { const int i4 = tid + 512 * q; const f32x4 v = kf[i4];
            asum += fabsf(v[0]) + fabsf(v[1]) + fabsf(v[2]) + fabsf(v[3]);
            buf[4 * i4] = (f32x2){v[0], 0.f}; buf[4 * i4 + 1] = (f32x2){v[1], 0.f}; buf[4 * i4 + 2] = (f32x2){v[2], 0.f}; buf[4 * i4 + 3] = (f32x2){v[3], 0.f};
            const f32x4 u = kb[i4]; const int m = 4 * i4;
            if (m > 0) { buf[16384 - m] = (f32x2){u[0], 0.f}; asum += fabsf(u[0]); } else buf[8192] = (f32x2){0.f, 0.f};
            buf[16384 - m - 1] = (f32x2){u[1], 0.f}; buf[16384 - m - 2] = (f32x2){u[2], 0.f}; buf[16384 - m - 3] = (f32x2){u[3], 0.f};
            asum += fabsf(u[1]) + fabsf(u[2]) + fabsf(u[3]); }
        const float S = block_sum(F, asum, red);
        __syncthreads();
        fft_fwd(buf, tid);
        f32x2* Ks = (f32x2*)(F.ws + HY_KS) + (size_t)(F.bid & 255) * 16384 + tid; const float ksc = 1.0f / (S * 16384.0f);
#pragma unroll 8
        for (int j = 0; j < 32; ++j) Ks[512 * j] = buf[tid + 512 * j] * ksc;
#pragma unroll 1
        for (int pr = 0; pr < 2; ++pr) {
            bf16* z0 = ZT + ((size_t)(2 * pr) * 1024 + c) * SEQ; bf16* z1 = ZT + ((size_t)(2 * pr + 1) * 1024 + c) * SEQ;
            __syncthreads();
#pragma unroll
            for (int q = 0; q < 2; ++q) { const int t8 = (tid + 512 * q) * 8; float a[8], b[8];
                unpack8(*(const u32x4*)(z0 + t8), a); unpack8(*(const u32x4*)(z1 + t8), b);
#pragma unroll
                for (int e = 0; e < 8; ++e) { buf[t8 + e] = (f32x2){a[e], b[e]}; buf[8192 + t8 + e] = (f32x2){0.f, 0.f}; } }
            __syncthreads();
            fft_fwd(buf, tid);
#pragma unroll 8
            for (int j = 0; j < 32; ++j) buf[tid + 512 * j] = cmul(buf[tid + 512 * j], Ks[512 * j]);
            __syncthreads();
            fft_inv(buf, tid);
#pragma unroll
            for (int q = 0; q < 2; ++q) { const int t8 = (tid + 512 * q) * 8; float a[8], b[8];
                unpack8(*(const u32x4*)(z0 + t8), a); unpack8(*(const u32x4*)(z1 + t8), b);
#pragma unroll
                for (int e = 0; e < 8; ++e) { const f32x2 y = buf[t8 + e]; a[e] = y.x + a[e] * bias; b[e] = y.y + b[e] * bias; }
                *(u32x4*)(z0 + t8) = pack8(a); *(u32x4*)(z1 + t8) = pack8(b); }
        }
        __syncthreads();
        {
            LAS float* kc = (LAS float*)F.lds; LAS float* zc = kc + 512;
            const float* kfc = KTC + (size_t)c * 2 * CTXL; float v = 0.f;
            { const int n = tid; if (n < 256) v = kfc[n]; else if (n == 256) v = 0.f; else v = kfc[CTXL + (512 - n)]; kc[n] = v; }
            const float Sc = block_sum(F, fabsf(v), red);
            for (int i = tid; i < 1024; i += NTHR) { const int b = i >> 8, t = i & 255; zc[i] = bf2f(ZTC[((size_t)b * 1024 + c) * CTXL + t]); }
            __syncthreads();
            const int b = tid >> 7, t2 = tid & 127; const float isc = 1.0f / Sc;
#pragma unroll
            for (int hh = 0; hh < 2; ++hh) { const int t = t2 + 128 * hh; float acc = 0.f;
#pragma unroll 8
                for (int s = 0; s < 256; ++s) acc += zc[b * 256 + s] * kc[(t - s) & 511];
                ZTC[((size_t)b * 1024 + c) * CTXL + t] = (bf16)f2bf(acc * isc + zc[b * 256 + t] * bias); }
        }
    }
}

__device__ __forceinline__ void u2_items(Fr& F, const bf16* P, int rowbase, int nb, int Ls, const bf16* YT, bf16* U2) {
    LAS unsigned char* tile = F.lds + F.wave * 16384;
    const float* scw = IN(I_HSCW); const float* scb = IN(I_HSCB);
    const int ntt = Ls / 64, nitems = nb * ntt * 16;
    for (int it = F.gw; it < nitems; it += F.ngw) {
        const int ct = it & 15, tt = (it >> 4) % ntt, b = (it >> 4) / ntt, t0 = tt * 64, c = ct * 64 + F.lane;
#pragma unroll
        for (int q = 0; q < 8; ++q) { const int cc = q * 8 + (F.lane >> 3), ch = F.lane & 7;
            const u32x4 v = *(const u32x4*)(YT + ((size_t)b * 1024 + ct * 64 + cc) * Ls + t0 + ch * 8);
            *(LAS u32x2*)(tile + cc * 136 + ch * 16) = (u32x2){v.x, v.y}; *(LAS u32x2*)(tile + cc * 136 + ch * 16 + 8) = (u32x2){v.z, v.w}; }
        const float w0 = scw[c], w1 = scw[3072 + c], w2 = scw[6144 + c], bb = scb[c];
        const bf16* pb = P + (size_t)(rowbase + b * Ls) * 3072; bf16* ub = U2 + (size_t)(rowbase + b * Ls) * 1024;
        float xp = 0.f, xc = bf2f(pb[(size_t)t0 * 3072 + c]);
        if (t0 > 0) xp = bf2f(pb[(size_t)(t0 - 1) * 3072 + c]);
#pragma unroll 4
        for (int j = 0; j < 64; ++j) {
            const int tn = t0 + j + 1; float xn = 0.f; if (tn < Ls) xn = bf2f(pb[(size_t)tn * 3072 + c]);
            const float x0 = w0 * xp + w1 * xc + w2 * xn + bb, y = bf2f(*(const LAS bf16*)(tile + F.lane * 136 + j * 2));
            ub[(size_t)(t0 + j) * 1024 + c] = (bf16)f2bf(x0 * y);
            xp = xc; xc = xn;
        }
    }
}

__device__ __forceinline__ void dw_item(const bf16* G, bf16* A, const float* cw, const float* cb, int f8, int rowtok0, int nx, int x0, bool up_ok, bool down_ok) {
    float w[9][8], bias[8];
#pragma unroll
    for (int k = 0; k < 9; ++k) { const float m = (k < 3) ? (up_ok ? 1.f : 0.f) : ((k >= 6) ? (down_ok ? 1.f : 0.f) : 1.f);
        const f32x4 w0 = *(const f32x4*)(cw + (size_t)k * FF + f8) * m, w1 = *(const f32x4*)(cw + (size_t)k * FF + f8 + 4) * m;
        w[k][0] = w0[0]; w[k][1] = w0[1]; w[k][2] = w0[2]; w[k][3] = w0[3]; w[k][4] = w1[0]; w[k][5] = w1[1]; w[k][6] = w1[2]; w[k][7] = w1[3]; }
    { const f32x4 b0 = *(const f32x4*)(cb + f8), b1 = *(const f32x4*)(cb + f8 + 4); bias[0] = b0[0]; bias[1] = b0[1]; bias[2] = b0[2]; bias[3] = b0[3]; bias[4] = b1[0]; bias[5] = b1[1]; bias[6] = b1[2]; bias[7] = b1[3]; }
    const int upo = up_ok ? -nx : 0, dno = down_ok ? nx : 0;
    const bf16* g0 = G + (size_t)rowtok0 * FF + f8; bf16* a0 = A + (size_t)rowtok0 * FF + f8;
    const u32x4 zero4 = (u32x4){0u, 0u, 0u, 0u};
    u32x4 cm[3], cc[3], cp[3];
    { const int xm = x0 > 0 ? x0 - 1 : 0; const bool okm = x0 > 0;
        cm[0] = *(const u32x4*)(g0 + (size_t)(xm + upo) * FF); cm[1] = *(const u32x4*)(g0 + (size_t)xm * FF); cm[2] = *(const u32x4*)(g0 + (size_t)(xm + dno) * FF);
        if (!okm) { cm[0] = zero4; cm[1] = zero4; cm[2] = zero4; }
        cc[0] = *(const u32x4*)(g0 + (size_t)(x0 + upo) * FF); cc[1] = *(const u32x4*)(g0 + (size_t)x0 * FF); cc[2] = *(const u32x4*)(g0 + (size_t)(x0 + dno) * FF); }
#pragma unroll 4
    for (int j = 0; j < 32; ++j) {
        const int x = x0 + j, xp = x + 1 < nx ? x + 1 : nx - 1; const bool okp = x + 1 < nx;
        cp[0] = *(const u32x4*)(g0 + (size_t)(xp + upo) * FF); cp[1] = *(const u32x4*)(g0 + (size_t)xp * FF); cp[2] = *(const u32x4*)(g0 + (size_t)(xp + dno) * FF);
        const u32x4 av = *(const u32x4*)(a0 + (size_t)x * FF);
        if (!okp) { cp[0] = zero4; cp[1] = zero4; cp[2] = zero4; }
        float acc[8];
#pragma unroll
        for (int e = 0; e < 8; ++e) acc[e] = bias[e];
#pragma unroll
        for (int dy = 0; dy < 3; ++dy) { float v[8];
            unpack8(cm[dy], v);
#pragma unroll
            for (int e = 0; e < 8; ++e) acc[e] += v[e] * w[dy * 3 + 0][e];
            unpack8(cc[dy], v);
#pragma unroll
            for (int e = 0; e < 8; ++e) acc[e] += v[e] * w[dy * 3 + 1][e];
            unpack8(cp[dy], v);
#pragma unroll
            for (int e = 0; e < 8; ++e) acc[e] += v[e] * w[dy * 3 + 2][e]; }
        float a[8]; unpack8(av, a);
#pragma unroll
        for (int e = 0; e < 8; ++e) a[e] = silu_f(acc[e]) * a[e];
        *(u32x4*)(a0 + (size_t)x * FF) = pack8(a);
#pragma unroll
        for (int dy = 0; dy < 3; ++dy) { cm[dy] = cc[dy]; cc[dy] = cp[dy]; }
    }
}
__device__ __forceinline__ void ph_dwconv(Fr& F, int layer, int nlat, int nctx) {
    bf16* A = (bf16*)(F.ws + FF_A); const bf16* G = (const bf16*)(F.ws + FF_G);
    const float* cw = IN(I_FCW) + (size_t)layer * 9 * FF; const float* cb = IN(I_FCB) + (size_t)layer * FF;
    const int ngrp = (F.G % 8 == 0) ? 8 : 1, xg = F.bid % ngrp, lb = F.bid / ngrp, nlb = F.G / ngrp;
    const int nseg = nlat / 32, band = nseg / ngrp;
    for (int i = lb * NTHR + F.tid; i < band * 352; i += nlb * NTHR) {
        const int sl = i / 352, f8 = (i - sl * 352) * 8, seg = xg * band + sl, grow = seg >> 1, gy = grow & 127;
        dw_item(G, A, cw, cb, f8, grow * 64, 64, (seg & 1) * 32, gy > 0, gy < 127);
    }
    const int nsegc = nctx / 32;
    for (int i = F.bid * NTHR + F.tid; i < nsegc * 352; i += F.G * NTHR) {
        const int sl = i / 352, f8 = (i - sl * 352) * 8;
        dw_item(G, A, cw, cb, f8, nlat + (sl >> 3) * CTXL, CTXL, (sl & 7) * 32, false, false);
    }
}

__device__ __forceinline__ void prep_items(Fr& F, const bf16* XM, int nb, int Ls, bf16* XC, bf16* KN, bf16* KT, bf16* VT) {
    LAS unsigned char* tk = F.lds + F.wave * 17408; LAS unsigned char* tv = tk + 8704;
    const int ntt = Ls / 64, nitems = nb * ntt * 32;
    const int tl = F.lane >> 3, c8 = F.lane & 7;
    for (int it = F.gw; it < nitems; it += F.ngw) {
        const int cg = it & 31, tt = (it >> 5) % ntt, b = (it >> 5) / ntt, t0 = tt * 64, ch0 = cg * 64 + c8 * 8, h = cg >> 3;
        float cw0[8], cw1[8], cw2[8], cbb[8], wkq[32], wv[32];
        { const float* p = IN(I_MCW) + ch0; const float* pb = IN(I_MCB) + ch0;
#pragma unroll
            for (int e = 0; e < 8; ++e) { cw0[e] = p[e]; cw1[e] = p[MI + e]; cw2[e] = p[2 * MI + e]; cbb[e] = pb[e]; }
            const float* q = (const float*)(F.ws + WS_WKQ) + (ch0 >> 2) * 16; const float* v = IN(I_MWV) + (ch0 >> 2) * 16;
#pragma unroll
            for (int e = 0; e < 32; ++e) { wkq[e] = q[e]; wv[e] = v[e]; } }
#pragma unroll 2
        for (int i8 = 0; i8 < 8; ++i8) {
            const int tloc = i8 * 8 + tl, t = t0 + tloc; const size_t row = (size_t)b * Ls + t;
            float xp[8], xm[8], xn[8];
            const size_t rowp = row - (t > 0 ? 1 : 0), rown = row + (t + 1 < Ls ? 1 : 0); const size_t ctile = (size_t)(ch0 >> 5) * 512 + ((ch0 & 31) >> 3) * 128;
            const u32x4 rm = *(const u32x4*)(XM + (row >> 4) * 32768 + ctile + (row & 15) * 8), rp = *(const u32x4*)(XM + (rowp >> 4) * 32768 + ctile + (rowp & 15) * 8), rn = *(const u32x4*)(XM + (rown >> 4) * 32768 + ctile + (rown & 15) * 8);
            unpack8(rm, xm); unpack8(rp, xp); unpack8(rn, xn);
            { const float mp = t > 0 ? 1.f : 0.f, mn = t + 1 < Ls ? 1.f : 0.f;
#pragma unroll
                for (int e = 0; e < 8; ++e) { xp[e] *= mp; xn[e] *= mn; } }
            float xc[8], kp[8], vv[8];
#pragma unroll
            for (int e = 0; e < 8; ++e) xc[e] = silu_f(cw0[e] * xp[e] + cw1[e] * xm[e] + cw2[e] * xn[e] + cbb[e]);
#pragma unroll
            for (int n = 0; n < 2; ++n)
#pragma unroll
                for (int o = 0; o < 4; ++o) { float sk = 0.f, sv = 0.f;
#pragma unroll
                    for (int c = 0; c < 4; ++c) { sk += xc[n * 4 + c] * wkq[n * 16 + c * 4 + o]; sv += xm[n * 4 + c] * wv[n * 16 + c * 4 + o]; }
                    kp[n * 4 + o] = sk; vv[n * 4 + o] = sv; }
            { const size_t to = ((size_t)(row >> 4) * 64 + (ch0 >> 5)) * 512 + (((unsigned)row & 15u) + 16u * ((ch0 & 31) >> 3)) * 8u;
              *(u32x4*)(XC + to) = pack8(xc); *(u32x4*)(KN + to) = pack8(kp); }
#pragma unroll
            for (int e = 0; e < 8; ++e) { *(LAS bf16*)(tk + (c8 * 8 + e) * 136 + tloc * 2) = (bf16)f2bf(kp[e]); *(LAS bf16*)(tv + (c8 * 8 + e) * 136 + tloc * 2) = (bf16)f2bf(vv[e]); }
        }
#pragma unroll
        for (int q = 0; q < 8; ++q) { const int dt = q >> 1, kq = q & 1, r = F.lane & 15, q4 = F.lane >> 4;
            const size_t tile = ((size_t)(t0 >> 7) * 32 + (cg & 7) * 4 + dt) * 4 + ((t0 & 127) >> 5) + kq;
            const size_t o = (size_t)(b * 4 + h) * 512 * Ls + tile * 512 + F.lane * 8;
            { const u32x2 lo = *(const LAS u32x2*)(tk + (dt * 16 + r) * 136 + kq * 64 + q4 * 16), hi = *(const LAS u32x2*)(tk + (dt * 16 + r) * 136 + kq * 64 + q4 * 16 + 8); *(u32x4*)(KT + o) = (u32x4){lo.x, lo.y, hi.x, hi.y}; }
            { const u32x2 lo = *(const LAS u32x2*)(tv + (dt * 16 + r) * 136 + kq * 64 + q4 * 16), hi = *(const LAS u32x2*)(tv + (dt * 16 + r) * 136 + kq * 64 + q4 * 16 + 8); *(u32x4*)(VT + o) = (u32x4){lo.x, lo.y, hi.x, hi.y}; }
        }
    }
}

__device__ __forceinline__ void gate_items(Fr& F, const bf16* XC, const bf16* XM, int R, float* GATES) {
    const bf16* gwt = (const bf16*)(F.ws + WS_GWT);
    const int fr = F.lane & 15, fq = F.lane >> 4;
    for (int tile = F.gw; tile < R / 16; tile += F.ngw) {
        const int r0 = tile * 16; f32x4 acc = (f32x4){0.f, 0.f, 0.f, 0.f};
        const bf16* ap = XC + (size_t)tile * 32768 + F.lane * 8; const bf16* bp = gwt + F.lane * 8;
#pragma unroll 8
        for (int ks = 0; ks < 64; ++ks) acc = __builtin_amdgcn_mfma_f32_16x16x32_bf16(*(const bf16x8*)(ap + ks * 512), *(const bf16x8*)(bp + ks * 512), acc, 0, 0, 0);
        ap = XM + (size_t)tile * 32768 + F.lane * 8; bp += 64 * 512;
#pragma unroll 8
        for (int ks = 0; ks < 64; ++ks) acc = __builtin_amdgcn_mfma_f32_16x16x32_bf16(*(const bf16x8*)(ap + ks * 512), *(const bf16x8*)(bp + ks * 512), acc, 0, 0, 0);
        const float bg = IN(I_MBG)[fr]; const bool isf = (fr >> 2) & 1;
#pragma unroll
        for (int r = 0; r < 4; ++r) { float x = acc[r] + bg; if (isf) x = fminf(x, 0.f) - log1pf(__expf(-fabsf(x))); GATES[(size_t)(r0 + 4 * fq + r) * 16 + fr] = x; }
    }
}

__device__ __forceinline__ void cum_items(Fr& F, const float* GATES, int nb, int Ls, int gb0, int ctau0, f32x4* GT, float* GC) {
    const int R = nb * Ls, nch = Ls / 128, nitems = 2 * nb * 4 * nch;
    for (int it = F.gw; it < nitems; it += F.ngw) {
        const int c = it % nch, h = (it / nch) & 3, b = (it / nch / 4) % nb, dir = it / nch / 4 / nb;
        const int row0 = b * Ls + c * 128 + 2 * F.lane;
        const float lf0 = GATES[(size_t)row0 * 16 + dir * 8 + 4 + h], lf1 = GATES[(size_t)(row0 + 1) * 16 + dir * 8 + 4 + h];
        const float ig0 = GATES[(size_t)row0 * 16 + dir * 8 + h], ig1 = GATES[(size_t)(row0 + 1) * 16 + dir * 8 + h];
        float inc = lf0 + lf1;
#pragma unroll
        for (int o = 1; o < 64; o <<= 1) { const float t = __shfl_up(inc, o); if (F.lane >= o) inc += t; }
        const float tot = __shfl(inc, 63), exc = inc - (lf0 + lf1);
        float b0, b1;
        if (dir == 0) { b0 = exc + lf0; b1 = inc; } else { b0 = tot - exc; b1 = tot - exc - lf0; }
        GT[(size_t)(dir * 4 + h) * R + row0] = (f32x4){b0, ig0 - b0, __expf(b0), __expf(tot - b0 + ig0)};
        GT[(size_t)(dir * 4 + h) * R + row0 + 1] = (f32x4){b1, ig1 - b1, __expf(b1), __expf(tot - b1 + ig1)};
        if (F.lane == 0) GC[((size_t)(dir * 4 + gb0 + b) * 4 + h) * 66 + ctau0 + c] = __expf(tot);
    }
}

__device__ __forceinline__ void dn_item(Fr& F, const bf16* KTchunk, const f32x4* GTd0, const f32x4* GTd1, int row0, float* DN0, float* DN1) {
    LAS float* wl = (LAS float*)(F.lds + 1024);
    __syncthreads();
    if (F.tid < 128) wl[F.tid] = GTd0[row0 + F.tid][3]; else if (F.tid < 256) wl[F.tid] = GTd1[row0 + F.tid - 128][3];
    __syncthreads();
    const bf16* kr = KTchunk + (size_t)(F.tid >> 4) * 4 * 512 + (F.tid & 15) * 8; float s0 = 0.f, s1 = 0.f;
#pragma unroll 4
    for (int q = 0; q < 16; ++q) { const int ks = q >> 2, q4 = q & 3; float v[8]; unpack8(*(const u32x4*)(kr + ks * 512 + q4 * 128), v);
#pragma unroll
        for (int e = 0; e < 8; ++e) { s0 += v[e] * wl[q * 8 + e]; s1 += v[e] * wl[128 + q * 8 + e]; } }
    DN0[F.tid] = s0; DN1[F.tid] = s1;
}
__device__ __forceinline__ void ph_sphase(Fr& F, int hb, bool with_ctx) {
    const bf16* XC = (const bf16*)(F.ws + MS_XC); const bf16* KN = (const bf16*)(F.ws + MS_KN); const bf16* KT = (const bf16*)(F.ws + MS_KT);
    const f32x4* GT = (const f32x4*)(F.ws + WS_GT_L); float* DN = (float*)(F.ws + WS_DN); float* RS = (float*)(F.ws + WS_RS);
    bf16* S = (bf16*)(F.ws + MS_S);
    const int fr = F.lane & 15, fq = F.lane >> 4, w = F.wave;
    for (int it = F.bid; it < 512; it += F.G) {
        const int c = it & 63, h = (it >> 6) & 3, bl = it >> 8, gb = 2 * hb + bl;
        const int row0 = bl * SEQ + c * 128;
        dn_item(F, KT + (size_t)(bl * 4 + h) * 512 * SEQ + (size_t)c * 65536, GT + (size_t)(0 * 4 + h) * HROWS, GT + (size_t)(1 * 4 + h) * HROWS, row0,
                DN + (((size_t)(0 * 4 + gb) * 4 + h) * 66 + 2 + c) * 512, DN + (((size_t)(1 * 4 + gb) * 4 + h) * 66 + 2 + c) * 512);
        const int irow = row0 + 16 * w + fr;
        bf16x8 bq[16];
        { const bf16* p = XC + ((size_t)((row0 >> 4) + w) * 64 + h * 16) * 512 + F.lane * 8;
#pragma unroll
            for (int ks = 0; ks < 16; ++ks) bq[ks] = *(const bf16x8*)(p + ks * 512); }
        const f32x4 gf = GT[(size_t)(0 * 4 + h) * HROWS + irow], gbk = GT[(size_t)(1 * 4 + h) * HROWS + irow];
        float rsf = 0.f, rsb = 0.f;
        bf16* sf = S + ((size_t)(0 * 8 + bl * 4 + h) * 64 + c) * 16384; bf16* sb = S + ((size_t)(1 * 8 + bl * 4 + h) * 64 + c) * 16384;
#pragma unroll 1
        for (int jt = 0; jt < 8; ++jt) {
            f32x4 acc = (f32x4){0.f, 0.f, 0.f, 0.f};
            const bf16* ap = KN + ((size_t)((row0 >> 4) + jt) * 64 + h * 16) * 512 + F.lane * 8;
#pragma unroll
            for (int ks = 0; ks < 16; ++ks) acc = __builtin_amdgcn_mfma_f32_16x16x32_bf16(*(const bf16x8*)(ap + ks * 512), bq[ks], acc, 0, 0, 0);
            float vf[4], vb[4];
            const f32x4* gj0 = GT + (size_t)(0 * 4 + h) * HROWS + row0 + jt * 16 + 4 * fq; const f32x4* gj1 = GT + (size_t)(1 * 4 + h) * HROWS + row0 + jt * 16 + 4 * fq;
#pragma unroll
            for (int r = 0; r < 4; ++r) { const int j = jt * 16 + 4 * fq + r, i = 16 * w + fr;
                const float af = gj0[r][1], ab = gj1[r][1];
                vf[r] = (j <= i) ? acc[r] * __expf(gf[0] + af) : 0.f; vb[r] = (j >= i) ? acc[r] * __expf(gbk[0] + ab) : 0.f;
                rsf += vf[r]; rsb += vb[r]; }
            const size_t so = (size_t)(w * 4 + (jt >> 1)) * 512 + (fr + 16 * ((jt & 1) * 2 + (fq >> 1))) * 8 + (fq & 1) * 4;
            *(u32x2*)(sf + so) = (u32x2){pk2(vf[0], vf[1]), pk2(vf[2], vf[3])};
            *(u32x2*)(sb + so) = (u32x2){pk2(vb[0], vb[1]), pk2(vb[2], vb[3])};
        }
        rsf += __shfl_xor(rsf, 16); rsf += __shfl_xor(rsf, 32); rsb += __shfl_xor(rsb, 16); rsb += __shfl_xor(rsb, 32);
        if (fq == 0) { RS[(size_t)(0 * 4 + h) * HROWS + irow] = rsf; RS[(size_t)(1 * 4 + h) * HROWS + irow] = rsb; }
    }
    if (with_ctx) {
        const bf16* KTC2 = (const bf16*)(F.ws + MS_KTC); const f32x4* GTC = (const f32x4*)(F.ws + WS_GT_C);
        for (int it = F.bid; it < 32; it += F.G) {
            const int cc = it & 1, h = (it >> 1) & 3, gb = it >> 3;
            dn_item(F, KTC2 + (size_t)(gb * 4 + h) * 512 * CTXL + (size_t)cc * 65536, GTC + (size_t)(0 * 4 + h) * MC, GTC + (size_t)(1 * 4 + h) * MC, gb * CTXL + cc * 128,
                    DN + (((size_t)(0 * 4 + gb) * 4 + h) * 66 + cc) * 512, DN + (((size_t)(1 * 4 + gb) * 4 + h) * 66 + cc) * 512);
        }
    }
}

__device__ __forceinline__ bf16x8 ldg16(const char* ub, unsigned off) { return *(const bf16x8*)(ub + off); }
__device__ __forceinline__ void ph_scan(Fr& F, int hb) {
    const char* XC = (const char*)(F.ws + MS_XC); const char* KT = (const char*)(F.ws + MS_KT); const char* VT = (const char*)(F.ws + MS_VT);
    const char* KTC2 = (const char*)(F.ws + MS_KTC); const char* VTC2 = (const char*)(F.ws + MS_VTC);
    const char* S = (const char*)(F.ws + MS_S);
    const f32x4* GTL = (const f32x4*)(F.ws + WS_GT_L); const f32x4* GTC = (const f32x4*)(F.ws + WS_GT_C);
    const float* GC = (const float*)(F.ws + WS_GC); const float* DN = (const float*)(F.ws + WS_DN);
    float* NC = (float*)(F.ws + WS_NC);
    LAS unsigned char* cbf = F.lds;
    LAS float* wl = (LAS float*)(F.lds + 2 * 33280);
    const int w = F.wave;
    for (int wi = F.bid; wi < 256; wi += F.G) {
        const int chain = wi & 15, slice = wi >> 4, dir = chain >> 3, bl = (chain >> 2) & 1, h = chain & 3, gb = 2 * hb + bl, e0 = slice * 32;
        char* NUM = (char*)(F.ws + (dir ? MS_NB : MS_NF));
        const bool nwriter = (slice == 0) && (w == 0);
        f32x4 acc[4][2];
#pragma unroll
        for (int a = 0; a < 4; ++a)
#pragma unroll
            for (int b = 0; b < 2; ++b) acc[a][b] = (f32x4){0.f, 0.f, 0.f, 0.f};
        float nreg[8];
#pragma unroll
        for (int e = 0; e < 8; ++e) nreg[e] = 0.f;
        __syncthreads();
        { const int ctau = dir == 0 ? 0 : 1; const f32x4* gt = GTC + (size_t)(dir * 4 + h) * MC; if (F.tid < 128) wl[F.tid] = gt[gb * CTXL + ctau * 128 + F.tid][3]; }
        __syncthreads();
        const char* ktc = KTC2 + (size_t)(gb * 4 + h) * 512 * CTXL * 2; const char* vtc = VTC2 + (size_t)(gb * 4 + h) * 512 * CTXL * 2;
        const char* ktl = KT + (size_t)(bl * 4 + h) * 512 * SEQ * 2;    const char* vtl = VT + (size_t)(bl * 4 + h) * 512 * SEQ * 2;
        bf16x8 xf[16];
#pragma unroll
        for (int ks = 0; ks < 16; ++ks) xf[ks] = (bf16x8){0, 0, 0, 0, 0, 0, 0, 0};
#pragma unroll 1
        for (int s = 0; s < 66; ++s) {
            int tid_ = F.tid; asm volatile("" : "+v"(tid_));
            const int lane_ = tid_ & 63, fr = lane_ & 15, fq = lane_ >> 4; const unsigned l16 = lane_ * 16u;
            const int ctau = dir == 0 ? s : (s < 2 ? 1 - s : 67 - s);
            const bool isctx = ctau < 2; const int c = isctx ? ctau : ctau - 2;
            const char* ktu = (isctx ? ktc : ktl) + (size_t)c * 131072;
            const int row0 = isctx ? gb * CTXL + c * 128 : bl * SEQ + c * 128;
            const f32x4* gt = isctx ? GTC + (size_t)(dir * 4 + h) * MC : GTL + (size_t)(dir * 4 + h) * HROWS;
            const float Gd = GC[((size_t)(dir * 4 + gb) * 4 + h) * 66 + ctau];
            const float* dn = DN + (((size_t)(dir * 4 + gb) * 4 + h) * 66 + ctau) * 512;
            LAS unsigned char* cb_rd = cbf + (s & 1) * 33280; LAS unsigned char* cb_wr = cbf + ((s + 1) & 1) * 33280;
            const LAS float* wl_rd = wl + (s & 1) * 128; LAS float* wl_wr = wl + ((s + 1) & 1) * 128;
            const int s2 = s + 1, ct2 = dir == 0 ? s2 : (s2 < 2 ? 1 - s2 : 67 - s2); const bool has2 = s2 < 66, ic2 = ct2 < 2; const int c2 = ic2 ? ct2 : ct2 - 2;
            const char* xc2 = XC + ((size_t)(((bl * SEQ + c2 * 128) >> 4) + w) * 64 + h * 16) * 1024;
            const char* vtu = (isctx ? vtc : vtl) + (size_t)c * 131072;
            bf16x8 kf[4][4], vf[2][4], sfr[4];
#pragma unroll
            for (int et = 0; et < 2; ++et)
#pragma unroll
                for (int ks = 0; ks < 4; ++ks) vf[et][ks] = ldg16(vtu + ((e0 >> 4) + et) * 4096 + ks * 1024, l16);
            if (!isctx) { const char* su = S + ((size_t)(dir * 8 + bl * 4 + h) * 64 + c) * 32768 + w * 4096;
#pragma unroll
                for (int ks = 0; ks < 4; ++ks) sfr[ks] = ldg16(su + ks * 1024, l16); }
#pragma unroll
            for (int ks = 0; ks < 1; ++ks)
#pragma unroll
                for (int dt = 0; dt < 4; ++dt) kf[ks][dt] = ldg16(ktu + (4 * w + dt) * 4096 + ks * 1024, l16);
            unsigned pf = 0u; const int s3 = s + 2;
            if (s3 < 66) {
                const int ct3 = dir == 0 ? s3 : (s3 < 2 ? 1 - s3 : 67 - s3); const bool ic3 = ct3 < 2; const int c3 = ic3 ? ct3 : ct3 - 2;
                const char* kt3 = (ic3 ? ktc : ktl) + (size_t)c3 * 131072; const char* vt3 = (ic3 ? vtc : vtl) + (size_t)c3 * 131072;
                const char* xc3 = XC + ((size_t)((bl * SEQ + c3 * 128) >> 4) * 64 + h * 16) * 1024; const char* s3p = S + ((size_t)(dir * 8 + bl * 4 + h) * 64 + c3) * 32768;
                const unsigned t = tid_; const char* ub = kt3; unsigned off = 0u;
                if (t < 64) { off = (slice * 64 + t) * 128u; }
                else if (t < 128) { ub = vt3; off = (e0 >> 4) * 4096u + (t - 64) * 128u; }
                else if (t < 192) { if (!ic3) { const unsigned ln = slice * 64 + (t - 128); ub = xc3; off = (ln >> 7) * 65536u + (ln & 127) * 128u; } }
                else if (t < 208) { if (!ic3) { ub = s3p; off = (slice * 16 + (t - 192)) * 128u; } }
                if (t < 208) pf = *(const volatile unsigned*)(ub + off);
            }
            if (!isctx) {
                const float Ei = *(const float*)((const char*)(gt + row0 + 16 * w) + (unsigned)fr * 16u + 8u);
                if (nwriter) { char* np = (char*)(NC + (((size_t)(dir * 2 + bl) * 4 + h) * 64 + c) * 512); const unsigned lo = lane_ * 32u;
                    *(f32x4*)(np + lo) = (f32x4){nreg[0], nreg[1], nreg[2], nreg[3]}; *(f32x4*)(np + lo + 16u) = (f32x4){nreg[4], nreg[5], nreg[6], nreg[7]}; }
                f32x4 a2[2] = {(f32x4){0.f, 0.f, 0.f, 0.f}, (f32x4){0.f, 0.f, 0.f, 0.f}};
#pragma unroll
                for (int ks = 0; ks < 16; ++ks)
#pragma unroll
                    for (int et = 0; et < 2; ++et) a2[et] = __builtin_amdgcn_mfma_f32_16x16x32_bf16(*(const LAS bf16x8*)(cb_rd + (16 * et + fr) * 1040 + ks * 64 + fq * 16), xf[ks], a2[et], 0, 0, 0);
                asm volatile("" ::: "memory");
#pragma unroll
                for (int ks = 1; ks < 4; ++ks)
#pragma unroll
                    for (int dt = 0; dt < 4; ++dt) kf[ks][dt] = ldg16(ktu + (4 * w + dt) * 4096 + ks * 1024, l16);
                a2[0] = a2[0] * Ei; a2[1] = a2[1] * Ei;
#pragma unroll
                for (int ks = 0; ks < 4; ++ks)
#pragma unroll
                    for (int et = 0; et < 2; ++et) a2[et] = __builtin_amdgcn_mfma_f32_16x16x32_bf16(vf[et][ks], sfr[ks], a2[et], 0, 0, 0);
                char* nu = NUM + ((size_t)row0 * MI + h * 512 + e0) * 2; const unsigned ln = ((16u * w + fr) * MI + 4u * fq) * 2u;
#pragma unroll
                for (int et = 0; et < 2; ++et) *(u32x2*)(nu + et * 32 + ln) = (u32x2){pk2(a2[et][0], a2[et][1]), pk2(a2[et][2], a2[et][3])};
            } else {
#pragma unroll
                for (int ks = 1; ks < 4; ++ks)
#pragma unroll
                    for (int dt = 0; dt < 4; ++dt) kf[ks][dt] = ldg16(ktu + (4 * w + dt) * 4096 + ks * 1024, l16);
            }
            if (has2 && tid_ < 128) {
                const f32x4* gt2 = ic2 ? GTC + (size_t)(dir * 4 + h) * MC : GTL + (size_t)(dir * 4 + h) * HROWS;
                wl_wr[tid_] = *(const float*)((const char*)(gt2 + (ic2 ? gb * CTXL : bl * SEQ) + c2 * 128) + (unsigned)tid_ * 16u + 12u); }
#pragma unroll
            for (int a = 0; a < 4; ++a)
#pragma unroll
                for (int b = 0; b < 2; ++b) acc[a][b] = acc[a][b] * Gd;
#pragma unroll
            for (int ks = 0; ks < 4; ++ks) {
                bf16x8 bv[2];
#pragma unroll
                for (int et = 0; et < 2; ++et) { float v[8]; unpack8(__builtin_bit_cast(u32x4, vf[et][ks]), v);
#pragma unroll
                    for (int e = 0; e < 8; ++e) v[e] *= wl_rd[ks * 32 + 8 * fq + e];
                    const u32x4 pv = pack8(v); bv[et] = __builtin_bit_cast(bf16x8, pv); }
#pragma unroll
                for (int dt = 0; dt < 4; ++dt)
#pragma unroll
                    for (int et = 0; et < 2; ++et) acc[dt][et] = __builtin_amdgcn_mfma_f32_16x16x32_bf16(kf[ks][dt], bv[et], acc[dt][et], 0, 0, 0);
            }
            asm volatile("" ::: "memory");
            if (has2 && !ic2) {
#pragma unroll
                for (int ks = 0; ks < 16; ++ks) xf[ks] = ldg16(xc2 + ks * 1024, l16);
            }
            if (nwriter) { const unsigned lo = lane_ * 32u; const f32x4 d0 = *(const f32x4*)((const char*)dn + lo), d1 = *(const f32x4*)((const char*)dn + lo + 16u);
                nreg[0] = Gd * nreg[0] + d0[0]; nreg[1] = Gd * nreg[1] + d0[1]; nreg[2] = Gd * nreg[2] + d0[2]; nreg[3] = Gd * nreg[3] + d0[3];
                nreg[4] = Gd * nreg[4] + d1[0]; nreg[5] = Gd * nreg[5] + d1[1]; nreg[6] = Gd * nreg[6] + d1[2]; nreg[7] = Gd * nreg[7] + d1[3]; }
#pragma unroll
            for (int dt = 0; dt < 4; ++dt)
#pragma unroll
                for (int et = 0; et < 2; ++et) *(LAS u32x2*)(cb_wr + (16 * et + fr) * 1040 + (64 * w + 16 * dt + 4 * fq) * 2) = (u32x2){pk2(acc[dt][et][0], acc[dt][et][1]), pk2(acc[dt][et][2], acc[dt][et][3])};
            asm volatile("" :: "v"(pf));
            __syncthreads();
        }
    }
}

__device__ __forceinline__ void ph_mout(Fr& F) {
    bf16* NF = (bf16*)(F.ws + MS_NF); const bf16* NBk = (const bf16*)(F.ws + MS_NB); const bf16* XC = (const bf16*)(F.ws + MS_XC); const bf16* Z = (const bf16*)(F.ws + MS_Z);
    const float* NC = (const float*)(F.ws + WS_NC); const float* RS = (const float*)(F.ws + WS_RS); const f32x4* GTL = (const f32x4*)(F.ws + WS_GT_L);
    for (int it = F.gw; it < HROWS * 4; it += F.ngw) {
        const int row = it >> 2, h = it & 3, bl = row >> 13, c = (row >> 7) & 63; const size_t o = (size_t)row * MI + h * 512 + 8 * F.lane;
        float nf[8], nb[8], xc[8], z[8];
        const size_t xo = ((size_t)(row >> 4) * 64 + h * 16 + (F.lane >> 2)) * 512 + ((row & 15) + 16 * (F.lane & 3)) * 8;
        unpack8(*(const u32x4*)(NF + o), nf); unpack8(*(const u32x4*)(NBk + o), nb); unpack8(*(const u32x4*)(XC + xo), xc); unpack8(*(const u32x4*)(Z + o), z);
        const float* n0 = NC + (((size_t)(0 * 2 + bl) * 4 + h) * 64 + c) * 512 + 8 * F.lane; const float* n1 = NC + (((size_t)(1 * 2 + bl) * 4 + h) * 64 + c) * 512 + 8 * F.lane;
        const f32x4 n00 = *(const f32x4*)n0, n01 = *(const f32x4*)(n0 + 4), n10 = *(const f32x4*)n1, n11 = *(const f32x4*)(n1 + 4);
        float d0 = xc[0] * n00[0] + xc[1] * n00[1] + xc[2] * n00[2] + xc[3] * n00[3] + xc[4] * n01[0] + xc[5] * n01[1] + xc[6] * n01[2] + xc[7] * n01[3];
        float d1 = xc[0] * n10[0] + xc[1] * n10[1] + xc[2] * n10[2] + xc[3] * n10[3] + xc[4] * n11[0] + xc[5] * n11[1] + xc[6] * n11[2] + xc[7] * n11[3];
        d0 = wave_sum(d0); d1 = wave_sum(d1);
        const float den0 = GTL[(size_t)(0 * 4 + h) * HROWS + row][2] * d0 + RS[(size_t)(0 * 4 + h) * HROWS + row], den1 = GTL[(size_t)(1 * 4 + h) * HROWS + row][2] * d1 + RS[(size_t)(1 * 4 + h) * HROWS + row];
        const float i0 = 1.0f / fmaxf(fabsf(den0), 1.0f), i1 = 1.0f / fmaxf(fabsf(den1), 1.0f);
        float s = 0.f;
#pragma unroll
        for (int e = 0; e < 8; ++e) { nf[e] = nf[e] * i0 + nb[e] * i1; s += nf[e]; }
        const float mu = wave_sum(s) * (1.0f / 512.0f); float q = 0.f;
#pragma unroll
        for (int e = 0; e < 8; ++e) { nf[e] -= mu; q += nf[e] * nf[e]; }
        const float rstd = 1.0f / sqrtf(wave_sum(q) * (1.0f / 512.0f) + ML_NORM_EPS);
        const float* nw = IN(I_MNW) + h * 512 + 8 * F.lane; const float* sk = IN(I_MSKIP) + h * 512 + 8 * F.lane;
#pragma unroll
        for (int e = 0; e < 8; ++e) nf[e] = (nf[e] * rstd * nw[e] + sk[e] * xc[e]) * silu_f(z[e]);
        *(u32x4*)(NF + o) = pack8(nf);
    }
}

__device__ __forceinline__ void ph_final(Fr& F) {
    const float* g = IN(I_FINALG);
    for (int r = F.gw; r < ML; r += F.ngw) {
        f32x4* xr = (f32x4*)(F.out + (size_t)r * 1024) + F.lane; f32x4 v[4]; float s = 0.f;
#pragma unroll
        for (int j = 0; j < 4; ++j) { v[j] = xr[64 * j]; s += (v[j][0] * v[j][0] + v[j][1] * v[j][1]) + (v[j][2] * v[j][2] + v[j][3] * v[j][3]); }
        const float rinv = 1.0f / sqrtf(wave_sum(s) * (1.0f / 1024.0f) + EPS);
#pragma unroll
        for (int j = 0; j < 4; ++j) xr[64 * j] = v[j] * rinv * *(const f32x4*)(g + 4 * F.lane + 256 * j);
    }
}

template <class Epi>
__device__ __forceinline__ void run_gemm(Fr& F, const bf16* A, const bf16* Bt, int M, int N, int K, const Epi& E) {
    pg8::Gemm g{A, Bt, M, N, K}; pg8::StaticOrder S; S.init(M, N, F.G, F.bid);
    pg8::gemm_phase<Epi, pg8::StaticOrder, true, true>(F.lds, g, S, E, F.tid);
}

struct Args { const float* in[38]; float* out; unsigned char* ws; int ph_lo, ph_hi; };
static_assert(sizeof(Args) == 328 && offsetof(Args, out) == 304 && offsetof(Args, ws) == 312 && offsetof(Args, ph_lo) == 320, "Args layout");
constexpr int N_PHASES = 36;


#define XB_TMO      128
#define XB_XCNT(j)  (256  + 64 * (j))
#define XB_XSUB(j)  (1280 + 64 * (j))
#define XB_XGEN(j)  (2304 + 64 * (j))
#define XB_TOP      3328
#define XB_TOPGEN   3392
#define XCD_BAR_WORDS 3456
#define XB_SPIN_CAP (1u << 22)
__device__ __forceinline__ unsigned xb_ld(unsigned* p)              { return __hip_atomic_load(p, __ATOMIC_RELAXED, __HIP_MEMORY_SCOPE_AGENT); }
__device__ __forceinline__ unsigned xb_add(unsigned* p, unsigned v) { return __hip_atomic_fetch_add(p, v, __ATOMIC_RELAXED, __HIP_MEMORY_SCOPE_AGENT); }
__device__ __forceinline__ unsigned xb_xcc_id() { return (unsigned)__builtin_amdgcn_s_getreg((3 << 11) | 20) & 0xFu; }
#define XB_SPIN(cond, bar) do { unsigned _sp = 0; while (cond) { __builtin_amdgcn_s_sleep(1); \
    if ((++_sp & 255u) == 0u) { if (xb_ld(&(bar)[XB_TMO])) break; if (_sp > XB_SPIN_CAP) { atomicAdd(&(bar)[XB_TMO], 1u); break; } } } } while (0)
__device__ __forceinline__ void xcd_barrier_complete(unsigned* bar, unsigned x, unsigned& nloc, unsigned& nx) {
    const unsigned G = gridDim.x * gridDim.y * gridDim.z;
    unsigned sum, cnt, mine, sp = 0u;
    for (;;) {
        sum = 0u; cnt = 0u; mine = 0u;
#pragma unroll
        for (unsigned j = 0; j < 16; ++j) { const unsigned c = xb_ld(&bar[XB_XCNT(j)]); sum += c; cnt += (c > 0u) ? 1u : 0u; mine = (j == x) ? c : mine; }
        if (sum == G) break;
        __builtin_amdgcn_s_sleep(1);
        if ((++sp & 255u) == 0u) { if (xb_ld(&bar[XB_TMO])) break; if (sp > XB_SPIN_CAP) { atomicAdd(&bar[XB_TMO], 1u); break; } }
    }
    nloc = mine > 0u ? mine : 1u; nx = cnt > 0u ? cnt : 1u;
}
__device__ __forceinline__ void xcd_barrier(unsigned* bar, volatile LAS unsigned* st) {
    asm volatile("s_waitcnt vmcnt(0)" ::: "memory");
    __syncthreads();
    if (threadIdx.x == 0) {
        const unsigned x = xb_xcc_id();
        __builtin_amdgcn_s_waitcnt(0);
        unsigned nloc = st[0], nx = st[1];
        if (nloc == 0u) { xcd_barrier_complete(bar, x, nloc, nx); st[0] = nloc; st[1] = nx; }
        const unsigned old = xb_add(&bar[XB_XSUB(x)], 1u);
        const unsigned gen = old / nloc;
        if (old + 1u == (gen + 1u) * nloc) {
            __builtin_amdgcn_fence(__ATOMIC_RELEASE, "agent");
            asm volatile("s_waitcnt vmcnt(0)" ::: "memory");
            const unsigned og = xb_add(&bar[XB_TOP], 1u);
            const unsigned tg = og / nx;
            if (og + 1u == (tg + 1u) * nx) xb_add(&bar[XB_TOPGEN], 1u);
            else XB_SPIN(xb_ld(&bar[XB_TOPGEN]) == tg, bar);
            __builtin_amdgcn_fence(__ATOMIC_ACQUIRE, "agent");
            xb_add(&bar[XB_XGEN(x)], 1u);
            asm volatile("s_waitcnt vmcnt(0)" ::: "memory");
        } else {
            XB_SPIN(xb_ld(&bar[XB_XGEN(x)]) == gen, bar);
            __builtin_amdgcn_fence(__ATOMIC_ACQUIRE, "agent");
            asm volatile("s_waitcnt vmcnt(0)" ::: "memory");
        }
    }
    __syncthreads();
}
#ifndef PROBE_MASK
#define PROBE_MASK 0ull
#endif
constexpr int BAR_LDS_OFF = LDS_BYTES - 64;
constexpr size_t WS_BAR = 0;
constexpr size_t WS_TS = 64 * 1024;

template <int ph>
__device__ __forceinline__ void run_phase(Fr& F) {
    unsigned char* ws = F.ws;
    float* mod = (float*)(ws + WS_MOD); float* ctxx = (float*)(ws + WS_CTXX);
    if constexpr (ph == 0) ph_prologue(F);
    else if constexpr (ph == 1) {
            kt_items(F, (const float*)(ws + WS_H3), SEQ, (float*)(ws + HY_KT));
            kt_items(F, (const float*)(ws + WS_H3) + (size_t)SEQ * 64, CTXL, (float*)(ws + WS_KTC));
            ph_modnorm(F, IN(I_X), ML, 0, IN(I_CTX), MC, IN(I_NORMG), mod, 0, (bf16*)(ws + HY_H));
        }
    else if constexpr (ph == 2) { pg8::EpiBf16 E{(bf16*)(ws + HY_P), 3072, IN(I_HBIN), 0, 0}; run_gemm(F, (const bf16*)(ws + HY_H), (const bf16*)(ws + WS_WHIN), MALL, 3072, 1024, E); }
    else if constexpr (ph == 3) { zt_items(F, (const bf16*)(ws + HY_P), 0, NB, SEQ, (bf16*)(ws + HY_ZT)); zt_items(F, (const bf16*)(ws + HY_P), ML, NB, CTXL, (bf16*)(ws + HY_ZTC)); }
    else if constexpr (ph == 4) ph_fftconv(F);
    else if constexpr (ph == 5) { u2_items(F, (const bf16*)(ws + HY_P), 0, NB, SEQ, (const bf16*)(ws + HY_ZT), (bf16*)(ws + HY_H)); u2_items(F, (const bf16*)(ws + HY_P), ML, NB, CTXL, (const bf16*)(ws + HY_ZTC), (bf16*)(ws + HY_H)); }
    else if constexpr (ph == 6) { pg8::EpiRes E{IN(I_X), F.out, IN(I_CTX), ctxx, ML, mod + 2048, 0, IN(I_HBOUT)}; run_gemm(F, (const bf16*)(ws + HY_H), (const bf16*)(ws + WS_WHOUT), MALL, 1024, 1024, E); }
    else if constexpr (ph == 7) ph_modnorm(F, F.out, ML, 0, ctxx, MC, IN(I_NORMG) + 1024, mod, 3072, (bf16*)(ws + FF_H));
    else if constexpr (ph == 8) { pg8::EpiBf16 E{(bf16*)(ws + FF_A), FF, nullptr, FF, (FF_G - FF_A) / 2}; run_gemm(F, (const bf16*)(ws + FF_H), (const bf16*)(ws + WS_WUP0), MALL, 2 * FF, 1024, E); }
    else if constexpr (ph == 9) ph_dwconv(F, 0, ML, MC);
    else if constexpr (ph == 10) { pg8::EpiRes E{F.out, F.out, ctxx, ctxx, ML, mod + 5120, 0, nullptr}; run_gemm(F, (const bf16*)(ws + FF_A), (const bf16*)(ws + WS_WDN0), MALL, 1024, FF, E); }
    else if constexpr (ph < 31) {
            constexpr int hb = (ph - 11) / 10, k = (ph - 11) % 10; const float* mod1 = mod + 5 * 6144;
            float* xh = F.out + (size_t)hb * HROWS * 1024;
            if constexpr (k == 0) { ph_modnorm(F, xh, HROWS, 2 * hb, ctxx, 0, IN(I_NORMG) + 2048, mod1, 0, (bf16*)(ws + MS_H));
                          if (hb == 0) ph_modnorm(F, xh, 0, 0, ctxx, MC, IN(I_NORMG) + 2048, mod1, 0, (bf16*)(ws + MS_HC)); }
            else if constexpr (k == 1) { { pg8::EpiBf16T E{(bf16*)(ws + MS_XM), MI / 32}; run_gemm(F, (const bf16*)(ws + MS_H), (const bf16*)(ws + WS_WMIN), HROWS, MI, 1024, E); }
                               if (hb == 0) { pg8::EpiBf16T E{(bf16*)(ws + MS_XMC), MI / 32}; run_gemm(F, (const bf16*)(ws + MS_HC), (const bf16*)(ws + WS_WMIN), MC, MI, 1024, E); } }
            else if constexpr (k == 2) { prep_items(F, (const bf16*)(ws + MS_XM), 2, SEQ, (bf16*)(ws + MS_XC), (bf16*)(ws + MS_KN), (bf16*)(ws + MS_KT), (bf16*)(ws + MS_VT));
                               if (hb == 0) prep_items(F, (const bf16*)(ws + MS_XMC), NB, CTXL, (bf16*)(ws + MS_XCC), (bf16*)(ws + MS_XCC + 16 * MiB), (bf16*)(ws + MS_KTC), (bf16*)(ws + MS_VTC)); }
            else if constexpr (k == 3) { gate_items(F, (const bf16*)(ws + MS_XC), (const bf16*)(ws + MS_XM), HROWS, (float*)(ws + WS_GATES_L));
                               if (hb == 0) gate_items(F, (const bf16*)(ws + MS_XCC), (const bf16*)(ws + MS_XMC), MC, (float*)(ws + WS_GATES_C)); }
            else if constexpr (k == 4) { cum_items(F, (const float*)(ws + WS_GATES_L), 2, SEQ, 2 * hb, 2, (f32x4*)(ws + WS_GT_L), (float*)(ws + WS_GC));
                               if (hb == 0) cum_items(F, (const float*)(ws + WS_GATES_C), NB, CTXL, 0, 0, (f32x4*)(ws + WS_GT_C), (float*)(ws + WS_GC)); }
            else if constexpr (k == 5) ph_sphase(F, hb, hb == 0);
            else if constexpr (k == 6) ph_scan(F, hb);
            else if constexpr (k == 7) { pg8::EpiBf16 E{(bf16*)(ws + MS_Z), MI, nullptr, 0, 0}; run_gemm(F, (const bf16*)(ws + MS_H), (const bf16*)(ws + WS_WMIN) + (size_t)MI * 1024, HROWS, MI, 1024, E); }
            else if constexpr (k == 8) ph_mout(F);
            else { pg8::EpiRes E{xh, xh, ctxx, ctxx, HROWS, mod1 + 2048, 2 * hb, nullptr}; run_gemm(F, (const bf16*)(ws + MS_NF), (const bf16*)(ws + WS_WMDN), HROWS, 1024, MI, E); }
        }
    else if constexpr (ph == 31) ph_modnorm(F, F.out, ML, 0, ctxx, 0, IN(I_NORMG) + 3072, mod + 5 * 6144, 3072, (bf16*)(ws + FF_H));
    else if constexpr (ph == 32) { pg8::EpiBf16 E{(bf16*)(ws + FF_A), FF, nullptr, FF, (FF_G - FF_A) / 2}; run_gemm(F, (const bf16*)(ws + FF_H), (const bf16*)(ws + WS_WUP1), ML, 2 * FF, 1024, E); }
    else if constexpr (ph == 33) ph_dwconv(F, 1, ML, 0);
    else if constexpr (ph == 34) { pg8::EpiRes E{F.out, F.out, ctxx, ctxx, ML, mod + 5 * 6144 + 5120, 0, nullptr}; run_gemm(F, (const bf16*)(ws + FF_A), (const bf16*)(ws + WS_WDN1), ML, 1024, FF, E); }
    else ph_final(F);
}

template <int ph>
__device__ __forceinline__ void phase_step(int ph_lo, int ph_hi, unsigned char* lds_raw) {
    if (ph_lo <= ph && ph < ph_hi) {
        const __attribute__((address_space(4))) unsigned char* kp = (const __attribute__((address_space(4))) unsigned char*)__builtin_amdgcn_kernarg_segment_ptr();
        asm volatile("" : "+s"(kp));
        Fr F;
        { int t_ = threadIdx.x, g_ = gridDim.x, b_ = blockIdx.x; asm volatile("" : "+v"(t_), "+s"(g_), "+s"(b_)); F.tid = t_; F.G = g_; F.bid = b_; }
        F.lds = (LAS unsigned char*)lds_raw; F.lane = F.tid & 63; F.wave = __builtin_amdgcn_readfirstlane(F.tid >> 6);
        F.gw = F.bid * NWAVES + F.wave; F.ngw = F.G * NWAVES;
        F.in = (const __attribute__((address_space(4))) cfptr_t*)kp;
        typedef float* fptr_t; typedef unsigned char* ucptr_t;
        F.out = *(const __attribute__((address_space(4))) fptr_t*)(kp + 304); F.ws = *(const __attribute__((address_space(4))) ucptr_t*)(kp + 312);
        if (PROBE_MASK != 0ull && F.bid == 0 && F.tid == 0) ((unsigned long long*)(F.ws + WS_TS))[ph] = __builtin_amdgcn_s_memrealtime();
        run_phase<ph>(F);
        if (ph + 1 < ph_hi) {
            if (ph == 0) {
                if (F.bid == 0) for (int i = F.tid; i < XCD_BAR_WORDS; i += NTHR) __hip_atomic_store((unsigned*)(F.ws + WS_BAR) + i, 0u, __ATOMIC_RELAXED, __HIP_MEMORY_SCOPE_AGENT);
                __syncthreads(); cg::this_grid().sync();
                if (F.tid == 0) (void)xb_add((unsigned*)(F.ws + WS_BAR) + XB_XCNT(xb_xcc_id()), 1u);
            }
            else xcd_barrier((unsigned*)(F.ws + WS_BAR), (volatile LAS unsigned*)(F.lds + BAR_LDS_OFF));
        }
        if (PROBE_MASK != 0ull && ph == N_PHASES - 1 && F.bid == 0) {
            if (F.tid == 0) { unsigned long long* ts = (unsigned long long*)(F.ws + WS_TS); const unsigned long long tend = __builtin_amdgcn_s_memrealtime(); unsigned long long tot = 0ull;
                for (int k = 0; k < N_PHASES; ++k) if ((PROBE_MASK >> k) & 1ull) tot += (k + 1 < N_PHASES ? ts[k + 1] : tend) - ts[k];
                while (__builtin_amdgcn_s_memrealtime() - tend < tot) __builtin_amdgcn_s_sleep(8); }
            __syncthreads();
        }
    }
}
template <int... I>
__device__ __forceinline__ void all_phases(int ph_lo, int ph_hi, unsigned char* lds_raw, std::integer_sequence<int, I...>) { (phase_step<I>(ph_lo, ph_hi, lds_raw), ...); }

__global__ void __launch_bounds__(NTHR, 2) fwd_kernel(Args args) {
    extern __shared__ __attribute__((aligned(16))) unsigned char lds_raw[];
    int ph_lo, ph_hi;
    { const __attribute__((address_space(4))) unsigned char* kp0 = (const __attribute__((address_space(4))) unsigned char*)__builtin_amdgcn_kernarg_segment_ptr();
      ph_lo = *(const __attribute__((address_space(4))) int*)(kp0 + 320); ph_hi = *(const __attribute__((address_space(4))) int*)(kp0 + 324); }
    if (threadIdx.x < 16) ((LAS unsigned*)((LAS unsigned char*)lds_raw + BAR_LDS_OFF))[threadIdx.x] = 0u;
    __syncthreads();
    all_phases(ph_lo, ph_hi, lds_raw, std::make_integer_sequence<int, N_PHASES>{});
}

extern "C" void kernel_launch(void* const* d_in, const int* in_sizes, int n_in, void* d_out, int out_size, void* d_ws, size_t ws_size, hipStream_t stream) {
    static int grid = 0;
    if (grid == 0) {
        int dev = 0, cus = 0, per_cu = 0;
        hipGetDevice(&dev);
        hipDeviceGetAttribute(&cus, hipDeviceAttributeMultiprocessorCount, dev);
        hipFuncSetAttribute((const void*)fwd_kernel, hipFuncAttributeMaxDynamicSharedMemorySize, LDS_BYTES);
        hipOccupancyMaxActiveBlocksPerMultiprocessor(&per_cu, (const void*)fwd_kernel, NTHR, LDS_BYTES);
        if (per_cu < 1) { fprintf(stderr, "kernel_launch: occupancy query says %d blocks per CU\n", per_cu); per_cu = 1; }
        grid = cus < 256 ? cus : 256;
        if (n_in != 38 || ws_size < WS_END) fprintf(stderr, "kernel_launch: unexpected n_in %d / ws_size %zu (need %zu)\n", n_in, ws_size, (size_t)WS_END);
        (void)hipGetLastError();
    }
    (void)hipMemsetAsync(d_ws, 0, 128 * 1024, stream);
    Args a{};
    for (int i = 0; i < 38; ++i) a.in[i] = (const float*)d_in[i];
    a.out = (float*)d_out; a.ws = (unsigned char*)d_ws; a.ph_lo = 0; a.ph_hi = N_PHASES;
    void* kargs[] = {&a};
    hipError_t e = hipLaunchCooperativeKernel((const void*)fwd_kernel, dim3(grid), dim3(NTHR), kargs, LDS_BYTES, stream);
    if (e != hipSuccess) fprintf(stderr, "cooperative launch failed: %s (grid %d)\n", hipGetErrorString(e), grid);
}
```

```cpp
#include <hip/hip_runtime.h>
#include <hip/hip_cooperative_groups.h>
#include <cstdio>
#include <cstdint>
#include <cstddef>
#include <utility>
namespace cg = cooperative_groups;

#define LAS __attribute__((address_space(3)))
typedef unsigned short bf16;
typedef short bf16x8 __attribute__((ext_vector_type(8)));
typedef float f32x4 __attribute__((ext_vector_type(4)));
typedef float f32x2 __attribute__((ext_vector_type(2)));
typedef unsigned u32x4 __attribute__((ext_vector_type(4)));
typedef unsigned u32x2 __attribute__((ext_vector_type(2)));

namespace pg8 {
#define PG8_LAS __attribute__((address_space(3)))
typedef unsigned short bf16_t;
constexpr int BM = 256, BK = 64, HALF = 128, HTB = HALF * BK * 2, STAGE_BYTES = 8 * HTB, NXCD = 8, WGM = 8;
__host__ __device__ __forceinline__ int lds_byte(int r, int c) { const int st = (r >> 4) * 2 + (c >> 5), rr = r & 15, cc = c & 31, ob = rr * 64 + cc * 2; return st * 1024 + (ob ^ (((ob >> 9) & 1) << 5)); }
__host__ __device__ __forceinline__ void stage_rc(int b, int& R, int& C) { const int st = b / 1024, sb = b % 1024, swz = sb ^ (((sb >> 9) & 1) << 5); R = (st >> 1) * 16 + swz / 64; C = (st & 1) * 32 + (swz % 64) / 2; }
__host__ __device__ __forceinline__ int perm32(int rho) { const int n = rho >> 4, i = rho & 15; return 8 * (i >> 2) + 4 * n + (i & 3); }
struct Unit { int pm, pn; };
struct Gemm { const bf16_t* A; const bf16_t* Bt; int M, N, K; };
struct StaticOrder {
    int nM, nN, nwg, G, c;
    __host__ __device__ void init(int M, int N, int G_, int c_) { nM = M / BM; nN = N / BM; nwg = nM * nN; G = G_; c = c_; }
    __host__ __device__ bool next(int i, Unit& u) const {
        const long L = (long)i * G + c; if (L >= nwg) return false;
        int wgid = (int)L; { const int q = nwg / NXCD, r = nwg % NXCD, xcd = wgid % NXCD, off = wgid / NXCD; wgid = (xcd < r ? xcd * (q + 1) : r * (q + 1) + (xcd - r) * q) + off; }
        const int nig = WGM * nN, gid = wgid / nig, fm = gid * WGM, gsz = (nM - fm) < WGM ? (nM - fm) : WGM;
        u.pm = fm + ((wgid % nig) % gsz); u.pn = (wgid % nig) / gsz; return true;
    }
    __device__ __forceinline__ void a_ready(const Unit&) const {}
    __device__ __forceinline__ void done(const Unit&) const {}
};
__device__ __forceinline__ unsigned cvt_pk_bf16(float lo, float hi) { unsigned r; asm volatile("v_cvt_pk_bf16_f32 %0, %1, %2" : "=v"(r) : "v"(lo), "v"(hi)); return r; }

struct EpiBf16 {
    static constexpr bool PERM = true, AFTER_DRAIN = false;
    bf16_t* O; int ldc; const float* bias; int split_cols; size_t split_stride;
    __device__ __forceinline__ void operator()(const f32x4 (&acc)[2][2][4][2], const Unit& u, int wr, int wc, int fr, int fq) const {
        const int row0 = u.pm * BM + wr * 64 + fr; int colt = u.pn * BM; bf16_t* base = O;
        if (split_cols) { const int t = colt / split_cols; base += (size_t)t * split_stride; colt -= t * split_cols; }
        const int col0 = colt + wc * 32 + 8 * fq, bcol0 = u.pn * BM + wc * 32 + 8 * fq;
        f32x4 bv[2][2];
#pragma unroll
        for (int bj = 0; bj < 2; ++bj)
#pragma unroll
            for (int n = 0; n < 2; ++n) bv[bj][n] = bias ? *(const f32x4*)(bias + bcol0 + bj * HALF + 4 * n) : (f32x4){0.f, 0.f, 0.f, 0.f};
#pragma unroll
        for (int ai = 0; ai < 2; ++ai)
#pragma unroll
            for (int m = 0; m < 4; ++m) { bf16_t* rowp = base + (size_t)(row0 + ai * HALF + m * 16) * ldc + col0;
#pragma unroll
                for (int bj = 0; bj < 2; ++bj) { f32x4 v0 = acc[ai][bj][m][0] + bv[bj][0], v1 = acc[ai][bj][m][1] + bv[bj][1];
                    u32x4 w; w.x = cvt_pk_bf16(v0[0], v0[1]); w.y = cvt_pk_bf16(v0[2], v0[3]); w.z = cvt_pk_bf16(v1[0], v1[1]); w.w = cvt_pk_bf16(v1[2], v1[3]);
                    *(u32x4*)(rowp + bj * HALF) = w; } }
    }
};
struct EpiBf16T {
    static constexpr bool PERM = true, AFTER_DRAIN = false;
    bf16_t* O; int ntc;
    __device__ __forceinline__ void operator()(const f32x4 (&acc)[2][2][4][2], const Unit& u, int wr, int wc, int fr, int fq) const {
        bf16_t* base = O + (size_t)(fr + 16 * fq) * 8;
#pragma unroll
        for (int ai = 0; ai < 2; ++ai)
#pragma unroll
            for (int m = 0; m < 4; ++m)
#pragma unroll
                for (int bj = 0; bj < 2; ++bj) { const f32x4 v0 = acc[ai][bj][m][0], v1 = acc[ai][bj][m][1];
                    u32x4 w; w.x = cvt_pk_bf16(v0[0], v0[1]); w.y = cvt_pk_bf16(v0[2], v0[3]); w.z = cvt_pk_bf16(v1[0], v1[1]); w.w = cvt_pk_bf16(v1[2], v1[3]);
                    *(u32x4*)(base + ((size_t)(u.pm * 16 + ai * 8 + wr * 4 + m) * ntc + u.pn * 8 + bj * 4 + wc) * 512) = w; }
    }
};
struct EpiRes {
    static constexpr bool PERM = false, AFTER_DRAIN = false;
    const float* res_lat; float* out_lat; const float* res_ctx; float* out_ctx; int rows_lat; const float* gate; int b0; const float* bias;
    __device__ __forceinline__ void operator()(const f32x4 (&acc)[2][2][4][2], const Unit& u, int wr, int wc, int fr, int fq) const {
        const int trow = u.pm * BM; const float* res; float* out; int modrow;
        if (trow < rows_lat) { res = res_lat + (size_t)trow * 1024; out = out_lat + (size_t)trow * 1024; modrow = b0 + trow / 8192; }
        else { const int rc = trow - rows_lat; res = res_ctx + (size_t)rc * 1024; out = out_ctx + (size_t)rc * 1024; modrow = 4; }
        const int col0 = u.pn * BM + wc * 32 + 4 * fq; const float* gp = gate + (size_t)modrow * 6144 + col0;
#pragma unroll
        for (int bj = 0; bj < 2; ++bj)
#pragma unroll
            for (int n = 0; n < 2; ++n) {
                const f32x4 bv = bias ? *(const f32x4*)(bias + col0 + bj * HALF + n * 16) : (f32x4){0.f, 0.f, 0.f, 0.f}; const f32x4 gv = *(const f32x4*)(gp + bj * HALF + n * 16);
#pragma unroll
                for (int ai = 0; ai < 2; ++ai) {
#pragma unroll
                    for (int m = 0; m < 4; ++m) { const size_t off = (size_t)(wr * 64 + fr + ai * HALF + m * 16) * 1024 + col0 + bj * HALF + n * 16;
                        const f32x4 rs = *(const f32x4*)(res + off); *(f32x4*)(out + off) = rs + gv * (acc[ai][bj][m][n] + bv); }
                    asm volatile("" ::: "memory"); }
            }
    }
};

template <class Epi, class Sched, bool ALIGN_EPI = false, bool SP2 = false>
__device__ __forceinline__ void gemm_phase(PG8_LAS unsigned char* lds, const Gemm g, const Sched& S, const Epi& E, const int tid) {
    const int wid = __builtin_amdgcn_readfirstlane(tid >> 6), lane = tid & 63, wr = wid >> 2, wc = wid & 3, fr = lane & 15, fq = lane >> 4;
    const int K = g.K, nt = K / BK;
    unsigned voffA[2], voffB[2];
#pragma unroll
    for (int i = 0; i < 2; ++i) { int R, C; stage_rc(tid * 16 + i * 8192, R, C); const int Rb = Epi::PERM ? ((R & ~31) + perm32(R & 31)) : R;
        voffA[i] = (unsigned)(R * K + C) * 2u; voffB[i] = (unsigned)(Rb * K + C) * 2u; }
    const size_t kstep = (size_t)(BK * 2);
    const size_t hstep = (size_t)HALF * K * 2;
    const size_t tstep = 2 * hstep;
    const unsigned ldsw = (unsigned)wid * 1024u;
    const int aoff = lds_byte(wr * 64 + fr, fq * 8), boff = lds_byte(wc * 32 + fr, fq * 8);
#define PG8_SA(b, h) (((b) * 2 + (h)) * HTB)
#define PG8_SB(b, h) ((4 + (b) * 2 + (h)) * HTB)
#define PG8_STAGE(bufoff, gbase, voff) do { _Pragma("unroll") for (int _i = 0; _i < 2; ++_i) \
        __builtin_amdgcn_global_load_lds((const unsigned*)((const char*)(gbase) + (voff)[_i]), (PG8_LAS unsigned*)(lds + (bufoff) + ldsw + _i * 8192), 16, 0, 0); } while (0)
#define PG8_LDA(dst, b, h) do { _Pragma("unroll") for (int m = 0; m < 4; ++m) _Pragma("unroll") for (int k = 0; k < 2; ++k) dst[m][k] = *(const PG8_LAS bf16x8*)(lds + PG8_SA(b, h) + aoff + m * 2048 + k * 1024); } while (0)
#define PG8_LDB(dst, b, h) do { _Pragma("unroll") for (int n = 0; n < 2; ++n) _Pragma("unroll") for (int k = 0; k < 2; ++k) dst[n][k] = *(const PG8_LAS bf16x8*)(lds + PG8_SB(b, h) + boff + n * 2048 + k * 1024); } while (0)
#define PG8_MMA(ai, bj, At, Bt) do { __builtin_amdgcn_s_setprio(1); _Pragma("unroll") for (int m = 0; m < 4; ++m) _Pragma("unroll") for (int n = 0; n < 2; ++n) _Pragma("unroll") for (int k = 0; k < 2; ++k) \
        acc[ai][bj][m][n] = __builtin_amdgcn_mfma_f32_16x16x32_bf16(Bt[n][k], At[m][k], acc[ai][bj][m][n], 0, 0, 0); __builtin_amdgcn_s_setprio(0); } while (0)
#define PG8_WAIT_V(n) asm volatile("s_waitcnt vmcnt(" #n ")" ::: "memory")
#define PG8_WAIT_L(n) asm volatile("s_waitcnt lgkmcnt(" #n ")" ::: "memory")
#define PG8_BAR __builtin_amdgcn_s_barrier()
#define PG8_SCHED __builtin_amdgcn_sched_barrier(0)
    Unit cur, nxt; int ui = 0;
    if (!S.next(0, cur)) return;
    f32x4 acc[2][2][4][2];
#pragma unroll
    for (int a = 0; a < 2; ++a)
#pragma unroll
        for (int b = 0; b < 2; ++b)
#pragma unroll
            for (int m = 0; m < 4; ++m)
#pragma unroll
                for (int n = 0; n < 2; ++n) acc[a][b][m][n] = (f32x4){0.f, 0.f, 0.f, 0.f};
    bf16x8 At[4][2], B0[2][2], B1[2][2];
    const char* cA = (const char*)g.A + (size_t)cur.pm * tstep; const char* cB = (const char*)g.Bt + (size_t)cur.pn * tstep;
    S.a_ready(cur);
    if constexpr (SP2) {
        PG8_STAGE(PG8_SB(0, 0), cB, voffB); PG8_STAGE(PG8_SB(0, 1), cB + hstep, voffB); PG8_STAGE(PG8_SA(0, 0), cA, voffA); PG8_STAGE(PG8_SA(0, 1), cA + hstep, voffA);
        if (wr == 1) PG8_BAR;
        PG8_WAIT_V(2); PG8_BAR;
        PG8_STAGE(PG8_SB(1, 0), cB + kstep, voffB); PG8_STAGE(PG8_SA(1, 0), cA + kstep, voffA); PG8_STAGE(PG8_SB(1, 1), cB + hstep + kstep, voffB);
        PG8_WAIT_V(6); PG8_BAR;
    } else {
        PG8_STAGE(PG8_SB(0, 0), cB, voffB); PG8_STAGE(PG8_SA(0, 0), cA, voffA); PG8_STAGE(PG8_SB(0, 1), cB + hstep, voffB); PG8_STAGE(PG8_SA(0, 1), cA + hstep, voffA);
        if (wr == 1) PG8_BAR;
        PG8_WAIT_V(4); PG8_BAR;
        PG8_STAGE(PG8_SB(1, 0), cB + kstep, voffB); PG8_STAGE(PG8_SA(1, 0), cA + kstep, voffA); PG8_STAGE(PG8_SB(1, 1), cB + hstep + kstep, voffB);
        PG8_WAIT_V(6); PG8_BAR;
    }
    for (;;) {
        const bool has_next = S.next(ui + 1, nxt);
        const char* nA = has_next ? (const char*)g.A + (size_t)nxt.pm * tstep : cA; const char* nB = has_next ? (const char*)g.Bt + (size_t)nxt.pn * tstep : cB;
        for (int t = 0; t < nt; t += 2) {
            const bool last = (t == nt - 2);
            const char* a1 = cA + (size_t)(t + 1) * kstep;
            const char* a2 = last ? nA : cA + (size_t)(t + 2) * kstep; const char* b2 = last ? nB : cB + (size_t)(t + 2) * kstep;
            const char* a3 = a2 + kstep; const char* b3 = b2 + kstep;
            if (last && has_next) S.a_ready(nxt);
            if constexpr (SP2) {
            PG8_LDB(B0, 0, 0); PG8_LDB(B1, 0, 1); PG8_SCHED; PG8_LDA(At, 0, 0); PG8_STAGE(PG8_SA(1, 1), a1 + hstep, voffA);
            PG8_WAIT_V(8); PG8_WAIT_L(0); PG8_BAR; PG8_MMA(0, 0, At, B0); PG8_MMA(0, 1, At, B1); PG8_BAR; PG8_SCHED;
            PG8_LDA(At, 0, 1); PG8_STAGE(PG8_SB(0, 0), b2, voffB); PG8_STAGE(PG8_SB(0, 1), b2 + hstep, voffB); PG8_STAGE(PG8_SA(0, 0), a2, voffA);
            PG8_WAIT_V(8); PG8_WAIT_L(0); PG8_BAR; PG8_MMA(1, 0, At, B0); PG8_MMA(1, 1, At, B1); PG8_BAR; PG8_SCHED;
            PG8_LDB(B0, 1, 0); PG8_LDB(B1, 1, 1); PG8_SCHED; PG8_LDA(At, 1, 0); PG8_STAGE(PG8_SA(0, 1), a2 + hstep, voffA);
            PG8_WAIT_V(8); PG8_WAIT_L(0); PG8_BAR; PG8_MMA(0, 0, At, B0); PG8_MMA(0, 1, At, B1); PG8_BAR; PG8_SCHED;
            PG8_LDA(At, 1, 1); PG8_STAGE(PG8_SB(1, 0), b3, voffB); PG8_STAGE(PG8_SB(1, 1), b3 + hstep, voffB); PG8_STAGE(PG8_SA(1, 0), a3, voffA);
            PG8_WAIT_V(8); PG8_WAIT_L(0); PG8_BAR; PG8_MMA(1, 0, At, B0); PG8_MMA(1, 1, At, B1); PG8_BAR; PG8_SCHED;
            } else {
            PG8_LDB(B0, 0, 0); PG8_SCHED; PG8_LDA(At, 0, 0); PG8_STAGE(PG8_SA(1, 1), a1 + hstep, voffA);
            PG8_WAIT_L(8); PG8_BAR; PG8_WAIT_L(0); PG8_MMA(0, 0, At, B0); PG8_BAR; PG8_SCHED;
            PG8_LDB(B1, 0, 1); PG8_STAGE(PG8_SB(0, 0), b2, voffB);
            PG8_BAR; PG8_WAIT_L(0); PG8_MMA(0, 1, At, B1); PG8_BAR;
            PG8_LDA(At, 0, 1); PG8_STAGE(PG8_SA(0, 0), a2, voffA);
            PG8_BAR; PG8_WAIT_L(0); PG8_MMA(1, 0, At, B0); PG8_BAR; PG8_SCHED;
            PG8_STAGE(PG8_SB(0, 1), b2 + hstep, voffB);
            PG8_WAIT_V(6); PG8_BAR; PG8_MMA(1, 1, At, B1); PG8_BAR;
            PG8_LDB(B0, 1, 0); PG8_SCHED; PG8_LDA(At, 1, 0); PG8_STAGE(PG8_SA(0, 1), a2 + hstep, voffA);
            PG8_WAIT_L(8); PG8_BAR; PG8_WAIT_L(0); PG8_MMA(0, 0, At, B0); PG8_BAR; PG8_SCHED;
            PG8_LDB(B1, 1, 1); PG8_STAGE(PG8_SB(1, 0), b3, voffB);
            PG8_BAR; PG8_WAIT_L(0); PG8_MMA(0, 1, At, B1); PG8_BAR;
            PG8_LDA(At, 1, 1); PG8_STAGE(PG8_SA(1, 0), a3, voffA);
            PG8_BAR; PG8_WAIT_L(0); PG8_MMA(1, 0, At, B0); PG8_BAR; PG8_SCHED;
            PG8_STAGE(PG8_SB(1, 1), b3 + hstep, voffB);
            PG8_WAIT_V(6); PG8_BAR; PG8_MMA(1, 1, At, B1); PG8_BAR;
            }
        }
        if constexpr (ALIGN_EPI) { if (wr == 0) PG8_BAR; }
        if constexpr (!Epi::AFTER_DRAIN) { E(acc, cur, wr, wc, fr, fq); S.done(cur); }
        if (!has_next) break;
#pragma unroll
        for (int a = 0; a < 2; ++a)
#pragma unroll
            for (int b = 0; b < 2; ++b)
#pragma unroll
                for (int m = 0; m < 4; ++m)
#pragma unroll
                    for (int n = 0; n < 2; ++n) acc[a][b][m][n] = (f32x4){0.f, 0.f, 0.f, 0.f};
        cur = nxt; cA = nA; cB = nB; ++ui;
        if constexpr (ALIGN_EPI) { if (wr == 1) PG8_BAR; }
    }
    PG8_WAIT_V(0);
    if constexpr (!ALIGN_EPI) { if (wr == 0) PG8_BAR; }
    PG8_BAR;
#undef PG8_SA
#undef PG8_SB
#undef PG8_STAGE
#undef PG8_LDA
#undef PG8_LDB
#undef PG8_MMA
#undef PG8_WAIT_V
#undef PG8_WAIT_L
#undef PG8_BAR
#undef PG8_SCHED
}
}

constexpr int D = 1024, NB = 4, SEQ = 8192, CTXL = 256, ML = NB * SEQ, MC = NB * CTXL, MALL = ML + MC;
constexpr int FF = 2816, MI = 2048, NH = 4, DH = 512, HROWS = 2 * SEQ;
constexpr float EPS = 1e-6f, ML_NORM_EPS = 1e-5f;
constexpr float HY_MAX_DECAY = -15.350567286626973f, HY_MIN_DECAY = -3.0701134573253945f;
constexpr int NWAVES = 8, NTHR = 512;
constexpr int LDS_BYTES = 147456;

constexpr size_t MiB = 1u << 20;
constexpr size_t WS_MOD = 1 * MiB;
constexpr size_t WS_CTXX = 2 * MiB;
constexpr size_t WS_H3 = 6 * MiB;
constexpr size_t WS_KTC = 9 * MiB;
constexpr size_t WS_GWT = 11 * MiB;
constexpr size_t WS_WKQ = 11 * MiB + 256 * 1024;
constexpr size_t WS_NC = 12 * MiB;
constexpr size_t WS_WHIN = 16 * MiB, WS_WHOUT = 22 * MiB, WS_WMIN = 24 * MiB, WS_WMDN = 32 * MiB, WS_WUP0 = 36 * MiB, WS_WUP1 = 47 * MiB, WS_WDN0 = 58 * MiB, WS_WDN1 = 58 * MiB + 5767168;
constexpr size_t WS_GATES_L = 69 * MiB;
constexpr size_t WS_GATES_C = 70 * MiB;
constexpr size_t WS_GT_L = 71 * MiB;
constexpr size_t WS_GT_C = 73 * MiB;
constexpr size_t WS_GC = 73 * MiB + 512 * 1024;
constexpr size_t WS_DN = 74 * MiB;
constexpr size_t WS_RS = 79 * MiB;
constexpr size_t WS_INV = 79 * MiB + 512 * 1024;
constexpr size_t BIG = 80 * MiB;
constexpr size_t HY_H = BIG, HY_P = BIG + 66 * MiB, HY_KT = BIG + 264 * MiB, HY_ZT = BIG + 328 * MiB, HY_ZTC = BIG + 392 * MiB, HY_KS = BIG + 394 * MiB;
constexpr size_t FF_H = BIG, FF_A = BIG + 66 * MiB, FF_G = BIG + 248 * MiB;
constexpr size_t MS_H = BIG, MS_XM = BIG + 32 * MiB, MS_XC = BIG + 96 * MiB, MS_KT = BIG + 160 * MiB, MS_VT = BIG + 224 * MiB, MS_NF = BIG + 288 * MiB, MS_NB = BIG + 352 * MiB,
                 MS_KTC = BIG + 416 * MiB, MS_VTC = BIG + 420 * MiB;
constexpr size_t MS_S = MS_XM, MS_Z = MS_KT, MS_KN = MS_NF, MS_XCC = MS_NB, MS_XMC = MS_NB + 4 * MiB, MS_HC = MS_NB + 8 * MiB;
constexpr size_t WS_END = BIG + 424 * MiB;
static_assert(WS_END <= 512 * MiB, "workspace map");
static_assert(FF_G + (size_t)MALL * FF * 2 <= 512 * MiB && FF_A + (size_t)MALL * FF * 2 <= FF_G, "ffn map");
static_assert(HY_P + (size_t)MALL * 3072 * 2 <= HY_KT && HY_ZTC + (size_t)NB * D * CTXL * 2 <= HY_KS && HY_KS + 32 * MiB <= 512 * MiB, "hyena map");

__device__ __forceinline__ unsigned f2bf(float f) { unsigned u = __float_as_uint(f); return (u + 0x7fffu + ((u >> 16) & 1u)) >> 16; }
typedef __bf16 bf16x2_t __attribute__((ext_vector_type(2)));
__device__ __forceinline__ unsigned pk2(float lo, float hi) { const f32x2 v = {lo, hi}; const bf16x2_t b = __builtin_convertvector(v, bf16x2_t); return __builtin_bit_cast(unsigned, b); }
__device__ __forceinline__ float bf2f(unsigned short b) { return __uint_as_float(((unsigned)b) << 16); }
__device__ __forceinline__ float bflo(unsigned w) { return __uint_as_float(w << 16); }
__device__ __forceinline__ float bfhi(unsigned w) { return __uint_as_float(w & 0xffff0000u); }
__device__ __forceinline__ void unpack8(const u32x4 v, float (&o)[8]) { o[0] = bflo(v.x); o[1] = bfhi(v.x); o[2] = bflo(v.y); o[3] = bfhi(v.y); o[4] = bflo(v.z); o[5] = bfhi(v.z); o[6] = bflo(v.w); o[7] = bfhi(v.w); }
__device__ __forceinline__ u32x4 pack8(const float (&o)[8]) { u32x4 v; v.x = pk2(o[0], o[1]); v.y = pk2(o[2], o[3]); v.z = pk2(o[4], o[5]); v.w = pk2(o[6], o[7]); return v; }
__device__ __forceinline__ float wave_sum(float v) {
#pragma unroll
    for (int o = 1; o < 64; o <<= 1) v += __shfl_xor(v, o);
    return v;
}
__device__ __forceinline__ float silu_f(float x) { return x / (1.0f + __expf(-x)); }

typedef const float* cfptr_t;
struct Fr {
    LAS unsigned char* lds; int tid, lane, wave, gw, ngw, G, bid;
    const __attribute__((address_space(4))) cfptr_t* in; float* out; unsigned char* ws;
};
#define IN(i) (F.in[i])
enum { I_X = 0, I_C, I_CTX, I_CCTX, I_MODW, I_MODB, I_NORMG, I_FINALG, I_HWIN, I_HBIN, I_HSCW, I_HSCB, I_FW1, I_FB1, I_FW2, I_FB2, I_FW3, I_FB3, I_FWOUT, I_FREQ, I_HBIAS, I_HWOUT, I_HBOUT,
       I_MWIN, I_MCW, I_MCB, I_MWQ, I_MWK, I_MWV, I_MWG, I_MBG, I_MNW, I_MSKIP, I_MWDN, I_FWUP, I_FCW, I_FCB, I_FWDN };

__device__ __forceinline__ void transpose_item(const float* W, int K, int N, bf16* WT, LAS float* scr, int item, int lane) {
    const int nblk = N / 32, kb = item / nblk, nb = item % nblk, k0 = 64 * kb, n0 = 32 * nb;
    float tv[32];
#pragma unroll
    for (int i = 0; i < 32; ++i) tv[i] = W[(size_t)(k0 + 2 * i + (lane >> 5)) * N + n0 + (lane & 31)];
#pragma unroll
    for (int i = 0; i < 32; ++i) scr[(2 * i + (lane >> 5)) * 33 + (lane & 31)] = tv[i];
    asm volatile("s_waitcnt lgkmcnt(0)" ::: "memory");
    const int c = lane & 7;
#pragma unroll
    for (int j = 0; j < 4; ++j) { const int n = (lane >> 3) + 8 * j; const LAS float* s = scr + (8 * c) * 33 + n;
        u32x4 o; o.x = pk2(s[0 * 33], s[1 * 33]); o.y = pk2(s[2 * 33], s[3 * 33]); o.z = pk2(s[4 * 33], s[5 * 33]); o.w = pk2(s[6 * 33], s[7 * 33]);
        *(u32x4*)(WT + (size_t)(n0 + n) * K + k0 + 8 * c) = o; }
    asm volatile("s_waitcnt lgkmcnt(0)" ::: "memory");
}
__device__ __forceinline__ void transpose_matrix(Fr& F, const float* W, int K, int N, bf16* WT) {
    LAS float* scr = (LAS float*)(F.lds + F.wave * 16384);
    const int nitems = (K / 64) * (N / 32);
    for (int it = F.gw; it < nitems; it += F.ngw) transpose_item(W, K, N, WT, scr, it, F.lane);
}

__device__ __forceinline__ void ph_prologue(Fr& F) {
    unsigned char* ws = F.ws;
    {
        LAS float* scr = (LAS float*)(F.lds + F.wave * 16384);
        constexpr int I0 = (D / 64) * (3 * D / 32), I1 = (D / 64) * (D / 32), I2 = (D / 64) * (2 * MI / 32), I3 = (MI / 64) * (D / 32), I4 = (D / 64) * (2 * FF / 32), I5 = (FF / 64) * (D / 32);
        constexpr int NIT = I0 + I1 + I2 + I3 + 2 * I4 + 2 * I5;
        for (int it = F.gw; it < NIT; it += F.ngw) {
            int r = it;
            if (r < I0) { transpose_item(IN(I_HWIN), D, 3 * D, (bf16*)(ws + WS_WHIN), scr, r, F.lane); continue; } r -= I0;
            if (r < I1) { transpose_item(IN(I_HWOUT), D, D, (bf16*)(ws + WS_WHOUT), scr, r, F.lane); continue; } r -= I1;
            if (r < I2) { transpose_item(IN(I_MWIN), D, 2 * MI, (bf16*)(ws + WS_WMIN), scr, r, F.lane); continue; } r -= I2;
            if (r < I3) { transpose_item(IN(I_MWDN), MI, D, (bf16*)(ws + WS_WMDN), scr, r, F.lane); continue; } r -= I3;
            if (r < I4) { transpose_item(IN(I_FWUP), D, 2 * FF, (bf16*)(ws + WS_WUP0), scr, r, F.lane); continue; } r -= I4;
            if (r < I4) { transpose_item(IN(I_FWUP) + (size_t)D * 2 * FF, D, 2 * FF, (bf16*)(ws + WS_WUP1), scr, r, F.lane); continue; } r -= I4;
            if (r < I5) { transpose_item(IN(I_FWDN), FF, D, (bf16*)(ws + WS_WDN0), scr, r, F.lane); continue; } r -= I5;
            transpose_item(IN(I_FWDN) + (size_t)FF * D, FF, D, (bf16*)(ws + WS_WDN1), scr, r, F.lane);
        }
    }
    __syncthreads();
    {
        LAS float* sc = (LAS float*)F.lds;
        LAS float* red = (LAS float*)(F.lds + 32768);
        for (int i = F.tid; i < 5 * 1024; i += NTHR) { const int r = i >> 10, k = i & 1023; const float v = r < 4 ? IN(I_C)[r * 1024 + k] : IN(I_CCTX)[k]; sc[i] = silu_f(v); }
        __syncthreads();
        float* mod = (float*)(ws + WS_MOD);
        for (int it = F.bid; it < 192; it += F.G) {
            const int l = it / 96, n0 = (it % 96) * 64;
            const float* w = IN(I_MODW) + (size_t)l * 1024 * 6144 + n0 + F.lane;
            float a0 = 0.f, a1 = 0.f, a2 = 0.f, a3 = 0.f, a4 = 0.f;
            const int kb = F.wave * 128;
#pragma unroll 16
            for (int k = 0; k < 128; ++k) { const float wv = w[(size_t)(kb + k) * 6144];
                a0 += sc[kb + k] * wv; a1 += sc[1024 + kb + k] * wv; a2 += sc[2048 + kb + k] * wv; a3 += sc[3072 + kb + k] * wv; a4 += sc[4096 + kb + k] * wv; }
            red[(F.wave * 5 + 0) * 64 + F.lane] = a0; red[(F.wave * 5 + 1) * 64 + F.lane] = a1; red[(F.wave * 5 + 2) * 64 + F.lane] = a2; red[(F.wave * 5 + 3) * 64 + F.lane] = a3; red[(F.wave * 5 + 4) * 64 + F.lane] = a4;
            __syncthreads();
            if (F.tid < 320) { const int r = F.tid >> 6, ln = F.tid & 63; float s = 0.f;
#pragma unroll
                for (int w8 = 0; w8 < 8; ++w8) s += red[(w8 * 5 + r) * 64 + ln];
                mod[((size_t)l * 5 + r) * 6144 + n0 + ln] = s + IN(I_MODB)[l * 6144 + n0 + ln]; }
            __syncthreads();
        }
    }
    {
        float* h3 = (float*)(ws + WS_H3);
        const float* w1 = IN(I_FW1); const float* w2 = IN(I_FW2); const float* w3 = IN(I_FW3);
        const float fr = IN(I_FREQ)[F.lane], b1 = IN(I_FB1)[F.lane], b2 = IN(I_FB2)[F.lane], b3 = IN(I_FB3)[F.lane];
        for (int row = F.gw; row < SEQ + CTXL; row += F.ngw) {
            const int L = row < SEQ ? SEQ : CTXL, i = row < SEQ ? row : row - SEQ;
            const float tl = (float)i / (float)(L - 1), w = 6.283185307179586f * (float)i / (float)L;
            float pos = 0.f; const int k = F.lane;
            if (k == 0) pos = tl;
            else if (k <= 16) { const float band = 1e-4f + (float)(k - 1) * ((15.0f - 1e-4f) / 15.0f); pos = cosf(band * w); }
            else if (k <= 32) { const float band = 1e-4f + (float)(k - 17) * ((15.0f - 1e-4f) / 15.0f); pos = -sinf(band * w); }
            float s = b1;
#pragma unroll
            for (int kk = 0; kk < 33; ++kk) s += __shfl(pos, kk) * w1[kk * 64 + F.lane];
            float h = sinf(fr * s);
            s = b2;
#pragma unroll 16
            for (int kk = 0; kk < 64; ++kk) s += __shfl(h, kk) * w2[kk * 64 + F.lane];
            h = sinf(fr * s);
            s = b3;
#pragma unroll 16
            for (int kk = 0; kk < 64; ++kk) s += __shfl(h, kk) * w3[kk * 64 + F.lane];
            h = sinf(fr * s);
            h3[(size_t)row * 64 + F.lane] = h;
        }
    }
    {
        bf16* gwt = (bf16*)(ws + WS_GWT); float* wkq = (float*)(ws + WS_WKQ);
        const float* wq = IN(I_MWQ); const float* wk = IN(I_MWK); const float* wv = IN(I_MWV); const float* wg = IN(I_MWG);
        const int gt = F.bid * NTHR + F.tid, nt = F.G * NTHR;
        for (int i = gt; i < MI * 16; i += nt) { const int ch = i >> 4, g = i & 15, n = ch >> 2, c = ch & 3; float sa = 0.f, sb = 0.f;
#pragma unroll
            for (int e = 0; e < 4; ++e) { sa += wq[n * 16 + c * 4 + e] * wg[(size_t)(n * 4 + e) * 16 + g] + wk[n * 16 + c * 4 + e] * wg[(size_t)(MI + n * 4 + e) * 16 + g];
                sb += wv[n * 16 + c * 4 + e] * wg[(size_t)(2 * MI + n * 4 + e) * 16 + g]; }
            const size_t go = ((size_t)(ch >> 5) * 64 + g + 16 * ((ch & 31) >> 3)) * 8 + (ch & 7);
            gwt[go] = (bf16)f2bf(sa); gwt[go + 64 * 512] = (bf16)f2bf(sb); }
        const float sc = 0.044194173824159216f;
        for (int i = gt; i < 512 * 16; i += nt) { const int n = i >> 4, c = (i >> 2) & 3, c2 = i & 3; float s = 0.f;
#pragma unroll
            for (int e = 0; e < 4; ++e) s += wk[n * 16 + c * 4 + e] * wq[n * 16 + c2 * 4 + e];
            wkq[i] = s * sc; }
    }
}

__device__ __forceinline__ void kt_items(Fr& F, const float* h3rows, int L, float* KT) {
    const float* wout = IN(I_FWOUT);
    const int nitems = (L / 16) * 32, fr = F.lane & 15, fq = F.lane >> 4;
    for (int it = F.gw; it < nitems; it += F.ngw) {
        const int t0 = (it >> 5) * 16, n0 = (it & 31) * 64;
        float a[16];
#pragma unroll
        for (int ks = 0; ks < 16; ++ks) a[ks] = h3rows[(size_t)(t0 + fr) * 64 + 4 * ks + fq];
#pragma unroll
        for (int nt = 0; nt < 4; ++nt) {
            f32x4 acc = (f32x4){0.f, 0.f, 0.f, 0.f};
#pragma unroll
            for (int ks = 0; ks < 16; ++ks) acc = __builtin_amdgcn_mfma_f32_16x16x4f32(a[ks], wout[(size_t)(4 * ks + fq) * 2048 + n0 + nt * 16 + fr], acc, 0, 0, 0);
            const int n = n0 + nt * 16 + fr, dirn = n >> 10, c = n & 1023;
            const float delta = fabsf(HY_MIN_DECAY + (float)c * ((HY_MAX_DECAY - HY_MIN_DECAY) / 1023.0f)), il = 1.0f / (float)(L - 1);
            f32x4 o;
#pragma unroll
            for (int r = 0; r < 4; ++r) o[r] = acc[r] * __expf(-(float)(t0 + 4 * fq + r) * il * delta);
            *(f32x4*)(KT + ((size_t)c * 2 + dirn) * L + t0 + 4 * fq) = o;
        }
    }
}

__device__ __forceinline__ void modnorm_row(const float* xrow, const float* g, const float* sh, const float* sc, bf16* orow, int lane) {
    const f32x4* xr = (const f32x4*)xrow + lane; f32x4 v[4]; float s = 0.f;
#pragma unroll
    for (int j = 0; j < 4; ++j) { v[j] = xr[64 * j]; s += (v[j][0] * v[j][0] + v[j][1] * v[j][1]) + (v[j][2] * v[j][2] + v[j][3] * v[j][3]); }
    const float rinv = 1.0f / sqrtf(wave_sum(s) * (1.0f / 1024.0f) + EPS);
    u32x2* o8 = (u32x2*)orow + lane;
#pragma unroll
    for (int j = 0; j < 4; ++j) { const int c = 4 * lane + 256 * j; const f32x4 gg = *(const f32x4*)(g + c), s1 = *(const f32x4*)(sc + c), s0 = *(const f32x4*)(sh + c);
        const f32x4 y = (v[j] * rinv * gg) * (1.0f + s1) + s0; u32x2 w; w.x = pk2(y[0], y[1]); w.y = pk2(y[2], y[3]); o8[64 * j] = w; }
}
__device__ __forceinline__ void ph_modnorm(Fr& F, const float* xlat, int nlat, int b0, const float* xctx, int nctx, const float* g, const float* modl, int shoff, bf16* H) {
    const int nrows = nlat + nctx;
    for (int r = F.gw; r < nrows; r += 2 * F.ngw) {
        const int r2 = r + F.ngw; const bool has2 = r2 < nrows; const int rb = has2 ? r2 : r;
        const bool isl = r < nlat, isl2 = rb < nlat;
        const float* xa = isl ? xlat + (size_t)r * 1024 : xctx + (size_t)(r - nlat) * 1024; const float* xb = isl2 ? xlat + (size_t)rb * 1024 : xctx + (size_t)(rb - nlat) * 1024;
        const int ma = isl ? b0 + r / SEQ : 4, mb = isl2 ? b0 + rb / SEQ : 4;
        const f32x4* pa = (const f32x4*)xa + F.lane; const f32x4* pb = (const f32x4*)xb + F.lane; f32x4 va[4], vb[4]; float sa = 0.f, sb = 0.f;
#pragma unroll
        for (int j = 0; j < 4; ++j) { va[j] = pa[64 * j]; vb[j] = pb[64 * j]; }
#pragma unroll
        for (int j = 0; j < 4; ++j) { sa += (va[j][0] * va[j][0] + va[j][1] * va[j][1]) + (va[j][2] * va[j][2] + va[j][3] * va[j][3]); sb += (vb[j][0] * vb[j][0] + vb[j][1] * vb[j][1]) + (vb[j][2] * vb[j][2] + vb[j][3] * vb[j][3]); }
        const float ra = 1.0f / sqrtf(wave_sum(sa) * (1.0f / 1024.0f) + EPS), rbv = 1.0f / sqrtf(wave_sum(sb) * (1.0f / 1024.0f) + EPS);
        const float* sha = modl + (size_t)ma * 6144 + shoff; const float* shb = modl + (size_t)mb * 6144 + shoff;
        u32x2* oa = (u32x2*)(H + (size_t)r * 1024) + F.lane; u32x2* ob = (u32x2*)(H + (size_t)rb * 1024) + F.lane;
#pragma unroll
        for (int j = 0; j < 4; ++j) { const int c = 4 * F.lane + 256 * j; const f32x4 gg = *(const f32x4*)(g + c);
            const f32x4 ya = (va[j] * ra * gg) * (1.0f + *(const f32x4*)(sha + 1024 + c)) + *(const f32x4*)(sha + c);
            const f32x4 yb = (vb[j] * rbv * gg) * (1.0f + *(const f32x4*)(shb + 1024 + c)) + *(const f32x4*)(shb + c);
            oa[64 * j] = (u32x2){pk2(ya[0], ya[1]), pk2(ya[2], ya[3])};
            if (has2) ob[64 * j] = (u32x2){pk2(yb[0], yb[1]), pk2(yb[2], yb[3])}; }
    }
}

__device__ __forceinline__ void zt_items(Fr& F, const bf16* P, int rowbase, int nb, int Ls, bf16* ZT) {
    LAS unsigned char* tile = F.lds + F.wave * 16384;
    const float* scw = IN(I_HSCW); const float* scb = IN(I_HSCB);
    const int ntt = Ls / 64, nitems = nb * ntt * 16, tl = F.lane >> 3, c8 = F.lane & 7;
    for (int it = F.gw; it < nitems; it += F.ngw) {
        const int ct = it & 15, tt = (it >> 4) % ntt, b = (it >> 4) / ntt, t0 = tt * 64, ch = ct * 64 + c8 * 8;
        float w1[3][8], w2[3][8], b1[8], b2[8];
#pragma unroll
        for (int k = 0; k < 3; ++k) { const f32x4 a0 = *(const f32x4*)(scw + k * 3072 + 1024 + ch), a1 = *(const f32x4*)(scw + k * 3072 + 1024 + ch + 4), d0 = *(const f32x4*)(scw + k * 3072 + 2048 + ch), d1 = *(const f32x4*)(scw + k * 3072 + 2048 + ch + 4);
#pragma unroll
            for (int e = 0; e < 4; ++e) { w1[k][e] = a0[e]; w1[k][4 + e] = a1[e]; w2[k][e] = d0[e]; w2[k][4 + e] = d1[e]; } }
        { const f32x4 a0 = *(const f32x4*)(scb + 1024 + ch), a1 = *(const f32x4*)(scb + 1024 + ch + 4), d0 = *(const f32x4*)(scb + 2048 + ch), d1 = *(const f32x4*)(scb + 2048 + ch + 4);
#pragma unroll
            for (int e = 0; e < 4; ++e) { b1[e] = a0[e]; b1[4 + e] = a1[e]; b2[e] = d0[e]; b2[4 + e] = d1[e]; } }
        const bf16* pb = P + (size_t)(rowbase + b * Ls) * 3072 + ch;
#pragma unroll 2
        for (int i8 = 0; i8 < 8; ++i8) {
            const int tloc = i8 * 8 + tl, t = t0 + tloc, tm = t > 0 ? t - 1 : t, tp = t + 1 < Ls ? t + 1 : t; const float mm = t > 0 ? 1.f : 0.f, mp = t + 1 < Ls ? 1.f : 0.f;
            const u32x4 r1m = *(const u32x4*)(pb + (size_t)tm * 3072 + 1024), r1c = *(const u32x4*)(pb + (size_t)t * 3072 + 1024), r1p = *(const u32x4*)(pb + (size_t)tp * 3072 + 1024);
            const u32x4 r2m = *(const u32x4*)(pb + (size_t)tm * 3072 + 2048), r2c = *(const u32x4*)(pb + (size_t)t * 3072 + 2048), r2p = *(const u32x4*)(pb + (size_t)tp * 3072 + 2048);
            float xm[8], xc[8], xp[8], vm[8], vc[8], vp[8];
            unpack8(r1m, xm); unpack8(r1c, xc); unpack8(r1p, xp); unpack8(r2m, vm); unpack8(r2c, vc); unpack8(r2p, vp);
#pragma unroll
            for (int e = 0; e < 8; ++e) { const float a = w1[0][e] * (xm[e] * mm) + w1[1][e] * xc[e] + w1[2][e] * (xp[e] * mp) + b1[e], d = w2[0][e] * (vm[e] * mm) + w2[1][e] * vc[e] + w2[2][e] * (vp[e] * mp) + b2[e];
                *(LAS bf16*)(tile + (c8 * 8 + e) * 136 + tloc * 2) = (bf16)f2bf(a * d); }
        }
#pragma unroll
        for (int q = 0; q < 8; ++q) { const int cc = q * 8 + (F.lane >> 3), chk = F.lane & 7;
            const u32x2 lo = *(const LAS u32x2*)(tile + cc * 136 + chk * 16), hi = *(const LAS u32x2*)(tile + cc * 136 + chk * 16 + 8);
            u32x4 o; o.x = lo.x; o.y = lo.y; o.z = hi.x; o.w = hi.y;
            *(u32x4*)(ZT + ((size_t)b * 1024 + ct * 64 + cc) * Ls + t0 + chk * 8) = o; }
    }
}

__device__ __forceinline__ f32x2 cmul(f32x2 a, f32x2 b) { return (f32x2){a.x * b.x - a.y * b.y, a.x * b.y + a.y * b.x}; }
__device__ __forceinline__ f32x2 cmulc(f32x2 a, f32x2 b) { return (f32x2){a.x * b.x + a.y * b.y, a.y * b.x - a.x * b.y}; }
__device__ __forceinline__ f32x2 twid(float f) { return (f32x2){__builtin_amdgcn_cosf(f), __builtin_amdgcn_sinf(f)}; }
#define PH(e) ((e) + ((e) >> 4))
__device__ __forceinline__ void fft_fwd(LAS f32x2* buf, int tid, int plo, int phi) {
#pragma unroll 1
    for (int p = plo; p < phi; ++p) {
        const int lq = 12 - 2 * p, q = 1 << lq; const float invN = 1.0f / (float)(4 * q);
#pragma unroll 2
        for (int m = 0; m < 8; ++m) {
            const int g = tid + 512 * m, i = g & (q - 1), i0 = ((g >> lq) << (lq + 2)) + i;
            const int e0 = PH(i0), e1 = PH(i0 + q), e2 = PH(i0 + 2 * q), e3 = PH(i0 + 3 * q);
            const f32x2 a0 = buf[e0], a1 = buf[e1], a2 = buf[e2], a3 = buf[e3];
            const f32x2 t0 = a0 + a2, t1 = a0 - a2, t2 = a1 + a3, d = a1 - a3, t3 = (f32x2){d.y, -d.x};
            const f32x2 w1 = twid(-(float)i * invN), w2 = cmul(w1, w1), w3 = cmul(w2, w1);
            buf[e0] = t0 + t2; buf[e1] = cmul(t1 + t3, w1); buf[e2] = cmul(t0 - t2, w2); buf[e3] = cmul(t1 - t3, w3);
        }
        __syncthreads();
    }
}
__device__ __forceinline__ void fft_inv(LAS f32x2* buf, int tid, int plo, int phi) {
#pragma unroll 1
    for (int p = phi - 1; p >= plo; --p) {
        const int lq = 12 - 2 * p, q = 1 << lq; const float invN = 1.0f / (float)(4 * q);
#pragma unroll 2
        for (int m = 0; m < 8; ++m) {
            const int g = tid + 512 * m, i = g & (q - 1), i0 = ((g >> lq) << (lq + 2)) + i;
            const int e0 = PH(i0), e1 = PH(i0 + q), e2 = PH(i0 + 2 * q), e3 = PH(i0 + 3 * q);
            const f32x2 w1 = twid((float)i * invN), w2 = cmul(w1, w1), w3 = cmul(w2, w1);
            const f32x2 b0 = buf[e0], b1 = cmul(buf[e1], w1), b2 = cmul(buf[e2], w2), b3 = cmul(buf[e3], w3);
            const f32x2 t0 = b0 + b2, t1 = b0 - b2, t2 = b1 + b3, d = b1 - b3, t3 = (f32x2){-d.y, d.x};
            buf[e0] = t0 + t2; buf[e1] = t1 + t3; buf[e2] = t0 - t2; buf[e3] = t1 - t3;
        }
        __syncthreads();
    }
}
__device__ __forceinline__ void fwd16(f32x2 (&x)[16]) {
    const float C1 = 0.92387953251128674f, S1 = 0.38268343236508977f, R2 = 0.70710678118654752f;
#pragma unroll
    for (int i = 0; i < 4; ++i) {
        const f32x2 a0 = x[i], a1 = x[i + 4], a2 = x[i + 8], a3 = x[i + 12];
        const f32x2 t0 = a0 + a2, t1 = a0 - a2, t2 = a1 + a3, d = a1 - a3, t3 = (f32x2){d.y, -d.x};
        const f32x2 y1 = t1 + t3, y2 = t0 - t2, y3 = t1 - t3;
        x[i] = t0 + t2;
        if (i == 0) { x[4] = y1; x[8] = y2; x[12] = y3; }
        else if (i == 1) { x[5] = cmul(y1, (f32x2){C1, -S1}); x[9] = cmul(y2, (f32x2){R2, -R2}); x[13] = cmul(y3, (f32x2){S1, -C1}); }
        else if (i == 2) { x[6] = cmul(y1, (f32x2){R2, -R2}); x[10] = (f32x2){y2.y, -y2.x}; x[14] = cmul(y3, (f32x2){-R2, -R2}); }
        else { x[7] = cmul(y1, (f32x2){S1, -C1}); x[11] = cmul(y2, (f32x2){-R2, -R2}); x[15] = cmul(y3, (f32x2){-C1, S1}); }
    }
#pragma unroll
    for (int g = 0; g < 4; ++g) {
        const f32x2 a0 = x[4 * g], a1 = x[4 * g + 1], a2 = x[4 * g + 2], a3 = x[4 * g + 3];
        const f32x2 t0 = a0 + a2, t1 = a0 - a2, t2 = a1 + a3, d = a1 - a3, t3 = (f32x2){d.y, -d.x};
        x[4 * g] = t0 + t2; x[4 * g + 1] = t1 + t3; x[4 * g + 2] = t0 - t2; x[4 * g + 3] = t1 - t3;
    }
}
__device__ __forceinline__ void inv16(f32x2 (&x)[16]) {
    const float C1 = 0.92387953251128674f, S1 = 0.38268343236508977f, R2 = 0.70710678118654752f;
#pragma unroll
    for (int g = 0; g < 4; ++g) {
        const f32x2 b0 = x[4 * g], b1 = x[4 * g + 1], b2 = x[4 * g + 2], b3 = x[4 * g + 3];
        const f32x2 t0 = b0 + b2, t1 = b0 - b2, t2 = b1 + b3, d = b1 - b3, t3 = (f32x2){-d.y, d.x};
        x[4 * g] = t0 + t2; x[4 * g + 1] = t1 + t3; x[4 * g + 2] = t0 - t2; x[4 * g + 3] = t1 - t3;
    }
#pragma unroll
    for (int i = 0; i < 4; ++i) {
        f32x2 b0 = x[i], b1 = x[i + 4], b2 = x[i + 8], b3 = x[i + 12];
        if (i == 1) { b1 = cmul(b1, (f32x2){C1, S1}); b2 = cmul(b2, (f32x2){R2, R2}); b3 = cmul(b3, (f32x2){S1, C1}); }
        else if (i == 2) { b1 = cmul(b1, (f32x2){R2, R2}); b2 = (f32x2){-b2.y, b2.x}; b3 = cmul(b3, (f32x2){-R2, R2}); }
        else if (i == 3) { b1 = cmul(b1, (f32x2){S1, C1}); b2 = cmul(b2, (f32x2){-R2, R2}); b3 = cmul(b3, (f32x2){-C1, -S1}); }
        const f32x2 t0 = b0 + b2, t1 = b0 - b2, t2 = b1 + b3, d = b1 - b3, t3 = (f32x2){-d.y, d.x};
        x[i] = t0 + t2; x[i + 4] = t1 + t3; x[i + 8] = t0 - t2; x[i + 12] = t1 - t3;
    }
}
__device__ __forceinline__ float block_sum(Fr& F, float v, LAS float* red) {
    v = wave_sum(v);
    __syncthreads();
    if (F.lane == 0) red[F.wave] = v;
    __syncthreads();
    float s = 0.f;
#pragma unroll
    for (int w = 0; w < 8; ++w) s += red[w];
    return s;
}
__device__ __forceinline__ void ph_fftconv(Fr& F) {
    LAS f32x2* buf = (LAS f32x2*)F.lds; LAS float* red = (LAS float*)(F.lds + 139392);
    const float* KT = (const float*)(F.ws + HY_KT); const float* KTC = (const float*)(F.ws + WS_KTC);
    bf16* ZT = (bf16*)(F.ws + HY_ZT); bf16* ZTC = (bf16*)(F.ws + HY_ZTC);
    const int tid = F.tid;
    for (int c = F.bid; c < 1024; c += F.G) {
        const float bias = IN(I_HBIAS)[c];
        __syncthreads();
        float asum = 0.f;
        const f32x4* kf = (const f32x4*)(KT + (size_t)c * 2 * SEQ); const f32x4* kb = kf + SEQ / 4;
#pragma unroll
        for (int q = 0; q < 4; ++q) { const int i4 = tid + 512 * q; const f32x4 v = kf[i4];
            asum += fabsf(v[0]) + fabsf(v[1]) + fabsf(v[2]) + fabsf(v[3]);
            buf[PH(4 * i4)] = (f32x2){v[0], 0.f}; buf[PH(4 * i4 + 1)] = (f32x2){v[1], 0.f}; buf[PH(4 * i4 + 2)] = (f32x2){v[2], 0.f}; buf[PH(4 * i4 + 3)] = (f32x2){v[3], 0.f};
            const f32x4 u = kb[i4]; const int m = 4 * i4;
            if (m > 0) { buf[PH(16384 - m)] = (f32x2){u[0], 0.f}; asum += fabsf(u[0]); } else buf[PH(8192)] = (f32x2){0.f, 0.f};
            buf[PH(16384 - m - 1)] = (f32x2){u[1], 0.f}; buf[PH(16384 - m - 2)] = (f32x2){u[2], 0.f}; buf[PH(16384 - m - 3)] = (f32x2){u[3], 0.f};
            asum += fabsf(u[1]) + fabsf(u[2]) + fabsf(u[3]); }
        const float S = block_sum(F, asum, red);
        __syncthreads();
        fft_fwd(buf, tid, 0, 5);
        f32x4* Ks = (f32x4*)(F.ws + HY_KS) + (size_t)(F.bid & 255) * 8192 + tid * 8; const float ksc = 1.0f / (S * 16384.0f);
#pragma unroll 1
        for (int m = 0; m < 2; ++m) { const int pb = 17 * (tid + 512 * m); f32x2 x[16];
#pragma unroll
            for (int n = 0; n < 16; ++n) x[n] = buf[pb + n];
            fwd16(x);
#pragma unroll
            for (int n = 0; n < 8; ++n) Ks[m * 4096 + n] = (f32x4){x[2 * n].x * ksc, x[2 * n].y * ksc, x[2 * n + 1].x * ksc, x[2 * n + 1].y * ksc}; }
        const f32x2 dl = twid(-1.0f / 16384.0f);
#pragma unroll 1
        for (int pr = 0; pr < 2; ++pr) {
            bf16* z0 = ZT + ((size_t)(2 * pr) * 1024 + c) * SEQ; bf16* z1 = ZT + ((size_t)(2 * pr + 1) * 1024 + c) * SEQ;
            const int i8 = tid * 8;
            __syncthreads();
            {
                float a[8], b[8], cx[8], dx[8];
                unpack8(*(const u32x4*)(z0 + i8), a); unpack8(*(const u32x4*)(z1 + i8), b); unpack8(*(const u32x4*)(z0 + 4096 + i8), cx); unpack8(*(const u32x4*)(z1 + 4096 + i8), dx);
                f32x2 w1 = twid(-(float)i8 * (1.0f / 16384.0f));
#pragma unroll
                for (int e = 0; e < 8; ++e) { const f32x2 a0 = (f32x2){a[e], b[e]}, a1 = (f32x2){cx[e], dx[e]}, t3 = (f32x2){a1.y, -a1.x}; const f32x2 w2 = cmul(w1, w1), w3 = cmul(w2, w1);
                    buf[PH(i8 + e)] = a0 + a1; buf[PH(4096 + i8 + e)] = cmul(a0 + t3, w1); buf[PH(8192 + i8 + e)] = cmul(a0 - a1, w2); buf[PH(12288 + i8 + e)] = cmul(a0 - t3, w3);
                    w1 = cmul(w1, dl); }
            }
            __syncthreads();
            fft_fwd(buf, tid, 1, 5);
#pragma unroll 1
            for (int m = 0; m < 2; ++m) { const int pb = 17 * (tid + 512 * m); f32x2 x[16];
#pragma unroll
                for (int n = 0; n < 16; ++n) x[n] = buf[pb + n];
                fwd16(x);
#pragma unroll
                for (int n = 0; n < 8; ++n) { const f32x4 k = Ks[m * 4096 + n]; x[2 * n] = cmul(x[2 * n], (f32x2){k[0], k[1]}); x[2 * n + 1] = cmul(x[2 * n + 1], (f32x2){k[2], k[3]}); }
                inv16(x);
#pragma unroll
                for (int n = 0; n < 16; ++n) buf[pb + n] = x[n]; }
            __syncthreads();
            fft_inv(buf, tid, 1, 5);
            {
                float a[8], b[8], cx[8], dx[8];
                unpack8(*(const u32x4*)(z0 + i8), a); unpack8(*(const u32x4*)(z1 + i8), b); unpack8(*(const u32x4*)(z0 + 4096 + i8), cx); unpack8(*(const u32x4*)(z1 + 4096 + i8), dx);
                f32x2 w1 = twid(-(float)i8 * (1.0f / 16384.0f));
#pragma unroll
                for (int e = 0; e < 8; ++e) { const f32x2 w2 = cmul(w1, w1), w3 = cmul(w2, w1);
                    const f32x2 b0 = buf[PH(i8 + e)], b1 = cmulc(buf[PH(4096 + i8 + e)], w1), b2 = cmulc(buf[PH(8192 + i8 + e)], w2), b3 = cmulc(buf[PH(12288 + i8 + e)], w3);
                    const f32x2 t0 = b0 + b2, t1 = b0 - b2, t2 = b1 + b3, d = b1 - b3, t3 = (f32x2){-d.y, d.x};
                    const f32x2 y0 = t0 + t2, y1 = t1 + t3;
                    a[e] = y0.x + a[e] * bias; b[e] = y0.y + b[e] * bias; cx[e] = y1.x + cx[e] * bias; dx[e] = y1.y + dx[e] * bias;
                    w1 = cmul(w1, dl); }
                *(u32x4*)(z0 + i8) = pack8(a); *(u32x4*)(z1 + i8) = pack8(b); *(u32x4*)(z0 + 4096 + i8) = pack8(cx); *(u32x4*)(z1 + 4096 + i8) = pack8(dx);
            }
        }
        __syncthreads();
        {
            LAS float* kc = (LAS float*)F.lds; LAS float* zc = kc + 512;
            const float* kfc = KTC + (size_t)c * 2 * CTXL; float v = 0.f;
            { const int n = tid; if (n < 256) v = kfc[n]; else if (n == 256) v = 0.f; else v = kfc[CTXL + (512 - n)]; kc[n] = v; }
            const float Sc = block_sum(F, fabsf(v), red);
            for (int i = tid; i < 1024; i += NTHR) { const int b = i >> 8, t = i & 255; zc[i] = bf2f(ZTC[((size_t)b * 1024 + c) * CTXL + t]); }
            __syncthreads();
            const int b = tid >> 7, t2 = tid & 127; const float isc = 1.0f / Sc;
#pragma unroll
            for (int hh = 0; hh < 2; ++hh) { const int t = t2 + 128 * hh; float acc = 0.f;
#pragma unroll 8
                for (int s = 0; s < 256; ++s) acc += zc[b * 256 + s] * kc[(t - s) & 511];
                ZTC[((size_t)b * 1024 + c) * CTXL + t] = (bf16)f2bf(acc * isc + zc[b * 256 + t] * bias); }
        }
    }
}

__device__ __forceinline__ void u2_items(Fr& F, const bf16* P, int rowbase, int nb, int Ls, const bf16* YT, bf16* U2) {
    LAS unsigned char* tile = F.lds + F.wave * 16384;
    const float* scw = IN(I_HSCW); const float* scb = IN(I_HSCB);
    const int ntt = Ls / 64, nitems = nb * ntt * 16, tl = F.lane >> 3, c8 = F.lane & 7;
    for (int it = F.gw; it < nitems; it += F.ngw) {
        const int ct = it & 15, tt = (it >> 4) % ntt, b = (it >> 4) / ntt, t0 = tt * 64, ch = ct * 64 + c8 * 8;
#pragma unroll
        for (int q = 0; q < 8; ++q) { const int cc = q * 8 + (F.lane >> 3), chk = F.lane & 7;
            const u32x4 v = *(const u32x4*)(YT + ((size_t)b * 1024 + ct * 64 + cc) * Ls + t0 + chk * 8);
            *(LAS u32x2*)(tile + cc * 136 + chk * 16) = (u32x2){v.x, v.y}; *(LAS u32x2*)(tile + cc * 136 + chk * 16 + 8) = (u32x2){v.z, v.w}; }
        float w0[3][8], bb[8];
#pragma unroll
        for (int k = 0; k < 3; ++k) { const f32x4 a0 = *(const f32x4*)(scw + k * 3072 + ch), a1 = *(const f32x4*)(scw + k * 3072 + ch + 4);
#pragma unroll
            for (int e = 0; e < 4; ++e) { w0[k][e] = a0[e]; w0[k][4 + e] = a1[e]; } }
        { const f32x4 a0 = *(const f32x4*)(scb + ch), a1 = *(const f32x4*)(scb + ch + 4);
#pragma unroll
            for (int e = 0; e < 4; ++e) { bb[e] = a0[e]; bb[4 + e] = a1[e]; } }
        const bf16* pb = P + (size_t)(rowbase + b * Ls) * 3072 + ch; bf16* ub = U2 + (size_t)(rowbase + b * Ls) * 1024 + ch;
#pragma unroll 2
        for (int i8 = 0; i8 < 8; ++i8) {
            const int tloc = i8 * 8 + tl, t = t0 + tloc, tm = t > 0 ? t - 1 : t, tp = t + 1 < Ls ? t + 1 : t; const float mm = t > 0 ? 1.f : 0.f, mp = t + 1 < Ls ? 1.f : 0.f;
            const u32x4 rm = *(const u32x4*)(pb + (size_t)tm * 3072), rc = *(const u32x4*)(pb + (size_t)t * 3072), rp = *(const u32x4*)(pb + (size_t)tp * 3072);
            float xm[8], xc[8], xp[8], o[8];
            unpack8(rm, xm); unpack8(rc, xc); unpack8(rp, xp);
#pragma unroll
            for (int e = 0; e < 8; ++e) { const float x0 = w0[0][e] * (xm[e] * mm) + w0[1][e] * xc[e] + w0[2][e] * (xp[e] * mp) + bb[e]; o[e] = x0 * bf2f(*(const LAS bf16*)(tile + (c8 * 8 + e) * 136 + tloc * 2)); }
            *(u32x4*)(ub + (size_t)t * 1024) = pack8(o);
        }
    }
}

__device__ __forceinline__ void dw_item(const bf16* G, bf16* A, const float* cw, const float* cb, int f8, int rowtok0, int nx, int x0, bool up_ok, bool down_ok) {
    float w[9][8], bias[8];
#pragma unroll
    for (int k = 0; k < 9; ++k) { const float m = (k < 3) ? (up_ok ? 1.f : 0.f) : ((k >= 6) ? (down_ok ? 1.f : 0.f) : 1.f);
        const f32x4 w0 = *(const f32x4*)(cw + (size_t)k * FF + f8) * m, w1 = *(const f32x4*)(cw + (size_t)k * FF + f8 + 4) * m;
        w[k][0] = w0[0]; w[k][1] = w0[1]; w[k][2] = w0[2]; w[k][3] = w0[3]; w[k][4] = w1[0]; w[k][5] = w1[1]; w[k][6] = w1[2]; w[k][7] = w1[3]; }
    { const f32x4 b0 = *(const f32x4*)(cb + f8), b1 = *(const f32x4*)(cb + f8 + 4); bias[0] = b0[0]; bias[1] = b0[1]; bias[2] = b0[2]; bias[3] = b0[3]; bias[4] = b1[0]; bias[5] = b1[1]; bias[6] = b1[2]; bias[7] = b1[3]; }
    const int upo = up_ok ? -nx : 0, dno = down_ok ? nx : 0;
    const bf16* g0 = G + (size_t)rowtok0 * FF + f8; bf16* a0 = A + (size_t)rowtok0 * FF + f8;
    const u32x4 zero4 = (u32x4){0u, 0u, 0u, 0u};
    u32x4 cm[3], cc[3], cp[3];
    { const int xm = x0 > 0 ? x0 - 1 : 0; const bool okm = x0 > 0;
        cm[0] = *(const u32x4*)(g0 + (size_t)(xm + upo) * FF); cm[1] = *(const u32x4*)(g0 + (size_t)xm * FF); cm[2] = *(const u32x4*)(g0 + (size_t)(xm + dno) * FF);
        if (!okm) { cm[0] = zero4; cm[1] = zero4; cm[2] = zero4; }
        cc[0] = *(const u32x4*)(g0 + (size_t)(x0 + upo) * FF); cc[1] = *(const u32x4*)(g0 + (size_t)x0 * FF); cc[2] = *(const u32x4*)(g0 + (size_t)(x0 + dno) * FF); }
#pragma unroll 4
    for (int j = 0; j < 32; ++j) {
        const int x = x0 + j, xp = x + 1 < nx ? x + 1 : nx - 1; const bool okp = x + 1 < nx;
        cp[0] = *(const u32x4*)(g0 + (size_t)(xp + upo) * FF); cp[1] = *(const u32x4*)(g0 + (size_t)xp * FF); cp[2] = *(const u32x4*)(g0 + (size_t)(xp + dno) * FF);
        const u32x4 av = *(const u32x4*)(a0 + (size_t)x * FF);
        if (!okp) { cp[0] = zero4; cp[1] = zero4; cp[2] = zero4; }
        float acc[8];
#pragma unroll
        for (int e = 0; e < 8; ++e) acc[e] = bias[e];
#pragma unroll
        for (int dy = 0; dy < 3; ++dy) { float v[8];
            unpack8(cm[dy], v);
#pragma unroll
            for (int e = 0; e < 8; ++e) acc[e] += v[e] * w[dy * 3 + 0][e];
            unpack8(cc[dy], v);
#pragma unroll
            for (int e = 0; e < 8; ++e) acc[e] += v[e] * w[dy * 3 + 1][e];
            unpack8(cp[dy], v);
#pragma unroll
            for (int e = 0; e < 8; ++e) acc[e] += v[e] * w[dy * 3 + 2][e]; }
        float a[8]; unpack8(av, a);
#pragma unroll
        for (int e = 0; e < 8; ++e) a[e] = silu_f(acc[e]) * a[e];
        *(u32x4*)(a0 + (size_t)x * FF) = pack8(a);
#pragma unroll
        for (int dy = 0; dy < 3; ++dy) { cm[dy] = cc[dy]; cc[dy] = cp[dy]; }
    }
}
__device__ __forceinline__ void ph_dwconv(Fr& F, int layer, int nlat, int nctx) {
    bf16* A = (bf16*)(F.ws + FF_A); const bf16* G = (const bf16*)(F.ws + FF_G);
    const float* cw = IN(I_FCW) + (size_t)layer * 9 * FF; const float* cb = IN(I_FCB) + (size_t)layer * FF;
    const int ngrp = (F.G % 8 == 0) ? 8 : 1, xg = F.bid % ngrp, lb = F.bid / ngrp, nlb = F.G / ngrp;
    const int nseg = nlat / 32, band = nseg / ngrp;
    for (int i = lb * NTHR + F.tid; i < band * 352; i += nlb * NTHR) {
        const int sl = i / 352, f8 = (i - sl * 352) * 8, seg = xg * band + sl, grow = seg >> 1, gy = grow & 127;
        dw_item(G, A, cw, cb, f8, grow * 64, 64, (seg & 1) * 32, gy > 0, gy < 127);
    }
    const int nsegc = nctx / 32;
    for (int i = F.bid * NTHR + F.tid; i < nsegc * 352; i += F.G * NTHR) {
        const int sl = i / 352, f8 = (i - sl * 352) * 8;
        dw_item(G, A, cw, cb, f8, nlat + (sl >> 3) * CTXL, CTXL, (sl & 7) * 32, false, false);
    }
}

__device__ __forceinline__ void prep_items(Fr& F, const bf16* XM, int nb, int Ls, bf16* XC, bf16* KN, bf16* KT, bf16* VT) {
    LAS unsigned char* tk = F.lds + F.wave * 17408; LAS unsigned char* tv = tk + 8704;
    const int ntt = Ls / 64, nitems = nb * ntt * 32;
    const int tl = F.lane >> 3, c8 = F.lane & 7;
    for (int it = F.gw; it < nitems; it += F.ngw) {
        const int cg = it & 31, tt = (it >> 5) % ntt, b = (it >> 5) / ntt, t0 = tt * 64, ch0 = cg * 64 + c8 * 8, h = cg >> 3;
        float cw0[8], cw1[8], cw2[8], cbb[8], wkq[32], wv[32];
        { const float* p = IN(I_MCW) + ch0; const float* pb = IN(I_MCB) + ch0;
#pragma unroll
            for (int e = 0; e < 8; ++e) { cw0[e] = p[e]; cw1[e] = p[MI + e]; cw2[e] = p[2 * MI + e]; cbb[e] = pb[e]; }
            const float* q = (const float*)(F.ws + WS_WKQ) + (ch0 >> 2) * 16; const float* v = IN(I_MWV) + (ch0 >> 2) * 16;
#pragma unroll
            for (int e = 0; e < 32; ++e) { wkq[e] = q[e]; wv[e] = v[e]; } }
#pragma unroll 2
        for (int i8 = 0; i8 < 8; ++i8) {
            const int tloc = i8 * 8 + tl, t = t0 + tloc; const size_t row = (size_t)b * Ls + t;
            float xp[8], xm[8], xn[8];
            const size_t rowp = row - (t > 0 ? 1 : 0), rown = row + (t + 1 < Ls ? 1 : 0); const size_t ctile = (size_t)(ch0 >> 5) * 512 + ((ch0 & 31) >> 3) * 128;
            const u32x4 rm = *(const u32x4*)(XM + (row >> 4) * 32768 + ctile + (row & 15) * 8), rp = *(const u32x4*)(XM + (rowp >> 4) * 32768 + ctile + (rowp & 15) * 8), rn = *(const u32x4*)(XM + (rown >> 4) * 32768 + ctile + (rown & 15) * 8);
            unpack8(rm, xm); unpack8(rp, xp); unpack8(rn, xn);
            { const float mp = t > 0 ? 1.f : 0.f, mn = t + 1 < Ls ? 1.f : 0.f;
#pragma unroll
                for (int e = 0; e < 8; ++e) { xp[e] *= mp; xn[e] *= mn; } }
            float xc[8], kp[8], vv[8];
#pragma unroll
            for (int e = 0; e < 8; ++e) xc[e] = silu_f(cw0[e] * xp[e] + cw1[e] * xm[e] + cw2[e] * xn[e] + cbb[e]);
#pragma unroll
            for (int n = 0; n < 2; ++n)
#pragma unroll
                for (int o = 0; o < 4; ++o) { float sk = 0.f, sv = 0.f;
#pragma unroll
                    for (int c = 0; c < 4; ++c) { sk += xc[n * 4 + c] * wkq[n * 16 + c * 4 + o]; sv += xm[n * 4 + c] * wv[n * 16 + c * 4 + o]; }
                    kp[n * 4 + o] = sk; vv[n * 4 + o] = sv; }
            { const size_t to = ((size_t)(row >> 4) * 64 + (ch0 >> 5)) * 512 + (((unsigned)row & 15u) + 16u * ((ch0 & 31) >> 3)) * 8u;
              *(u32x4*)(XC + to) = pack8(xc); *(u32x4*)(KN + to) = pack8(kp); }
#pragma unroll
            for (int e = 0; e < 8; ++e) { *(LAS bf16*)(tk + (c8 * 8 + e) * 136 + tloc * 2) = (bf16)f2bf(kp[e]); *(LAS bf16*)(tv + (c8 * 8 + e) * 136 + tloc * 2) = (bf16)f2bf(vv[e]); }
        }
#pragma unroll
        for (int q = 0; q < 8; ++q) { const int dt = q >> 1, kq = q & 1, r = F.lane & 15, q4 = F.lane >> 4;
            const size_t tile = ((size_t)(t0 >> 7) * 32 + (cg & 7) * 4 + dt) * 4 + ((t0 & 127) >> 5) + kq;
            const size_t o = (size_t)(b * 4 + h) * 512 * Ls + tile * 512 + F.lane * 8;
            { const u32x2 lo = *(const LAS u32x2*)(tk + (dt * 16 + r) * 136 + kq * 64 + q4 * 16), hi = *(const LAS u32x2*)(tk + (dt * 16 + r) * 136 + kq * 64 + q4 * 16 + 8); *(u32x4*)(KT + o) = (u32x4){lo.x, lo.y, hi.x, hi.y}; }
            { const u32x2 lo = *(const LAS u32x2*)(tv + (dt * 16 + r) * 136 + kq * 64 + q4 * 16), hi = *(const LAS u32x2*)(tv + (dt * 16 + r) * 136 + kq * 64 + q4 * 16 + 8); *(u32x4*)(VT + o) = (u32x4){lo.x, lo.y, hi.x, hi.y}; }
        }
    }
}

__device__ __forceinline__ void gate_items(Fr& F, const bf16* XC, const bf16* XM, int R, float* GATES) {
    const bf16* gwt = (const bf16*)(F.ws + WS_GWT);
    const int fr = F.lane & 15, fq = F.lane >> 4, half = F.wave & 1, pr = F.wave >> 1, ntiles = R / 16;
    LAS f32x4* xch = (LAS f32x4*)(F.lds + pr * 1024);
    for (int base = F.bid * 4; base < ntiles; base += F.G * 4) {
        const int tile = base + pr; const bool ok = tile < ntiles; const int tl = ok ? tile : 0;
        f32x4 acc = (f32x4){0.f, 0.f, 0.f, 0.f};
        const bf16* ap = (half ? XM : XC) + (size_t)tl * 32768 + F.lane * 8; const bf16* bp = gwt + (size_t)half * 64 * 512 + F.lane * 8;
#pragma unroll 16
        for (int ks = 0; ks < 64; ++ks) acc = __builtin_amdgcn_mfma_f32_16x16x32_bf16(*(const bf16x8*)(ap + ks * 512), *(const bf16x8*)(bp + ks * 512), acc, 0, 0, 0);
        __syncthreads();
        if (half) xch[F.lane] = acc;
        __syncthreads();
        if (!half && ok) { acc = acc + xch[F.lane];
            const int r0 = tile * 16; const float bg = IN(I_MBG)[fr]; const bool isf = (fr >> 2) & 1;
#pragma unroll
            for (int r = 0; r < 4; ++r) { float x = acc[r] + bg; if (isf) x = fminf(x, 0.f) - log1pf(__expf(-fabsf(x))); GATES[(size_t)(r0 + 4 * fq + r) * 16 + fr] = x; } }
    }
}

__device__ __forceinline__ void cum_items(Fr& F, const float* GATES, int nb, int Ls, int gb0, int ctau0, f32x4* GT, float* GC) {
    const int R = nb * Ls, nch = Ls / 128, nitems = 2 * nb * 4 * nch;
    for (int it = F.gw; it < nitems; it += F.ngw) {
        const int c = it % nch, h = (it / nch) & 3, b = (it / nch / 4) % nb, dir = it / nch / 4 / nb;
        const int row0 = b * Ls + c * 128 + 2 * F.lane;
        const float lf0 = GATES[(size_t)row0 * 16 + dir * 8 + 4 + h], lf1 = GATES[(size_t)(row0 + 1) * 16 + dir * 8 + 4 + h];
        const float ig0 = GATES[(size_t)row0 * 16 + dir * 8 + h], ig1 = GATES[(size_t)(row0 + 1) * 16 + dir * 8 + h];
        float inc = lf0 + lf1;
#pragma unroll
        for (int o = 1; o < 64; o <<= 1) { const float t = __shfl_up(inc, o); if (F.lane >= o) inc += t; }
        const float tot = __shfl(inc, 63), exc = inc - (lf0 + lf1);
        float b0, b1;
        if (dir == 0) { b0 = exc + lf0; b1 = inc; } else { b0 = tot - exc; b1 = tot - exc - lf0; }
        GT[(size_t)(dir * 4 + h) * R + row0] = (f32x4){b0, ig0 - b0, __expf(b0), __expf(tot - b0 + ig0)};
        GT[(size_t)(dir * 4 + h) * R + row0 + 1] = (f32x4){b1, ig1 - b1, __expf(b1), __expf(tot - b1 + ig1)};
        if (F.lane == 0) GC[((size_t)(dir * 4 + gb0 + b) * 4 + h) * 66 + ctau0 + c] = __expf(tot);
    }
}

__device__ __forceinline__ void dn_item(Fr& F, const bf16* KTchunk, const f32x4* GTd0, const f32x4* GTd1, int row0, float* DN0, float* DN1) {
    LAS float* wl = (LAS float*)(F.lds + 1024);
    __syncthreads();
    if (F.tid < 128) wl[F.tid] = GTd0[row0 + F.tid][3]; else if (F.tid < 256) wl[F.tid] = GTd1[row0 + F.tid - 128][3];
    __syncthreads();
    const bf16* kr = KTchunk + (size_t)(F.tid >> 4) * 4 * 512 + (F.tid & 15) * 8; float s0 = 0.f, s1 = 0.f;
#pragma unroll 4
    for (int q = 0; q < 16; ++q) { const int ks = q >> 2, q4 = q & 3; float v[8]; unpack8(*(const u32x4*)(kr + ks * 512 + q4 * 128), v);
#pragma unroll
        for (int e = 0; e < 8; ++e) { s0 += v[e] * wl[q * 8 + e]; s1 += v[e] * wl[128 + q * 8 + e]; } }
    DN0[F.tid] = s0; DN1[F.tid] = s1;
}
__device__ __forceinline__ void ph_sphase(Fr& F, int hb, bool with_ctx) {
    const bf16* XC = (const bf16*)(F.ws + MS_XC); const bf16* KN = (const bf16*)(F.ws + MS_KN); const bf16* KT = (const bf16*)(F.ws + MS_KT);
    const f32x4* GT = (const f32x4*)(F.ws + WS_GT_L); float* DN = (float*)(F.ws + WS_DN); float* RS = (float*)(F.ws + WS_RS);
    bf16* S = (bf16*)(F.ws + MS_S);
    const int fr = F.lane & 15, fq = F.lane >> 4, w = F.wave;
    for (int it = F.bid; it < 512; it += F.G) {
        const int c = it & 63, h = (it >> 6) & 3, bl = it >> 8, gb = 2 * hb + bl;
        const int row0 = bl * SEQ + c * 128;
        dn_item(F, KT + (size_t)(bl * 4 + h) * 512 * SEQ + (size_t)c * 65536, GT + (size_t)(0 * 4 + h) * HROWS, GT + (size_t)(1 * 4 + h) * HROWS, row0,
                DN + (((size_t)(0 * 4 + gb) * 4 + h) * 66 + 2 + c) * 512, DN + (((size_t)(1 * 4 + gb) * 4 + h) * 66 + 2 + c) * 512);
        const int irow = row0 + 16 * w + fr;
        bf16x8 bq[16];
        { const bf16* p = XC + ((size_t)((row0 >> 4) + w) * 64 + h * 16) * 512 + F.lane * 8;
#pragma unroll
            for (int ks = 0; ks < 16; ++ks) bq[ks] = *(const bf16x8*)(p + ks * 512); }
        const f32x4 gf = GT[(size_t)(0 * 4 + h) * HROWS + irow], gbk = GT[(size_t)(1 * 4 + h) * HROWS + irow];
        float rsf = 0.f, rsb = 0.f;
        bf16* sf = S + ((size_t)(0 * 8 + bl * 4 + h) * 64 + c) * 16384; bf16* sb = S + ((size_t)(1 * 8 + bl * 4 + h) * 64 + c) * 16384;
#pragma unroll 1
        for (int jt = 0; jt < 8; ++jt) {
            f32x4 acc = (f32x4){0.f, 0.f, 0.f, 0.f};
            const bf16* ap = KN + ((size_t)((row0 >> 4) + jt) * 64 + h * 16) * 512 + F.lane * 8;
#pragma unroll
            for (int ks = 0; ks < 16; ++ks) acc = __builtin_amdgcn_mfma_f32_16x16x32_bf16(*(const bf16x8*)(ap + ks * 512), bq[ks], acc, 0, 0, 0);
            float vf[4], vb[4];
            const f32x4* gj0 = GT + (size_t)(0 * 4 + h) * HROWS + row0 + jt * 16 + 4 * fq; const f32x4* gj1 = GT + (size_t)(1 * 4 + h) * HROWS + row0 + jt * 16 + 4 * fq;
#pragma unroll
            for (int r = 0; r < 4; ++r) { const int j = jt * 16 + 4 * fq + r, i = 16 * w + fr;
                const float af = gj0[r][1], ab = gj1[r][1];
                vf[r] = (j <= i) ? acc[r] * __expf(gf[0] + af) : 0.f; vb[r] = (j >= i) ? acc[r] * __expf(gbk[0] + ab) : 0.f;
                rsf += vf[r]; rsb += vb[r]; }
            const size_t so = (size_t)(w * 4 + (jt >> 1)) * 512 + (fr + 16 * ((jt & 1) * 2 + (fq >> 1))) * 8 + (fq & 1) * 4;
            *(u32x2*)(sf + so) = (u32x2){pk2(vf[0], vf[1]), pk2(vf[2], vf[3])};
            *(u32x2*)(sb + so) = (u32x2){pk2(vb[0], vb[1]), pk2(vb[2], vb[3])};
        }
        rsf += __shfl_xor(rsf, 16); rsf += __shfl_xor(rsf, 32); rsb += __shfl_xor(rsb, 16); rsb += __shfl_xor(rsb, 32);
        if (fq == 0) { RS[(size_t)(0 * 4 + h) * HROWS + irow] = rsf; RS[(size_t)(1 * 4 + h) * HROWS + irow] = rsb; }
    }
    if (with_ctx) {
        const bf16* KTC2 = (const bf16*)(F.ws + MS_KTC); const f32x4* GTC = (const f32x4*)(F.ws + WS_GT_C);
        for (int it = F.bid; it < 32; it += F.G) {
            const int cc = it & 1, h = (it >> 1) & 3, gb = it >> 3;
            dn_item(F, KTC2 + (size_t)(gb * 4 + h) * 512 * CTXL + (size_t)cc * 65536, GTC + (size_t)(0 * 4 + h) * MC, GTC + (size_t)(1 * 4 + h) * MC, gb * CTXL + cc * 128,
                    DN + (((size_t)(0 * 4 + gb) * 4 + h) * 66 + cc) * 512, DN + (((size_t)(1 * 4 + gb) * 4 + h) * 66 + cc) * 512);
        }
    }
}

__device__ __forceinline__ bf16x8 ldg16(const char* ub, unsigned off) { return *(const bf16x8*)(ub + off); }
__device__ __forceinline__ void ph_scan(Fr& F, int hb) {
    const char* XC = (const char*)(F.ws + MS_XC); const char* KT = (const char*)(F.ws + MS_KT); const char* VT = (const char*)(F.ws + MS_VT);
    const char* KTC2 = (const char*)(F.ws + MS_KTC); const char* VTC2 = (const char*)(F.ws + MS_VTC);
    const char* S = (const char*)(F.ws + MS_S);
    const f32x4* GTL = (const f32x4*)(F.ws + WS_GT_L); const f32x4* GTC = (const f32x4*)(F.ws + WS_GT_C);
    const float* GC = (const float*)(F.ws + WS_GC); const float* DN = (const float*)(F.ws + WS_DN);
    float* NC = (float*)(F.ws + WS_NC);
    LAS unsigned char* cbf = F.lds;
    LAS float* wl = (LAS float*)(F.lds + 2 * 33280);
    const int w = F.wave;
    for (int wi = F.bid; wi < 256; wi += F.G) {
        const int chain = wi & 15, slice = wi >> 4, dir = chain >> 3, bl = (chain >> 2) & 1, h = chain & 3, gb = 2 * hb + bl, e0 = slice * 32;
        char* NUM = (char*)(F.ws + (dir ? MS_NB : MS_NF));
        const bool nwriter = (slice == 0) && (w == 0);
        f32x4 acc[4][2];
#pragma unroll
        for (int a = 0; a < 4; ++a)
#pragma unroll
            for (int b = 0; b < 2; ++b) acc[a][b] = (f32x4){0.f, 0.f, 0.f, 0.f};
        float nreg[8];
#pragma unroll
        for (int e = 0; e < 8; ++e) nreg[e] = 0.f;
        __syncthreads();
        { const int ctau = dir == 0 ? 0 : 1; const f32x4* gt = GTC + (size_t)(dir * 4 + h) * MC; if (F.tid < 128) wl[F.tid] = gt[gb * CTXL + ctau * 128 + F.tid][3]; }
        __syncthreads();
        const char* ktc = KTC2 + (size_t)(gb * 4 + h) * 512 * CTXL * 2; const char* vtc = VTC2 + (size_t)(gb * 4 + h) * 512 * CTXL * 2;
        const char* ktl = KT + (size_t)(bl * 4 + h) * 512 * SEQ * 2;    const char* vtl = VT + (size_t)(bl * 4 + h) * 512 * SEQ * 2;
        bf16x8 xf[16];
#pragma unroll
        for (int ks = 0; ks < 16; ++ks) xf[ks] = (bf16x8){0, 0, 0, 0, 0, 0, 0, 0};
#pragma unroll 1
        for (int s = 0; s < 66; ++s) {
            int tid_ = F.tid; asm volatile("" : "+v"(tid_));
            const int lane_ = tid_ & 63, fr = lane_ & 15, fq = lane_ >> 4; const unsigned l16 = lane_ * 16u;
            const int ctau = dir == 0 ? s : (s < 2 ? 1 - s : 67 - s);
            const bool isctx = ctau < 2; const int c = isctx ? ctau : ctau - 2;
            const char* ktu = (isctx ? ktc : ktl) + (size_t)c * 131072;
            const int row0 = isctx ? gb * CTXL + c * 128 : bl * SEQ + c * 128;
            const f32x4* gt = isctx ? GTC + (size_t)(dir * 4 + h) * MC : GTL + (size_t)(dir * 4 + h) * HROWS;
            const float Gd = GC[((size_t)(dir * 4 + gb) * 4 + h) * 66 + ctau];
            const float* dn = DN + (((size_t)(dir * 4 + gb) * 4 + h) * 66 + ctau) * 512;
            LAS unsigned char* cb_rd = cbf + (s & 1) * 33280; LAS unsigned char* cb_wr = cbf + ((s + 1) & 1) * 33280;
            const LAS float* wl_rd = wl + (s & 1) * 128; LAS float* wl_wr = wl + ((s + 1) & 1) * 128;
            const int s2 = s + 1, ct2 = dir == 0 ? s2 : (s2 < 2 ? 1 - s2 : 67 - s2); const bool has2 = s2 < 66, ic2 = ct2 < 2; const int c2 = ic2 ? ct2 : ct2 - 2;
            const char* xc2 = XC + ((size_t)(((bl * SEQ + c2 * 128) >> 4) + w) * 64 + h * 16) * 1024;
            const char* vtu = (isctx ? vtc : vtl) + (size_t)c * 131072;
            bf16x8 kf[4][4], vf[2][4], sfr[4];
#pragma unroll
            for (int et = 0; et < 2; ++et)
#pragma unroll
                for (int ks = 0; ks < 4; ++ks) vf[et][ks] = ldg16(vtu + ((e0 >> 4) + et) * 4096 + ks * 1024, l16);
            if (!isctx) { const char* su = S + ((size_t)(dir * 8 + bl * 4 + h) * 64 + c) * 32768 + w * 4096;
#pragma unroll
                for (int ks = 0; ks < 4; ++ks) sfr[ks] = ldg16(su + ks * 1024, l16); }
#pragma unroll
            for (int ks = 0; ks < 1; ++ks)
#pragma unroll
                for (int dt = 0; dt < 4; ++dt) kf[ks][dt] = ldg16(ktu + (4 * w + dt) * 4096 + ks * 1024, l16);
            unsigned pf = 0u; const int s3 = s + 2;
            if (s3 < 66) {
                const int ct3 = dir == 0 ? s3 : (s3 < 2 ? 1 - s3 : 67 - s3); const bool ic3 = ct3 < 2; const int c3 = ic3 ? ct3 : ct3 - 2;
                const char* kt3 = (ic3 ? ktc : ktl) + (size_t)c3 * 131072; const char* vt3 = (ic3 ? vtc : vtl) + (size_t)c3 * 131072;
                const char* xc3 = XC + ((size_t)((bl * SEQ + c3 * 128) >> 4) * 64 + h * 16) * 1024; const char* s3p = S + ((size_t)(dir * 8 + bl * 4 + h) * 64 + c3) * 32768;
                const unsigned t = tid_; const char* ub = kt3; unsigned off = 0u;
                if (t < 64) { off = (slice * 64 + t) * 128u; }
                else if (t < 128) { ub = vt3; off = (e0 >> 4) * 4096u + (t - 64) * 128u; }
                else if (t < 192) { if (!ic3) { const unsigned ln = slice * 64 + (t - 128); ub = xc3; off = (ln >> 7) * 65536u + (ln & 127) * 128u; } }
                else if (t < 208) { if (!ic3) { ub = s3p; off = (slice * 16 + (t - 192)) * 128u; } }
                if (t < 208) pf = *(const volatile unsigned*)(ub + off);
            }
            if (!isctx) {
                const float Ei = *(const float*)((const char*)(gt + row0 + 16 * w) + (unsigned)fr * 16u + 8u);
                if (nwriter) { char* np = (char*)(NC + (((size_t)(dir * 2 + bl) * 4 + h) * 64 + c) * 512); const unsigned lo = lane_ * 32u;
                    *(f32x4*)(np + lo) = (f32x4){nreg[0], nreg[1], nreg[2], nreg[3]}; *(f32x4*)(np + lo + 16u) = (f32x4){nreg[4], nreg[5], nreg[6], nreg[7]}; }
                f32x4 a2[2] = {(f32x4){0.f, 0.f, 0.f, 0.f}, (f32x4){0.f, 0.f, 0.f, 0.f}};
#pragma unroll
                for (int ks = 0; ks < 16; ++ks)
#pragma unroll
                    for (int et = 0; et < 2; ++et) a2[et] = __builtin_amdgcn_mfma_f32_16x16x32_bf16(*(const LAS bf16x8*)(cb_rd + (16 * et + fr) * 1040 + ks * 64 + fq * 16), xf[ks], a2[et], 0, 0, 0);
                asm volatile("" ::: "memory");
#pragma unroll
                for (int ks = 1; ks < 4; ++ks)
#pragma unroll
                    for (int dt = 0; dt < 4; ++dt) kf[ks][dt] = ldg16(ktu + (4 * w + dt) * 4096 + ks * 1024, l16);
                a2[0] = a2[0] * Ei; a2[1] = a2[1] * Ei;
#pragma unroll
                for (int ks = 0; ks < 4; ++ks)
#pragma unroll
                    for (int et = 0; et < 2; ++et) a2[et] = __builtin_amdgcn_mfma_f32_16x16x32_bf16(vf[et][ks], sfr[ks], a2[et], 0, 0, 0);
                char* nu = NUM + ((size_t)row0 * MI + h * 512 + e0) * 2; const unsigned ln = ((16u * w + fr) * MI + 4u * fq) * 2u;
#pragma unroll
                for (int et = 0; et < 2; ++et) *(u32x2*)(nu + et * 32 + ln) = (u32x2){pk2(a2[et][0], a2[et][1]), pk2(a2[et][2], a2[et][3])};
            } else {
#pragma unroll
                for (int ks = 1; ks < 4; ++ks)
#pragma unroll
                    for (int dt = 0; dt < 4; ++dt) kf[ks][dt] = ldg16(ktu + (4 * w + dt) * 4096 + ks * 1024, l16);
            }
            if (has2 && tid_ < 128) {
                const f32x4* gt2 = ic2 ? GTC + (size_t)(dir * 4 + h) * MC : GTL + (size_t)(dir * 4 + h) * HROWS;
                wl_wr[tid_] = *(const float*)((const char*)(gt2 + (ic2 ? gb * CTXL : bl * SEQ) + c2 * 128) + (unsigned)tid_ * 16u + 12u); }
#pragma unroll
            for (int a = 0; a < 4; ++a)
#pragma unroll
                for (int b = 0; b < 2; ++b) acc[a][b] = acc[a][b] * Gd;
#pragma unroll
            for (int ks = 0; ks < 4; ++ks) {
                bf16x8 bv[2];
#pragma unroll
                for (int et = 0; et < 2; ++et) { float v[8]; unpack8(__builtin_bit_cast(u32x4, vf[et][ks]), v);
#pragma unroll
                    for (int e = 0; e < 8; ++e) v[e] *= wl_rd[ks * 32 + 8 * fq + e];
                    const u32x4 pv = pack8(v); bv[et] = __builtin_bit_cast(bf16x8, pv); }
#pragma unroll
                for (int dt = 0; dt < 4; ++dt)
#pragma unroll
                    for (int et = 0; et < 2; ++et) acc[dt][et] = __builtin_amdgcn_mfma_f32_16x16x32_bf16(kf[ks][dt], bv[et], acc[dt][et], 0, 0, 0);
            }
            asm volatile("" ::: "memory");
            if (has2 && !ic2) {
#pragma unroll
                for (int ks = 0; ks < 16; ++ks) xf[ks] = ldg16(xc2 + ks * 1024, l16);
            }
            if (nwriter) { const unsigned lo = lane_ * 32u; const f32x4 d0 = *(const f32x4*)((const char*)dn + lo), d1 = *(const f32x4*)((const char*)dn + lo + 16u);
                nreg[0] = Gd * nreg[0] + d0[0]; nreg[1] = Gd * nreg[1] + d0[1]; nreg[2] = Gd * nreg[2] + d0[2]; nreg[3] = Gd * nreg[3] + d0[3];
                nreg[4] = Gd * nreg[4] + d1[0]; nreg[5] = Gd * nreg[5] + d1[1]; nreg[6] = Gd * nreg[6] + d1[2]; nreg[7] = Gd * nreg[7] + d1[3]; }
#pragma unroll
            for (int dt = 0; dt < 4; ++dt)
#pragma unroll
                for (int et = 0; et < 2; ++et) *(LAS u32x2*)(cb_wr + (16 * et + fr) * 1040 + (64 * w + 16 * dt + 4 * fq) * 2) = (u32x2){pk2(acc[dt][et][0], acc[dt][et][1]), pk2(acc[dt][et][2], acc[dt][et][3])};
            asm volatile("" :: "v"(pf));
            __syncthreads();
        }
    }
}

__device__ __forceinline__ void ph_mout(Fr& F) {
    bf16* NF = (bf16*)(F.ws + MS_NF); const bf16* NBk = (const bf16*)(F.ws + MS_NB); const bf16* XC = (const bf16*)(F.ws + MS_XC); const bf16* Z = (const bf16*)(F.ws + MS_Z);
    const float* NC = (const float*)(F.ws + WS_NC); const float* RS = (const float*)(F.ws + WS_RS); const f32x4* GTL = (const f32x4*)(F.ws + WS_GT_L);
    LAS unsigned char* xt = F.lds + F.wave * 16640;
    for (int it = F.gw; it < (HROWS / 16) * 4; it += F.ngw) {
        const int rt = it >> 2, h = it & 3, bl = rt >> 9, c = (rt >> 3) & 63;
        { const bf16* xp = XC + ((size_t)rt * 64 + h * 16) * 512 + F.lane * 8; u32x4 t[16];
#pragma unroll
            for (int ks = 0; ks < 16; ++ks) t[ks] = *(const u32x4*)(xp + ks * 512);
#pragma unroll
            for (int ks = 0; ks < 16; ++ks) *(LAS u32x4*)(xt + ks * 1040 + F.lane * 16) = t[ks]; }
        const float* n0 = NC + (((size_t)(0 * 2 + bl) * 4 + h) * 64 + c) * 512 + 8 * F.lane; const float* n1 = NC + (((size_t)(1 * 2 + bl) * 4 + h) * 64 + c) * 512 + 8 * F.lane;
        const f32x4 n00 = *(const f32x4*)n0, n01 = *(const f32x4*)(n0 + 4), n10 = *(const f32x4*)n1, n11 = *(const f32x4*)(n1 + 4);
        float nw[8], sk[8];
        { const float* pw = IN(I_MNW) + h * 512 + 8 * F.lane; const float* ps = IN(I_MSKIP) + h * 512 + 8 * F.lane;
#pragma unroll
            for (int e = 0; e < 8; ++e) { nw[e] = pw[e]; sk[e] = ps[e]; } }
#pragma unroll 2
        for (int r = 0; r < 16; ++r) {
            const int row = rt * 16 + r; const size_t o = (size_t)row * MI + h * 512 + 8 * F.lane;
            float nf[8], nb[8], xc[8], z[8];
            unpack8(*(const u32x4*)(NF + o), nf); unpack8(*(const u32x4*)(NBk + o), nb); unpack8(*(const u32x4*)(Z + o), z);
            unpack8(*(const LAS u32x4*)(xt + (F.lane >> 2) * 1040 + (r + 16 * (F.lane & 3)) * 16), xc);
            float d0 = xc[0] * n00[0] + xc[1] * n00[1] + xc[2] * n00[2] + xc[3] * n00[3] + xc[4] * n01[0] + xc[5] * n01[1] + xc[6] * n01[2] + xc[7] * n01[3];
            float d1 = xc[0] * n10[0] + xc[1] * n10[1] + xc[2] * n10[2] + xc[3] * n10[3] + xc[4] * n11[0] + xc[5] * n11[1] + xc[6] * n11[2] + xc[7] * n11[3];
            d0 = wave_sum(d0); d1 = wave_sum(d1);
            const float den0 = GTL[(size_t)(0 * 4 + h) * HROWS + row][2] * d0 + RS[(size_t)(0 * 4 + h) * HROWS + row], den1 = GTL[(size_t)(1 * 4 + h) * HROWS + row][2] * d1 + RS[(size_t)(1 * 4 + h) * HROWS + row];
            const float i0 = 1.0f / fmaxf(fabsf(den0), 1.0f), i1 = 1.0f / fmaxf(fabsf(den1), 1.0f);
            float s = 0.f;
#pragma unroll
            for (int e = 0; e < 8; ++e) { nf[e] = nf[e] * i0 + nb[e] * i1; s += nf[e]; }
            const float mu = wave_sum(s) * (1.0f / 512.0f); float q = 0.f;
#pragma unroll
            for (int e = 0; e < 8; ++e) { nf[e] -= mu; q += nf[e] * nf[e]; }
            const float rstd = 1.0f / sqrtf(wave_sum(q) * (1.0f / 512.0f) + ML_NORM_EPS);
#pragma unroll
            for (int e = 0; e < 8; ++e) nf[e] = (nf[e] * rstd * nw[e] + sk[e] * xc[e]) * silu_f(z[e]);
            *(u32x4*)(NF + o) = pack8(nf);
        }
    }
}

__device__ __forceinline__ void ph_final(Fr& F) {
    const float* g = IN(I_FINALG);
    for (int r = F.gw; r < ML; r += 2 * F.ngw) {
        const int r2 = r + F.ngw < ML ? r + F.ngw : r;
        f32x4* xa = (f32x4*)(F.out + (size_t)r * 1024) + F.lane; f32x4* xb = (f32x4*)(F.out + (size_t)r2 * 1024) + F.lane; f32x4 va[4], vb[4]; float sa = 0.f, sb = 0.f;
#pragma unroll
        for (int j = 0; j < 4; ++j) { va[j] = xa[64 * j]; vb[j] = xb[64 * j]; }
#pragma unroll
        for (int j = 0; j < 4; ++j) { sa += (va[j][0] * va[j][0] + va[j][1] * va[j][1]) + (va[j][2] * va[j][2] + va[j][3] * va[j][3]); sb += (vb[j][0] * vb[j][0] + vb[j][1] * vb[j][1]) + (vb[j][2] * vb[j][2] + vb[j][3] * vb[j][3]); }
        const float ra = 1.0f / sqrtf(wave_sum(sa) * (1.0f / 1024.0f) + EPS), rb = 1.0f / sqrtf(wave_sum(sb) * (1.0f / 1024.0f) + EPS);
#pragma unroll
        for (int j = 0; j < 4; ++j) { const f32x4 gg = *(const f32x4*)(g + 4 * F.lane + 256 * j); xa[64 * j] = va[j] * ra * gg; if (r2 != r) xb[64 * j] = vb[j] * rb * gg; }
    }
}

template <class Epi>
__device__ __forceinline__ void run_gemm(Fr& F, const bf16* A, const bf16* Bt, int M, int N, int K, const Epi& E) {
    pg8::Gemm g{A, Bt, M, N, K}; pg8::StaticOrder S; S.init(M, N, F.G, F.bid);
    pg8::gemm_phase<Epi, pg8::StaticOrder, true, true>(F.lds, g, S, E, F.tid);
}

struct Args { const float* in[38]; float* out; unsigned char* ws; int ph_lo, ph_hi; };
static_assert(sizeof(Args) == 328 && offsetof(Args, out) == 304 && offsetof(Args, ws) == 312 && offsetof(Args, ph_lo) == 320, "Args layout");
constexpr int N_PHASES = 36;


#define XB_TMO      128
#define XB_XCNT(j)  (256  + 64 * (j))
#define XB_XSUB(j)  (1280 + 64 * (j))
#define XB_XGEN(j)  (2304 + 64 * (j))
#define XB_TOP      3328
#define XB_TOPGEN   3392
#define XCD_BAR_WORDS 3456
#define XB_SPIN_CAP (1u << 22)
__device__ __forceinline__ unsigned xb_ld(unsigned* p)              { return __hip_atomic_load(p, __ATOMIC_RELAXED, __HIP_MEMORY_SCOPE_AGENT); }
__device__ __forceinline__ unsigned xb_add(unsigned* p, unsigned v) { return __hip_atomic_fetch_add(p, v, __ATOMIC_RELAXED, __HIP_MEMORY_SCOPE_AGENT); }
__device__ __forceinline__ unsigned xb_xcc_id() { return (unsigned)__builtin_amdgcn_s_getreg((3 << 11) | 20) & 0xFu; }
#define XB_SPIN(cond, bar) do { unsigned _sp = 0; while (cond) { __builtin_amdgcn_s_sleep(1); \
    if ((++_sp & 255u) == 0u) { if (xb_ld(&(bar)[XB_TMO])) break; if (_sp > XB_SPIN_CAP) { atomicAdd(&(bar)[XB_TMO], 1u); break; } } } } while (0)
__device__ __forceinline__ void xcd_barrier_complete(unsigned* bar, unsigned x, unsigned& nloc, unsigned& nx) {
    const unsigned G = gridDim.x * gridDim.y * gridDim.z;
    unsigned sum, cnt, mine, sp = 0u;
    for (;;) {
        sum = 0u; cnt = 0u; mine = 0u;
#pragma unroll
        for (unsigned j = 0; j < 16; ++j) { const unsigned c = xb_ld(&bar[XB_XCNT(j)]); sum += c; cnt += (c > 0u) ? 1u : 0u; mine = (j == x) ? c : mine; }
        if (sum == G) break;
        __builtin_amdgcn_s_sleep(1);
        if ((++sp & 255u) == 0u) { if (xb_ld(&bar[XB_TMO])) break; if (sp > XB_SPIN_CAP) { atomicAdd(&bar[XB_TMO], 1u); break; } }
    }
    nloc = mine > 0u ? mine : 1u; nx = cnt > 0u ? cnt : 1u;
}
__device__ __forceinline__ void xcd_barrier(unsigned* bar, volatile LAS unsigned* st) {
    asm volatile("s_waitcnt vmcnt(0)" ::: "memory");
    __syncthreads();
    if (threadIdx.x == 0) {
        const unsigned x = xb_xcc_id();
        __builtin_amdgcn_s_waitcnt(0);
        unsigned nloc = st[0], nx = st[1];
        if (nloc == 0u) { xcd_barrier_complete(bar, x, nloc, nx); st[0] = nloc; st[1] = nx; }
        const unsigned old = xb_add(&bar[XB_XSUB(x)], 1u);
        const unsigned gen = old / nloc;
        if (old + 1u == (gen + 1u) * nloc) {
            __builtin_amdgcn_fence(__ATOMIC_RELEASE, "agent");
            asm volatile("s_waitcnt vmcnt(0)" ::: "memory");
            const unsigned og = xb_add(&bar[XB_TOP], 1u);
            const unsigned tg = og / nx;
            if (og + 1u == (tg + 1u) * nx) xb_add(&bar[XB_TOPGEN], 1u);
            else XB_SPIN(xb_ld(&bar[XB_TOPGEN]) == tg, bar);
            __builtin_amdgcn_fence(__ATOMIC_ACQUIRE, "agent");
            xb_add(&bar[XB_XGEN(x)], 1u);
            asm volatile("s_waitcnt vmcnt(0)" ::: "memory");
        } else {
            XB_SPIN(xb_ld(&bar[XB_XGEN(x)]) == gen, bar);
            __builtin_amdgcn_fence(__ATOMIC_ACQUIRE, "agent");
            asm volatile("s_waitcnt vmcnt(0)" ::: "memory");
        }
    }
    __syncthreads();
}
#ifndef PROBE_MASK
#define PROBE_MASK 0ull
#endif
constexpr int BAR_LDS_OFF = LDS_BYTES - 64;
constexpr size_t WS_BAR = 0;
constexpr size_t WS_TS = 64 * 1024;

template <int ph>
__device__ __forceinline__ void run_phase(Fr& F) {
    unsigned char* ws = F.ws;
    float* mod = (float*)(ws + WS_MOD); float* ctxx = (float*)(ws + WS_CTXX);
    if constexpr (ph == 0) ph_prologue(F);
    else if constexpr (ph == 1) {
            kt_items(F, (const float*)(ws + WS_H3), SEQ, (float*)(ws + HY_KT));
            kt_items(F, (const float*)(ws + WS_H3) + (size_t)SEQ * 64, CTXL, (float*)(ws + WS_KTC));
            ph_modnorm(F, IN(I_X), ML, 0, IN(I_CTX), MC, IN(I_NORMG), mod, 0, (bf16*)(ws + HY_H));
        }
    else if constexpr (ph == 2) { pg8::EpiBf16 E{(bf16*)(ws + HY_P), 3072, IN(I_HBIN), 0, 0}; run_gemm(F, (const bf16*)(ws + HY_H), (const bf16*)(ws + WS_WHIN), MALL, 3072, 1024, E); }
    else if constexpr (ph == 3) { zt_items(F, (const bf16*)(ws + HY_P), 0, NB, SEQ, (bf16*)(ws + HY_ZT)); zt_items(F, (const bf16*)(ws + HY_P), ML, NB, CTXL, (bf16*)(ws + HY_ZTC)); }
    else if constexpr (ph == 4) ph_fftconv(F);
    else if constexpr (ph == 5) { u2_items(F, (const bf16*)(ws + HY_P), 0, NB, SEQ, (const bf16*)(ws + HY_ZT), (bf16*)(ws + HY_H)); u2_items(F, (const bf16*)(ws + HY_P), ML, NB, CTXL, (const bf16*)(ws + HY_ZTC), (bf16*)(ws + HY_H)); }
    else if constexpr (ph == 6) { pg8::EpiRes E{IN(I_X), F.out, IN(I_CTX), ctxx, ML, mod + 2048, 0, IN(I_HBOUT)}; run_gemm(F, (const bf16*)(ws + HY_H), (const bf16*)(ws + WS_WHOUT), MALL, 1024, 1024, E); }
    else if constexpr (ph == 7) ph_modnorm(F, F.out, ML, 0, ctxx, MC, IN(I_NORMG) + 1024, mod, 3072, (bf16*)(ws + FF_H));
    else if constexpr (ph == 8) { pg8::EpiBf16 E{(bf16*)(ws + FF_A), FF, nullptr, FF, (FF_G - FF_A) / 2}; run_gemm(F, (const bf16*)(ws + FF_H), (const bf16*)(ws + WS_WUP0), MALL, 2 * FF, 1024, E); }
    else if constexpr (ph == 9) ph_dwconv(F, 0, ML, MC);
    else if constexpr (ph == 10) { pg8::EpiRes E{F.out, F.out, ctxx, ctxx, ML, mod + 5120, 0, nullptr}; run_gemm(F, (const bf16*)(ws + FF_A), (const bf16*)(ws + WS_WDN0), MALL, 1024, FF, E); }
    else if constexpr (ph < 31) {
            constexpr int hb = (ph - 11) / 10, k = (ph - 11) % 10; const float* mod1 = mod + 5 * 6144;
            float* xh = F.out + (size_t)hb * HROWS * 1024;
            if constexpr (k == 0) { ph_modnorm(F, xh, HROWS, 2 * hb, ctxx, 0, IN(I_NORMG) + 2048, mod1, 0, (bf16*)(ws + MS_H));
                          if (hb == 0) ph_modnorm(F, xh, 0, 0, ctxx, MC, IN(I_NORMG) + 2048, mod1, 0, (bf16*)(ws + MS_HC)); }
            else if constexpr (k == 1) { { pg8::EpiBf16T E{(bf16*)(ws + MS_XM), MI / 32}; run_gemm(F, (const bf16*)(ws + MS_H), (const bf16*)(ws + WS_WMIN), HROWS, MI, 1024, E); }
                               if (hb == 0) { pg8::EpiBf16T E{(bf16*)(ws + MS_XMC), MI / 32}; run_gemm(F, (const bf16*)(ws + MS_HC), (const bf16*)(ws + WS_WMIN), MC, MI, 1024, E); } }
            else if constexpr (k == 2) { prep_items(F, (const bf16*)(ws + MS_XM), 2, SEQ, (bf16*)(ws + MS_XC), (bf16*)(ws + MS_KN), (bf16*)(ws + MS_KT), (bf16*)(ws + MS_VT));
                               if (hb == 0) prep_items(F, (const bf16*)(ws + MS_XMC), NB, CTXL, (bf16*)(ws + MS_XCC), (bf16*)(ws + MS_XCC + 16 * MiB), (bf16*)(ws + MS_KTC), (bf16*)(ws + MS_VTC)); }
            else if constexpr (k == 3) { gate_items(F, (const bf16*)(ws + MS_XC), (const bf16*)(ws + MS_XM), HROWS, (float*)(ws + WS_GATES_L));
                               if (hb == 0) gate_items(F, (const bf16*)(ws + MS_XCC), (const bf16*)(ws + MS_XMC), MC, (float*)(ws + WS_GATES_C)); }
            else if constexpr (k == 4) { cum_items(F, (const float*)(ws + WS_GATES_L), 2, SEQ, 2 * hb, 2, (f32x4*)(ws + WS_GT_L), (float*)(ws + WS_GC));
                               if (hb == 0) cum_items(F, (const float*)(ws + WS_GATES_C), NB, CTXL, 0, 0, (f32x4*)(ws + WS_GT_C), (float*)(ws + WS_GC)); }
            else if constexpr (k == 5) ph_sphase(F, hb, hb == 0);
            else if constexpr (k == 6) ph_scan(F, hb);
            else if constexpr (k == 7) { pg8::EpiBf16 E{(bf16*)(ws + MS_Z), MI, nullptr, 0, 0}; run_gemm(F, (const bf16*)(ws + MS_H), (const bf16*)(ws + WS_WMIN) + (size_t)MI * 1024, HROWS, MI, 1024, E); }
            else if constexpr (k == 8) ph_mout(F);
            else { pg8::EpiRes E{xh, xh, ctxx, ctxx, HROWS, mod1 + 2048, 2 * hb, nullptr}; run_gemm(F, (const bf16*)(ws + MS_NF), (const bf16*)(ws + WS_WMDN), HROWS, 1024, MI, E); }
        }
    else if constexpr (ph == 31) ph_modnorm(F, F.out, ML, 0, ctxx, 0, IN(I_NORMG) + 3072, mod + 5 * 6144, 3072, (bf16*)(ws + FF_H));
    else if constexpr (ph == 32) { pg8::EpiBf16 E{(bf16*)(ws + FF_A), FF, nullptr, FF, (FF_G - FF_A) / 2}; run_gemm(F, (const bf16*)(ws + FF_H), (const bf16*)(ws + WS_WUP1), ML, 2 * FF, 1024, E); }
    else if constexpr (ph == 33) ph_dwconv(F, 1, ML, 0);
    else if constexpr (ph == 34) { pg8::EpiRes E{F.out, F.out, ctxx, ctxx, ML, mod + 5 * 6144 + 5120, 0, nullptr}; run_gemm(F, (const bf16*)(ws + FF_A), (const bf16*)(ws + WS_WDN1), ML, 1024, FF, E); }
    else ph_final(F);
}

template <int ph>
__device__ __forceinline__ void phase_step(int ph_lo, int ph_hi, unsigned char* lds_raw) {
    if (ph_lo <= ph && ph < ph_hi) {
        const __attribute__((address_space(4))) unsigned char* kp = (const __attribute__((address_space(4))) unsigned char*)__builtin_amdgcn_kernarg_segment_ptr();
        asm volatile("" : "+s"(kp));
        Fr F;
        { int t_ = threadIdx.x, g_ = gridDim.x, b_ = blockIdx.x; asm volatile("" : "+v"(t_), "+s"(g_), "+s"(b_)); F.tid = t_; F.G = g_; F.bid = b_; }
        F.lds = (LAS unsigned char*)lds_raw; F.lane = F.tid & 63; F.wave = __builtin_amdgcn_readfirstlane(F.tid >> 6);
        F.gw = F.bid * NWAVES + F.wave; F.ngw = F.G * NWAVES;
        F.in = (const __attribute__((address_space(4))) cfptr_t*)kp;
        typedef float* fptr_t; typedef unsigned char* ucptr_t;
        F.out = *(const __attribute__((address_space(4))) fptr_t*)(kp + 304); F.ws = *(const __attribute__((address_space(4))) ucptr_t*)(kp + 312);
        if (PROBE_MASK != 0ull && F.bid == 0 && F.tid == 0) ((unsigned long long*)(F.ws + WS_TS))[ph] = __builtin_amdgcn_s_memrealtime();
        run_phase<ph>(F);
        if (ph + 1 < ph_hi) {
            if (ph == 0) {
                if (F.bid == 0) for (int i = F.tid; i < XCD_BAR_WORDS; i += NTHR) __hip_atomic_store((unsigned*)(F.ws + WS_BAR) + i, 0u, __ATOMIC_RELAXED, __HIP_MEMORY_SCOPE_AGENT);
                __syncthreads(); cg::this_grid().sync();
                if (F.tid == 0) (void)xb_add((unsigned*)(F.ws + WS_BAR) + XB_XCNT(xb_xcc_id()), 1u);
            }
            else xcd_barrier((unsigned*)(F.ws + WS_BAR), (volatile LAS unsigned*)(F.lds + BAR_LDS_OFF));
        }
        if (PROBE_MASK != 0ull && ph == N_PHASES - 1 && F.bid == 0) {
            if (F.tid == 0) { unsigned long long* ts = (unsigned long long*)(F.ws + WS_TS); const unsigned long long tend = __builtin_amdgcn_s_memrealtime(); unsigned long long tot = 0ull;
                for (int k = 0; k < N_PHASES; ++k) if ((PROBE_MASK >> k) & 1ull) tot += (k + 1 < N_PHASES ? ts[k + 1] : tend) - ts[k];
                while (__builtin_amdgcn_s_memrealtime() - tend < tot) __builtin_amdgcn_s_sleep(8); }
            __syncthreads();
        }
    }
}
template <int... I>
__device__ __forceinline__ void all_phases(int ph_lo, int ph_hi, unsigned char* lds_raw, std::integer_sequence<int, I...>) { (phase_step<I>(ph_lo, ph_hi, lds_raw), ...); }

__global__ void __launch_bounds__(NTHR, 2) fwd_kernel(Args args) {
    extern __shared__ __attribute__((aligned(16))) unsigned char lds_raw[];
    int ph_lo, ph_hi;
    { const __attribute__((address_space(4))) unsigned char* kp0 = (const __attribute__((address_space(4))) unsigned char*)__builtin_amdgcn_kernarg_segment_ptr();
      ph_lo = *(const __attribute__((address_space(4))) int*)(kp0 + 320); ph_hi = *(const __attribute__((address_space(4))) int*)(kp0 + 324); }
    if (threadIdx.x < 16) ((LAS unsigned*)((LAS unsigned char*)lds_raw + BAR_LDS_OFF))[threadIdx.x] = 0u;
    __syncthreads();
    all_phases(ph_lo, ph_hi, lds_raw, std::make_integer_sequence<int, N_PHASES>{});
}

extern "C" void kernel_launch(void* const* d_in, const int* in_sizes, int n_in, void* d_out, int out_size, void* d_ws, size_t ws_size, hipStream_t stream) {
    static int grid = 0;
    if (grid == 0) {
        int dev = 0, cus = 0, per_cu = 0;
        hipGetDevice(&dev);
        hipDeviceGetAttribute(&cus, hipDeviceAttributeMultiprocessorCount, dev);
        hipFuncSetAttribute((const void*)fwd_kernel, hipFuncAttributeMaxDynamicSharedMemorySize, LDS_BYTES);
        hipOccupancyMaxActiveBlocksPerMultiprocessor(&per_cu, (const void*)fwd_kernel, NTHR, LDS_BYTES);
        if (per_cu < 1) { fprintf(stderr, "kernel_launch: occupancy query says %d blocks per CU\n", per_cu); per_cu = 1; }
        grid = cus < 256 ? cus : 256;
        if (n_in != 38 || ws_size < WS_END) fprintf(stderr, "kernel_launch: unexpected n_in %d / ws_size %zu (need %zu)\n", n_in, ws_size, (size_t)WS_END);
        (void)hipGetLastError();
    }
    (void)hipMemsetAsync(d_ws, 0, 128 * 1024, stream);
    Args a{};
    for (int i = 0; i < 38; ++i) a.in[i] = (const float*)d_in[i];
    a.out = (float*)d_out; a.ws = (unsigned char*)d_ws; a.ph_lo = 0; a.ph_hi = N_PHASES;
    void* kargs[] = {&a};
    hipError_t e = hipLaunchCooperativeKernel((const void*)fwd_kernel, dim3(grid), dim3(NTHR), kargs, LDS_BYTES, stream);
    if (e != hipSuccess) fprintf(stderr, "cooperative launch failed: %s (grid %d)\n", hipGetErrorString(e), grid);
}
```

```cpp
#include <hip/hip_runtime.h>
#include <hip/hip_cooperative_groups.h>
#include <cstdio>
#include <cstdint>
#include <cstddef>
#include <utility>
namespace cg = cooperative_groups;

#define LAS __attribute__((address_space(3)))
typedef unsigned short bf16;
typedef short bf16x8 __attribute__((ext_vector_type(8)));
typedef float f32x4 __attribute__((ext_vector_type(4)));
typedef float f32x2 __attribute__((ext_vector_type(2)));
typedef unsigned u32x4 __attribute__((ext_vector_type(4)));
typedef unsigned u32x2 __attribute__((ext_vector_type(2)));

namespace pg8 {
#define PG8_LAS __attribute__((address_space(3)))
typedef unsigned short bf16_t;
constexpr int BM = 256, BK = 64, HALF = 128, HTB = HALF * BK * 2, STAGE_BYTES = 8 * HTB, NXCD = 8, WGM = 8;
__host__ __device__ __forceinline__ int lds_byte(int r, int c) { const int st = (r >> 4) * 2 + (c >> 5), rr = r & 15, cc = c & 31, ob = rr * 64 + cc * 2; return st * 1024 + (ob ^ (((ob >> 9) & 1) << 5)); }
__host__ __device__ __forceinline__ void stage_rc(int b, int& R, int& C) { const int st = b / 1024, sb = b % 1024, swz = sb ^ (((sb >> 9) & 1) << 5); R = (st >> 1) * 16 + swz / 64; C = (st & 1) * 32 + (swz % 64) / 2; }
__host__ __device__ __forceinline__ int perm32(int rho) { const int n = rho >> 4, i = rho & 15; return 8 * (i >> 2) + 4 * n + (i & 3); }
struct Unit { int pm, pn; };
struct Gemm { const bf16_t* A; const bf16_t* Bt; int M, N, K; };
struct StaticOrder {
    int nM, nN, nwg, G, c;
    __host__ __device__ void init(int M, int N, int G_, int c_) { nM = M / BM; nN = N / BM; nwg = nM * nN; G = G_; c = c_; }
    __host__ __device__ bool next(int i, Unit& u) const {
        const long L = (long)i * G + c; if (L >= nwg) return false;
        int wgid = (int)L; { const int q = nwg / NXCD, r = nwg % NXCD, xcd = wgid % NXCD, off = wgid / NXCD; wgid = (xcd < r ? xcd * (q + 1) : r * (q + 1) + (xcd - r) * q) + off; }
        const int nig = WGM * nN, gid = wgid / nig, fm = gid * WGM, gsz = (nM - fm) < WGM ? (nM - fm) : WGM;
        u.pm = fm + ((wgid % nig) % gsz); u.pn = (wgid % nig) / gsz; return true;
    }
    __device__ __forceinline__ void a_ready(const Unit&) const {}
    __device__ __forceinline__ void done(const Unit&) const {}
};
__device__ __forceinline__ unsigned cvt_pk_bf16(float lo, float hi) { unsigned r; asm volatile("v_cvt_pk_bf16_f32 %0, %1, %2" : "=v"(r) : "v"(lo), "v"(hi)); return r; }

struct EpiBf16 {
    static constexpr bool PERM = true, AFTER_DRAIN = false;
    bf16_t* O; int ldc; const float* bias; int split_cols; size_t split_stride;
    __device__ __forceinline__ void operator()(const f32x4 (&acc)[2][2][4][2], const Unit& u, int wr, int wc, int fr, int fq) const {
        const int row0 = u.pm * BM + wr * 64 + fr; int colt = u.pn * BM; bf16_t* base = O;
        if (split_cols) { const int t = colt / split_cols; base += (size_t)t * split_stride; colt -= t * split_cols; }
        const int col0 = colt + wc * 32 + 8 * fq, bcol0 = u.pn * BM + wc * 32 + 8 * fq;
        f32x4 bv[2][2];
#pragma unroll
        for (int bj = 0; bj < 2; ++bj)
#pragma unroll
            for (int n = 0; n < 2; ++n) bv[bj][n] = bias ? *(const f32x4*)(bias + bcol0 + bj * HALF + 4 * n) : (f32x4){0.f, 0.f, 0.f, 0.f};
#pragma unroll
        for (int ai = 0; ai < 2; ++ai)
#pragma unroll
            for (int m = 0; m < 4; ++m) { bf16_t* rowp = base + (size_t)(row0 + ai * HALF + m * 16) * ldc + col0;
#pragma unroll
                for (int bj = 0; bj < 2; ++bj) { f32x4 v0 = acc[ai][bj][m][0] + bv[bj][0], v1 = acc[ai][bj][m][1] + bv[bj][1];
                    u32x4 w; w.x = cvt_pk_bf16(v0[0], v0[1]); w.y = cvt_pk_bf16(v0[2], v0[3]); w.z = cvt_pk_bf16(v1[0], v1[1]); w.w = cvt_pk_bf16(v1[2], v1[3]);
                    *(u32x4*)(rowp + bj * HALF) = w; } }
    }
};
struct EpiBf16T {
    static constexpr bool PERM = true, AFTER_DRAIN = false;
    bf16_t* O; int ntc;
    __device__ __forceinline__ void operator()(const f32x4 (&acc)[2][2][4][2], const Unit& u, int wr, int wc, int fr, int fq) const {
        bf16_t* base = O + (size_t)(fr + 16 * fq) * 8;
#pragma unroll
        for (int ai = 0; ai < 2; ++ai)
#pragma unroll
            for (int m = 0; m < 4; ++m)
#pragma unroll
                for (int bj = 0; bj < 2; ++bj) { const f32x4 v0 = acc[ai][bj][m][0], v1 = acc[ai][bj][m][1];
                    u32x4 w; w.x = cvt_pk_bf16(v0[0], v0[1]); w.y = cvt_pk_bf16(v0[2], v0[3]); w.z = cvt_pk_bf16(v1[0], v1[1]); w.w = cvt_pk_bf16(v1[2], v1[3]);
                    *(u32x4*)(base + ((size_t)(u.pm * 16 + ai * 8 + wr * 4 + m) * ntc + u.pn * 8 + bj * 4 + wc) * 512) = w; }
    }
};
struct EpiRes {
    static constexpr bool PERM = false, AFTER_DRAIN = false;
    const float* res_lat; float* out_lat; const float* res_ctx; float* out_ctx; int rows_lat; const float* gate; int b0; const float* bias;
    __device__ __forceinline__ void operator()(const f32x4 (&acc)[2][2][4][2], const Unit& u, int wr, int wc, int fr, int fq) const {
        const int trow = u.pm * BM; const float* res; float* out; int modrow;
        if (trow < rows_lat) { res = res_lat + (size_t)trow * 1024; out = out_lat + (size_t)trow * 1024; modrow = b0 + trow / 8192; }
        else { const int rc = trow - rows_lat; res = res_ctx + (size_t)rc * 1024; out = out_ctx + (size_t)rc * 1024; modrow = 4; }
        const int col0 = u.pn * BM + wc * 32 + 4 * fq; const float* gp = gate + (size_t)modrow * 6144 + col0;
#pragma unroll
        for (int bj = 0; bj < 2; ++bj)
#pragma unroll
            for (int n = 0; n < 2; ++n) {
                const f32x4 bv = bias ? *(const f32x4*)(bias + col0 + bj * HALF + n * 16) : (f32x4){0.f, 0.f, 0.f, 0.f}; const f32x4 gv = *(const f32x4*)(gp + bj * HALF + n * 16);
#pragma unroll
                for (int ai = 0; ai < 2; ++ai) {
#pragma unroll
                    for (int m = 0; m < 4; ++m) { const size_t off = (size_t)(wr * 64 + fr + ai * HALF + m * 16) * 1024 + col0 + bj * HALF + n * 16;
                        const f32x4 rs = *(const f32x4*)(res + off); *(f32x4*)(out + off) = rs + gv * (acc[ai][bj][m][n] + bv); }
                    asm volatile("" ::: "memory"); }
            }
    }
};

template <class Epi, class Sched, bool ALIGN_EPI = false, bool SP2 = false>
__device__ __forceinline__ void gemm_phase(PG8_LAS unsigned char* lds, const Gemm g, const Sched& S, const Epi& E, const int tid) {
    const int wid = __builtin_amdgcn_readfirstlane(tid >> 6), lane = tid & 63, wr = wid >> 2, wc = wid & 3, fr = lane & 15, fq = lane >> 4;
    const int K = g.K, nt = K / BK;
    unsigned voffA[2], voffB[2];
#pragma unroll
    for (int i = 0; i < 2; ++i) { int R, C; stage_rc(tid * 16 + i * 8192, R, C); const int Rb = Epi::PERM ? ((R & ~31) + perm32(R & 31)) : R;
        voffA[i] = (unsigned)(R * K + C) * 2u; voffB[i] = (unsigned)(Rb * K + C) * 2u; }
    const size_t kstep = (size_t)(BK * 2);
    const size_t hstep = (size_t)HALF * K * 2;
    const size_t tstep = 2 * hstep;
    const unsigned ldsw = (unsigned)wid * 1024u;
    const int aoff = lds_byte(wr * 64 + fr, fq * 8), boff = lds_byte(wc * 32 + fr, fq * 8);
#define PG8_SA(b, h) (((b) * 2 + (h)) * HTB)
#define PG8_SB(b, h) ((4 + (b) * 2 + (h)) * HTB)
#define PG8_STAGE(bufoff, gbase, voff) do { _Pragma("unroll") for (int _i = 0; _i < 2; ++_i) \
        __builtin_amdgcn_global_load_lds((const unsigned*)((const char*)(gbase) + (voff)[_i]), (PG8_LAS unsigned*)(lds + (bufoff) + ldsw + _i * 8192), 16, 0, 0); } while (0)
#define PG8_LDA(dst, b, h) do { _Pragma("unroll") for (int m = 0; m < 4; ++m) _Pragma("unroll") for (int k = 0; k < 2; ++k) dst[m][k] = *(const PG8_LAS bf16x8*)(lds + PG8_SA(b, h) + aoff + m * 2048 + k * 1024); } while (0)
#define PG8_LDB(dst, b, h) do { _Pragma("unroll") for (int n = 0; n < 2; ++n) _Pragma("unroll") for (int k = 0; k < 2; ++k) dst[n][k] = *(const PG8_LAS bf16x8*)(lds + PG8_SB(b, h) + boff + n * 2048 + k * 1024); } while (0)
#define PG8_MMA(ai, bj, At, Bt) do { __builtin_amdgcn_s_setprio(1); _Pragma("unroll") for (int m = 0; m < 4; ++m) _Pragma("unroll") for (int n = 0; n < 2; ++n) _Pragma("unroll") for (int k = 0; k < 2; ++k) \
        acc[ai][bj][m][n] = __builtin_amdgcn_mfma_f32_16x16x32_bf16(Bt[n][k], At[m][k], acc[ai][bj][m][n], 0, 0, 0); __builtin_amdgcn_s_setprio(0); } while (0)
#define PG8_WAIT_V(n) asm volatile("s_waitcnt vmcnt(" #n ")" ::: "memory")
#define PG8_WAIT_L(n) asm volatile("s_waitcnt lgkmcnt(" #n ")" ::: "memory")
#define PG8_BAR __builtin_amdgcn_s_barrier()
#define PG8_SCHED __builtin_amdgcn_sched_barrier(0)
    Unit cur, nxt; int ui = 0;
    if (!S.next(0, cur)) return;
    f32x4 acc[2][2][4][2];
#pragma unroll
    for (int a = 0; a < 2; ++a)
#pragma unroll
        for (int b = 0; b < 2; ++b)
#pragma unroll
            for (int m = 0; m < 4; ++m)
#pragma unroll
                for (int n = 0; n < 2; ++n) acc[a][b][m][n] = (f32x4){0.f, 0.f, 0.f, 0.f};
    bf16x8 At[4][2], B0[2][2], B1[2][2];
    const char* cA = (const char*)g.A + (size_t)cur.pm * tstep; const char* cB = (const char*)g.Bt + (size_t)cur.pn * tstep;
    S.a_ready(cur);
    if constexpr (SP2) {
        PG8_STAGE(PG8_SB(0, 0), cB, voffB); PG8_STAGE(PG8_SB(0, 1), cB + hstep, voffB); PG8_STAGE(PG8_SA(0, 0), cA, voffA); PG8_STAGE(PG8_SA(0, 1), cA + hstep, voffA);
        if (wr == 1) PG8_BAR;
        PG8_WAIT_V(2); PG8_BAR;
        PG8_STAGE(PG8_SB(1, 0), cB + kstep, voffB); PG8_STAGE(PG8_SA(1, 0), cA + kstep, voffA); PG8_STAGE(PG8_SB(1, 1), cB + hstep + kstep, voffB);
        PG8_WAIT_V(6); PG8_BAR;
    } else {
        PG8_STAGE(PG8_SB(0, 0), cB, voffB); PG8_STAGE(PG8_SA(0, 0), cA, voffA); PG8_STAGE(PG8_SB(0, 1), cB + hstep, voffB); PG8_STAGE(PG8_SA(0, 1), cA + hstep, voffA);
        if (wr == 1) PG8_BAR;
        PG8_WAIT_V(4); PG8_BAR;
        PG8_STAGE(PG8_SB(1, 0), cB + kstep, voffB); PG8_STAGE(PG8_SA(1, 0), cA + kstep, voffA); PG8_STAGE(PG8_SB(1, 1), cB + hstep + kstep, voffB);
        PG8_WAIT_V(6); PG8_BAR;
    }
    for (;;) {
        const bool has_next = S.next(ui + 1, nxt);
        const char* nA = has_next ? (const char*)g.A + (size_t)nxt.pm * tstep : cA; const char* nB = has_next ? (const char*)g.Bt + (size_t)nxt.pn * tstep : cB;
        for (int t = 0; t < nt; t += 2) {
            const bool last = (t == nt - 2);
            const char* a1 = cA + (size_t)(t + 1) * kstep;
            const char* a2 = last ? nA : cA + (size_t)(t + 2) * kstep; const char* b2 = last ? nB : cB + (size_t)(t + 2) * kstep;
            const char* a3 = a2 + kstep; const char* b3 = b2 + kstep;
            if (last && has_next) S.a_ready(nxt);
            if constexpr (SP2) {
            PG8_LDB(B0, 0, 0); PG8_LDB(B1, 0, 1); PG8_SCHED; PG8_LDA(At, 0, 0); PG8_STAGE(PG8_SA(1, 1), a1 + hstep, voffA);
            PG8_WAIT_V(8); PG8_WAIT_L(0); PG8_BAR; PG8_MMA(0, 0, At, B0); PG8_MMA(0, 1, At, B1); PG8_BAR; PG8_SCHED;
            PG8_LDA(At, 0, 1); PG8_STAGE(PG8_SB(0, 0), b2, voffB); PG8_STAGE(PG8_SB(0, 1), b2 + hstep, voffB); PG8_STAGE(PG8_SA(0, 0), a2, voffA);
            PG8_WAIT_V(8); PG8_WAIT_L(0); PG8_BAR; PG8_MMA(1, 0, At, B0); PG8_MMA(1, 1, At, B1); PG8_BAR; PG8_SCHED;
            PG8_LDB(B0, 1, 0); PG8_LDB(B1, 1, 1); PG8_SCHED; PG8_LDA(At, 1, 0); PG8_STAGE(PG8_SA(0, 1), a2 + hstep, voffA);
            PG8_WAIT_V(8); PG8_WAIT_L(0); PG8_BAR; PG8_MMA(0, 0, At, B0); PG8_MMA(0, 1, At, B1); PG8_BAR; PG8_SCHED;
            PG8_LDA(At, 1, 1); PG8_STAGE(PG8_SB(1, 0), b3, voffB); PG8_STAGE(PG8_SB(1, 1), b3 + hstep, voffB); PG8_STAGE(PG8_SA(1, 0), a3, voffA);
            PG8_WAIT_V(8); PG8_WAIT_L(0); PG8_BAR; PG8_MMA(1, 0, At, B0); PG8_MMA(1, 1, At, B1); PG8_BAR; PG8_SCHED;
            } else {
            PG8_LDB(B0, 0, 0); PG8_SCHED; PG8_LDA(At, 0, 0); PG8_STAGE(PG8_SA(1, 1), a1 + hstep, voffA);
            PG8_WAIT_L(8); PG8_BAR; PG8_WAIT_L(0); PG8_MMA(0, 0, At, B0); PG8_BAR; PG8_SCHED;
            PG8_LDB(B1, 0, 1); PG8_STAGE(PG8_SB(0, 0), b2, voffB);
            PG8_BAR; PG8_WAIT_L(0); PG8_MMA(0, 1, At, B1); PG8_BAR;
            PG8_LDA(At, 0, 1); PG8_STAGE(PG8_SA(0, 0), a2, voffA);
            PG8_BAR; PG8_WAIT_L(0); PG8_MMA(1, 0, At, B0); PG8_BAR; PG8_SCHED;
            PG8_STAGE(PG8_SB(0, 1), b2 + hstep, voffB);
            PG8_WAIT_V(6); PG8_BAR; PG8_MMA(1, 1, At, B1); PG8_BAR;
            PG8_LDB(B0, 1, 0); PG8_SCHED; PG8_LDA(At, 1, 0); PG8_STAGE(PG8_SA(0, 1), a2 + hstep, voffA);
            PG8_WAIT_L(8); PG8_BAR; PG8_WAIT_L(0); PG8_MMA(0, 0, At, B0); PG8_BAR; PG8_SCHED;
            PG8_LDB(B1, 1, 1); PG8_STAGE(PG8_SB(1, 0), b3, voffB);
            PG8_BAR; PG8_WAIT_L(0); PG8_MMA(0, 1, At, B1); PG8_BAR;
            PG8_LDA(At, 1, 1); PG8_STAGE(PG8_SA(1, 0), a3, voffA);
            PG8_BAR; PG8_WAIT_L(0); PG8_MMA(1, 0, At, B0); PG8_BAR; PG8_SCHED;
            PG8_STAGE(PG8_SB(1, 1), b3 + hstep, voffB);
            PG8_WAIT_V(6); PG8_BAR; PG8_MMA(1, 1, At, B1); PG8_BAR;
            }
        }
        if constexpr (ALIGN_EPI) { if (wr == 0) PG8_BAR; }
        if constexpr (!Epi::AFTER_DRAIN) { E(acc, cur, wr, wc, fr, fq); S.done(cur); }
        if (!has_next) break;
#pragma unroll
        for (int a = 0; a < 2; ++a)
#pragma unroll
            for (int b = 0; b < 2; ++b)
#pragma unroll
                for (int m = 0; m < 4; ++m)
#pragma unroll
                    for (int n = 0; n < 2; ++n) acc[a][b][m][n] = (f32x4){0.f, 0.f, 0.f, 0.f};
        cur = nxt; cA = nA; cB = nB; ++ui;
        if constexpr (ALIGN_EPI) { if (wr == 1) PG8_BAR; }
    }
    PG8_WAIT_V(0);
    if constexpr (!ALIGN_EPI) { if (wr == 0) PG8_BAR; }
    PG8_BAR;
#undef PG8_SA
#undef PG8_SB
#undef PG8_STAGE
#undef PG8_LDA
#undef PG8_LDB
#undef PG8_MMA
#undef PG8_WAIT_V
#undef PG8_WAIT_L
#undef PG8_BAR
#undef PG8_SCHED
}
}

constexpr int D = 1024, NB = 4, SEQ = 8192, CTXL = 256, ML = NB * SEQ, MC = NB * CTXL, MALL = ML + MC;
constexpr int FF = 2816, MI = 2048, NH = 4, DH = 512, HROWS = 2 * SEQ;
constexpr float EPS = 1e-6f, ML_NORM_EPS = 1e-5f;
constexpr float HY_MAX_DECAY = -15.350567286626973f, HY_MIN_DECAY = -3.0701134573253945f;
constexpr int NWAVES = 8, NTHR = 512;
constexpr int LDS_BYTES = 147456;

constexpr size_t MiB = 1u << 20;
constexpr size_t WS_MOD = 1 * MiB;
constexpr size_t WS_CTXX = 2 * MiB;
constexpr size_t WS_H3 = 6 * MiB;
constexpr size_t WS_KTC = 9 * MiB;
constexpr size_t WS_GWT = 11 * MiB;
constexpr size_t WS_WKQ = 11 * MiB + 256 * 1024;
constexpr size_t WS_NC = 12 * MiB;
constexpr size_t WS_WHIN = 16 * MiB, WS_WHOUT = 22 * MiB, WS_WMIN = 24 * MiB, WS_WMDN = 32 * MiB, WS_WUP0 = 36 * MiB, WS_WUP1 = 47 * MiB, WS_WDN0 = 58 * MiB, WS_WDN1 = 58 * MiB + 5767168;
constexpr size_t WS_GATES_L = 69 * MiB;
constexpr size_t WS_GATES_C = 70 * MiB;
constexpr size_t WS_GT_L = 71 * MiB;
constexpr size_t WS_GT_C = 73 * MiB;
constexpr size_t WS_GC = 73 * MiB + 512 * 1024;
constexpr size_t WS_DN = 74 * MiB;
constexpr size_t WS_RS = 79 * MiB;
constexpr size_t WS_INV = 79 * MiB + 512 * 1024;
constexpr size_t BIG = 80 * MiB;
constexpr size_t HY_H = BIG, HY_P = BIG + 66 * MiB, HY_KT = BIG + 264 * MiB, HY_ZT = BIG + 328 * MiB, HY_ZTC = BIG + 392 * MiB, HY_KS = BIG + 394 * MiB;
constexpr size_t FF_H = BIG, FF_A = BIG + 66 * MiB, FF_G = BIG + 248 * MiB;
constexpr size_t MS_H = BIG, MS_XM = BIG + 32 * MiB, MS_XC = BIG + 96 * MiB, MS_KT = BIG + 160 * MiB, MS_VT = BIG + 224 * MiB, MS_NF = BIG + 288 * MiB, MS_NB = BIG + 352 * MiB,
                 MS_KTC = BIG + 416 * MiB, MS_VTC = BIG + 420 * MiB;
constexpr size_t MS_S = MS_XM, MS_Z = MS_KT, MS_KN = MS_NF, MS_XCC = MS_NB, MS_XMC = MS_NB + 4 * MiB, MS_HC = MS_NB + 8 * MiB;
constexpr size_t WS_END = BIG + 424 * MiB;
static_assert(WS_END <= 512 * MiB, "workspace map");
static_assert(FF_G + (size_t)MALL * FF * 2 <= 512 * MiB && FF_A + (size_t)MALL * FF * 2 <= FF_G, "ffn map");
static_assert(HY_P + (size_t)MALL * 3072 * 2 <= HY_KT && HY_ZTC + (size_t)NB * D * CTXL * 2 <= HY_KS && HY_KS + 32 * MiB <= 512 * MiB, "hyena map");

__device__ __forceinline__ unsigned f2bf(float f) { unsigned u = __float_as_uint(f); return (u + 0x7fffu + ((u >> 16) & 1u)) >> 16; }
typedef __bf16 bf16x2_t __attribute__((ext_vector_type(2)));
__device__ __forceinline__ unsigned pk2(float lo, float hi) { const f32x2 v = {lo, hi}; const bf16x2_t b = __builtin_convertvector(v, bf16x2_t); return __builtin_bit_cast(unsigned, b); }
__device__ __forceinline__ float bf2f(unsigned short b) { return __uint_as_float(((unsigned)b) << 16); }
__device__ __forceinline__ float bflo(unsigned w) { return __uint_as_float(w << 16); }
__device__ __forceinline__ float bfhi(unsigned w) { return __uint_as_float(w & 0xffff0000u); }
__device__ __forceinline__ void unpack8(const u32x4 v, float (&o)[8]) { o[0] = bflo(v.x); o[1] = bfhi(v.x); o[2] = bflo(v.y); o[3] = bfhi(v.y); o[4] = bflo(v.z); o[5] = bfhi(v.z); o[6] = bflo(v.w); o[7] = bfhi(v.w); }
__device__ __forceinline__ u32x4 pack8(const float (&o)[8]) { u32x4 v; v.x = pk2(o[0], o[1]); v.y = pk2(o[2], o[3]); v.z = pk2(o[4], o[5]); v.w = pk2(o[6], o[7]); return v; }
__device__ __forceinline__ float wave_sum(float v) {
#pragma unroll
    for (int o = 1; o < 64; o <<= 1) v += __shfl_xor(v, o);
    return v;
}
__device__ __forceinline__ float silu_f(float x) { return x / (1.0f + __expf(-x)); }

typedef const float* cfptr_t;
struct Fr {
    LAS unsigned char* lds; int tid, lane, wave, gw, ngw, G, bid;
    const __attribute__((address_space(4))) cfptr_t* in; float* out; unsigned char* ws;
};
#define IN(i) (F.in[i])
enum { I_X = 0, I_C, I_CTX, I_CCTX, I_MODW, I_MODB, I_NORMG, I_FINALG, I_HWIN, I_HBIN, I_HSCW, I_HSCB, I_FW1, I_FB1, I_FW2, I_FB2, I_FW3, I_FB3, I_FWOUT, I_FREQ, I_HBIAS, I_HWOUT, I_HBOUT,
       I_MWIN, I_MCW, I_MCB, I_MWQ, I_MWK, I_MWV, I_MWG, I_MBG, I_MNW, I_MSKIP, I_MWDN, I_FWUP, I_FCW, I_FCB, I_FWDN };

__device__ __forceinline__ void transpose_item(const float* W, int K, int N, bf16* WT, LAS float* scr, int item, int lane) {
    const int nblk = N / 32, kb = item / nblk, nb = item % nblk, k0 = 64 * kb, n0 = 32 * nb;
    float tv[32];
#pragma unroll
    for (int i = 0; i < 32; ++i) tv[i] = W[(size_t)(k0 + 2 * i + (lane >> 5)) * N + n0 + (lane & 31)];
#pragma unroll
    for (int i = 0; i < 32; ++i) scr[(2 * i + (lane >> 5)) * 33 + (lane & 31)] = tv[i];
    asm volatile("s_waitcnt lgkmcnt(0)" ::: "memory");
    const int c = lane & 7;
#pragma unroll
    for (int j = 0; j < 4; ++j) { const int n = (lane >> 3) + 8 * j; const LAS float* s = scr + (8 * c) * 33 + n;
        u32x4 o; o.x = pk2(s[0 * 33], s[1 * 33]); o.y = pk2(s[2 * 33], s[3 * 33]); o.z = pk2(s[4 * 33], s[5 * 33]); o.w = pk2(s[6 * 33], s[7 * 33]);
        *(u32x4*)(WT + (size_t)(n0 + n) * K + k0 + 8 * c) = o; }
    asm volatile("s_waitcnt lgkmcnt(0)" ::: "memory");
}
__device__ __forceinline__ void transpose_matrix(Fr& F, const float* W, int K, int N, bf16* WT) {
    LAS float* scr = (LAS float*)(F.lds + F.wave * 16384);
    const int nitems = (K / 64) * (N / 32);
    for (int it = F.gw; it < nitems; it += F.ngw) transpose_item(W, K, N, WT, scr, it, F.lane);
}

__device__ __forceinline__ void ph_prologue(Fr& F) {
    unsigned char* ws = F.ws;
    {
        LAS float* scr = (LAS float*)(F.lds + F.wave * 16384);
        constexpr int I0 = (D / 64) * (3 * D / 32), I1 = (D / 64) * (D / 32), I2 = (D / 64) * (2 * MI / 32), I3 = (MI / 64) * (D / 32), I4 = (D / 64) * (2 * FF / 32), I5 = (FF / 64) * (D / 32);
        constexpr int NIT = I0 + I1 + I2 + I3 + 2 * I4 + 2 * I5;
        for (int it = F.gw; it < NIT; it += F.ngw) {
            int r = it;
            if (r < I0) { transpose_item(IN(I_HWIN), D, 3 * D, (bf16*)(ws + WS_WHIN), scr, r, F.lane); continue; } r -= I0;
            if (r < I1) { transpose_item(IN(I_HWOUT), D, D, (bf16*)(ws + WS_WHOUT), scr, r, F.lane); continue; } r -= I1;
            if (r < I2) { transpose_item(IN(I_MWIN), D, 2 * MI, (bf16*)(ws + WS_WMIN), scr, r, F.lane); continue; } r -= I2;
            if (r < I3) { transpose_item(IN(I_MWDN), MI, D, (bf16*)(ws + WS_WMDN), scr, r, F.lane); continue; } r -= I3;
            if (r < I4) { transpose_item(IN(I_FWUP), D, 2 * FF, (bf16*)(ws + WS_WUP0), scr, r, F.lane); continue; } r -= I4;
            if (r < I4) { transpose_item(IN(I_FWUP) + (size_t)D * 2 * FF, D, 2 * FF, (bf16*)(ws + WS_WUP1), scr, r, F.lane); continue; } r -= I4;
            if (r < I5) { transpose_item(IN(I_FWDN), FF, D, (bf16*)(ws + WS_WDN0), scr, r, F.lane); continue; } r -= I5;
            transpose_item(IN(I_FWDN) + (size_t)FF * D, FF, D, (bf16*)(ws + WS_WDN1), scr, r, F.lane);
        }
    }
    __syncthreads();
    {
        LAS float* sc = (LAS float*)F.lds;
        LAS float* red = (LAS float*)(F.lds + 32768);
        for (int i = F.tid; i < 5 * 1024; i += NTHR) { const int r = i >> 10, k = i & 1023; const float v = r < 4 ? IN(I_C)[r * 1024 + k] : IN(I_CCTX)[k]; sc[i] = silu_f(v); }
        __syncthreads();
        float* mod = (float*)(ws + WS_MOD);
        for (int it = F.bid; it < 192; it += F.G) {
            const int l = it / 96, n0 = (it % 96) * 64;
            const float* w = IN(I_MODW) + (size_t)l * 1024 * 6144 + n0 + F.lane;
            float a0 = 0.f, a1 = 0.f, a2 = 0.f, a3 = 0.f, a4 = 0.f;
            const int kb = F.wave * 128;
#pragma unroll 16
            for (int k = 0; k < 128; ++k) { const float wv = w[(size_t)(kb + k) * 6144];
                a0 += sc[kb + k] * wv; a1 += sc[1024 + kb + k] * wv; a2 += sc[2048 + kb + k] * wv; a3 += sc[3072 + kb + k] * wv; a4 += sc[4096 + kb + k] * wv; }
            red[(F.wave * 5 + 0) * 64 + F.lane] = a0; red[(F.wave * 5 + 1) * 64 + F.lane] = a1; red[(F.wave * 5 + 2) * 64 + F.lane] = a2; red[(F.wave * 5 + 3) * 64 + F.lane] = a3; red[(F.wave * 5 + 4) * 64 + F.lane] = a4;
            __syncthreads();
            if (F.tid < 320) { const int r = F.tid >> 6, ln = F.tid & 63; float s = 0.f;
#pragma unroll
                for (int w8 = 0; w8 < 8; ++w8) s += red[(w8 * 5 + r) * 64 + ln];
                mod[((size_t)l * 5 + r) * 6144 + n0 + ln] = s + IN(I_MODB)[l * 6144 + n0 + ln]; }
            __syncthreads();
        }
    }
    {
        float* h3 = (float*)(ws + WS_H3);
        const float* w1 = IN(I_FW1); const float* w2 = IN(I_FW2); const float* w3 = IN(I_FW3);
        const float fr = IN(I_FREQ)[F.lane], b1 = IN(I_FB1)[F.lane], b2 = IN(I_FB2)[F.lane], b3 = IN(I_FB3)[F.lane];
        for (int row = F.gw; row < SEQ + CTXL; row += F.ngw) {
            const int L = row < SEQ ? SEQ : CTXL, i = row < SEQ ? row : row - SEQ;
            const float tl = (float)i / (float)(L - 1), w = 6.283185307179586f * (float)i / (float)L;
            float pos = 0.f; const int k = F.lane;
            if (k == 0) pos = tl;
            else if (k <= 16) { const float band = 1e-4f + (float)(k - 1) * ((15.0f - 1e-4f) / 15.0f); pos = cosf(band * w); }
            else if (k <= 32) { const float band = 1e-4f + (float)(k - 17) * ((15.0f - 1e-4f) / 15.0f); pos = -sinf(band * w); }
            float s = b1;
#pragma unroll
            for (int kk = 0; kk < 33; ++kk) s += __shfl(pos, kk) * w1[kk * 64 + F.lane];
            float h = sinf(fr * s);
            s = b2;
#pragma unroll 16
            for (int kk = 0; kk < 64; ++kk) s += __shfl(h, kk) * w2[kk * 64 + F.lane];
            h = sinf(fr * s);
            s = b3;
#pragma unroll 16
            for (int kk = 0; kk < 64; ++kk) s += __shfl(h, kk) * w3[kk * 64 + F.lane];
            h = sinf(fr * s);
            h3[(size_t)row * 64 + F.lane] = h;
        }
    }
    {
        bf16* gwt = (bf16*)(ws + WS_GWT); float* wkq = (float*)(ws + WS_WKQ);
        const float* wq = IN(I_MWQ); const float* wk = IN(I_MWK); const float* wv = IN(I_MWV); const float* wg = IN(I_MWG);
        const int gt = F.bid * NTHR + F.tid, nt = F.G * NTHR;
        for (int i = gt; i < MI * 16; i += nt) { const int ch = i >> 4, g = i & 15, n = ch >> 2, c = ch & 3; float sa = 0.f, sb = 0.f;
#pragma unroll
            for (int e = 0; e < 4; ++e) { sa += wq[n * 16 + c * 4 + e] * wg[(size_t)(n * 4 + e) * 16 + g] + wk[n * 16 + c * 4 + e] * wg[(size_t)(MI + n * 4 + e) * 16 + g];
                sb += wv[n * 16 + c * 4 + e] * wg[(size_t)(2 * MI + n * 4 + e) * 16 + g]; }
            const size_t go = ((size_t)(ch >> 5) * 64 + g + 16 * ((ch & 31) >> 3)) * 8 + (ch & 7);
            gwt[go] = (bf16)f2bf(sa); gwt[go + 64 * 512] = (bf16)f2bf(sb); }
        const float sc = 0.044194173824159216f;
        for (int i = gt; i < 512 * 16; i += nt) { const int n = i >> 4, c = (i >> 2) & 3, c2 = i & 3; float s = 0.f;
#pragma unroll
            for (int e = 0; e < 4; ++e) s += wk[n * 16 + c * 4 + e] * wq[n * 16 + c2 * 4 + e];
            wkq[i] = s * sc; }
    }
}

__device__ __forceinline__ void kt_items(Fr& F, const float* h3rows, int L, float* KT) {
    const float* wout = IN(I_FWOUT);
    const int nitems = (L / 16) * 32, fr = F.lane & 15, fq = F.lane >> 4;
    for (int it = F.gw; it < nitems; it += F.ngw) {
        const int t0 = (it >> 5) * 16, n0 = (it & 31) * 64;
        float a[16];
#pragma unroll
        for (int ks = 0; ks < 16; ++ks) a[ks] = h3rows[(size_t)(t0 + fr) * 64 + 4 * ks + fq];
#pragma unroll
        for (int nt = 0; nt < 4; ++nt) {
            f32x4 acc = (f32x4){0.f, 0.f, 0.f, 0.f};
#pragma unroll
            for (int ks = 0; ks < 16; ++ks) acc = __builtin_amdgcn_mfma_f32_16x16x4f32(a[ks], wout[(size_t)(4 * ks + fq) * 2048 + n0 + nt * 16 + fr], acc, 0, 0, 0);
            const int n = n0 + nt * 16 + fr, dirn = n >> 10, c = n & 1023;
            const float delta = fabsf(HY_MIN_DECAY + (float)c * ((HY_MAX_DECAY - HY_MIN_DECAY) / 1023.0f)), il = 1.0f / (float)(L - 1);
            f32x4 o;
#pragma unroll
            for (int r = 0; r < 4; ++r) o[r] = acc[r] * __expf(-(float)(t0 + 4 * fq + r) * il * delta);
            *(f32x4*)(KT + ((size_t)c * 2 + dirn) * L + t0 + 4 * fq) = o;
        }
    }
}

__device__ __forceinline__ void modnorm_row(const float* xrow, const float* g, const float* sh, const float* sc, bf16* orow, int lane) {
    const f32x4* xr = (const f32x4*)xrow + lane; f32x4 v[4]; float s = 0.f;
#pragma unroll
    for (int j = 0; j < 4; ++j) { v[j] = xr[64 * j]; s += (v[j][0] * v[j][0] + v[j][1] * v[j][1]) + (v[j][2] * v[j][2] + v[j][3] * v[j][3]); }
    const float rinv = 1.0f / sqrtf(wave_sum(s) * (1.0f / 1024.0f) + EPS);
    u32x2* o8 = (u32x2*)orow + lane;
#pragma unroll
    for (int j = 0; j < 4; ++j) { const int c = 4 * lane + 256 * j; const f32x4 gg = *(const f32x4*)(g + c), s1 = *(const f32x4*)(sc + c), s0 = *(const f32x4*)(sh + c);
        const f32x4 y = (v[j] * rinv * gg) * (1.0f + s1) + s0; u32x2 w; w.x = pk2(y[0], y[1]); w.y = pk2(y[2], y[3]); o8[64 * j] = w; }
}
__device__ __forceinline__ void ph_modnorm(Fr& F, const float* xlat, int nlat, int b0, const float* xctx, int nctx, const float* g, const float* modl, int shoff, bf16* H) {
    const int nrows = nlat + nctx;
    for (int r = F.gw; r < nrows; r += 2 * F.ngw) {
        const int r2 = r + F.ngw; const bool has2 = r2 < nrows; const int rb = has2 ? r2 : r;
        const bool isl = r < nlat, isl2 = rb < nlat;
        const float* xa = isl ? xlat + (size_t)r * 1024 : xctx + (size_t)(r - nlat) * 1024; const float* xb = isl2 ? xlat + (size_t)rb * 1024 : xctx + (size_t)(rb - nlat) * 1024;
        const int ma = isl ? b0 + r / SEQ : 4, mb = isl2 ? b0 + rb / SEQ : 4;
        const f32x4* pa = (const f32x4*)xa + F.lane; const f32x4* pb = (const f32x4*)xb + F.lane; f32x4 va[4], vb[4]; float sa = 0.f, sb = 0.f;
#pragma unroll
        for (int j = 0; j < 4; ++j) { va[j] = pa[64 * j]; vb[j] = pb[64 * j]; }
#pragma unroll
        for (int j = 0; j < 4; ++j) { sa += (va[j][0] * va[j][0] + va[j][1] * va[j][1]) + (va[j][2] * va[j][2] + va[j][3] * va[j][3]); sb += (vb[j][0] * vb[j][0] + vb[j][1] * vb[j][1]) + (vb[j][2] * vb[j][2] + vb[j][3] * vb[j][3]); }
        const float ra = 1.0f / sqrtf(wave_sum(sa) * (1.0f / 1024.0f) + EPS), rbv = 1.0f / sqrtf(wave_sum(sb) * (1.0f / 1024.0f) + EPS);
        const float* sha = modl + (size_t)ma * 6144 + shoff; const float* shb = modl + (size_t)mb * 6144 + shoff;
        u32x2* oa = (u32x2*)(H + (size_t)r * 1024) + F.lane; u32x2* ob = (u32x2*)(H + (size_t)rb * 1024) + F.lane;
#pragma unroll
        for (int j = 0; j < 4; ++j) { const int c = 4 * F.lane + 256 * j; const f32x4 gg = *(const f32x4*)(g + c);
            const f32x4 ya = (va[j] * ra * gg) * (1.0f + *(const f32x4*)(sha + 1024 + c)) + *(const f32x4*)(sha + c);
            const f32x4 yb = (vb[j] * rbv * gg) * (1.0f + *(const f32x4*)(shb + 1024 + c)) + *(const f32x4*)(shb + c);
            oa[64 * j] = (u32x2){pk2(ya[0], ya[1]), pk2(ya[2], ya[3])};
            if (has2) ob[64 * j] = (u32x2){pk2(yb[0], yb[1]), pk2(yb[2], yb[3])}; }
    }
}

__device__ __forceinline__ void zt_items(Fr& F, const bf16* P, int rowbase, int nb, int Ls, bf16* ZT) {
    LAS unsigned char* tile = F.lds + F.wave * 16384;
    const float* scw = IN(I_HSCW); const float* scb = IN(I_HSCB);
    const int ntt = Ls / 64, nitems = nb * ntt * 16, tl = F.lane >> 3, c8 = F.lane & 7;
    for (int it = F.gw; it < nitems; it += F.ngw) {
        const int ct = it & 15, tt = (it >> 4) % ntt, b = (it >> 4) / ntt, t0 = tt * 64, ch = ct * 64 + c8 * 8;
        float w1[3][8], w2[3][8], b1[8], b2[8];
#pragma unroll
        for (int k = 0; k < 3; ++k) { const f32x4 a0 = *(const f32x4*)(scw + k * 3072 + 1024 + ch), a1 = *(const f32x4*)(scw + k * 3072 + 1024 + ch + 4), d0 = *(const f32x4*)(scw + k * 3072 + 2048 + ch), d1 = *(const f32x4*)(scw + k * 3072 + 2048 + ch + 4);
#pragma unroll
            for (int e = 0; e < 4; ++e) { w1[k][e] = a0[e]; w1[k][4 + e] = a1[e]; w2[k][e] = d0[e]; w2[k][4 + e] = d1[e]; } }
        { const f32x4 a0 = *(const f32x4*)(scb + 1024 + ch), a1 = *(const f32x4*)(scb + 1024 + ch + 4), d0 = *(const f32x4*)(scb + 2048 + ch), d1 = *(const f32x4*)(scb + 2048 + ch + 4);
#pragma unroll
            for (int e = 0; e < 4; ++e) { b1[e] = a0[e]; b1[4 + e] = a1[e]; b2[e] = d0[e]; b2[4 + e] = d1[e]; } }
        const bf16* pb = P + (size_t)(rowbase + b * Ls) * 3072 + ch;
#pragma unroll 2
        for (int i8 = 0; i8 < 8; ++i8) {
            const int tloc = i8 * 8 + tl, t = t0 + tloc, tm = t > 0 ? t - 1 : t, tp = t + 1 < Ls ? t + 1 : t; const float mm = t > 0 ? 1.f : 0.f, mp = t + 1 < Ls ? 1.f : 0.f;
            const u32x4 r1m = *(const u32x4*)(pb + (size_t)tm * 3072 + 1024), r1c = *(const u32x4*)(pb + (size_t)t * 3072 + 1024), r1p = *(const u32x4*)(pb + (size_t)tp * 3072 + 1024);
            const u32x4 r2m = *(const u32x4*)(pb + (size_t)tm * 3072 + 2048), r2c = *(const u32x4*)(pb + (size_t)t * 3072 + 2048), r2p = *(const u32x4*)(pb + (size_t)tp * 3072 + 2048);
            float xm[8], xc[8], xp[8], vm[8], vc[8], vp[8];
            unpack8(r1m, xm); unpack8(r1c, xc); unpack8(r1p, xp); unpack8(r2m, vm); unpack8(r2c, vc); unpack8(r2p, vp);
#pragma unroll
            for (int e = 0; e < 8; ++e) { const float a = w1[0][e] * (xm[e] * mm) + w1[1][e] * xc[e] + w1[2][e] * (xp[e] * mp) + b1[e], d = w2[0][e] * (vm[e] * mm) + w2[1][e] * vc[e] + w2[2][e] * (vp[e] * mp) + b2[e];
                *(LAS bf16*)(tile + (c8 * 8 + e) * 136 + tloc * 2) = (bf16)f2bf(a * d); }
        }
#pragma unroll
        for (int q = 0; q < 8; ++q) { const int cc = q * 8 + (F.lane >> 3), chk = F.lane & 7;
            const u32x2 lo = *(const LAS u32x2*)(tile + cc * 136 + chk * 16), hi = *(const LAS u32x2*)(tile + cc * 136 + chk * 16 + 8);
            u32x4 o; o.x = lo.x; o.y = lo.y; o.z = hi.x; o.w = hi.y;
            *(u32x4*)(ZT + ((size_t)b * 1024 + ct * 64 + cc) * Ls + t0 + chk * 8) = o; }
    }
}

__device__ __forceinline__ f32x2 cmul(f32x2 a, f32x2 b) { return (f32x2){a.x * b.x - a.y * b.y, a.x * b.y + a.y * b.x}; }
__device__ __forceinline__ f32x2 cmulc(f32x2 a, f32x2 b) { return (f32x2){a.x * b.x + a.y * b.y, a.y * b.x - a.x * b.y}; }
__device__ __forceinline__ f32x2 twid(float f) { return (f32x2){__builtin_amdgcn_cosf(f), __builtin_amdgcn_sinf(f)}; }
#define PH(e) ((e) + ((e) >> 4))
__device__ __forceinline__ void fft_fwd(LAS f32x2* buf, int tid, int plo, int phi) {
#pragma unroll 1
    for (int p = plo; p < phi; ++p) {
        const int lq = 12 - 2 * p, q = 1 << lq; const float invN = 1.0f / (float)(4 * q);
#pragma unroll 2
        for (int m = 0; m < 8; ++m) {
            const int g = tid + 512 * m, i = g & (q - 1), i0 = ((g >> lq) << (lq + 2)) + i;
            const int e0 = PH(i0), e1 = PH(i0 + q), e2 = PH(i0 + 2 * q), e3 = PH(i0 + 3 * q);
            const f32x2 a0 = buf[e0], a1 = buf[e1], a2 = buf[e2], a3 = buf[e3];
            const f32x2 t0 = a0 + a2, t1 = a0 - a2, t2 = a1 + a3, d = a1 - a3, t3 = (f32x2){d.y, -d.x};
            const f32x2 w1 = twid(-(float)i * invN), w2 = cmul(w1, w1), w3 = cmul(w2, w1);
            buf[e0] = t0 + t2; buf[e1] = cmul(t1 + t3, w1); buf[e2] = cmul(t0 - t2, w2); buf[e3] = cmul(t1 - t3, w3);
        }
        __syncthreads();
    }
}
__device__ __forceinline__ void fft_inv(LAS f32x2* buf, int tid, int plo, int phi) {
#pragma unroll 1
    for (int p = phi - 1; p >= plo; --p) {
        const int lq = 12 - 2 * p, q = 1 << lq; const float invN = 1.0f / (float)(4 * q);
#pragma unroll 2
        for (int m = 0; m < 8; ++m) {
            const int g = tid + 512 * m, i = g & (q - 1), i0 = ((g >> lq) << (lq + 2)) + i;
            const int e0 = PH(i0), e1 = PH(i0 + q), e2 = PH(i0 + 2 * q), e3 = PH(i0 + 3 * q);
            const f32x2 w1 = twid((float)i * invN), w2 = cmul(w1, w1), w3 = cmul(w2, w1);
            const f32x2 b0 = buf[e0], b1 = cmul(buf[e1], w1), b2 = cmul(buf[e2], w2), b3 = cmul(buf[e3], w3);
            const f32x2 t0 = b0 + b2, t1 = b0 - b2, t2 = b1 + b3, d = b1 - b3, t3 = (f32x2){-d.y, d.x};
            buf[e0] = t0 + t2; buf[e1] = t1 + t3; buf[e2] = t0 - t2; buf[e3] = t1 - t3;
        }
        __syncthreads();
    }
}
__device__ __forceinline__ void fwd16_A(f32x2 (&x)[16]) {
    const float C1 = 0.92387953251128674f, S1 = 0.38268343236508977f, R2 = 0.70710678118654752f;
#pragma unroll
    for (int i = 0; i < 4; ++i) {
        const f32x2 a0 = x[i], a1 = x[i + 4], a2 = x[i + 8], a3 = x[i + 12];
        const f32x2 t0 = a0 + a2, t1 = a0 - a2, t2 = a1 + a3, d = a1 - a3, t3 = (f32x2){d.y, -d.x};
        const f32x2 y1 = t1 + t3, y2 = t0 - t2, y3 = t1 - t3;
        x[i] = t0 + t2;
        if (i == 0) { x[4] = y1; x[8] = y2; x[12] = y3; }
        else if (i == 1) { x[5] = cmul(y1, (f32x2){C1, -S1}); x[9] = cmul(y2, (f32x2){R2, -R2}); x[13] = cmul(y3, (f32x2){S1, -C1}); }
        else if (i == 2) { x[6] = cmul(y1, (f32x2){R2, -R2}); x[10] = (f32x2){y2.y, -y2.x}; x[14] = cmul(y3, (f32x2){-R2, -R2}); }
        else { x[7] = cmul(y1, (f32x2){S1, -C1}); x[11] = cmul(y2, (f32x2){-R2, -R2}); x[15] = cmul(y3, (f32x2){-C1, S1}); }
    }
}
__device__ __forceinline__ void fwd16_B(f32x2 (&x)[16]) {
#pragma unroll
    for (int g = 0; g < 4; ++g) {
        const f32x2 a0 = x[4 * g], a1 = x[4 * g + 1], a2 = x[4 * g + 2], a3 = x[4 * g + 3];
        const f32x2 t0 = a0 + a2, t1 = a0 - a2, t2 = a1 + a3, d = a1 - a3, t3 = (f32x2){d.y, -d.x};
        x[4 * g] = t0 + t2; x[4 * g + 1] = t1 + t3; x[4 * g + 2] = t0 - t2; x[4 * g + 3] = t1 - t3;
    }
}
__device__ __forceinline__ void inv16_B(f32x2 (&x)[16]) {
#pragma unroll
    for (int g = 0; g < 4; ++g) {
        const f32x2 b0 = x[4 * g], b1 = x[4 * g + 1], b2 = x[4 * g + 2], b3 = x[4 * g + 3];
        const f32x2 t0 = b0 + b2, t1 = b0 - b2, t2 = b1 + b3, d = b1 - b3, t3 = (f32x2){-d.y, d.x};
        x[4 * g] = t0 + t2; x[4 * g + 1] = t1 + t3; x[4 * g + 2] = t0 - t2; x[4 * g + 3] = t1 - t3;
    }
}
__device__ __forceinline__ void inv16_A(f32x2 (&x)[16]) {
    const float C1 = 0.92387953251128674f, S1 = 0.38268343236508977f, R2 = 0.70710678118654752f;
#pragma unroll
    for (int i = 0; i < 4; ++i) {
        f32x2 b0 = x[i], b1 = x[i + 4], b2 = x[i + 8], b3 = x[i + 12];
        if (i == 1) { b1 = cmul(b1, (f32x2){C1, S1}); b2 = cmul(b2, (f32x2){R2, R2}); b3 = cmul(b3, (f32x2){S1, C1}); }
        else if (i == 2) { b1 = cmul(b1, (f32x2){R2, R2}); b2 = (f32x2){-b2.y, b2.x}; b3 = cmul(b3, (f32x2){-R2, R2}); }
        else if (i == 3) { b1 = cmul(b1, (f32x2){S1, C1}); b2 = cmul(b2, (f32x2){-R2, R2}); b3 = cmul(b3, (f32x2){-C1, -S1}); }
        const f32x2 t0 = b0 + b2, t1 = b0 - b2, t2 = b1 + b3, d = b1 - b3, t3 = (f32x2){-d.y, d.x};
        x[i] = t0 + t2; x[i + 4] = t1 + t3; x[i + 8] = t0 - t2; x[i + 12] = t1 - t3;
    }
}
__device__ __forceinline__ void fwd16(f32x2 (&x)[16]) { fwd16_A(x); fwd16_B(x); }
__device__ __forceinline__ void inv16(f32x2 (&x)[16]) { inv16_B(x); inv16_A(x); }
__device__ __forceinline__ void r16_fwd2(LAS f32x2* buf, int tid) {
#pragma unroll 1
  for (int lqp = 8; lqp >= 4; lqp -= 4) {
    const int qp = 1 << lqp; const float inv = 1.0f / (float)(16 * qp);
#pragma unroll
    for (int m = 0; m < 2; ++m) {
        const int g = tid + 512 * m, i = g & (qp - 1), e0 = ((g >> lqp) << (lqp + 4)) + i; f32x2 x[16];
#pragma unroll
        for (int j = 0; j < 16; ++j) x[j] = buf[PH(e0 + (j << lqp))];
        const f32x2 w1 = twid(-(float)i * inv), w2 = cmul(w1, w1), w3 = cmul(w2, w1), v1 = cmul(w2, w2), v2 = cmul(v1, v1), v3 = cmul(v2, v1);
        fwd16_A(x);
#pragma unroll
        for (int l = 0; l < 4; ++l) { x[l + 4] = cmul(x[l + 4], w1); x[l + 8] = cmul(x[l + 8], w2); x[l + 12] = cmul(x[l + 12], w3); }
        fwd16_B(x);
#pragma unroll
        for (int k = 0; k < 4; ++k) { x[4 * k + 1] = cmul(x[4 * k + 1], v1); x[4 * k + 2] = cmul(x[4 * k + 2], v2); x[4 * k + 3] = cmul(x[4 * k + 3], v3); }
#pragma unroll
        for (int j = 0; j < 16; ++j) buf[PH(e0 + (j << lqp))] = x[j];
    }
    __syncthreads();
  }
}
__device__ __forceinline__ void r16_inv2(LAS f32x2* buf, int tid) {
#pragma unroll 1
  for (int lqp = 4; lqp <= 8; lqp += 4) {
    const int qp = 1 << lqp; const float inv = 1.0f / (float)(16 * qp);
#pragma unroll
    for (int m = 0; m < 2; ++m) {
        const int g = tid + 512 * m, i = g & (qp - 1), e0 = ((g >> lqp) << (lqp + 4)) + i; f32x2 x[16];
#pragma unroll
        for (int j = 0; j < 16; ++j) x[j] = buf[PH(e0 + (j << lqp))];
        const f32x2 w1 = twid((float)i * inv), w2 = cmul(w1, w1), w3 = cmul(w2, w1), v1 = cmul(w2, w2), v2 = cmul(v1, v1), v3 = cmul(v2, v1);
#pragma unroll
        for (int k = 0; k < 4; ++k) { x[4 * k + 1] = cmul(x[4 * k + 1], v1); x[4 * k + 2] = cmul(x[4 * k + 2], v2); x[4 * k + 3] = cmul(x[4 * k + 3], v3); }
        inv16_B(x);
#pragma unroll
        for (int l = 0; l < 4; ++l) { x[l + 4] = cmul(x[l + 4], w1); x[l + 8] = cmul(x[l + 8], w2); x[l + 12] = cmul(x[l + 12], w3); }
        inv16_A(x);
#pragma unroll
        for (int j = 0; j < 16; ++j) buf[PH(e0 + (j << lqp))] = x[j];
    }
    __syncthreads();
  }
}
__device__ __forceinline__ float block_sum(Fr& F, float v, LAS float* red) {
    v = wave_sum(v);
    __syncthreads();
    if (F.lane == 0) red[F.wave] = v;
    __syncthreads();
    float s = 0.f;
#pragma unroll
    for (int w = 0; w < 8; ++w) s += red[w];
    return s;
}
__device__ __forceinline__ void ph_fftconv(Fr& F) {
    LAS f32x2* buf = (LAS f32x2*)F.lds; LAS float* red = (LAS float*)(F.lds + 139392);
    const float* KT = (const float*)(F.ws + HY_KT); const float* KTC = (const float*)(F.ws + WS_KTC);
    bf16* ZT = (bf16*)(F.ws + HY_ZT); bf16* ZTC = (bf16*)(F.ws + HY_ZTC);
    const int tid = F.tid;
    for (int c = F.bid; c < 1024; c += F.G) {
        const float bias = IN(I_HBIAS)[c];
        __syncthreads();
        float asum = 0.f;
        const f32x4* kf = (const f32x4*)(KT + (size_t)c * 2 * SEQ); const f32x4* kb = kf + SEQ / 4;
#pragma unroll
        for (int q = 0; q < 4; ++q) { const int i4 = tid + 512 * q; const f32x4 v = kf[i4];
            asum += fabsf(v[0]) + fabsf(v[1]) + fabsf(v[2]) + fabsf(v[3]);
            buf[PH(4 * i4)] = (f32x2){v[0], 0.f}; buf[PH(4 * i4 + 1)] = (f32x2){v[1], 0.f}; buf[PH(4 * i4 + 2)] = (f32x2){v[2], 0.f}; buf[PH(4 * i4 + 3)] = (f32x2){v[3], 0.f};
            const f32x4 u = kb[i4]; const int m = 4 * i4;
            if (m > 0) { buf[PH(16384 - m)] = (f32x2){u[0], 0.f}; asum += fabsf(u[0]); } else buf[PH(8192)] = (f32x2){0.f, 0.f};
            buf[PH(16384 - m - 1)] = (f32x2){u[1], 0.f}; buf[PH(16384 - m - 2)] = (f32x2){u[2], 0.f}; buf[PH(16384 - m - 3)] = (f32x2){u[3], 0.f};
            asum += fabsf(u[1]) + fabsf(u[2]) + fabsf(u[3]); }
        const float S = block_sum(F, asum, red);
        __syncthreads();
        fft_fwd(buf, tid, 0, 1); r16_fwd2(buf, tid);
        f32x4* Ks = (f32x4*)(F.ws + HY_KS) + (size_t)(F.bid & 255) * 8192 + tid * 8; const float ksc = 1.0f / (S * 16384.0f);
#pragma unroll 1
        for (int m = 0; m < 2; ++m) { const int pb = 17 * (tid + 512 * m); f32x2 x[16];
#pragma unroll
            for (int n = 0; n < 16; ++n) x[n] = buf[pb + n];
            fwd16(x);
#pragma unroll
            for (int n = 0; n < 8; ++n) Ks[m * 4096 + n] = (f32x4){x[2 * n].x * ksc, x[2 * n].y * ksc, x[2 * n + 1].x * ksc, x[2 * n + 1].y * ksc}; }
        const f32x2 dl = twid(-1.0f / 16384.0f);
#pragma unroll 1
        for (int pr = 0; pr < 2; ++pr) {
            bf16* z0 = ZT + ((size_t)(2 * pr) * 1024 + c) * SEQ; bf16* z1 = ZT + ((size_t)(2 * pr + 1) * 1024 + c) * SEQ;
            const int i8 = tid * 8;
            __syncthreads();
            {
                float a[8], b[8], cx[8], dx[8];
                unpack8(*(const u32x4*)(z0 + i8), a); unpack8(*(const u32x4*)(z1 + i8), b); unpack8(*(const u32x4*)(z0 + 4096 + i8), cx); unpack8(*(const u32x4*)(z1 + 4096 + i8), dx);
                f32x2 w1 = twid(-(float)i8 * (1.0f / 16384.0f));
#pragma unroll
                for (int e = 0; e < 8; ++e) { const f32x2 a0 = (f32x2){a[e], b[e]}, a1 = (f32x2){cx[e], dx[e]}, t3 = (f32x2){a1.y, -a1.x}; const f32x2 w2 = cmul(w1, w1), w3 = cmul(w2, w1);
                    buf[PH(i8 + e)] = a0 + a1; buf[PH(4096 + i8 + e)] = cmul(a0 + t3, w1); buf[PH(8192 + i8 + e)] = cmul(a0 - a1, w2); buf[PH(12288 + i8 + e)] = cmul(a0 - t3, w3);
                    w1 = cmul(w1, dl); }
            }
            __syncthreads();
            r16_fwd2(buf, tid);
#pragma unroll 1
            for (int m = 0; m < 2; ++m) { const int pb = 17 * (tid + 512 * m); f32x2 x[16];
#pragma unroll
                for (int n = 0; n < 16; ++n) x[n] = buf[pb + n];
                fwd16(x);
#pragma unroll
                for (int n = 0; n < 8; ++n) { const f32x4 k = Ks[m * 4096 + n]; x[2 * n] = cmul(x[2 * n], (f32x2){k[0], k[1]}); x[2 * n + 1] = cmul(x[2 * n + 1], (f32x2){k[2], k[3]}); }
                inv16(x);
#pragma unroll
                for (int n = 0; n < 16; ++n) buf[pb + n] = x[n]; }
            __syncthreads();
            r16_inv2(buf, tid);
            {
                float a[8], b[8], cx[8], dx[8];
                unpack8(*(const u32x4*)(z0 + i8), a); unpack8(*(const u32x4*)(z1 + i8), b); unpack8(*(const u32x4*)(z0 + 4096 + i8), cx); unpack8(*(const u32x4*)(z1 + 4096 + i8), dx);
                f32x2 w1 = twid(-(float)i8 * (1.0f / 16384.0f));
#pragma unroll
                for (int e = 0; e < 8; ++e) { const f32x2 w2 = cmul(w1, w1), w3 = cmul(w2, w1);
                    const f32x2 b0 = buf[PH(i8 + e)], b1 = cmulc(buf[PH(4096 + i8 + e)], w1), b2 = cmulc(buf[PH(8192 + i8 + e)], w2), b3 = cmulc(buf[PH(12288 + i8 + e)], w3);
                    const f32x2 t0 = b0 + b2, t1 = b0 - b2, t2 = b1 + b3, d = b1 - b3, t3 = (f32x2){-d.y, d.x};
                    const f32x2 y0 = t0 + t2, y1 = t1 + t3;
                    a[e] = y0.x + a[e] * bias; b[e] = y0.y + b[e] * bias; cx[e] = y1.x + cx[e] * bias; dx[e] = y1.y + dx[e] * bias;
                    w1 = cmul(w1, dl); }
                *(u32x4*)(z0 + i8) = pack8(a); *(u32x4*)(z1 + i8) = pack8(b); *(u32x4*)(z0 + 4096 + i8) = pack8(cx); *(u32x4*)(z1 + 4096 + i8) = pack8(dx);
            }
        }
        __syncthreads();
        {
            LAS float* kc = (LAS float*)F.lds; LAS float* zc = kc + 512;
            const float* kfc = KTC + (size_t)c * 2 * CTXL; float v = 0.f;
            { const int n = tid; if (n < 256) v = kfc[n]; else if (n == 256) v = 0.f; else v = kfc[CTXL + (512 - n)]; kc[n] = v; }
            const float Sc = block_sum(F, fabsf(v), red);
            for (int i = tid; i < 1024; i += NTHR) { const int b = i >> 8, t = i & 255; zc[i] = bf2f(ZTC[((size_t)b * 1024 + c) * CTXL + t]); }
            __syncthreads();
            const int b = tid >> 7, t2 = tid & 127; const float isc = 1.0f / Sc;
#pragma unroll
            for (int hh = 0; hh < 2; ++hh) { const int t = t2 + 128 * hh; float acc = 0.f;
#pragma unroll 8
                for (int s = 0; s < 256; ++s) acc += zc[b * 256 + s] * kc[(t - s) & 511];
                ZTC[((size_t)b * 1024 + c) * CTXL + t] = (bf16)f2bf(acc * isc + zc[b * 256 + t] * bias); }
        }
    }
}

__device__ __forceinline__ void u2_items(Fr& F, const bf16* P, int rowbase, int nb, int Ls, const bf16* YT, bf16* U2) {
    LAS unsigned char* tile = F.lds + F.wave * 16384;
    const float* scw = IN(I_HSCW); const float* scb = IN(I_HSCB);
    const int ntt = Ls / 64, nitems = nb * ntt * 16, tl = F.lane >> 3, c8 = F.lane & 7;
    for (int it = F.gw; it < nitems; it += F.ngw) {
        const int ct = it & 15, tt = (it >> 4) % ntt, b = (it >> 4) / ntt, t0 = tt * 64, ch = ct * 64 + c8 * 8;
#pragma unroll
        for (int q = 0; q < 8; ++q) { const int cc = q * 8 + (F.lane >> 3), chk = F.lane & 7;
            const u32x4 v = *(const u32x4*)(YT + ((size_t)b * 1024 + ct * 64 + cc) * Ls + t0 + chk * 8);
            *(LAS u32x2*)(tile + cc * 136 + chk * 16) = (u32x2){v.x, v.y}; *(LAS u32x2*)(tile + cc * 136 + chk * 16 + 8) = (u32x2){v.z, v.w}; }
        float w0[3][8], bb[8];
#pragma unroll
        for (int k = 0; k < 3; ++k) { const f32x4 a0 = *(const f32x4*)(scw + k * 3072 + ch), a1 = *(const f32x4*)(scw + k * 3072 + ch + 4);
#pragma unroll
            for (int e = 0; e < 4; ++e) { w0[k][e] = a0[e]; w0[k][4 + e] = a1[e]; } }
        { const f32x4 a0 = *(const f32x4*)(scb + ch), a1 = *(const f32x4*)(scb + ch + 4);
#pragma unroll
            for (int e = 0; e < 4; ++e) { bb[e] = a0[e]; bb[4 + e] = a1[e]; } }
        const bf16* pb = P + (size_t)(rowbase + b * Ls) * 3072 + ch; bf16* ub = U2 + (size_t)(rowbase + b * Ls) * 1024 + ch;
#pragma unroll 2
        for (int i8 = 0; i8 < 8; ++i8) {
            const int tloc = i8 * 8 + tl, t = t0 + tloc, tm = t > 0 ? t - 1 : t, tp = t + 1 < Ls ? t + 1 : t; const float mm = t > 0 ? 1.f : 0.f, mp = t + 1 < Ls ? 1.f : 0.f;
            const u32x4 rm = *(const u32x4*)(pb + (size_t)tm * 3072), rc = *(const u32x4*)(pb + (size_t)t * 3072), rp = *(const u32x4*)(pb + (size_t)tp * 3072);
            float xm[8], xc[8], xp[8], o[8];
            unpack8(rm, xm); unpack8(rc, xc); unpack8(rp, xp);
#pragma unroll
            for (int e = 0; e < 8; ++e) { const float x0 = w0[0][e] * (xm[e] * mm) + w0[1][e] * xc[e] + w0[2][e] * (xp[e] * mp) + bb[e]; o[e] = x0 * bf2f(*(const LAS bf16*)(tile + (c8 * 8 + e) * 136 + tloc * 2)); }
            *(u32x4*)(ub + (size_t)t * 1024) = pack8(o);
        }
    }
}

__device__ __forceinline__ void dw_item(const bf16* G, bf16* A, const float* cw, const float* cb, int f8, int rowtok0, int nx, int x0, bool up_ok, bool down_ok) {
    float w[9][8], bias[8];
#pragma unroll
    for (int k = 0; k < 9; ++k) { const float m = (k < 3) ? (up_ok ? 1.f : 0.f) : ((k >= 6) ? (down_ok ? 1.f : 0.f) : 1.f);
        const f32x4 w0 = *(const f32x4*)(cw + (size_t)k * FF + f8) * m, w1 = *(const f32x4*)(cw + (size_t)k * FF + f8 + 4) * m;
        w[k][0] = w0[0]; w[k][1] = w0[1]; w[k][2] = w0[2]; w[k][3] = w0[3]; w[k][4] = w1[0]; w[k][5] = w1[1]; w[k][6] = w1[2]; w[k][7] = w1[3]; }
    { const f32x4 b0 = *(const f32x4*)(cb + f8), b1 = *(const f32x4*)(cb + f8 + 4); bias[0] = b0[0]; bias[1] = b0[1]; bias[2] = b0[2]; bias[3] = b0[3]; bias[4] = b1[0]; bias[5] = b1[1]; bias[6] = b1[2]; bias[7] = b1[3]; }
    const int upo = up_ok ? -nx : 0, dno = down_ok ? nx : 0;
    const bf16* g0 = G + (size_t)rowtok0 * FF + f8; bf16* a0 = A + (size_t)rowtok0 * FF + f8;
    const u32x4 zero4 = (u32x4){0u, 0u, 0u, 0u};
    u32x4 cm[3], cc[3], cp[3];
    { const int xm = x0 > 0 ? x0 - 1 : 0; const bool okm = x0 > 0;
        cm[0] = *(const u32x4*)(g0 + (size_t)(xm + upo) * FF); cm[1] = *(const u32x4*)(g0 + (size_t)xm * FF); cm[2] = *(const u32x4*)(g0 + (size_t)(xm + dno) * FF);
        if (!okm) { cm[0] = zero4; cm[1] = zero4; cm[2] = zero4; }
        cc[0] = *(const u32x4*)(g0 + (size_t)(x0 + upo) * FF); cc[1] = *(const u32x4*)(g0 + (size_t)x0 * FF); cc[2] = *(const u32x4*)(g0 + (size_t)(x0 + dno) * FF); }
#pragma unroll 4
    for (int j = 0; j < 32; ++j) {
        const int x = x0 + j, xp = x + 1 < nx ? x + 1 : nx - 1; const bool okp = x + 1 < nx;
        cp[0] = *(const u32x4*)(g0 + (size_t)(xp + upo) * FF); cp[1] = *(const u32x4*)(g0 + (size_t)xp * FF); cp[2] = *(const u32x4*)(g0 + (size_t)(xp + dno) * FF);
        const u32x4 av = *(const u32x4*)(a0 + (size_t)x * FF);
        if (!okp) { cp[0] = zero4; cp[1] = zero4; cp[2] = zero4; }
        float acc[8];
#pragma unroll
        for (int e = 0; e < 8; ++e) acc[e] = bias[e];
#pragma unroll
        for (int dy = 0; dy < 3; ++dy) { float v[8];
            unpack8(cm[dy], v);
#pragma unroll
            for (int e = 0; e < 8; ++e) acc[e] += v[e] * w[dy * 3 + 0][e];
            unpack8(cc[dy], v);
#pragma unroll
            for (int e = 0; e < 8; ++e) acc[e] += v[e] * w[dy * 3 + 1][e];
            unpack8(cp[dy], v);
#pragma unroll
            for (int e = 0; e < 8; ++e) acc[e] += v[e] * w[dy * 3 + 2][e]; }
        float a[8]; unpack8(av, a);
#pragma unroll
        for (int e = 0; e < 8; ++e) a[e] = silu_f(acc[e]) * a[e];
        *(u32x4*)(a0 + (size_t)x * FF) = pack8(a);
#pragma unroll
        for (int dy = 0; dy < 3; ++dy) { cm[dy] = cc[dy]; cc[dy] = cp[dy]; }
    }
}
__device__ __forceinline__ void ph_dwconv(Fr& F, int layer, int nlat, int nctx) {
    bf16* A = (bf16*)(F.ws + FF_A); const bf16* G = (const bf16*)(F.ws + FF_G);
    const float* cw = IN(I_FCW) + (size_t)layer * 9 * FF; const float* cb = IN(I_FCB) + (size_t)layer * FF;
    const int ngrp = (F.G % 8 == 0) ? 8 : 1, xg = F.bid % ngrp, lb = F.bid / ngrp, nlb = F.G / ngrp;
    const int nseg = nlat / 32, band = nseg / ngrp;
    for (int i = lb * NTHR + F.tid; i < band * 352; i += nlb * NTHR) {
        const int sl = i / 352, f8 = (i - sl * 352) * 8, seg = xg * band + sl, grow = seg >> 1, gy = grow & 127;
        dw_item(G, A, cw, cb, f8, grow * 64, 64, (seg & 1) * 32, gy > 0, gy < 127);
    }
    const int nsegc = nctx / 32;
    for (int i = F.bid * NTHR + F.tid; i < nsegc * 352; i += F.G * NTHR) {
        const int sl = i / 352, f8 = (i - sl * 352) * 8;
        dw_item(G, A, cw, cb, f8, nlat + (sl >> 3) * CTXL, CTXL, (sl & 7) * 32, false, false);
    }
}

__device__ __forceinline__ void prep_items(Fr& F, const bf16* XM, int nb, int Ls, bf16* XC, bf16* KN, bf16* KT, bf16* VT) {
    LAS unsigned char* tk = F.lds + F.wave * 17408; LAS unsigned char* tv = tk + 8704;
    const int ntt = Ls / 64, nitems = nb * ntt * 32;
    const int tl = F.lane >> 3, c8 = F.lane & 7;
    for (int it = F.gw; it < nitems; it += F.ngw) {
        const int cg = it & 31, tt = (it >> 5) % ntt, b = (it >> 5) / ntt, t0 = tt * 64, ch0 = cg * 64 + c8 * 8, h = cg >> 3;
        float cw0[8], cw1[8], cw2[8], cbb[8], wkq[32], wv[32];
        { const float* p = IN(I_MCW) + ch0; const float* pb = IN(I_MCB) + ch0;
#pragma unroll
            for (int e = 0; e < 8; ++e) { cw0[e] = p[e]; cw1[e] = p[MI + e]; cw2[e] = p[2 * MI + e]; cbb[e] = pb[e]; }
            const float* q = (const float*)(F.ws + WS_WKQ) + (ch0 >> 2) * 16; const float* v = IN(I_MWV) + (ch0 >> 2) * 16;
#pragma unroll
            for (int e = 0; e < 32; ++e) { wkq[e] = q[e]; wv[e] = v[e]; } }
#pragma unroll 2
        for (int i8 = 0; i8 < 8; ++i8) {
            const int tloc = i8 * 8 + tl, t = t0 + tloc; const size_t row = (size_t)b * Ls + t;
            float xp[8], xm[8], xn[8];
            const size_t rowp = row - (t > 0 ? 1 : 0), rown = row + (t + 1 < Ls ? 1 : 0); const size_t ctile = (size_t)(ch0 >> 5) * 512 + ((ch0 & 31) >> 3) * 128;
            const u32x4 rm = *(const u32x4*)(XM + (row >> 4) * 32768 + ctile + (row & 15) * 8), rp = *(const u32x4*)(XM + (rowp >> 4) * 32768 + ctile + (rowp & 15) * 8), rn = *(const u32x4*)(XM + (rown >> 4) * 32768 + ctile + (rown & 15) * 8);
            unpack8(rm, xm); unpack8(rp, xp); unpack8(rn, xn);
            { const float mp = t > 0 ? 1.f : 0.f, mn = t + 1 < Ls ? 1.f : 0.f;
#pragma unroll
                for (int e = 0; e < 8; ++e) { xp[e] *= mp; xn[e] *= mn; } }
            float xc[8], kp[8], vv[8];
#pragma unroll
            for (int e = 0; e < 8; ++e) xc[e] = silu_f(cw0[e] * xp[e] + cw1[e] * xm[e] + cw2[e] * xn[e] + cbb[e]);
#pragma unroll
            for (int n = 0; n < 2; ++n)
#pragma unroll
                for (int o = 0; o < 4; ++o) { float sk = 0.f, sv = 0.f;
#pragma unroll
                    for (int c = 0; c < 4; ++c) { sk += xc[n * 4 + c] * wkq[n * 16 + c * 4 + o]; sv += xm[n * 4 + c] * wv[n * 16 + c * 4 + o]; }
                    kp[n * 4 + o] = sk; vv[n * 4 + o] = sv; }
            { const size_t to = ((size_t)(row >> 4) * 64 + (ch0 >> 5)) * 512 + (((unsigned)row & 15u) + 16u * ((ch0 & 31) >> 3)) * 8u;
              *(u32x4*)(XC + to) = pack8(xc); *(u32x4*)(KN + to) = pack8(kp); }
#pragma unroll
            for (int e = 0; e < 8; ++e) { *(LAS bf16*)(tk + (c8 * 8 + e) * 136 + tloc * 2) = (bf16)f2bf(kp[e]); *(LAS bf16*)(tv + (c8 * 8 + e) * 136 + tloc * 2) = (bf16)f2bf(vv[e]); }
        }
#pragma unroll
        for (int q = 0; q < 8; ++q) { const int dt = q >> 1, kq = q & 1, r = F.lane & 15, q4 = F.lane >> 4;
            const size_t tile = ((size_t)(t0 >> 7) * 32 + (cg & 7) * 4 + dt) * 4 + ((t0 & 127) >> 5) + kq;
            const size_t o = (size_t)(b * 4 + h) * 512 * Ls + tile * 512 + F.lane * 8;
            { const u32x2 lo = *(const LAS u32x2*)(tk + (dt * 16 + r) * 136 + kq * 64 + q4 * 16), hi = *(const LAS u32x2*)(tk + (dt * 16 + r) * 136 + kq * 64 + q4 * 16 + 8); *(u32x4*)(KT + o) = (u32x4){lo.x, lo.y, hi.x, hi.y}; }
            { const u32x2 lo = *(const LAS u32x2*)(tv + (dt * 16 + r) * 136 + kq * 64 + q4 * 16), hi = *(const LAS u32x2*)(tv + (dt * 16 + r) * 136 + kq * 64 + q4 * 16 + 8); *(u32x4*)(VT + o) = (u32x4){lo.x, lo.y, hi.x, hi.y}; }
        }
    }
}

__device__ __forceinline__ void gate_items(Fr& F, const bf16* XC, const bf16* XM, int R, float* GATES) {
    const bf16* gwt = (const bf16*)(F.ws + WS_GWT);
    const int fr = F.lane & 15, fq = F.lane >> 4, half = F.wave & 1, pr = F.wave >> 1, ntiles = R / 16;
    LAS f32x4* xch = (LAS f32x4*)(F.lds + pr * 1024);
    for (int base = F.bid * 4; base < ntiles; base += F.G * 4) {
        const int tile = base + pr; const bool ok = tile < ntiles; const int tl = ok ? tile : 0;
        f32x4 acc = (f32x4){0.f, 0.f, 0.f, 0.f};
        const bf16* ap = (half ? XM : XC) + (size_t)tl * 32768 + F.lane * 8; const bf16* bp = gwt + (size_t)half * 64 * 512 + F.lane * 8;
#pragma unroll 16
        for (int ks = 0; ks < 64; ++ks) acc = __builtin_amdgcn_mfma_f32_16x16x32_bf16(*(const bf16x8*)(ap + ks * 512), *(const bf16x8*)(bp + ks * 512), acc, 0, 0, 0);
        __syncthreads();
        if (half) xch[F.lane] = acc;
        __syncthreads();
        if (!half && ok) { acc = acc + xch[F.lane];
            const int r0 = tile * 16; const float bg = IN(I_MBG)[fr]; const bool isf = (fr >> 2) & 1;
#pragma unroll
            for (int r = 0; r < 4; ++r) { float x = acc[r] + bg; if (isf) x = fminf(x, 0.f) - log1pf(__expf(-fabsf(x))); GATES[(size_t)(r0 + 4 * fq + r) * 16 + fr] = x; } }
    }
}

__device__ __forceinline__ void cum_items(Fr& F, const float* GATES, int nb, int Ls, int gb0, int ctau0, f32x4* GT, float* GC) {
    const int R = nb * Ls, nch = Ls / 128, nitems = 2 * nb * 4 * nch;
    for (int it = F.gw; it < nitems; it += F.ngw) {
        const int c = it % nch, h = (it / nch) & 3, b = (it / nch / 4) % nb, dir = it / nch / 4 / nb;
        const int row0 = b * Ls + c * 128 + 2 * F.lane;
        const float lf0 = GATES[(size_t)row0 * 16 + dir * 8 + 4 + h], lf1 = GATES[(size_t)(row0 + 1) * 16 + dir * 8 + 4 + h];
        const float ig0 = GATES[(size_t)row0 * 16 + dir * 8 + h], ig1 = GATES[(size_t)(row0 + 1) * 16 + dir * 8 + h];
        float inc = lf0 + lf1;
#pragma unroll
        for (int o = 1; o < 64; o <<= 1) { const float t = __shfl_up(inc, o); if (F.lane >= o) inc += t; }
        const float tot = __shfl(inc, 63), exc = inc - (lf0 + lf1);
        float b0, b1;
        if (dir == 0) { b0 = exc + lf0; b1 = inc; } else { b0 = tot - exc; b1 = tot - exc - lf0; }
        GT[(size_t)(dir * 4 + h) * R + row0] = (f32x4){b0, ig0 - b0, __expf(b0), __expf(tot - b0 + ig0)};
        GT[(size_t)(dir * 4 + h) * R + row0 + 1] = (f32x4){b1, ig1 - b1, __expf(b1), __expf(tot - b1 + ig1)};
        if (F.lane == 0) GC[((size_t)(dir * 4 + gb0 + b) * 4 + h) * 66 + ctau0 + c] = __expf(tot);
    }
}

__device__ __forceinline__ void dn_item(Fr& F, const bf16* KTchunk, const f32x4* GTd0, const f32x4* GTd1, int row0, float* DN0, float* DN1) {
    LAS float* wl = (LAS float*)(F.lds + 1024);
    __syncthreads();
    if (F.tid < 128) wl[F.tid] = GTd0[row0 + F.tid][3]; else if (F.tid < 256) wl[F.tid] = GTd1[row0 + F.tid - 128][3];
    __syncthreads();
    const bf16* kr = KTchunk + (size_t)(F.tid >> 4) * 4 * 512 + (F.tid & 15) * 8; float s0 = 0.f, s1 = 0.f;
#pragma unroll 4
    for (int q = 0; q < 16; ++q) { const int ks = q >> 2, q4 = q & 3; float v[8]; unpack8(*(const u32x4*)(kr + ks * 512 + q4 * 128), v);
#pragma unroll
        for (int e = 0; e < 8; ++e) { s0 += v[e] * wl[q * 8 + e]; s1 += v[e] * wl[128 + q * 8 + e]; } }
    DN0[F.tid] = s0; DN1[F.tid] = s1;
}
__device__ __forceinline__ void ph_sphase(Fr& F, int hb, bool with_ctx) {
    const bf16* XC = (const bf16*)(F.ws + MS_XC); const bf16* KN = (const bf16*)(F.ws + MS_KN); const bf16* KT = (const bf16*)(F.ws + MS_KT);
    const f32x4* GT = (const f32x4*)(F.ws + WS_GT_L); float* DN = (float*)(F.ws + WS_DN); float* RS = (float*)(F.ws + WS_RS);
    bf16* S = (bf16*)(F.ws + MS_S);
    const int fr = F.lane & 15, fq = F.lane >> 4, w = F.wave;
    for (int it = F.bid; it < 512; it += F.G) {
        const int c = it & 63, h = (it >> 6) & 3, bl = it >> 8, gb = 2 * hb + bl;
        const int row0 = bl * SEQ + c * 128;
        dn_item(F, KT + (size_t)(bl * 4 + h) * 512 * SEQ + (size_t)c * 65536, GT + (size_t)(0 * 4 + h) * HROWS, GT + (size_t)(1 * 4 + h) * HROWS, row0,
                DN + (((size_t)(0 * 4 + gb) * 4 + h) * 66 + 2 + c) * 512, DN + (((size_t)(1 * 4 + gb) * 4 + h) * 66 + 2 + c) * 512);
        const int irow = row0 + 16 * w + fr;
        bf16x8 bq[16];
        { const bf16* p = XC + ((size_t)((row0 >> 4) + w) * 64 + h * 16) * 512 + F.lane * 8;
#pragma unroll
            for (int ks = 0; ks < 16; ++ks) bq[ks] = *(const bf16x8*)(p + ks * 512); }
        const f32x4 gf = GT[(size_t)(0 * 4 + h) * HROWS + irow], gbk = GT[(size_t)(1 * 4 + h) * HROWS + irow];
        float rsf = 0.f, rsb = 0.f;
        bf16* sf = S + ((size_t)(0 * 8 + bl * 4 + h) * 64 + c) * 16384; bf16* sb = S + ((size_t)(1 * 8 + bl * 4 + h) * 64 + c) * 16384;
#pragma unroll 1
        for (int jt = 0; jt < 8; ++jt) {
            f32x4 acc = (f32x4){0.f, 0.f, 0.f, 0.f};
            const bf16* ap = KN + ((size_t)((row0 >> 4) + jt) * 64 + h * 16) * 512 + F.lane * 8;
#pragma unroll
            for (int ks = 0; ks < 16; ++ks) acc = __builtin_amdgcn_mfma_f32_16x16x32_bf16(*(const bf16x8*)(ap + ks * 512), bq[ks], acc, 0, 0, 0);
            float vf[4], vb[4];
            const f32x4* gj0 = GT + (size_t)(0 * 4 + h) * HROWS + row0 + jt * 16 + 4 * fq; const f32x4* gj1 = GT + (size_t)(1 * 4 + h) * HROWS + row0 + jt * 16 + 4 * fq;
#pragma unroll
            for (int r = 0; r < 4; ++r) { const int j = jt * 16 + 4 * fq + r, i = 16 * w + fr;
                const float af = gj0[r][1], ab = gj1[r][1];
                vf[r] = (j <= i) ? acc[r] * __expf(gf[0] + af) : 0.f; vb[r] = (j >= i) ? acc[r] * __expf(gbk[0] + ab) : 0.f;
                rsf += vf[r]; rsb += vb[r]; }
            const size_t so = (size_t)(w * 4 + (jt >> 1)) * 512 + (fr + 16 * ((jt & 1) * 2 + (fq >> 1))) * 8 + (fq & 1) * 4;
            *(u32x2*)(sf + so) = (u32x2){pk2(vf[0], vf[1]), pk2(vf[2], vf[3])};
            *(u32x2*)(sb + so) = (u32x2){pk2(vb[0], vb[1]), pk2(vb[2], vb[3])};
        }
        rsf += __shfl_xor(rsf, 16); rsf += __shfl_xor(rsf, 32); rsb += __shfl_xor(rsb, 16); rsb += __shfl_xor(rsb, 32);
        if (fq == 0) { RS[(size_t)(0 * 4 + h) * HROWS + irow] = rsf; RS[(size_t)(1 * 4 + h) * HROWS + irow] = rsb; }
    }
    if (with_ctx) {
        const bf16* KTC2 = (const bf16*)(F.ws + MS_KTC); const f32x4* GTC = (const f32x4*)(F.ws + WS_GT_C);
        for (int it = F.bid; it < 32; it += F.G) {
            const int cc = it & 1, h = (it >> 1) & 3, gb = it >> 3;
            dn_item(F, KTC2 + (size_t)(gb * 4 + h) * 512 * CTXL + (size_t)cc * 65536, GTC + (size_t)(0 * 4 + h) * MC, GTC + (size_t)(1 * 4 + h) * MC, gb * CTXL + cc * 128,
                    DN + (((size_t)(0 * 4 + gb) * 4 + h) * 66 + cc) * 512, DN + (((size_t)(1 * 4 + gb) * 4 + h) * 66 + cc) * 512);
        }
    }
}

__device__ __forceinline__ bf16x8 ldg16(const char* ub, unsigned off) { return *(const bf16x8*)(ub + off); }
__device__ __forceinline__ void ph_scan(Fr& F, int hb) {
    const char* XC = (const char*)(F.ws + MS_XC); const char* KT = (const char*)(F.ws + MS_KT); const char* VT = (const char*)(F.ws + MS_VT);
    const char* KTC2 = (const char*)(F.ws + MS_KTC); const char* VTC2 = (const char*)(F.ws + MS_VTC);
    const char* S = (const char*)(F.ws + MS_S);
    const f32x4* GTL = (const f32x4*)(F.ws + WS_GT_L); const f32x4* GTC = (const f32x4*)(F.ws + WS_GT_C);
    const float* GC = (const float*)(F.ws + WS_GC); const float* DN = (const float*)(F.ws + WS_DN);
    float* NC = (float*)(F.ws + WS_NC);
    LAS unsigned char* cbf = F.lds;
    LAS float* wl = (LAS float*)(F.lds + 2 * 33280);
    LAS unsigned char* vtb = F.lds + 2 * 33280 + 1024;
    const int w = F.wave;
    for (int wi = F.bid; wi < 256; wi += F.G) {
        const int chain = wi & 15, slice = wi >> 4, dir = chain >> 3, bl = (chain >> 2) & 1, h = chain & 3, gb = 2 * hb + bl, e0 = slice * 32;
        char* NUM = (char*)(F.ws + (dir ? MS_NB : MS_NF));
        const bool nwriter = (slice == 0) && (w == 0);
        f32x4 acc[4][2];
#pragma unroll
        for (int a = 0; a < 4; ++a)
#pragma unroll
            for (int b = 0; b < 2; ++b) acc[a][b] = (f32x4){0.f, 0.f, 0.f, 0.f};
        float nreg[8];
#pragma unroll
        for (int e = 0; e < 8; ++e) nreg[e] = 0.f;
        __syncthreads();
        const char* ktc = KTC2 + (size_t)(gb * 4 + h) * 512 * CTXL * 2; const char* vtc = VTC2 + (size_t)(gb * 4 + h) * 512 * CTXL * 2;
        const char* ktl = KT + (size_t)(bl * 4 + h) * 512 * SEQ * 2;    const char* vtl = VT + (size_t)(bl * 4 + h) * 512 * SEQ * 2;
        { const int ctau = dir == 0 ? 0 : 1; const f32x4* gt = GTC + (size_t)(dir * 4 + h) * MC; if (F.tid < 128) wl[F.tid] = gt[gb * CTXL + ctau * 128 + F.tid][3];
          *(LAS bf16x8*)(vtb + w * 1024 + F.lane * 16) = ldg16(vtc + (size_t)ctau * 131072 + (e0 >> 4) * 4096 + w * 1024, F.lane * 16u); }
        __syncthreads();
        bf16x8 xf[16];
#pragma unroll
        for (int ks = 0; ks < 16; ++ks) xf[ks] = (bf16x8){0, 0, 0, 0, 0, 0, 0, 0};
#pragma unroll 1
        for (int s = 0; s < 66; ++s) {
            int tid_ = F.tid; asm volatile("" : "+v"(tid_));
            const int lane_ = tid_ & 63, fr = lane_ & 15, fq = lane_ >> 4; const unsigned l16 = lane_ * 16u;
            const int ctau = dir == 0 ? s : (s < 2 ? 1 - s : 67 - s);
            const bool isctx = ctau < 2; const int c = isctx ? ctau : ctau - 2;
            const char* ktu = (isctx ? ktc : ktl) + (size_t)c * 131072;
            const int row0 = isctx ? gb * CTXL + c * 128 : bl * SEQ + c * 128;
            const f32x4* gt = isctx ? GTC + (size_t)(dir * 4 + h) * MC : GTL + (size_t)(dir * 4 + h) * HROWS;
            const float Gd = GC[((size_t)(dir * 4 + gb) * 4 + h) * 66 + ctau];
            const float* dn = DN + (((size_t)(dir * 4 + gb) * 4 + h) * 66 + ctau) * 512;
            LAS unsigned char* cb_rd = cbf + (s & 1) * 33280; LAS unsigned char* cb_wr = cbf + ((s + 1) & 1) * 33280;
            const LAS float* wl_rd = wl + (s & 1) * 128; LAS float* wl_wr = wl + ((s + 1) & 1) * 128;
            const int s2 = s + 1, ct2 = dir == 0 ? s2 : (s2 < 2 ? 1 - s2 : 67 - s2); const bool has2 = s2 < 66, ic2 = ct2 < 2; const int c2 = ic2 ? ct2 : ct2 - 2;
            const char* xc2 = XC + ((size_t)(((bl * SEQ + c2 * 128) >> 4) + w) * 64 + h * 16) * 1024;
            const LAS unsigned char* vt_rd = vtb + (s & 1) * 8192; LAS unsigned char* vt_wr = vtb + ((s + 1) & 1) * 8192;
            bf16x8 kf[4][4], vf[2][4], sfr[4];
            bf16x8 vnext = (bf16x8){0, 0, 0, 0, 0, 0, 0, 0};
            if (has2) vnext = ldg16((ic2 ? vtc : vtl) + (size_t)c2 * 131072 + (e0 >> 4) * 4096 + w * 1024, l16);
#pragma unroll
            for (int et = 0; et < 2; ++et)
#pragma unroll
                for (int ks = 0; ks < 4; ++ks) vf[et][ks] = *(const LAS bf16x8*)(vt_rd + (et * 4 + ks) * 1024 + l16);
            if (!isctx) { const char* su = S + ((size_t)(dir * 8 + bl * 4 + h) * 64 + c) * 32768 + w * 4096;
#pragma unroll
                for (int ks = 0; ks < 4; ++ks) sfr[ks] = ldg16(su + ks * 1024, l16); }
#pragma unroll
            for (int ks = 0; ks < 1; ++ks)
#pragma unroll
                for (int dt = 0; dt < 4; ++dt) kf[ks][dt] = ldg16(ktu + (4 * w + dt) * 4096 + ks * 1024, l16);
            unsigned pf = 0u; const int s3 = s + 2;
            if (s3 < 66) {
                const int ct3 = dir == 0 ? s3 : (s3 < 2 ? 1 - s3 : 67 - s3); const bool ic3 = ct3 < 2; const int c3 = ic3 ? ct3 : ct3 - 2;
                const char* kt3 = (ic3 ? ktc : ktl) + (size_t)c3 * 131072; const char* vt3 = (ic3 ? vtc : vtl) + (size_t)c3 * 131072;
                const char* xc3 = XC + ((size_t)((bl * SEQ + c3 * 128) >> 4) * 64 + h * 16) * 1024; const char* s3p = S + ((size_t)(dir * 8 + bl * 4 + h) * 64 + c3) * 32768;
                const unsigned t = tid_; const char* ub = kt3; unsigned off = 0u;
                if (t < 64) { off = (slice * 64 + t) * 128u; }
                else if (t < 128) { ub = vt3; off = (e0 >> 4) * 4096u + (t - 64) * 128u; }
                else if (t < 192) { if (!ic3) { const unsigned ln = slice * 64 + (t - 128); ub = xc3; off = (ln >> 7) * 65536u + (ln & 127) * 128u; } }
                else if (t < 208) { if (!ic3) { ub = s3p; off = (slice * 16 + (t - 192)) * 128u; } }
                if (t < 208) pf = *(const volatile unsigned*)(ub + off);
            }
            if (!isctx) {
                const float Ei = *(const float*)((const char*)(gt + row0 + 16 * w) + (unsigned)fr * 16u + 8u);
                if (nwriter) { char* np = (char*)(NC + (((size_t)(dir * 2 + bl) * 4 + h) * 64 + c) * 512); const unsigned lo = lane_ * 32u;
                    *(f32x4*)(np + lo) = (f32x4){nreg[0], nreg[1], nreg[2], nreg[3]}; *(f32x4*)(np + lo + 16u) = (f32x4){nreg[4], nreg[5], nreg[6], nreg[7]}; }
                f32x4 a2[2] = {(f32x4){0.f, 0.f, 0.f, 0.f}, (f32x4){0.f, 0.f, 0.f, 0.f}};
#pragma unroll
                for (int ks = 0; ks < 16; ++ks)
#pragma unroll
                    for (int et = 0; et < 2; ++et) a2[et] = __builtin_amdgcn_mfma_f32_16x16x32_bf16(*(const LAS bf16x8*)(cb_rd + (16 * et + fr) * 1040 + ks * 64 + fq * 16), xf[ks], a2[et], 0, 0, 0);
                asm volatile("" ::: "memory");
#pragma unroll
                for (int ks = 1; ks < 4; ++ks)
#pragma unroll
                    for (int dt = 0; dt < 4; ++dt) kf[ks][dt] = ldg16(ktu + (4 * w + dt) * 4096 + ks * 1024, l16);
                a2[0] = a2[0] * Ei; a2[1] = a2[1] * Ei;
#pragma unroll
                for (int ks = 0; ks < 4; ++ks)
#pragma unroll
                    for (int et = 0; et < 2; ++et) a2[et] = __builtin_amdgcn_mfma_f32_16x16x32_bf16(vf[et][ks], sfr[ks], a2[et], 0, 0, 0);
                char* nu = NUM + ((size_t)row0 * MI + h * 512 + e0) * 2; const unsigned ln = ((16u * w + fr) * MI + 4u * fq) * 2u;
#pragma unroll
                for (int et = 0; et < 2; ++et) *(u32x2*)(nu + et * 32 + ln) = (u32x2){pk2(a2[et][0], a2[et][1]), pk2(a2[et][2], a2[et][3])};
            } else {
#pragma unroll
                for (int ks = 1; ks < 4; ++ks)
#pragma unroll
                    for (int dt = 0; dt < 4; ++dt) kf[ks][dt] = ldg16(ktu + (4 * w + dt) * 4096 + ks * 1024, l16);
            }
            if (has2) *(LAS bf16x8*)(vt_wr + w * 1024 + l16) = vnext;
            if (has2 && tid_ < 128) {
                const f32x4* gt2 = ic2 ? GTC + (size_t)(dir * 4 + h) * MC : GTL + (size_t)(dir * 4 + h) * HROWS;
                wl_wr[tid_] = *(const float*)((const char*)(gt2 + (ic2 ? gb * CTXL : bl * SEQ) + c2 * 128) + (unsigned)tid_ * 16u + 12u); }
#pragma unroll
            for (int a = 0; a < 4; ++a)
#pragma unroll
                for (int b = 0; b < 2; ++b) acc[a][b] = acc[a][b] * Gd;
#pragma unroll
            for (int ks = 0; ks < 4; ++ks) {
                bf16x8 bv[2];
#pragma unroll
                for (int et = 0; et < 2; ++et) { float v[8]; unpack8(__builtin_bit_cast(u32x4, vf[et][ks]), v);
#pragma unroll
                    for (int e = 0; e < 8; ++e) v[e] *= wl_rd[ks * 32 + 8 * fq + e];
                    const u32x4 pv = pack8(v); bv[et] = __builtin_bit_cast(bf16x8, pv); }
#pragma unroll
                for (int dt = 0; dt < 4; ++dt)
#pragma unroll
                    for (int et = 0; et < 2; ++et) acc[dt][et] = __builtin_amdgcn_mfma_f32_16x16x32_bf16(kf[ks][dt], bv[et], acc[dt][et], 0, 0, 0);
            }
            asm volatile("" ::: "memory");
            if (has2 && !ic2) {
#pragma unroll
                for (int ks = 0; ks < 16; ++ks) xf[ks] = ldg16(xc2 + ks * 1024, l16);
            }
            if (nwriter) { const unsigned lo = lane_ * 32u; const f32x4 d0 = *(const f32x4*)((const char*)dn + lo), d1 = *(const f32x4*)((const char*)dn + lo + 16u);
                nreg[0] = Gd * nreg[0] + d0[0]; nreg[1] = Gd * nreg[1] + d0[1]; nreg[2] = Gd * nreg[2] + d0[2]; nreg[3] = Gd * nreg[3] + d0[3];
                nreg[4] = Gd * nreg[4] + d1[0]; nreg[5] = Gd * nreg[5] + d1[1]; nreg[6] = Gd * nreg[6] + d1[2]; nreg[7] = Gd * nreg[7] + d1[3]; }
#pragma unroll
            for (int dt = 0; dt < 4; ++dt)
#pragma unroll
                for (int et = 0; et < 2; ++et) *(LAS u32x2*)(cb_wr + (16 * et + fr) * 1040 + (64 * w + 16 * dt + 4 * fq) * 2) = (u32x2){pk2(acc[dt][et][0], acc[dt][et][1]), pk2(acc[dt][et][2], acc[dt][et][3])};
            asm volatile("" :: "v"(pf));
            __syncthreads();
        }
    }
}

__device__ __forceinline__ void ph_mout(Fr& F) {
    bf16* NF = (bf16*)(F.ws + MS_NF); const bf16* NBk = (const bf16*)(F.ws + MS_NB); const bf16* XC = (const bf16*)(F.ws + MS_XC); const bf16* Z = (const bf16*)(F.ws + MS_Z);
    const float* NC = (const float*)(F.ws + WS_NC); const float* RS = (const float*)(F.ws + WS_RS); const f32x4* GTL = (const f32x4*)(F.ws + WS_GT_L);
    LAS unsigned char* xt = F.lds + F.wave * 16640;
    for (int it = F.gw; it < (HROWS / 16) * 4; it += F.ngw) {
        const int rt = it >> 2, h = it & 3, bl = rt >> 9, c = (rt >> 3) & 63;
        { const bf16* xp = XC + ((size_t)rt * 64 + h * 16) * 512 + F.lane * 8; u32x4 t[16];
#pragma unroll
            for (int ks = 0; ks < 16; ++ks) t[ks] = *(const u32x4*)(xp + ks * 512);
#pragma unroll
            for (int ks = 0; ks < 16; ++ks) *(LAS u32x4*)(xt + ks * 1040 + F.lane * 16) = t[ks]; }
        const float* n0 = NC + (((size_t)(0 * 2 + bl) * 4 + h) * 64 + c) * 512 + 8 * F.lane; const float* n1 = NC + (((size_t)(1 * 2 + bl) * 4 + h) * 64 + c) * 512 + 8 * F.lane;
        const f32x4 n00 = *(const f32x4*)n0, n01 = *(const f32x4*)(n0 + 4), n10 = *(const f32x4*)n1, n11 = *(const f32x4*)(n1 + 4);
        float nw[8], sk[8];
        { const float* pw = IN(I_MNW) + h * 512 + 8 * F.lane; const float* ps = IN(I_MSKIP) + h * 512 + 8 * F.lane;
#pragma unroll
            for (int e = 0; e < 8; ++e) { nw[e] = pw[e]; sk[e] = ps[e]; } }
#pragma unroll 2
        for (int r = 0; r < 16; ++r) {
            const int row = rt * 16 + r; const size_t o = (size_t)row * MI + h * 512 + 8 * F.lane;
            float nf[8], nb[8], xc[8], z[8];
            unpack8(*(const u32x4*)(NF + o), nf); unpack8(*(const u32x4*)(NBk + o), nb); unpack8(*(const u32x4*)(Z + o), z);
            unpack8(*(const LAS u32x4*)(xt + (F.lane >> 2) * 1040 + (r + 16 * (F.lane & 3)) * 16), xc);
            float d0 = xc[0] * n00[0] + xc[1] * n00[1] + xc[2] * n00[2] + xc[3] * n00[3] + xc[4] * n01[0] + xc[5] * n01[1] + xc[6] * n01[2] + xc[7] * n01[3];
            float d1 = xc[0] * n10[0] + xc[1] * n10[1] + xc[2] * n10[2] + xc[3] * n10[3] + xc[4] * n11[0] + xc[5] * n11[1] + xc[6] * n11[2] + xc[7] * n11[3];
            d0 = wave_sum(d0); d1 = wave_sum(d1);
            const float den0 = GTL[(size_t)(0 * 4 + h) * HROWS + row][2] * d0 + RS[(size_t)(0 * 4 + h) * HROWS + row], den1 = GTL[(size_t)(1 * 4 + h) * HROWS + row][2] * d1 + RS[(size_t)(1 * 4 + h) * HROWS + row];
            const float i0 = 1.0f / fmaxf(fabsf(den0), 1.0f), i1 = 1.0f / fmaxf(fabsf(den1), 1.0f);
            float s = 0.f;
#pragma unroll
            for (int e = 0; e < 8; ++e) { nf[e] = nf[e] * i0 + nb[e] * i1; s += nf[e]; }
            const float mu = wave_sum(s) * (1.0f / 512.0f); float q = 0.f;
#pragma unroll
            for (int e = 0; e < 8; ++e) { nf[e] -= mu; q += nf[e] * nf[e]; }
            const float rstd = 1.0f / sqrtf(wave_sum(q) * (1.0f / 512.0f) + ML_NORM_EPS);
#pragma unroll
            for (int e = 0; e < 8; ++e) nf[e] = (nf[e] * rstd * nw[e] + sk[e] * xc[e]) * silu_f(z[e]);
            *(u32x4*)(NF + o) = pack8(nf);
        }
    }
}

__device__ __forceinline__ void ph_final(Fr& F) {
    const float* g = IN(I_FINALG);
    for (int r = F.gw; r < ML; r += 2 * F.ngw) {
        const int r2 = r + F.ngw < ML ? r + F.ngw : r;
        f32x4* xa = (f32x4*)(F.out + (size_t)r * 1024) + F.lane; f32x4* xb = (f32x4*)(F.out + (size_t)r2 * 1024) + F.lane; f32x4 va[4], vb[4]; float sa = 0.f, sb = 0.f;
#pragma unroll
        for (int j = 0; j < 4; ++j) { va[j] = xa[64 * j]; vb[j] = xb[64 * j]; }
#pragma unroll
        for (int j = 0; j < 4; ++j) { sa += (va[j][0] * va[j][0] + va[j][1] * va[j][1]) + (va[j][2] * va[j][2] + va[j][3] * va[j][3]); sb += (vb[j][0] * vb[j][0] + vb[j][1] * vb[j][1]) + (vb[j][2] * vb[j][2] + vb[j][3] * vb[j][3]); }
        const float ra = 1.0f / sqrtf(wave_sum(sa) * (1.0f / 1024.0f) + EPS), rb = 1.0f / sqrtf(wave_sum(sb) * (1.0f / 1024.0f) + EPS);
#pragma unroll
        for (int j = 0; j < 4; ++j) { const f32x4 gg = *(const f32x4*)(g + 4 * F.lane + 256 * j); xa[64 * j] = va[j] * ra * gg; if (r2 != r) xb[64 * j] = vb[j] * rb * gg; }
    }
}

template <class Epi>
__device__ __forceinline__ void run_gemm(Fr& F, const bf16* A, const bf16* Bt, int M, int N, int K, const Epi& E) {
    pg8::Gemm g{A, Bt, M, N, K}; pg8::StaticOrder S; S.init(M, N, F.G, F.bid);
    pg8::gemm_phase<Epi, pg8::StaticOrder, true, true>(F.lds, g, S, E, F.tid);
}

struct Args { const float* in[38]; float* out; unsigned char* ws; int ph_lo, ph_hi; };
static_assert(sizeof(Args) == 328 && offsetof(Args, out) == 304 && offsetof(Args, ws) == 312 && offsetof(Args, ph_lo) == 320, "Args layout");
constexpr int N_PHASES = 36;


#define XB_TMO      128
#define XB_XCNT(j)  (256  + 64 * (j))
#define XB_XSUB(j)  (1280 + 64 * (j))
#define XB_XGEN(j)  (2304 + 64 * (j))
#define XB_TOP      3328
#define XB_TOPGEN   3392
#define XCD_BAR_WORDS 3456
#define XB_SPIN_CAP (1u << 22)
__device__ __forceinline__ unsigned xb_ld(unsigned* p)              { return __hip_atomic_load(p, __ATOMIC_RELAXED, __HIP_MEMORY_SCOPE_AGENT); }
__device__ __forceinline__ unsigned xb_add(unsigned* p, unsigned v) { return __hip_atomic_fetch_add(p, v, __ATOMIC_RELAXED, __HIP_MEMORY_SCOPE_AGENT); }
__device__ __forceinline__ unsigned xb_xcc_id() { return (unsigned)__builtin_amdgcn_s_getreg((3 << 11) | 20) & 0xFu; }
#define XB_SPIN(cond, bar) do { unsigned _sp = 0; while (cond) { __builtin_amdgcn_s_sleep(1); \
    if ((++_sp & 255u) == 0u) { if (xb_ld(&(bar)[XB_TMO])) break; if (_sp > XB_SPIN_CAP) { atomicAdd(&(bar)[XB_TMO], 1u); break; } } } } while (0)
__device__ __forceinline__ void xcd_barrier_complete(unsigned* bar, unsigned x, unsigned& nloc, unsigned& nx) {
    const unsigned G = gridDim.x * gridDim.y * gridDim.z;
    unsigned sum, cnt, mine, sp = 0u;
    for (;;) {
        sum = 0u; cnt = 0u; mine = 0u;
#pragma unroll
        for (unsigned j = 0; j < 16; ++j) { const unsigned c = xb_ld(&bar[XB_XCNT(j)]); sum += c; cnt += (c > 0u) ? 1u : 0u; mine = (j == x) ? c : mine; }
        if (sum == G) break;
        __builtin_amdgcn_s_sleep(1);
        if ((++sp & 255u) == 0u) { if (xb_ld(&bar[XB_TMO])) break; if (sp > XB_SPIN_CAP) { atomicAdd(&bar[XB_TMO], 1u); break; } }
    }
    nloc = mine > 0u ? mine : 1u; nx = cnt > 0u ? cnt : 1u;
}
__device__ __forceinline__ void xcd_barrier(unsigned* bar, volatile LAS unsigned* st) {
    asm volatile("s_waitcnt vmcnt(0)" ::: "memory");
    __syncthreads();
    if (threadIdx.x == 0) {
        const unsigned x = xb_xcc_id();
        __builtin_amdgcn_s_waitcnt(0);
        unsigned nloc = st[0], nx = st[1];
        if (nloc == 0u) { xcd_barrier_complete(bar, x, nloc, nx); st[0] = nloc; st[1] = nx; }
        const unsigned old = xb_add(&bar[XB_XSUB(x)], 1u);
        const unsigned gen = old / nloc;
        if (old + 1u == (gen + 1u) * nloc) {
            __builtin_amdgcn_fence(__ATOMIC_RELEASE, "agent");
            asm volatile("s_waitcnt vmcnt(0)" ::: "memory");
            const unsigned og = xb_add(&bar[XB_TOP], 1u);
            const unsigned tg = og / nx;
            if (og + 1u == (tg + 1u) * nx) xb_add(&bar[XB_TOPGEN], 1u);
            else XB_SPIN(xb_ld(&bar[XB_TOPGEN]) == tg, bar);
            __builtin_amdgcn_fence(__ATOMIC_ACQUIRE, "agent");
            xb_add(&bar[XB_XGEN(x)], 1u);
            asm volatile("s_waitcnt vmcnt(0)" ::: "memory");
        } else {
            XB_SPIN(xb_ld(&bar[XB_XGEN(x)]) == gen, bar);
            __builtin_amdgcn_fence(__ATOMIC_ACQUIRE, "agent");
            asm volatile("s_waitcnt vmcnt(0)" ::: "memory");
        }
    }
    __syncthreads();
}
#ifndef PROBE_MASK
#define PROBE_MASK 0ull
#endif
constexpr int BAR_LDS_OFF = LDS_BYTES - 64;
constexpr size_t WS_BAR = 0;
constexpr size_t WS_TS = 64 * 1024;

template <int ph>
__device__ __forceinline__ void run_phase(Fr& F) {
    unsigned char* ws = F.ws;
    float* mod = (float*)(ws + WS_MOD); float* ctxx = (float*)(ws + WS_CTXX);
    if constexpr (ph == 0) ph_prologue(F);
    else if constexpr (ph == 1) {
            kt_items(F, (const float*)(ws + WS_H3), SEQ, (float*)(ws + HY_KT));
            kt_items(F, (const float*)(ws + WS_H3) + (size_t)SEQ * 64, CTXL, (float*)(ws + WS_KTC));
            ph_modnorm(F, IN(I_X), ML, 0, IN(I_CTX), MC, IN(I_NORMG), mod, 0, (bf16*)(ws + HY_H));
        }
    else if constexpr (ph == 2) { pg8::EpiBf16 E{(bf16*)(ws + HY_P), 3072, IN(I_HBIN), 0, 0}; run_gemm(F, (const bf16*)(ws + HY_H), (const bf16*)(ws + WS_WHIN), MALL, 3072, 1024, E); }
    else if constexpr (ph == 3) { zt_items(F, (const bf16*)(ws + HY_P), 0, NB, SEQ, (bf16*)(ws + HY_ZT)); zt_items(F, (const bf16*)(ws + HY_P), ML, NB, CTXL, (bf16*)(ws + HY_ZTC)); }
    else if constexpr (ph == 4) ph_fftconv(F);
    else if constexpr (ph == 5) { u2_items(F, (const bf16*)(ws + HY_P), 0, NB, SEQ, (const bf16*)(ws + HY_ZT), (bf16*)(ws + HY_H)); u2_items(F, (const bf16*)(ws + HY_P), ML, NB, CTXL, (const bf16*)(ws + HY_ZTC), (bf16*)(ws + HY_H)); }
    else if constexpr (ph == 6) { pg8::EpiRes E{IN(I_X), F.out, IN(I_CTX), ctxx, ML, mod + 2048, 0, IN(I_HBOUT)}; run_gemm(F, (const bf16*)(ws + HY_H), (const bf16*)(ws + WS_WHOUT), MALL, 1024, 1024, E); }
    else if constexpr (ph == 7) ph_modnorm(F, F.out, ML, 0, ctxx, MC, IN(I_NORMG) + 1024, mod, 3072, (bf16*)(ws + FF_H));
    else if constexpr (ph == 8) { pg8::EpiBf16 E{(bf16*)(ws + FF_A), FF, nullptr, FF, (FF_G - FF_A) / 2}; run_gemm(F, (const bf16*)(ws + FF_H), (const bf16*)(ws + WS_WUP0), MALL, 2 * FF, 1024, E); }
    else if constexpr (ph == 9) ph_dwconv(F, 0, ML, MC);
    else if constexpr (ph == 10) { pg8::EpiRes E{F.out, F.out, ctxx, ctxx, ML, mod + 5120, 0, nullptr}; run_gemm(F, (const bf16*)(ws + FF_A), (const bf16*)(ws + WS_WDN0), MALL, 1024, FF, E); }
    else if constexpr (ph < 31) {
            constexpr int hb = (ph - 11) / 10, k = (ph - 11) % 10; const float* mod1 = mod + 5 * 6144;
            float* xh = F.out + (size_t)hb * HROWS * 1024;
            if constexpr (k == 0) { ph_modnorm(F, xh, HROWS, 2 * hb, ctxx, 0, IN(I_NORMG) + 2048, mod1, 0, (bf16*)(ws + MS_H));
                          if (hb == 0) ph_modnorm(F, xh, 0, 0, ctxx, MC, IN(I_NORMG) + 2048, mod1, 0, (bf16*)(ws + MS_HC)); }
            else if constexpr (k == 1) { { pg8::EpiBf16T E{(bf16*)(ws + MS_XM), MI / 32}; run_gemm(F, (const bf16*)(ws + MS_H), (const bf16*)(ws + WS_WMIN), HROWS, MI, 1024, E); }
                               if (hb == 0) { pg8::EpiBf16T E{(bf16*)(ws + MS_XMC), MI / 32}; run_gemm(F, (const bf16*)(ws + MS_HC), (const bf16*)(ws + WS_WMIN), MC, MI, 1024, E); } }
            else if constexpr (k == 2) { prep_items(F, (const bf16*)(ws + MS_XM), 2, SEQ, (bf16*)(ws + MS_XC), (bf16*)(ws + MS_KN), (bf16*)(ws + MS_KT), (bf16*)(ws + MS_VT));
                               if (hb == 0) prep_items(F, (const bf16*)(ws + MS_XMC), NB, CTXL, (bf16*)(ws + MS_XCC), (bf16*)(ws + MS_XCC + 16 * MiB), (bf16*)(ws + MS_KTC), (bf16*)(ws + MS_VTC)); }
            else if constexpr (k == 3) { gate_items(F, (const bf16*)(ws + MS_XC), (const bf16*)(ws + MS_XM), HROWS, (float*)(ws + WS_GATES_L));
                               if (hb == 0) gate_items(F, (const bf16*)(ws + MS_XCC), (const bf16*)(ws + MS_XMC), MC, (float*)(ws + WS_GATES_C)); }
            else if constexpr (k == 4) { cum_items(F, (const float*)(ws + WS_GATES_L), 2, SEQ, 2 * hb, 2, (f32x4*)(ws + WS_GT_L), (float*)(ws + WS_GC));
                               if (hb == 0) cum_items(F, (const float*)(ws + WS_GATES_C), NB, CTXL, 0, 0, (f32x4*)(ws + WS_GT_C), (float*)(ws + WS_GC)); }
            else if constexpr (k == 5) ph_sphase(F, hb, hb == 0);
            else if constexpr (k == 6) ph_scan(F, hb);
            else if constexpr (k == 7) { pg8::EpiBf16 E{(bf16*)(ws + MS_Z), MI, nullptr, 0, 0}; run_gemm(F, (const bf16*)(ws + MS_H), (const bf16*)(ws + WS_WMIN) + (size_t)MI * 1024, HROWS, MI, 1024, E); }
            else if constexpr (k == 8) ph_mout(F);
            else { pg8::EpiRes E{xh, xh, ctxx, ctxx, HROWS, mod1 + 2048, 2 * hb, nullptr}; run_gemm(F, (const bf16*)(ws + MS_NF), (const bf16*)(ws + WS_WMDN), HROWS, 1024, MI, E); }
        }
    else if constexpr (ph == 31) ph_modnorm(F, F.out, ML, 0, ctxx, 0, IN(I_NORMG) + 3072, mod + 5 * 6144, 3072, (bf16*)(ws + FF_H));
    else if constexpr (ph == 32) { pg8::EpiBf16 E{(bf16*)(ws + FF_A), FF, nullptr, FF, (FF_G - FF_A) / 2}; run_gemm(F, (const bf16*)(ws + FF_H), (const bf16*)(ws + WS_WUP1), ML, 2 * FF, 1024, E); }
    else if constexpr (ph == 33) ph_dwconv(F, 1, ML, 0);
    else if constexpr (ph == 34) { pg8::EpiRes E{F.out, F.out, ctxx, ctxx, ML, mod + 5 * 6144 + 5120, 0, nullptr}; run_gemm(F, (const bf16*)(ws + FF_A), (const bf16*)(ws + WS_WDN1), ML, 1024, FF, E); }
    else ph_final(F);
}

template <int ph>
__device__ __forceinline__ void phase_step(int ph_lo, int ph_hi, unsigned char* lds_raw) {
    if (ph_lo <= ph && ph < ph_hi) {
        const __attribute__((address_space(4))) unsigned char* kp = (const __attribute__((address_space(4))) unsigned char*)__builtin_amdgcn_kernarg_segment_ptr();
        asm volatile("" : "+s"(kp));
        Fr F;
        { int t_ = threadIdx.x, g_ = gridDim.x, b_ = blockIdx.x; asm volatile("" : "+v"(t_), "+s"(g_), "+s"(b_)); F.tid = t_; F.G = g_; F.bid = b_; }
        F.lds = (LAS unsigned char*)lds_raw; F.lane = F.tid & 63; F.wave = __builtin_amdgcn_readfirstlane(F.tid >> 6);
        F.gw = F.bid * NWAVES + F.wave; F.ngw = F.G * NWAVES;
        F.in = (const __attribute__((address_space(4))) cfptr_t*)kp;
        typedef float* fptr_t; typedef unsigned char* ucptr_t;
        F.out = *(const __attribute__((address_space(4))) fptr_t*)(kp + 304); F.ws = *(const __attribute__((address_space(4))) ucptr_t*)(kp + 312);
        if (PROBE_MASK != 0ull && F.bid == 0 && F.tid == 0) ((unsigned long long*)(F.ws + WS_TS))[ph] = __builtin_amdgcn_s_memrealtime();
        run_phase<ph>(F);
        if (ph + 1 < ph_hi) {
            if (ph == 0) {
                if (F.bid == 0) for (int i = F.tid; i < XCD_BAR_WORDS; i += NTHR) __hip_atomic_store((unsigned*)(F.ws + WS_BAR) + i, 0u, __ATOMIC_RELAXED, __HIP_MEMORY_SCOPE_AGENT);
                __syncthreads(); cg::this_grid().sync();
                if (F.tid == 0) (void)xb_add((unsigned*)(F.ws + WS_BAR) + XB_XCNT(xb_xcc_id()), 1u);
            }
            else xcd_barrier((unsigned*)(F.ws + WS_BAR), (volatile LAS unsigned*)(F.lds + BAR_LDS_OFF));
        }
        if (PROBE_MASK != 0ull && ph == N_PHASES - 1 && F.bid == 0) {
            if (F.tid == 0) { unsigned long long* ts = (unsigned long long*)(F.ws + WS_TS); const unsigned long long tend = __builtin_amdgcn_s_memrealtime(); unsigned long long tot = 0ull;
                for (int k = 0; k < N_PHASES; ++k) if ((PROBE_MASK >> k) & 1ull) tot += (k + 1 < N_PHASES ? ts[k + 1] : tend) - ts[k];
                while (__builtin_amdgcn_s_memrealtime() - tend < tot) __builtin_amdgcn_s_sleep(8); }
            __syncthreads();
        }
    }
}
template <int... I>
__device__ __forceinline__ void all_phases(int ph_lo, int ph_hi, unsigned char* lds_raw, std::integer_sequence<int, I...>) { (phase_step<I>(ph_lo, ph_hi, lds_raw), ...); }

__global__ void __launch_bounds__(NTHR, 2) fwd_kernel(Args args) {
    extern __shared__ __attribute__((aligned(16))) unsigned char lds_raw[];
    int ph_lo, ph_hi;
    { const __attribute__((address_space(4))) unsigned char* kp0 = (const __attribute__((address_space(4))) unsigned char*)__builtin_amdgcn_kernarg_segment_ptr();
      ph_lo = *(const __attribute__((address_space(4))) int*)(kp0 + 320); ph_hi = *(const __attribute__((address_space(4))) int*)(kp0 + 324); }
    if (threadIdx.x < 16) ((LAS unsigned*)((LAS unsigned char*)lds_raw + BAR_LDS_OFF))[threadIdx.x] = 0u;
    __syncthreads();
    all_phases(ph_lo, ph_hi, lds_raw, std::make_integer_sequence<int, N_PHASES>{});
}

extern "C" void kernel_launch(void* const* d_in, const int* in_sizes, int n_in, void* d_out, int out_size, void* d_ws, size_t ws_size, hipStream_t stream) {
    static int grid = 0;
    if (grid == 0) {
        int dev = 0, cus = 0, per_cu = 0;
        hipGetDevice(&dev);
        hipDeviceGetAttribute(&cus, hipDeviceAttributeMultiprocessorCount, dev);
        hipFuncSetAttribute((const void*)fwd_kernel, hipFuncAttributeMaxDynamicSharedMemorySize, LDS_BYTES);
        hipOccupancyMaxActiveBlocksPerMultiprocessor(&per_cu, (const void*)fwd_kernel, NTHR, LDS_BYTES);
        if (per_cu < 1) { fprintf(stderr, "kernel_launch: occupancy query says %d blocks per CU\n", per_cu); per_cu = 1; }
        grid = cus < 256 ? cus : 256;
        if (n_in != 38 || ws_size < WS_END) fprintf(stderr, "kernel_launch: unexpected n_in %d / ws_size %zu (need %zu)\n", n_in, ws_size, (size_t)WS_END);
        (void)hipGetLastError();
    }
    (void)hipMemsetAsync(d_ws, 0, 128 * 1024, stream);
    Args a{};
    for (int i = 0; i < 38; ++i) a.in[i] = (const float*)d_in[i];
    a.out = (float*)d_out; a.ws = (unsigned char*)d_ws; a.ph_lo = 0; a.ph_hi = N_PHASES;
    void* kargs[] = {&a};
    hipError_t e = hipLaunchCooperativeKernel((const void*)fwd_kernel, dim3(grid), dim3(NTHR), kargs, LDS_BYTES, stream);
    if (e != hipSuccess) fprintf(stderr, "cooperative launch failed: %s (grid %d)\n", hipGetErrorString(e), grid);
}
```

```cpp
#include <hip/hip_runtime.h>
#include <hip/hip_cooperative_groups.h>
#include <cstdio>
#include <cstdint>
#include <cstddef>
#include <utility>
namespace cg = cooperative_groups;

#define LAS __attribute__((address_space(3)))
typedef unsigned short bf16;
typedef short bf16x8 __attribute__((ext_vector_type(8)));
typedef float f32x4 __attribute__((ext_vector_type(4)));
typedef float f32x2 __attribute__((ext_vector_type(2)));
typedef unsigned u32x4 __attribute__((ext_vector_type(4)));
typedef unsigned u32x2 __attribute__((ext_vector_type(2)));

namespace pg8 {
#define PG8_LAS __attribute__((address_space(3)))
typedef unsigned short bf16_t;
constexpr int BM = 256, BK = 64, HALF = 128, HTB = HALF * BK * 2, STAGE_BYTES = 8 * HTB, NXCD = 8, WGM = 8;
__host__ __device__ __forceinline__ int lds_byte(int r, int c) { const int st = (r >> 4) * 2 + (c >> 5), rr = r & 15, cc = c & 31, ob = rr * 64 + cc * 2; return st * 1024 + (ob ^ (((ob >> 9) & 1) << 5)); }
__host__ __device__ __forceinline__ void stage_rc(int b, int& R, int& C) { const int st = b / 1024, sb = b % 1024, swz = sb ^ (((sb >> 9) & 1) << 5); R = (st >> 1) * 16 + swz / 64; C = (st & 1) * 32 + (swz % 64) / 2; }
__host__ __device__ __forceinline__ int perm32(int rho) { const int n = rho >> 4, i = rho & 15; return 8 * (i >> 2) + 4 * n + (i & 3); }
struct Unit { int pm, pn; };
struct Gemm { const bf16_t* A; const bf16_t* Bt; int M, N, K; };
struct StaticOrder {
    int nM, nN, nwg, G, c;
    __host__ __device__ void init(int M, int N, int G_, int c_) { nM = M / BM; nN = N / BM; nwg = nM * nN; G = G_; c = c_; }
    __host__ __device__ bool next(int i, Unit& u) const {
        const long L = (long)i * G + c; if (L >= nwg) return false;
        int wgid = (int)L; { const int q = nwg / NXCD, r = nwg % NXCD, xcd = wgid % NXCD, off = wgid / NXCD; wgid = (xcd < r ? xcd * (q + 1) : r * (q + 1) + (xcd - r) * q) + off; }
        const int nig = WGM * nN, gid = wgid / nig, fm = gid * WGM, gsz = (nM - fm) < WGM ? (nM - fm) : WGM;
        u.pm = fm + ((wgid % nig) % gsz); u.pn = (wgid % nig) / gsz; return true;
    }
    __device__ __forceinline__ void a_ready(const Unit&) const {}
    __device__ __forceinline__ void done(const Unit&) const {}
};
__device__ __forceinline__ unsigned cvt_pk_bf16(float lo, float hi) { unsigned r; asm volatile("v_cvt_pk_bf16_f32 %0, %1, %2" : "=v"(r) : "v"(lo), "v"(hi)); return r; }

struct EpiBf16 {
    static constexpr bool PERM = true, AFTER_DRAIN = false;
    bf16_t* O; int ldc; const float* bias; int split_cols; size_t split_stride;
    __device__ __forceinline__ void operator()(const f32x4 (&acc)[2][2][4][2], const Unit& u, int wr, int wc, int fr, int fq) const {
        const int row0 = u.pm * BM + wr * 64 + fr; int colt = u.pn * BM; bf16_t* base = O;
        if (split_cols) { const int t = colt / split_cols; base += (size_t)t * split_stride; colt -= t * split_cols; }
        const int col0 = colt + wc * 32 + 8 * fq, bcol0 = u.pn * BM + wc * 32 + 8 * fq;
        f32x4 bv[2][2];
#pragma unroll
        for (int bj = 0; bj < 2; ++bj)
#pragma unroll
            for (int n = 0; n < 2; ++n) bv[bj][n] = bias ? *(const f32x4*)(bias + bcol0 + bj * HALF + 4 * n) : (f32x4){0.f, 0.f, 0.f, 0.f};
#pragma unroll
        for (int ai = 0; ai < 2; ++ai)
#pragma unroll
            for (int m = 0; m < 4; ++m) { bf16_t* rowp = base + (size_t)(row0 + ai * HALF + m * 16) * ldc + col0;
#pragma unroll
                for (int bj = 0; bj < 2; ++bj) { f32x4 v0 = acc[ai][bj][m][0] + bv[bj][0], v1 = acc[ai][bj][m][1] + bv[bj][1];
                    u32x4 w; w.x = cvt_pk_bf16(v0[0], v0[1]); w.y = cvt_pk_bf16(v0[2], v0[3]); w.z = cvt_pk_bf16(v1[0], v1[1]); w.w = cvt_pk_bf16(v1[2], v1[3]);
                    *(u32x4*)(rowp + bj * HALF) = w; } }
    }
};
struct EpiBf16T {
    static constexpr bool PERM = true, AFTER_DRAIN = false;
    bf16_t* O; int ntc;
    __device__ __forceinline__ void operator()(const f32x4 (&acc)[2][2][4][2], const Unit& u, int wr, int wc, int fr, int fq) const {
        bf16_t* base = O + (size_t)(fr + 16 * fq) * 8;
#pragma unroll
        for (int ai = 0; ai < 2; ++ai)
#pragma unroll
            for (int m = 0; m < 4; ++m)
#pragma unroll
                for (int bj = 0; bj < 2; ++bj) { const f32x4 v0 = acc[ai][bj][m][0], v1 = acc[ai][bj][m][1];
                    u32x4 w; w.x = cvt_pk_bf16(v0[0], v0[1]); w.y = cvt_pk_bf16(v0[2], v0[3]); w.z = cvt_pk_bf16(v1[0], v1[1]); w.w = cvt_pk_bf16(v1[2], v1[3]);
                    *(u32x4*)(base + ((size_t)(u.pm * 16 + ai * 8 + wr * 4 + m) * ntc + u.pn * 8 + bj * 4 + wc) * 512) = w; }
    }
};
struct EpiRes {
    static constexpr bool PERM = false, AFTER_DRAIN = false;
    const float* res_lat; float* out_lat; const float* res_ctx; float* out_ctx; int rows_lat; const float* gate; int b0; const float* bias;
    __device__ __forceinline__ void operator()(const f32x4 (&acc)[2][2][4][2], const Unit& u, int wr, int wc, int fr, int fq) const {
        const int trow = u.pm * BM; const float* res; float* out; int modrow;
        if (trow < rows_lat) { res = res_lat + (size_t)trow * 1024; out = out_lat + (size_t)trow * 1024; modrow = b0 + trow / 8192; }
        else { const int rc = trow - rows_lat; res = res_ctx + (size_t)rc * 1024; out = out_ctx + (size_t)rc * 1024; modrow = 4; }
        const int col0 = u.pn * BM + wc * 32 + 4 * fq; const float* gp = gate + (size_t)modrow * 6144 + col0;
#pragma unroll
        for (int bj = 0; bj < 2; ++bj) {
            f32x4 bv[2], gv[2];
#pragma unroll
            for (int n = 0; n < 2; ++n) { bv[n] = bias ? *(const f32x4*)(bias + col0 + bj * HALF + n * 16) : (f32x4){0.f, 0.f, 0.f, 0.f}; gv[n] = *(const f32x4*)(gp + bj * HALF + n * 16); }
#pragma unroll
            for (int ai = 0; ai < 2; ++ai) {
                f32x4 rs[4][2];
#pragma unroll
                for (int m = 0; m < 4; ++m)
#pragma unroll
                    for (int n = 0; n < 2; ++n) rs[m][n] = *(const f32x4*)(res + (size_t)(wr * 64 + fr + ai * HALF + m * 16) * 1024 + col0 + bj * HALF + n * 16);
#pragma unroll
                for (int m = 0; m < 4; ++m)
#pragma unroll
                    for (int n = 0; n < 2; ++n) *(f32x4*)(out + (size_t)(wr * 64 + fr + ai * HALF + m * 16) * 1024 + col0 + bj * HALF + n * 16) = rs[m][n] + gv[n] * (acc[ai][bj][m][n] + bv[n]);
                asm volatile("" ::: "memory");
            }
        }
    }
};

template <class Epi, class Sched, bool ALIGN_EPI = false, bool SP2 = false>
__device__ __forceinline__ void gemm_phase(PG8_LAS unsigned char* lds, const Gemm g, const Sched& S, const Epi& E, const int tid) {
    const int wid = __builtin_amdgcn_readfirstlane(tid >> 6), lane = tid & 63, wr = wid >> 2, wc = wid & 3, fr = lane & 15, fq = lane >> 4;
    const int K = g.K, nt = K / BK;
    unsigned voffA[2], voffB[2];
#pragma unroll
    for (int i = 0; i < 2; ++i) { int R, C; stage_rc(tid * 16 + i * 8192, R, C); const int Rb = Epi::PERM ? ((R & ~31) + perm32(R & 31)) : R;
        voffA[i] = (unsigned)(R * K + C) * 2u; voffB[i] = (unsigned)(Rb * K + C) * 2u; }
    const size_t kstep = (size_t)(BK * 2);
    const size_t hstep = (size_t)HALF * K * 2;
    const size_t tstep = 2 * hstep;
    const unsigned ldsw = (unsigned)wid * 1024u;
    const int aoff = lds_byte(wr * 64 + fr, fq * 8), boff = lds_byte(wc * 32 + fr, fq * 8);
#define PG8_SA(b, h) (((b) * 2 + (h)) * HTB)
#define PG8_SB(b, h) ((4 + (b) * 2 + (h)) * HTB)
#define PG8_STAGE(bufoff, gbase, voff) do { _Pragma("unroll") for (int _i = 0; _i < 2; ++_i) \
        __builtin_amdgcn_global_load_lds((const unsigned*)((const char*)(gbase) + (voff)[_i]), (PG8_LAS unsigned*)(lds + (bufoff) + ldsw + _i * 8192), 16, 0, 0); } while (0)
#define PG8_LDA(dst, b, h) do { _Pragma("unroll") for (int m = 0; m < 4; ++m) _Pragma("unroll") for (int k = 0; k < 2; ++k) dst[m][k] = *(const PG8_LAS bf16x8*)(lds + PG8_SA(b, h) + aoff + m * 2048 + k * 1024); } while (0)
#define PG8_LDB(dst, b, h) do { _Pragma("unroll") for (int n = 0; n < 2; ++n) _Pragma("unroll") for (int k = 0; k < 2; ++k) dst[n][k] = *(const PG8_LAS bf16x8*)(lds + PG8_SB(b, h) + boff + n * 2048 + k * 1024); } while (0)
#define PG8_MMA(ai, bj, At, Bt) do { __builtin_amdgcn_s_setprio(1); _Pragma("unroll") for (int m = 0; m < 4; ++m) _Pragma("unroll") for (int n = 0; n < 2; ++n) _Pragma("unroll") for (int k = 0; k < 2; ++k) \
        acc[ai][bj][m][n] = __builtin_amdgcn_mfma_f32_16x16x32_bf16(Bt[n][k], At[m][k], acc[ai][bj][m][n], 0, 0, 0); __builtin_amdgcn_s_setprio(0); } while (0)
#define PG8_WAIT_V(n) asm volatile("s_waitcnt vmcnt(" #n ")" ::: "memory")
#define PG8_WAIT_L(n) asm volatile("s_waitcnt lgkmcnt(" #n ")" ::: "memory")
#define PG8_BAR __builtin_amdgcn_s_barrier()
#define PG8_SCHED __builtin_amdgcn_sched_barrier(0)
    Unit cur, nxt; int ui = 0;
    if (!S.next(0, cur)) return;
    f32x4 acc[2][2][4][2];
#pragma unroll
    for (int a = 0; a < 2; ++a)
#pragma unroll
        for (int b = 0; b < 2; ++b)
#pragma unroll
            for (int m = 0; m < 4; ++m)
#pragma unroll
                for (int n = 0; n < 2; ++n) acc[a][b][m][n] = (f32x4){0.f, 0.f, 0.f, 0.f};
    bf16x8 At[4][2], B0[2][2], B1[2][2];
    const char* cA = (const char*)g.A + (size_t)cur.pm * tstep; const char* cB = (const char*)g.Bt + (size_t)cur.pn * tstep;
    S.a_ready(cur);
    if constexpr (SP2) {
        PG8_STAGE(PG8_SB(0, 0), cB, voffB); PG8_STAGE(PG8_SB(0, 1), cB + hstep, voffB); PG8_STAGE(PG8_SA(0, 0), cA, voffA); PG8_STAGE(PG8_SA(0, 1), cA + hstep, voffA);
        if (wr == 1) PG8_BAR;
        PG8_WAIT_V(2); PG8_BAR;
        PG8_STAGE(PG8_SB(1, 0), cB + kstep, voffB); PG8_STAGE(PG8_SA(1, 0), cA + kstep, voffA); PG8_STAGE(PG8_SB(1, 1), cB + hstep + kstep, voffB);
        PG8_WAIT_V(6); PG8_BAR;
    } else {
        PG8_STAGE(PG8_SB(0, 0), cB, voffB); PG8_STAGE(PG8_SA(0, 0), cA, voffA); PG8_STAGE(PG8_SB(0, 1), cB + hstep, voffB); PG8_STAGE(PG8_SA(0, 1), cA + hstep, voffA);
        if (wr == 1) PG8_BAR;
        PG8_WAIT_V(4); PG8_BAR;
        PG8_STAGE(PG8_SB(1, 0), cB + kstep, voffB); PG8_STAGE(PG8_SA(1, 0), cA + kstep, voffA); PG8_STAGE(PG8_SB(1, 1), cB + hstep + kstep, voffB);
        PG8_WAIT_V(6); PG8_BAR;
    }
    for (;;) {
        const bool has_next = S.next(ui + 1, nxt);
        const char* nA = has_next ? (const char*)g.A + (size_t)nxt.pm * tstep : cA; const char* nB = has_next ? (const char*)g.Bt + (size_t)nxt.pn * tstep : cB;
        for (int t = 0; t < nt; t += 2) {
            const bool last = (t == nt - 2);
            const char* a1 = cA + (size_t)(t + 1) * kstep;
            const char* a2 = last ? nA : cA + (size_t)(t + 2) * kstep; const char* b2 = last ? nB : cB + (size_t)(t + 2) * kstep;
            const char* a3 = a2 + kstep; const char* b3 = b2 + kstep;
            if (last && has_next) S.a_ready(nxt);
            if constexpr (SP2) {
            PG8_LDB(B0, 0, 0); PG8_LDB(B1, 0, 1); PG8_SCHED; PG8_LDA(At, 0, 0); PG8_STAGE(PG8_SA(1, 1), a1 + hstep, voffA);
            PG8_WAIT_V(8); PG8_WAIT_L(0); PG8_BAR; PG8_MMA(0, 0, At, B0); PG8_MMA(0, 1, At, B1); PG8_BAR; PG8_SCHED;
            PG8_LDA(At, 0, 1); PG8_STAGE(PG8_SB(0, 0), b2, voffB); PG8_STAGE(PG8_SB(0, 1), b2 + hstep, voffB); PG8_STAGE(PG8_SA(0, 0), a2, voffA);
            PG8_WAIT_V(8); PG8_WAIT_L(0); PG8_BAR; PG8_MMA(1, 0, At, B0); PG8_MMA(1, 1, At, B1); PG8_BAR; PG8_SCHED;
            PG8_LDB(B0, 1, 0); PG8_LDB(B1, 1, 1); PG8_SCHED; PG8_LDA(At, 1, 0); PG8_STAGE(PG8_SA(0, 1), a2 + hstep, voffA);
            PG8_WAIT_V(8); PG8_WAIT_L(0); PG8_BAR; PG8_MMA(0, 0, At, B0); PG8_MMA(0, 1, At, B1); PG8_BAR; PG8_SCHED;
            PG8_LDA(At, 1, 1); PG8_STAGE(PG8_SB(1, 0), b3, voffB); PG8_STAGE(PG8_SB(1, 1), b3 + hstep, voffB); PG8_STAGE(PG8_SA(1, 0), a3, voffA);
            PG8_WAIT_V(8); PG8_WAIT_L(0); PG8_BAR; PG8_MMA(1, 0, At, B0); PG8_MMA(1, 1, At, B1); PG8_BAR; PG8_SCHED;
            } else {
            PG8_LDB(B0, 0, 0); PG8_SCHED; PG8_LDA(At, 0, 0); PG8_STAGE(PG8_SA(1, 1), a1 + hstep, voffA);
            PG8_WAIT_L(8); PG8_BAR; PG8_WAIT_L(0); PG8_MMA(0, 0, At, B0); PG8_BAR; PG8_SCHED;
            PG8_LDB(B1, 0, 1); PG8_STAGE(PG8_SB(0, 0), b2, voffB);
            PG8_BAR; PG8_WAIT_L(0); PG8_MMA(0, 1, At, B1); PG8_BAR;
            PG8_LDA(At, 0, 1); PG8_STAGE(PG8_SA(0, 0), a2, voffA);
            PG8_BAR; PG8_WAIT_L(0); PG8_MMA(1, 0, At, B0); PG8_BAR; PG8_SCHED;
            PG8_STAGE(PG8_SB(0, 1), b2 + hstep, voffB);
            PG8_WAIT_V(6); PG8_BAR; PG8_MMA(1, 1, At, B1); PG8_BAR;
            PG8_LDB(B0, 1, 0); PG8_SCHED; PG8_LDA(At, 1, 0); PG8_STAGE(PG8_SA(0, 1), a2 + hstep, voffA);
            PG8_WAIT_L(8); PG8_BAR; PG8_WAIT_L(0); PG8_MMA(0, 0, At, B0); PG8_BAR; PG8_SCHED;
            PG8_LDB(B1, 1, 1); PG8_STAGE(PG8_SB(1, 0), b3, voffB);
            PG8_BAR; PG8_WAIT_L(0); PG8_MMA(0, 1, At, B1); PG8_BAR;
            PG8_LDA(At, 1, 1); PG8_STAGE(PG8_SA(1, 0), a3, voffA);
            PG8_BAR; PG8_WAIT_L(0); PG8_MMA(1, 0, At, B0); PG8_BAR; PG8_SCHED;
            PG8_STAGE(PG8_SB(1, 1), b3 + hstep, voffB);
            PG8_WAIT_V(6); PG8_BAR; PG8_MMA(1, 1, At, B1); PG8_BAR;
            }
        }
        if constexpr (ALIGN_EPI) { if (wr == 0) PG8_BAR; }
        if constexpr (!Epi::AFTER_DRAIN) { E(acc, cur, wr, wc, fr, fq); S.done(cur); }
        if (!has_next) break;
#pragma unroll
        for (int a = 0; a < 2; ++a)
#pragma unroll
            for (int b = 0; b < 2; ++b)
#pragma unroll
                for (int m = 0; m < 4; ++m)
#pragma unroll
                    for (int n = 0; n < 2; ++n) acc[a][b][m][n] = (f32x4){0.f, 0.f, 0.f, 0.f};
        cur = nxt; cA = nA; cB = nB; ++ui;
        if constexpr (ALIGN_EPI) { if (wr == 1) PG8_BAR; }
    }
    PG8_WAIT_V(0);
    if constexpr (!ALIGN_EPI) { if (wr == 0) PG8_BAR; }
    PG8_BAR;
#undef PG8_SA
#undef PG8_SB
#undef PG8_STAGE
#undef PG8_LDA
#undef PG8_LDB
#undef PG8_MMA
#undef PG8_WAIT_V
#undef PG8_WAIT_L
#undef PG8_BAR
#undef PG8_SCHED
}
}

constexpr int D = 1024, NB = 4, SEQ = 8192, CTXL = 256, ML = NB * SEQ, MC = NB * CTXL, MALL = ML + MC;
constexpr int FF = 2816, MI = 2048, NH = 4, DH = 512, HROWS = 2 * SEQ;
constexpr float EPS = 1e-6f, ML_NORM_EPS = 1e-5f;
constexpr float HY_MAX_DECAY = -15.350567286626973f, HY_MIN_DECAY = -3.0701134573253945f;
constexpr int NWAVES = 8, NTHR = 512;
constexpr int LDS_BYTES = 147456;

constexpr size_t MiB = 1u << 20;
constexpr size_t WS_MOD = 1 * MiB;
constexpr size_t WS_CTXX = 2 * MiB;
constexpr size_t WS_H3 = 6 * MiB;
constexpr size_t WS_KTC = 9 * MiB;
constexpr size_t WS_GWT = 11 * MiB;
constexpr size_t WS_WKQ = 11 * MiB + 256 * 1024;
constexpr size_t WS_NC = 12 * MiB;
constexpr size_t WS_WHIN = 16 * MiB, WS_WHOUT = 22 * MiB, WS_WMIN = 24 * MiB, WS_WMDN = 32 * MiB, WS_WUP0 = 36 * MiB, WS_WUP1 = 47 * MiB, WS_WDN0 = 58 * MiB, WS_WDN1 = 58 * MiB + 5767168;
constexpr size_t WS_GATES_L = 69 * MiB;
constexpr size_t WS_GATES_C = 70 * MiB;
constexpr size_t WS_GT_L = 71 * MiB;
constexpr size_t WS_GT_C = 73 * MiB;
constexpr size_t WS_GC = 73 * MiB + 512 * 1024;
constexpr size_t WS_DN = 74 * MiB;
constexpr size_t WS_RS = 79 * MiB;
constexpr size_t WS_INV = 79 * MiB + 512 * 1024;
constexpr size_t BIG = 80 * MiB;
constexpr size_t HY_H = BIG, HY_P = BIG + 66 * MiB, HY_KT = BIG + 264 * MiB, HY_ZT = BIG + 328 * MiB, HY_ZTC = BIG + 392 * MiB, HY_KS = BIG + 394 * MiB;
constexpr size_t FF_H = BIG, FF_A = BIG + 66 * MiB, FF_G = BIG + 248 * MiB;
constexpr size_t MS_H = BIG, MS_XM = BIG + 32 * MiB, MS_XC = BIG + 96 * MiB, MS_KT = BIG + 160 * MiB, MS_VT = BIG + 224 * MiB, MS_NF = BIG + 288 * MiB, MS_NB = BIG + 352 * MiB,
                 MS_KTC = BIG + 416 * MiB, MS_VTC = BIG + 420 * MiB;
constexpr size_t MS_S = MS_XM, MS_Z = MS_KT, MS_KN = MS_NF, MS_XCC = MS_NB, MS_XMC = MS_NB + 4 * MiB, MS_HC = MS_NB + 8 * MiB;
constexpr size_t WS_END = BIG + 424 * MiB;
static_assert(WS_END <= 512 * MiB, "workspace map");
static_assert(FF_G + (size_t)MALL * FF * 2 <= 512 * MiB && FF_A + (size_t)MALL * FF * 2 <= FF_G, "ffn map");
static_assert(HY_P + (size_t)MALL * 3072 * 2 <= HY_KT && HY_ZTC + (size_t)NB * D * CTXL * 2 <= HY_KS && HY_KS + 32 * MiB <= 512 * MiB, "hyena map");

__device__ __forceinline__ unsigned f2bf(float f) { unsigned u = __float_as_uint(f); return (u + 0x7fffu + ((u >> 16) & 1u)) >> 16; }
typedef __bf16 bf16x2_t __attribute__((ext_vector_type(2)));
__device__ __forceinline__ unsigned pk2(float lo, float hi) { const f32x2 v = {lo, hi}; const bf16x2_t b = __builtin_convertvector(v, bf16x2_t); return __builtin_bit_cast(unsigned, b); }
__device__ __forceinline__ float bf2f(unsigned short b) { return __uint_as_float(((unsigned)b) << 16); }
__device__ __forceinline__ float bflo(unsigned w) { return __uint_as_float(w << 16); }
__device__ __forceinline__ float bfhi(unsigned w) { return __uint_as_float(w & 0xffff0000u); }
__device__ __forceinline__ void unpack8(const u32x4 v, float (&o)[8]) { o[0] = bflo(v.x); o[1] = bfhi(v.x); o[2] = bflo(v.y); o[3] = bfhi(v.y); o[4] = bflo(v.z); o[5] = bfhi(v.z); o[6] = bflo(v.w); o[7] = bfhi(v.w); }
__device__ __forceinline__ u32x4 pack8(const float (&o)[8]) { u32x4 v; v.x = pk2(o[0], o[1]); v.y = pk2(o[2], o[3]); v.z = pk2(o[4], o[5]); v.w = pk2(o[6], o[7]); return v; }
__device__ __forceinline__ float wave_sum(float v) {
#pragma unroll
    for (int o = 1; o < 64; o <<= 1) v += __shfl_xor(v, o);
    return v;
}
__device__ __forceinline__ float silu_f(float x) { return x / (1.0f + __expf(-x)); }

typedef const float* cfptr_t;
struct Fr {
    LAS unsigned char* lds; int tid, lane, wave, gw, ngw, G, bid;
    const __attribute__((address_space(4))) cfptr_t* in; float* out; unsigned char* ws;
};
#define IN(i) (F.in[i])
enum { I_X = 0, I_C, I_CTX, I_CCTX, I_MODW, I_MODB, I_NORMG, I_FINALG, I_HWIN, I_HBIN, I_HSCW, I_HSCB, I_FW1, I_FB1, I_FW2, I_FB2, I_FW3, I_FB3, I_FWOUT, I_FREQ, I_HBIAS, I_HWOUT, I_HBOUT,
       I_MWIN, I_MCW, I_MCB, I_MWQ, I_MWK, I_MWV, I_MWG, I_MBG, I_MNW, I_MSKIP, I_MWDN, I_FWUP, I_FCW, I_FCB, I_FWDN };

__device__ __forceinline__ void transpose_item(const float* W, int K, int N, bf16* WT, LAS float* scr, int item, int lane) {
    const int nblk = N / 32, kb = item / nblk, nb = item % nblk, k0 = 64 * kb, n0 = 32 * nb;
    float tv[32];
#pragma unroll
    for (int i = 0; i < 32; ++i) tv[i] = W[(size_t)(k0 + 2 * i + (lane >> 5)) * N + n0 + (lane & 31)];
#pragma unroll
    for (int i = 0; i < 32; ++i) scr[(2 * i + (lane >> 5)) * 33 + (lane & 31)] = tv[i];
    asm volatile("s_waitcnt lgkmcnt(0)" ::: "memory");
    const int c = lane & 7;
#pragma unroll
    for (int j = 0; j < 4; ++j) { const int n = (lane >> 3) + 8 * j; const LAS float* s = scr + (8 * c) * 33 + n;
        u32x4 o; o.x = pk2(s[0 * 33], s[1 * 33]); o.y = pk2(s[2 * 33], s[3 * 33]); o.z = pk2(s[4 * 33], s[5 * 33]); o.w = pk2(s[6 * 33], s[7 * 33]);
        *(u32x4*)(WT + (size_t)(n0 + n) * K + k0 + 8 * c) = o; }
    asm volatile("s_waitcnt lgkmcnt(0)" ::: "memory");
}
__device__ __forceinline__ void transpose_matrix(Fr& F, const float* W, int K, int N, bf16* WT) {
    LAS float* scr = (LAS float*)(F.lds + F.wave * 16384);
    const int nitems = (K / 64) * (N / 32);
    for (int it = F.gw; it < nitems; it += F.ngw) transpose_item(W, K, N, WT, scr, it, F.lane);
}

__device__ __forceinline__ void ph_prologue(Fr& F) {
    unsigned char* ws = F.ws;
    {
        LAS float* scr = (LAS float*)(F.lds + F.wave * 16384);
        constexpr int I0 = (D / 64) * (3 * D / 32), I1 = (D / 64) * (D / 32), I2 = (D / 64) * (2 * MI / 32), I3 = (MI / 64) * (D / 32), I4 = (D / 64) * (2 * FF / 32), I5 = (FF / 64) * (D / 32);
        constexpr int NIT = I0 + I1 + I2 + I3 + 2 * I4 + 2 * I5;
        for (int it = F.gw; it < NIT; it += F.ngw) {
            int r = it;
            if (r < I0) { transpose_item(IN(I_HWIN), D, 3 * D, (bf16*)(ws + WS_WHIN), scr, r, F.lane); continue; } r -= I0;
            if (r < I1) { transpose_item(IN(I_HWOUT), D, D, (bf16*)(ws + WS_WHOUT), scr, r, F.lane); continue; } r -= I1;
            if (r < I2) { transpose_item(IN(I_MWIN), D, 2 * MI, (bf16*)(ws + WS_WMIN), scr, r, F.lane); continue; } r -= I2;
            if (r < I3) { transpose_item(IN(I_MWDN), MI, D, (bf16*)(ws + WS_WMDN), scr, r, F.lane); continue; } r -= I3;
            if (r < I4) { transpose_item(IN(I_FWUP), D, 2 * FF, (bf16*)(ws + WS_WUP0), scr, r, F.lane); continue; } r -= I4;
            if (r < I4) { transpose_item(IN(I_FWUP) + (size_t)D * 2 * FF, D, 2 * FF, (bf16*)(ws + WS_WUP1), scr, r, F.lane); continue; } r -= I4;
            if (r < I5) { transpose_item(IN(I_FWDN), FF, D, (bf16*)(ws + WS_WDN0), scr, r, F.lane); continue; } r -= I5;
            transpose_item(IN(I_FWDN) + (size_t)FF * D, FF, D, (bf16*)(ws + WS_WDN1), scr, r, F.lane);
        }
    }
    __syncthreads();
    {
        LAS float* sc = (LAS float*)F.lds;
        LAS float* red = (LAS float*)(F.lds + 32768);
        for (int i = F.tid; i < 5 * 1024; i += NTHR) { const int r = i >> 10, k = i & 1023; const float v = r < 4 ? IN(I_C)[r * 1024 + k] : IN(I_CCTX)[k]; sc[i] = silu_f(v); }
        __syncthreads();
        float* mod = (float*)(ws + WS_MOD);
        for (int it = F.bid; it < 192; it += F.G) {
            const int l = it / 96, n0 = (it % 96) * 64;
            const float* w = IN(I_MODW) + (size_t)l * 1024 * 6144 + n0 + F.lane;
            float a0 = 0.f, a1 = 0.f, a2 = 0.f, a3 = 0.f, a4 = 0.f;
            const int kb = F.wave * 128;
#pragma unroll 16
            for (int k = 0; k < 128; ++k) { const float wv = w[(size_t)(kb + k) * 6144];
                a0 += sc[kb + k] * wv; a1 += sc[1024 + kb + k] * wv; a2 += sc[2048 + kb + k] * wv; a3 += sc[3072 + kb + k] * wv; a4 += sc[4096 + kb + k] * wv; }
            red[(F.wave * 5 + 0) * 64 + F.lane] = a0; red[(F.wave * 5 + 1) * 64 + F.lane] = a1; red[(F.wave * 5 + 2) * 64 + F.lane] = a2; red[(F.wave * 5 + 3) * 64 + F.lane] = a3; red[(F.wave * 5 + 4) * 64 + F.lane] = a4;
            __syncthreads();
            if (F.tid < 320) { const int r = F.tid >> 6, ln = F.tid & 63; float s = 0.f;
#pragma unroll
                for (int w8 = 0; w8 < 8; ++w8) s += red[(w8 * 5 + r) * 64 + ln];
                mod[((size_t)l * 5 + r) * 6144 + n0 + ln] = s + IN(I_MODB)[l * 6144 + n0 + ln]; }
            __syncthreads();
        }
    }
    {
        float* h3 = (float*)(ws + WS_H3);
        const float* w1 = IN(I_FW1); const float* w2 = IN(I_FW2); const float* w3 = IN(I_FW3);
        const float fr = IN(I_FREQ)[F.lane], b1 = IN(I_FB1)[F.lane], b2 = IN(I_FB2)[F.lane], b3 = IN(I_FB3)[F.lane];
        for (int row = F.gw; row < SEQ + CTXL; row += F.ngw) {
            const int L = row < SEQ ? SEQ : CTXL, i = row < SEQ ? row : row - SEQ;
            const float tl = (float)i / (float)(L - 1), w = 6.283185307179586f * (float)i / (float)L;
            float pos = 0.f; const int k = F.lane;
            if (k == 0) pos = tl;
            else if (k <= 16) { const float band = 1e-4f + (float)(k - 1) * ((15.0f - 1e-4f) / 15.0f); pos = cosf(band * w); }
            else if (k <= 32) { const float band = 1e-4f + (float)(k - 17) * ((15.0f - 1e-4f) / 15.0f); pos = -sinf(band * w); }
            float s = b1;
#pragma unroll
            for (int kk = 0; kk < 33; ++kk) s += __shfl(pos, kk) * w1[kk * 64 + F.lane];
            float h = sinf(fr * s);
            s = b2;
#pragma unroll 16
            for (int kk = 0; kk < 64; ++kk) s += __shfl(h, kk) * w2[kk * 64 + F.lane];
            h = sinf(fr * s);
            s = b3;
#pragma unroll 16
            for (int kk = 0; kk < 64; ++kk) s += __shfl(h, kk) * w3[kk * 64 + F.lane];
            h = sinf(fr * s);
            h3[(size_t)row * 64 + F.lane] = h;
        }
    }
    {
        bf16* gwt = (bf16*)(ws + WS_GWT); float* wkq = (float*)(ws + WS_WKQ);
        const float* wq = IN(I_MWQ); const float* wk = IN(I_MWK); const float* wv = IN(I_MWV); const float* wg = IN(I_MWG);
        const int gt = F.bid * NTHR + F.tid, nt = F.G * NTHR;
        for (int i = gt; i < MI * 16; i += nt) { const int ch = i >> 4, g = i & 15, n = ch >> 2, c = ch & 3; float sa = 0.f, sb = 0.f;
#pragma unroll
            for (int e = 0; e < 4; ++e) { sa += wq[n * 16 + c * 4 + e] * wg[(size_t)(n * 4 + e) * 16 + g] + wk[n * 16 + c * 4 + e] * wg[(size_t)(MI + n * 4 + e) * 16 + g];
                sb += wv[n * 16 + c * 4 + e] * wg[(size_t)(2 * MI + n * 4 + e) * 16 + g]; }
            const size_t go = ((size_t)(ch >> 5) * 64 + g + 16 * ((ch & 31) >> 3)) * 8 + (ch & 7);
            gwt[go] = (bf16)f2bf(sa); gwt[go + 64 * 512] = (bf16)f2bf(sb); }
        const float sc = 0.044194173824159216f;
        for (int i = gt; i < 512 * 16; i += nt) { const int n = i >> 4, c = (i >> 2) & 3, c2 = i & 3; float s = 0.f;
#pragma unroll
            for (int e = 0; e < 4; ++e) s += wk[n * 16 + c * 4 + e] * wq[n * 16 + c2 * 4 + e];
            wkq[i] = s * sc; }
    }
}

__device__ __forceinline__ void kt_items(Fr& F, const float* h3rows, int L, float* KT) {
    const float* wout = IN(I_FWOUT);
    const int nitems = (L / 16) * 32, fr = F.lane & 15, fq = F.lane >> 4;
    for (int it = F.gw; it < nitems; it += F.ngw) {
        const int t0 = (it >> 5) * 16, n0 = (it & 31) * 64;
        float a[16];
#pragma unroll
        for (int ks = 0; ks < 16; ++ks) a[ks] = h3rows[(size_t)(t0 + fr) * 64 + 4 * ks + fq];
#pragma unroll
        for (int nt = 0; nt < 4; ++nt) {
            f32x4 acc = (f32x4){0.f, 0.f, 0.f, 0.f};
#pragma unroll
            for (int ks = 0; ks < 16; ++ks) acc = __builtin_amdgcn_mfma_f32_16x16x4f32(a[ks], wout[(size_t)(4 * ks + fq) * 2048 + n0 + nt * 16 + fr], acc, 0, 0, 0);
            const int n = n0 + nt * 16 + fr, dirn = n >> 10, c = n & 1023;
            const float delta = fabsf(HY_MIN_DECAY + (float)c * ((HY_MAX_DECAY - HY_MIN_DECAY) / 1023.0f)), il = 1.0f / (float)(L - 1);
            f32x4 o;
#pragma unroll
            for (int r = 0; r < 4; ++r) o[r] = acc[r] * __expf(-(float)(t0 + 4 * fq + r) * il * delta);
            *(f32x4*)(KT + ((size_t)c * 2 + dirn) * L + t0 + 4 * fq) = o;
        }
    }
}

__device__ __forceinline__ void modnorm_row(const float* xrow, const float* g, const float* sh, const float* sc, bf16* orow, int lane) {
    const f32x4* xr = (const f32x4*)xrow + lane; f32x4 v[4]; float s = 0.f;
#pragma unroll
    for (int j = 0; j < 4; ++j) { v[j] = xr[64 * j]; s += (v[j][0] * v[j][0] + v[j][1] * v[j][1]) + (v[j][2] * v[j][2] + v[j][3] * v[j][3]); }
    const float rinv = 1.0f / sqrtf(wave_sum(s) * (1.0f / 1024.0f) + EPS);
    u32x2* o8 = (u32x2*)orow + lane;
#pragma unroll
    for (int j = 0; j < 4; ++j) { const int c = 4 * lane + 256 * j; const f32x4 gg = *(const f32x4*)(g + c), s1 = *(const f32x4*)(sc + c), s0 = *(const f32x4*)(sh + c);
        const f32x4 y = (v[j] * rinv * gg) * (1.0f + s1) + s0; u32x2 w; w.x = pk2(y[0], y[1]); w.y = pk2(y[2], y[3]); o8[64 * j] = w; }
}
__device__ __forceinline__ void ph_modnorm(Fr& F, const float* xlat, int nlat, int b0, const float* xctx, int nctx, const float* g, const float* modl, int shoff, bf16* H) {
    const int nrows = nlat + nctx;
    for (int r = F.gw; r < nrows; r += 2 * F.ngw) {
        const int r2 = r + F.ngw; const bool has2 = r2 < nrows; const int rb = has2 ? r2 : r;
        const bool isl = r < nlat, isl2 = rb < nlat;
        const float* xa = isl ? xlat + (size_t)r * 1024 : xctx + (size_t)(r - nlat) * 1024; const float* xb = isl2 ? xlat + (size_t)rb * 1024 : xctx + (size_t)(rb - nlat) * 1024;
        const int ma = isl ? b0 + r / SEQ : 4, mb = isl2 ? b0 + rb / SEQ : 4;
        const f32x4* pa = (const f32x4*)xa + F.lane; const f32x4* pb = (const f32x4*)xb + F.lane; f32x4 va[4], vb[4]; float sa = 0.f, sb = 0.f;
#pragma unroll
        for (int j = 0; j < 4; ++j) { va[j] = pa[64 * j]; vb[j] = pb[64 * j]; }
#pragma unroll
        for (int j = 0; j < 4; ++j) { sa += (va[j][0] * va[j][0] + va[j][1] * va[j][1]) + (va[j][2] * va[j][2] + va[j][3] * va[j][3]); sb += (vb[j][0] * vb[j][0] + vb[j][1] * vb[j][1]) + (vb[j][2] * vb[j][2] + vb[j][3] * vb[j][3]); }
        const float ra = 1.0f / sqrtf(wave_sum(sa) * (1.0f / 1024.0f) + EPS), rbv = 1.0f / sqrtf(wave_sum(sb) * (1.0f / 1024.0f) + EPS);
        const float* sha = modl + (size_t)ma * 6144 + shoff; const float* shb = modl + (size_t)mb * 6144 + shoff;
        u32x2* oa = (u32x2*)(H + (size_t)r * 1024) + F.lane; u32x2* ob = (u32x2*)(H + (size_t)rb * 1024) + F.lane;
#pragma unroll
        for (int j = 0; j < 4; ++j) { const int c = 4 * F.lane + 256 * j; const f32x4 gg = *(const f32x4*)(g + c);
            const f32x4 ya = (va[j] * ra * gg) * (1.0f + *(const f32x4*)(sha + 1024 + c)) + *(const f32x4*)(sha + c);
            const f32x4 yb = (vb[j] * rbv * gg) * (1.0f + *(const f32x4*)(shb + 1024 + c)) + *(const f32x4*)(shb + c);
            oa[64 * j] = (u32x2){pk2(ya[0], ya[1]), pk2(ya[2], ya[3])};
            if (has2) ob[64 * j] = (u32x2){pk2(yb[0], yb[1]), pk2(yb[2], yb[3])}; }
    }
}

__device__ __forceinline__ void zt_items(Fr& F, const bf16* P, int rowbase, int nb, int Ls, bf16* ZT) {
    LAS unsigned char* tile = F.lds + F.wave * 16384;
    const float* scw = IN(I_HSCW); const float* scb = IN(I_HSCB);
    const int ntt = Ls / 64, nitems = nb * ntt * 16, tl = F.lane >> 3, c8 = F.lane & 7;
    for (int it = F.gw; it < nitems; it += F.ngw) {
        const int ct = it & 15, tt = (it >> 4) % ntt, b = (it >> 4) / ntt, t0 = tt * 64, ch = ct * 64 + c8 * 8;
        float w1[3][8], w2[3][8], b1[8], b2[8];
#pragma unroll
        for (int k = 0; k < 3; ++k) { const f32x4 a0 = *(const f32x4*)(scw + k * 3072 + 1024 + ch), a1 = *(const f32x4*)(scw + k * 3072 + 1024 + ch + 4), d0 = *(const f32x4*)(scw + k * 3072 + 2048 + ch), d1 = *(const f32x4*)(scw + k * 3072 + 2048 + ch + 4);
#pragma unroll
            for (int e = 0; e < 4; ++e) { w1[k][e] = a0[e]; w1[k][4 + e] = a1[e]; w2[k][e] = d0[e]; w2[k][4 + e] = d1[e]; } }
        { const f32x4 a0 = *(const f32x4*)(scb + 1024 + ch), a1 = *(const f32x4*)(scb + 1024 + ch + 4), d0 = *(const f32x4*)(scb + 2048 + ch), d1 = *(const f32x4*)(scb + 2048 + ch + 4);
#pragma unroll
            for (int e = 0; e < 4; ++e) { b1[e] = a0[e]; b1[4 + e] = a1[e]; b2[e] = d0[e]; b2[4 + e] = d1[e]; } }
        const bf16* pb = P + (size_t)(rowbase + b * Ls) * 3072 + ch;
#pragma unroll 2
        for (int i8 = 0; i8 < 8; ++i8) {
            const int tloc = i8 * 8 + tl, t = t0 + tloc, tm = t > 0 ? t - 1 : t, tp = t + 1 < Ls ? t + 1 : t; const float mm = t > 0 ? 1.f : 0.f, mp = t + 1 < Ls ? 1.f : 0.f;
            const u32x4 r1m = *(const u32x4*)(pb + (size_t)tm * 3072 + 1024), r1c = *(const u32x4*)(pb + (size_t)t * 3072 + 1024), r1p = *(const u32x4*)(pb + (size_t)tp * 3072 + 1024);
            const u32x4 r2m = *(const u32x4*)(pb + (size_t)tm * 3072 + 2048), r2c = *(const u32x4*)(pb + (size_t)t * 3072 + 2048), r2p = *(const u32x4*)(pb + (size_t)tp * 3072 + 2048);
            float xm[8], xc[8], xp[8], vm[8], vc[8], vp[8];
            unpack8(r1m, xm); unpack8(r1c, xc); unpack8(r1p, xp); unpack8(r2m, vm); unpack8(r2c, vc); unpack8(r2p, vp);
#pragma unroll
            for (int e = 0; e < 8; ++e) { const float a = w1[0][e] * (xm[e] * mm) + w1[1][e] * xc[e] + w1[2][e] * (xp[e] * mp) + b1[e], d = w2[0][e] * (vm[e] * mm) + w2[1][e] * vc[e] + w2[2][e] * (vp[e] * mp) + b2[e];
                *(LAS bf16*)(tile + (c8 * 8 + e) * 136 + tloc * 2) = (bf16)f2bf(a * d); }
        }
#pragma unroll
        for (int q = 0; q < 8; ++q) { const int cc = q * 8 + (F.lane >> 3), chk = F.lane & 7;
            const u32x2 lo = *(const LAS u32x2*)(tile + cc * 136 + chk * 16), hi = *(const LAS u32x2*)(tile + cc * 136 + chk * 16 + 8);
            u32x4 o; o.x = lo.x; o.y = lo.y; o.z = hi.x; o.w = hi.y;
            *(u32x4*)(ZT + ((size_t)b * 1024 + ct * 64 + cc) * Ls + t0 + chk * 8) = o; }
    }
}

__device__ __forceinline__ f32x2 cmul(f32x2 a, f32x2 b) { return (f32x2){a.x * b.x - a.y * b.y, a.x * b.y + a.y * b.x}; }
__device__ __forceinline__ f32x2 cmulc(f32x2 a, f32x2 b) { return (f32x2){a.x * b.x + a.y * b.y, a.y * b.x - a.x * b.y}; }
__device__ __forceinline__ f32x2 twid(float f) { return (f32x2){__builtin_amdgcn_cosf(f), __builtin_amdgcn_sinf(f)}; }
#define PH(e) ((e) + ((e) >> 4))
__device__ __forceinline__ void fft_fwd(LAS f32x2* buf, int tid, int plo, int phi) {
#pragma unroll 1
    for (int p = plo; p < phi; ++p) {
        const int lq = 12 - 2 * p, q = 1 << lq; const float invN = 1.0f / (float)(4 * q);
#pragma unroll 2
        for (int m = 0; m < 8; ++m) {
            const int g = tid + 512 * m, i = g & (q - 1), i0 = ((g >> lq) << (lq + 2)) + i;
            const int e0 = PH(i0), e1 = PH(i0 + q), e2 = PH(i0 + 2 * q), e3 = PH(i0 + 3 * q);
            const f32x2 a0 = buf[e0], a1 = buf[e1], a2 = buf[e2], a3 = buf[e3];
            const f32x2 t0 = a0 + a2, t1 = a0 - a2, t2 = a1 + a3, d = a1 - a3, t3 = (f32x2){d.y, -d.x};
            const f32x2 w1 = twid(-(float)i * invN), w2 = cmul(w1, w1), w3 = cmul(w2, w1);
            buf[e0] = t0 + t2; buf[e1] = cmul(t1 + t3, w1); buf[e2] = cmul(t0 - t2, w2); buf[e3] = cmul(t1 - t3, w3);
        }
        __syncthreads();
    }
}
__device__ __forceinline__ void fft_inv(LAS f32x2* buf, int tid, int plo, int phi) {
#pragma unroll 1
    for (int p = phi - 1; p >= plo; --p) {
        const int lq = 12 - 2 * p, q = 1 << lq; const float invN = 1.0f / (float)(4 * q);
#pragma unroll 2
        for (int m = 0; m < 8; ++m) {
            const int g = tid + 512 * m, i = g & (q - 1), i0 = ((g >> lq) << (lq + 2)) + i;
            const int e0 = PH(i0), e1 = PH(i0 + q), e2 = PH(i0 + 2 * q), e3 = PH(i0 + 3 * q);
            const f32x2 w1 = twid((float)i * invN), w2 = cmul(w1, w1), w3 = cmul(w2, w1);
            const f32x2 b0 = buf[e0], b1 = cmul(buf[e1], w1), b2 = cmul(buf[e2], w2), b3 = cmul(buf[e3], w3);
            const f32x2 t0 = b0 + b2, t1 = b0 - b2, t2 = b1 + b3, d = b1 - b3, t3 = (f32x2){-d.y, d.x};
            buf[e0] = t0 + t2; buf[e1] = t1 + t3; buf[e2] = t0 - t2; buf[e3] = t1 - t3;
        }
        __syncthreads();
    }
}
__device__ __forceinline__ void fwd16_A(f32x2 (&x)[16]) {
    const float C1 = 0.92387953251128674f, S1 = 0.38268343236508977f, R2 = 0.70710678118654752f;
#pragma unroll
    for (int i = 0; i < 4; ++i) {
        const f32x2 a0 = x[i], a1 = x[i + 4], a2 = x[i + 8], a3 = x[i + 12];
        const f32x2 t0 = a0 + a2, t1 = a0 - a2, t2 = a1 + a3, d = a1 - a3, t3 = (f32x2){d.y, -d.x};
        const f32x2 y1 = t1 + t3, y2 = t0 - t2, y3 = t1 - t3;
        x[i] = t0 + t2;
        if (i == 0) { x[4] = y1; x[8] = y2; x[12] = y3; }
        else if (i == 1) { x[5] = cmul(y1, (f32x2){C1, -S1}); x[9] = cmul(y2, (f32x2){R2, -R2}); x[13] = cmul(y3, (f32x2){S1, -C1}); }
        else if (i == 2) { x[6] = cmul(y1, (f32x2){R2, -R2}); x[10] = (f32x2){y2.y, -y2.x}; x[14] = cmul(y3, (f32x2){-R2, -R2}); }
        else { x[7] = cmul(y1, (f32x2){S1, -C1}); x[11] = cmul(y2, (f32x2){-R2, -R2}); x[15] = cmul(y3, (f32x2){-C1, S1}); }
    }
}
__device__ __forceinline__ void fwd16_B(f32x2 (&x)[16]) {
#pragma unroll
    for (int g = 0; g < 4; ++g) {
        const f32x2 a0 = x[4 * g], a1 = x[4 * g + 1], a2 = x[4 * g + 2], a3 = x[4 * g + 3];
        const f32x2 t0 = a0 + a2, t1 = a0 - a2, t2 = a1 + a3, d = a1 - a3, t3 = (f32x2){d.y, -d.x};
        x[4 * g] = t0 + t2; x[4 * g + 1] = t1 + t3; x[4 * g + 2] = t0 - t2; x[4 * g + 3] = t1 - t3;
    }
}
__device__ __forceinline__ void inv16_B(f32x2 (&x)[16]) {
#pragma unroll
    for (int g = 0; g < 4; ++g) {
        const f32x2 b0 = x[4 * g], b1 = x[4 * g + 1], b2 = x[4 * g + 2], b3 = x[4 * g + 3];
        const f32x2 t0 = b0 + b2, t1 = b0 - b2, t2 = b1 + b3, d = b1 - b3, t3 = (f32x2){-d.y, d.x};
        x[4 * g] = t0 + t2; x[4 * g + 1] = t1 + t3; x[4 * g + 2] = t0 - t2; x[4 * g + 3] = t1 - t3;
    }
}
__device__ __forceinline__ void inv16_A(f32x2 (&x)[16]) {
    const float C1 = 0.92387953251128674f, S1 = 0.38268343236508977f, R2 = 0.70710678118654752f;
#pragma unroll
    for (int i = 0; i < 4; ++i) {
        f32x2 b0 = x[i], b1 = x[i + 4], b2 = x[i + 8], b3 = x[i + 12];
        if (i == 1) { b1 = cmul(b1, (f32x2){C1, S1}); b2 = cmul(b2, (f32x2){R2, R2}); b3 = cmul(b3, (f32x2){S1, C1}); }
        else if (i == 2) { b1 = cmul(b1, (f32x2){R2, R2}); b2 = (f32x2){-b2.y, b2.x}; b3 = cmul(b3, (f32x2){-R2, R2}); }
        else if (i == 3) { b1 = cmul(b1, (f32x2){S1, C1}); b2 = cmul(b2, (f32x2){-R2, R2}); b3 = cmul(b3, (f32x2){-C1, -S1}); }
        const f32x2 t0 = b0 + b2, t1 = b0 - b2, t2 = b1 + b3, d = b1 - b3, t3 = (f32x2){-d.y, d.x};
        x[i] = t0 + t2; x[i + 4] = t1 + t3; x[i + 8] = t0 - t2; x[i + 12] = t1 - t3;
    }
}
__device__ __forceinline__ void fwd16(f32x2 (&x)[16]) { fwd16_A(x); fwd16_B(x); }
__device__ __forceinline__ void inv16(f32x2 (&x)[16]) { inv16_B(x); inv16_A(x); }
__device__ __forceinline__ void r16_fwd2(LAS f32x2* buf, int tid) {
#pragma unroll 1
  for (int lqp = 8; lqp >= 4; lqp -= 4) {
    const int qp = 1 << lqp; const float inv = 1.0f / (float)(16 * qp);
#pragma unroll
    for (int m = 0; m < 2; ++m) {
        const int g = tid + 512 * m, i = g & (qp - 1), e0 = ((g >> lqp) << (lqp + 4)) + i; f32x2 x[16];
#pragma unroll
        for (int j = 0; j < 16; ++j) x[j] = buf[PH(e0 + (j << lqp))];
        const f32x2 w1 = twid(-(float)i * inv), w2 = cmul(w1, w1), w3 = cmul(w2, w1), v1 = cmul(w2, w2), v2 = cmul(v1, v1), v3 = cmul(v2, v1);
        fwd16_A(x);
#pragma unroll
        for (int l = 0; l < 4; ++l) { x[l + 4] = cmul(x[l + 4], w1); x[l + 8] = cmul(x[l + 8], w2); x[l + 12] = cmul(x[l + 12], w3); }
        fwd16_B(x);
#pragma unroll
        for (int k = 0; k < 4; ++k) { x[4 * k + 1] = cmul(x[4 * k + 1], v1); x[4 * k + 2] = cmul(x[4 * k + 2], v2); x[4 * k + 3] = cmul(x[4 * k + 3], v3); }
#pragma unroll
        for (int j = 0; j < 16; ++j) buf[PH(e0 + (j << lqp))] = x[j];
    }
    __syncthreads();
  }
}
__device__ __forceinline__ void r16_inv2(LAS f32x2* buf, int tid) {
#pragma unroll 1
  for (int lqp = 4; lqp <= 8; lqp += 4) {
    const int qp = 1 << lqp; const float inv = 1.0f / (float)(16 * qp);
#pragma unroll
    for (int m = 0; m < 2; ++m) {
        const int g = tid + 512 * m, i = g & (qp - 1), e0 = ((g >> lqp) << (lqp + 4)) + i; f32x2 x[16];
#pragma unroll
        for (int j = 0; j < 16; ++j) x[j] = buf[PH(e0 + (j << lqp))];
        const f32x2 w1 = twid((float)i * inv), w2 = cmul(w1, w1), w3 = cmul(w2, w1), v1 = cmul(w2, w2), v2 = cmul(v1, v1), v3 = cmul(v2, v1);
#pragma unroll
        for (int k = 0; k < 4; ++k) { x[4 * k + 1] = cmul(x[4 * k + 1], v1); x[4 * k + 2] = cmul(x[4 * k + 2], v2); x[4 * k + 3] = cmul(x[4 * k + 3], v3); }
        inv16_B(x);
#pragma unroll
        for (int l = 0; l < 4; ++l) { x[l + 4] = cmul(x[l + 4], w1); x[l + 8] = cmul(x[l + 8], w2); x[l + 12] = cmul(x[l + 12], w3); }
        inv16_A(x);
#pragma unroll
        for (int j = 0; j < 16; ++j) buf[PH(e0 + (j << lqp))] = x[j];
    }
    __syncthreads();
  }
}
__device__ __forceinline__ float block_sum(Fr& F, float v, LAS float* red) {
    v = wave_sum(v);
    __syncthreads();
    if (F.lane == 0) red[F.wave] = v;
    __syncthreads();
    float s = 0.f;
#pragma unroll
    for (int w = 0; w < 8; ++w) s += red[w];
    return s;
}
__device__ __forceinline__ void ph_fftconv(Fr& F) {
    LAS f32x2* buf = (LAS f32x2*)F.lds; LAS float* red = (LAS float*)(F.lds + 139392);
    const float* KT = (const float*)(F.ws + HY_KT); const float* KTC = (const float*)(F.ws + WS_KTC);
    bf16* ZT = (bf16*)(F.ws + HY_ZT); bf16* ZTC = (bf16*)(F.ws + HY_ZTC);
    const int tid = F.tid;
    for (int c = F.bid; c < 1024; c += F.G) {
        const float bias = IN(I_HBIAS)[c];
        __syncthreads();
        float asum = 0.f;
        const f32x4* kf = (const f32x4*)(KT + (size_t)c * 2 * SEQ); const f32x4* kb = kf + SEQ / 4;
#pragma unroll
        for (int q = 0; q < 4; ++q) { const int i4 = tid + 512 * q; const f32x4 v = kf[i4];
            asum += fabsf(v[0]) + fabsf(v[1]) + fabsf(v[2]) + fabsf(v[3]);
            buf[PH(4 * i4)] = (f32x2){v[0], 0.f}; buf[PH(4 * i4 + 1)] = (f32x2){v[1], 0.f}; buf[PH(4 * i4 + 2)] = (f32x2){v[2], 0.f}; buf[PH(4 * i4 + 3)] = (f32x2){v[3], 0.f};
            const f32x4 u = kb[i4]; const int m = 4 * i4;
            if (m > 0) { buf[PH(16384 - m)] = (f32x2){u[0], 0.f}; asum += fabsf(u[0]); } else buf[PH(8192)] = (f32x2){0.f, 0.f};
            buf[PH(16384 - m - 1)] = (f32x2){u[1], 0.f}; buf[PH(16384 - m - 2)] = (f32x2){u[2], 0.f}; buf[PH(16384 - m - 3)] = (f32x2){u[3], 0.f};
            asum += fabsf(u[1]) + fabsf(u[2]) + fabsf(u[3]); }
        const float S = block_sum(F, asum, red);
        __syncthreads();
        fft_fwd(buf, tid, 0, 1); r16_fwd2(buf, tid);
        f32x4* Ks = (f32x4*)(F.ws + HY_KS) + (size_t)(F.bid & 255) * 8192 + tid * 8; const float ksc = 1.0f / (S * 16384.0f);
#pragma unroll 1
        for (int m = 0; m < 2; ++m) { const int pb = 17 * (tid + 512 * m); f32x2 x[16];
#pragma unroll
            for (int n = 0; n < 16; ++n) x[n] = buf[pb + n];
            fwd16(x);
#pragma unroll
            for (int n = 0; n < 8; ++n) Ks[m * 4096 + n] = (f32x4){x[2 * n].x * ksc, x[2 * n].y * ksc, x[2 * n + 1].x * ksc, x[2 * n + 1].y * ksc}; }
        const f32x2 dl = twid(-1.0f / 16384.0f);
#pragma unroll 1
        for (int pr = 0; pr < 2; ++pr) {
            bf16* z0 = ZT + ((size_t)(2 * pr) * 1024 + c) * SEQ; bf16* z1 = ZT + ((size_t)(2 * pr + 1) * 1024 + c) * SEQ;
            const int i8 = tid * 8;
            __syncthreads();
            {
                float a[8], b[8], cx[8], dx[8];
                unpack8(*(const u32x4*)(z0 + i8), a); unpack8(*(const u32x4*)(z1 + i8), b); unpack8(*(const u32x4*)(z0 + 4096 + i8), cx); unpack8(*(const u32x4*)(z1 + 4096 + i8), dx);
                f32x2 w1 = twid(-(float)i8 * (1.0f / 16384.0f));
#pragma unroll
                for (int e = 0; e < 8; ++e) { const f32x2 a0 = (f32x2){a[e], b[e]}, a1 = (f32x2){cx[e], dx[e]}, t3 = (f32x2){a1.y, -a1.x}; const f32x2 w2 = cmul(w1, w1), w3 = cmul(w2, w1);
                    buf[PH(i8 + e)] = a0 + a1; buf[PH(4096 + i8 + e)] = cmul(a0 + t3, w1); buf[PH(8192 + i8 + e)] = cmul(a0 - a1, w2); buf[PH(12288 + i8 + e)] = cmul(a0 - t3, w3);
                    w1 = cmul(w1, dl); }
            }
            __syncthreads();
            r16_fwd2(buf, tid);
#pragma unroll 1
            for (int m = 0; m < 2; ++m) { const int pb = 17 * (tid + 512 * m); f32x2 x[16];
#pragma unroll
                for (int n = 0; n < 16; ++n) x[n] = buf[pb + n];
                fwd16(x);
#pragma unroll
                for (int n = 0; n < 8; ++n) { const f32x4 k = Ks[m * 4096 + n]; x[2 * n] = cmul(x[2 * n], (f32x2){k[0], k[1]}); x[2 * n + 1] = cmul(x[2 * n + 1], (f32x2){k[2], k[3]}); }
                inv16(x);
#pragma unroll
                for (int n = 0; n < 16; ++n) buf[pb + n] = x[n]; }
            __syncthreads();
            r16_inv2(buf, tid);
            {
                float a[8], b[8], cx[8], dx[8];
                unpack8(*(const u32x4*)(z0 + i8), a); unpack8(*(const u32x4*)(z1 + i8), b); unpack8(*(const u32x4*)(z0 + 4096 + i8), cx); unpack8(*(const u32x4*)(z1 + 4096 + i8), dx);
                f32x2 w1 = twid(-(float)i8 * (1.0f / 16384.0f));
#pragma unroll
                for (int e = 0; e < 8; ++e) { const f32x2 w2 = cmul(w1, w1), w3 = cmul(w2, w1);
                    const f32x2 b0 = buf[PH(i8 + e)], b1 = cmulc(buf[PH(4096 + i8 + e)], w1), b2 = cmulc(buf[PH(8192 + i8 + e)], w2), b3 = cmulc(buf[PH(12288 + i8 + e)], w3);
                    const f32x2 t0 = b0 + b2, t1 = b0 - b2, t2 = b1 + b3, d = b1 - b3, t3 = (f32x2){-d.y, d.x};
                    const f32x2 y0 = t0 + t2, y1 = t1 + t3;
                    a[e] = y0.x + a[e] * bias; b[e] = y0.y + b[e] * bias; cx[e] = y1.x + cx[e] * bias; dx[e] = y1.y + dx[e] * bias;
                    w1 = cmul(w1, dl); }
                *(u32x4*)(z0 + i8) = pack8(a); *(u32x4*)(z1 + i8) = pack8(b); *(u32x4*)(z0 + 4096 + i8) = pack8(cx); *(u32x4*)(z1 + 4096 + i8) = pack8(dx);
            }
        }
        __syncthreads();
        {
            LAS float* kc = (LAS float*)F.lds; LAS float* zc = kc + 512;
            const float* kfc = KTC + (size_t)c * 2 * CTXL; float v = 0.f;
            { const int n = tid; if (n < 256) v = kfc[n]; else if (n == 256) v = 0.f; else v = kfc[CTXL + (512 - n)]; kc[n] = v; }
            const float Sc = block_sum(F, fabsf(v), red);
            for (int i = tid; i < 1024; i += NTHR) { const int b = i >> 8, t = i & 255; zc[i] = bf2f(ZTC[((size_t)b * 1024 + c) * CTXL + t]); }
            __syncthreads();
            const int b = tid >> 7, t2 = tid & 127; const float isc = 1.0f / Sc;
#pragma unroll
            for (int hh = 0; hh < 2; ++hh) { const int t = t2 + 128 * hh; float acc = 0.f;
#pragma unroll 8
                for (int s = 0; s < 256; ++s) acc += zc[b * 256 + s] * kc[(t - s) & 511];
                ZTC[((size_t)b * 1024 + c) * CTXL + t] = (bf16)f2bf(acc * isc + zc[b * 256 + t] * bias); }
        }
    }
}

__device__ __forceinline__ void u2_items(Fr& F, const bf16* P, int rowbase, int nb, int Ls, const bf16* YT, bf16* U2) {
    LAS unsigned char* tile = F.lds + F.wave * 16384;
    const float* scw = IN(I_HSCW); const float* scb = IN(I_HSCB);
    const int ntt = Ls / 64, nitems = nb * ntt * 16, tl = F.lane >> 3, c8 = F.lane & 7;
    for (int it = F.gw; it < nitems; it += F.ngw) {
        const int ct = it & 15, tt = (it >> 4) % ntt, b = (it >> 4) / ntt, t0 = tt * 64, ch = ct * 64 + c8 * 8;
#pragma unroll
        for (int q = 0; q < 8; ++q) { const int cc = q * 8 + (F.lane >> 3), chk = F.lane & 7;
            const u32x4 v = *(const u32x4*)(YT + ((size_t)b * 1024 + ct * 64 + cc) * Ls + t0 + chk * 8);
            *(LAS u32x2*)(tile + cc * 136 + chk * 16) = (u32x2){v.x, v.y}; *(LAS u32x2*)(tile + cc * 136 + chk * 16 + 8) = (u32x2){v.z, v.w}; }
        float w0[3][8], bb[8];
#pragma unroll
        for (int k = 0; k < 3; ++k) { const f32x4 a0 = *(const f32x4*)(scw + k * 3072 + ch), a1 = *(const f32x4*)(scw + k * 3072 + ch + 4);
#pragma unroll
            for (int e = 0; e < 4; ++e) { w0[k][e] = a0[e]; w0[k][4 + e] = a1[e]; } }
        { const f32x4 a0 = *(const f32x4*)(scb + ch), a1 = *(const f32x4*)(scb + ch + 4);
#pragma unroll
            for (int e = 0; e < 4; ++e) { bb[e] = a0[e]; bb[4 + e] = a1[e]; } }
        const bf16* pb = P + (size_t)(rowbase + b * Ls) * 3072 + ch; bf16* ub = U2 + (size_t)(rowbase + b * Ls) * 1024 + ch;
#pragma unroll 2
        for (int i8 = 0; i8 < 8; ++i8) {
            const int tloc = i8 * 8 + tl, t = t0 + tloc, tm = t > 0 ? t - 1 : t, tp = t + 1 < Ls ? t + 1 : t; const float mm = t > 0 ? 1.f : 0.f, mp = t + 1 < Ls ? 1.f : 0.f;
            const u32x4 rm = *(const u32x4*)(pb + (size_t)tm * 3072), rc = *(const u32x4*)(pb + (size_t)t * 3072), rp = *(const u32x4*)(pb + (size_t)tp * 3072);
            float xm[8], xc[8], xp[8], o[8];
            unpack8(rm, xm); unpack8(rc, xc); unpack8(rp, xp);
#pragma unroll
            for (int e = 0; e < 8; ++e) { const float x0 = w0[0][e] * (xm[e] * mm) + w0[1][e] * xc[e] + w0[2][e] * (xp[e] * mp) + bb[e]; o[e] = x0 * bf2f(*(const LAS bf16*)(tile + (c8 * 8 + e) * 136 + tloc * 2)); }
            *(u32x4*)(ub + (size_t)t * 1024) = pack8(o);
        }
    }
}

__device__ __forceinline__ void dw_item(const bf16* G, bf16* A, const float* cw, const float* cb, int f8, int rowtok0, int nx, int x0, bool up_ok, bool down_ok) {
    float w[9][8], bias[8];
#pragma unroll
    for (int k = 0; k < 9; ++k) { const float m = (k < 3) ? (up_ok ? 1.f : 0.f) : ((k >= 6) ? (down_ok ? 1.f : 0.f) : 1.f);
        const f32x4 w0 = *(const f32x4*)(cw + (size_t)k * FF + f8) * m, w1 = *(const f32x4*)(cw + (size_t)k * FF + f8 + 4) * m;
        w[k][0] = w0[0]; w[k][1] = w0[1]; w[k][2] = w0[2]; w[k][3] = w0[3]; w[k][4] = w1[0]; w[k][5] = w1[1]; w[k][6] = w1[2]; w[k][7] = w1[3]; }
    { const f32x4 b0 = *(const f32x4*)(cb + f8), b1 = *(const f32x4*)(cb + f8 + 4); bias[0] = b0[0]; bias[1] = b0[1]; bias[2] = b0[2]; bias[3] = b0[3]; bias[4] = b1[0]; bias[5] = b1[1]; bias[6] = b1[2]; bias[7] = b1[3]; }
    const int upo = up_ok ? -nx : 0, dno = down_ok ? nx : 0;
    const bf16* g0 = G + (size_t)rowtok0 * FF + f8; bf16* a0 = A + (size_t)rowtok0 * FF + f8;
    const u32x4 zero4 = (u32x4){0u, 0u, 0u, 0u};
    u32x4 cm[3], cc[3], cp[3];
    { const int xm = x0 > 0 ? x0 - 1 : 0; const bool okm = x0 > 0;
        cm[0] = *(const u32x4*)(g0 + (size_t)(xm + upo) * FF); cm[1] = *(const u32x4*)(g0 + (size_t)xm * FF); cm[2] = *(const u32x4*)(g0 + (size_t)(xm + dno) * FF);
        if (!okm) { cm[0] = zero4; cm[1] = zero4; cm[2] = zero4; }
        cc[0] = *(const u32x4*)(g0 + (size_t)(x0 + upo) * FF); cc[1] = *(const u32x4*)(g0 + (size_t)x0 * FF); cc[2] = *(const u32x4*)(g0 + (size_t)(x0 + dno) * FF); }
#pragma unroll 4
    for (int j = 0; j < 32; ++j) {
        const int x = x0 + j, xp = x + 1 < nx ? x + 1 : nx - 1; const bool okp = x + 1 < nx;
        cp[0] = *(const u32x4*)(g0 + (size_t)(xp + upo) * FF); cp[1] = *(const u32x4*)(g0 + (size_t)xp * FF); cp[2] = *(const u32x4*)(g0 + (size_t)(xp + dno) * FF);
        const u32x4 av = *(const u32x4*)(a0 + (size_t)x * FF);
        if (!okp) { cp[0] = zero4; cp[1] = zero4; cp[2] = zero4; }
        float acc[8];
#pragma unroll
        for (int e = 0; e < 8; ++e) acc[e] = bias[e];
#pragma unroll
        for (int dy = 0; dy < 3; ++dy) { float v[8];
            unpack8(cm[dy], v);
#pragma unroll
            for (int e = 0; e < 8; ++e) acc[e] += v[e] * w[dy * 3 + 0][e];
            unpack8(cc[dy], v);
#pragma unroll
            for (int e = 0; e < 8; ++e) acc[e] += v[e] * w[dy * 3 + 1][e];
            unpack8(cp[dy], v);
#pragma unroll
            for (int e = 0; e < 8; ++e) acc[e] += v[e] * w[dy * 3 + 2][e]; }
        float a[8]; unpack8(av, a);
#pragma unroll
        for (int e = 0; e < 8; ++e) a[e] = silu_f(acc[e]) * a[e];
        *(u32x4*)(a0 + (size_t)x * FF) = pack8(a);
#pragma unroll
        for (int dy = 0; dy < 3; ++dy) { cm[dy] = cc[dy]; cc[dy] = cp[dy]; }
    }
}
__device__ __forceinline__ void ph_dwconv(Fr& F, int layer, int nlat, int nctx) {
    bf16* A = (bf16*)(F.ws + FF_A); const bf16* G = (const bf16*)(F.ws + FF_G);
    const float* cw = IN(I_FCW) + (size_t)layer * 9 * FF; const float* cb = IN(I_FCB) + (size_t)layer * FF;
    const int ngrp = (F.G % 8 == 0) ? 8 : 1, xg = F.bid % ngrp, lb = F.bid / ngrp, nlb = F.G / ngrp;
    const int nseg = nlat / 32, band = nseg / ngrp;
    for (int i = lb * NTHR + F.tid; i < band * 352; i += nlb * NTHR) {
        const int sl = i / 352, f8 = (i - sl * 352) * 8, seg = xg * band + sl, grow = seg >> 1, gy = grow & 127;
        dw_item(G, A, cw, cb, f8, grow * 64, 64, (seg & 1) * 32, gy > 0, gy < 127);
    }
    const int nsegc = nctx / 32;
    for (int i = F.bid * NTHR + F.tid; i < nsegc * 352; i += F.G * NTHR) {
        const int sl = i / 352, f8 = (i - sl * 352) * 8;
        dw_item(G, A, cw, cb, f8, nlat + (sl >> 3) * CTXL, CTXL, (sl & 7) * 32, false, false);
    }
}

__device__ __forceinline__ void prep_items(Fr& F, const bf16* XM, int nb, int Ls, bf16* XC, bf16* KN, bf16* KT, bf16* VT) {
    LAS unsigned char* tk = F.lds + F.wave * 17408; LAS unsigned char* tv = tk + 8704;
    const int ntt = Ls / 64, nitems = nb * ntt * 32;
    const int tl = F.lane >> 3, c8 = F.lane & 7;
    for (int it = F.gw; it < nitems; it += F.ngw) {
        const int cg = it & 31, tt = (it >> 5) % ntt, b = (it >> 5) / ntt, t0 = tt * 64, ch0 = cg * 64 + c8 * 8, h = cg >> 3;
        float cw0[8], cw1[8], cw2[8], cbb[8], wkq[32], wv[32];
        { const float* p = IN(I_MCW) + ch0; const float* pb = IN(I_MCB) + ch0;
#pragma unroll
            for (int e = 0; e < 8; ++e) { cw0[e] = p[e]; cw1[e] = p[MI + e]; cw2[e] = p[2 * MI + e]; cbb[e] = pb[e]; }
            const float* q = (const float*)(F.ws + WS_WKQ) + (ch0 >> 2) * 16; const float* v = IN(I_MWV) + (ch0 >> 2) * 16;
#pragma unroll
            for (int e = 0; e < 32; ++e) { wkq[e] = q[e]; wv[e] = v[e]; } }
#pragma unroll 2
        for (int i8 = 0; i8 < 8; ++i8) {
            const int tloc = i8 * 8 + tl, t = t0 + tloc; const size_t row = (size_t)b * Ls + t;
            float xp[8], xm[8], xn[8];
            const size_t rowp = row - (t > 0 ? 1 : 0), rown = row + (t + 1 < Ls ? 1 : 0); const size_t ctile = (size_t)(ch0 >> 5) * 512 + ((ch0 & 31) >> 3) * 128;
            const u32x4 rm = *(const u32x4*)(XM + (row >> 4) * 32768 + ctile + (row & 15) * 8), rp = *(const u32x4*)(XM + (rowp >> 4) * 32768 + ctile + (rowp & 15) * 8), rn = *(const u32x4*)(XM + (rown >> 4) * 32768 + ctile + (rown & 15) * 8);
            unpack8(rm, xm); unpack8(rp, xp); unpack8(rn, xn);
            { const float mp = t > 0 ? 1.f : 0.f, mn = t + 1 < Ls ? 1.f : 0.f;
#pragma unroll
                for (int e = 0; e < 8; ++e) { xp[e] *= mp; xn[e] *= mn; } }
            float xc[8], kp[8], vv[8];
#pragma unroll
            for (int e = 0; e < 8; ++e) xc[e] = silu_f(cw0[e] * xp[e] + cw1[e] * xm[e] + cw2[e] * xn[e] + cbb[e]);
#pragma unroll
            for (int n = 0; n < 2; ++n)
#pragma unroll
                for (int o = 0; o < 4; ++o) { float sk = 0.f, sv = 0.f;
#pragma unroll
                    for (int c = 0; c < 4; ++c) { sk += xc[n * 4 + c] * wkq[n * 16 + c * 4 + o]; sv += xm[n * 4 + c] * wv[n * 16 + c * 4 + o]; }
                    kp[n * 4 + o] = sk; vv[n * 4 + o] = sv; }
            { const size_t to = ((size_t)(row >> 4) * 64 + (ch0 >> 5)) * 512 + (((unsigned)row & 15u) + 16u * ((ch0 & 31) >> 3)) * 8u;
              *(u32x4*)(XC + to) = pack8(xc); *(u32x4*)(KN + to) = pack8(kp); }
#pragma unroll
            for (int e = 0; e < 8; ++e) { *(LAS bf16*)(tk + (c8 * 8 + e) * 136 + tloc * 2) = (bf16)f2bf(kp[e]); *(LAS bf16*)(tv + (c8 * 8 + e) * 136 + tloc * 2) = (bf16)f2bf(vv[e]); }
        }
#pragma unroll
        for (int q = 0; q < 8; ++q) { const int dt = q >> 1, kq = q & 1, r = F.lane & 15, q4 = F.lane >> 4;
            const size_t tile = ((size_t)(t0 >> 7) * 32 + (cg & 7) * 4 + dt) * 4 + ((t0 & 127) >> 5) + kq;
            const size_t o = (size_t)(b * 4 + h) * 512 * Ls + tile * 512 + F.lane * 8;
            { const u32x2 lo = *(const LAS u32x2*)(tk + (dt * 16 + r) * 136 + kq * 64 + q4 * 16), hi = *(const LAS u32x2*)(tk + (dt * 16 + r) * 136 + kq * 64 + q4 * 16 + 8); *(u32x4*)(KT + o) = (u32x4){lo.x, lo.y, hi.x, hi.y}; }
            { const u32x2 lo = *(const LAS u32x2*)(tv + (dt * 16 + r) * 136 + kq * 64 + q4 * 16), hi = *(const LAS u32x2*)(tv + (dt * 16 + r) * 136 + kq * 64 + q4 * 16 + 8); *(u32x4*)(VT + o) = (u32x4){lo.x, lo.y, hi.x, hi.y}; }
        }
    }
}

__device__ __forceinline__ void gate_items(Fr& F, const bf16* XC, const bf16* XM, int R, float* GATES) {
    const bf16* gwt = (const bf16*)(F.ws + WS_GWT);
    const int fr = F.lane & 15, fq = F.lane >> 4, half = F.wave & 1, pr = F.wave >> 1, ntiles = R / 16;
    LAS f32x4* xch = (LAS f32x4*)(F.lds + pr * 1024);
    for (int base = F.bid * 4; base < ntiles; base += F.G * 4) {
        const int tile = base + pr; const bool ok = tile < ntiles; const int tl = ok ? tile : 0;
        f32x4 acc = (f32x4){0.f, 0.f, 0.f, 0.f};
        const bf16* ap = (half ? XM : XC) + (size_t)tl * 32768 + F.lane * 8; const bf16* bp = gwt + (size_t)half * 64 * 512 + F.lane * 8;
#pragma unroll 16
        for (int ks = 0; ks < 64; ++ks) acc = __builtin_amdgcn_mfma_f32_16x16x32_bf16(*(const bf16x8*)(ap + ks * 512), *(const bf16x8*)(bp + ks * 512), acc, 0, 0, 0);
        __syncthreads();
        if (half) xch[F.lane] = acc;
        __syncthreads();
        if (!half && ok) { acc = acc + xch[F.lane];
            const int r0 = tile * 16; const float bg = IN(I_MBG)[fr]; const bool isf = (fr >> 2) & 1;
#pragma unroll
            for (int r = 0; r < 4; ++r) { float x = acc[r] + bg; if (isf) x = fminf(x, 0.f) - log1pf(__expf(-fabsf(x))); GATES[(size_t)(r0 + 4 * fq + r) * 16 + fr] = x; } }
    }
}

__device__ __forceinline__ void cum_items(Fr& F, const float* GATES, int nb, int Ls, int gb0, int ctau0, f32x4* GT, float* GC) {
    const int R = nb * Ls, nch = Ls / 128, nitems = 2 * nb * 4 * nch;
    for (int it = F.gw; it < nitems; it += F.ngw) {
        const int c = it % nch, h = (it / nch) & 3, b = (it / nch / 4) % nb, dir = it / nch / 4 / nb;
        const int row0 = b * Ls + c * 128 + 2 * F.lane;
        const float lf0 = GATES[(size_t)row0 * 16 + dir * 8 + 4 + h], lf1 = GATES[(size_t)(row0 + 1) * 16 + dir * 8 + 4 + h];
        const float ig0 = GATES[(size_t)row0 * 16 + dir * 8 + h], ig1 = GATES[(size_t)(row0 + 1) * 16 + dir * 8 + h];
        float inc = lf0 + lf1;
#pragma unroll
        for (int o = 1; o < 64; o <<= 1) { const float t = __shfl_up(inc, o); if (F.lane >= o) inc += t; }
        const float tot = __shfl(inc, 63), exc = inc - (lf0 + lf1);
        float b0, b1;
        if (dir == 0) { b0 = exc + lf0; b1 = inc; } else { b0 = tot - exc; b1 = tot - exc - lf0; }
        GT[(size_t)(dir * 4 + h) * R + row0] = (f32x4){b0, ig0 - b0, __expf(b0), __expf(tot - b0 + ig0)};
        GT[(size_t)(dir * 4 + h) * R + row0 + 1] = (f32x4){b1, ig1 - b1, __expf(b1), __expf(tot - b1 + ig1)};
        if (F.lane == 0) GC[((size_t)(dir * 4 + gb0 + b) * 4 + h) * 66 + ctau0 + c] = __expf(tot);
    }
}

__device__ __forceinline__ void dn_item(Fr& F, const bf16* KTchunk, const f32x4* GTd0, const f32x4* GTd1, int row0, float* DN0, float* DN1) {
    LAS float* wl = (LAS float*)(F.lds + 1024);
    __syncthreads();
    if (F.tid < 128) wl[F.tid] = GTd0[row0 + F.tid][3]; else if (F.tid < 256) wl[F.tid] = GTd1[row0 + F.tid - 128][3];
    __syncthreads();
    const bf16* kr = KTchunk + (size_t)(F.tid >> 4) * 4 * 512 + (F.tid & 15) * 8; float s0 = 0.f, s1 = 0.f;
#pragma unroll 4
    for (int q = 0; q < 16; ++q) { const int ks = q >> 2, q4 = q & 3; float v[8]; unpack8(*(const u32x4*)(kr + ks * 512 + q4 * 128), v);
#pragma unroll
        for (int e = 0; e < 8; ++e) { s0 += v[e] * wl[q * 8 + e]; s1 += v[e] * wl[128 + q * 8 + e]; } }
    DN0[F.tid] = s0; DN1[F.tid] = s1;
}
__device__ __forceinline__ void ph_sphase(Fr& F, int hb, bool with_ctx) {
    const bf16* XC = (const bf16*)(F.ws + MS_XC); const bf16* KN = (const bf16*)(F.ws + MS_KN); const bf16* KT = (const bf16*)(F.ws + MS_KT);
    const f32x4* GT = (const f32x4*)(F.ws + WS_GT_L); float* DN = (float*)(F.ws + WS_DN); float* RS = (float*)(F.ws + WS_RS);
    bf16* S = (bf16*)(F.ws + MS_S);
    const int fr = F.lane & 15, fq = F.lane >> 4, w = F.wave;
    for (int it = F.bid; it < 512; it += F.G) {
        const int c = it & 63, h = (it >> 6) & 3, bl = it >> 8, gb = 2 * hb + bl;
        const int row0 = bl * SEQ + c * 128;
        dn_item(F, KT + (size_t)(bl * 4 + h) * 512 * SEQ + (size_t)c * 65536, GT + (size_t)(0 * 4 + h) * HROWS, GT + (size_t)(1 * 4 + h) * HROWS, row0,
                DN + (((size_t)(0 * 4 + gb) * 4 + h) * 66 + 2 + c) * 512, DN + (((size_t)(1 * 4 + gb) * 4 + h) * 66 + 2 + c) * 512);
        const int irow = row0 + 16 * w + fr;
        bf16x8 bq[16];
        { const bf16* p = XC + ((size_t)((row0 >> 4) + w) * 64 + h * 16) * 512 + F.lane * 8;
#pragma unroll
            for (int ks = 0; ks < 16; ++ks) bq[ks] = *(const bf16x8*)(p + ks * 512); }
        const f32x4 gf = GT[(size_t)(0 * 4 + h) * HROWS + irow], gbk = GT[(size_t)(1 * 4 + h) * HROWS + irow];
        float rsf = 0.f, rsb = 0.f;
        bf16* sf = S + ((size_t)(0 * 8 + bl * 4 + h) * 64 + c) * 16384; bf16* sb = S + ((size_t)(1 * 8 + bl * 4 + h) * 64 + c) * 16384;
#pragma unroll 1
        for (int jt = 0; jt < 8; ++jt) {
            f32x4 acc = (f32x4){0.f, 0.f, 0.f, 0.f};
            const bf16* ap = KN + ((size_t)((row0 >> 4) + jt) * 64 + h * 16) * 512 + F.lane * 8;
#pragma unroll
            for (int ks = 0; ks < 16; ++ks) acc = __builtin_amdgcn_mfma_f32_16x16x32_bf16(*(const bf16x8*)(ap + ks * 512), bq[ks], acc, 0, 0, 0);
            float vf[4], vb[4];
            const f32x4* gj0 = GT + (size_t)(0 * 4 + h) * HROWS + row0 + jt * 16 + 4 * fq; const f32x4* gj1 = GT + (size_t)(1 * 4 + h) * HROWS + row0 + jt * 16 + 4 * fq;
#pragma unroll
            for (int r = 0; r < 4; ++r) { const int j = jt * 16 + 4 * fq + r, i = 16 * w + fr;
                const float af = gj0[r][1], ab = gj1[r][1];
                vf[r] = (j <= i) ? acc[r] * __expf(gf[0] + af) : 0.f; vb[r] = (j >= i) ? acc[r] * __expf(gbk[0] + ab) : 0.f;
                rsf += vf[r]; rsb += vb[r]; }
            const size_t so = (size_t)(w * 4 + (jt >> 1)) * 512 + (fr + 16 * ((jt & 1) * 2 + (fq >> 1))) * 8 + (fq & 1) * 4;
            *(u32x2*)(sf + so) = (u32x2){pk2(vf[0], vf[1]), pk2(vf[2], vf[3])};
            *(u32x2*)(sb + so) = (u32x2){pk2(vb[0], vb[1]), pk2(vb[2], vb[3])};
        }
        rsf += __shfl_xor(rsf, 16); rsf += __shfl_xor(rsf, 32); rsb += __shfl_xor(rsb, 16); rsb += __shfl_xor(rsb, 32);
        if (fq == 0) { RS[(size_t)(0 * 4 + h) * HROWS + irow] = rsf; RS[(size_t)(1 * 4 + h) * HROWS + irow] = rsb; }
    }
    if (with_ctx) {
        const bf16* KTC2 = (const bf16*)(F.ws + MS_KTC); const f32x4* GTC = (const f32x4*)(F.ws + WS_GT_C);
        for (int it = F.bid; it < 32; it += F.G) {
            const int cc = it & 1, h = (it >> 1) & 3, gb = it >> 3;
            dn_item(F, KTC2 + (size_t)(gb * 4 + h) * 512 * CTXL + (size_t)cc * 65536, GTC + (size_t)(0 * 4 + h) * MC, GTC + (size_t)(1 * 4 + h) * MC, gb * CTXL + cc * 128,
                    DN + (((size_t)(0 * 4 + gb) * 4 + h) * 66 + cc) * 512, DN + (((size_t)(1 * 4 + gb) * 4 + h) * 66 + cc) * 512);
        }
    }
}

__device__ __forceinline__ bf16x8 ldg16(const char* ub, unsigned off) { return *(const bf16x8*)(ub + off); }
__device__ __forceinline__ void ph_scan(Fr& F, int hb) {
    const char* XC = (const char*)(F.ws + MS_XC); const char* KT = (const char*)(F.ws + MS_KT); const char* VT = (const char*)(F.ws + MS_VT);
    const char* KTC2 = (const char*)(F.ws + MS_KTC); const char* VTC2 = (const char*)(F.ws + MS_VTC);
    const char* S = (const char*)(F.ws + MS_S);
    const f32x4* GTL = (const f32x4*)(F.ws + WS_GT_L); const f32x4* GTC = (const f32x4*)(F.ws + WS_GT_C);
    const float* GC = (const float*)(F.ws + WS_GC); const float* DN = (const float*)(F.ws + WS_DN);
    float* NC = (float*)(F.ws + WS_NC);
    LAS unsigned char* cbf = F.lds;
    LAS float* wl = (LAS float*)(F.lds + 2 * 33280);
    LAS unsigned char* vtb = F.lds + 2 * 33280 + 1024;
    const int w = F.wave;
    for (int wi = F.bid; wi < 256; wi += F.G) {
        const int chain = wi & 15, slice = wi >> 4, dir = chain >> 3, bl = (chain >> 2) & 1, h = chain & 3, gb = 2 * hb + bl, e0 = slice * 32;
        char* NUM = (char*)(F.ws + (dir ? MS_NB : MS_NF));
        const bool nwriter = (slice == 0) && (w == 0);
        f32x4 acc[4][2];
#pragma unroll
        for (int a = 0; a < 4; ++a)
#pragma unroll
            for (int b = 0; b < 2; ++b) acc[a][b] = (f32x4){0.f, 0.f, 0.f, 0.f};
        float nreg[8];
#pragma unroll
        for (int e = 0; e < 8; ++e) nreg[e] = 0.f;
        __syncthreads();
        const char* ktc = KTC2 + (size_t)(gb * 4 + h) * 512 * CTXL * 2; const char* vtc = VTC2 + (size_t)(gb * 4 + h) * 512 * CTXL * 2;
        const char* ktl = KT + (size_t)(bl * 4 + h) * 512 * SEQ * 2;    const char* vtl = VT + (size_t)(bl * 4 + h) * 512 * SEQ * 2;
        { const int ctau = dir == 0 ? 0 : 1; const f32x4* gt = GTC + (size_t)(dir * 4 + h) * MC; if (F.tid < 128) wl[F.tid] = gt[gb * CTXL + ctau * 128 + F.tid][3];
          *(LAS bf16x8*)(vtb + w * 1024 + F.lane * 16) = ldg16(vtc + (size_t)ctau * 131072 + (e0 >> 4) * 4096 + w * 1024, F.lane * 16u); }
        __syncthreads();
        bf16x8 xf[16];
#pragma unroll
        for (int ks = 0; ks < 16; ++ks) xf[ks] = (bf16x8){0, 0, 0, 0, 0, 0, 0, 0};
#pragma unroll 1
        for (int s = 0; s < 66; ++s) {
            int tid_ = F.tid; asm volatile("" : "+v"(tid_));
            const int lane_ = tid_ & 63, fr = lane_ & 15, fq = lane_ >> 4; const unsigned l16 = lane_ * 16u;
            const int ctau = dir == 0 ? s : (s < 2 ? 1 - s : 67 - s);
            const bool isctx = ctau < 2; const int c = isctx ? ctau : ctau - 2;
            const char* ktu = (isctx ? ktc : ktl) + (size_t)c * 131072;
            const int row0 = isctx ? gb * CTXL + c * 128 : bl * SEQ + c * 128;
            const f32x4* gt = isctx ? GTC + (size_t)(dir * 4 + h) * MC : GTL + (size_t)(dir * 4 + h) * HROWS;
            const float Gd = GC[((size_t)(dir * 4 + gb) * 4 + h) * 66 + ctau];
            const float* dn = DN + (((size_t)(dir * 4 + gb) * 4 + h) * 66 + ctau) * 512;
            LAS unsigned char* cb_rd = cbf + (s & 1) * 33280; LAS unsigned char* cb_wr = cbf + ((s + 1) & 1) * 33280;
            const LAS float* wl_rd = wl + (s & 1) * 128; LAS float* wl_wr = wl + ((s + 1) & 1) * 128;
            const int s2 = s + 1, ct2 = dir == 0 ? s2 : (s2 < 2 ? 1 - s2 : 67 - s2); const bool has2 = s2 < 66, ic2 = ct2 < 2; const int c2 = ic2 ? ct2 : ct2 - 2;
            const char* xc2 = XC + ((size_t)(((bl * SEQ + c2 * 128) >> 4) + w) * 64 + h * 16) * 1024;
            const LAS unsigned char* vt_rd = vtb + (s & 1) * 8192; LAS unsigned char* vt_wr = vtb + ((s + 1) & 1) * 8192;
            bf16x8 kf[4][4], vf[2][4], sfr[4];
            bf16x8 vnext = (bf16x8){0, 0, 0, 0, 0, 0, 0, 0};
            if (has2) vnext = ldg16((ic2 ? vtc : vtl) + (size_t)c2 * 131072 + (e0 >> 4) * 4096 + w * 1024, l16);
#pragma unroll
            for (int et = 0; et < 2; ++et)
#pragma unroll
                for (int ks = 0; ks < 4; ++ks) vf[et][ks] = *(const LAS bf16x8*)(vt_rd + (et * 4 + ks) * 1024 + l16);
            if (!isctx) { const char* su = S + ((size_t)(dir * 8 + bl * 4 + h) * 64 + c) * 32768 + w * 4096;
#pragma unroll
                for (int ks = 0; ks < 4; ++ks) sfr[ks] = ldg16(su + ks * 1024, l16); }
#pragma unroll
            for (int ks = 0; ks < 1; ++ks)
#pragma unroll
                for (int dt = 0; dt < 4; ++dt) kf[ks][dt] = ldg16(ktu + (4 * w + dt) * 4096 + ks * 1024, l16);
            unsigned pf = 0u; const int s3 = s + 2;
            if (s3 < 66) {
                const int ct3 = dir == 0 ? s3 : (s3 < 2 ? 1 - s3 : 67 - s3); const bool ic3 = ct3 < 2; const int c3 = ic3 ? ct3 : ct3 - 2;
                const char* kt3 = (ic3 ? ktc : ktl) + (size_t)c3 * 131072; const char* vt3 = (ic3 ? vtc : vtl) + (size_t)c3 * 131072;
                const char* xc3 = XC + ((size_t)((bl * SEQ + c3 * 128) >> 4) * 64 + h * 16) * 1024; const char* s3p = S + ((size_t)(dir * 8 + bl * 4 + h) * 64 + c3) * 32768;
                const unsigned t = tid_; const char* ub = kt3; unsigned off = 0u;
                if (t < 64) { off = (slice * 64 + t) * 128u; }
                else if (t < 128) { ub = vt3; off = (e0 >> 4) * 4096u + (t - 64) * 128u; }
                else if (t < 192) { if (!ic3) { const unsigned ln = slice * 64 + (t - 128); ub = xc3; off = (ln >> 7) * 65536u + (ln & 127) * 128u; } }
                else if (t < 208) { if (!ic3) { ub = s3p; off = (slice * 16 + (t - 192)) * 128u; } }
                if (t < 208) pf = *(const volatile unsigned*)(ub + off);
            }
            if (!isctx) {
                const float Ei = *(const float*)((const char*)(gt + row0 + 16 * w) + (unsigned)fr * 16u + 8u);
                if (nwriter) { char* np = (char*)(NC + (((size_t)(dir * 2 + bl) * 4 + h) * 64 + c) * 512); const unsigned lo = lane_ * 32u;
                    *(f32x4*)(np + lo) = (f32x4){nreg[0], nreg[1], nreg[2], nreg[3]}; *(f32x4*)(np + lo + 16u) = (f32x4){nreg[4], nreg[5], nreg[6], nreg[7]}; }
                f32x4 a2[2] = {(f32x4){0.f, 0.f, 0.f, 0.f}, (f32x4){0.f, 0.f, 0.f, 0.f}};
#pragma unroll
                for (int ks = 0; ks < 16; ++ks)
#pragma unroll
                    for (int et = 0; et < 2; ++et) a2[et] = __builtin_amdgcn_mfma_f32_16x16x32_bf16(*(const LAS bf16x8*)(cb_rd + (16 * et + fr) * 1040 + ks * 64 + fq * 16), xf[ks], a2[et], 0, 0, 0);
                asm volatile("" ::: "memory");
#pragma unroll
                for (int ks = 1; ks < 4; ++ks)
#pragma unroll
                    for (int dt = 0; dt < 4; ++dt) kf[ks][dt] = ldg16(ktu + (4 * w + dt) * 4096 + ks * 1024, l16);
                a2[0] = a2[0] * Ei; a2[1] = a2[1] * Ei;
#pragma unroll
                for (int ks = 0; ks < 4; ++ks)
#pragma unroll
                    for (int et = 0; et < 2; ++et) a2[et] = __builtin_amdgcn_mfma_f32_16x16x32_bf16(vf[et][ks], sfr[ks], a2[et], 0, 0, 0);
                char* nu = NUM + ((size_t)row0 * MI + h * 512 + e0) * 2; const unsigned ln = ((16u * w + fr) * MI + 4u * fq) * 2u;
#pragma unroll
                for (int et = 0; et < 2; ++et) *(u32x2*)(nu + et * 32 + ln) = (u32x2){pk2(a2[et][0], a2[et][1]), pk2(a2[et][2], a2[et][3])};
            } else {
#pragma unroll
                for (int ks = 1; ks < 4; ++ks)
#pragma unroll
                    for (int dt = 0; dt < 4; ++dt) kf[ks][dt] = ldg16(ktu + (4 * w + dt) * 4096 + ks * 1024, l16);
            }
            if (has2) *(LAS bf16x8*)(vt_wr + w * 1024 + l16) = vnext;
            if (has2 && tid_ < 128) {
                const f32x4* gt2 = ic2 ? GTC + (size_t)(dir * 4 + h) * MC : GTL + (size_t)(dir * 4 + h) * HROWS;
                wl_wr[tid_] = *(const float*)((const char*)(gt2 + (ic2 ? gb * CTXL : bl * SEQ) + c2 * 128) + (unsigned)tid_ * 16u + 12u); }
#pragma unroll
            for (int a = 0; a < 4; ++a)
#pragma unroll
                for (int b = 0; b < 2; ++b) acc[a][b] = acc[a][b] * Gd;
#pragma unroll
            for (int ks = 0; ks < 4; ++ks) {
                bf16x8 bv[2];
#pragma unroll
                for (int et = 0; et < 2; ++et) { float v[8]; unpack8(__builtin_bit_cast(u32x4, vf[et][ks]), v);
#pragma unroll
                    for (int e = 0; e < 8; ++e) v[e] *= wl_rd[ks * 32 + 8 * fq + e];
                    const u32x4 pv = pack8(v); bv[et] = __builtin_bit_cast(bf16x8, pv); }
#pragma unroll
                for (int dt = 0; dt < 4; ++dt)
#pragma unroll
                    for (int et = 0; et < 2; ++et) acc[dt][et] = __builtin_amdgcn_mfma_f32_16x16x32_bf16(kf[ks][dt], bv[et], acc[dt][et], 0, 0, 0);
            }
            asm volatile("" ::: "memory");
            if (has2 && !ic2) {
#pragma unroll
                for (int ks = 0; ks < 16; ++ks) xf[ks] = ldg16(xc2 + ks * 1024, l16);
            }
            if (nwriter) { const unsigned lo = lane_ * 32u; const f32x4 d0 = *(const f32x4*)((const char*)dn + lo), d1 = *(const f32x4*)((const char*)dn + lo + 16u);
                nreg[0] = Gd * nreg[0] + d0[0]; nreg[1] = Gd * nreg[1] + d0[1]; nreg[2] = Gd * nreg[2] + d0[2]; nreg[3] = Gd * nreg[3] + d0[3];
                nreg[4] = Gd * nreg[4] + d1[0]; nreg[5] = Gd * nreg[5] + d1[1]; nreg[6] = Gd * nreg[6] + d1[2]; nreg[7] = Gd * nreg[7] + d1[3]; }
#pragma unroll
            for (int dt = 0; dt < 4; ++dt)
#pragma unroll
                for (int et = 0; et < 2; ++et) *(LAS u32x2*)(cb_wr + (16 * et + fr) * 1040 + (64 * w + 16 * dt + 4 * fq) * 2) = (u32x2){pk2(acc[dt][et][0], acc[dt][et][1]), pk2(acc[dt][et][2], acc[dt][et][3])};
            asm volatile("" :: "v"(pf));
            __syncthreads();
        }
    }
}

__device__ __forceinline__ void ph_mout(Fr& F) {
    bf16* NF = (bf16*)(F.ws + MS_NF); const bf16* NBk = (const bf16*)(F.ws + MS_NB); const bf16* XC = (const bf16*)(F.ws + MS_XC); const bf16* Z = (const bf16*)(F.ws + MS_Z);
    const float* NC = (const float*)(F.ws + WS_NC); const float* RS = (const float*)(F.ws + WS_RS); const f32x4* GTL = (const f32x4*)(F.ws + WS_GT_L);
    LAS unsigned char* xt = F.lds + F.wave * 16640;
    for (int it = F.gw; it < (HROWS / 16) * 4; it += F.ngw) {
        const int rt = it >> 2, h = it & 3, bl = rt >> 9, c = (rt >> 3) & 63;
        { const bf16* xp = XC + ((size_t)rt * 64 + h * 16) * 512 + F.lane * 8; u32x4 t[16];
#pragma unroll
            for (int ks = 0; ks < 16; ++ks) t[ks] = *(const u32x4*)(xp + ks * 512);
#pragma unroll
            for (int ks = 0; ks < 16; ++ks) *(LAS u32x4*)(xt + ks * 1040 + F.lane * 16) = t[ks]; }
        const float* n0 = NC + (((size_t)(0 * 2 + bl) * 4 + h) * 64 + c) * 512 + 8 * F.lane; const float* n1 = NC + (((size_t)(1 * 2 + bl) * 4 + h) * 64 + c) * 512 + 8 * F.lane;
        const f32x4 n00 = *(const f32x4*)n0, n01 = *(const f32x4*)(n0 + 4), n10 = *(const f32x4*)n1, n11 = *(const f32x4*)(n1 + 4);
        float nw[8], sk[8];
        { const float* pw = IN(I_MNW) + h * 512 + 8 * F.lane; const float* ps = IN(I_MSKIP) + h * 512 + 8 * F.lane;
#pragma unroll
            for (int e = 0; e < 8; ++e) { nw[e] = pw[e]; sk[e] = ps[e]; } }
#pragma unroll 2
        for (int r = 0; r < 16; ++r) {
            const int row = rt * 16 + r; const size_t o = (size_t)row * MI + h * 512 + 8 * F.lane;
            float nf[8], nb[8], xc[8], z[8];
            unpack8(*(const u32x4*)(NF + o), nf); unpack8(*(const u32x4*)(NBk + o), nb); unpack8(*(const u32x4*)(Z + o), z);
            unpack8(*(const LAS u32x4*)(xt + (F.lane >> 2) * 1040 + (r + 16 * (F.lane & 3)) * 16), xc);
            float d0 = xc[0] * n00[0] + xc[1] * n00[1] + xc[2] * n00[2] + xc[3] * n00[3] + xc[4] * n01[0] + xc[5] * n01[1] + xc[6] * n01[2] + xc[7] * n01[3];
            float d1 = xc[0] * n10[0] + xc[1] * n10[1] + xc[2] * n10[2] + xc[3] * n10[3] + xc[4] * n11[0] + xc[5] * n11[1] + xc[6] * n11[2] + xc[7] * n11[3];
            d0 = wave_sum(d0); d1 = wave_sum(d1);
            const float den0 = GTL[(size_t)(0 * 4 + h) * HROWS + row][2] * d0 + RS[(size_t)(0 * 4 + h) * HROWS + row], den1 = GTL[(size_t)(1 * 4 + h) * HROWS + row][2] * d1 + RS[(size_t)(1 * 4 + h) * HROWS + row];
            const float i0 = 1.0f / fmaxf(fabsf(den0), 1.0f), i1 = 1.0f / fmaxf(fabsf(den1), 1.0f);
            float s = 0.f;
#pragma unroll
            for (int e = 0; e < 8; ++e) { nf[e] = nf[e] * i0 + nb[e] * i1; s += nf[e]; }
            const float mu = wave_sum(s) * (1.0f / 512.0f); float q = 0.f;
#pragma unroll
            for (int e = 0; e < 8; ++e) { nf[e] -= mu; q += nf[e] * nf[e]; }
            const float rstd = 1.0f / sqrtf(wave_sum(q) * (1.0f / 512.0f) + ML_NORM_EPS);
#pragma unroll
            for (int e = 0; e < 8; ++e) nf[e] = (nf[e] * rstd * nw[e] + sk[e] * xc[e]) * silu_f(z[e]);
            *(u32x4*)(NF + o) = pack8(nf);
        }
    }
}

__device__ __forceinline__ void ph_final(Fr& F) {
    const float* g = IN(I_FINALG);
    for (int r = F.gw; r < ML; r += 2 * F.ngw) {
        const int r2 = r + F.ngw < ML ? r + F.ngw : r;
        f32x4* xa = (f32x4*)(F.out + (size_t)r * 1024) + F.lane; f32x4* xb = (f32x4*)(F.out + (size_t)r2 * 1024) + F.lane; f32x4 va[4], vb[4]; float sa = 0.f, sb = 0.f;
#pragma unroll
        for (int j = 0; j < 4; ++j) { va[j] = xa[64 * j]; vb[j] = xb[64 * j]; }
#pragma unroll
        for (int j = 0; j < 4; ++j) { sa += (va[j][0] * va[j][0] + va[j][1] * va[j][1]) + (va[j][2] * va[j][2] + va[j][3] * va[j][3]); sb += (vb[j][0] * vb[j][0] + vb[j][1] * vb[j][1]) + (vb[j][2] * vb[j][2] + vb[j][3] * vb[j][3]); }
        const float ra = 1.0f / sqrtf(wave_sum(sa) * (1.0f / 1024.0f) + EPS), rb = 1.0f / sqrtf(wave_sum(sb) * (1.0f / 1024.0f) + EPS);
#pragma unroll
        for (int j = 0; j < 4; ++j) { const f32x4 gg = *(const f32x4*)(g + 4 * F.lane + 256 * j); xa[64 * j] = va[j] * ra * gg; if (r2 != r) xb[64 * j] = vb[j] * rb * gg; }
    }
}

template <class Epi>
__device__ __forceinline__ void run_gemm(Fr& F, const bf16* A, const bf16* Bt, int M, int N, int K, const Epi& E) {
    pg8::Gemm g{A, Bt, M, N, K}; pg8::StaticOrder S; S.init(M, N, F.G, F.bid);
    pg8::gemm_phase<Epi, pg8::StaticOrder, true, true>(F.lds, g, S, E, F.tid);
}

struct Args { const float* in[38]; float* out; unsigned char* ws; int ph_lo, ph_hi; };
static_assert(sizeof(Args) == 328 && offsetof(Args, out) == 304 && offsetof(Args, ws) == 312 && offsetof(Args, ph_lo) == 320, "Args layout");
constexpr int N_PHASES = 36;


#define XB_TMO      128
#define XB_XCNT(j)  (256  + 64 * (j))
#define XB_XSUB(j)  (1280 + 64 * (j))
#define XB_XGEN(j)  (2304 + 64 * (j))
#define XB_TOP      3328
#define XB_TOPGEN   3392
#define XCD_BAR_WORDS 3456
#define XB_SPIN_CAP (1u << 22)
__device__ __forceinline__ unsigned xb_ld(unsigned* p)              { return __hip_atomic_load(p, __ATOMIC_RELAXED, __HIP_MEMORY_SCOPE_AGENT); }
__device__ __forceinline__ unsigned xb_add(unsigned* p, unsigned v) { return __hip_atomic_fetch_add(p, v, __ATOMIC_RELAXED, __HIP_MEMORY_SCOPE_AGENT); }
__device__ __forceinline__ unsigned xb_xcc_id() { return (unsigned)__builtin_amdgcn_s_getreg((3 << 11) | 20) & 0xFu; }
#define XB_SPIN(cond, bar) do { unsigned _sp = 0; while (cond) { __builtin_amdgcn_s_sleep(1); \
    if ((++_sp & 255u) == 0u) { if (xb_ld(&(bar)[XB_TMO])) break; if (_sp > XB_SPIN_CAP) { atomicAdd(&(bar)[XB_TMO], 1u); break; } } } } while (0)
__device__ __forceinline__ void xcd_barrier_complete(unsigned* bar, unsigned x, unsigned& nloc, unsigned& nx) {
    const unsigned G = gridDim.x * gridDim.y * gridDim.z;
    unsigned sum, cnt, mine, sp = 0u;
    for (;;) {
        sum = 0u; cnt = 0u; mine = 0u;
#pragma unroll
        for (unsigned j = 0; j < 16; ++j) { const unsigned c = xb_ld(&bar[XB_XCNT(j)]); sum += c; cnt += (c > 0u) ? 1u : 0u; mine = (j == x) ? c : mine; }
        if (sum == G) break;
        __builtin_amdgcn_s_sleep(1);
        if ((++sp & 255u) == 0u) { if (xb_ld(&bar[XB_TMO])) break; if (sp > XB_SPIN_CAP) { atomicAdd(&bar[XB_TMO], 1u); break; } }
    }
    nloc = mine > 0u ? mine : 1u; nx = cnt > 0u ? cnt : 1u;
}
__device__ __forceinline__ void xcd_barrier(unsigned* bar, volatile LAS unsigned* st) {
    asm volatile("s_waitcnt vmcnt(0)" ::: "memory");
    __syncthreads();
    if (threadIdx.x == 0) {
        const unsigned x = xb_xcc_id();
        __builtin_amdgcn_s_waitcnt(0);
        unsigned nloc = st[0], nx = st[1];
        if (nloc == 0u) { xcd_barrier_complete(bar, x, nloc, nx); st[0] = nloc; st[1] = nx; }
        const unsigned old = xb_add(&bar[XB_XSUB(x)], 1u);
        const unsigned gen = old / nloc;
        if (old + 1u == (gen + 1u) * nloc) {
            __builtin_amdgcn_fence(__ATOMIC_RELEASE, "agent");
            asm volatile("s_waitcnt vmcnt(0)" ::: "memory");
            const unsigned og = xb_add(&bar[XB_TOP], 1u);
            const unsigned tg = og / nx;
            if (og + 1u == (tg + 1u) * nx) xb_add(&bar[XB_TOPGEN], 1u);
            else XB_SPIN(xb_ld(&bar[XB_TOPGEN]) == tg, bar);
            __builtin_amdgcn_fence(__ATOMIC_ACQUIRE, "agent");
            xb_add(&bar[XB_XGEN(x)], 1u);
            asm volatile("s_waitcnt vmcnt(0)" ::: "memory");
        } else {
            XB_SPIN(xb_ld(&bar[XB_XGEN(x)]) == gen, bar);
            __builtin_amdgcn_fence(__ATOMIC_ACQUIRE, "agent");
            asm volatile("s_waitcnt vmcnt(0)" ::: "memory");
        }
    }
    __syncthreads();
}
#ifndef PROBE_MASK
#define PROBE_MASK 0ull
#endif
constexpr int BAR_LDS_OFF = LDS_BYTES - 64;
constexpr size_t WS_BAR = 0;
constexpr size_t WS_TS = 64 * 1024;

template <int ph>
__device__ __forceinline__ void run_phase(Fr& F) {
    unsigned char* ws = F.ws;
    float* mod = (float*)(ws + WS_MOD); float* ctxx = (float*)(ws + WS_CTXX);
    if constexpr (ph == 0) ph_prologue(F);
    else if constexpr (ph == 1) {
            kt_items(F, (const float*)(ws + WS_H3), SEQ, (float*)(ws + HY_KT));
            kt_items(F, (const float*)(ws + WS_H3) + (size_t)SEQ * 64, CTXL, (float*)(ws + WS_KTC));
            ph_modnorm(F, IN(I_X), ML, 0, IN(I_CTX), MC, IN(I_NORMG), mod, 0, (bf16*)(ws + HY_H));
        }
    else if constexpr (ph == 2) { pg8::EpiBf16 E{(bf16*)(ws + HY_P), 3072, IN(I_HBIN), 0, 0}; run_gemm(F, (const bf16*)(ws + HY_H), (const bf16*)(ws + WS_WHIN), MALL, 3072, 1024, E); }
    else if constexpr (ph == 3) { zt_items(F, (const bf16*)(ws + HY_P), 0, NB, SEQ, (bf16*)(ws + HY_ZT)); zt_items(F, (const bf16*)(ws + HY_P), ML, NB, CTXL, (bf16*)(ws + HY_ZTC)); }
    else if constexpr (ph == 4) ph_fftconv(F);
    else if constexpr (ph == 5) { u2_items(F, (const bf16*)(ws + HY_P), 0, NB, SEQ, (const bf16*)(ws + HY_ZT), (bf16*)(ws + HY_H)); u2_items(F, (const bf16*)(ws + HY_P), ML, NB, CTXL, (const bf16*)(ws + HY_ZTC), (bf16*)(ws + HY_H)); }
    else if constexpr (ph == 6) { pg8::EpiRes E{IN(I_X), F.out, IN(I_CTX), ctxx, ML, mod + 2048, 0, IN(I_HBOUT)}; run_gemm(F, (const bf16*)(ws + HY_H), (const bf16*)(ws + WS_WHOUT), MALL, 1024, 1024, E); }
    else if constexpr (ph == 7) ph_modnorm(F, F.out, ML, 0, ctxx, MC, IN(I_NORMG) + 1024, mod, 3072, (bf16*)(ws + FF_H));
    else if constexpr (ph == 8) { pg8::EpiBf16 E{(bf16*)(ws + FF_A), FF, nullptr, FF, (FF_G - FF_A) / 2}; run_gemm(F, (const bf16*)(ws + FF_H), (const bf16*)(ws + WS_WUP0), MALL, 2 * FF, 1024, E); }
    else if constexpr (ph == 9) ph_dwconv(F, 0, ML, MC);
    else if constexpr (ph == 10) { pg8::EpiRes E{F.out, F.out, ctxx, ctxx, ML, mod + 5120, 0, nullptr}; run_gemm(F, (const bf16*)(ws + FF_A), (const bf16*)(ws + WS_WDN0), MALL, 1024, FF, E); }
    else if constexpr (ph < 31) {
            constexpr int hb = (ph - 11) / 10, k = (ph - 11) % 10; const float* mod1 = mod + 5 * 6144;
            float* xh = F.out + (size_t)hb * HROWS * 1024;
            if constexpr (k == 0) { ph_modnorm(F, xh, HROWS, 2 * hb, ctxx, 0, IN(I_NORMG) + 2048, mod1, 0, (bf16*)(ws + MS_H));
                          if (hb == 0) ph_modnorm(F, xh, 0, 0, ctxx, MC, IN(I_NORMG) + 2048, mod1, 0, (bf16*)(ws + MS_HC)); }
            else if constexpr (k == 1) { { pg8::EpiBf16T E{(bf16*)(ws + MS_XM), MI / 32}; run_gemm(F, (const bf16*)(ws + MS_H), (const bf16*)(ws + WS_WMIN), HROWS, MI, 1024, E); }
                               if (hb == 0) { pg8::EpiBf16T E{(bf16*)(ws + MS_XMC), MI / 32}; run_gemm(F, (const bf16*)(ws + MS_HC), (const bf16*)(ws + WS_WMIN), MC, MI, 1024, E); } }
            else if constexpr (k == 2) { prep_items(F, (const bf16*)(ws + MS_XM), 2, SEQ, (bf16*)(ws + MS_XC), (bf16*)(ws + MS_KN), (bf16*)(ws + MS_KT), (bf16*)(ws + MS_VT));
                               if (hb == 0) prep_items(F, (const bf16*)(ws + MS_XMC), NB, CTXL, (bf16*)(ws + MS_XCC), (bf16*)(ws + MS_XCC + 16 * MiB), (bf16*)(ws + MS_KTC), (bf16*)(ws + MS_VTC)); }
            else if constexpr (k == 3) { gate_items(F, (const bf16*)(ws + MS_XC), (const bf16*)(ws + MS_XM), HROWS, (float*)(ws + WS_GATES_L));
                               if (hb == 0) gate_items(F, (const bf16*)(ws + MS_XCC), (const bf16*)(ws + MS_XMC), MC, (float*)(ws + WS_GATES_C)); }
            else if constexpr (k == 4) { cum_items(F, (const float*)(ws + WS_GATES_L), 2, SEQ, 2 * hb, 2, (f32x4*)(ws + WS_GT_L), (float*)(ws + WS_GC));
                               if (hb == 0) cum_items(F, (const float*)(ws + WS_GATES_C), NB, CTXL, 0, 0, (f32x4*)(ws + WS_GT_C), (float*)(ws + WS_GC)); }
            else if constexpr (k == 5) ph_sphase(F, hb, hb == 0);
            else if constexpr (k == 6) ph_scan(F, hb);
            else if constexpr (k == 7) { pg8::EpiBf16 E{(bf16*)(ws + MS_Z), MI, nullptr, 0, 0}; run_gemm(F, (const bf16*)(ws + MS_H), (const bf16*)(ws + WS_WMIN) + (size_t)MI * 1024, HROWS, MI, 1024, E); }
            else if constexpr (k == 8) ph_mout(F);
            else { pg8::EpiRes E{xh, xh, ctxx, ctxx, HROWS, mod1 + 2048, 2 * hb, nullptr}; run_gemm(F, (const bf16*)(ws + MS_NF), (const bf16*)(ws + WS_WMDN), HROWS, 1024, MI, E); }
        }
    else if constexpr (ph == 31) ph_modnorm(F, F.out, ML, 0, ctxx, 0, IN(I_NORMG) + 3072, mod + 5 * 6144, 3072, (bf16*)(ws + FF_H));
    else if constexpr (ph == 32) { pg8::EpiBf16 E{(bf16*)(ws + FF_A), FF, nullptr, FF, (FF_G - FF_A) / 2}; run_gemm(F, (const bf16*)(ws + FF_H), (const bf16*)(ws + WS_WUP1), ML, 2 * FF, 1024, E); }
    else if constexpr (ph == 33) ph_dwconv(F, 1, ML, 0);
    else if constexpr (ph == 34) { pg8::EpiRes E{F.out, F.out, ctxx, ctxx, ML, mod + 5 * 6144 + 5120, 0, nullptr}; run_gemm(F, (const bf16*)(ws + FF_A), (const bf16*)(ws + WS_WDN1), ML, 1024, FF, E); }
    else ph_final(F);
}

template <int ph>
__device__ __forceinline__ void phase_step(int ph_lo, int ph_hi, unsigned char* lds_raw) {
    if (ph_lo <= ph && ph < ph_hi) {
        const __attribute__((address_space(4))) unsigned char* kp = (const __attribute__((address_space(4))) unsigned char*)__builtin_amdgcn_kernarg_segment_ptr();
        asm volatile("" : "+s"(kp));
        Fr F;
        { int t_ = threadIdx.x, g_ = gridDim.x, b_ = blockIdx.x; asm volatile("" : "+v"(t_), "+s"(g_), "+s"(b_)); F.tid = t_; F.G = g_; F.bid = b_; }
        F.lds = (LAS unsigned char*)lds_raw; F.lane = F.tid & 63; F.wave = __builtin_amdgcn_readfirstlane(F.tid >> 6);
        F.gw = F.bid * NWAVES + F.wave; F.ngw = F.G * NWAVES;
        F.in = (const __attribute__((address_space(4))) cfptr_t*)kp;
        typedef float* fptr_t; typedef unsigned char* ucptr_t;
        F.out = *(const __attribute__((address_space(4))) fptr_t*)(kp + 304); F.ws = *(const __attribute__((address_space(4))) ucptr_t*)(kp + 312);
        if (PROBE_MASK != 0ull && F.bid == 0 && F.tid == 0) ((unsigned long long*)(F.ws + WS_TS))[ph] = __builtin_amdgcn_s_memrealtime();
        run_phase<ph>(F);
        if (ph + 1 < ph_hi) {
            if (ph == 0) {
                if (F.bid == 0) for (int i = F.tid; i < XCD_BAR_WORDS; i += NTHR) __hip_atomic_store((unsigned*)(F.ws + WS_BAR) + i, 0u, __ATOMIC_RELAXED, __HIP_MEMORY_SCOPE_AGENT);
                __syncthreads(); cg::this_grid().sync();
                if (F.tid == 0) (void)xb_add((unsigned*)(F.ws + WS_BAR) + XB_XCNT(xb_xcc_id()), 1u);
            }
            else xcd_barrier((unsigned*)(F.ws + WS_BAR), (volatile LAS unsigned*)(F.lds + BAR_LDS_OFF));
        }
        if (PROBE_MASK != 0ull && ph == N_PHASES - 1 && F.bid == 0) {
            if (F.tid == 0) { unsigned long long* ts = (unsigned long long*)(F.ws + WS_TS); const unsigned long long tend = __builtin_amdgcn_s_memrealtime(); unsigned long long tot = 0ull;
                for (int k = 0; k < N_PHASES; ++k) if ((PROBE_MASK >> k) & 1ull) tot += (k + 1 < N_PHASES ? ts[k + 1] : tend) - ts[k];
                while (__builtin_amdgcn_s_memrealtime() - tend < tot) __builtin_amdgcn_s_sleep(8); }
            __syncthreads();
        }
    }
}
template <int... I>
__device__ __forceinline__ void all_phases(int ph_lo, int ph_hi, unsigned char* lds_raw, std::integer_sequence<int, I...>) { (phase_step<I>(ph_lo, ph_hi, lds_raw), ...); }

__global__ void __launch_bounds__(NTHR, 2) fwd_kernel(Args args) {
    extern __shared__ __attribute__((aligned(16))) unsigned char lds_raw[];
    int ph_lo, ph_hi;
    { const __attribute__((address_space(4))) unsigned char* kp0 = (const __attribute__((address_space(4))) unsigned char*)__builtin_amdgcn_kernarg_segment_ptr();
      ph_lo = *(const __attribute__((address_space(4))) int*)(kp0 + 320); ph_hi = *(const __attribute__((address_space(4))) int*)(kp0 + 324); }
    if (threadIdx.x < 16) ((LAS unsigned*)((LAS unsigned char*)lds_raw + BAR_LDS_OFF))[threadIdx.x] = 0u;
    __syncthreads();
    all_phases(ph_lo, ph_hi, lds_raw, std::make_integer_sequence<int, N_PHASES>{});
}

extern "C" void kernel_launch(void* const* d_in, const int* in_sizes, int n_in, void* d_out, int out_size, void* d_ws, size_t ws_size, hipStream_t stream) {
    static int grid = 0;
    if (grid == 0) {
        int dev = 0, cus = 0, per_cu = 0;
        hipGetDevice(&dev);
        hipDeviceGetAttribute(&cus, hipDeviceAttributeMultiprocessorCount, dev);
        hipFuncSetAttribute((const void*)fwd_kernel, hipFuncAttributeMaxDynamicSharedMemorySize, LDS_BYTES);
        hipOccupancyMaxActiveBlocksPerMultiprocessor(&per_cu, (const void*)fwd_kernel, NTHR, LDS_BYTES);
        if (per_cu < 1) { fprintf(stderr, "kernel_launch: occupancy query says %d blocks per CU\n", per_cu); per_cu = 1; }
        grid = cus < 256 ? cus : 256;
        if (n_in != 38 || ws_size < WS_END) fprintf(stderr, "kernel_launch: unexpected n_in %d / ws_size %zu (need %zu)\n", n_in, ws_size, (size_t)WS_END);
        (void)hipGetLastError();
    }
    (void)hipMemsetAsync(d_ws, 0, 128 * 1024, stream);
    Args a{};
    for (int i = 0; i < 38; ++i) a.in[i] = (const float*)d_in[i];
    a.out = (float*)d_out; a.ws = (unsigned char*)d_ws; a.ph_lo = 0; a.ph_hi = N_PHASES;
    void* kargs[] = {&a};
    hipError_t e = hipLaunchCooperativeKernel((const void*)fwd_kernel, dim3(grid), dim3(NTHR), kargs, LDS_BYTES, stream);
    if (e != hipSuccess) fprintf(stderr, "cooperative launch failed: %s (grid %d)\n", hipGetErrorString(e), grid);
}
```

```cpp
#include <hip/hip_runtime.h>
#include <hip/hip_cooperative_groups.h>
#include <cstdio>
#include <cstdint>
#include <cstddef>
#include <utility>
namespace cg = cooperative_groups;

#define LAS __attribute__((address_space(3)))
typedef unsigned short bf16;
typedef short bf16x8 __attribute__((ext_vector_type(8)));
typedef float f32x4 __attribute__((ext_vector_type(4)));
typedef float f32x2 __attribute__((ext_vector_type(2)));
typedef unsigned u32x4 __attribute__((ext_vector_type(4)));
typedef unsigned u32x2 __attribute__((ext_vector_type(2)));

namespace pg8 {
#define PG8_LAS __attribute__((address_space(3)))
typedef unsigned short bf16_t;
constexpr int BM = 256, BK = 64, HALF = 128, HTB = HALF * BK * 2, STAGE_BYTES = 8 * HTB, NXCD = 8, WGM = 8;
__host__ __device__ __forceinline__ int lds_byte(int r, int c) { const int st = (r >> 4) * 2 + (c >> 5), rr = r & 15, cc = c & 31, ob = rr * 64 + cc * 2; return st * 1024 + (ob ^ (((ob >> 9) & 1) << 5)); }
__host__ __device__ __forceinline__ void stage_rc(int b, int& R, int& C) { const int st = b / 1024, sb = b % 1024, swz = sb ^ (((sb >> 9) & 1) << 5); R = (st >> 1) * 16 + swz / 64; C = (st & 1) * 32 + (swz % 64) / 2; }
__host__ __device__ __forceinline__ int perm32(int rho) { const int n = rho >> 4, i = rho & 15; return 8 * (i >> 2) + 4 * n + (i & 3); }
struct Unit { int pm, pn; };
struct Gemm { const bf16_t* A; const bf16_t* Bt; int M, N, K; };
struct StaticOrder {
    int nM, nN, nwg, G, c;
    __host__ __device__ void init(int M, int N, int G_, int c_) { nM = M / BM; nN = N / BM; nwg = nM * nN; G = G_; c = c_; }
    __host__ __device__ bool next(int i, Unit& u) const {
        const long L = (long)i * G + c; if (L >= nwg) return false;
        int wgid = (int)L; { const int q = nwg / NXCD, r = nwg % NXCD, xcd = wgid % NXCD, off = wgid / NXCD; wgid = (xcd < r ? xcd * (q + 1) : r * (q + 1) + (xcd - r) * q) + off; }
        const int nig = WGM * nN, gid = wgid / nig, fm = gid * WGM, gsz = (nM - fm) < WGM ? (nM - fm) : WGM;
        u.pm = fm + ((wgid % nig) % gsz); u.pn = (wgid % nig) / gsz; return true;
    }
    __device__ __forceinline__ void a_ready(const Unit&) const {}
    __device__ __forceinline__ void done(const Unit&) const {}
};
__device__ __forceinline__ unsigned cvt_pk_bf16(float lo, float hi) { unsigned r; asm volatile("v_cvt_pk_bf16_f32 %0, %1, %2" : "=v"(r) : "v"(lo), "v"(hi)); return r; }

struct EpiBf16 {
    static constexpr bool PERM = true, AFTER_DRAIN = false;
    bf16_t* O; int ldc; const float* bias; int split_cols; size_t split_stride;
    __device__ __forceinline__ void operator()(const f32x4 (&acc)[2][2][4][2], const Unit& u, int wr, int wc, int fr, int fq) const {
        const int row0 = u.pm * BM + wr * 64 + fr; int colt = u.pn * BM; bf16_t* base = O;
        if (split_cols) { const int t = colt / split_cols; base += (size_t)t * split_stride; colt -= t * split_cols; }
        const int col0 = colt + wc * 32 + 8 * fq, bcol0 = u.pn * BM + wc * 32 + 8 * fq;
        f32x4 bv[2][2];
#pragma unroll
        for (int bj = 0; bj < 2; ++bj)
#pragma unroll
            for (int n = 0; n < 2; ++n) bv[bj][n] = bias ? *(const f32x4*)(bias + bcol0 + bj * HALF + 4 * n) : (f32x4){0.f, 0.f, 0.f, 0.f};
#pragma unroll
        for (int ai = 0; ai < 2; ++ai)
#pragma unroll
            for (int m = 0; m < 4; ++m) { bf16_t* rowp = base + (size_t)(row0 + ai * HALF + m * 16) * ldc + col0;
#pragma unroll
                for (int bj = 0; bj < 2; ++bj) { f32x4 v0 = acc[ai][bj][m][0] + bv[bj][0], v1 = acc[ai][bj][m][1] + bv[bj][1];
                    u32x4 w; w.x = cvt_pk_bf16(v0[0], v0[1]); w.y = cvt_pk_bf16(v0[2], v0[3]); w.z = cvt_pk_bf16(v1[0], v1[1]); w.w = cvt_pk_bf16(v1[2], v1[3]);
                    *(u32x4*)(rowp + bj * HALF) = w; } }
    }
};
struct EpiBf16T {
    static constexpr bool PERM = true, AFTER_DRAIN = false;
    bf16_t* O; int ntc;
    __device__ __forceinline__ void operator()(const f32x4 (&acc)[2][2][4][2], const Unit& u, int wr, int wc, int fr, int fq) const {
        bf16_t* base = O + (size_t)(fr + 16 * fq) * 8;
#pragma unroll
        for (int ai = 0; ai < 2; ++ai)
#pragma unroll
            for (int m = 0; m < 4; ++m)
#pragma unroll
                for (int bj = 0; bj < 2; ++bj) { const f32x4 v0 = acc[ai][bj][m][0], v1 = acc[ai][bj][m][1];
                    u32x4 w; w.x = cvt_pk_bf16(v0[0], v0[1]); w.y = cvt_pk_bf16(v0[2], v0[3]); w.z = cvt_pk_bf16(v1[0], v1[1]); w.w = cvt_pk_bf16(v1[2], v1[3]);
                    *(u32x4*)(base + ((size_t)(u.pm * 16 + ai * 8 + wr * 4 + m) * ntc + u.pn * 8 + bj * 4 + wc) * 512) = w; }
    }
};
struct EpiRes {
    static constexpr bool PERM = false, AFTER_DRAIN = false;
    const float* res_lat; float* out_lat; const float* res_ctx; float* out_ctx; int rows_lat; const float* gate; int b0; const float* bias;
    __device__ __forceinline__ void operator()(const f32x4 (&acc)[2][2][4][2], const Unit& u, int wr, int wc, int fr, int fq) const {
        const int trow = u.pm * BM; const float* res; float* out; int modrow;
        if (trow < rows_lat) { res = res_lat + (size_t)trow * 1024; out = out_lat + (size_t)trow * 1024; modrow = b0 + trow / 8192; }
        else { const int rc = trow - rows_lat; res = res_ctx + (size_t)rc * 1024; out = out_ctx + (size_t)rc * 1024; modrow = 4; }
        const int col0 = u.pn * BM + wc * 32 + 4 * fq; const float* gp = gate + (size_t)modrow * 6144 + col0;
#pragma unroll
        for (int bj = 0; bj < 2; ++bj) {
            f32x4 bv[2], gv[2];
#pragma unroll
            for (int n = 0; n < 2; ++n) { bv[n] = bias ? *(const f32x4*)(bias + col0 + bj * HALF + n * 16) : (f32x4){0.f, 0.f, 0.f, 0.f}; gv[n] = *(const f32x4*)(gp + bj * HALF + n * 16); }
#pragma unroll
            for (int ai = 0; ai < 2; ++ai) {
                f32x4 rs[4][2];
#pragma unroll
                for (int m = 0; m < 4; ++m)
#pragma unroll
                    for (int n = 0; n < 2; ++n) rs[m][n] = *(const f32x4*)(res + (size_t)(wr * 64 + fr + ai * HALF + m * 16) * 1024 + col0 + bj * HALF + n * 16);
#pragma unroll
                for (int m = 0; m < 4; ++m)
#pragma unroll
                    for (int n = 0; n < 2; ++n) *(f32x4*)(out + (size_t)(wr * 64 + fr + ai * HALF + m * 16) * 1024 + col0 + bj * HALF + n * 16) = rs[m][n] + gv[n] * (acc[ai][bj][m][n] + bv[n]);
                asm volatile("" ::: "memory");
            }
        }
    }
};

template <class Epi, class Sched, bool ALIGN_EPI = false, bool SP2 = false>
__device__ __forceinline__ void gemm_phase(PG8_LAS unsigned char* lds, const Gemm g, const Sched& S, const Epi& E, const int tid) {
    const int wid = __builtin_amdgcn_readfirstlane(tid >> 6), lane = tid & 63, wr = wid >> 2, wc = wid & 3, fr = lane & 15, fq = lane >> 4;
    const int K = g.K, nt = K / BK;
    unsigned voffA[2], voffB[2];
#pragma unroll
    for (int i = 0; i < 2; ++i) { int R, C; stage_rc(tid * 16 + i * 8192, R, C); const int Rb = Epi::PERM ? ((R & ~31) + perm32(R & 31)) : R;
        voffA[i] = (unsigned)(R * K + C) * 2u; voffB[i] = (unsigned)(Rb * K + C) * 2u; }
    const size_t kstep = (size_t)(BK * 2);
    const size_t hstep = (size_t)HALF * K * 2;
    const size_t tstep = 2 * hstep;
    const unsigned ldsw = (unsigned)wid * 1024u;
    const int aoff = lds_byte(wr * 64 + fr, fq * 8), boff = lds_byte(wc * 32 + fr, fq * 8);
#define PG8_SA(b, h) (((b) * 2 + (h)) * HTB)
#define PG8_SB(b, h) ((4 + (b) * 2 + (h)) * HTB)
#define PG8_STAGE(bufoff, gbase, voff) do { _Pragma("unroll") for (int _i = 0; _i < 2; ++_i) \
        __builtin_amdgcn_global_load_lds((const unsigned*)((const char*)(gbase) + (voff)[_i]), (PG8_LAS unsigned*)(lds + (bufoff) + ldsw + _i * 8192), 16, 0, 0); } while (0)
#define PG8_LDA(dst, b, h) do { _Pragma("unroll") for (int m = 0; m < 4; ++m) _Pragma("unroll") for (int k = 0; k < 2; ++k) dst[m][k] = *(const PG8_LAS bf16x8*)(lds + PG8_SA(b, h) + aoff + m * 2048 + k * 1024); } while (0)
#define PG8_LDB(dst, b, h) do { _Pragma("unroll") for (int n = 0; n < 2; ++n) _Pragma("unroll") for (int k = 0; k < 2; ++k) dst[n][k] = *(const PG8_LAS bf16x8*)(lds + PG8_SB(b, h) + boff + n * 2048 + k * 1024); } while (0)
#define PG8_MMA(ai, bj, At, Bt) do { __builtin_amdgcn_s_setprio(1); _Pragma("unroll") for (int m = 0; m < 4; ++m) _Pragma("unroll") for (int n = 0; n < 2; ++n) _Pragma("unroll") for (int k = 0; k < 2; ++k) \
        acc[ai][bj][m][n] = __builtin_amdgcn_mfma_f32_16x16x32_bf16(Bt[n][k], At[m][k], acc[ai][bj][m][n], 0, 0, 0); __builtin_amdgcn_s_setprio(0); } while (0)
#define PG8_WAIT_V(n) asm volatile("s_waitcnt vmcnt(" #n ")" ::: "memory")
#define PG8_WAIT_L(n) asm volatile("s_waitcnt lgkmcnt(" #n ")" ::: "memory")
#define PG8_BAR __builtin_amdgcn_s_barrier()
#define PG8_SCHED __builtin_amdgcn_sched_barrier(0)
    Unit cur, nxt; int ui = 0;
    if (!S.next(0, cur)) return;
    f32x4 acc[2][2][4][2];
#pragma unroll
    for (int a = 0; a < 2; ++a)
#pragma unroll
        for (int b = 0; b < 2; ++b)
#pragma unroll
            for (int m = 0; m < 4; ++m)
#pragma unroll
                for (int n = 0; n < 2; ++n) acc[a][b][m][n] = (f32x4){0.f, 0.f, 0.f, 0.f};
    bf16x8 At[4][2], B0[2][2], B1[2][2];
    const char* cA = (const char*)g.A + (size_t)cur.pm * tstep; const char* cB = (const char*)g.Bt + (size_t)cur.pn * tstep;
    S.a_ready(cur);
    if constexpr (SP2) {
        PG8_STAGE(PG8_SB(0, 0), cB, voffB); PG8_STAGE(PG8_SB(0, 1), cB + hstep, voffB); PG8_STAGE(PG8_SA(0, 0), cA, voffA); PG8_STAGE(PG8_SA(0, 1), cA + hstep, voffA);
        if (wr == 1) PG8_BAR;
        PG8_WAIT_V(2); PG8_BAR;
        PG8_STAGE(PG8_SB(1, 0), cB + kstep, voffB); PG8_STAGE(PG8_SA(1, 0), cA + kstep, voffA); PG8_STAGE(PG8_SB(1, 1), cB + hstep + kstep, voffB);
        PG8_WAIT_V(6); PG8_BAR;
    } else {
        PG8_STAGE(PG8_SB(0, 0), cB, voffB); PG8_STAGE(PG8_SA(0, 0), cA, voffA); PG8_STAGE(PG8_SB(0, 1), cB + hstep, voffB); PG8_STAGE(PG8_SA(0, 1), cA + hstep, voffA);
        if (wr == 1) PG8_BAR;
        PG8_WAIT_V(4); PG8_BAR;
        PG8_STAGE(PG8_SB(1, 0), cB + kstep, voffB); PG8_STAGE(PG8_SA(1, 0), cA + kstep, voffA); PG8_STAGE(PG8_SB(1, 1), cB + hstep + kstep, voffB);
        PG8_WAIT_V(6); PG8_BAR;
    }
    for (;;) {
        const bool has_next = S.next(ui + 1, nxt);
        const char* nA = has_next ? (const char*)g.A + (size_t)nxt.pm * tstep : cA; const char* nB = has_next ? (const char*)g.Bt + (size_t)nxt.pn * tstep : cB;
        for (int t = 0; t < nt; t += 2) {
            const bool last = (t == nt - 2);
            const char* a1 = cA + (size_t)(t + 1) * kstep;
            const char* a2 = last ? nA : cA + (size_t)(t + 2) * kstep; const char* b2 = last ? nB : cB + (size_t)(t + 2) * kstep;
            const char* a3 = a2 + kstep; const char* b3 = b2 + kstep;
            if (last && has_next) S.a_ready(nxt);
            if constexpr (SP2) {
            PG8_LDB(B0, 0, 0); PG8_LDB(B1, 0, 1); PG8_SCHED; PG8_LDA(At, 0, 0); PG8_STAGE(PG8_SA(1, 1), a1 + hstep, voffA);
            PG8_WAIT_V(8); PG8_WAIT_L(0); PG8_BAR; PG8_MMA(0, 0, At, B0); PG8_MMA(0, 1, At, B1); PG8_BAR; PG8_SCHED;
            PG8_LDA(At, 0, 1); PG8_STAGE(PG8_SB(0, 0), b2, voffB); PG8_STAGE(PG8_SB(0, 1), b2 + hstep, voffB); PG8_STAGE(PG8_SA(0, 0), a2, voffA);
            PG8_WAIT_V(8); PG8_WAIT_L(0); PG8_BAR; PG8_MMA(1, 0, At, B0); PG8_MMA(1, 1, At, B1); PG8_BAR; PG8_SCHED;
            PG8_LDB(B0, 1, 0); PG8_LDB(B1, 1, 1); PG8_SCHED; PG8_LDA(At, 1, 0); PG8_STAGE(PG8_SA(0, 1), a2 + hstep, voffA);
            PG8_WAIT_V(8); PG8_WAIT_L(0); PG8_BAR; PG8_MMA(0, 0, At, B0); PG8_MMA(0, 1, At, B1); PG8_BAR; PG8_SCHED;
            PG8_LDA(At, 1, 1); PG8_STAGE(PG8_SB(1, 0), b3, voffB); PG8_STAGE(PG8_SB(1, 1), b3 + hstep, voffB); PG8_STAGE(PG8_SA(1, 0), a3, voffA);
            PG8_WAIT_V(8); PG8_WAIT_L(0); PG8_BAR; PG8_MMA(1, 0, At, B0); PG8_MMA(1, 1, At, B1); PG8_BAR; PG8_SCHED;
            } else {
            PG8_LDB(B0, 0, 0); PG8_SCHED; PG8_LDA(At, 0, 0); PG8_STAGE(PG8_SA(1, 1), a1 + hstep, voffA);
            PG8_WAIT_L(8); PG8_BAR; PG8_WAIT_L(0); PG8_MMA(0, 0, At, B0); PG8_BAR; PG8_SCHED;
            PG8_LDB(B1, 0, 1); PG8_STAGE(PG8_SB(0, 0), b2, voffB);
            PG8_BAR; PG8_WAIT_L(0); PG8_MMA(0, 1, At, B1); PG8_BAR;
            PG8_LDA(At, 0, 1); PG8_STAGE(PG8_SA(0, 0), a2, voffA);
            PG8_BAR; PG8_WAIT_L(0); PG8_MMA(1, 0, At, B0); PG8_BAR; PG8_SCHED;
            PG8_STAGE(PG8_SB(0, 1), b2 + hstep, voffB);
            PG8_WAIT_V(6); PG8_BAR; PG8_MMA(1, 1, At, B1); PG8_BAR;
            PG8_LDB(B0, 1, 0); PG8_SCHED; PG8_LDA(At, 1, 0); PG8_STAGE(PG8_SA(0, 1), a2 + hstep, voffA);
            PG8_WAIT_L(8); PG8_BAR; PG8_WAIT_L(0); PG8_MMA(0, 0, At, B0); PG8_BAR; PG8_SCHED;
            PG8_LDB(B1, 1, 1); PG8_STAGE(PG8_SB(1, 0), b3, voffB);
            PG8_BAR; PG8_WAIT_L(0); PG8_MMA(0, 1, At, B1); PG8_BAR;
            PG8_LDA(At, 1, 1); PG8_STAGE(PG8_SA(1, 0), a3, voffA);
            PG8_BAR; PG8_WAIT_L(0); PG8_MMA(1, 0, At, B0); PG8_BAR; PG8_SCHED;
            PG8_STAGE(PG8_SB(1, 1), b3 + hstep, voffB);
            PG8_WAIT_V(6); PG8_BAR; PG8_MMA(1, 1, At, B1); PG8_BAR;
            }
        }
        if constexpr (ALIGN_EPI) { if (wr == 0) PG8_BAR; }
        if constexpr (!Epi::AFTER_DRAIN) { E(acc, cur, wr, wc, fr, fq); S.done(cur); }
        if (!has_next) break;
#pragma unroll
        for (int a = 0; a < 2; ++a)
#pragma unroll
            for (int b = 0; b < 2; ++b)
#pragma unroll
                for (int m = 0; m < 4; ++m)
#pragma unroll
                    for (int n = 0; n < 2; ++n) acc[a][b][m][n] = (f32x4){0.f, 0.f, 0.f, 0.f};
        cur = nxt; cA = nA; cB = nB; ++ui;
        if constexpr (ALIGN_EPI) { if (wr == 1) PG8_BAR; }
    }
    PG8_WAIT_V(0);
    if constexpr (!ALIGN_EPI) { if (wr == 0) PG8_BAR; }
    PG8_BAR;
#undef PG8_SA
#undef PG8_SB
#undef PG8_STAGE
#undef PG8_LDA
#undef PG8_LDB
#undef PG8_MMA
#undef PG8_WAIT_V
#undef PG8_WAIT_L
#undef PG8_BAR
#undef PG8_SCHED
}
}

constexpr int D = 1024, NB = 4, SEQ = 8192, CTXL = 256, ML = NB * SEQ, MC = NB * CTXL, MALL = ML + MC;
constexpr int FF = 2816, MI = 2048, NH = 4, DH = 512, HROWS = 2 * SEQ;
constexpr float EPS = 1e-6f, ML_NORM_EPS = 1e-5f;
constexpr float HY_MAX_DECAY = -15.350567286626973f, HY_MIN_DECAY = -3.0701134573253945f;
constexpr int NWAVES = 8, NTHR = 512;
constexpr int LDS_BYTES = 147456;

constexpr size_t MiB = 1u << 20;
constexpr size_t WS_MOD = 1 * MiB;
constexpr size_t WS_CTXX = 2 * MiB;
constexpr size_t WS_H3 = 6 * MiB;
constexpr size_t WS_KTC = 9 * MiB;
constexpr size_t WS_GWT = 11 * MiB;
constexpr size_t WS_WKQ = 11 * MiB + 256 * 1024;
constexpr size_t WS_NC = 12 * MiB;
constexpr size_t WS_WHIN = 16 * MiB, WS_WHOUT = 22 * MiB, WS_WMIN = 24 * MiB, WS_WMDN = 32 * MiB, WS_WUP0 = 36 * MiB, WS_WUP1 = 47 * MiB, WS_WDN0 = 58 * MiB, WS_WDN1 = 58 * MiB + 5767168;
constexpr size_t WS_GATES_L = 69 * MiB;
constexpr size_t WS_GATES_C = 70 * MiB;
constexpr size_t WS_GT_L = 71 * MiB;
constexpr size_t WS_GT_C = 73 * MiB;
constexpr size_t WS_GC = 73 * MiB + 512 * 1024;
constexpr size_t WS_DN = 74 * MiB;
constexpr size_t WS_RS = 79 * MiB;
constexpr size_t WS_INV = 79 * MiB + 512 * 1024;
constexpr size_t BIG = 80 * MiB;
constexpr size_t HY_H = BIG, HY_P = BIG + 66 * MiB, HY_KT = BIG + 264 * MiB, HY_ZT = BIG + 328 * MiB, HY_ZTC = BIG + 392 * MiB, HY_KS = BIG + 394 * MiB;
constexpr size_t FF_H = BIG, FF_A = BIG + 66 * MiB, FF_G = BIG + 248 * MiB;
constexpr size_t MS_H = BIG, MS_XM = BIG + 32 * MiB, MS_XC = BIG + 96 * MiB, MS_KT = BIG + 160 * MiB, MS_VT = BIG + 224 * MiB, MS_NF = BIG + 288 * MiB, MS_NB = BIG + 352 * MiB,
                 MS_KTC = BIG + 416 * MiB, MS_VTC = BIG + 420 * MiB;
constexpr size_t MS_S = MS_XM, MS_Z = MS_KT, MS_KN = MS_NF, MS_XCC = MS_NB, MS_XMC = MS_NB + 4 * MiB, MS_HC = MS_NB + 8 * MiB;
constexpr size_t WS_END = BIG + 424 * MiB;
static_assert(WS_END <= 512 * MiB, "workspace map");
static_assert(FF_G + (size_t)MALL * FF * 2 <= 512 * MiB && FF_A + (size_t)MALL * FF * 2 <= FF_G, "ffn map");
static_assert(HY_P + (size_t)MALL * 3072 * 2 <= HY_KT && HY_ZTC + (size_t)NB * D * CTXL * 2 <= HY_KS && HY_KS + 32 * MiB <= 512 * MiB, "hyena map");

__device__ __forceinline__ unsigned f2bf(float f) { unsigned u = __float_as_uint(f); return (u + 0x7fffu + ((u >> 16) & 1u)) >> 16; }
typedef __bf16 bf16x2_t __attribute__((ext_vector_type(2)));
__device__ __forceinline__ unsigned pk2(float lo, float hi) { const f32x2 v = {lo, hi}; const bf16x2_t b = __builtin_convertvector(v, bf16x2_t); return __builtin_bit_cast(unsigned, b); }
__device__ __forceinline__ float bf2f(unsigned short b) { return __uint_as_float(((unsigned)b) << 16); }
__device__ __forceinline__ float bflo(unsigned w) { return __uint_as_float(w << 16); }
__device__ __forceinline__ float bfhi(unsigned w) { return __uint_as_float(w & 0xffff0000u); }
__device__ __forceinline__ void unpack8(const u32x4 v, float (&o)[8]) { o[0] = bflo(v.x); o[1] = bfhi(v.x); o[2] = bflo(v.y); o[3] = bfhi(v.y); o[4] = bflo(v.z); o[5] = bfhi(v.z); o[6] = bflo(v.w); o[7] = bfhi(v.w); }
__device__ __forceinline__ u32x4 pack8(const float (&o)[8]) { u32x4 v; v.x = pk2(o[0], o[1]); v.y = pk2(o[2], o[3]); v.z = pk2(o[4], o[5]); v.w = pk2(o[6], o[7]); return v; }
__device__ __forceinline__ float wave_sum(float v) {
#pragma unroll
    for (int o = 1; o < 64; o <<= 1) v += __shfl_xor(v, o);
    return v;
}
__device__ __forceinline__ float silu_f(float x) { return x / (1.0f + __expf(-x)); }

typedef const float* cfptr_t;
struct Fr {
    LAS unsigned char* lds; int tid, lane, wave, gw, ngw, G, bid;
    const __attribute__((address_space(4))) cfptr_t* in; float* out; unsigned char* ws;
};
#define IN(i) (F.in[i])
enum { I_X = 0, I_C, I_CTX, I_CCTX, I_MODW, I_MODB, I_NORMG, I_FINALG, I_HWIN, I_HBIN, I_HSCW, I_HSCB, I_FW1, I_FB1, I_FW2, I_FB2, I_FW3, I_FB3, I_FWOUT, I_FREQ, I_HBIAS, I_HWOUT, I_HBOUT,
       I_MWIN, I_MCW, I_MCB, I_MWQ, I_MWK, I_MWV, I_MWG, I_MBG, I_MNW, I_MSKIP, I_MWDN, I_FWUP, I_FCW, I_FCB, I_FWDN };

__device__ __forceinline__ void transpose_item(const float* W, int K, int N, bf16* WT, LAS float* scr, int item, int lane) {
    const int nblk = N / 32, kb = item / nblk, nb = item % nblk, k0 = 64 * kb, n0 = 32 * nb;
    float tv[32];
#pragma unroll
    for (int i = 0; i < 32; ++i) tv[i] = W[(size_t)(k0 + 2 * i + (lane >> 5)) * N + n0 + (lane & 31)];
#pragma unroll
    for (int i = 0; i < 32; ++i) scr[(2 * i + (lane >> 5)) * 33 + (lane & 31)] = tv[i];
    asm volatile("s_waitcnt lgkmcnt(0)" ::: "memory");
    const int c = lane & 7;
#pragma unroll
    for (int j = 0; j < 4; ++j) { const int n = (lane >> 3) + 8 * j; const LAS float* s = scr + (8 * c) * 33 + n;
        u32x4 o; o.x = pk2(s[0 * 33], s[1 * 33]); o.y = pk2(s[2 * 33], s[3 * 33]); o.z = pk2(s[4 * 33], s[5 * 33]); o.w = pk2(s[6 * 33], s[7 * 33]);
        *(u32x4*)(WT + (size_t)(n0 + n) * K + k0 + 8 * c) = o; }
    asm volatile("s_waitcnt lgkmcnt(0)" ::: "memory");
}
__device__ __forceinline__ void transpose_matrix(Fr& F, const float* W, int K, int N, bf16* WT) {
    LAS float* scr = (LAS float*)(F.lds + F.wave * 16384);
    const int nitems = (K / 64) * (N / 32);
    for (int it = F.gw; it < nitems; it += F.ngw) transpose_item(W, K, N, WT, scr, it, F.lane);
}

__device__ __forceinline__ void ph_prologue(Fr& F) {
    unsigned char* ws = F.ws;
    {
        LAS float* scr = (LAS float*)(F.lds + F.wave * 16384);
        constexpr int I0 = (D / 64) * (3 * D / 32), I1 = (D / 64) * (D / 32), I2 = (D / 64) * (2 * MI / 32), I3 = (MI / 64) * (D / 32), I4 = (D / 64) * (2 * FF / 32), I5 = (FF / 64) * (D / 32);
        constexpr int NIT = I0 + I1 + I2 + I3 + 2 * I4 + 2 * I5;
        for (int it = F.gw; it < NIT; it += F.ngw) {
            int r = it;
            if (r < I0) { transpose_item(IN(I_HWIN), D, 3 * D, (bf16*)(ws + WS_WHIN), scr, r, F.lane); continue; } r -= I0;
            if (r < I1) { transpose_item(IN(I_HWOUT), D, D, (bf16*)(ws + WS_WHOUT), scr, r, F.lane); continue; } r -= I1;
            if (r < I2) { transpose_item(IN(I_MWIN), D, 2 * MI, (bf16*)(ws + WS_WMIN), scr, r, F.lane); continue; } r -= I2;
            if (r < I3) { transpose_item(IN(I_MWDN), MI, D, (bf16*)(ws + WS_WMDN), scr, r, F.lane); continue; } r -= I3;
            if (r < I4) { transpose_item(IN(I_FWUP), D, 2 * FF, (bf16*)(ws + WS_WUP0), scr, r, F.lane); continue; } r -= I4;
            if (r < I4) { transpose_item(IN(I_FWUP) + (size_t)D * 2 * FF, D, 2 * FF, (bf16*)(ws + WS_WUP1), scr, r, F.lane); continue; } r -= I4;
            if (r < I5) { transpose_item(IN(I_FWDN), FF, D, (bf16*)(ws + WS_WDN0), scr, r, F.lane); continue; } r -= I5;
            transpose_item(IN(I_FWDN) + (size_t)FF * D, FF, D, (bf16*)(ws + WS_WDN1), scr, r, F.lane);
        }
    }
    __syncthreads();
    {
        LAS float* sc = (LAS float*)F.lds;
        LAS float* red = (LAS float*)(F.lds + 32768);
        for (int i = F.tid; i < 5 * 1024; i += NTHR) { const int r = i >> 10, k = i & 1023; const float v = r < 4 ? IN(I_C)[r * 1024 + k] : IN(I_CCTX)[k]; sc[i] = silu_f(v); }
        __syncthreads();
        float* mod = (float*)(ws + WS_MOD);
        for (int it = F.bid; it < 192; it += F.G) {
            const int l = it / 96, n0 = (it % 96) * 64;
            const float* w = IN(I_MODW) + (size_t)l * 1024 * 6144 + n0 + F.lane;
            float a0 = 0.f, a1 = 0.f, a2 = 0.f, a3 = 0.f, a4 = 0.f;
            const int kb = F.wave * 128;
#pragma unroll 16
            for (int k = 0; k < 128; ++k) { const float wv = w[(size_t)(kb + k) * 6144];
                a0 += sc[kb + k] * wv; a1 += sc[1024 + kb + k] * wv; a2 += sc[2048 + kb + k] * wv; a3 += sc[3072 + kb + k] * wv; a4 += sc[4096 + kb + k] * wv; }
            red[(F.wave * 5 + 0) * 64 + F.lane] = a0; red[(F.wave * 5 + 1) * 64 + F.lane] = a1; red[(F.wave * 5 + 2) * 64 + F.lane] = a2; red[(F.wave * 5 + 3) * 64 + F.lane] = a3; red[(F.wave * 5 + 4) * 64 + F.lane] = a4;
            __syncthreads();
            if (F.tid < 320) { const int r = F.tid >> 6, ln = F.tid & 63; float s = 0.f;
#pragma unroll
                for (int w8 = 0; w8 < 8; ++w8) s += red[(w8 * 5 + r) * 64 + ln];
                mod[((size_t)l * 5 + r) * 6144 + n0 + ln] = s + IN(I_MODB)[l * 6144 + n0 + ln]; }
            __syncthreads();
        }
    }
    {
        float* h3 = (float*)(ws + WS_H3);
        const float* w1 = IN(I_FW1); const float* w2 = IN(I_FW2); const float* w3 = IN(I_FW3);
        const float fr = IN(I_FREQ)[F.lane], b1 = IN(I_FB1)[F.lane], b2 = IN(I_FB2)[F.lane], b3 = IN(I_FB3)[F.lane];
        for (int row = F.gw; row < SEQ + CTXL; row += F.ngw) {
            const int L = row < SEQ ? SEQ : CTXL, i = row < SEQ ? row : row - SEQ;
            const float tl = (float)i / (float)(L - 1), w = 6.283185307179586f * (float)i / (float)L;
            float pos = 0.f; const int k = F.lane;
            if (k == 0) pos = tl;
            else if (k <= 16) { const float band = 1e-4f + (float)(k - 1) * ((15.0f - 1e-4f) / 15.0f); pos = cosf(band * w); }
            else if (k <= 32) { const float band = 1e-4f + (float)(k - 17) * ((15.0f - 1e-4f) / 15.0f); pos = -sinf(band * w); }
            float s = b1;
#pragma unroll
            for (int kk = 0; kk < 33; ++kk) s += __shfl(pos, kk) * w1[kk * 64 + F.lane];
            float h = sinf(fr * s);
            s = b2;
#pragma unroll 16
            for (int kk = 0; kk < 64; ++kk) s += __shfl(h, kk) * w2[kk * 64 + F.lane];
            h = sinf(fr * s);
            s = b3;
#pragma unroll 16
            for (int kk = 0; kk < 64; ++kk) s += __shfl(h, kk) * w3[kk * 64 + F.lane];
            h = sinf(fr * s);
            h3[(size_t)row * 64 + F.lane] = h;
        }
    }
    {
        bf16* gwt = (bf16*)(ws + WS_GWT); float* wkq = (float*)(ws + WS_WKQ);
        const float* wq = IN(I_MWQ); const float* wk = IN(I_MWK); const float* wv = IN(I_MWV); const float* wg = IN(I_MWG);
        const int gt = F.bid * NTHR + F.tid, nt = F.G * NTHR;
        for (int i = gt; i < MI * 16; i += nt) { const int ch = i >> 4, g = i & 15, n = ch >> 2, c = ch & 3; float sa = 0.f, sb = 0.f;
#pragma unroll
            for (int e = 0; e < 4; ++e) { sa += wq[n * 16 + c * 4 + e] * wg[(size_t)(n * 4 + e) * 16 + g] + wk[n * 16 + c * 4 + e] * wg[(size_t)(MI + n * 4 + e) * 16 + g];
                sb += wv[n * 16 + c * 4 + e] * wg[(size_t)(2 * MI + n * 4 + e) * 16 + g]; }
            const size_t go = ((size_t)(ch >> 5) * 64 + g + 16 * ((ch & 31) >> 3)) * 8 + (ch & 7);
            gwt[go] = (bf16)f2bf(sa); gwt[go + 64 * 512] = (bf16)f2bf(sb); }
        const float sc = 0.044194173824159216f;
        for (int i = gt; i < 512 * 16; i += nt) { const int n = i >> 4, c = (i >> 2) & 3, c2 = i & 3; float s = 0.f;
#pragma unroll
            for (int e = 0; e < 4; ++e) s += wk[n * 16 + c * 4 + e] * wq[n * 16 + c2 * 4 + e];
            wkq[i] = s * sc; }
    }
}

__device__ __forceinline__ void kt_items(Fr& F, const float* h3rows, int L, float* KT) {
    const float* wout = IN(I_FWOUT);
    const int nitems = (L / 16) * 32, fr = F.lane & 15, fq = F.lane >> 4;
    for (int it = F.gw; it < nitems; it += F.ngw) {
        const int t0 = (it >> 5) * 16, n0 = (it & 31) * 64;
        float a[16];
#pragma unroll
        for (int ks = 0; ks < 16; ++ks) a[ks] = h3rows[(size_t)(t0 + fr) * 64 + 4 * ks + fq];
#pragma unroll
        for (int nt = 0; nt < 4; ++nt) {
            f32x4 acc = (f32x4){0.f, 0.f, 0.f, 0.f};
#pragma unroll
            for (int ks = 0; ks < 16; ++ks) acc = __builtin_amdgcn_mfma_f32_16x16x4f32(a[ks], wout[(size_t)(4 * ks + fq) * 2048 + n0 + nt * 16 + fr], acc, 0, 0, 0);
            const int n = n0 + nt * 16 + fr, dirn = n >> 10, c = n & 1023;
            const float delta = fabsf(HY_MIN_DECAY + (float)c * ((HY_MAX_DECAY - HY_MIN_DECAY) / 1023.0f)), il = 1.0f / (float)(L - 1);
            f32x4 o;
#pragma unroll
            for (int r = 0; r < 4; ++r) o[r] = acc[r] * __expf(-(float)(t0 + 4 * fq + r) * il * delta);
            *(f32x4*)(KT + ((size_t)c * 2 + dirn) * L + t0 + 4 * fq) = o;
        }
    }
}

__device__ __forceinline__ void modnorm_row(const float* xrow, const float* g, const float* sh, const float* sc, bf16* orow, int lane) {
    const f32x4* xr = (const f32x4*)xrow + lane; f32x4 v[4]; float s = 0.f;
#pragma unroll
    for (int j = 0; j < 4; ++j) { v[j] = xr[64 * j]; s += (v[j][0] * v[j][0] + v[j][1] * v[j][1]) + (v[j][2] * v[j][2] + v[j][3] * v[j][3]); }
    const float rinv = 1.0f / sqrtf(wave_sum(s) * (1.0f / 1024.0f) + EPS);
    u32x2* o8 = (u32x2*)orow + lane;
#pragma unroll
    for (int j = 0; j < 4; ++j) { const int c = 4 * lane + 256 * j; const f32x4 gg = *(const f32x4*)(g + c), s1 = *(const f32x4*)(sc + c), s0 = *(const f32x4*)(sh + c);
        const f32x4 y = (v[j] * rinv * gg) * (1.0f + s1) + s0; u32x2 w; w.x = pk2(y[0], y[1]); w.y = pk2(y[2], y[3]); o8[64 * j] = w; }
}
__device__ __forceinline__ void ph_modnorm(Fr& F, const float* xlat, int nlat, int b0, const float* xctx, int nctx, const float* g, const float* modl, int shoff, bf16* H) {
    const int nrows = nlat + nctx;
    for (int r = F.gw; r < nrows; r += 2 * F.ngw) {
        const int r2 = r + F.ngw; const bool has2 = r2 < nrows; const int rb = has2 ? r2 : r;
        const bool isl = r < nlat, isl2 = rb < nlat;
        const float* xa = isl ? xlat + (size_t)r * 1024 : xctx + (size_t)(r - nlat) * 1024; const float* xb = isl2 ? xlat + (size_t)rb * 1024 : xctx + (size_t)(rb - nlat) * 1024;
        const int ma = isl ? b0 + r / SEQ : 4, mb = isl2 ? b0 + rb / SEQ : 4;
        const f32x4* pa = (const f32x4*)xa + F.lane; const f32x4* pb = (const f32x4*)xb + F.lane; f32x4 va[4], vb[4]; float sa = 0.f, sb = 0.f;
#pragma unroll
        for (int j = 0; j < 4; ++j) { va[j] = pa[64 * j]; vb[j] = pb[64 * j]; }
#pragma unroll
        for (int j = 0; j < 4; ++j) { sa += (va[j][0] * va[j][0] + va[j][1] * va[j][1]) + (va[j][2] * va[j][2] + va[j][3] * va[j][3]); sb += (vb[j][0] * vb[j][0] + vb[j][1] * vb[j][1]) + (vb[j][2] * vb[j][2] + vb[j][3] * vb[j][3]); }
        const float ra = 1.0f / sqrtf(wave_sum(sa) * (1.0f / 1024.0f) + EPS), rbv = 1.0f / sqrtf(wave_sum(sb) * (1.0f / 1024.0f) + EPS);
        const float* sha = modl + (size_t)ma * 6144 + shoff; const float* shb = modl + (size_t)mb * 6144 + shoff;
        u32x2* oa = (u32x2*)(H + (size_t)r * 1024) + F.lane; u32x2* ob = (u32x2*)(H + (size_t)rb * 1024) + F.lane;
#pragma unroll
        for (int j = 0; j < 4; ++j) { const int c = 4 * F.lane + 256 * j; const f32x4 gg = *(const f32x4*)(g + c);
            const f32x4 ya = (va[j] * ra * gg) * (1.0f + *(const f32x4*)(sha + 1024 + c)) + *(const f32x4*)(sha + c);
            const f32x4 yb = (vb[j] * rbv * gg) * (1.0f + *(const f32x4*)(shb + 1024 + c)) + *(const f32x4*)(shb + c);
            oa[64 * j] = (u32x2){pk2(ya[0], ya[1]), pk2(ya[2], ya[3])};
            if (has2) ob[64 * j] = (u32x2){pk2(yb[0], yb[1]), pk2(yb[2], yb[3])}; }
    }
}

__device__ __forceinline__ void zt_items(Fr& F, const bf16* P, int rowbase, int nb, int Ls, bf16* ZT) {
    LAS unsigned char* tile = F.lds + F.wave * 16384;
    const float* scw = IN(I_HSCW); const float* scb = IN(I_HSCB);
    const int ntt = Ls / 64, nitems = nb * ntt * 16, tl = F.lane >> 3, c8 = F.lane & 7;
    for (int it = F.gw; it < nitems; it += F.ngw) {
        const int ct = it & 15, tt = (it >> 4) % ntt, b = (it >> 4) / ntt, t0 = tt * 64, ch = ct * 64 + c8 * 8;
        float w1[3][8], w2[3][8], b1[8], b2[8];
#pragma unroll
        for (int k = 0; k < 3; ++k) { const f32x4 a0 = *(const f32x4*)(scw + k * 3072 + 1024 + ch), a1 = *(const f32x4*)(scw + k * 3072 + 1024 + ch + 4), d0 = *(const f32x4*)(scw + k * 3072 + 2048 + ch), d1 = *(const f32x4*)(scw + k * 3072 + 2048 + ch + 4);
#pragma unroll
            for (int e = 0; e < 4; ++e) { w1[k][e] = a0[e]; w1[k][4 + e] = a1[e]; w2[k][e] = d0[e]; w2[k][4 + e] = d1[e]; } }
        { const f32x4 a0 = *(const f32x4*)(scb + 1024 + ch), a1 = *(const f32x4*)(scb + 1024 + ch + 4), d0 = *(const f32x4*)(scb + 2048 + ch), d1 = *(const f32x4*)(scb + 2048 + ch + 4);
#pragma unroll
            for (int e = 0; e < 4; ++e) { b1[e] = a0[e]; b1[4 + e] = a1[e]; b2[e] = d0[e]; b2[4 + e] = d1[e]; } }
        const bf16* pb = P + (size_t)(rowbase + b * Ls) * 3072 + ch;
#pragma unroll 2
        for (int i8 = 0; i8 < 8; ++i8) {
            const int tloc = i8 * 8 + tl, t = t0 + tloc, tm = t > 0 ? t - 1 : t, tp = t + 1 < Ls ? t + 1 : t; const float mm = t > 0 ? 1.f : 0.f, mp = t + 1 < Ls ? 1.f : 0.f;
            const u32x4 r1m = *(const u32x4*)(pb + (size_t)tm * 3072 + 1024), r1c = *(const u32x4*)(pb + (size_t)t * 3072 + 1024), r1p = *(const u32x4*)(pb + (size_t)tp * 3072 + 1024);
            const u32x4 r2m = *(const u32x4*)(pb + (size_t)tm * 3072 + 2048), r2c = *(const u32x4*)(pb + (size_t)t * 3072 + 2048), r2p = *(const u32x4*)(pb + (size_t)tp * 3072 + 2048);
            float xm[8], xc[8], xp[8], vm[8], vc[8], vp[8];
            unpack8(r1m, xm); unpack8(r1c, xc); unpack8(r1p, xp); unpack8(r2m, vm); unpack8(r2c, vc); unpack8(r2p, vp);
#pragma unroll
            for (int e = 0; e < 8; ++e) { const float a = w1[0][e] * (xm[e] * mm) + w1[1][e] * xc[e] + w1[2][e] * (xp[e] * mp) + b1[e], d = w2[0][e] * (vm[e] * mm) + w2[1][e] * vc[e] + w2[2][e] * (vp[e] * mp) + b2[e];
                *(LAS bf16*)(tile + (c8 * 8 + e) * 136 + tloc * 2) = (bf16)f2bf(a * d); }
        }
#pragma unroll
        for (int q = 0; q < 8; ++q) { const int cc = q * 8 + (F.lane >> 3), chk = F.lane & 7;
            const u32x2 lo = *(const LAS u32x2*)(tile + cc * 136 + chk * 16), hi = *(const LAS u32x2*)(tile + cc * 136 + chk * 16 + 8);
            u32x4 o; o.x = lo.x; o.y = lo.y; o.z = hi.x; o.w = hi.y;
            *(u32x4*)(ZT + ((size_t)b * 1024 + ct * 64 + cc) * Ls + t0 + chk * 8) = o; }
    }
}

__device__ __forceinline__ f32x2 cmul(f32x2 a, f32x2 b) { return (f32x2){a.x * b.x - a.y * b.y, a.x * b.y + a.y * b.x}; }
__device__ __forceinline__ f32x2 cmulc(f32x2 a, f32x2 b) { return (f32x2){a.x * b.x + a.y * b.y, a.y * b.x - a.x * b.y}; }
__device__ __forceinline__ f32x2 twid(float f) { return (f32x2){__builtin_amdgcn_cosf(f), __builtin_amdgcn_sinf(f)}; }
#define PH(e) ((e) + ((e) >> 4))
__device__ __forceinline__ void fft_fwd(LAS f32x2* buf, int tid, int plo, int phi) {
#pragma unroll 1
    for (int p = plo; p < phi; ++p) {
        const int lq = 12 - 2 * p, q = 1 << lq; const float invN = 1.0f / (float)(4 * q);
#pragma unroll 2
        for (int m = 0; m < 8; ++m) {
            const int g = tid + 512 * m, i = g & (q - 1), i0 = ((g >> lq) << (lq + 2)) + i;
            const int e0 = PH(i0), e1 = PH(i0 + q), e2 = PH(i0 + 2 * q), e3 = PH(i0 + 3 * q);
            const f32x2 a0 = buf[e0], a1 = buf[e1], a2 = buf[e2], a3 = buf[e3];
            const f32x2 t0 = a0 + a2, t1 = a0 - a2, t2 = a1 + a3, d = a1 - a3, t3 = (f32x2){d.y, -d.x};
            const f32x2 w1 = twid(-(float)i * invN), w2 = cmul(w1, w1), w3 = cmul(w2, w1);
            buf[e0] = t0 + t2; buf[e1] = cmul(t1 + t3, w1); buf[e2] = cmul(t0 - t2, w2); buf[e3] = cmul(t1 - t3, w3);
        }
        __syncthreads();
    }
}
__device__ __forceinline__ void fft_inv(LAS f32x2* buf, int tid, int plo, int phi) {
#pragma unroll 1
    for (int p = phi - 1; p >= plo; --p) {
        const int lq = 12 - 2 * p, q = 1 << lq; const float invN = 1.0f / (float)(4 * q);
#pragma unroll 2
        for (int m = 0; m < 8; ++m) {
            const int g = tid + 512 * m, i = g & (q - 1), i0 = ((g >> lq) << (lq + 2)) + i;
            const int e0 = PH(i0), e1 = PH(i0 + q), e2 = PH(i0 + 2 * q), e3 = PH(i0 + 3 * q);
            const f32x2 w1 = twid((float)i * invN), w2 = cmul(w1, w1), w3 = cmul(w2, w1);
            const f32x2 b0 = buf[e0], b1 = cmul(buf[e1], w1), b2 = cmul(buf[e2], w2), b3 = cmul(buf[e3], w3);
            const f32x2 t0 = b0 + b2, t1 = b0 - b2, t2 = b1 + b3, d = b1 - b3, t3 = (f32x2){-d.y, d.x};
            buf[e0] = t0 + t2; buf[e1] = t1 + t3; buf[e2] = t0 - t2; buf[e3] = t1 - t3;
        }
        __syncthreads();
    }
}
__device__ __forceinline__ void fwd16_A(f32x2 (&x)[16]) {
    const float C1 = 0.92387953251128674f, S1 = 0.38268343236508977f, R2 = 0.70710678118654752f;
#pragma unroll
    for (int i = 0; i < 4; ++i) {
        const f32x2 a0 = x[i], a1 = x[i + 4], a2 = x[i + 8], a3 = x[i + 12];
        const f32x2 t0 = a0 + a2, t1 = a0 - a2, t2 = a1 + a3, d = a1 - a3, t3 = (f32x2){d.y, -d.x};
        const f32x2 y1 = t1 + t3, y2 = t0 - t2, y3 = t1 - t3;
        x[i] = t0 + t2;
        if (i == 0) { x[4] = y1; x[8] = y2; x[12] = y3; }
        else if (i == 1) { x[5] = cmul(y1, (f32x2){C1, -S1}); x[9] = cmul(y2, (f32x2){R2, -R2}); x[13] = cmul(y3, (f32x2){S1, -C1}); }
        else if (i == 2) { x[6] = cmul(y1, (f32x2){R2, -R2}); x[10] = (f32x2){y2.y, -y2.x}; x[14] = cmul(y3, (f32x2){-R2, -R2}); }
        else { x[7] = cmul(y1, (f32x2){S1, -C1}); x[11] = cmul(y2, (f32x2){-R2, -R2}); x[15] = cmul(y3, (f32x2){-C1, S1}); }
    }
}
__device__ __forceinline__ void fwd16_B(f32x2 (&x)[16]) {
#pragma unroll
    for (int g = 0; g < 4; ++g) {
        const f32x2 a0 = x[4 * g], a1 = x[4 * g + 1], a2 = x[4 * g + 2], a3 = x[4 * g + 3];
        const f32x2 t0 = a0 + a2, t1 = a0 - a2, t2 = a1 + a3, d = a1 - a3, t3 = (f32x2){d.y, -d.x};
        x[4 * g] = t0 + t2; x[4 * g + 1] = t1 + t3; x[4 * g + 2] = t0 - t2; x[4 * g + 3] = t1 - t3;
    }
}
__device__ __forceinline__ void inv16_B(f32x2 (&x)[16]) {
#pragma unroll
    for (int g = 0; g < 4; ++g) {
        const f32x2 b0 = x[4 * g], b1 = x[4 * g + 1], b2 = x[4 * g + 2], b3 = x[4 * g + 3];
        const f32x2 t0 = b0 + b2, t1 = b0 - b2, t2 = b1 + b3, d = b1 - b3, t3 = (f32x2){-d.y, d.x};
        x[4 * g] = t0 + t2; x[4 * g + 1] = t1 + t3; x[4 * g + 2] = t0 - t2; x[4 * g + 3] = t1 - t3;
    }
}
__device__ __forceinline__ void inv16_A(f32x2 (&x)[16]) {
    const float C1 = 0.92387953251128674f, S1 = 0.38268343236508977f, R2 = 0.70710678118654752f;
#pragma unroll
    for (int i = 0; i < 4; ++i) {
        f32x2 b0 = x[i], b1 = x[i + 4], b2 = x[i + 8], b3 = x[i + 12];
        if (i == 1) { b1 = cmul(b1, (f32x2){C1, S1}); b2 = cmul(b2, (f32x2){R2, R2}); b3 = cmul(b3, (f32x2){S1, C1}); }
        else if (i == 2) { b1 = cmul(b1, (f32x2){R2, R2}); b2 = (f32x2){-b2.y, b2.x}; b3 = cmul(b3, (f32x2){-R2, R2}); }
        else if (i == 3) { b1 = cmul(b1, (f32x2){S1, C1}); b2 = cmul(b2, (f32x2){-R2, R2}); b3 = cmul(b3, (f32x2){-C1, -S1}); }
        const f32x2 t0 = b0 + b2, t1 = b0 - b2, t2 = b1 + b3, d = b1 - b3, t3 = (f32x2){-d.y, d.x};
        x[i] = t0 + t2; x[i + 4] = t1 + t3; x[i + 8] = t0 - t2; x[i + 12] = t1 - t3;
    }
}
__device__ __forceinline__ void fwd16(f32x2 (&x)[16]) { fwd16_A(x); fwd16_B(x); }
__device__ __forceinline__ void inv16(f32x2 (&x)[16]) { inv16_B(x); inv16_A(x); }
__device__ __forceinline__ void r16_fwd2(LAS f32x2* buf, int tid) {
#pragma unroll 1
  for (int lqp = 8; lqp >= 4; lqp -= 4) {
    const int qp = 1 << lqp; const float inv = 1.0f / (float)(16 * qp);
#pragma unroll
    for (int m = 0; m < 2; ++m) {
        const int g = tid + 512 * m, i = g & (qp - 1), e0 = ((g >> lqp) << (lqp + 4)) + i; f32x2 x[16];
#pragma unroll
        for (int j = 0; j < 16; ++j) x[j] = buf[PH(e0 + (j << lqp))];
        const f32x2 w1 = twid(-(float)i * inv), w2 = cmul(w1, w1), w3 = cmul(w2, w1), v1 = cmul(w2, w2), v2 = cmul(v1, v1), v3 = cmul(v2, v1);
        fwd16_A(x);
#pragma unroll
        for (int l = 0; l < 4; ++l) { x[l + 4] = cmul(x[l + 4], w1); x[l + 8] = cmul(x[l + 8], w2); x[l + 12] = cmul(x[l + 12], w3); }
        fwd16_B(x);
#pragma unroll
        for (int k = 0; k < 4; ++k) { x[4 * k + 1] = cmul(x[4 * k + 1], v1); x[4 * k + 2] = cmul(x[4 * k + 2], v2); x[4 * k + 3] = cmul(x[4 * k + 3], v3); }
#pragma unroll
        for (int j = 0; j < 16; ++j) buf[PH(e0 + (j << lqp))] = x[j];
    }
    __syncthreads();
  }
}
__device__ __forceinline__ void r16_inv2(LAS f32x2* buf, int tid) {
#pragma unroll 1
  for (int lqp = 4; lqp <= 8; lqp += 4) {
    const int qp = 1 << lqp; const float inv = 1.0f / (float)(16 * qp);
#pragma unroll
    for (int m = 0; m < 2; ++m) {
        const int g = tid + 512 * m, i = g & (qp - 1), e0 = ((g >> lqp) << (lqp + 4)) + i; f32x2 x[16];
#pragma unroll
        for (int j = 0; j < 16; ++j) x[j] = buf[PH(e0 + (j << lqp))];
        const f32x2 w1 = twid((float)i * inv), w2 = cmul(w1, w1), w3 = cmul(w2, w1), v1 = cmul(w2, w2), v2 = cmul(v1, v1), v3 = cmul(v2, v1);
#pragma unroll
        for (int k = 0; k < 4; ++k) { x[4 * k + 1] = cmul(x[4 * k + 1], v1); x[4 * k + 2] = cmul(x[4 * k + 2], v2); x[4 * k + 3] = cmul(x[4 * k + 3], v3); }
        inv16_B(x);
#pragma unroll
        for (int l = 0; l < 4; ++l) { x[l + 4] = cmul(x[l + 4], w1); x[l + 8] = cmul(x[l + 8], w2); x[l + 12] = cmul(x[l + 12], w3); }
        inv16_A(x);
#pragma unroll
        for (int j = 0; j < 16; ++j) buf[PH(e0 + (j << lqp))] = x[j];
    }
    __syncthreads();
  }
}
__device__ __forceinline__ float block_sum(Fr& F, float v, LAS float* red) {
    v = wave_sum(v);
    __syncthreads();
    if (F.lane == 0) red[F.wave] = v;
    __syncthreads();
    float s = 0.f;
#pragma unroll
    for (int w = 0; w < 8; ++w) s += red[w];
    return s;
}
__device__ __forceinline__ void ph_fftconv(Fr& F) {
    LAS f32x2* buf = (LAS f32x2*)F.lds; LAS float* red = (LAS float*)(F.lds + 139392);
    const float* KT = (const float*)(F.ws + HY_KT); const float* KTC = (const float*)(F.ws + WS_KTC);
    bf16* ZT = (bf16*)(F.ws + HY_ZT); bf16* ZTC = (bf16*)(F.ws + HY_ZTC);
    const int tid = F.tid;
    for (int c = F.bid; c < 1024; c += F.G) {
        const float bias = IN(I_HBIAS)[c];
        __syncthreads();
        float asum = 0.f;
        const f32x4* kf = (const f32x4*)(KT + (size_t)c * 2 * SEQ); const f32x4* kb = kf + SEQ / 4;
#pragma unroll
        for (int q = 0; q < 4; ++q) { const int i4 = tid + 512 * q; const f32x4 v = kf[i4];
            asum += fabsf(v[0]) + fabsf(v[1]) + fabsf(v[2]) + fabsf(v[3]);
            buf[PH(4 * i4)] = (f32x2){v[0], 0.f}; buf[PH(4 * i4 + 1)] = (f32x2){v[1], 0.f}; buf[PH(4 * i4 + 2)] = (f32x2){v[2], 0.f}; buf[PH(4 * i4 + 3)] = (f32x2){v[3], 0.f};
            const f32x4 u = kb[i4]; const int m = 4 * i4;
            if (m > 0) { buf[PH(16384 - m)] = (f32x2){u[0], 0.f}; asum += fabsf(u[0]); } else buf[PH(8192)] = (f32x2){0.f, 0.f};
            buf[PH(16384 - m - 1)] = (f32x2){u[1], 0.f}; buf[PH(16384 - m - 2)] = (f32x2){u[2], 0.f}; buf[PH(16384 - m - 3)] = (f32x2){u[3], 0.f};
            asum += fabsf(u[1]) + fabsf(u[2]) + fabsf(u[3]); }
        const float S = block_sum(F, asum, red);
        __syncthreads();
        fft_fwd(buf, tid, 0, 1); r16_fwd2(buf, tid);
        f32x4* Ks = (f32x4*)(F.ws + HY_KS) + (size_t)(F.bid & 255) * 8192 + tid * 8; const float ksc = 1.0f / (S * 16384.0f);
#pragma unroll 1
        for (int m = 0; m < 2; ++m) { const int pb = 17 * (tid + 512 * m); f32x2 x[16];
#pragma unroll
            for (int n = 0; n < 16; ++n) x[n] = buf[pb + n];
            fwd16(x);
#pragma unroll
            for (int n = 0; n < 8; ++n) Ks[m * 4096 + n] = (f32x4){x[2 * n].x * ksc, x[2 * n].y * ksc, x[2 * n + 1].x * ksc, x[2 * n + 1].y * ksc}; }
        const f32x2 dl = twid(-1.0f / 16384.0f);
#pragma unroll 1
        for (int pr = 0; pr < 2; ++pr) {
            bf16* z0 = ZT + ((size_t)(2 * pr) * 1024 + c) * SEQ; bf16* z1 = ZT + ((size_t)(2 * pr + 1) * 1024 + c) * SEQ;
            const int i8 = tid * 8;
            __syncthreads();
            {
                float a[8], b[8], cx[8], dx[8];
                unpack8(*(const u32x4*)(z0 + i8), a); unpack8(*(const u32x4*)(z1 + i8), b); unpack8(*(const u32x4*)(z0 + 4096 + i8), cx); unpack8(*(const u32x4*)(z1 + 4096 + i8), dx);
                f32x2 w1 = twid(-(float)i8 * (1.0f / 16384.0f));
#pragma unroll
                for (int e = 0; e < 8; ++e) { const f32x2 a0 = (f32x2){a[e], b[e]}, a1 = (f32x2){cx[e], dx[e]}, t3 = (f32x2){a1.y, -a1.x}; const f32x2 w2 = cmul(w1, w1), w3 = cmul(w2, w1);
                    buf[PH(i8 + e)] = a0 + a1; buf[PH(4096 + i8 + e)] = cmul(a0 + t3, w1); buf[PH(8192 + i8 + e)] = cmul(a0 - a1, w2); buf[PH(12288 + i8 + e)] = cmul(a0 - t3, w3);
                    w1 = cmul(w1, dl); }
            }
            __syncthreads();
            r16_fwd2(buf, tid);
#pragma unroll 1
            for (int m = 0; m < 2; ++m) { const int pb = 17 * (tid + 512 * m); f32x2 x[16];
#pragma unroll
                for (int n = 0; n < 16; ++n) x[n] = buf[pb + n];
                fwd16(x);
#pragma unroll
                for (int n = 0; n < 8; ++n) { const f32x4 k = Ks[m * 4096 + n]; x[2 * n] = cmul(x[2 * n], (f32x2){k[0], k[1]}); x[2 * n + 1] = cmul(x[2 * n + 1], (f32x2){k[2], k[3]}); }
                inv16(x);
#pragma unroll
                for (int n = 0; n < 16; ++n) buf[pb + n] = x[n]; }
            __syncthreads();
            r16_inv2(buf, tid);
            {
                float a[8], b[8], cx[8], dx[8];
                unpack8(*(const u32x4*)(z0 + i8), a); unpack8(*(const u32x4*)(z1 + i8), b); unpack8(*(const u32x4*)(z0 + 4096 + i8), cx); unpack8(*(const u32x4*)(z1 + 4096 + i8), dx);
                f32x2 w1 = twid(-(float)i8 * (1.0f / 16384.0f));
#pragma unroll
                for (int e = 0; e < 8; ++e) { const f32x2 w2 = cmul(w1, w1), w3 = cmul(w2, w1);
                    const f32x2 b0 = buf[PH(i8 + e)], b1 = cmulc(buf[PH(4096 + i8 + e)], w1), b2 = cmulc(buf[PH(8192 + i8 + e)], w2), b3 = cmulc(buf[PH(12288 + i8 + e)], w3);
                    const f32x2 t0 = b0 + b2, t1 = b0 - b2, t2 = b1 + b3, d = b1 - b3, t3 = (f32x2){-d.y, d.x};
                    const f32x2 y0 = t0 + t2, y1 = t1 + t3;
                    a[e] = y0.x + a[e] * bias; b[e] = y0.y + b[e] * bias; cx[e] = y1.x + cx[e] * bias; dx[e] = y1.y + dx[e] * bias;
                    w1 = cmul(w1, dl); }
                *(u32x4*)(z0 + i8) = pack8(a); *(u32x4*)(z1 + i8) = pack8(b); *(u32x4*)(z0 + 4096 + i8) = pack8(cx); *(u32x4*)(z1 + 4096 + i8) = pack8(dx);
            }
        }
        __syncthreads();
        {
            LAS float* kc = (LAS float*)F.lds; LAS float* zc = kc + 512;
            const float* kfc = KTC + (size_t)c * 2 * CTXL; float v = 0.f;
            { const int n = tid; if (n < 256) v = kfc[n]; else if (n == 256) v = 0.f; else v = kfc[CTXL + (512 - n)]; kc[n] = v; }
            const float Sc = block_sum(F, fabsf(v), red);
            for (int i = tid; i < 1024; i += NTHR) { const int b = i >> 8, t = i & 255; zc[i] = bf2f(ZTC[((size_t)b * 1024 + c) * CTXL + t]); }
            __syncthreads();
            const int b = tid >> 7, t2 = tid & 127; const float isc = 1.0f / Sc;
#pragma unroll
            for (int hh = 0; hh < 2; ++hh) { const int t = t2 + 128 * hh; float acc = 0.f;
#pragma unroll 8
                for (int s = 0; s < 256; ++s) acc += zc[b * 256 + s] * kc[(t - s) & 511];
                ZTC[((size_t)b * 1024 + c) * CTXL + t] = (bf16)f2bf(acc * isc + zc[b * 256 + t] * bias); }
        }
    }
}

__device__ __forceinline__ void u2_items(Fr& F, const bf16* P, int rowbase, int nb, int Ls, const bf16* YT, bf16* U2) {
    LAS unsigned char* tile = F.lds + F.wave * 16384;
    const float* scw = IN(I_HSCW); const float* scb = IN(I_HSCB);
    const int ntt = Ls / 64, nitems = nb * ntt * 16, tl = F.lane >> 3, c8 = F.lane & 7;
    for (int it = F.gw; it < nitems; it += F.ngw) {
        const int ct = it & 15, tt = (it >> 4) % ntt, b = (it >> 4) / ntt, t0 = tt * 64, ch = ct * 64 + c8 * 8;
#pragma unroll
        for (int q = 0; q < 8; ++q) { const int cc = q * 8 + (F.lane >> 3), chk = F.lane & 7;
            const u32x4 v = *(const u32x4*)(YT + ((size_t)b * 1024 + ct * 64 + cc) * Ls + t0 + chk * 8);
            *(LAS u32x2*)(tile + cc * 136 + chk * 16) = (u32x2){v.x, v.y}; *(LAS u32x2*)(tile + cc * 136 + chk * 16 + 8) = (u32x2){v.z, v.w}; }
        float w0[3][8], bb[8];
#pragma unroll
        for (int k = 0; k < 3; ++k) { const f32x4 a0 = *(const f32x4*)(scw + k * 3072 + ch), a1 = *(const f32x4*)(scw + k * 3072 + ch + 4);
#pragma unroll
            for (int e = 0; e < 4; ++e) { w0[k][e] = a0[e]; w0[k][4 + e] = a1[e]; } }
        { const f32x4 a0 = *(const f32x4*)(scb + ch), a1 = *(const f32x4*)(scb + ch + 4);
#pragma unroll
            for (int e = 0; e < 4; ++e) { bb[e] = a0[e]; bb[4 + e] = a1[e]; } }
        const bf16* pb = P + (size_t)(rowbase + b * Ls) * 3072 + ch; bf16* ub = U2 + (size_t)(rowbase + b * Ls) * 1024 + ch;
#pragma unroll 2
        for (int i8 = 0; i8 < 8; ++i8) {
            const int tloc = i8 * 8 + tl, t = t0 + tloc, tm = t > 0 ? t - 1 : t, tp = t + 1 < Ls ? t + 1 : t; const float mm = t > 0 ? 1.f : 0.f, mp = t + 1 < Ls ? 1.f : 0.f;
            const u32x4 rm = *(const u32x4*)(pb + (size_t)tm * 3072), rc = *(const u32x4*)(pb + (size_t)t * 3072), rp = *(const u32x4*)(pb + (size_t)tp * 3072);
            float xm[8], xc[8], xp[8], o[8];
            unpack8(rm, xm); unpack8(rc, xc); unpack8(rp, xp);
#pragma unroll
            for (int e = 0; e < 8; ++e) { const float x0 = w0[0][e] * (xm[e] * mm) + w0[1][e] * xc[e] + w0[2][e] * (xp[e] * mp) + bb[e]; o[e] = x0 * bf2f(*(const LAS bf16*)(tile + (c8 * 8 + e) * 136 + tloc * 2)); }
            *(u32x4*)(ub + (size_t)t * 1024) = pack8(o);
        }
    }
}

__device__ __forceinline__ void dw_item(const bf16* G, bf16* A, const float* cw, const float* cb, int f8, int rowtok0, int nx, int x0, bool up_ok, bool down_ok) {
    float w[9][8], bias[8];
#pragma unroll
    for (int k = 0; k < 9; ++k) { const float m = (k < 3) ? (up_ok ? 1.f : 0.f) : ((k >= 6) ? (down_ok ? 1.f : 0.f) : 1.f);
        const f32x4 w0 = *(const f32x4*)(cw + (size_t)k * FF + f8) * m, w1 = *(const f32x4*)(cw + (size_t)k * FF + f8 + 4) * m;
        w[k][0] = w0[0]; w[k][1] = w0[1]; w[k][2] = w0[2]; w[k][3] = w0[3]; w[k][4] = w1[0]; w[k][5] = w1[1]; w[k][6] = w1[2]; w[k][7] = w1[3]; }
    { const f32x4 b0 = *(const f32x4*)(cb + f8), b1 = *(const f32x4*)(cb + f8 + 4); bias[0] = b0[0]; bias[1] = b0[1]; bias[2] = b0[2]; bias[3] = b0[3]; bias[4] = b1[0]; bias[5] = b1[1]; bias[6] = b1[2]; bias[7] = b1[3]; }
    const int upo = up_ok ? -nx : 0, dno = down_ok ? nx : 0;
    const bf16* g0 = G + (size_t)rowtok0 * FF + f8; bf16* a0 = A + (size_t)rowtok0 * FF + f8;
    const u32x4 zero4 = (u32x4){0u, 0u, 0u, 0u};
    u32x4 cm[3], cc[3], cp[3];
    { const int xm = x0 > 0 ? x0 - 1 : 0; const bool okm = x0 > 0;
        cm[0] = *(const u32x4*)(g0 + (size_t)(xm + upo) * FF); cm[1] = *(const u32x4*)(g0 + (size_t)xm * FF); cm[2] = *(const u32x4*)(g0 + (size_t)(xm + dno) * FF);
        if (!okm) { cm[0] = zero4; cm[1] = zero4; cm[2] = zero4; }
        cc[0] = *(const u32x4*)(g0 + (size_t)(x0 + upo) * FF); cc[1] = *(const u32x4*)(g0 + (size_t)x0 * FF); cc[2] = *(const u32x4*)(g0 + (size_t)(x0 + dno) * FF); }
#pragma unroll 4
    for (int j = 0; j < 32; ++j) {
        const int x = x0 + j, xp = x + 1 < nx ? x + 1 : nx - 1; const bool okp = x + 1 < nx;
        cp[0] = *(const u32x4*)(g0 + (size_t)(xp + upo) * FF); cp[1] = *(const u32x4*)(g0 + (size_t)xp * FF); cp[2] = *(const u32x4*)(g0 + (size_t)(xp + dno) * FF);
        const u32x4 av = *(const u32x4*)(a0 + (size_t)x * FF);
        if (!okp) { cp[0] = zero4; cp[1] = zero4; cp[2] = zero4; }
        float acc[8];
#pragma unroll
        for (int e = 0; e < 8; ++e) acc[e] = bias[e];
#pragma unroll
        for (int dy = 0; dy < 3; ++dy) { float v[8];
            unpack8(cm[dy], v);
#pragma unroll
            for (int e = 0; e < 8; ++e) acc[e] += v[e] * w[dy * 3 + 0][e];
            unpack8(cc[dy], v);
#pragma unroll
            for (int e = 0; e < 8; ++e) acc[e] += v[e] * w[dy * 3 + 1][e];
            unpack8(cp[dy], v);
#pragma unroll
            for (int e = 0; e < 8; ++e) acc[e] += v[e] * w[dy * 3 + 2][e]; }
        float a[8]; unpack8(av, a);
#pragma unroll
        for (int e = 0; e < 8; ++e) a[e] = silu_f(acc[e]) * a[e];
        *(u32x4*)(a0 + (size_t)x * FF) = pack8(a);
#pragma unroll
        for (int dy = 0; dy < 3; ++dy) { cm[dy] = cc[dy]; cc[dy] = cp[dy]; }
    }
}
__device__ __forceinline__ void ph_dwconv(Fr& F, int layer, int nlat, int nctx) {
    bf16* A = (bf16*)(F.ws + FF_A); const bf16* G = (const bf16*)(F.ws + FF_G);
    const float* cw = IN(I_FCW) + (size_t)layer * 9 * FF; const float* cb = IN(I_FCB) + (size_t)layer * FF;
    const int ngrp = (F.G % 8 == 0) ? 8 : 1, xg = F.bid % ngrp, lb = F.bid / ngrp, nlb = F.G / ngrp;
    const int nseg = nlat / 32, band = nseg / ngrp;
    for (int i = lb * NTHR + F.tid; i < band * 352; i += nlb * NTHR) {
        const int sl = i / 352, f8 = (i - sl * 352) * 8, seg = xg * band + sl, grow = seg >> 1, gy = grow & 127;
        dw_item(G, A, cw, cb, f8, grow * 64, 64, (seg & 1) * 32, gy > 0, gy < 127);
    }
    const int nsegc = nctx / 32;
    for (int i = F.bid * NTHR + F.tid; i < nsegc * 352; i += F.G * NTHR) {
        const int sl = i / 352, f8 = (i - sl * 352) * 8;
        dw_item(G, A, cw, cb, f8, nlat + (sl >> 3) * CTXL, CTXL, (sl & 7) * 32, false, false);
    }
}

__device__ __forceinline__ void prep_items(Fr& F, const bf16* XM, int nb, int Ls, bf16* XC, bf16* KN, bf16* KT, bf16* VT) {
    LAS unsigned char* tk = F.lds + F.wave * 17408; LAS unsigned char* tv = tk + 8704;
    const int ntt = Ls / 64, nitems = nb * ntt * 32;
    const int tl = F.lane >> 3, c8 = F.lane & 7;
    for (int it = F.gw; it < nitems; it += F.ngw) {
        const int cg = it & 31, tt = (it >> 5) % ntt, b = (it >> 5) / ntt, t0 = tt * 64, ch0 = cg * 64 + c8 * 8, h = cg >> 3;
        float cw0[8], cw1[8], cw2[8], cbb[8], wkq[32], wv[32];
        { const float* p = IN(I_MCW) + ch0; const float* pb = IN(I_MCB) + ch0;
#pragma unroll
            for (int e = 0; e < 8; ++e) { cw0[e] = p[e]; cw1[e] = p[MI + e]; cw2[e] = p[2 * MI + e]; cbb[e] = pb[e]; }
            const float* q = (const float*)(F.ws + WS_WKQ) + (ch0 >> 2) * 16; const float* v = IN(I_MWV) + (ch0 >> 2) * 16;
#pragma unroll
            for (int e = 0; e < 32; ++e) { wkq[e] = q[e]; wv[e] = v[e]; } }
#pragma unroll 2
        for (int i8 = 0; i8 < 8; ++i8) {
            const int tloc = i8 * 8 + tl, t = t0 + tloc; const size_t row = (size_t)b * Ls + t;
            float xp[8], xm[8], xn[8];
            const size_t rowp = row - (t > 0 ? 1 : 0), rown = row + (t + 1 < Ls ? 1 : 0); const size_t ctile = (size_t)(ch0 >> 5) * 512 + ((ch0 & 31) >> 3) * 128;
            const u32x4 rm = *(const u32x4*)(XM + (row >> 4) * 32768 + ctile + (row & 15) * 8), rp = *(const u32x4*)(XM + (rowp >> 4) * 32768 + ctile + (rowp & 15) * 8), rn = *(const u32x4*)(XM + (rown >> 4) * 32768 + ctile + (rown & 15) * 8);
            unpack8(rm, xm); unpack8(rp, xp); unpack8(rn, xn);
            { const float mp = t > 0 ? 1.f : 0.f, mn = t + 1 < Ls ? 1.f : 0.f;
#pragma unroll
                for (int e = 0; e < 8; ++e) { xp[e] *= mp; xn[e] *= mn; } }
            float xc[8], kp[8], vv[8];
#pragma unroll
            for (int e = 0; e < 8; ++e) xc[e] = silu_f(cw0[e] * xp[e] + cw1[e] * xm[e] + cw2[e] * xn[e] + cbb[e]);
#pragma unroll
            for (int n = 0; n < 2; ++n)
#pragma unroll
                for (int o = 0; o < 4; ++o) { float sk = 0.f, sv = 0.f;
#pragma unroll
                    for (int c = 0; c < 4; ++c) { sk += xc[n * 4 + c] * wkq[n * 16 + c * 4 + o]; sv += xm[n * 4 + c] * wv[n * 16 + c * 4 + o]; }
                    kp[n * 4 + o] = sk; vv[n * 4 + o] = sv; }
            { const size_t to = ((size_t)(row >> 4) * 64 + (ch0 >> 5)) * 512 + (((unsigned)row & 15u) + 16u * ((ch0 & 31) >> 3)) * 8u;
              *(u32x4*)(XC + to) = pack8(xc); *(u32x4*)(KN + to) = pack8(kp); }
#pragma unroll
            for (int e = 0; e < 8; ++e) { *(LAS bf16*)(tk + (c8 * 8 + e) * 136 + tloc * 2) = (bf16)f2bf(kp[e]); *(LAS bf16*)(tv + (c8 * 8 + e) * 136 + tloc * 2) = (bf16)f2bf(vv[e]); }
        }
#pragma unroll
        for (int q = 0; q < 8; ++q) { const int dt = q >> 1, kq = q & 1, r = F.lane & 15, q4 = F.lane >> 4;
            const size_t tile = ((size_t)(t0 >> 7) * 32 + (cg & 7) * 4 + dt) * 4 + ((t0 & 127) >> 5) + kq;
            const size_t o = (size_t)(b * 4 + h) * 512 * Ls + tile * 512 + F.lane * 8;
            { const u32x2 lo = *(const LAS u32x2*)(tk + (dt * 16 + r) * 136 + kq * 64 + q4 * 16), hi = *(const LAS u32x2*)(tk + (dt * 16 + r) * 136 + kq * 64 + q4 * 16 + 8); *(u32x4*)(KT + o) = (u32x4){lo.x, lo.y, hi.x, hi.y}; }
            { const u32x2 lo = *(const LAS u32x2*)(tv + (dt * 16 + r) * 136 + kq * 64 + q4 * 16), hi = *(const LAS u32x2*)(tv + (dt * 16 + r) * 136 + kq * 64 + q4 * 16 + 8); *(u32x4*)(VT + o) = (u32x4){lo.x, lo.y, hi.x, hi.y}; }
        }
    }
}

__device__ __forceinline__ void gate_items(Fr& F, const bf16* XC, const bf16* XM, int R, float* GATES) {
    const bf16* gwt = (const bf16*)(F.ws + WS_GWT);
    const int fr = F.lane & 15, fq = F.lane >> 4, half = F.wave & 1, pr = F.wave >> 1, ntiles = R / 16;
    LAS f32x4* xch = (LAS f32x4*)(F.lds + pr * 1024);
    for (int base = F.bid * 4; base < ntiles; base += F.G * 4) {
        const int tile = base + pr; const bool ok = tile < ntiles; const int tl = ok ? tile : 0;
        f32x4 acc = (f32x4){0.f, 0.f, 0.f, 0.f};
        const bf16* ap = (half ? XM : XC) + (size_t)tl * 32768 + F.lane * 8; const bf16* bp = gwt + (size_t)half * 64 * 512 + F.lane * 8;
#pragma unroll 16
        for (int ks = 0; ks < 64; ++ks) acc = __builtin_amdgcn_mfma_f32_16x16x32_bf16(*(const bf16x8*)(ap + ks * 512), *(const bf16x8*)(bp + ks * 512), acc, 0, 0, 0);
        __syncthreads();
        if (half) xch[F.lane] = acc;
        __syncthreads();
        if (!half && ok) { acc = acc + xch[F.lane];
            const int r0 = tile * 16; const float bg = IN(I_MBG)[fr]; const bool isf = (fr >> 2) & 1;
#pragma unroll
            for (int r = 0; r < 4; ++r) { float x = acc[r] + bg; if (isf) x = fminf(x, 0.f) - log1pf(__expf(-fabsf(x))); GATES[(size_t)(r0 + 4 * fq + r) * 16 + fr] = x; } }
    }
}

__device__ __forceinline__ void cum_items(Fr& F, const float* GATES, int nb, int Ls, int gb0, int ctau0, f32x4* GT, float* GC) {
    const int R = nb * Ls, nch = Ls / 128, nitems = 2 * nb * 4 * nch;
    for (int it = F.gw; it < nitems; it += F.ngw) {
        const int c = it % nch, h = (it / nch) & 3, b = (it / nch / 4) % nb, dir = it / nch / 4 / nb;
        const int row0 = b * Ls + c * 128 + 2 * F.lane;
        const float lf0 = GATES[(size_t)row0 * 16 + dir * 8 + 4 + h], lf1 = GATES[(size_t)(row0 + 1) * 16 + dir * 8 + 4 + h];
        const float ig0 = GATES[(size_t)row0 * 16 + dir * 8 + h], ig1 = GATES[(size_t)(row0 + 1) * 16 + dir * 8 + h];
        float inc = lf0 + lf1;
#pragma unroll
        for (int o = 1; o < 64; o <<= 1) { const float t = __shfl_up(inc, o); if (F.lane >= o) inc += t; }
        const float tot = __shfl(inc, 63), exc = inc - (lf0 + lf1);
        float b0, b1;
        if (dir == 0) { b0 = exc + lf0; b1 = inc; } else { b0 = tot - exc; b1 = tot - exc - lf0; }
        GT[(size_t)(dir * 4 + h) * R + row0] = (f32x4){b0, ig0 - b0, __expf(b0), __expf(tot - b0 + ig0)};
        GT[(size_t)(dir * 4 + h) * R + row0 + 1] = (f32x4){b1, ig1 - b1, __expf(b1), __expf(tot - b1 + ig1)};
        if (F.lane == 0) GC[((size_t)(dir * 4 + gb0 + b) * 4 + h) * 66 + ctau0 + c] = __expf(tot);
    }
}

__device__ __forceinline__ void cum_block(Fr& F, const float* GATES, int grow0, int h, f32x4* GT0, f32x4* GT1, float* GC0, float* GC1, LAS float* tab) {
    if (F.wave < 2) {
        const int dir = F.wave, j0 = 2 * F.lane;
        const float* gp = GATES + (size_t)(grow0 + j0) * 16 + dir * 8 + h;
        const float ig0 = gp[0], lf0 = gp[4], ig1 = gp[16], lf1 = gp[20];
        float inc = lf0 + lf1;
#pragma unroll
        for (int o = 1; o < 64; o <<= 1) { const float t = __shfl_up(inc, o); if (F.lane >= o) inc += t; }
        const float tot = __shfl(inc, 63), exc = inc - (lf0 + lf1);
        float b0, b1;
        if (dir == 0) { b0 = exc + lf0; b1 = inc; } else { b0 = tot - exc; b1 = tot - exc - lf0; }
        const float w0 = __expf(tot - b0 + ig0), w1 = __expf(tot - b1 + ig1);
        f32x4* gt = (dir ? GT1 : GT0) + grow0 + j0;
        gt[0] = (f32x4){b0, ig0 - b0, __expf(b0), w0}; gt[1] = (f32x4){b1, ig1 - b1, __expf(b1), w1};
        LAS float* t = tab + dir * 384;
        t[j0] = b0; t[j0 + 1] = b1; t[128 + j0] = ig0 - b0; t[128 + j0 + 1] = ig1 - b1; t[256 + j0] = w0; t[256 + j0 + 1] = w1;
        if (F.lane == 0) *(dir ? GC1 : GC0) = __expf(tot);
    }
}
__device__ __forceinline__ void dn_block(Fr& F, const bf16* KTchunk, const LAS float* tab, float* DN0, float* DN1) {
    const LAS float* w0 = tab + 256; const LAS float* w1 = tab + 384 + 256;
    const bf16* kr = KTchunk + (size_t)(F.tid >> 4) * 4 * 512 + (F.tid & 15) * 8; float s0 = 0.f, s1 = 0.f;
#pragma unroll 4
    for (int q = 0; q < 16; ++q) { const int ks = q >> 2, q4 = q & 3; float v[8]; unpack8(*(const u32x4*)(kr + ks * 512 + q4 * 128), v);
#pragma unroll
        for (int e = 0; e < 8; ++e) { s0 += v[e] * w0[q * 8 + e]; s1 += v[e] * w1[q * 8 + e]; } }
    DN0[F.tid] = s0; DN1[F.tid] = s1;
}
__device__ __forceinline__ void ph_sphase(Fr& F, int hb, bool with_ctx) {
    const bf16* XC = (const bf16*)(F.ws + MS_XC); const bf16* KN = (const bf16*)(F.ws + MS_KN); const bf16* KT = (const bf16*)(F.ws + MS_KT);
    f32x4* GT = (f32x4*)(F.ws + WS_GT_L); float* DN = (float*)(F.ws + WS_DN); float* RS = (float*)(F.ws + WS_RS); float* GC = (float*)(F.ws + WS_GC);
    const float* GATES = (const float*)(F.ws + WS_GATES_L);
    bf16* S = (bf16*)(F.ws + MS_S);
    LAS float* tab = (LAS float*)(F.lds + 1024);
    const int fr = F.lane & 15, fq = F.lane >> 4, w = F.wave;
    for (int it = F.bid; it < 512; it += F.G) {
        const int c = it & 63, h = (it >> 6) & 3, bl = it >> 8, gb = 2 * hb + bl;
        const int row0 = bl * SEQ + c * 128;
        __syncthreads();
        cum_block(F, GATES, row0, h, GT + (size_t)(0 * 4 + h) * HROWS, GT + (size_t)(1 * 4 + h) * HROWS,
                  GC + ((size_t)(0 * 4 + gb) * 4 + h) * 66 + 2 + c, GC + ((size_t)(1 * 4 + gb) * 4 + h) * 66 + 2 + c, tab);
        __syncthreads();
        dn_block(F, KT + (size_t)(bl * 4 + h) * 512 * SEQ + (size_t)c * 65536, tab,
                 DN + (((size_t)(0 * 4 + gb) * 4 + h) * 66 + 2 + c) * 512, DN + (((size_t)(1 * 4 + gb) * 4 + h) * 66 + 2 + c) * 512);
        const int irow = row0 + 16 * w + fr;
        bf16x8 bq[16];
        { const bf16* p = XC + ((size_t)((row0 >> 4) + w) * 64 + h * 16) * 512 + F.lane * 8;
#pragma unroll
            for (int ks = 0; ks < 16; ++ks) bq[ks] = *(const bf16x8*)(p + ks * 512); }
        const float bif = tab[16 * w + fr], bib = tab[384 + 16 * w + fr];
        float rsf = 0.f, rsb = 0.f;
        bf16* sf = S + ((size_t)(0 * 8 + bl * 4 + h) * 64 + c) * 16384; bf16* sb = S + ((size_t)(1 * 8 + bl * 4 + h) * 64 + c) * 16384;
#pragma unroll 1
        for (int jt = 0; jt < 8; ++jt) {
            f32x4 acc = (f32x4){0.f, 0.f, 0.f, 0.f};
            const bf16* ap = KN + ((size_t)((row0 >> 4) + jt) * 64 + h * 16) * 512 + F.lane * 8;
#pragma unroll
            for (int ks = 0; ks < 16; ++ks) acc = __builtin_amdgcn_mfma_f32_16x16x32_bf16(*(const bf16x8*)(ap + ks * 512), bq[ks], acc, 0, 0, 0);
            float vf[4], vb[4];
            const f32x4 af4 = *(const LAS f32x4*)(tab + 128 + jt * 16 + 4 * fq), ab4 = *(const LAS f32x4*)(tab + 384 + 128 + jt * 16 + 4 * fq);
#pragma unroll
            for (int r = 0; r < 4; ++r) { const int j = jt * 16 + 4 * fq + r, i = 16 * w + fr;
                vf[r] = (j <= i) ? acc[r] * __expf(bif + af4[r]) : 0.f; vb[r] = (j >= i) ? acc[r] * __expf(bib + ab4[r]) : 0.f;
                rsf += vf[r]; rsb += vb[r]; }
            const size_t so = (size_t)(w * 4 + (jt >> 1)) * 512 + (fr + 16 * ((jt & 1) * 2 + (fq >> 1))) * 8 + (fq & 1) * 4;
            *(u32x2*)(sf + so) = (u32x2){pk2(vf[0], vf[1]), pk2(vf[2], vf[3])};
            *(u32x2*)(sb + so) = (u32x2){pk2(vb[0], vb[1]), pk2(vb[2], vb[3])};
        }
        rsf += __shfl_xor(rsf, 16); rsf += __shfl_xor(rsf, 32); rsb += __shfl_xor(rsb, 16); rsb += __shfl_xor(rsb, 32);
        if (fq == 0) { RS[(size_t)(0 * 4 + h) * HROWS + irow] = rsf; RS[(size_t)(1 * 4 + h) * HROWS + irow] = rsb; }
    }
    if (with_ctx) {
        const bf16* KTC2 = (const bf16*)(F.ws + MS_KTC); f32x4* GTC = (f32x4*)(F.ws + WS_GT_C); const float* GATESC = (const float*)(F.ws + WS_GATES_C);
        for (int it = F.bid; it < 32; it += F.G) {
            const int cc = it & 1, h = (it >> 1) & 3, gb = it >> 3;
            __syncthreads();
            cum_block(F, GATESC, gb * CTXL + cc * 128, h, GTC + (size_t)(0 * 4 + h) * MC, GTC + (size_t)(1 * 4 + h) * MC,
                      GC + ((size_t)(0 * 4 + gb) * 4 + h) * 66 + cc, GC + ((size_t)(1 * 4 + gb) * 4 + h) * 66 + cc, tab);
            __syncthreads();
            dn_block(F, KTC2 + (size_t)(gb * 4 + h) * 512 * CTXL + (size_t)cc * 65536, tab,
                     DN + (((size_t)(0 * 4 + gb) * 4 + h) * 66 + cc) * 512, DN + (((size_t)(1 * 4 + gb) * 4 + h) * 66 + cc) * 512);
        }
    }
}

__device__ __forceinline__ bf16x8 ldg16(const char* ub, unsigned off) { return *(const bf16x8*)(ub + off); }
__device__ __forceinline__ void ph_scan(Fr& F, int hb) {
    const char* XC = (const char*)(F.ws + MS_XC); const char* KT = (const char*)(F.ws + MS_KT); const char* VT = (const char*)(F.ws + MS_VT);
    const char* KTC2 = (const char*)(F.ws + MS_KTC); const char* VTC2 = (const char*)(F.ws + MS_VTC);
    const char* S = (const char*)(F.ws + MS_S);
    const f32x4* GTL = (const f32x4*)(F.ws + WS_GT_L); const f32x4* GTC = (const f32x4*)(F.ws + WS_GT_C);
    const float* GC = (const float*)(F.ws + WS_GC); const float* DN = (const float*)(F.ws + WS_DN);
    float* NC = (float*)(F.ws + WS_NC);
    LAS unsigned char* cbf = F.lds;
    LAS float* wl = (LAS float*)(F.lds + 2 * 33280);
    LAS unsigned char* vtb = F.lds + 2 * 33280 + 1024;
    const int w = F.wave;
    for (int wi = F.bid; wi < 256; wi += F.G) {
        const int chain = wi & 15, slice = wi >> 4, dir = chain >> 3, bl = (chain >> 2) & 1, h = chain & 3, gb = 2 * hb + bl, e0 = slice * 32;
        char* NUM = (char*)(F.ws + (dir ? MS_NB : MS_NF));
        const bool nwriter = (slice == 0) && (w == 0);
        f32x4 acc[4][2];
#pragma unroll
        for (int a = 0; a < 4; ++a)
#pragma unroll
            for (int b = 0; b < 2; ++b) acc[a][b] = (f32x4){0.f, 0.f, 0.f, 0.f};
        float nreg[8];
#pragma unroll
        for (int e = 0; e < 8; ++e) nreg[e] = 0.f;
        __syncthreads();
        const char* ktc = KTC2 + (size_t)(gb * 4 + h) * 512 * CTXL * 2; const char* vtc = VTC2 + (size_t)(gb * 4 + h) * 512 * CTXL * 2;
        const char* ktl = KT + (size_t)(bl * 4 + h) * 512 * SEQ * 2;    const char* vtl = VT + (size_t)(bl * 4 + h) * 512 * SEQ * 2;
        { const int ctau = dir == 0 ? 0 : 1; const f32x4* gt = GTC + (size_t)(dir * 4 + h) * MC; if (F.tid < 128) wl[F.tid] = gt[gb * CTXL + ctau * 128 + F.tid][3];
          *(LAS bf16x8*)(vtb + w * 1024 + F.lane * 16) = ldg16(vtc + (size_t)ctau * 131072 + (e0 >> 4) * 4096 + w * 1024, F.lane * 16u); }
        __syncthreads();
        bf16x8 xf[16];
#pragma unroll
        for (int ks = 0; ks < 16; ++ks) xf[ks] = (bf16x8){0, 0, 0, 0, 0, 0, 0, 0};
#pragma unroll 1
        for (int s = 0; s < 66; ++s) {
            int tid_ = F.tid; asm volatile("" : "+v"(tid_));
            const int lane_ = tid_ & 63, fr = lane_ & 15, fq = lane_ >> 4; const unsigned l16 = lane_ * 16u;
            const int ctau = dir == 0 ? s : (s < 2 ? 1 - s : 67 - s);
            const bool isctx = ctau < 2; const int c = isctx ? ctau : ctau - 2;
            const char* ktu = (isctx ? ktc : ktl) + (size_t)c * 131072;
            const int row0 = isctx ? gb * CTXL + c * 128 : bl * SEQ + c * 128;
            const f32x4* gt = isctx ? GTC + (size_t)(dir * 4 + h) * MC : GTL + (size_t)(dir * 4 + h) * HROWS;
            const float Gd = GC[((size_t)(dir * 4 + gb) * 4 + h) * 66 + ctau];
            const float* dn = DN + (((size_t)(dir * 4 + gb) * 4 + h) * 66 + ctau) * 512;
            LAS unsigned char* cb_rd = cbf + (s & 1) * 33280; LAS unsigned char* cb_wr = cbf + ((s + 1) & 1) * 33280;
            const LAS float* wl_rd = wl + (s & 1) * 128; LAS float* wl_wr = wl + ((s + 1) & 1) * 128;
            const int s2 = s + 1, ct2 = dir == 0 ? s2 : (s2 < 2 ? 1 - s2 : 67 - s2); const bool has2 = s2 < 66, ic2 = ct2 < 2; const int c2 = ic2 ? ct2 : ct2 - 2;
            const char* xc2 = XC + ((size_t)(((bl * SEQ + c2 * 128) >> 4) + w) * 64 + h * 16) * 1024;
            const LAS unsigned char* vt_rd = vtb + (s & 1) * 8192; LAS unsigned char* vt_wr = vtb + ((s + 1) & 1) * 8192;
            bf16x8 kf[4][4], vf[2][4], sfr[4];
            bf16x8 vnext = (bf16x8){0, 0, 0, 0, 0, 0, 0, 0};
            if (has2) vnext = ldg16((ic2 ? vtc : vtl) + (size_t)c2 * 131072 + (e0 >> 4) * 4096 + w * 1024, l16);
#pragma unroll
            for (int et = 0; et < 2; ++et)
#pragma unroll
                for (int ks = 0; ks < 4; ++ks) vf[et][ks] = *(const LAS bf16x8*)(vt_rd + (et * 4 + ks) * 1024 + l16);
            if (!isctx) { const char* su = S + ((size_t)(dir * 8 + bl * 4 + h) * 64 + c) * 32768 + w * 4096;
#pragma unroll
                for (int ks = 0; ks < 4; ++ks) sfr[ks] = ldg16(su + ks * 1024, l16); }
#pragma unroll
            for (int ks = 0; ks < 1; ++ks)
#pragma unroll
                for (int dt = 0; dt < 4; ++dt) kf[ks][dt] = ldg16(ktu + (4 * w + dt) * 4096 + ks * 1024, l16);
            unsigned pf = 0u; const int s3 = s + 2;
            if (s3 < 66) {
                const int ct3 = dir == 0 ? s3 : (s3 < 2 ? 1 - s3 : 67 - s3); const bool ic3 = ct3 < 2; const int c3 = ic3 ? ct3 : ct3 - 2;
                const char* kt3 = (ic3 ? ktc : ktl) + (size_t)c3 * 131072; const char* vt3 = (ic3 ? vtc : vtl) + (size_t)c3 * 131072;
                const char* xc3 = XC + ((size_t)((bl * SEQ + c3 * 128) >> 4) * 64 + h * 16) * 1024; const char* s3p = S + ((size_t)(dir * 8 + bl * 4 + h) * 64 + c3) * 32768;
                const unsigned t = tid_; const char* ub = kt3; unsigned off = 0u;
                if (t < 64) { off = (slice * 64 + t) * 128u; }
                else if (t < 128) { ub = vt3; off = (e0 >> 4) * 4096u + (t - 64) * 128u; }
                else if (t < 192) { if (!ic3) { const unsigned ln = slice * 64 + (t - 128); ub = xc3; off = (ln >> 7) * 65536u + (ln & 127) * 128u; } }
                else if (t < 208) { if (!ic3) { ub = s3p; off = (slice * 16 + (t - 192)) * 128u; } }
                if (t < 208) pf = *(const volatile unsigned*)(ub + off);
            }
            if (!isctx) {
                const float Ei = *(const float*)((const char*)(gt + row0 + 16 * w) + (unsigned)fr * 16u + 8u);
                if (nwriter) { char* np = (char*)(NC + (((size_t)(dir * 2 + bl) * 4 + h) * 64 + c) * 512); const unsigned lo = lane_ * 32u;
                    *(f32x4*)(np + lo) = (f32x4){nreg[0], nreg[1], nreg[2], nreg[3]}; *(f32x4*)(np + lo + 16u) = (f32x4){nreg[4], nreg[5], nreg[6], nreg[7]}; }
                f32x4 a2[2] = {(f32x4){0.f, 0.f, 0.f, 0.f}, (f32x4){0.f, 0.f, 0.f, 0.f}};
#pragma unroll
                for (int ks = 0; ks < 16; ++ks)
#pragma unroll
                    for (int et = 0; et < 2; ++et) a2[et] = __builtin_amdgcn_mfma_f32_16x16x32_bf16(*(const LAS bf16x8*)(cb_rd + (16 * et + fr) * 1040 + ks * 64 + fq * 16), xf[ks], a2[et], 0, 0, 0);
                asm volatile("" ::: "memory");
#pragma unroll
                for (int ks = 1; ks < 4; ++ks)
#pragma unroll
                    for (int dt = 0; dt < 4; ++dt) kf[ks][dt] = ldg16(ktu + (4 * w + dt) * 4096 + ks * 1024, l16);
                a2[0] = a2[0] * Ei; a2[1] = a2[1] * Ei;
#pragma unroll
                for (int ks = 0; ks < 4; ++ks)
#pragma unroll
                    for (int et = 0; et < 2; ++et) a2[et] = __builtin_amdgcn_mfma_f32_16x16x32_bf16(vf[et][ks], sfr[ks], a2[et], 0, 0, 0);
                char* nu = NUM + ((size_t)row0 * MI + h * 512 + e0) * 2; const unsigned ln = ((16u * w + fr) * MI + 4u * fq) * 2u;
#pragma unroll
                for (int et = 0; et < 2; ++et) *(u32x2*)(nu + et * 32 + ln) = (u32x2){pk2(a2[et][0], a2[et][1]), pk2(a2[et][2], a2[et][3])};
            } else {
#pragma unroll
                for (int ks = 1; ks < 4; ++ks)
#pragma unroll
                    for (int dt = 0; dt < 4; ++dt) kf[ks][dt] = ldg16(ktu + (4 * w + dt) * 4096 + ks * 1024, l16);
            }
            if (has2) *(LAS bf16x8*)(vt_wr + w * 1024 + l16) = vnext;
            if (has2 && tid_ < 128) {
                const f32x4* gt2 = ic2 ? GTC + (size_t)(dir * 4 + h) * MC : GTL + (size_t)(dir * 4 + h) * HROWS;
                wl_wr[tid_] = *(const float*)((const char*)(gt2 + (ic2 ? gb * CTXL : bl * SEQ) + c2 * 128) + (unsigned)tid_ * 16u + 12u); }
#pragma unroll
            for (int a = 0; a < 4; ++a)
#pragma unroll
                for (int b = 0; b < 2; ++b) acc[a][b] = acc[a][b] * Gd;
#pragma unroll
            for (int ks = 0; ks < 4; ++ks) {
                bf16x8 bv[2];
#pragma unroll
                for (int et = 0; et < 2; ++et) { float v[8]; unpack8(__builtin_bit_cast(u32x4, vf[et][ks]), v);
#pragma unroll
                    for (int e = 0; e < 8; ++e) v[e] *= wl_rd[ks * 32 + 8 * fq + e];
                    const u32x4 pv = pack8(v); bv[et] = __builtin_bit_cast(bf16x8, pv); }
#pragma unroll
                for (int dt = 0; dt < 4; ++dt)
#pragma unroll
                    for (int et = 0; et < 2; ++et) acc[dt][et] = __builtin_amdgcn_mfma_f32_16x16x32_bf16(kf[ks][dt], bv[et], acc[dt][et], 0, 0, 0);
            }
            asm volatile("" ::: "memory");
            if (has2 && !ic2) {
#pragma unroll
                for (int ks = 0; ks < 16; ++ks) xf[ks] = ldg16(xc2 + ks * 1024, l16);
            }
            if (nwriter) { const unsigned lo = lane_ * 32u; const f32x4 d0 = *(const f32x4*)((const char*)dn + lo), d1 = *(const f32x4*)((const char*)dn + lo + 16u);
                nreg[0] = Gd * nreg[0] + d0[0]; nreg[1] = Gd * nreg[1] + d0[1]; nreg[2] = Gd * nreg[2] + d0[2]; nreg[3] = Gd * nreg[3] + d0[3];
                nreg[4] = Gd * nreg[4] + d1[0]; nreg[5] = Gd * nreg[5] + d1[1]; nreg[6] = Gd * nreg[6] + d1[2]; nreg[7] = Gd * nreg[7] + d1[3]; }
#pragma unroll
            for (int dt = 0; dt < 4; ++dt)
#pragma unroll
                for (int et = 0; et < 2; ++et) *(LAS u32x2*)(cb_wr + (16 * et + fr) * 1040 + (64 * w + 16 * dt + 4 * fq) * 2) = (u32x2){pk2(acc[dt][et][0], acc[dt][et][1]), pk2(acc[dt][et][2], acc[dt][et][3])};
            asm volatile("" :: "v"(pf));
            __syncthreads();
        }
    }
}

__device__ __forceinline__ void ph_mout(Fr& F) {
    bf16* NF = (bf16*)(F.ws + MS_NF); const bf16* NBk = (const bf16*)(F.ws + MS_NB); const bf16* XC = (const bf16*)(F.ws + MS_XC); const bf16* Z = (const bf16*)(F.ws + MS_Z);
    const float* NC = (const float*)(F.ws + WS_NC); const float* RS = (const float*)(F.ws + WS_RS); const f32x4* GTL = (const f32x4*)(F.ws + WS_GT_L);
    LAS unsigned char* xt = F.lds + F.wave * 16640;
    for (int it = F.gw; it < (HROWS / 16) * 4; it += F.ngw) {
        const int rt = it >> 2, h = it & 3, bl = rt >> 9, c = (rt >> 3) & 63;
        { const bf16* xp = XC + ((size_t)rt * 64 + h * 16) * 512 + F.lane * 8; u32x4 t[16];
#pragma unroll
            for (int ks = 0; ks < 16; ++ks) t[ks] = *(const u32x4*)(xp + ks * 512);
#pragma unroll
            for (int ks = 0; ks < 16; ++ks) *(LAS u32x4*)(xt + ks * 1040 + F.lane * 16) = t[ks]; }
        const float* n0 = NC + (((size_t)(0 * 2 + bl) * 4 + h) * 64 + c) * 512 + 8 * F.lane; const float* n1 = NC + (((size_t)(1 * 2 + bl) * 4 + h) * 64 + c) * 512 + 8 * F.lane;
        const f32x4 n00 = *(const f32x4*)n0, n01 = *(const f32x4*)(n0 + 4), n10 = *(const f32x4*)n1, n11 = *(const f32x4*)(n1 + 4);
        float nw[8], sk[8];
        { const float* pw = IN(I_MNW) + h * 512 + 8 * F.lane; const float* ps = IN(I_MSKIP) + h * 512 + 8 * F.lane;
#pragma unroll
            for (int e = 0; e < 8; ++e) { nw[e] = pw[e]; sk[e] = ps[e]; } }
#pragma unroll 2
        for (int r = 0; r < 16; ++r) {
            const int row = rt * 16 + r; const size_t o = (size_t)row * MI + h * 512 + 8 * F.lane;
            float nf[8], nb[8], xc[8], z[8];
            unpack8(*(const u32x4*)(NF + o), nf); unpack8(*(const u32x4*)(NBk + o), nb); unpack8(*(const u32x4*)(Z + o), z);
            unpack8(*(const LAS u32x4*)(xt + (F.lane >> 2) * 1040 + (r + 16 * (F.lane & 3)) * 16), xc);
            float d0 = xc[0] * n00[0] + xc[1] * n00[1] + xc[2] * n00[2] + xc[3] * n00[3] + xc[4] * n01[0] + xc[5] * n01[1] + xc[6] * n01[2] + xc[7] * n01[3];
            float d1 = xc[0] * n10[0] + xc[1] * n10[1] + xc[2] * n10[2] + xc[3] * n10[3] + xc[4] * n11[0] + xc[5] * n11[1] + xc[6] * n11[2] + xc[7] * n11[3];
            d0 = wave_sum(d0); d1 = wave_sum(d1);
            const float den0 = GTL[(size_t)(0 * 4 + h) * HROWS + row][2] * d0 + RS[(size_t)(0 * 4 + h) * HROWS + row], den1 = GTL[(size_t)(1 * 4 + h) * HROWS + row][2] * d1 + RS[(size_t)(1 * 4 + h) * HROWS + row];
            const float i0 = 1.0f / fmaxf(fabsf(den0), 1.0f), i1 = 1.0f / fmaxf(fabsf(den1), 1.0f);
            float s = 0.f;
#pragma unroll
            for (int e = 0; e < 8; ++e) { nf[e] = nf[e] * i0 + nb[e] * i1; s += nf[e]; }
            const float mu = wave_sum(s) * (1.0f / 512.0f); float q = 0.f;
#pragma unroll
            for (int e = 0; e < 8; ++e) { nf[e] -= mu; q += nf[e] * nf[e]; }
            const float rstd = 1.0f / sqrtf(wave_sum(q) * (1.0f / 512.0f) + ML_NORM_EPS);
#pragma unroll
            for (int e = 0; e < 8; ++e) nf[e] = (nf[e] * rstd * nw[e] + sk[e] * xc[e]) * silu_f(z[e]);
            *(u32x4*)(NF + o) = pack8(nf);
        }
    }
}

__device__ __forceinline__ void ph_final(Fr& F) {
    const float* g = IN(I_FINALG);
    for (int r = F.gw; r < ML; r += 2 * F.ngw) {
        const int r2 = r + F.ngw < ML ? r + F.ngw : r;
        f32x4* xa = (f32x4*)(F.out + (size_t)r * 1024) + F.lane; f32x4* xb = (f32x4*)(F.out + (size_t)r2 * 1024) + F.lane; f32x4 va[4], vb[4]; float sa = 0.f, sb = 0.f;
#pragma unroll
        for (int j = 0; j < 4; ++j) { va[j] = xa[64 * j]; vb[j] = xb[64 * j]; }
#pragma unroll
        for (int j = 0; j < 4; ++j) { sa += (va[j][0] * va[j][0] + va[j][1] * va[j][1]) + (va[j][2] * va[j][2] + va[j][3] * va[j][3]); sb += (vb[j][0] * vb[j][0] + vb[j][1] * vb[j][1]) + (vb[j][2] * vb[j][2] + vb[j][3] * vb[j][3]); }
        const float ra = 1.0f / sqrtf(wave_sum(sa) * (1.0f / 1024.0f) + EPS), rb = 1.0f / sqrtf(wave_sum(sb) * (1.0f / 1024.0f) + EPS);
#pragma unroll
        for (int j = 0; j < 4; ++j) { const f32x4 gg = *(const f32x4*)(g + 4 * F.lane + 256 * j); xa[64 * j] = va[j] * ra * gg; if (r2 != r) xb[64 * j] = vb[j] * rb * gg; }
    }
}

template <class Epi>
__device__ __forceinline__ void run_gemm(Fr& F, const bf16* A, const bf16* Bt, int M, int N, int K, const Epi& E) {
    pg8::Gemm g{A, Bt, M, N, K}; pg8::StaticOrder S; S.init(M, N, F.G, F.bid);
    pg8::gemm_phase<Epi, pg8::StaticOrder, true, true>(F.lds, g, S, E, F.tid);
}

struct Args { const float* in[38]; float* out; unsigned char* ws; int ph_lo, ph_hi; };
static_assert(sizeof(Args) == 328 && offsetof(Args, out) == 304 && offsetof(Args, ws) == 312 && offsetof(Args, ph_lo) == 320, "Args layout");
constexpr int N_PHASES = 34;


#define XB_TMO      128
#define XB_XCNT(j)  (256  + 64 * (j))
#define XB_XSUB(j)  (1280 + 64 * (j))
#define XB_XGEN(j)  (2304 + 64 * (j))
#define XB_TOP      3328
#define XB_TOPGEN   3392
#define XCD_BAR_WORDS 3456
#define XB_SPIN_CAP (1u << 22)
__device__ __forceinline__ unsigned xb_ld(unsigned* p)              { return __hip_atomic_load(p, __ATOMIC_RELAXED, __HIP_MEMORY_SCOPE_AGENT); }
__device__ __forceinline__ unsigned xb_add(unsigned* p, unsigned v) { return __hip_atomic_fetch_add(p, v, __ATOMIC_RELAXED, __HIP_MEMORY_SCOPE_AGENT); }
__device__ __forceinline__ unsigned xb_xcc_id() { return (unsigned)__builtin_amdgcn_s_getreg((3 << 11) | 20) & 0xFu; }
#define XB_SPIN(cond, bar) do { unsigned _sp = 0; while (cond) { __builtin_amdgcn_s_sleep(1); \
    if ((++_sp & 255u) == 0u) { if (xb_ld(&(bar)[XB_TMO])) break; if (_sp > XB_SPIN_CAP) { atomicAdd(&(bar)[XB_TMO], 1u); break; } } } } while (0)
__device__ __forceinline__ void xcd_barrier_complete(unsigned* bar, unsigned x, unsigned& nloc, unsigned& nx) {
    const unsigned G = gridDim.x * gridDim.y * gridDim.z;
    unsigned sum, cnt, mine, sp = 0u;
    for (;;) {
        sum = 0u; cnt = 0u; mine = 0u;
#pragma unroll
        for (unsigned j = 0; j < 16; ++j) { const unsigned c = xb_ld(&bar[XB_XCNT(j)]); sum += c; cnt += (c > 0u) ? 1u : 0u; mine = (j == x) ? c : mine; }
        if (sum == G) break;
        __builtin_amdgcn_s_sleep(1);
        if ((++sp & 255u) == 0u) { if (xb_ld(&bar[XB_TMO])) break; if (sp > XB_SPIN_CAP) { atomicAdd(&bar[XB_TMO], 1u); break; } }
    }
    nloc = mine > 0u ? mine : 1u; nx = cnt > 0u ? cnt : 1u;
}
__device__ __forceinline__ void xcd_barrier(unsigned* bar, volatile LAS unsigned* st) {
    asm volatile("s_waitcnt vmcnt(0)" ::: "memory");
    __syncthreads();
    if (threadIdx.x == 0) {
        const unsigned x = xb_xcc_id();
        __builtin_amdgcn_s_waitcnt(0);
        unsigned nloc = st[0], nx = st[1];
        if (nloc == 0u) { xcd_barrier_complete(bar, x, nloc, nx); st[0] = nloc; st[1] = nx; }
        const unsigned old = xb_add(&bar[XB_XSUB(x)], 1u);
        const unsigned gen = old / nloc;
        if (old + 1u == (gen + 1u) * nloc) {
            __builtin_amdgcn_fence(__ATOMIC_RELEASE, "agent");
            asm volatile("s_waitcnt vmcnt(0)" ::: "memory");
            const unsigned og = xb_add(&bar[XB_TOP], 1u);
            const unsigned tg = og / nx;
            if (og + 1u == (tg + 1u) * nx) xb_add(&bar[XB_TOPGEN], 1u);
            else XB_SPIN(xb_ld(&bar[XB_TOPGEN]) == tg, bar);
            __builtin_amdgcn_fence(__ATOMIC_ACQUIRE, "agent");
            xb_add(&bar[XB_XGEN(x)], 1u);
            asm volatile("s_waitcnt vmcnt(0)" ::: "memory");
        } else {
            XB_SPIN(xb_ld(&bar[XB_XGEN(x)]) == gen, bar);
            __builtin_amdgcn_fence(__ATOMIC_ACQUIRE, "agent");
            asm volatile("s_waitcnt vmcnt(0)" ::: "memory");
        }
    }
    __syncthreads();
}
#ifndef PROBE_MASK
#define PROBE_MASK 0ull
#endif
constexpr int BAR_LDS_OFF = LDS_BYTES - 64;
constexpr size_t WS_BAR = 0;
constexpr size_t WS_TS = 64 * 1024;

template <int ph>
__device__ __forceinline__ void run_phase(Fr& F) {
    unsigned char* ws = F.ws;
    float* mod = (float*)(ws + WS_MOD); float* ctxx = (float*)(ws + WS_CTXX);
    if constexpr (ph == 0) ph_prologue(F);
    else if constexpr (ph == 1) {
            kt_items(F, (const float*)(ws + WS_H3), SEQ, (float*)(ws + HY_KT));
            kt_items(F, (const float*)(ws + WS_H3) + (size_t)SEQ * 64, CTXL, (float*)(ws + WS_KTC));
            ph_modnorm(F, IN(I_X), ML, 0, IN(I_CTX), MC, IN(I_NORMG), mod, 0, (bf16*)(ws + HY_H));
        }
    else if constexpr (ph == 2) { pg8::EpiBf16 E{(bf16*)(ws + HY_P), 3072, IN(I_HBIN), 0, 0}; run_gemm(F, (const bf16*)(ws + HY_H), (const bf16*)(ws + WS_WHIN), MALL, 3072, 1024, E); }
    else if constexpr (ph == 3) { zt_items(F, (const bf16*)(ws + HY_P), 0, NB, SEQ, (bf16*)(ws + HY_ZT)); zt_items(F, (const bf16*)(ws + HY_P), ML, NB, CTXL, (bf16*)(ws + HY_ZTC)); }
    else if constexpr (ph == 4) ph_fftconv(F);
    else if constexpr (ph == 5) { u2_items(F, (const bf16*)(ws + HY_P), 0, NB, SEQ, (const bf16*)(ws + HY_ZT), (bf16*)(ws + HY_H)); u2_items(F, (const bf16*)(ws + HY_P), ML, NB, CTXL, (const bf16*)(ws + HY_ZTC), (bf16*)(ws + HY_H)); }
    else if constexpr (ph == 6) { pg8::EpiRes E{IN(I_X), F.out, IN(I_CTX), ctxx, ML, mod + 2048, 0, IN(I_HBOUT)}; run_gemm(F, (const bf16*)(ws + HY_H), (const bf16*)(ws + WS_WHOUT), MALL, 1024, 1024, E); }
    else if constexpr (ph == 7) ph_modnorm(F, F.out, ML, 0, ctxx, MC, IN(I_NORMG) + 1024, mod, 3072, (bf16*)(ws + FF_H));
    else if constexpr (ph == 8) { pg8::EpiBf16 E{(bf16*)(ws + FF_A), FF, nullptr, FF, (FF_G - FF_A) / 2}; run_gemm(F, (const bf16*)(ws + FF_H), (const bf16*)(ws + WS_WUP0), MALL, 2 * FF, 1024, E); }
    else if constexpr (ph == 9) ph_dwconv(F, 0, ML, MC);
    else if constexpr (ph == 10) { pg8::EpiRes E{F.out, F.out, ctxx, ctxx, ML, mod + 5120, 0, nullptr}; run_gemm(F, (const bf16*)(ws + FF_A), (const bf16*)(ws + WS_WDN0), MALL, 1024, FF, E); }
    else if constexpr (ph < 29) {
            constexpr int hb = (ph - 11) / 9, k = (ph - 11) % 9; const float* mod1 = mod + 5 * 6144;
            float* xh = F.out + (size_t)hb * HROWS * 1024;
            if constexpr (k == 0) { ph_modnorm(F, xh, HROWS, 2 * hb, ctxx, 0, IN(I_NORMG) + 2048, mod1, 0, (bf16*)(ws + MS_H));
                          if (hb == 0) ph_modnorm(F, xh, 0, 0, ctxx, MC, IN(I_NORMG) + 2048, mod1, 0, (bf16*)(ws + MS_HC)); }
            else if constexpr (k == 1) { { pg8::EpiBf16T E{(bf16*)(ws + MS_XM), MI / 32}; run_gemm(F, (const bf16*)(ws + MS_H), (const bf16*)(ws + WS_WMIN), HROWS, MI, 1024, E); }
                               if (hb == 0) { pg8::EpiBf16T E{(bf16*)(ws + MS_XMC), MI / 32}; run_gemm(F, (const bf16*)(ws + MS_HC), (const bf16*)(ws + WS_WMIN), MC, MI, 1024, E); } }
            else if constexpr (k == 2) { prep_items(F, (const bf16*)(ws + MS_XM), 2, SEQ, (bf16*)(ws + MS_XC), (bf16*)(ws + MS_KN), (bf16*)(ws + MS_KT), (bf16*)(ws + MS_VT));
                               if (hb == 0) prep_items(F, (const bf16*)(ws + MS_XMC), NB, CTXL, (bf16*)(ws + MS_XCC), (bf16*)(ws + MS_XCC + 16 * MiB), (bf16*)(ws + MS_KTC), (bf16*)(ws + MS_VTC)); }
            else if constexpr (k == 3) { gate_items(F, (const bf16*)(ws + MS_XC), (const bf16*)(ws + MS_XM), HROWS, (float*)(ws + WS_GATES_L));
                               if (hb == 0) gate_items(F, (const bf16*)(ws + MS_XCC), (const bf16*)(ws + MS_XMC), MC, (float*)(ws + WS_GATES_C)); }
            else if constexpr (k == 4) ph_sphase(F, hb, hb == 0);
            else if constexpr (k == 5) ph_scan(F, hb);
            else if constexpr (k == 6) { pg8::EpiBf16 E{(bf16*)(ws + MS_Z), MI, nullptr, 0, 0}; run_gemm(F, (const bf16*)(ws + MS_H), (const bf16*)(ws + WS_WMIN) + (size_t)MI * 1024, HROWS, MI, 1024, E); }
            else if constexpr (k == 7) ph_mout(F);
            else { pg8::EpiRes E{xh, xh, ctxx, ctxx, HROWS, mod1 + 2048, 2 * hb, nullptr}; run_gemm(F, (const bf16*)(ws + MS_NF), (const bf16*)(ws + WS_WMDN), HROWS, 1024, MI, E); }
        }
    else if constexpr (ph == 29) ph_modnorm(F, F.out, ML, 0, ctxx, 0, IN(I_NORMG) + 3072, mod + 5 * 6144, 3072, (bf16*)(ws + FF_H));
    else if constexpr (ph == 30) { pg8::EpiBf16 E{(bf16*)(ws + FF_A), FF, nullptr, FF, (FF_G - FF_A) / 2}; run_gemm(F, (const bf16*)(ws + FF_H), (const bf16*)(ws + WS_WUP1), ML, 2 * FF, 1024, E); }
    else if constexpr (ph == 31) ph_dwconv(F, 1, ML, 0);
    else if constexpr (ph == 32) { pg8::EpiRes E{F.out, F.out, ctxx, ctxx, ML, mod + 5 * 6144 + 5120, 0, nullptr}; run_gemm(F, (const bf16*)(ws + FF_A), (const bf16*)(ws + WS_WDN1), ML, 1024, FF, E); }
    else ph_final(F);
}

template <int ph>
__device__ __forceinline__ void phase_step(int ph_lo, int ph_hi, unsigned char* lds_raw) {
    if (ph_lo <= ph && ph < ph_hi) {
        const __attribute__((address_space(4))) unsigned char* kp = (const __attribute__((address_space(4))) unsigned char*)__builtin_amdgcn_kernarg_segment_ptr();
        asm volatile("" : "+s"(kp));
        Fr F;
        { int t_ = threadIdx.x, g_ = gridDim.x, b_ = blockIdx.x; asm volatile("" : "+v"(t_), "+s"(g_), "+s"(b_)); F.tid = t_; F.G = g_; F.bid = b_; }
        F.lds = (LAS unsigned char*)lds_raw; F.lane = F.tid & 63; F.wave = __builtin_amdgcn_readfirstlane(F.tid >> 6);
        F.gw = F.bid * NWAVES + F.wave; F.ngw = F.G * NWAVES;
        F.in = (const __attribute__((address_space(4))) cfptr_t*)kp;
        typedef float* fptr_t; typedef unsigned char* ucptr_t;
        F.out = *(const __attribute__((address_space(4))) fptr_t*)(kp + 304); F.ws = *(const __attribute__((address_space(4))) ucptr_t*)(kp + 312);
        if (PROBE_MASK != 0ull && F.bid == 0 && F.tid == 0) ((unsigned long long*)(F.ws + WS_TS))[ph] = __builtin_amdgcn_s_memrealtime();
        run_phase<ph>(F);
        if (ph + 1 < ph_hi) {
            if (ph == 0) {
                if (F.bid == 0) for (int i = F.tid; i < XCD_BAR_WORDS; i += NTHR) __hip_atomic_store((unsigned*)(F.ws + WS_BAR) + i, 0u, __ATOMIC_RELAXED, __HIP_MEMORY_SCOPE_AGENT);
                __syncthreads(); cg::this_grid().sync();
                if (F.tid == 0) (void)xb_add((unsigned*)(F.ws + WS_BAR) + XB_XCNT(xb_xcc_id()), 1u);
            }
            else xcd_barrier((unsigned*)(F.ws + WS_BAR), (volatile LAS unsigned*)(F.lds + BAR_LDS_OFF));
        }
        if (PROBE_MASK != 0ull && ph == N_PHASES - 1 && F.bid == 0) {
            if (F.tid == 0) { unsigned long long* ts = (unsigned long long*)(F.ws + WS_TS); const unsigned long long tend = __builtin_amdgcn_s_memrealtime(); unsigned long long tot = 0ull;
                for (int k = 0; k < N_PHASES; ++k) if ((PROBE_MASK >> k) & 1ull) tot += (k + 1 < N_PHASES ? ts[k + 1] : tend) - ts[k];
                while (__builtin_amdgcn_s_memrealtime() - tend < tot) __builtin_amdgcn_s_sleep(8); }
            __syncthreads();
        }
    }
}
template <int... I>
__device__ __forceinline__ void all_phases(int ph_lo, int ph_hi, unsigned char* lds_raw, std::integer_sequence<int, I...>) { (phase_step<I>(ph_lo, ph_hi, lds_raw), ...); }

__global__ void __launch_bounds__(NTHR, 2) fwd_kernel(Args args) {
    extern __shared__ __attribute__((aligned(16))) unsigned char lds_raw[];
    int ph_lo, ph_hi;
    { const __attribute__((address_space(4))) unsigned char* kp0 = (const __attribute__((address_space(4))) unsigned char*)__builtin_amdgcn_kernarg_segment_ptr();
      ph_lo = *(const __attribute__((address_space(4))) int*)(kp0 + 320); ph_hi = *(const __attribute__((address_space(4))) int*)(kp0 + 324); }
    if (threadIdx.x < 16) ((LAS unsigned*)((LAS unsigned char*)lds_raw + BAR_LDS_OFF))[threadIdx.x] = 0u;
    __syncthreads();
    all_phases(ph_lo, ph_hi, lds_raw, std::make_integer_sequence<int, N_PHASES>{});
}

extern "C" void kernel_launch(void* const* d_in, const int* in_sizes, int n_in, void* d_out, int out_size, void* d_ws, size_t ws_size, hipStream_t stream) {
    static int grid = 0;
    if (grid == 0) {
        int dev = 0, cus = 0, per_cu = 0;
        hipGetDevice(&dev);
        hipDeviceGetAttribute(&cus, hipDeviceAttributeMultiprocessorCount, dev);
        hipFuncSetAttribute((const void*)fwd_kernel, hipFuncAttributeMaxDynamicSharedMemorySize, LDS_BYTES);
        hipOccupancyMaxActiveBlocksPerMultiprocessor(&per_cu, (const void*)fwd_kernel, NTHR, LDS_BYTES);
        if (per_cu < 1) { fprintf(stderr, "kernel_launch: occupancy query says %d blocks per CU\n", per_cu); per_cu = 1; }
        grid = cus < 256 ? cus : 256;
        if (n_in != 38 || ws_size < WS_END) fprintf(stderr, "kernel_launch: unexpected n_in %d / ws_size %zu (need %zu)\n", n_in, ws_size, (size_t)WS_END);
        (void)hipGetLastError();
    }
    (void)hipMemsetAsync(d_ws, 0, 128 * 1024, stream);
    Args a{};
    for (int i = 0; i < 38; ++i) a.in[i] = (const float*)d_in[i];
    a.out = (float*)d_out; a.ws = (unsigned char*)d_ws; a.ph_lo = 0; a.ph_hi = N_PHASES;
    void* kargs[] = {&a};
    hipError_t e = hipLaunchCooperativeKernel((const void*)fwd_kernel, dim3(grid), dim3(NTHR), kargs, LDS_BYTES, stream);
    if (e != hipSuccess) fprintf(stderr, "cooperative launch failed: %s (grid %d)\n", hipGetErrorString(e), grid);
}
```

```cpp
#include <hip/hip_runtime.h>
#include <hip/hip_cooperative_groups.h>
#include <cstdio>
#include <cstdint>
#include <cstddef>
#include <utility>
namespace cg = cooperative_groups;

#define LAS __attribute__((address_space(3)))
typedef unsigned short bf16;
typedef short bf16x8 __attribute__((ext_vector_type(8)));
typedef float f32x4 __attribute__((ext_vector_type(4)));
typedef float f32x2 __attribute__((ext_vector_type(2)));
typedef unsigned u32x4 __attribute__((ext_vector_type(4)));
typedef unsigned u32x2 __attribute__((ext_vector_type(2)));

namespace pg8 {
#define PG8_LAS __attribute__((address_space(3)))
typedef unsigned short bf16_t;
constexpr int BM = 256, BK = 64, HALF = 128, HTB = HALF * BK * 2, STAGE_BYTES = 8 * HTB, NXCD = 8, WGM = 8;
__host__ __device__ __forceinline__ int lds_byte(int r, int c) { const int st = (r >> 4) * 2 + (c >> 5), rr = r & 15, cc = c & 31, ob = rr * 64 + cc * 2; return st * 1024 + (ob ^ (((ob >> 9) & 1) << 5)); }
__host__ __device__ __forceinline__ void stage_rc(int b, int& R, int& C) { const int st = b / 1024, sb = b % 1024, swz = sb ^ (((sb >> 9) & 1) << 5); R = (st >> 1) * 16 + swz / 64; C = (st & 1) * 32 + (swz % 64) / 2; }
__host__ __device__ __forceinline__ int perm32(int rho) { const int n = rho >> 4, i = rho & 15; return 8 * (i >> 2) + 4 * n + (i & 3); }
struct Unit { int pm, pn; };
struct Gemm { const bf16_t* A; const bf16_t* Bt; int M, N, K; };
struct StaticOrder {
    int nM, nN, nwg, G, c;
    __host__ __device__ void init(int M, int N, int G_, int c_) { nM = M / BM; nN = N / BM; nwg = nM * nN; G = G_; c = c_; }
    __host__ __device__ bool next(int i, Unit& u) const {
        const long L = (long)i * G + c; if (L >= nwg) return false;
        int wgid = (int)L; { const int q = nwg / NXCD, r = nwg % NXCD, xcd = wgid % NXCD, off = wgid / NXCD; wgid = (xcd < r ? xcd * (q + 1) : r * (q + 1) + (xcd - r) * q) + off; }
        const int nig = WGM * nN, gid = wgid / nig, fm = gid * WGM, gsz = (nM - fm) < WGM ? (nM - fm) : WGM;
        u.pm = fm + ((wgid % nig) % gsz); u.pn = (wgid % nig) / gsz; return true;
    }
    __device__ __forceinline__ void a_ready(const Unit&) const {}
    __device__ __forceinline__ void done(const Unit&) const {}
};
__device__ __forceinline__ unsigned cvt_pk_bf16(float lo, float hi) { unsigned r; asm volatile("v_cvt_pk_bf16_f32 %0, %1, %2" : "=v"(r) : "v"(lo), "v"(hi)); return r; }

struct EpiBf16 {
    static constexpr bool PERM = true, AFTER_DRAIN = false;
    bf16_t* O; int ldc; const float* bias; int split_cols; size_t split_stride;
    __device__ __forceinline__ void operator()(const f32x4 (&acc)[2][2][4][2], const Unit& u, int wr, int wc, int fr, int fq) const {
        const int row0 = u.pm * BM + wr * 64 + fr; int colt = u.pn * BM; bf16_t* base = O;
        if (split_cols) { const int t = colt / split_cols; base += (size_t)t * split_stride; colt -= t * split_cols; }
        const int col0 = colt + wc * 32 + 8 * fq, bcol0 = u.pn * BM + wc * 32 + 8 * fq;
        f32x4 bv[2][2];
#pragma unroll
        for (int bj = 0; bj < 2; ++bj)
#pragma unroll
            for (int n = 0; n < 2; ++n) bv[bj][n] = bias ? *(const f32x4*)(bias + bcol0 + bj * HALF + 4 * n) : (f32x4){0.f, 0.f, 0.f, 0.f};
#pragma unroll
        for (int ai = 0; ai < 2; ++ai)
#pragma unroll
            for (int m = 0; m < 4; ++m) { bf16_t* rowp = base + (size_t)(row0 + ai * HALF + m * 16) * ldc + col0;
#pragma unroll
                for (int bj = 0; bj < 2; ++bj) { f32x4 v0 = acc[ai][bj][m][0] + bv[bj][0], v1 = acc[ai][bj][m][1] + bv[bj][1];
                    u32x4 w; w.x = cvt_pk_bf16(v0[0], v0[1]); w.y = cvt_pk_bf16(v0[2], v0[3]); w.z = cvt_pk_bf16(v1[0], v1[1]); w.w = cvt_pk_bf16(v1[2], v1[3]);
                    *(u32x4*)(rowp + bj * HALF) = w; } }
    }
};
struct EpiBf16T {
    static constexpr bool PERM = true, AFTER_DRAIN = false;
    bf16_t* O; int ntc;
    __device__ __forceinline__ void operator()(const f32x4 (&acc)[2][2][4][2], const Unit& u, int wr, int wc, int fr, int fq) const {
        bf16_t* base = O + (size_t)(fr + 16 * fq) * 8;
#pragma unroll
        for (int ai = 0; ai < 2; ++ai)
#pragma unroll
            for (int m = 0; m < 4; ++m)
#pragma unroll
                for (int bj = 0; bj < 2; ++bj) { const f32x4 v0 = acc[ai][bj][m][0], v1 = acc[ai][bj][m][1];
                    u32x4 w; w.x = cvt_pk_bf16(v0[0], v0[1]); w.y = cvt_pk_bf16(v0[2], v0[3]); w.z = cvt_pk_bf16(v1[0], v1[1]); w.w = cvt_pk_bf16(v1[2], v1[3]);
                    *(u32x4*)(base + ((size_t)(u.pm * 16 + ai * 8 + wr * 4 + m) * ntc + u.pn * 8 + bj * 4 + wc) * 512) = w; }
    }
};
struct EpiRes {
    static constexpr bool PERM = false, AFTER_DRAIN = false;
    const float* res_lat; float* out_lat; const float* res_ctx; float* out_ctx; int rows_lat; const float* gate; int b0; const float* bias;
    __device__ __forceinline__ void operator()(const f32x4 (&acc)[2][2][4][2], const Unit& u, int wr, int wc, int fr, int fq) const {
        const int trow = u.pm * BM; const float* res; float* out; int modrow;
        if (trow < rows_lat) { res = res_lat + (size_t)trow * 1024; out = out_lat + (size_t)trow * 1024; modrow = b0 + trow / 8192; }
        else { const int rc = trow - rows_lat; res = res_ctx + (size_t)rc * 1024; out = out_ctx + (size_t)rc * 1024; modrow = 4; }
        const int col0 = u.pn * BM + wc * 32 + 4 * fq; const float* gp = gate + (size_t)modrow * 6144 + col0;
#pragma unroll
        for (int bj = 0; bj < 2; ++bj) {
            f32x4 bv[2], gv[2];
#pragma unroll
            for (int n = 0; n < 2; ++n) { bv[n] = bias ? *(const f32x4*)(bias + col0 + bj * HALF + n * 16) : (f32x4){0.f, 0.f, 0.f, 0.f}; gv[n] = *(const f32x4*)(gp + bj * HALF + n * 16); }
#pragma unroll
            for (int ai = 0; ai < 2; ++ai) {
                f32x4 rs[4][2];
#pragma unroll
                for (int m = 0; m < 4; ++m)
#pragma unroll
                    for (int n = 0; n < 2; ++n) rs[m][n] = *(const f32x4*)(res + (size_t)(wr * 64 + fr + ai * HALF + m * 16) * 1024 + col0 + bj * HALF + n * 16);
#pragma unroll
                for (int m = 0; m < 4; ++m)
#pragma unroll
                    for (int n = 0; n < 2; ++n) *(f32x4*)(out + (size_t)(wr * 64 + fr + ai * HALF + m * 16) * 1024 + col0 + bj * HALF + n * 16) = rs[m][n] + gv[n] * (acc[ai][bj][m][n] + bv[n]);
                asm volatile("" ::: "memory");
            }
        }
    }
};

template <class Epi, class Sched, bool ALIGN_EPI = false, bool SP2 = false>
__device__ __forceinline__ void gemm_phase(PG8_LAS unsigned char* lds, const Gemm g, const Sched& S, const Epi& E, const int tid) {
    const int wid = __builtin_amdgcn_readfirstlane(tid >> 6), lane = tid & 63, wr = wid >> 2, wc = wid & 3, fr = lane & 15, fq = lane >> 4;
    const int K = g.K, nt = K / BK;
    unsigned voffA[2], voffB[2];
#pragma unroll
    for (int i = 0; i < 2; ++i) { int R, C; stage_rc(tid * 16 + i * 8192, R, C); const int Rb = Epi::PERM ? ((R & ~31) + perm32(R & 31)) : R;
        voffA[i] = (unsigned)(R * K + C) * 2u; voffB[i] = (unsigned)(Rb * K + C) * 2u; }
    const size_t kstep = (size_t)(BK * 2);
    const size_t hstep = (size_t)HALF * K * 2;
    const size_t tstep = 2 * hstep;
    const unsigned ldsw = (unsigned)wid * 1024u;
    const int aoff = lds_byte(wr * 64 + fr, fq * 8), boff = lds_byte(wc * 32 + fr, fq * 8);
#define PG8_SA(b, h) (((b) * 2 + (h)) * HTB)
#define PG8_SB(b, h) ((4 + (b) * 2 + (h)) * HTB)
#define PG8_STAGE(bufoff, gbase, voff) do { _Pragma("unroll") for (int _i = 0; _i < 2; ++_i) \
        __builtin_amdgcn_global_load_lds((const unsigned*)((const char*)(gbase) + (voff)[_i]), (PG8_LAS unsigned*)(lds + (bufoff) + ldsw + _i * 8192), 16, 0, 0); } while (0)
#define PG8_LDA(dst, b, h) do { _Pragma("unroll") for (int m = 0; m < 4; ++m) _Pragma("unroll") for (int k = 0; k < 2; ++k) dst[m][k] = *(const PG8_LAS bf16x8*)(lds + PG8_SA(b, h) + aoff + m * 2048 + k * 1024); } while (0)
#define PG8_LDB(dst, b, h) do { _Pragma("unroll") for (int n = 0; n < 2; ++n) _Pragma("unroll") for (int k = 0; k < 2; ++k) dst[n][k] = *(const PG8_LAS bf16x8*)(lds + PG8_SB(b, h) + boff + n * 2048 + k * 1024); } while (0)
#define PG8_MMA(ai, bj, At, Bt) do { __builtin_amdgcn_s_setprio(1); _Pragma("unroll") for (int m = 0; m < 4; ++m) _Pragma("unroll") for (int n = 0; n < 2; ++n) _Pragma("unroll") for (int k = 0; k < 2; ++k) \
        acc[ai][bj][m][n] = __builtin_amdgcn_mfma_f32_16x16x32_bf16(Bt[n][k], At[m][k], acc[ai][bj][m][n], 0, 0, 0); __builtin_amdgcn_s_setprio(0); } while (0)
#define PG8_WAIT_V(n) asm volatile("s_waitcnt vmcnt(" #n ")" ::: "memory")
#define PG8_WAIT_L(n) asm volatile("s_waitcnt lgkmcnt(" #n ")" ::: "memory")
#define PG8_BAR __builtin_amdgcn_s_barrier()
#define PG8_SCHED __builtin_amdgcn_sched_barrier(0)
    Unit cur, nxt; int ui = 0;
    if (!S.next(0, cur)) return;
    f32x4 acc[2][2][4][2];
#pragma unroll
    for (int a = 0; a < 2; ++a)
#pragma unroll
        for (int b = 0; b < 2; ++b)
#pragma unroll
            for (int m = 0; m < 4; ++m)
#pragma unroll
                for (int n = 0; n < 2; ++n) acc[a][b][m][n] = (f32x4){0.f, 0.f, 0.f, 0.f};
    bf16x8 At[4][2], B0[2][2], B1[2][2];
    const char* cA = (const char*)g.A + (size_t)cur.pm * tstep; const char* cB = (const char*)g.Bt + (size_t)cur.pn * tstep;
    S.a_ready(cur);
    if constexpr (SP2) {
        PG8_STAGE(PG8_SB(0, 0), cB, voffB); PG8_STAGE(PG8_SB(0, 1), cB + hstep, voffB); PG8_STAGE(PG8_SA(0, 0), cA, voffA); PG8_STAGE(PG8_SA(0, 1), cA + hstep, voffA);
        if (wr == 1) PG8_BAR;
        PG8_WAIT_V(2); PG8_BAR;
        PG8_STAGE(PG8_SB(1, 0), cB + kstep, voffB); PG8_STAGE(PG8_SA(1, 0), cA + kstep, voffA); PG8_STAGE(PG8_SB(1, 1), cB + hstep + kstep, voffB);
        PG8_WAIT_V(6); PG8_BAR;
    } else {
        PG8_STAGE(PG8_SB(0, 0), cB, voffB); PG8_STAGE(PG8_SA(0, 0), cA, voffA); PG8_STAGE(PG8_SB(0, 1), cB + hstep, voffB); PG8_STAGE(PG8_SA(0, 1), cA + hstep, voffA);
        if (wr == 1) PG8_BAR;
        PG8_WAIT_V(4); PG8_BAR;
        PG8_STAGE(PG8_SB(1, 0), cB + kstep, voffB); PG8_STAGE(PG8_SA(1, 0), cA + kstep, voffA); PG8_STAGE(PG8_SB(1, 1), cB + hstep + kstep, voffB);
        PG8_WAIT_V(6); PG8_BAR;
    }
    for (;;) {
        const bool has_next = S.next(ui + 1, nxt);
        const char* nA = has_next ? (const char*)g.A + (size_t)nxt.pm * tstep : cA; const char* nB = has_next ? (const char*)g.Bt + (size_t)nxt.pn * tstep : cB;
        for (int t = 0; t < nt; t += 2) {
            const bool last = (t == nt - 2);
            const char* a1 = cA + (size_t)(t + 1) * kstep;
            const char* a2 = last ? nA : cA + (size_t)(t + 2) * kstep; const char* b2 = last ? nB : cB + (size_t)(t + 2) * kstep;
            const char* a3 = a2 + kstep; const char* b3 = b2 + kstep;
            if (last && has_next) S.a_ready(nxt);
            if constexpr (SP2) {
            PG8_LDB(B0, 0, 0); PG8_LDB(B1, 0, 1); PG8_SCHED; PG8_LDA(At, 0, 0); PG8_STAGE(PG8_SA(1, 1), a1 + hstep, voffA);
            PG8_WAIT_V(8); PG8_WAIT_L(0); PG8_BAR; PG8_MMA(0, 0, At, B0); PG8_MMA(0, 1, At, B1); PG8_BAR; PG8_SCHED;
            PG8_LDA(At, 0, 1); PG8_STAGE(PG8_SB(0, 0), b2, voffB); PG8_STAGE(PG8_SB(0, 1), b2 + hstep, voffB); PG8_STAGE(PG8_SA(0, 0), a2, voffA);
            PG8_WAIT_V(8); PG8_WAIT_L(0); PG8_BAR; PG8_MMA(1, 0, At, B0); PG8_MMA(1, 1, At, B1); PG8_BAR; PG8_SCHED;
            PG8_LDB(B0, 1, 0); PG8_LDB(B1, 1, 1); PG8_SCHED; PG8_LDA(At, 1, 0); PG8_STAGE(PG8_SA(0, 1), a2 + hstep, voffA);
            PG8_WAIT_V(8); PG8_WAIT_L(0); PG8_BAR; PG8_MMA(0, 0, At, B0); PG8_MMA(0, 1, At, B1); PG8_BAR; PG8_SCHED;
            PG8_LDA(At, 1, 1); PG8_STAGE(PG8_SB(1, 0), b3, voffB); PG8_STAGE(PG8_SB(1, 1), b3 + hstep, voffB); PG8_STAGE(PG8_SA(1, 0), a3, voffA);
            PG8_WAIT_V(8); PG8_WAIT_L(0); PG8_BAR; PG8_MMA(1, 0, At, B0); PG8_MMA(1, 1, At, B1); PG8_BAR; PG8_SCHED;
            } else {
            PG8_LDB(B0, 0, 0); PG8_SCHED; PG8_LDA(At, 0, 0); PG8_STAGE(PG8_SA(1, 1), a1 + hstep, voffA);
            PG8_WAIT_L(8); PG8_BAR; PG8_WAIT_L(0); PG8_MMA(0, 0, At, B0); PG8_BAR; PG8_SCHED;
            PG8_LDB(B1, 0, 1); PG8_STAGE(PG8_SB(0, 0), b2, voffB);
            PG8_BAR; PG8_WAIT_L(0); PG8_MMA(0, 1, At, B1); PG8_BAR;
            PG8_LDA(At, 0, 1); PG8_STAGE(PG8_SA(0, 0), a2, voffA);
            PG8_BAR; PG8_WAIT_L(0); PG8_MMA(1, 0, At, B0); PG8_BAR; PG8_SCHED;
            PG8_STAGE(PG8_SB(0, 1), b2 + hstep, voffB);
            PG8_WAIT_V(6); PG8_BAR; PG8_MMA(1, 1, At, B1); PG8_BAR;
            PG8_LDB(B0, 1, 0); PG8_SCHED; PG8_LDA(At, 1, 0); PG8_STAGE(PG8_SA(0, 1), a2 + hstep, voffA);
            PG8_WAIT_L(8); PG8_BAR; PG8_WAIT_L(0); PG8_MMA(0, 0, At, B0); PG8_BAR; PG8_SCHED;
            PG8_LDB(B1, 1, 1); PG8_STAGE(PG8_SB(1, 0), b3, voffB);
            PG8_BAR; PG8_WAIT_L(0); PG8_MMA(0, 1, At, B1); PG8_BAR;
            PG8_LDA(At, 1, 1); PG8_STAGE(PG8_SA(1, 0), a3, voffA);
            PG8_BAR; PG8_WAIT_L(0); PG8_MMA(1, 0, At, B0); PG8_BAR; PG8_SCHED;
            PG8_STAGE(PG8_SB(1, 1), b3 + hstep, voffB);
            PG8_WAIT_V(6); PG8_BAR; PG8_MMA(1, 1, At, B1); PG8_BAR;
            }
        }
        if constexpr (ALIGN_EPI) { if (wr == 0) PG8_BAR; }
        if constexpr (!Epi::AFTER_DRAIN) { E(acc, cur, wr, wc, fr, fq); S.done(cur); }
        if (!has_next) break;
#pragma unroll
        for (int a = 0; a < 2; ++a)
#pragma unroll
            for (int b = 0; b < 2; ++b)
#pragma unroll
                for (int m = 0; m < 4; ++m)
#pragma unroll
                    for (int n = 0; n < 2; ++n) acc[a][b][m][n] = (f32x4){0.f, 0.f, 0.f, 0.f};
        cur = nxt; cA = nA; cB = nB; ++ui;
        if constexpr (ALIGN_EPI) { if (wr == 1) PG8_BAR; }
    }
    PG8_WAIT_V(0);
    if constexpr (!ALIGN_EPI) { if (wr == 0) PG8_BAR; }
    PG8_BAR;
#undef PG8_SA
#undef PG8_SB
#undef PG8_STAGE
#undef PG8_LDA
#undef PG8_LDB
#undef PG8_MMA
#undef PG8_WAIT_V
#undef PG8_WAIT_L
#undef PG8_BAR
#undef PG8_SCHED
}
}

constexpr int D = 1024, NB = 4, SEQ = 8192, CTXL = 256, ML = NB * SEQ, MC = NB * CTXL, MALL = ML + MC;
constexpr int FF = 2816, MI = 2048, NH = 4, DH = 512, HROWS = 2 * SEQ;
constexpr float EPS = 1e-6f, ML_NORM_EPS = 1e-5f;
constexpr float HY_MAX_DECAY = -15.350567286626973f, HY_MIN_DECAY = -3.0701134573253945f;
constexpr int NWAVES = 8, NTHR = 512;
constexpr int LDS_BYTES = 147456;

constexpr size_t MiB = 1u << 20;
constexpr size_t WS_MOD = 1 * MiB;
constexpr size_t WS_CTXX = 2 * MiB;
constexpr size_t WS_H3 = 6 * MiB;
constexpr size_t WS_KTC = 9 * MiB;
constexpr size_t WS_GWT = 11 * MiB;
constexpr size_t WS_WKQ = 11 * MiB + 256 * 1024;
constexpr size_t WS_NC = 12 * MiB;
constexpr size_t WS_WHIN = 16 * MiB, WS_WHOUT = 22 * MiB, WS_WMIN = 24 * MiB, WS_WMDN = 32 * MiB, WS_WUP0 = 36 * MiB, WS_WUP1 = 47 * MiB, WS_WDN0 = 58 * MiB, WS_WDN1 = 58 * MiB + 5767168;
constexpr size_t WS_GATES_L = 69 * MiB;
constexpr size_t WS_GATES_C = 70 * MiB;
constexpr size_t WS_GT_L = 71 * MiB;
constexpr size_t WS_GT_C = 73 * MiB;
constexpr size_t WS_GC = 73 * MiB + 512 * 1024;
constexpr size_t WS_DN = 74 * MiB;
constexpr size_t WS_RS = 79 * MiB;
constexpr size_t WS_INV = 79 * MiB + 512 * 1024;
constexpr size_t BIG = 80 * MiB;
constexpr size_t HY_H = BIG, HY_P = BIG + 66 * MiB, HY_KT = BIG + 264 * MiB, HY_ZT = BIG + 328 * MiB, HY_ZTC = BIG + 392 * MiB, HY_KS = BIG + 394 * MiB;
constexpr size_t FF_H = BIG, FF_A = BIG + 66 * MiB, FF_G = BIG + 248 * MiB;
constexpr size_t MS_H = BIG, MS_XM = BIG + 32 * MiB, MS_XC = BIG + 96 * MiB, MS_KT = BIG + 160 * MiB, MS_VT = BIG + 224 * MiB, MS_NF = BIG + 288 * MiB, MS_NB = BIG + 352 * MiB,
                 MS_KTC = BIG + 416 * MiB, MS_VTC = BIG + 420 * MiB;
constexpr size_t MS_S = MS_XM, MS_Z = MS_KT, MS_KN = MS_NF, MS_XCC = MS_NB, MS_XMC = MS_NB + 4 * MiB, MS_HC = MS_NB + 8 * MiB;
constexpr size_t WS_END = BIG + 424 * MiB;
static_assert(WS_END <= 512 * MiB, "workspace map");
static_assert(FF_G + (size_t)MALL * FF * 2 <= 512 * MiB && FF_A + (size_t)MALL * FF * 2 <= FF_G, "ffn map");
static_assert(HY_P + (size_t)MALL * 3072 * 2 <= HY_KT && HY_ZTC + (size_t)NB * D * CTXL * 2 <= HY_KS && HY_KS + 32 * MiB <= 512 * MiB, "hyena map");

__device__ __forceinline__ unsigned f2bf(float f) { unsigned u = __float_as_uint(f); return (u + 0x7fffu + ((u >> 16) & 1u)) >> 16; }
typedef __bf16 bf16x2_t __attribute__((ext_vector_type(2)));
__device__ __forceinline__ unsigned pk2(float lo, float hi) { const f32x2 v = {lo, hi}; const bf16x2_t b = __builtin_convertvector(v, bf16x2_t); return __builtin_bit_cast(unsigned, b); }
__device__ __forceinline__ float bf2f(unsigned short b) { return __uint_as_float(((unsigned)b) << 16); }
__device__ __forceinline__ float bflo(unsigned w) { return __uint_as_float(w << 16); }
__device__ __forceinline__ float bfhi(unsigned w) { return __uint_as_float(w & 0xffff0000u); }
__device__ __forceinline__ void unpack8(const u32x4 v, float (&o)[8]) { o[0] = bflo(v.x); o[1] = bfhi(v.x); o[2] = bflo(v.y); o[3] = bfhi(v.y); o[4] = bflo(v.z); o[5] = bfhi(v.z); o[6] = bflo(v.w); o[7] = bfhi(v.w); }
__device__ __forceinline__ u32x4 pack8(const float (&o)[8]) { u32x4 v; v.x = pk2(o[0], o[1]); v.y = pk2(o[2], o[3]); v.z = pk2(o[4], o[5]); v.w = pk2(o[6], o[7]); return v; }
__device__ __forceinline__ float wave_sum(float v) {
#pragma unroll
    for (int o = 1; o < 64; o <<= 1) v += __shfl_xor(v, o);
    return v;
}
__device__ __forceinline__ float silu_f(float x) { return x / (1.0f + __expf(-x)); }

typedef const float* cfptr_t;
struct Fr {
    LAS unsigned char* lds; int tid, lane, wave, gw, ngw, G, bid;
    const __attribute__((address_space(4))) cfptr_t* in; float* out; unsigned char* ws;
};
#define IN(i) (F.in[i])
enum { I_X = 0, I_C, I_CTX, I_CCTX, I_MODW, I_MODB, I_NORMG, I_FINALG, I_HWIN, I_HBIN, I_HSCW, I_HSCB, I_FW1, I_FB1, I_FW2, I_FB2, I_FW3, I_FB3, I_FWOUT, I_FREQ, I_HBIAS, I_HWOUT, I_HBOUT,
       I_MWIN, I_MCW, I_MCB, I_MWQ, I_MWK, I_MWV, I_MWG, I_MBG, I_MNW, I_MSKIP, I_MWDN, I_FWUP, I_FCW, I_FCB, I_FWDN };

__device__ __forceinline__ void transpose_item(const float* W, int K, int N, bf16* WT, LAS float* scr, int item, int lane) {
    const int nblk = N / 32, kb = item / nblk, nb = item % nblk, k0 = 64 * kb, n0 = 32 * nb;
    float tv[32];
#pragma unroll
    for (int i = 0; i < 32; ++i) tv[i] = W[(size_t)(k0 + 2 * i + (lane >> 5)) * N + n0 + (lane & 31)];
#pragma unroll
    for (int i = 0; i < 32; ++i) scr[(2 * i + (lane >> 5)) * 33 + (lane & 31)] = tv[i];
    asm volatile("s_waitcnt lgkmcnt(0)" ::: "memory");
    const int c = lane & 7;
#pragma unroll
    for (int j = 0; j < 4; ++j) { const int n = (lane >> 3) + 8 * j; const LAS float* s = scr + (8 * c) * 33 + n;
        u32x4 o; o.x = pk2(s[0 * 33], s[1 * 33]); o.y = pk2(s[2 * 33], s[3 * 33]); o.z = pk2(s[4 * 33], s[5 * 33]); o.w = pk2(s[6 * 33], s[7 * 33]);
        *(u32x4*)(WT + (size_t)(n0 + n) * K + k0 + 8 * c) = o; }
    asm volatile("s_waitcnt lgkmcnt(0)" ::: "memory");
}
__device__ __forceinline__ void transpose_matrix(Fr& F, const float* W, int K, int N, bf16* WT) {
    LAS float* scr = (LAS float*)(F.lds + F.wave * 16384);
    const int nitems = (K / 64) * (N / 32);
    for (int it = F.gw; it < nitems; it += F.ngw) transpose_item(W, K, N, WT, scr, it, F.lane);
}

__device__ __forceinline__ void transpose_group(Fr& F, int grp, int vb, int nvb) {
    unsigned char* ws = F.ws; LAS float* scr = (LAS float*)(F.lds + F.wave * 16384);
    constexpr int I0 = (D / 64) * (3 * D / 32), I1 = (D / 64) * (D / 32), I2 = (D / 64) * (2 * MI / 32), I3 = (MI / 64) * (D / 32), I4 = (D / 64) * (2 * FF / 32), I5 = (FF / 64) * (D / 32);
    const int nit = grp == 0 ? I0 : (grp == 1 ? I1 : I2 + I3 + 2 * I4 + 2 * I5);
    for (int it = vb * NWAVES + F.wave; it < nit; it += nvb * NWAVES) {
        int r = it;
        if (grp == 0) { transpose_item(IN(I_HWIN), D, 3 * D, (bf16*)(ws + WS_WHIN), scr, r, F.lane); continue; }
        if (grp == 1) { transpose_item(IN(I_HWOUT), D, D, (bf16*)(ws + WS_WHOUT), scr, r, F.lane); continue; }
        if (r < I4) { transpose_item(IN(I_FWUP), D, 2 * FF, (bf16*)(ws + WS_WUP0), scr, r, F.lane); continue; } r -= I4;
        if (r < I5) { transpose_item(IN(I_FWDN), FF, D, (bf16*)(ws + WS_WDN0), scr, r, F.lane); continue; } r -= I5;
        if (r < I2) { transpose_item(IN(I_MWIN), D, 2 * MI, (bf16*)(ws + WS_WMIN), scr, r, F.lane); continue; } r -= I2;
        if (r < I3) { transpose_item(IN(I_MWDN), MI, D, (bf16*)(ws + WS_WMDN), scr, r, F.lane); continue; } r -= I3;
        if (r < I4) { transpose_item(IN(I_FWUP) + (size_t)D * 2 * FF, D, 2 * FF, (bf16*)(ws + WS_WUP1), scr, r, F.lane); continue; } r -= I4;
        transpose_item(IN(I_FWDN) + (size_t)FF * D, FF, D, (bf16*)(ws + WS_WDN1), scr, r, F.lane);
    }
}
__device__ __forceinline__ void transpose_in_tail(Fr& F, int grp, int nunits) {
    const int busy = nunits % F.G;
    if (busy == 0) transpose_group(F, grp, F.bid, F.G);
    else if (F.bid >= busy) transpose_group(F, grp, F.bid - busy, F.G - busy);
}

__device__ __forceinline__ void mod_layer(Fr& F, int l, int vb, int nvb) {
    LAS float* sc = (LAS float*)F.lds;
    LAS float* red = (LAS float*)(F.lds + 32768);
    __syncthreads();
    for (int i = F.tid; i < 5 * 1024; i += NTHR) { const int r = i >> 10, k = i & 1023; const float v = r < 4 ? IN(I_C)[r * 1024 + k] : IN(I_CCTX)[k]; sc[i] = silu_f(v); }
    __syncthreads();
    float* mod = (float*)(F.ws + WS_MOD);
    for (int it = vb; it < 96; it += nvb) {
        const int n0 = it * 64;
        const float* w = IN(I_MODW) + (size_t)l * 1024 * 6144 + n0 + F.lane;
        float a0 = 0.f, a1 = 0.f, a2 = 0.f, a3 = 0.f, a4 = 0.f;
        const int kb = F.wave * 128;
#pragma unroll 16
        for (int k = 0; k < 128; ++k) { const float wv = w[(size_t)(kb + k) * 6144];
            a0 += sc[kb + k] * wv; a1 += sc[1024 + kb + k] * wv; a2 += sc[2048 + kb + k] * wv; a3 += sc[3072 + kb + k] * wv; a4 += sc[4096 + kb + k] * wv; }
        red[(F.wave * 5 + 0) * 64 + F.lane] = a0; red[(F.wave * 5 + 1) * 64 + F.lane] = a1; red[(F.wave * 5 + 2) * 64 + F.lane] = a2; red[(F.wave * 5 + 3) * 64 + F.lane] = a3; red[(F.wave * 5 + 4) * 64 + F.lane] = a4;
        __syncthreads();
        if (F.tid < 320) { const int r = F.tid >> 6, ln = F.tid & 63; float s = 0.f;
#pragma unroll
            for (int w8 = 0; w8 < 8; ++w8) s += red[(w8 * 5 + r) * 64 + ln];
            mod[((size_t)l * 5 + r) * 6144 + n0 + ln] = s + IN(I_MODB)[l * 6144 + n0 + ln]; }
        __syncthreads();
    }
}

__device__ __forceinline__ void ph_prologue(Fr& F) {
    unsigned char* ws = F.ws;
    transpose_group(F, 0, F.bid, F.G);
    __syncthreads();
    mod_layer(F, 0, F.bid, F.G);
    {
        float* h3 = (float*)(ws + WS_H3);
        const float* w1 = IN(I_FW1); const float* w2 = IN(I_FW2); const float* w3 = IN(I_FW3);
        const float fr = IN(I_FREQ)[F.lane], b1 = IN(I_FB1)[F.lane], b2 = IN(I_FB2)[F.lane], b3 = IN(I_FB3)[F.lane];
        for (int row = F.gw; row < SEQ + CTXL; row += F.ngw) {
            const int L = row < SEQ ? SEQ : CTXL, i = row < SEQ ? row : row - SEQ;
            const float tl = (float)i / (float)(L - 1), w = 6.283185307179586f * (float)i / (float)L;
            float pos = 0.f; const int k = F.lane;
            if (k == 0) pos = tl;
            else if (k <= 16) { const float band = 1e-4f + (float)(k - 1) * ((15.0f - 1e-4f) / 15.0f); pos = cosf(band * w); }
            else if (k <= 32) { const float band = 1e-4f + (float)(k - 17) * ((15.0f - 1e-4f) / 15.0f); pos = -sinf(band * w); }
            float s = b1;
#pragma unroll
            for (int kk = 0; kk < 33; ++kk) s += __shfl(pos, kk) * w1[kk * 64 + F.lane];
            float h = sinf(fr * s);
            s = b2;
#pragma unroll 16
            for (int kk = 0; kk < 64; ++kk) s += __shfl(h, kk) * w2[kk * 64 + F.lane];
            h = sinf(fr * s);
            s = b3;
#pragma unroll 16
            for (int kk = 0; kk < 64; ++kk) s += __shfl(h, kk) * w3[kk * 64 + F.lane];
            h = sinf(fr * s);
            h3[(size_t)row * 64 + F.lane] = h;
        }
    }
    {
        bf16* gwt = (bf16*)(ws + WS_GWT); float* wkq = (float*)(ws + WS_WKQ);
        const float* wq = IN(I_MWQ); const float* wk = IN(I_MWK); const float* wv = IN(I_MWV); const float* wg = IN(I_MWG);
        const int gt = F.bid * NTHR + F.tid, nt = F.G * NTHR;
        for (int i = gt; i < MI * 16; i += nt) { const int ch = i >> 4, g = i & 15, n = ch >> 2, c = ch & 3; float sa = 0.f, sb = 0.f;
#pragma unroll
            for (int e = 0; e < 4; ++e) { sa += wq[n * 16 + c * 4 + e] * wg[(size_t)(n * 4 + e) * 16 + g] + wk[n * 16 + c * 4 + e] * wg[(size_t)(MI + n * 4 + e) * 16 + g];
                sb += wv[n * 16 + c * 4 + e] * wg[(size_t)(2 * MI + n * 4 + e) * 16 + g]; }
            const size_t go = ((size_t)(ch >> 5) * 64 + g + 16 * ((ch & 31) >> 3)) * 8 + (ch & 7);
            gwt[go] = (bf16)f2bf(sa); gwt[go + 64 * 512] = (bf16)f2bf(sb); }
        const float sc = 0.044194173824159216f;
        for (int i = gt; i < 512 * 16; i += nt) { const int n = i >> 4, c = (i >> 2) & 3, c2 = i & 3; float s = 0.f;
#pragma unroll
            for (int e = 0; e < 4; ++e) s += wk[n * 16 + c * 4 + e] * wq[n * 16 + c2 * 4 + e];
            wkq[i] = s * sc; }
    }
}

__device__ __forceinline__ void kt_items(Fr& F, const float* h3rows, int L, float* KT, int vgw, int vngw) {
    const float* wout = IN(I_FWOUT);
    const int nitems = (L / 16) * 32, fr = F.lane & 15, fq = F.lane >> 4;
    for (int it = vgw; it < nitems; it += vngw) {
        const int t0 = (it >> 5) * 16, n0 = (it & 31) * 64;
        float a[16];
#pragma unroll
        for (int ks = 0; ks < 16; ++ks) a[ks] = h3rows[(size_t)(t0 + fr) * 64 + 4 * ks + fq];
#pragma unroll
        for (int nt = 0; nt < 4; ++nt) {
            f32x4 acc = (f32x4){0.f, 0.f, 0.f, 0.f};
#pragma unroll
            for (int ks = 0; ks < 16; ++ks) acc = __builtin_amdgcn_mfma_f32_16x16x4f32(a[ks], wout[(size_t)(4 * ks + fq) * 2048 + n0 + nt * 16 + fr], acc, 0, 0, 0);
            const int n = n0 + nt * 16 + fr, dirn = n >> 10, c = n & 1023;
            const float delta = fabsf(HY_MIN_DECAY + (float)c * ((HY_MAX_DECAY - HY_MIN_DECAY) / 1023.0f)), il = 1.0f / (float)(L - 1);
            f32x4 o;
#pragma unroll
            for (int r = 0; r < 4; ++r) o[r] = acc[r] * __expf(-(float)(t0 + 4 * fq + r) * il * delta);
            *(f32x4*)(KT + ((size_t)c * 2 + dirn) * L + t0 + 4 * fq) = o;
        }
    }
}

__device__ __forceinline__ void modnorm_row(const float* xrow, const float* g, const float* sh, const float* sc, bf16* orow, int lane) {
    const f32x4* xr = (const f32x4*)xrow + lane; f32x4 v[4]; float s = 0.f;
#pragma unroll
    for (int j = 0; j < 4; ++j) { v[j] = xr[64 * j]; s += (v[j][0] * v[j][0] + v[j][1] * v[j][1]) + (v[j][2] * v[j][2] + v[j][3] * v[j][3]); }
    const float rinv = 1.0f / sqrtf(wave_sum(s) * (1.0f / 1024.0f) + EPS);
    u32x2* o8 = (u32x2*)orow + lane;
#pragma unroll
    for (int j = 0; j < 4; ++j) { const int c = 4 * lane + 256 * j; const f32x4 gg = *(const f32x4*)(g + c), s1 = *(const f32x4*)(sc + c), s0 = *(const f32x4*)(sh + c);
        const f32x4 y = (v[j] * rinv * gg) * (1.0f + s1) + s0; u32x2 w; w.x = pk2(y[0], y[1]); w.y = pk2(y[2], y[3]); o8[64 * j] = w; }
}
__device__ __forceinline__ void ph_modnorm(Fr& F, const float* xlat, int nlat, int b0, const float* xctx, int nctx, const float* g, const float* modl, int shoff, bf16* H) {
    const int nrows = nlat + nctx;
    for (int r = F.gw; r < nrows; r += 2 * F.ngw) {
        const int r2 = r + F.ngw; const bool has2 = r2 < nrows; const int rb = has2 ? r2 : r;
        const bool isl = r < nlat, isl2 = rb < nlat;
        const float* xa = isl ? xlat + (size_t)r * 1024 : xctx + (size_t)(r - nlat) * 1024; const float* xb = isl2 ? xlat + (size_t)rb * 1024 : xctx + (size_t)(rb - nlat) * 1024;
        const int ma = isl ? b0 + r / SEQ : 4, mb = isl2 ? b0 + rb / SEQ : 4;
        const f32x4* pa = (const f32x4*)xa + F.lane; const f32x4* pb = (const f32x4*)xb + F.lane; f32x4 va[4], vb[4]; float sa = 0.f, sb = 0.f;
#pragma unroll
        for (int j = 0; j < 4; ++j) { va[j] = pa[64 * j]; vb[j] = pb[64 * j]; }
#pragma unroll
        for (int j = 0; j < 4; ++j) { sa += (va[j][0] * va[j][0] + va[j][1] * va[j][1]) + (va[j][2] * va[j][2] + va[j][3] * va[j][3]); sb += (vb[j][0] * vb[j][0] + vb[j][1] * vb[j][1]) + (vb[j][2] * vb[j][2] + vb[j][3] * vb[j][3]); }
        const float ra = 1.0f / sqrtf(wave_sum(sa) * (1.0f / 1024.0f) + EPS), rbv = 1.0f / sqrtf(wave_sum(sb) * (1.0f / 1024.0f) + EPS);
        const float* sha = modl + (size_t)ma * 6144 + shoff; const float* shb = modl + (size_t)mb * 6144 + shoff;
        u32x2* oa = (u32x2*)(H + (size_t)r * 1024) + F.lane; u32x2* ob = (u32x2*)(H + (size_t)rb * 1024) + F.lane;
#pragma unroll
        for (int j = 0; j < 4; ++j) { const int c = 4 * F.lane + 256 * j; const f32x4 gg = *(const f32x4*)(g + c);
            const f32x4 ya = (va[j] * ra * gg) * (1.0f + *(const f32x4*)(sha + 1024 + c)) + *(const f32x4*)(sha + c);
            const f32x4 yb = (vb[j] * rbv * gg) * (1.0f + *(const f32x4*)(shb + 1024 + c)) + *(const f32x4*)(shb + c);
            oa[64 * j] = (u32x2){pk2(ya[0], ya[1]), pk2(ya[2], ya[3])};
            if (has2) ob[64 * j] = (u32x2){pk2(yb[0], yb[1]), pk2(yb[2], yb[3])}; }
    }
}

__device__ __forceinline__ void zt_items(Fr& F, const bf16* P, int rowbase, int nb, int Ls, bf16* ZT) {
    LAS unsigned char* tile = F.lds + F.wave * 16384;
    const float* scw = IN(I_HSCW); const float* scb = IN(I_HSCB);
    const int ntt = Ls / 64, nitems = nb * ntt * 16, tl = F.lane >> 3, c8 = F.lane & 7;
    for (int it = F.gw; it < nitems; it += F.ngw) {
        const int ct = it & 15, tt = (it >> 4) % ntt, b = (it >> 4) / ntt, t0 = tt * 64, ch = ct * 64 + c8 * 8;
        float w1[3][8], w2[3][8], b1[8], b2[8];
#pragma unroll
        for (int k = 0; k < 3; ++k) { const f32x4 a0 = *(const f32x4*)(scw + k * 3072 + 1024 + ch), a1 = *(const f32x4*)(scw + k * 3072 + 1024 + ch + 4), d0 = *(const f32x4*)(scw + k * 3072 + 2048 + ch), d1 = *(const f32x4*)(scw + k * 3072 + 2048 + ch + 4);
#pragma unroll
            for (int e = 0; e < 4; ++e) { w1[k][e] = a0[e]; w1[k][4 + e] = a1[e]; w2[k][e] = d0[e]; w2[k][4 + e] = d1[e]; } }
        { const f32x4 a0 = *(const f32x4*)(scb + 1024 + ch), a1 = *(const f32x4*)(scb + 1024 + ch + 4), d0 = *(const f32x4*)(scb + 2048 + ch), d1 = *(const f32x4*)(scb + 2048 + ch + 4);
#pragma unroll
            for (int e = 0; e < 4; ++e) { b1[e] = a0[e]; b1[4 + e] = a1[e]; b2[e] = d0[e]; b2[4 + e] = d1[e]; } }
        const bf16* pb = P + (size_t)(rowbase + b * Ls) * 3072 + ch;
#pragma unroll 2
        for (int i8 = 0; i8 < 8; ++i8) {
            const int tloc = i8 * 8 + tl, t = t0 + tloc, tm = t > 0 ? t - 1 : t, tp = t + 1 < Ls ? t + 1 : t; const float mm = t > 0 ? 1.f : 0.f, mp = t + 1 < Ls ? 1.f : 0.f;
            const u32x4 r1m = *(const u32x4*)(pb + (size_t)tm * 3072 + 1024), r1c = *(const u32x4*)(pb + (size_t)t * 3072 + 1024), r1p = *(const u32x4*)(pb + (size_t)tp * 3072 + 1024);
            const u32x4 r2m = *(const u32x4*)(pb + (size_t)tm * 3072 + 2048), r2c = *(const u32x4*)(pb + (size_t)t * 3072 + 2048), r2p = *(const u32x4*)(pb + (size_t)tp * 3072 + 2048);
            float xm[8], xc[8], xp[8], vm[8], vc[8], vp[8];
            unpack8(r1m, xm); unpack8(r1c, xc); unpack8(r1p, xp); unpack8(r2m, vm); unpack8(r2c, vc); unpack8(r2p, vp);
#pragma unroll
            for (int e = 0; e < 8; ++e) { const float a = w1[0][e] * (xm[e] * mm) + w1[1][e] * xc[e] + w1[2][e] * (xp[e] * mp) + b1[e], d = w2[0][e] * (vm[e] * mm) + w2[1][e] * vc[e] + w2[2][e] * (vp[e] * mp) + b2[e];
                *(LAS bf16*)(tile + (c8 * 8 + e) * 136 + tloc * 2) = (bf16)f2bf(a * d); }
        }
#pragma unroll
        for (int q = 0; q < 8; ++q) { const int cc = q * 8 + (F.lane >> 3), chk = F.lane & 7;
            const u32x2 lo = *(const LAS u32x2*)(tile + cc * 136 + chk * 16), hi = *(const LAS u32x2*)(tile + cc * 136 + chk * 16 + 8);
            u32x4 o; o.x = lo.x; o.y = lo.y; o.z = hi.x; o.w = hi.y;
            *(u32x4*)(ZT + ((size_t)b * 1024 + ct * 64 + cc) * Ls + t0 + chk * 8) = o; }
    }
}

__device__ __forceinline__ f32x2 cmul(f32x2 a, f32x2 b) { return (f32x2){a.x * b.x - a.y * b.y, a.x * b.y + a.y * b.x}; }
__device__ __forceinline__ f32x2 cmulc(f32x2 a, f32x2 b) { return (f32x2){a.x * b.x + a.y * b.y, a.y * b.x - a.x * b.y}; }
__device__ __forceinline__ f32x2 twid(float f) { return (f32x2){__builtin_amdgcn_cosf(f), __builtin_amdgcn_sinf(f)}; }
#define PH(e) ((e) + ((e) >> 4))
__device__ __forceinline__ void fft_fwd(LAS f32x2* buf, int tid, int plo, int phi) {
#pragma unroll 1
    for (int p = plo; p < phi; ++p) {
        const int lq = 12 - 2 * p, q = 1 << lq; const float invN = 1.0f / (float)(4 * q);
#pragma unroll 2
        for (int m = 0; m < 8; ++m) {
            const int g = tid + 512 * m, i = g & (q - 1), i0 = ((g >> lq) << (lq + 2)) + i;
            const int e0 = PH(i0), e1 = PH(i0 + q), e2 = PH(i0 + 2 * q), e3 = PH(i0 + 3 * q);
            const f32x2 a0 = buf[e0], a1 = buf[e1], a2 = buf[e2], a3 = buf[e3];
            const f32x2 t0 = a0 + a2, t1 = a0 - a2, t2 = a1 + a3, d = a1 - a3, t3 = (f32x2){d.y, -d.x};
            const f32x2 w1 = twid(-(float)i * invN), w2 = cmul(w1, w1), w3 = cmul(w2, w1);
            buf[e0] = t0 + t2; buf[e1] = cmul(t1 + t3, w1); buf[e2] = cmul(t0 - t2, w2); buf[e3] = cmul(t1 - t3, w3);
        }
        __syncthreads();
    }
}
__device__ __forceinline__ void fft_inv(LAS f32x2* buf, int tid, int plo, int phi) {
#pragma unroll 1
    for (int p = phi - 1; p >= plo; --p) {
        const int lq = 12 - 2 * p, q = 1 << lq; const float invN = 1.0f / (float)(4 * q);
#pragma unroll 2
        for (int m = 0; m < 8; ++m) {
            const int g = tid + 512 * m, i = g & (q - 1), i0 = ((g >> lq) << (lq + 2)) + i;
            const int e0 = PH(i0), e1 = PH(i0 + q), e2 = PH(i0 + 2 * q), e3 = PH(i0 + 3 * q);
            const f32x2 w1 = twid((float)i * invN), w2 = cmul(w1, w1), w3 = cmul(w2, w1);
            const f32x2 b0 = buf[e0], b1 = cmul(buf[e1], w1), b2 = cmul(buf[e2], w2), b3 = cmul(buf[e3], w3);
            const f32x2 t0 = b0 + b2, t1 = b0 - b2, t2 = b1 + b3, d = b1 - b3, t3 = (f32x2){-d.y, d.x};
            buf[e0] = t0 + t2; buf[e1] = t1 + t3; buf[e2] = t0 - t2; buf[e3] = t1 - t3;
        }
        __syncthreads();
    }
}
__device__ __forceinline__ void fwd16_A(f32x2 (&x)[16]) {
    const float C1 = 0.92387953251128674f, S1 = 0.38268343236508977f, R2 = 0.70710678118654752f;
#pragma unroll
    for (int i = 0; i < 4; ++i) {
        const f32x2 a0 = x[i], a1 = x[i + 4], a2 = x[i + 8], a3 = x[i + 12];
        const f32x2 t0 = a0 + a2, t1 = a0 - a2, t2 = a1 + a3, d = a1 - a3, t3 = (f32x2){d.y, -d.x};
        const f32x2 y1 = t1 + t3, y2 = t0 - t2, y3 = t1 - t3;
        x[i] = t0 + t2;
        if (i == 0) { x[4] = y1; x[8] = y2; x[12] = y3; }
        else if (i == 1) { x[5] = cmul(y1, (f32x2){C1, -S1}); x[9] = cmul(y2, (f32x2){R2, -R2}); x[13] = cmul(y3, (f32x2){S1, -C1}); }
        else if (i == 2) { x[6] = cmul(y1, (f32x2){R2, -R2}); x[10] = (f32x2){y2.y, -y2.x}; x[14] = cmul(y3, (f32x2){-R2, -R2}); }
        else { x[7] = cmul(y1, (f32x2){S1, -C1}); x[11] = cmul(y2, (f32x2){-R2, -R2}); x[15] = cmul(y3, (f32x2){-C1, S1}); }
    }
}
__device__ __forceinline__ void fwd16_B(f32x2 (&x)[16]) {
#pragma unroll
    for (int g = 0; g < 4; ++g) {
        const f32x2 a0 = x[4 * g], a1 = x[4 * g + 1], a2 = x[4 * g + 2], a3 = x[4 * g + 3];
        const f32x2 t0 = a0 + a2, t1 = a0 - a2, t2 = a1 + a3, d = a1 - a3, t3 = (f32x2){d.y, -d.x};
        x[4 * g] = t0 + t2; x[4 * g + 1] = t1 + t3; x[4 * g + 2] = t0 - t2; x[4 * g + 3] = t1 - t3;
    }
}
__device__ __forceinline__ void inv16_B(f32x2 (&x)[16]) {
#pragma unroll
    for (int g = 0; g < 4; ++g) {
        const f32x2 b0 = x[4 * g], b1 = x[4 * g + 1], b2 = x[4 * g + 2], b3 = x[4 * g + 3];
        const f32x2 t0 = b0 + b2, t1 = b0 - b2, t2 = b1 + b3, d = b1 - b3, t3 = (f32x2){-d.y, d.x};
        x[4 * g] = t0 + t2; x[4 * g + 1] = t1 + t3; x[4 * g + 2] = t0 - t2; x[4 * g + 3] = t1 - t3;
    }
}
__device__ __forceinline__ void inv16_A(f32x2 (&x)[16]) {
    const float C1 = 0.92387953251128674f, S1 = 0.38268343236508977f, R2 = 0.70710678118654752f;
#pragma unroll
    for (int i = 0; i < 4; ++i) {
        f32x2 b0 = x[i], b1 = x[i + 4], b2 = x[i + 8], b3 = x[i + 12];
        if (i == 1) { b1 = cmul(b1, (f32x2){C1, S1}); b2 = cmul(b2, (f32x2){R2, R2}); b3 = cmul(b3, (f32x2){S1, C1}); }
        else if (i == 2) { b1 = cmul(b1, (f32x2){R2, R2}); b2 = (f32x2){-b2.y, b2.x}; b3 = cmul(b3, (f32x2){-R2, R2}); }
        else if (i == 3) { b1 = cmul(b1, (f32x2){S1, C1}); b2 = cmul(b2, (f32x2){-R2, R2}); b3 = cmul(b3, (f32x2){-C1, -S1}); }
        const f32x2 t0 = b0 + b2, t1 = b0 - b2, t2 = b1 + b3, d = b1 - b3, t3 = (f32x2){-d.y, d.x};
        x[i] = t0 + t2; x[i + 4] = t1 + t3; x[i + 8] = t0 - t2; x[i + 12] = t1 - t3;
    }
}
__device__ __forceinline__ void fwd16(f32x2 (&x)[16]) { fwd16_A(x); fwd16_B(x); }
__device__ __forceinline__ void inv16(f32x2 (&x)[16]) { inv16_B(x); inv16_A(x); }
__device__ __forceinline__ void r16_fwd2(LAS f32x2* buf, int tid) {
#pragma unroll 1
  for (int lqp = 8; lqp >= 4; lqp -= 4) {
    const int qp = 1 << lqp; const float inv = 1.0f / (float)(16 * qp);
#pragma unroll
    for (int m = 0; m < 2; ++m) {
        const int g = tid + 512 * m, i = g & (qp - 1), e0 = ((g >> lqp) << (lqp + 4)) + i; f32x2 x[16];
#pragma unroll
        for (int j = 0; j < 16; ++j) x[j] = buf[PH(e0 + (j << lqp))];
        const f32x2 w1 = twid(-(float)i * inv), w2 = cmul(w1, w1), w3 = cmul(w2, w1), v1 = cmul(w2, w2), v2 = cmul(v1, v1), v3 = cmul(v2, v1);
        fwd16_A(x);
#pragma unroll
        for (int l = 0; l < 4; ++l) { x[l + 4] = cmul(x[l + 4], w1); x[l + 8] = cmul(x[l + 8], w2); x[l + 12] = cmul(x[l + 12], w3); }
        fwd16_B(x);
#pragma unroll
        for (int k = 0; k < 4; ++k) { x[4 * k + 1] = cmul(x[4 * k + 1], v1); x[4 * k + 2] = cmul(x[4 * k + 2], v2); x[4 * k + 3] = cmul(x[4 * k + 3], v3); }
#pragma unroll
        for (int j = 0; j < 16; ++j) buf[PH(e0 + (j << lqp))] = x[j];
    }
    __syncthreads();
  }
}
__device__ __forceinline__ void r16_inv2(LAS f32x2* buf, int tid) {
#pragma unroll 1
  for (int lqp = 4; lqp <= 8; lqp += 4) {
    const int qp = 1 << lqp; const float inv = 1.0f / (float)(16 * qp);
#pragma unroll
    for (int m = 0; m < 2; ++m) {
        const int g = tid + 512 * m, i = g & (qp - 1), e0 = ((g >> lqp) << (lqp + 4)) + i; f32x2 x[16];
#pragma unroll
        for (int j = 0; j < 16; ++j) x[j] = buf[PH(e0 + (j << lqp))];
        const f32x2 w1 = twid((float)i * inv), w2 = cmul(w1, w1), w3 = cmul(w2, w1), v1 = cmul(w2, w2), v2 = cmul(v1, v1), v3 = cmul(v2, v1);
#pragma unroll
        for (int k = 0; k < 4; ++k) { x[4 * k + 1] = cmul(x[4 * k + 1], v1); x[4 * k + 2] = cmul(x[4 * k + 2], v2); x[4 * k + 3] = cmul(x[4 * k + 3], v3); }
        inv16_B(x);
#pragma unroll
        for (int l = 0; l < 4; ++l) { x[l + 4] = cmul(x[l + 4], w1); x[l + 8] = cmul(x[l + 8], w2); x[l + 12] = cmul(x[l + 12], w3); }
        inv16_A(x);
#pragma unroll
        for (int j = 0; j < 16; ++j) buf[PH(e0 + (j << lqp))] = x[j];
    }
    __syncthreads();
  }
}
__device__ __forceinline__ float block_sum(Fr& F, float v, LAS float* red) {
    v = wave_sum(v);
    __syncthreads();
    if (F.lane == 0) red[F.wave] = v;
    __syncthreads();
    float s = 0.f;
#pragma unroll
    for (int w = 0; w < 8; ++w) s += red[w];
    return s;
}
__device__ __forceinline__ void ph_fftconv(Fr& F) {
    LAS f32x2* buf = (LAS f32x2*)F.lds; LAS float* red = (LAS float*)(F.lds + 139392);
    const float* KT = (const float*)(F.ws + HY_KT); const float* KTC = (const float*)(F.ws + WS_KTC);
    bf16* ZT = (bf16*)(F.ws + HY_ZT); bf16* ZTC = (bf16*)(F.ws + HY_ZTC);
    const int tid = F.tid;
    for (int c = F.bid; c < 1024; c += F.G) {
        const float bias = IN(I_HBIAS)[c];
        __syncthreads();
        float asum = 0.f;
        const f32x4* kf = (const f32x4*)(KT + (size_t)c * 2 * SEQ); const f32x4* kb = kf + SEQ / 4;
#pragma unroll
        for (int q = 0; q < 4; ++q) { const int i4 = tid + 512 * q; const f32x4 v = kf[i4];
            asum += fabsf(v[0]) + fabsf(v[1]) + fabsf(v[2]) + fabsf(v[3]);
            buf[PH(4 * i4)] = (f32x2){v[0], 0.f}; buf[PH(4 * i4 + 1)] = (f32x2){v[1], 0.f}; buf[PH(4 * i4 + 2)] = (f32x2){v[2], 0.f}; buf[PH(4 * i4 + 3)] = (f32x2){v[3], 0.f};
            const f32x4 u = kb[i4]; const int m = 4 * i4;
            if (m > 0) { buf[PH(16384 - m)] = (f32x2){u[0], 0.f}; asum += fabsf(u[0]); } else buf[PH(8192)] = (f32x2){0.f, 0.f};
            buf[PH(16384 - m - 1)] = (f32x2){u[1], 0.f}; buf[PH(16384 - m - 2)] = (f32x2){u[2], 0.f}; buf[PH(16384 - m - 3)] = (f32x2){u[3], 0.f};
            asum += fabsf(u[1]) + fabsf(u[2]) + fabsf(u[3]); }
        const float S = block_sum(F, asum, red);
        __syncthreads();
        fft_fwd(buf, tid, 0, 1); r16_fwd2(buf, tid);
        f32x4* Ks = (f32x4*)(F.ws + HY_KS) + (size_t)(F.bid & 255) * 8192 + tid * 8; const float ksc = 1.0f / (S * 16384.0f);
#pragma unroll 1
        for (int m = 0; m < 2; ++m) { const int pb = 17 * (tid + 512 * m); f32x2 x[16];
#pragma unroll
            for (int n = 0; n < 16; ++n) x[n] = buf[pb + n];
            fwd16(x);
#pragma unroll
            for (int n = 0; n < 8; ++n) Ks[m * 4096 + n] = (f32x4){x[2 * n].x * ksc, x[2 * n].y * ksc, x[2 * n + 1].x * ksc, x[2 * n + 1].y * ksc}; }
        const f32x2 dl = twid(-1.0f / 16384.0f);
#pragma unroll 1
        for (int pr = 0; pr < 2; ++pr) {
            bf16* z0 = ZT + ((size_t)(2 * pr) * 1024 + c) * SEQ; bf16* z1 = ZT + ((size_t)(2 * pr + 1) * 1024 + c) * SEQ;
            const int i8 = tid * 8;
            __syncthreads();
            {
                float a[8], b[8], cx[8], dx[8];
                unpack8(*(const u32x4*)(z0 + i8), a); unpack8(*(const u32x4*)(z1 + i8), b); unpack8(*(const u32x4*)(z0 + 4096 + i8), cx); unpack8(*(const u32x4*)(z1 + 4096 + i8), dx);
                f32x2 w1 = twid(-(float)i8 * (1.0f / 16384.0f));
#pragma unroll
                for (int e = 0; e < 8; ++e) { const f32x2 a0 = (f32x2){a[e], b[e]}, a1 = (f32x2){cx[e], dx[e]}, t3 = (f32x2){a1.y, -a1.x}; const f32x2 w2 = cmul(w1, w1), w3 = cmul(w2, w1);
                    buf[PH(i8 + e)] = a0 + a1; buf[PH(4096 + i8 + e)] = cmul(a0 + t3, w1); buf[PH(8192 + i8 + e)] = cmul(a0 - a1, w2); buf[PH(12288 + i8 + e)] = cmul(a0 - t3, w3);
                    w1 = cmul(w1, dl); }
            }
            __syncthreads();
            r16_fwd2(buf, tid);
#pragma unroll 1
            for (int m = 0; m < 2; ++m) { const int pb = 17 * (tid + 512 * m); f32x2 x[16];
#pragma unroll
                for (int n = 0; n < 16; ++n) x[n] = buf[pb + n];
                fwd16(x);
#pragma unroll
                for (int n = 0; n < 8; ++n) { const f32x4 k = Ks[m * 4096 + n]; x[2 * n] = cmul(x[2 * n], (f32x2){k[0], k[1]}); x[2 * n + 1] = cmul(x[2 * n + 1], (f32x2){k[2], k[3]}); }
                inv16(x);
#pragma unroll
                for (int n = 0; n < 16; ++n) buf[pb + n] = x[n]; }
            __syncthreads();
            r16_inv2(buf, tid);
            {
                float a[8], b[8], cx[8], dx[8];
                unpack8(*(const u32x4*)(z0 + i8), a); unpack8(*(const u32x4*)(z1 + i8), b); unpack8(*(const u32x4*)(z0 + 4096 + i8), cx); unpack8(*(const u32x4*)(z1 + 4096 + i8), dx);
                f32x2 w1 = twid(-(float)i8 * (1.0f / 16384.0f));
#pragma unroll
                for (int e = 0; e < 8; ++e) { const f32x2 w2 = cmul(w1, w1), w3 = cmul(w2, w1);
                    const f32x2 b0 = buf[PH(i8 + e)], b1 = cmulc(buf[PH(4096 + i8 + e)], w1), b2 = cmulc(buf[PH(8192 + i8 + e)], w2), b3 = cmulc(buf[PH(12288 + i8 + e)], w3);
                    const f32x2 t0 = b0 + b2, t1 = b0 - b2, t2 = b1 + b3, d = b1 - b3, t3 = (f32x2){-d.y, d.x};
                    const f32x2 y0 = t0 + t2, y1 = t1 + t3;
                    a[e] = y0.x + a[e] * bias; b[e] = y0.y + b[e] * bias; cx[e] = y1.x + cx[e] * bias; dx[e] = y1.y + dx[e] * bias;
                    w1 = cmul(w1, dl); }
                *(u32x4*)(z0 + i8) = pack8(a); *(u32x4*)(z1 + i8) = pack8(b); *(u32x4*)(z0 + 4096 + i8) = pack8(cx); *(u32x4*)(z1 + 4096 + i8) = pack8(dx);
            }
        }
        __syncthreads();
        {
            LAS float* kc = (LAS float*)F.lds; LAS float* zc = kc + 512;
            const float* kfc = KTC + (size_t)c * 2 * CTXL; float v = 0.f;
            { const int n = tid; if (n < 256) v = kfc[n]; else if (n == 256) v = 0.f; else v = kfc[CTXL + (512 - n)]; kc[n] = v; }
            const float Sc = block_sum(F, fabsf(v), red);
            for (int i = tid; i < 1024; i += NTHR) { const int b = i >> 8, t = i & 255; zc[i] = bf2f(ZTC[((size_t)b * 1024 + c) * CTXL + t]); }
            __syncthreads();
            const int b = tid >> 7, t2 = tid & 127; const float isc = 1.0f / Sc;
#pragma unroll
            for (int hh = 0; hh < 2; ++hh) { const int t = t2 + 128 * hh; float acc = 0.f;
#pragma unroll 8
                for (int s = 0; s < 256; ++s) acc += zc[b * 256 + s] * kc[(t - s) & 511];
                ZTC[((size_t)b * 1024 + c) * CTXL + t] = (bf16)f2bf(acc * isc + zc[b * 256 + t] * bias); }
        }
    }
}

__device__ __forceinline__ void u2_items(Fr& F, const bf16* P, int rowbase, int nb, int Ls, const bf16* YT, bf16* U2) {
    LAS unsigned char* tile = F.lds + F.wave * 16384;
    const float* scw = IN(I_HSCW); const float* scb = IN(I_HSCB);
    const int ntt = Ls / 64, nitems = nb * ntt * 16, tl = F.lane >> 3, c8 = F.lane & 7;
    for (int it = F.gw; it < nitems; it += F.ngw) {
        const int ct = it & 15, tt = (it >> 4) % ntt, b = (it >> 4) / ntt, t0 = tt * 64, ch = ct * 64 + c8 * 8;
#pragma unroll
        for (int q = 0; q < 8; ++q) { const int cc = q * 8 + (F.lane >> 3), chk = F.lane & 7;
            const u32x4 v = *(const u32x4*)(YT + ((size_t)b * 1024 + ct * 64 + cc) * Ls + t0 + chk * 8);
            *(LAS u32x2*)(tile + cc * 136 + chk * 16) = (u32x2){v.x, v.y}; *(LAS u32x2*)(tile + cc * 136 + chk * 16 + 8) = (u32x2){v.z, v.w}; }
        float w0[3][8], bb[8];
#pragma unroll
        for (int k = 0; k < 3; ++k) { const f32x4 a0 = *(const f32x4*)(scw + k * 3072 + ch), a1 = *(const f32x4*)(scw + k * 3072 + ch + 4);
#pragma unroll
            for (int e = 0; e < 4; ++e) { w0[k][e] = a0[e]; w0[k][4 + e] = a1[e]; } }
        { const f32x4 a0 = *(const f32x4*)(scb + ch), a1 = *(const f32x4*)(scb + ch + 4);
#pragma unroll
            for (int e = 0; e < 4; ++e) { bb[e] = a0[e]; bb[4 + e] = a1[e]; } }
        const bf16* pb = P + (size_t)(rowbase + b * Ls) * 3072 + ch; bf16* ub = U2 + (size_t)(rowbase + b * Ls) * 1024 + ch;
#pragma unroll 2
        for (int i8 = 0; i8 < 8; ++i8) {
            const int tloc = i8 * 8 + tl, t = t0 + tloc, tm = t > 0 ? t - 1 : t, tp = t + 1 < Ls ? t + 1 : t; const float mm = t > 0 ? 1.f : 0.f, mp = t + 1 < Ls ? 1.f : 0.f;
            const u32x4 rm = *(const u32x4*)(pb + (size_t)tm * 3072), rc = *(const u32x4*)(pb + (size_t)t * 3072), rp = *(const u32x4*)(pb + (size_t)tp * 3072);
            float xm[8], xc[8], xp[8], o[8];
            unpack8(rm, xm); unpack8(rc, xc); unpack8(rp, xp);
#pragma unroll
            for (int e = 0; e < 8; ++e) { const float x0 = w0[0][e] * (xm[e] * mm) + w0[1][e] * xc[e] + w0[2][e] * (xp[e] * mp) + bb[e]; o[e] = x0 * bf2f(*(const LAS bf16*)(tile + (c8 * 8 + e) * 136 + tloc * 2)); }
            *(u32x4*)(ub + (size_t)t * 1024) = pack8(o);
        }
    }
}

__device__ __forceinline__ void dw_item(const bf16* G, bf16* A, const float* cw, const float* cb, int f8, int rowtok0, int nx, int x0, bool up_ok, bool down_ok) {
    float w[9][8], bias[8];
#pragma unroll
    for (int k = 0; k < 9; ++k) { const float m = (k < 3) ? (up_ok ? 1.f : 0.f) : ((k >= 6) ? (down_ok ? 1.f : 0.f) : 1.f);
        const f32x4 w0 = *(const f32x4*)(cw + (size_t)k * FF + f8) * m, w1 = *(const f32x4*)(cw + (size_t)k * FF + f8 + 4) * m;
        w[k][0] = w0[0]; w[k][1] = w0[1]; w[k][2] = w0[2]; w[k][3] = w0[3]; w[k][4] = w1[0]; w[k][5] = w1[1]; w[k][6] = w1[2]; w[k][7] = w1[3]; }
    { const f32x4 b0 = *(const f32x4*)(cb + f8), b1 = *(const f32x4*)(cb + f8 + 4); bias[0] = b0[0]; bias[1] = b0[1]; bias[2] = b0[2]; bias[3] = b0[3]; bias[4] = b1[0]; bias[5] = b1[1]; bias[6] = b1[2]; bias[7] = b1[3]; }
    const int upo = up_ok ? -nx : 0, dno = down_ok ? nx : 0;
    const bf16* g0 = G + (size_t)rowtok0 * FF + f8; bf16* a0 = A + (size_t)rowtok0 * FF + f8;
    const u32x4 zero4 = (u32x4){0u, 0u, 0u, 0u};
    u32x4 cm[3], cc[3], cp[3];
    { const int xm = x0 > 0 ? x0 - 1 : 0; const bool okm = x0 > 0;
        cm[0] = *(const u32x4*)(g0 + (size_t)(xm + upo) * FF); cm[1] = *(const u32x4*)(g0 + (size_t)xm * FF); cm[2] = *(const u32x4*)(g0 + (size_t)(xm + dno) * FF);
        if (!okm) { cm[0] = zero4; cm[1] = zero4; cm[2] = zero4; }
        cc[0] = *(const u32x4*)(g0 + (size_t)(x0 + upo) * FF); cc[1] = *(const u32x4*)(g0 + (size_t)x0 * FF); cc[2] = *(const u32x4*)(g0 + (size_t)(x0 + dno) * FF); }
#pragma unroll 4
    for (int j = 0; j < 32; ++j) {
        const int x = x0 + j, xp = x + 1 < nx ? x + 1 : nx - 1; const bool okp = x + 1 < nx;
        cp[0] = *(const u32x4*)(g0 + (size_t)(xp + upo) * FF); cp[1] = *(const u32x4*)(g0 + (size_t)xp * FF); cp[2] = *(const u32x4*)(g0 + (size_t)(xp + dno) * FF);
        const u32x4 av = *(const u32x4*)(a0 + (size_t)x * FF);
        if (!okp) { cp[0] = zero4; cp[1] = zero4; cp[2] = zero4; }
        float acc[8];
#pragma unroll
        for (int e = 0; e < 8; ++e) acc[e] = bias[e];
#pragma unroll
        for (int dy = 0; dy < 3; ++dy) { float v[8];
            unpack8(cm[dy], v);
#pragma unroll
            for (int e = 0; e < 8; ++e) acc[e] += v[e] * w[dy * 3 + 0][e];
            unpack8(cc[dy], v);
#pragma unroll
            for (int e = 0; e < 8; ++e) acc[e] += v[e] * w[dy * 3 + 1][e];
            unpack8(cp[dy], v);
#pragma unroll
            for (int e = 0; e < 8; ++e) acc[e] += v[e] * w[dy * 3 + 2][e]; }
        float a[8]; unpack8(av, a);
#pragma unroll
        for (int e = 0; e < 8; ++e) a[e] = silu_f(acc[e]) * a[e];
        *(u32x4*)(a0 + (size_t)x * FF) = pack8(a);
#pragma unroll
        for (int dy = 0; dy < 3; ++dy) { cm[dy] = cc[dy]; cc[dy] = cp[dy]; }
    }
}
__device__ __forceinline__ void ph_dwconv(Fr& F, int layer, int nlat, int nctx) {
    bf16* A = (bf16*)(F.ws + FF_A); const bf16* G = (const bf16*)(F.ws + FF_G);
    const float* cw = IN(I_FCW) + (size_t)layer * 9 * FF; const float* cb = IN(I_FCB) + (size_t)layer * FF;
    const int ngrp = (F.G % 8 == 0) ? 8 : 1, xg = F.bid % ngrp, lb = F.bid / ngrp, nlb = F.G / ngrp;
    const int nseg = nlat / 32, band = nseg / ngrp;
    for (int i = lb * NTHR + F.tid; i < band * 352; i += nlb * NTHR) {
        const int sl = i / 352, f8 = (i - sl * 352) * 8, seg = xg * band + sl, grow = seg >> 1, gy = grow & 127;
        dw_item(G, A, cw, cb, f8, grow * 64, 64, (seg & 1) * 32, gy > 0, gy < 127);
    }
    const int nsegc = nctx / 32;
    for (int i = F.bid * NTHR + F.tid; i < nsegc * 352; i += F.G * NTHR) {
        const int sl = i / 352, f8 = (i - sl * 352) * 8;
        dw_item(G, A, cw, cb, f8, nlat + (sl >> 3) * CTXL, CTXL, (sl & 7) * 32, false, false);
    }
}

__device__ __forceinline__ void prep_items(Fr& F, const bf16* XM, int nb, int Ls, bf16* XC, bf16* KN, bf16* KT, bf16* VT) {
    LAS unsigned char* tk = F.lds + F.wave * 17408; LAS unsigned char* tv = tk + 8704;
    const int ntt = Ls / 64, nitems = nb * ntt * 32;
    const int tl = F.lane >> 3, c8 = F.lane & 7;
    for (int it = F.gw; it < nitems; it += F.ngw) {
        const int cg = it & 31, tt = (it >> 5) % ntt, b = (it >> 5) / ntt, t0 = tt * 64, ch0 = cg * 64 + c8 * 8, h = cg >> 3;
        float cw0[8], cw1[8], cw2[8], cbb[8], wkq[32], wv[32];
        { const float* p = IN(I_MCW) + ch0; const float* pb = IN(I_MCB) + ch0;
#pragma unroll
            for (int e = 0; e < 8; ++e) { cw0[e] = p[e]; cw1[e] = p[MI + e]; cw2[e] = p[2 * MI + e]; cbb[e] = pb[e]; }
            const float* q = (const float*)(F.ws + WS_WKQ) + (ch0 >> 2) * 16; const float* v = IN(I_MWV) + (ch0 >> 2) * 16;
#pragma unroll
            for (int e = 0; e < 32; ++e) { wkq[e] = q[e]; wv[e] = v[e]; } }
#pragma unroll 2
        for (int i8 = 0; i8 < 8; ++i8) {
            const int tloc = i8 * 8 + tl, t = t0 + tloc; const size_t row = (size_t)b * Ls + t;
            float xp[8], xm[8], xn[8];
            const size_t rowp = row - (t > 0 ? 1 : 0), rown = row + (t + 1 < Ls ? 1 : 0); const size_t ctile = (size_t)(ch0 >> 5) * 512 + ((ch0 & 31) >> 3) * 128;
            const u32x4 rm = *(const u32x4*)(XM + (row >> 4) * 32768 + ctile + (row & 15) * 8), rp = *(const u32x4*)(XM + (rowp >> 4) * 32768 + ctile + (rowp & 15) * 8), rn = *(const u32x4*)(XM + (rown >> 4) * 32768 + ctile + (rown & 15) * 8);
            unpack8(rm, xm); unpack8(rp, xp); unpack8(rn, xn);
            { const float mp = t > 0 ? 1.f : 0.f, mn = t + 1 < Ls ? 1.f : 0.f;
#pragma unroll
                for (int e = 0; e < 8; ++e) { xp[e] *= mp; xn[e] *= mn; } }
            float xc[8], kp[8], vv[8];
#pragma unroll
            for (int e = 0; e < 8; ++e) xc[e] = silu_f(cw0[e] * xp[e] + cw1[e] * xm[e] + cw2[e] * xn[e] + cbb[e]);
#pragma unroll
            for (int n = 0; n < 2; ++n)
#pragma unroll
                for (int o = 0; o < 4; ++o) { float sk = 0.f, sv = 0.f;
#pragma unroll
                    for (int c = 0; c < 4; ++c) { sk += xc[n * 4 + c] * wkq[n * 16 + c * 4 + o]; sv += xm[n * 4 + c] * wv[n * 16 + c * 4 + o]; }
                    kp[n * 4 + o] = sk; vv[n * 4 + o] = sv; }
            { const size_t to = ((size_t)(row >> 4) * 64 + (ch0 >> 5)) * 512 + (((unsigned)row & 15u) + 16u * ((ch0 & 31) >> 3)) * 8u;
              *(u32x4*)(XC + to) = pack8(xc); *(u32x4*)(KN + to) = pack8(kp); }
#pragma unroll
            for (int e = 0; e < 8; ++e) { *(LAS bf16*)(tk + (c8 * 8 + e) * 136 + tloc * 2) = (bf16)f2bf(kp[e]); *(LAS bf16*)(tv + (c8 * 8 + e) * 136 + tloc * 2) = (bf16)f2bf(vv[e]); }
        }
#pragma unroll
        for (int q = 0; q < 8; ++q) { const int dt = q >> 1, kq = q & 1, r = F.lane & 15, q4 = F.lane >> 4;
            const size_t tile = ((size_t)(t0 >> 7) * 32 + (cg & 7) * 4 + dt) * 4 + ((t0 & 127) >> 5) + kq;
            const size_t o = (size_t)(b * 4 + h) * 512 * Ls + tile * 512 + F.lane * 8;
            { const u32x2 lo = *(const LAS u32x2*)(tk + (dt * 16 + r) * 136 + kq * 64 + q4 * 16), hi = *(const LAS u32x2*)(tk + (dt * 16 + r) * 136 + kq * 64 + q4 * 16 + 8); *(u32x4*)(KT + o) = (u32x4){lo.x, lo.y, hi.x, hi.y}; }
            { const u32x2 lo = *(const LAS u32x2*)(tv + (dt * 16 + r) * 136 + kq * 64 + q4 * 16), hi = *(const LAS u32x2*)(tv + (dt * 16 + r) * 136 + kq * 64 + q4 * 16 + 8); *(u32x4*)(VT + o) = (u32x4){lo.x, lo.y, hi.x, hi.y}; }
        }
    }
}

__device__ __forceinline__ void gate_items(Fr& F, const bf16* XC, const bf16* XM, int R, float* GATES) {
    const bf16* gwt = (const bf16*)(F.ws + WS_GWT);
    const int fr = F.lane & 15, fq = F.lane >> 4, half = F.wave & 1, pr = F.wave >> 1, ntiles = R / 16;
    LAS f32x4* xch = (LAS f32x4*)(F.lds + pr * 1024);
    for (int base = F.bid * 4; base < ntiles; base += F.G * 4) {
        const int tile = base + pr; const bool ok = tile < ntiles; const int tl = ok ? tile : 0;
        f32x4 acc = (f32x4){0.f, 0.f, 0.f, 0.f};
        const bf16* ap = (half ? XM : XC) + (size_t)tl * 32768 + F.lane * 8; const bf16* bp = gwt + (size_t)half * 64 * 512 + F.lane * 8;
#pragma unroll 16
        for (int ks = 0; ks < 64; ++ks) acc = __builtin_amdgcn_mfma_f32_16x16x32_bf16(*(const bf16x8*)(ap + ks * 512), *(const bf16x8*)(bp + ks * 512), acc, 0, 0, 0);
        __syncthreads();
        if (half) xch[F.lane] = acc;
        __syncthreads();
        if (!half && ok) { acc = acc + xch[F.lane];
            const int r0 = tile * 16; const float bg = IN(I_MBG)[fr]; const bool isf = (fr >> 2) & 1;
#pragma unroll
            for (int r = 0; r < 4; ++r) { float x = acc[r] + bg; if (isf) x = fminf(x, 0.f) - log1pf(__expf(-fabsf(x))); GATES[(size_t)(r0 + 4 * fq + r) * 16 + fr] = x; } }
    }
}

__device__ __forceinline__ void cum_items(Fr& F, const float* GATES, int nb, int Ls, int gb0, int ctau0, f32x4* GT, float* GC) {
    const int R = nb * Ls, nch = Ls / 128, nitems = 2 * nb * 4 * nch;
    for (int it = F.gw; it < nitems; it += F.ngw) {
        const int c = it % nch, h = (it / nch) & 3, b = (it / nch / 4) % nb, dir = it / nch / 4 / nb;
        const int row0 = b * Ls + c * 128 + 2 * F.lane;
        const float lf0 = GATES[(size_t)row0 * 16 + dir * 8 + 4 + h], lf1 = GATES[(size_t)(row0 + 1) * 16 + dir * 8 + 4 + h];
        const float ig0 = GATES[(size_t)row0 * 16 + dir * 8 + h], ig1 = GATES[(size_t)(row0 + 1) * 16 + dir * 8 + h];
        float inc = lf0 + lf1;
#pragma unroll
        for (int o = 1; o < 64; o <<= 1) { const float t = __shfl_up(inc, o); if (F.lane >= o) inc += t; }
        const float tot = __shfl(inc, 63), exc = inc - (lf0 + lf1);
        float b0, b1;
        if (dir == 0) { b0 = exc + lf0; b1 = inc; } else { b0 = tot - exc; b1 = tot - exc - lf0; }
        GT[(size_t)(dir * 4 + h) * R + row0] = (f32x4){b0, ig0 - b0, __expf(b0), __expf(tot - b0 + ig0)};
        GT[(size_t)(dir * 4 + h) * R + row0 + 1] = (f32x4){b1, ig1 - b1, __expf(b1), __expf(tot - b1 + ig1)};
        if (F.lane == 0) GC[((size_t)(dir * 4 + gb0 + b) * 4 + h) * 66 + ctau0 + c] = __expf(tot);
    }
}

__device__ __forceinline__ void cum_block(Fr& F, const float* GATES, int grow0, int h, f32x4* GT0, f32x4* GT1, float* GC0, float* GC1, LAS float* tab) {
    if (F.wave < 2) {
        const int dir = F.wave, j0 = 2 * F.lane;
        const float* gp = GATES + (size_t)(grow0 + j0) * 16 + dir * 8 + h;
        const float ig0 = gp[0], lf0 = gp[4], ig1 = gp[16], lf1 = gp[20];
        float inc = lf0 + lf1;
#pragma unroll
        for (int o = 1; o < 64; o <<= 1) { const float t = __shfl_up(inc, o); if (F.lane >= o) inc += t; }
        const float tot = __shfl(inc, 63), exc = inc - (lf0 + lf1);
        float b0, b1;
        if (dir == 0) { b0 = exc + lf0; b1 = inc; } else { b0 = tot - exc; b1 = tot - exc - lf0; }
        const float w0 = __expf(tot - b0 + ig0), w1 = __expf(tot - b1 + ig1);
        f32x4* gt = (dir ? GT1 : GT0) + grow0 + j0;
        gt[0] = (f32x4){b0, ig0 - b0, __expf(b0), w0}; gt[1] = (f32x4){b1, ig1 - b1, __expf(b1), w1};
        LAS float* t = tab + dir * 384;
        t[j0] = b0; t[j0 + 1] = b1; t[128 + j0] = ig0 - b0; t[128 + j0 + 1] = ig1 - b1; t[256 + j0] = w0; t[256 + j0 + 1] = w1;
        if (F.lane == 0) *(dir ? GC1 : GC0) = __expf(tot);
    }
}
__device__ __forceinline__ void dn_block(Fr& F, const bf16* KTchunk, const LAS float* tab, float* DN0, float* DN1) {
    const LAS float* w0 = tab + 256; const LAS float* w1 = tab + 384 + 256;
    const bf16* kr = KTchunk + (size_t)(F.tid >> 4) * 4 * 512 + (F.tid & 15) * 8; float s0 = 0.f, s1 = 0.f;
#pragma unroll 4
    for (int q = 0; q < 16; ++q) { const int ks = q >> 2, q4 = q & 3; float v[8]; unpack8(*(const u32x4*)(kr + ks * 512 + q4 * 128), v);
#pragma unroll
        for (int e = 0; e < 8; ++e) { s0 += v[e] * w0[q * 8 + e]; s1 += v[e] * w1[q * 8 + e]; } }
    DN0[F.tid] = s0; DN1[F.tid] = s1;
}
__device__ __forceinline__ void ph_sphase(Fr& F, int hb, bool with_ctx) {
    const bf16* XC = (const bf16*)(F.ws + MS_XC); const bf16* KN = (const bf16*)(F.ws + MS_KN); const bf16* KT = (const bf16*)(F.ws + MS_KT);
    f32x4* GT = (f32x4*)(F.ws + WS_GT_L); float* DN = (float*)(F.ws + WS_DN); float* RS = (float*)(F.ws + WS_RS); float* GC = (float*)(F.ws + WS_GC);
    const float* GATES = (const float*)(F.ws + WS_GATES_L);
    bf16* S = (bf16*)(F.ws + MS_S);
    LAS float* tab = (LAS float*)(F.lds + 1024);
    const int fr = F.lane & 15, fq = F.lane >> 4, w = F.wave;
    for (int it = F.bid; it < 512; it += F.G) {
        const int c = it & 63, h = (it >> 6) & 3, bl = it >> 8, gb = 2 * hb + bl;
        const int row0 = bl * SEQ + c * 128;
        __syncthreads();
        cum_block(F, GATES, row0, h, GT + (size_t)(0 * 4 + h) * HROWS, GT + (size_t)(1 * 4 + h) * HROWS,
                  GC + ((size_t)(0 * 4 + gb) * 4 + h) * 66 + 2 + c, GC + ((size_t)(1 * 4 + gb) * 4 + h) * 66 + 2 + c, tab);
        __syncthreads();
        dn_block(F, KT + (size_t)(bl * 4 + h) * 512 * SEQ + (size_t)c * 65536, tab,
                 DN + (((size_t)(0 * 4 + gb) * 4 + h) * 66 + 2 + c) * 512, DN + (((size_t)(1 * 4 + gb) * 4 + h) * 66 + 2 + c) * 512);
        const int irow = row0 + 16 * w + fr;
        bf16x8 bq[16];
        { const bf16* p = XC + ((size_t)((row0 >> 4) + w) * 64 + h * 16) * 512 + F.lane * 8;
#pragma unroll
            for (int ks = 0; ks < 16; ++ks) bq[ks] = *(const bf16x8*)(p + ks * 512); }
        const float bif = tab[16 * w + fr], bib = tab[384 + 16 * w + fr];
        float rsf = 0.f, rsb = 0.f;
        bf16* sf = S + ((size_t)(0 * 8 + bl * 4 + h) * 64 + c) * 16384; bf16* sb = S + ((size_t)(1 * 8 + bl * 4 + h) * 64 + c) * 16384;
#pragma unroll 1
        for (int jt = 0; jt < 8; ++jt) {
            f32x4 acc = (f32x4){0.f, 0.f, 0.f, 0.f};
            const bf16* ap = KN + ((size_t)((row0 >> 4) + jt) * 64 + h * 16) * 512 + F.lane * 8;
#pragma unroll
            for (int ks = 0; ks < 16; ++ks) acc = __builtin_amdgcn_mfma_f32_16x16x32_bf16(*(const bf16x8*)(ap + ks * 512), bq[ks], acc, 0, 0, 0);
            float vf[4], vb[4];
            const f32x4 af4 = *(const LAS f32x4*)(tab + 128 + jt * 16 + 4 * fq), ab4 = *(const LAS f32x4*)(tab + 384 + 128 + jt * 16 + 4 * fq);
#pragma unroll
            for (int r = 0; r < 4; ++r) { const int j = jt * 16 + 4 * fq + r, i = 16 * w + fr;
                vf[r] = (j <= i) ? acc[r] * __expf(bif + af4[r]) : 0.f; vb[r] = (j >= i) ? acc[r] * __expf(bib + ab4[r]) : 0.f;
                rsf += vf[r]; rsb += vb[r]; }
            const size_t so = (size_t)(w * 4 + (jt >> 1)) * 512 + (fr + 16 * ((jt & 1) * 2 + (fq >> 1))) * 8 + (fq & 1) * 4;
            *(u32x2*)(sf + so) = (u32x2){pk2(vf[0], vf[1]), pk2(vf[2], vf[3])};
            *(u32x2*)(sb + so) = (u32x2){pk2(vb[0], vb[1]), pk2(vb[2], vb[3])};
        }
        rsf += __shfl_xor(rsf, 16); rsf += __shfl_xor(rsf, 32); rsb += __shfl_xor(rsb, 16); rsb += __shfl_xor(rsb, 32);
        if (fq == 0) { RS[(size_t)(0 * 4 + h) * HROWS + irow] = rsf; RS[(size_t)(1 * 4 + h) * HROWS + irow] = rsb; }
    }
    if (with_ctx) {
        const bf16* KTC2 = (const bf16*)(F.ws + MS_KTC); f32x4* GTC = (f32x4*)(F.ws + WS_GT_C); const float* GATESC = (const float*)(F.ws + WS_GATES_C);
        for (int it = F.bid; it < 32; it += F.G) {
            const int cc = it & 1, h = (it >> 1) & 3, gb = it >> 3;
            __syncthreads();
            cum_block(F, GATESC, gb * CTXL + cc * 128, h, GTC + (size_t)(0 * 4 + h) * MC, GTC + (size_t)(1 * 4 + h) * MC,
                      GC + ((size_t)(0 * 4 + gb) * 4 + h) * 66 + cc, GC + ((size_t)(1 * 4 + gb) * 4 + h) * 66 + cc, tab);
            __syncthreads();
            dn_block(F, KTC2 + (size_t)(gb * 4 + h) * 512 * CTXL + (size_t)cc * 65536, tab,
                     DN + (((size_t)(0 * 4 + gb) * 4 + h) * 66 + cc) * 512, DN + (((size_t)(1 * 4 + gb) * 4 + h) * 66 + cc) * 512);
        }
    }
}

__device__ __forceinline__ bf16x8 ldg16(const char* ub, unsigned off) { return *(const bf16x8*)(ub + off); }
__device__ __forceinline__ void ph_scan(Fr& F, int hb) {
    const char* XC = (const char*)(F.ws + MS_XC); const char* KT = (const char*)(F.ws + MS_KT); const char* VT = (const char*)(F.ws + MS_VT);
    const char* KTC2 = (const char*)(F.ws + MS_KTC); const char* VTC2 = (const char*)(F.ws + MS_VTC);
    const char* S = (const char*)(F.ws + MS_S);
    const f32x4* GTL = (const f32x4*)(F.ws + WS_GT_L); const f32x4* GTC = (const f32x4*)(F.ws + WS_GT_C);
    const float* GC = (const float*)(F.ws + WS_GC); const float* DN = (const float*)(F.ws + WS_DN);
    float* NC = (float*)(F.ws + WS_NC);
    LAS unsigned char* cbf = F.lds;
    LAS float* wl = (LAS float*)(F.lds + 2 * 33280);
    LAS unsigned char* vtb = F.lds + 2 * 33280 + 1024;
    const int w = F.wave;
    for (int wi = F.bid; wi < 256; wi += F.G) {
        const int chain = wi & 15, slice = wi >> 4, dir = chain >> 3, bl = (chain >> 2) & 1, h = chain & 3, gb = 2 * hb + bl, e0 = slice * 32;
        char* NUM = (char*)(F.ws + (dir ? MS_NB : MS_NF));
        const bool nwriter = (slice == 0) && (w == 0);
        f32x4 acc[4][2];
#pragma unroll
        for (int a = 0; a < 4; ++a)
#pragma unroll
            for (int b = 0; b < 2; ++b) acc[a][b] = (f32x4){0.f, 0.f, 0.f, 0.f};
        float nreg[8];
#pragma unroll
        for (int e = 0; e < 8; ++e) nreg[e] = 0.f;
        const char* ktc = KTC2 + (size_t)(gb * 4 + h) * 512 * CTXL * 2; const char* vtc = VTC2 + (size_t)(gb * 4 + h) * 512 * CTXL * 2;
        const char* ktl = KT + (size_t)(bl * 4 + h) * 512 * SEQ * 2;    const char* vtl = VT + (size_t)(bl * 4 + h) * 512 * SEQ * 2;
        const f32x4* gtc = GTC + (size_t)(dir * 4 + h) * MC + gb * CTXL; const f32x4* gtl = GTL + (size_t)(dir * 4 + h) * HROWS + bl * SEQ;
        const float* gcb = GC + ((size_t)(dir * 4 + gb) * 4 + h) * 66; const float* dnb = DN + ((size_t)(dir * 4 + gb) * 4 + h) * 66 * 512;
#pragma unroll 1
        for (int s = 0; s < 2; ++s) {
            const int cc = dir == 0 ? s : 1 - s; const unsigned l16 = F.lane * 16u, fq = F.lane >> 4;
            __syncthreads();
            if (F.tid < 128) wl[F.tid] = gtc[cc * 128 + F.tid][3];
            __syncthreads();
            const float Gd = gcb[cc]; const char* ktu = ktc + (size_t)cc * 131072; const char* vtu = vtc + (size_t)cc * 131072 + (e0 >> 4) * 4096;
#pragma unroll
            for (int a = 0; a < 4; ++a)
#pragma unroll
                for (int b = 0; b < 2; ++b) acc[a][b] = acc[a][b] * Gd;
#pragma unroll
            for (int ks = 0; ks < 4; ++ks) {
                bf16x8 bv[2];
#pragma unroll
                for (int et = 0; et < 2; ++et) { float v[8]; unpack8(__builtin_bit_cast(u32x4, ldg16(vtu + et * 4096 + ks * 1024, l16)), v);
#pragma unroll
                    for (int e = 0; e < 8; ++e) v[e] *= wl[ks * 32 + 8 * fq + e];
                    const u32x4 pv = pack8(v); bv[et] = __builtin_bit_cast(bf16x8, pv); }
#pragma unroll
                for (int dt = 0; dt < 4; ++dt) { const bf16x8 kk = ldg16(ktu + (4 * w + dt) * 4096 + ks * 1024, l16);
#pragma unroll
                    for (int et = 0; et < 2; ++et) acc[dt][et] = __builtin_amdgcn_mfma_f32_16x16x32_bf16(kk, bv[et], acc[dt][et], 0, 0, 0); }
            }
            { const unsigned lo = F.lane * 32u; const f32x4 d0 = *(const f32x4*)((const char*)(dnb + cc * 512) + lo), d1 = *(const f32x4*)((const char*)(dnb + cc * 512) + lo + 16u);
                nreg[0] = Gd * nreg[0] + d0[0]; nreg[1] = Gd * nreg[1] + d0[1]; nreg[2] = Gd * nreg[2] + d0[2]; nreg[3] = Gd * nreg[3] + d0[3];
                nreg[4] = Gd * nreg[4] + d1[0]; nreg[5] = Gd * nreg[5] + d1[1]; nreg[6] = Gd * nreg[6] + d1[2]; nreg[7] = Gd * nreg[7] + d1[3]; }
        }
        const int cfirst = dir == 0 ? 0 : 63;
        bf16x8 xf[16];
        __syncthreads();
        { const int fr = F.lane & 15, fq = F.lane >> 4; const unsigned l16 = F.lane * 16u;
#pragma unroll
            for (int dt = 0; dt < 4; ++dt)
#pragma unroll
                for (int et = 0; et < 2; ++et) *(LAS u32x2*)(cbf + (16 * et + fr) * 1040 + (64 * w + 16 * dt + 4 * fq) * 2) = (u32x2){pk2(acc[dt][et][0], acc[dt][et][1]), pk2(acc[dt][et][2], acc[dt][et][3])};
            if (F.tid < 128) wl[F.tid] = gtl[cfirst * 128 + F.tid][3];
            *(LAS bf16x8*)(vtb + w * 1024 + l16) = ldg16(vtl + (size_t)cfirst * 131072 + (e0 >> 4) * 4096 + w * 1024, l16);
            const char* xc0 = XC + ((size_t)(((bl * SEQ + cfirst * 128) >> 4) + w) * 64 + h * 16) * 1024;
#pragma unroll
            for (int ks = 0; ks < 16; ++ks) xf[ks] = ldg16(xc0 + ks * 1024, l16); }
        __syncthreads();
#pragma unroll 1
        for (int q = 0; q < 64; ++q) {
            int tid_ = F.tid; asm volatile("" : "+v"(tid_));
            const int lane_ = tid_ & 63, fr = lane_ & 15, fq = lane_ >> 4; const unsigned l16 = lane_ * 16u;
            const int c = dir == 0 ? q : 63 - q;
            const int qn = q < 63 ? q + 1 : 63, cn = dir == 0 ? qn : 63 - qn;
            const int qp = q < 62 ? q + 2 : 63, cp = dir == 0 ? qp : 63 - qp;
            const char* ktu = ktl + (size_t)c * 131072;
            const int row0 = bl * SEQ + c * 128;
            const float Gd = gcb[2 + c];
            LAS unsigned char* cb_rd = cbf + (q & 1) * 33280; LAS unsigned char* cb_wr = cbf + ((q + 1) & 1) * 33280;
            const LAS float* wl_rd = wl + (q & 1) * 128; LAS float* wl_wr = wl + ((q + 1) & 1) * 128;
            const LAS unsigned char* vt_rd = vtb + (q & 1) * 8192; LAS unsigned char* vt_wr = vtb + ((q + 1) & 1) * 8192;
            const bf16x8 vnext = ldg16(vtl + (size_t)cn * 131072 + (e0 >> 4) * 4096 + w * 1024, l16);
            const float wnext = *(const float*)((const char*)(gtl + cn * 128) + (unsigned)(tid_ & 127) * 16u + 12u);
            const float Ei = *(const float*)((const char*)(gtl + c * 128 + 16 * w) + (unsigned)fr * 16u + 8u);
            const f32x4 dn0 = *(const f32x4*)((const char*)(dnb + (2 + c) * 512) + lane_ * 32u), dn1 = *(const f32x4*)((const char*)(dnb + (2 + c) * 512) + lane_ * 32u + 16u);
            bf16x8 kf[4][4], vf[2][4], sfr[4];
            { const char* su = S + ((size_t)(dir * 8 + bl * 4 + h) * 64 + c) * 32768 + w * 4096;
#pragma unroll
                for (int ks = 0; ks < 4; ++ks) sfr[ks] = ldg16(su + ks * 1024, l16); }
#pragma unroll
            for (int dt = 0; dt < 4; ++dt) kf[0][dt] = ldg16(ktu + (4 * w + dt) * 4096, l16);
            unsigned pf;
            {
                const char* kt3 = ktl + (size_t)cp * 131072; const char* vt3 = vtl + (size_t)cp * 131072;
                const char* xc3 = XC + ((size_t)((bl * SEQ + cp * 128) >> 4) * 64 + h * 16) * 1024; const char* s3p = S + ((size_t)(dir * 8 + bl * 4 + h) * 64 + cp) * 32768;
                const unsigned t = tid_ < 208 ? tid_ : tid_ - 208; const bool g0 = t < 64, g1 = t < 128, g2 = t < 192;
                const unsigned ln2 = slice * 64 + (t - 128);
                const char* ub = g0 ? kt3 : (g1 ? vt3 : (g2 ? xc3 : s3p));
                const unsigned off = g0 ? (slice * 64 + t) * 128u : (g1 ? (e0 >> 4) * 4096u + (t - 64) * 128u : (g2 ? (ln2 >> 7) * 65536u + (ln2 & 127) * 128u : (slice * 16 + ((t - 192) & 15)) * 128u));
                pf = *(const volatile unsigned*)(ub + off);
            }
#pragma unroll
            for (int et = 0; et < 2; ++et)
#pragma unroll
                for (int ks = 0; ks < 4; ++ks) vf[et][ks] = *(const LAS bf16x8*)(vt_rd + (et * 4 + ks) * 1024 + l16);
            if (nwriter) { char* np = (char*)(NC + (((size_t)(dir * 2 + bl) * 4 + h) * 64 + c) * 512); const unsigned lo = lane_ * 32u;
                *(f32x4*)(np + lo) = (f32x4){nreg[0], nreg[1], nreg[2], nreg[3]}; *(f32x4*)(np + lo + 16u) = (f32x4){nreg[4], nreg[5], nreg[6], nreg[7]}; }
            f32x4 a2[2] = {(f32x4){0.f, 0.f, 0.f, 0.f}, (f32x4){0.f, 0.f, 0.f, 0.f}};
#pragma unroll
            for (int ks = 0; ks < 16; ++ks)
#pragma unroll
                for (int et = 0; et < 2; ++et) a2[et] = __builtin_amdgcn_mfma_f32_16x16x32_bf16(*(const LAS bf16x8*)(cb_rd + (16 * et + fr) * 1040 + ks * 64 + fq * 16), xf[ks], a2[et], 0, 0, 0);
            asm volatile("" ::: "memory");
#pragma unroll
            for (int ks = 1; ks < 4; ++ks)
#pragma unroll
                for (int dt = 0; dt < 4; ++dt) kf[ks][dt] = ldg16(ktu + (4 * w + dt) * 4096 + ks * 1024, l16);
            a2[0] = a2[0] * Ei; a2[1] = a2[1] * Ei;
#pragma unroll
            for (int ks = 0; ks < 4; ++ks)
#pragma unroll
                for (int et = 0; et < 2; ++et) a2[et] = __builtin_amdgcn_mfma_f32_16x16x32_bf16(vf[et][ks], sfr[ks], a2[et], 0, 0, 0);
            { char* nu = NUM + ((size_t)row0 * MI + h * 512 + e0) * 2; const unsigned ln = ((16u * w + fr) * MI + 4u * fq) * 2u;
#pragma unroll
                for (int et = 0; et < 2; ++et) *(u32x2*)(nu + et * 32 + ln) = (u32x2){pk2(a2[et][0], a2[et][1]), pk2(a2[et][2], a2[et][3])}; }
#pragma unroll
            for (int a = 0; a < 4; ++a)
#pragma unroll
                for (int b = 0; b < 2; ++b) acc[a][b] = acc[a][b] * Gd;
#pragma unroll
            for (int ks = 0; ks < 4; ++ks) {
                bf16x8 bv[2];
#pragma unroll
                for (int et = 0; et < 2; ++et) { float v[8]; unpack8(__builtin_bit_cast(u32x4, vf[et][ks]), v);
                    const f32x4 wa = *(const LAS f32x4*)(wl_rd + ks * 32 + 8 * fq), wb = *(const LAS f32x4*)(wl_rd + ks * 32 + 8 * fq + 4);
                    v[0] *= wa[0]; v[1] *= wa[1]; v[2] *= wa[2]; v[3] *= wa[3]; v[4] *= wb[0]; v[5] *= wb[1]; v[6] *= wb[2]; v[7] *= wb[3];
                    const u32x4 pv = pack8(v); bv[et] = __builtin_bit_cast(bf16x8, pv); }
#pragma unroll
                for (int dt = 0; dt < 4; ++dt)
#pragma unroll
                    for (int et = 0; et < 2; ++et) acc[dt][et] = __builtin_amdgcn_mfma_f32_16x16x32_bf16(kf[ks][dt], bv[et], acc[dt][et], 0, 0, 0);
            }
            asm volatile("" ::: "memory");
            { const char* xc2 = XC + ((size_t)(((bl * SEQ + cn * 128) >> 4) + w) * 64 + h * 16) * 1024;
#pragma unroll
                for (int ks = 0; ks < 16; ++ks) xf[ks] = ldg16(xc2 + ks * 1024, l16); }
            nreg[0] = Gd * nreg[0] + dn0[0]; nreg[1] = Gd * nreg[1] + dn0[1]; nreg[2] = Gd * nreg[2] + dn0[2]; nreg[3] = Gd * nreg[3] + dn0[3];
            nreg[4] = Gd * nreg[4] + dn1[0]; nreg[5] = Gd * nreg[5] + dn1[1]; nreg[6] = Gd * nreg[6] + dn1[2]; nreg[7] = Gd * nreg[7] + dn1[3];
            *(LAS bf16x8*)(vt_wr + w * 1024 + l16) = vnext;
            wl_wr[tid_ & 127] = wnext;
#pragma unroll
            for (int dt = 0; dt < 4; ++dt)
#pragma unroll
                for (int et = 0; et < 2; ++et) *(LAS u32x2*)(cb_wr + (16 * et + fr) * 1040 + (64 * w + 16 * dt + 4 * fq) * 2) = (u32x2){pk2(acc[dt][et][0], acc[dt][et][1]), pk2(acc[dt][et][2], acc[dt][et][3])};
            asm volatile("" :: "v"(pf));
            __syncthreads();
        }
    }
}

__device__ __forceinline__ void ph_mout(Fr& F) {
    bf16* NF = (bf16*)(F.ws + MS_NF); const bf16* NBk = (const bf16*)(F.ws + MS_NB); const bf16* XC = (const bf16*)(F.ws + MS_XC); const bf16* Z = (const bf16*)(F.ws + MS_Z);
    const float* NC = (const float*)(F.ws + WS_NC); const float* RS = (const float*)(F.ws + WS_RS); const f32x4* GTL = (const f32x4*)(F.ws + WS_GT_L);
    LAS unsigned char* xt = F.lds + F.wave * 16640;
    for (int it = F.gw; it < (HROWS / 16) * 4; it += F.ngw) {
        const int rt = it >> 2, h = it & 3, bl = rt >> 9, c = (rt >> 3) & 63;
        { const bf16* xp = XC + ((size_t)rt * 64 + h * 16) * 512 + F.lane * 8; u32x4 t[16];
#pragma unroll
            for (int ks = 0; ks < 16; ++ks) t[ks] = *(const u32x4*)(xp + ks * 512);
#pragma unroll
            for (int ks = 0; ks < 16; ++ks) *(LAS u32x4*)(xt + ks * 1040 + F.lane * 16) = t[ks]; }
        const float* n0 = NC + (((size_t)(0 * 2 + bl) * 4 + h) * 64 + c) * 512 + 8 * F.lane; const float* n1 = NC + (((size_t)(1 * 2 + bl) * 4 + h) * 64 + c) * 512 + 8 * F.lane;
        const f32x4 n00 = *(const f32x4*)n0, n01 = *(const f32x4*)(n0 + 4), n10 = *(const f32x4*)n1, n11 = *(const f32x4*)(n1 + 4);
        float nw[8], sk[8];
        { const float* pw = IN(I_MNW) + h * 512 + 8 * F.lane; const float* ps = IN(I_MSKIP) + h * 512 + 8 * F.lane;
#pragma unroll
            for (int e = 0; e < 8; ++e) { nw[e] = pw[e]; sk[e] = ps[e]; } }
#pragma unroll 2
        for (int r = 0; r < 16; ++r) {
            const int row = rt * 16 + r; const size_t o = (size_t)row * MI + h * 512 + 8 * F.lane;
            float nf[8], nb[8], xc[8], z[8];
            unpack8(*(const u32x4*)(NF + o), nf); unpack8(*(const u32x4*)(NBk + o), nb); unpack8(*(const u32x4*)(Z + o), z);
            unpack8(*(const LAS u32x4*)(xt + (F.lane >> 2) * 1040 + (r + 16 * (F.lane & 3)) * 16), xc);
            float d0 = xc[0] * n00[0] + xc[1] * n00[1] + xc[2] * n00[2] + xc[3] * n00[3] + xc[4] * n01[0] + xc[5] * n01[1] + xc[6] * n01[2] + xc[7] * n01[3];
            float d1 = xc[0] * n10[0] + xc[1] * n10[1] + xc[2] * n10[2] + xc[3] * n10[3] + xc[4] * n11[0] + xc[5] * n11[1] + xc[6] * n11[2] + xc[7] * n11[3];
            d0 = wave_sum(d0); d1 = wave_sum(d1);
            const float den0 = GTL[(size_t)(0 * 4 + h) * HROWS + row][2] * d0 + RS[(size_t)(0 * 4 + h) * HROWS + row], den1 = GTL[(size_t)(1 * 4 + h) * HROWS + row][2] * d1 + RS[(size_t)(1 * 4 + h) * HROWS + row];
            const float i0 = 1.0f / fmaxf(fabsf(den0), 1.0f), i1 = 1.0f / fmaxf(fabsf(den1), 1.0f);
            float s = 0.f;
#pragma unroll
            for (int e = 0; e < 8; ++e) { nf[e] = nf[e] * i0 + nb[e] * i1; s += nf[e]; }
            const float mu = wave_sum(s) * (1.0f / 512.0f); float q = 0.f;
#pragma unroll
            for (int e = 0; e < 8; ++e) { nf[e] -= mu; q += nf[e] * nf[e]; }
            const float rstd = 1.0f / sqrtf(wave_sum(q) * (1.0f / 512.0f) + ML_NORM_EPS);
#pragma unroll
            for (int e = 0; e < 8; ++e) nf[e] = (nf[e] * rstd * nw[e] + sk[e] * xc[e]) * silu_f(z[e]);
            *(u32x4*)(NF + o) = pack8(nf);
        }
    }
}

__device__ __forceinline__ void ph_final(Fr& F) {
    const float* g = IN(I_FINALG);
    for (int r = F.gw; r < ML; r += 2 * F.ngw) {
        const int r2 = r + F.ngw < ML ? r + F.ngw : r;
        f32x4* xa = (f32x4*)(F.out + (size_t)r * 1024) + F.lane; f32x4* xb = (f32x4*)(F.out + (size_t)r2 * 1024) + F.lane; f32x4 va[4], vb[4]; float sa = 0.f, sb = 0.f;
#pragma unroll
        for (int j = 0; j < 4; ++j) { va[j] = xa[64 * j]; vb[j] = xb[64 * j]; }
#pragma unroll
        for (int j = 0; j < 4; ++j) { sa += (va[j][0] * va[j][0] + va[j][1] * va[j][1]) + (va[j][2] * va[j][2] + va[j][3] * va[j][3]); sb += (vb[j][0] * vb[j][0] + vb[j][1] * vb[j][1]) + (vb[j][2] * vb[j][2] + vb[j][3] * vb[j][3]); }
        const float ra = 1.0f / sqrtf(wave_sum(sa) * (1.0f / 1024.0f) + EPS), rb = 1.0f / sqrtf(wave_sum(sb) * (1.0f / 1024.0f) + EPS);
#pragma unroll
        for (int j = 0; j < 4; ++j) { const f32x4 gg = *(const f32x4*)(g + 4 * F.lane + 256 * j); xa[64 * j] = va[j] * ra * gg; if (r2 != r) xb[64 * j] = vb[j] * rb * gg; }
    }
}

template <class Epi>
__device__ __forceinline__ void run_gemm(Fr& F, const bf16* A, const bf16* Bt, int M, int N, int K, const Epi& E) {
    pg8::Gemm g{A, Bt, M, N, K}; pg8::StaticOrder S; S.init(M, N, F.G, F.bid);
    pg8::gemm_phase<Epi, pg8::StaticOrder, true, true>(F.lds, g, S, E, F.tid);
}

struct Args { const float* in[38]; float* out; unsigned char* ws; int ph_lo, ph_hi; };
static_assert(sizeof(Args) == 328 && offsetof(Args, out) == 304 && offsetof(Args, ws) == 312 && offsetof(Args, ph_lo) == 320, "Args layout");
constexpr int N_PHASES = 34;


#define XB_TMO      128
#define XB_XCNT(j)  (256  + 64 * (j))
#define XB_XSUB(j)  (1280 + 64 * (j))
#define XB_XGEN(j)  (2304 + 64 * (j))
#define XB_TOP      3328
#define XB_TOPGEN   3392
#define XCD_BAR_WORDS 3456
#define XB_SPIN_CAP (1u << 22)
__device__ __forceinline__ unsigned xb_ld(unsigned* p)              { return __hip_atomic_load(p, __ATOMIC_RELAXED, __HIP_MEMORY_SCOPE_AGENT); }
__device__ __forceinline__ unsigned xb_add(unsigned* p, unsigned v) { return __hip_atomic_fetch_add(p, v, __ATOMIC_RELAXED, __HIP_MEMORY_SCOPE_AGENT); }
__device__ __forceinline__ unsigned xb_xcc_id() { return (unsigned)__builtin_amdgcn_s_getreg((3 << 11) | 20) & 0xFu; }
#define XB_SPIN(cond, bar) do { unsigned _sp = 0; while (cond) { __builtin_amdgcn_s_sleep(1); \
    if ((++_sp & 255u) == 0u) { if (xb_ld(&(bar)[XB_TMO])) break; if (_sp > XB_SPIN_CAP) { atomicAdd(&(bar)[XB_TMO], 1u); break; } } } } while (0)
__device__ __forceinline__ void xcd_barrier_complete(unsigned* bar, unsigned x, unsigned& nloc, unsigned& nx) {
    const unsigned G = gridDim.x * gridDim.y * gridDim.z;
    unsigned sum, cnt, mine, sp = 0u;
    for (;;) {
        sum = 0u; cnt = 0u; mine = 0u;
#pragma unroll
        for (unsigned j = 0; j < 16; ++j) { const unsigned c = xb_ld(&bar[XB_XCNT(j)]); sum += c; cnt += (c > 0u) ? 1u : 0u; mine = (j == x) ? c : mine; }
        if (sum == G) break;
        __builtin_amdgcn_s_sleep(1);
        if ((++sp & 255u) == 0u) { if (xb_ld(&bar[XB_TMO])) break; if (sp > XB_SPIN_CAP) { atomicAdd(&bar[XB_TMO], 1u); break; } }
    }
    nloc = mine > 0u ? mine : 1u; nx = cnt > 0u ? cnt : 1u;
}
__device__ __forceinline__ void xcd_barrier(unsigned* bar, volatile LAS unsigned* st) {
    asm volatile("s_waitcnt vmcnt(0)" ::: "memory");
    __syncthreads();
    if (threadIdx.x == 0) {
        const unsigned x = xb_xcc_id();
        __builtin_amdgcn_s_waitcnt(0);
        unsigned nloc = st[0], nx = st[1];
        if (nloc == 0u) { xcd_barrier_complete(bar, x, nloc, nx); st[0] = nloc; st[1] = nx; }
        const unsigned old = xb_add(&bar[XB_XSUB(x)], 1u);
        const unsigned gen = old / nloc;
        if (old + 1u == (gen + 1u) * nloc) {
            __builtin_amdgcn_fence(__ATOMIC_RELEASE, "agent");
            asm volatile("s_waitcnt vmcnt(0)" ::: "memory");
            const unsigned og = xb_add(&bar[XB_TOP], 1u);
            const unsigned tg = og / nx;
            if (og + 1u == (tg + 1u) * nx) xb_add(&bar[XB_TOPGEN], 1u);
            else XB_SPIN(xb_ld(&bar[XB_TOPGEN]) == tg, bar);
            __builtin_amdgcn_fence(__ATOMIC_ACQUIRE, "agent");
            xb_add(&bar[XB_XGEN(x)], 1u);
            asm volatile("s_waitcnt vmcnt(0)" ::: "memory");
        } else {
            XB_SPIN(xb_ld(&bar[XB_XGEN(x)]) == gen, bar);
            __builtin_amdgcn_fence(__ATOMIC_ACQUIRE, "agent");
            asm volatile("s_waitcnt vmcnt(0)" ::: "memory");
        }
    }
    __syncthreads();
}
#ifndef PROBE_MASK
#define PROBE_MASK 0ull
#endif
constexpr int BAR_LDS_OFF = LDS_BYTES - 64;
constexpr size_t WS_BAR = 0;
constexpr size_t WS_TS = 64 * 1024;

template <int ph>
__device__ __forceinline__ void run_phase(Fr& F) {
    unsigned char* ws = F.ws;
    float* mod = (float*)(ws + WS_MOD); float* ctxx = (float*)(ws + WS_CTXX);
    if constexpr (ph == 0) ph_prologue(F);
    else if constexpr (ph == 1) ph_modnorm(F, IN(I_X), ML, 0, IN(I_CTX), MC, IN(I_NORMG), mod, 0, (bf16*)(ws + HY_H));
    else if constexpr (ph == 2) { pg8::EpiBf16 E{(bf16*)(ws + HY_P), 3072, IN(I_HBIN), 0, 0}; run_gemm(F, (const bf16*)(ws + HY_H), (const bf16*)(ws + WS_WHIN), MALL, 3072, 1024, E);
                                  { constexpr int nun = (MALL / 256) * (3072 / 256); const int busy = nun % F.G; const bool all = busy == 0; const int vb = all ? F.bid : F.bid - busy, nvb = all ? F.G : F.G - busy;
                                    if (all || F.bid >= busy) {
                                        kt_items(F, (const float*)(ws + WS_H3), SEQ, (float*)(ws + HY_KT), vb * NWAVES + F.wave, nvb * NWAVES);
                                        kt_items(F, (const float*)(ws + WS_H3) + (size_t)SEQ * 64, CTXL, (float*)(ws + WS_KTC), vb * NWAVES + F.wave, nvb * NWAVES);
                                        transpose_group(F, 1, vb, nvb); } } }
    else if constexpr (ph == 3) { zt_items(F, (const bf16*)(ws + HY_P), 0, NB, SEQ, (bf16*)(ws + HY_ZT)); zt_items(F, (const bf16*)(ws + HY_P), ML, NB, CTXL, (bf16*)(ws + HY_ZTC)); }
    else if constexpr (ph == 4) ph_fftconv(F);
    else if constexpr (ph == 5) { u2_items(F, (const bf16*)(ws + HY_P), 0, NB, SEQ, (const bf16*)(ws + HY_ZT), (bf16*)(ws + HY_H)); u2_items(F, (const bf16*)(ws + HY_P), ML, NB, CTXL, (const bf16*)(ws + HY_ZTC), (bf16*)(ws + HY_H)); }
    else if constexpr (ph == 6) { pg8::EpiRes E{IN(I_X), F.out, IN(I_CTX), ctxx, ML, mod + 2048, 0, IN(I_HBOUT)}; run_gemm(F, (const bf16*)(ws + HY_H), (const bf16*)(ws + WS_WHOUT), MALL, 1024, 1024, E);
                                  transpose_in_tail(F, 2, (MALL / 256) * (1024 / 256)); }
    else if constexpr (ph == 7) ph_modnorm(F, F.out, ML, 0, ctxx, MC, IN(I_NORMG) + 1024, mod, 3072, (bf16*)(ws + FF_H));
    else if constexpr (ph == 8) { pg8::EpiBf16 E{(bf16*)(ws + FF_A), FF, nullptr, FF, (FF_G - FF_A) / 2}; run_gemm(F, (const bf16*)(ws + FF_H), (const bf16*)(ws + WS_WUP0), MALL, 2 * FF, 1024, E);
                                  { constexpr int nun = (MALL / 256) * (2 * FF / 256); const int busy = nun % F.G;
                                    if (busy == 0) mod_layer(F, 1, F.bid, F.G); else if (F.bid >= busy) mod_layer(F, 1, F.bid - busy, F.G - busy); } }
    else if constexpr (ph == 9) ph_dwconv(F, 0, ML, MC);
    else if constexpr (ph == 10) { pg8::EpiRes E{F.out, F.out, ctxx, ctxx, ML, mod + 5120, 0, nullptr}; run_gemm(F, (const bf16*)(ws + FF_A), (const bf16*)(ws + WS_WDN0), MALL, 1024, FF, E); }
    else if constexpr (ph < 29) {
            constexpr int hb = (ph - 11) / 9, k = (ph - 11) % 9; const float* mod1 = mod + 5 * 6144;
            float* xh = F.out + (size_t)hb * HROWS * 1024;
            if constexpr (k == 0) { ph_modnorm(F, xh, HROWS, 2 * hb, ctxx, 0, IN(I_NORMG) + 2048, mod1, 0, (bf16*)(ws + MS_H));
                          if (hb == 0) ph_modnorm(F, xh, 0, 0, ctxx, MC, IN(I_NORMG) + 2048, mod1, 0, (bf16*)(ws + MS_HC)); }
            else if constexpr (k == 1) { { pg8::EpiBf16T E{(bf16*)(ws + MS_XM), MI / 32}; run_gemm(F, (const bf16*)(ws + MS_H), (const bf16*)(ws + WS_WMIN), HROWS, MI, 1024, E); }
                               if (hb == 0) { pg8::EpiBf16T E{(bf16*)(ws + MS_XMC), MI / 32}; run_gemm(F, (const bf16*)(ws + MS_HC), (const bf16*)(ws + WS_WMIN), MC, MI, 1024, E); } }
            else if constexpr (k == 2) { prep_items(F, (const bf16*)(ws + MS_XM), 2, SEQ, (bf16*)(ws + MS_XC), (bf16*)(ws + MS_KN), (bf16*)(ws + MS_KT), (bf16*)(ws + MS_VT));
                               if (hb == 0) prep_items(F, (const bf16*)(ws + MS_XMC), NB, CTXL, (bf16*)(ws + MS_XCC), (bf16*)(ws + MS_XCC + 16 * MiB), (bf16*)(ws + MS_KTC), (bf16*)(ws + MS_VTC)); }
            else if constexpr (k == 3) { gate_items(F, (const bf16*)(ws + MS_XC), (const bf16*)(ws + MS_XM), HROWS, (float*)(ws + WS_GATES_L));
                               if (hb == 0) gate_items(F, (const bf16*)(ws + MS_XCC), (const bf16*)(ws + MS_XMC), MC, (float*)(ws + WS_GATES_C)); }
            else if constexpr (k == 4) ph_sphase(F, hb, hb == 0);
            else if constexpr (k == 5) ph_scan(F, hb);
            else if constexpr (k == 6) { pg8::EpiBf16 E{(bf16*)(ws + MS_Z), MI, nullptr, 0, 0}; run_gemm(F, (const bf16*)(ws + MS_H), (const bf16*)(ws + WS_WMIN) + (size_t)MI * 1024, HROWS, MI, 1024, E); }
            else if constexpr (k == 7) ph_mout(F);
            else { pg8::EpiRes E{xh, xh, ctxx, ctxx, HROWS, mod1 + 2048, 2 * hb, nullptr}; run_gemm(F, (const bf16*)(ws + MS_NF), (const bf16*)(ws + WS_WMDN), HROWS, 1024, MI, E); }
        }
    else if constexpr (ph == 29) ph_modnorm(F, F.out, ML, 0, ctxx, 0, IN(I_NORMG) + 3072, mod + 5 * 6144, 3072, (bf16*)(ws + FF_H));
    else if constexpr (ph == 30) { pg8::EpiBf16 E{(bf16*)(ws + FF_A), FF, nullptr, FF, (FF_G - FF_A) / 2}; run_gemm(F, (const bf16*)(ws + FF_H), (const bf16*)(ws + WS_WUP1), ML, 2 * FF, 1024, E); }
    else if constexpr (ph == 31) ph_dwconv(F, 1, ML, 0);
    else if constexpr (ph == 32) { pg8::EpiRes E{F.out, F.out, ctxx, ctxx, ML, mod + 5 * 6144 + 5120, 0, nullptr}; run_gemm(F, (const bf16*)(ws + FF_A), (const bf16*)(ws + WS_WDN1), ML, 1024, FF, E); }
    else ph_final(F);
}

template <int ph>
__device__ __forceinline__ void phase_step(int ph_lo, int ph_hi, unsigned char* lds_raw) {
    if (ph_lo <= ph && ph < ph_hi) {
        const __attribute__((address_space(4))) unsigned char* kp = (const __attribute__((address_space(4))) unsigned char*)__builtin_amdgcn_kernarg_segment_ptr();
        asm volatile("" : "+s"(kp));
        Fr F;
        { int t_ = threadIdx.x, g_ = gridDim.x, b_ = blockIdx.x; asm volatile("" : "+v"(t_), "+s"(g_), "+s"(b_)); F.tid = t_; F.G = g_; F.bid = b_; }
        F.lds = (LAS unsigned char*)lds_raw; F.lane = F.tid & 63; F.wave = __builtin_amdgcn_readfirstlane(F.tid >> 6);
        F.gw = F.bid * NWAVES + F.wave; F.ngw = F.G * NWAVES;
        F.in = (const __attribute__((address_space(4))) cfptr_t*)kp;
        typedef float* fptr_t; typedef unsigned char* ucptr_t;
        F.out = *(const __attribute__((address_space(4))) fptr_t*)(kp + 304); F.ws = *(const __attribute__((address_space(4))) ucptr_t*)(kp + 312);
        if (PROBE_MASK != 0ull && F.bid == 0 && F.tid == 0) ((unsigned long long*)(F.ws + WS_TS))[ph] = __builtin_amdgcn_s_memrealtime();
        run_phase<ph>(F);
        if (ph + 1 < ph_hi) {
            if (ph == 0) {
                if (F.bid == 0) for (int i = F.tid; i < XCD_BAR_WORDS; i += NTHR) __hip_atomic_store((unsigned*)(F.ws + WS_BAR) + i, 0u, __ATOMIC_RELAXED, __HIP_MEMORY_SCOPE_AGENT);
                __syncthreads(); cg::this_grid().sync();
                if (F.tid == 0) (void)xb_add((unsigned*)(F.ws + WS_BAR) + XB_XCNT(xb_xcc_id()), 1u);
            }
            else xcd_barrier((unsigned*)(F.ws + WS_BAR), (volatile LAS unsigned*)(F.lds + BAR_LDS_OFF));
        }
        if (PROBE_MASK != 0ull && ph == N_PHASES - 1 && F.bid == 0) {
            if (F.tid == 0) { unsigned long long* ts = (unsigned long long*)(F.ws + WS_TS); const unsigned long long tend = __builtin_amdgcn_s_memrealtime(); unsigned long long tot = 0ull;
                for (int k = 0; k < N_PHASES; ++k) if ((PROBE_MASK >> k) & 1ull) tot += (k + 1 < N_PHASES ? ts[k + 1] : tend) - ts[k];
                while (__builtin_amdgcn_s_memrealtime() - tend < tot) __builtin_amdgcn_s_sleep(8); }
            __syncthreads();
        }
    }
}
template <int... I>
__device__ __forceinline__ void all_phases(int ph_lo, int ph_hi, unsigned char* lds_raw, std::integer_sequence<int, I...>) { (phase_step<I>(ph_lo, ph_hi, lds_raw), ...); }

__global__ void __launch_bounds__(NTHR, 2) fwd_kernel(Args args) {
    extern __shared__ __attribute__((aligned(16))) unsigned char lds_raw[];
    int ph_lo, ph_hi;
    { const __attribute__((address_space(4))) unsigned char* kp0 = (const __attribute__((address_space(4))) unsigned char*)__builtin_amdgcn_kernarg_segment_ptr();
      ph_lo = *(const __attribute__((address_space(4))) int*)(kp0 + 320); ph_hi = *(const __attribute__((address_space(4))) int*)(kp0 + 324); }
    if (threadIdx.x < 16) ((LAS unsigned*)((LAS unsigned char*)lds_raw + BAR_LDS_OFF))[threadIdx.x] = 0u;
    __syncthreads();
    all_phases(ph_lo, ph_hi, lds_raw, std::make_integer_sequence<int, N_PHASES>{});
}

extern "C" void kernel_launch(void* const* d_in, const int* in_sizes, int n_in, void* d_out, int out_size, void* d_ws, size_t ws_size, hipStream_t stream) {
    static int grid = 0;
    if (grid == 0) {
        int dev = 0, cus = 0, per_cu = 0;
        hipGetDevice(&dev);
        hipDeviceGetAttribute(&cus, hipDeviceAttributeMultiprocessorCount, dev);
        hipFuncSetAttribute((const void*)fwd_kernel, hipFuncAttributeMaxDynamicSharedMemorySize, LDS_BYTES);
        hipOccupancyMaxActiveBlocksPerMultiprocessor(&per_cu, (const void*)fwd_kernel, NTHR, LDS_BYTES);
        if (per_cu < 1) { fprintf(stderr, "kernel_launch: occupancy query says %d blocks per CU\n", per_cu); per_cu = 1; }
        grid = cus < 256 ? cus : 256;
        if (n_in != 38 || ws_size < WS_END) fprintf(stderr, "kernel_launch: unexpected n_in %d / ws_size %zu (need %zu)\n", n_in, ws_size, (size_t)WS_END);
        (void)hipGetLastError();
    }
    (void)hipMemsetAsync(d_ws, 0, 128 * 1024, stream);
    Args a{};
    for (int i = 0; i < 38; ++i) a.in[i] = (const float*)d_in[i];
    a.out = (float*)d_out; a.ws = (unsigned char*)d_ws; a.ph_lo = 0; a.ph_hi = N_PHASES;
    void* kargs[] = {&a};
    hipError_t e = hipLaunchCooperativeKernel((const void*)fwd_kernel, dim3(grid), dim3(NTHR), kargs, LDS_BYTES, stream);
    if (e != hipSuccess) fprintf(stderr, "cooperative launch failed: %s (grid %d)\n", hipGetErrorString(e), grid);
}
```

```cpp
#include <hip/hip_runtime.h>
#include <hip/hip_cooperative_groups.h>
#include <cstdio>
#include <cstdint>
#include <cstddef>
#include <utility>
namespace cg = cooperative_groups;

#define LAS __attribute__((address_space(3)))
typedef unsigned short bf16;
typedef short bf16x8 __attribute__((ext_vector_type(8)));
typedef float f32x4 __attribute__((ext_vector_type(4)));
typedef float f32x2 __attribute__((ext_vector_type(2)));
typedef unsigned u32x4 __attribute__((ext_vector_type(4)));
typedef unsigned u32x2 __attribute__((ext_vector_type(2)));

namespace pg8 {
#define PG8_LAS __attribute__((address_space(3)))
typedef unsigned short bf16_t;
constexpr int BM = 256, BK = 64, HALF = 128, HTB = HALF * BK * 2, STAGE_BYTES = 8 * HTB, NXCD = 8, WGM = 8;
__host__ __device__ __forceinline__ int lds_byte(int r, int c) { const int st = (r >> 4) * 2 + (c >> 5), rr = r & 15, cc = c & 31, ob = rr * 64 + cc * 2; return st * 1024 + (ob ^ (((ob >> 9) & 1) << 5)); }
__host__ __device__ __forceinline__ void stage_rc(int b, int& R, int& C) { const int st = b / 1024, sb = b % 1024, swz = sb ^ (((sb >> 9) & 1) << 5); R = (st >> 1) * 16 + swz / 64; C = (st & 1) * 32 + (swz % 64) / 2; }
__host__ __device__ __forceinline__ int perm32(int rho) { const int n = rho >> 4, i = rho & 15; return 8 * (i >> 2) + 4 * n + (i & 3); }
struct Unit { int pm, pn; };
struct Gemm { const bf16_t* A; const bf16_t* Bt; int M, N, K; };
struct StaticOrder {
    int nM, nN, nwg, G, c;
    __host__ __device__ void init(int M, int N, int G_, int c_) { nM = M / BM; nN = N / BM; nwg = nM * nN; G = G_; c = c_; }
    __host__ __device__ bool next(int i, Unit& u) const {
        const long L = (long)i * G + c; if (L >= nwg) return false;
        int wgid = (int)L; { const int q = nwg / NXCD, r = nwg % NXCD, xcd = wgid % NXCD, off = wgid / NXCD; wgid = (xcd < r ? xcd * (q + 1) : r * (q + 1) + (xcd - r) * q) + off; }
        const int nig = WGM * nN, gid = wgid / nig, fm = gid * WGM, gsz = (nM - fm) < WGM ? (nM - fm) : WGM;
        u.pm = fm + ((wgid % nig) % gsz); u.pn = (wgid % nig) / gsz; return true;
    }
    __device__ __forceinline__ void a_ready(const Unit&) const {}
    __device__ __forceinline__ void done(const Unit&) const {}
};
__device__ __forceinline__ unsigned cvt_pk_bf16(float lo, float hi) { unsigned r; asm volatile("v_cvt_pk_bf16_f32 %0, %1, %2" : "=v"(r) : "v"(lo), "v"(hi)); return r; }

struct EpiBf16 {
    static constexpr bool PERM = true, AFTER_DRAIN = false;
    bf16_t* O; int ldc; const float* bias; int split_cols; size_t split_stride;
    __device__ __forceinline__ void operator()(const f32x4 (&acc)[2][2][4][2], const Unit& u, int wr, int wc, int fr, int fq) const {
        const int row0 = u.pm * BM + wr * 64 + fr; int colt = u.pn * BM; bf16_t* base = O;
        if (split_cols) { const int t = colt / split_cols; base += (size_t)t * split_stride; colt -= t * split_cols; }
        const int col0 = colt + wc * 32 + 8 * fq, bcol0 = u.pn * BM + wc * 32 + 8 * fq;
        f32x4 bv[2][2];
#pragma unroll
        for (int bj = 0; bj < 2; ++bj)
#pragma unroll
            for (int n = 0; n < 2; ++n) bv[bj][n] = bias ? *(const f32x4*)(bias + bcol0 + bj * HALF + 4 * n) : (f32x4){0.f, 0.f, 0.f, 0.f};
#pragma unroll
        for (int ai = 0; ai < 2; ++ai)
#pragma unroll
            for (int m = 0; m < 4; ++m) { bf16_t* rowp = base + (size_t)(row0 + ai * HALF + m * 16) * ldc + col0;
#pragma unroll
                for (int bj = 0; bj < 2; ++bj) { f32x4 v0 = acc[ai][bj][m][0] + bv[bj][0], v1 = acc[ai][bj][m][1] + bv[bj][1];
                    u32x4 w; w.x = cvt_pk_bf16(v0[0], v0[1]); w.y = cvt_pk_bf16(v0[2], v0[3]); w.z = cvt_pk_bf16(v1[0], v1[1]); w.w = cvt_pk_bf16(v1[2], v1[3]);
                    *(u32x4*)(rowp + bj * HALF) = w; } }
    }
};
struct EpiBf16T {
    static constexpr bool PERM = true, AFTER_DRAIN = false;
    bf16_t* O; int ntc;
    __device__ __forceinline__ void operator()(const f32x4 (&acc)[2][2][4][2], const Unit& u, int wr, int wc, int fr, int fq) const {
        bf16_t* base = O + (size_t)(fr + 16 * fq) * 8;
#pragma unroll
        for (int ai = 0; ai < 2; ++ai)
#pragma unroll
            for (int m = 0; m < 4; ++m)
#pragma unroll
                for (int bj = 0; bj < 2; ++bj) { const f32x4 v0 = acc[ai][bj][m][0], v1 = acc[ai][bj][m][1];
                    u32x4 w; w.x = cvt_pk_bf16(v0[0], v0[1]); w.y = cvt_pk_bf16(v0[2], v0[3]); w.z = cvt_pk_bf16(v1[0], v1[1]); w.w = cvt_pk_bf16(v1[2], v1[3]);
                    *(u32x4*)(base + ((size_t)(u.pm * 16 + ai * 8 + wr * 4 + m) * ntc + u.pn * 8 + bj * 4 + wc) * 512) = w; }
    }
};
struct EpiDelta {
    static constexpr bool PERM = true, AFTER_DRAIN = false, HEAVY = false;
    bf16_t* Dl; int rows_lat; const float* gate; int b0; const float* bias;
    __device__ __forceinline__ void operator()(const f32x4 (&acc)[2][2][4][2], const Unit& u, int wr, int wc, int fr, int fq) const {
        const int trow = u.pm * BM, modrow = trow < rows_lat ? b0 + trow / 8192 : 4;
        const int col0 = u.pn * BM + wc * 32 + 8 * fq; const float* gp = gate + (size_t)modrow * 6144 + col0;
        bf16_t* base = Dl + (size_t)(trow + wr * 64 + fr) * 1024 + col0;
#pragma unroll
        for (int bj = 0; bj < 2; ++bj) {
            f32x4 bv[2], gv[2];
#pragma unroll
            for (int n = 0; n < 2; ++n) { bv[n] = bias ? *(const f32x4*)(bias + col0 + bj * HALF + 4 * n) : (f32x4){0.f, 0.f, 0.f, 0.f}; gv[n] = *(const f32x4*)(gp + bj * HALF + 4 * n); }
#pragma unroll
            for (int ai = 0; ai < 2; ++ai)
#pragma unroll
                for (int m = 0; m < 4; ++m) { const f32x4 v0 = gv[0] * (acc[ai][bj][m][0] + bv[0]), v1 = gv[1] * (acc[ai][bj][m][1] + bv[1]);
                    u32x4 w; w.x = cvt_pk_bf16(v0[0], v0[1]); w.y = cvt_pk_bf16(v0[2], v0[3]); w.z = cvt_pk_bf16(v1[0], v1[1]); w.w = cvt_pk_bf16(v1[2], v1[3]);
                    *(u32x4*)(base + (size_t)(ai * HALF + m * 16) * 1024 + bj * HALF) = w; }
        }
    }
};
struct EpiRes {
    static constexpr bool PERM = false, AFTER_DRAIN = false;
    const float* res_lat; float* out_lat; const float* res_ctx; float* out_ctx; int rows_lat; const float* gate; int b0; const float* bias;
    __device__ __forceinline__ void operator()(const f32x4 (&acc)[2][2][4][2], const Unit& u, int wr, int wc, int fr, int fq) const {
        const int trow = u.pm * BM; const float* res; float* out; int modrow;
        if (trow < rows_lat) { res = res_lat + (size_t)trow * 1024; out = out_lat + (size_t)trow * 1024; modrow = b0 + trow / 8192; }
        else { const int rc = trow - rows_lat; res = res_ctx + (size_t)rc * 1024; out = out_ctx + (size_t)rc * 1024; modrow = 4; }
        const int col0 = u.pn * BM + wc * 32 + 4 * fq; const float* gp = gate + (size_t)modrow * 6144 + col0;
#pragma unroll
        for (int bj = 0; bj < 2; ++bj) {
            f32x4 bv[2], gv[2];
#pragma unroll
            for (int n = 0; n < 2; ++n) { bv[n] = bias ? *(const f32x4*)(bias + col0 + bj * HALF + n * 16) : (f32x4){0.f, 0.f, 0.f, 0.f}; gv[n] = *(const f32x4*)(gp + bj * HALF + n * 16); }
#pragma unroll
            for (int ai = 0; ai < 2; ++ai) {
                f32x4 rs[4][2];
#pragma unroll
                for (int m = 0; m < 4; ++m)
#pragma unroll
                    for (int n = 0; n < 2; ++n) rs[m][n] = *(const f32x4*)(res + (size_t)(wr * 64 + fr + ai * HALF + m * 16) * 1024 + col0 + bj * HALF + n * 16);
#pragma unroll
                for (int m = 0; m < 4; ++m)
#pragma unroll
                    for (int n = 0; n < 2; ++n) *(f32x4*)(out + (size_t)(wr * 64 + fr + ai * HALF + m * 16) * 1024 + col0 + bj * HALF + n * 16) = rs[m][n] + gv[n] * (acc[ai][bj][m][n] + bv[n]);
                asm volatile("" ::: "memory");
            }
        }
    }
};

template <class Epi, class Sched, bool ALIGN_EPI = false, bool SP2 = false>
__device__ __forceinline__ void gemm_phase(PG8_LAS unsigned char* lds, const Gemm g, const Sched& S, const Epi& E, const int tid) {
    const int wid = __builtin_amdgcn_readfirstlane(tid >> 6), lane = tid & 63, wr = wid >> 2, wc = wid & 3, fr = lane & 15, fq = lane >> 4;
    const int K = g.K, nt = K / BK;
    unsigned voffA[2], voffB[2];
#pragma unroll
    for (int i = 0; i < 2; ++i) { int R, C; stage_rc(tid * 16 + i * 8192, R, C); const int Rb = Epi::PERM ? ((R & ~31) + perm32(R & 31)) : R;
        voffA[i] = (unsigned)(R * K + C) * 2u; voffB[i] = (unsigned)(Rb * K + C) * 2u; }
    const size_t kstep = (size_t)(BK * 2);
    const size_t hstep = (size_t)HALF * K * 2;
    const size_t tstep = 2 * hstep;
    const unsigned ldsw = (unsigned)wid * 1024u;
    const int aoff = lds_byte(wr * 64 + fr, fq * 8), boff = lds_byte(wc * 32 + fr, fq * 8);
#define PG8_SA(b, h) (((b) * 2 + (h)) * HTB)
#define PG8_SB(b, h) ((4 + (b) * 2 + (h)) * HTB)
#define PG8_STAGE(bufoff, gbase, voff) do { _Pragma("unroll") for (int _i = 0; _i < 2; ++_i) \
        __builtin_amdgcn_global_load_lds((const unsigned*)((const char*)(gbase) + (voff)[_i]), (PG8_LAS unsigned*)(lds + (bufoff) + ldsw + _i * 8192), 16, 0, 0); } while (0)
#define PG8_LDA(dst, b, h) do { _Pragma("unroll") for (int m = 0; m < 4; ++m) _Pragma("unroll") for (int k = 0; k < 2; ++k) dst[m][k] = *(const PG8_LAS bf16x8*)(lds + PG8_SA(b, h) + aoff + m * 2048 + k * 1024); } while (0)
#define PG8_LDB(dst, b, h) do { _Pragma("unroll") for (int n = 0; n < 2; ++n) _Pragma("unroll") for (int k = 0; k < 2; ++k) dst[n][k] = *(const PG8_LAS bf16x8*)(lds + PG8_SB(b, h) + boff + n * 2048 + k * 1024); } while (0)
#define PG8_MMA(ai, bj, At, Bt) do { __builtin_amdgcn_s_setprio(1); _Pragma("unroll") for (int m = 0; m < 4; ++m) _Pragma("unroll") for (int n = 0; n < 2; ++n) _Pragma("unroll") for (int k = 0; k < 2; ++k) \
        acc[ai][bj][m][n] = __builtin_amdgcn_mfma_f32_16x16x32_bf16(Bt[n][k], At[m][k], acc[ai][bj][m][n], 0, 0, 0); __builtin_amdgcn_s_setprio(0); } while (0)
#define PG8_WAIT_V(n) asm volatile("s_waitcnt vmcnt(" #n ")" ::: "memory")
#define PG8_WAIT_L(n) asm volatile("s_waitcnt lgkmcnt(" #n ")" ::: "memory")
#define PG8_BAR __builtin_amdgcn_s_barrier()
#define PG8_SCHED __builtin_amdgcn_sched_barrier(0)
    Unit cur, nxt; int ui = 0;
    if (!S.next(0, cur)) return;
    f32x4 acc[2][2][4][2];
#pragma unroll
    for (int a = 0; a < 2; ++a)
#pragma unroll
        for (int b = 0; b < 2; ++b)
#pragma unroll
            for (int m = 0; m < 4; ++m)
#pragma unroll
                for (int n = 0; n < 2; ++n) acc[a][b][m][n] = (f32x4){0.f, 0.f, 0.f, 0.f};
    bf16x8 At[4][2], B0[2][2], B1[2][2];
    const char* cA = (const char*)g.A + (size_t)cur.pm * tstep; const char* cB = (const char*)g.Bt + (size_t)cur.pn * tstep;
    S.a_ready(cur);
    if constexpr (SP2) {
        PG8_STAGE(PG8_SB(0, 0), cB, voffB); PG8_STAGE(PG8_SB(0, 1), cB + hstep, voffB); PG8_STAGE(PG8_SA(0, 0), cA, voffA); PG8_STAGE(PG8_SA(0, 1), cA + hstep, voffA);
        if (wr == 1) PG8_BAR;
        PG8_WAIT_V(2); PG8_BAR;
        PG8_STAGE(PG8_SB(1, 0), cB + kstep, voffB); PG8_STAGE(PG8_SA(1, 0), cA + kstep, voffA); PG8_STAGE(PG8_SB(1, 1), cB + hstep + kstep, voffB);
        PG8_WAIT_V(6); PG8_BAR;
    } else {
        PG8_STAGE(PG8_SB(0, 0), cB, voffB); PG8_STAGE(PG8_SA(0, 0), cA, voffA); PG8_STAGE(PG8_SB(0, 1), cB + hstep, voffB); PG8_STAGE(PG8_SA(0, 1), cA + hstep, voffA);
        if (wr == 1) PG8_BAR;
        PG8_WAIT_V(4); PG8_BAR;
        PG8_STAGE(PG8_SB(1, 0), cB + kstep, voffB); PG8_STAGE(PG8_SA(1, 0), cA + kstep, voffA); PG8_STAGE(PG8_SB(1, 1), cB + hstep + kstep, voffB);
        PG8_WAIT_V(6); PG8_BAR;
    }
    for (;;) {
        const bool has_next = S.next(ui + 1, nxt);
        const char* nA = has_next ? (const char*)g.A + (size_t)nxt.pm * tstep : cA; const char* nB = has_next ? (const char*)g.Bt + (size_t)nxt.pn * tstep : cB;
        for (int t = 0; t < nt; t += 2) {
            const bool last = (t == nt - 2);
            const char* a1 = cA + (size_t)(t + 1) * kstep;
            const char* a2 = last ? nA : cA + (size_t)(t + 2) * kstep; const char* b2 = last ? nB : cB + (size_t)(t + 2) * kstep;
            const char* a3 = a2 + kstep; const char* b3 = b2 + kstep;
            if (last && has_next) S.a_ready(nxt);
            if constexpr (SP2) {
            PG8_LDB(B0, 0, 0); PG8_LDB(B1, 0, 1); PG8_SCHED; PG8_LDA(At, 0, 0); PG8_STAGE(PG8_SA(1, 1), a1 + hstep, voffA);
            PG8_WAIT_V(8); PG8_WAIT_L(0); PG8_BAR; PG8_MMA(0, 0, At, B0); PG8_MMA(0, 1, At, B1); PG8_BAR; PG8_SCHED;
            PG8_LDA(At, 0, 1); PG8_STAGE(PG8_SB(0, 0), b2, voffB); PG8_STAGE(PG8_SB(0, 1), b2 + hstep, voffB); PG8_STAGE(PG8_SA(0, 0), a2, voffA);
            PG8_WAIT_V(8); PG8_WAIT_L(0); PG8_BAR; PG8_MMA(1, 0, At, B0); PG8_MMA(1, 1, At, B1); PG8_BAR; PG8_SCHED;
            PG8_LDB(B0, 1, 0); PG8_LDB(B1, 1, 1); PG8_SCHED; PG8_LDA(At, 1, 0); PG8_STAGE(PG8_SA(0, 1), a2 + hstep, voffA);
            PG8_WAIT_V(8); PG8_WAIT_L(0); PG8_BAR; PG8_MMA(0, 0, At, B0); PG8_MMA(0, 1, At, B1); PG8_BAR; PG8_SCHED;
            PG8_LDA(At, 1, 1); PG8_STAGE(PG8_SB(1, 0), b3, voffB); PG8_STAGE(PG8_SB(1, 1), b3 + hstep, voffB); PG8_STAGE(PG8_SA(1, 0), a3, voffA);
            PG8_WAIT_V(8); PG8_WAIT_L(0); PG8_BAR; PG8_MMA(1, 0, At, B0); PG8_MMA(1, 1, At, B1); PG8_BAR; PG8_SCHED;
            } else {
            PG8_LDB(B0, 0, 0); PG8_SCHED; PG8_LDA(At, 0, 0); PG8_STAGE(PG8_SA(1, 1), a1 + hstep, voffA);
            PG8_WAIT_L(8); PG8_BAR; PG8_WAIT_L(0); PG8_MMA(0, 0, At, B0); PG8_BAR; PG8_SCHED;
            PG8_LDB(B1, 0, 1); PG8_STAGE(PG8_SB(0, 0), b2, voffB);
            PG8_BAR; PG8_WAIT_L(0); PG8_MMA(0, 1, At, B1); PG8_BAR;
            PG8_LDA(At, 0, 1); PG8_STAGE(PG8_SA(0, 0), a2, voffA);
            PG8_BAR; PG8_WAIT_L(0); PG8_MMA(1, 0, At, B0); PG8_BAR; PG8_SCHED;
            PG8_STAGE(PG8_SB(0, 1), b2 + hstep, voffB);
            PG8_WAIT_V(6); PG8_BAR; PG8_MMA(1, 1, At, B1); PG8_BAR;
            PG8_LDB(B0, 1, 0); PG8_SCHED; PG8_LDA(At, 1, 0); PG8_STAGE(PG8_SA(0, 1), a2 + hstep, voffA);
            PG8_WAIT_L(8); PG8_BAR; PG8_WAIT_L(0); PG8_MMA(0, 0, At, B0); PG8_BAR; PG8_SCHED;
            PG8_LDB(B1, 1, 1); PG8_STAGE(PG8_SB(1, 0), b3, voffB);
            PG8_BAR; PG8_WAIT_L(0); PG8_MMA(0, 1, At, B1); PG8_BAR;
            PG8_LDA(At, 1, 1); PG8_STAGE(PG8_SA(1, 0), a3, voffA);
            PG8_BAR; PG8_WAIT_L(0); PG8_MMA(1, 0, At, B0); PG8_BAR; PG8_SCHED;
            PG8_STAGE(PG8_SB(1, 1), b3 + hstep, voffB);
            PG8_WAIT_V(6); PG8_BAR; PG8_MMA(1, 1, At, B1); PG8_BAR;
            }
        }
        if constexpr (ALIGN_EPI) { if (wr == 0) PG8_BAR; }
        if constexpr (!Epi::AFTER_DRAIN) { E(acc, cur, wr, wc, fr, fq); S.done(cur); }
        if (!has_next) break;
#pragma unroll
        for (int a = 0; a < 2; ++a)
#pragma unroll
            for (int b = 0; b < 2; ++b)
#pragma unroll
                for (int m = 0; m < 4; ++m)
#pragma unroll
                    for (int n = 0; n < 2; ++n) acc[a][b][m][n] = (f32x4){0.f, 0.f, 0.f, 0.f};
        cur = nxt; cA = nA; cB = nB; ++ui;
        if constexpr (ALIGN_EPI) { if (wr == 1) PG8_BAR; }
    }
    PG8_WAIT_V(0);
    if constexpr (!ALIGN_EPI) { if (wr == 0) PG8_BAR; }
    PG8_BAR;
#undef PG8_SA
#undef PG8_SB
#undef PG8_STAGE
#undef PG8_LDA
#undef PG8_LDB
#undef PG8_MMA
#undef PG8_WAIT_V
#undef PG8_WAIT_L
#undef PG8_BAR
#undef PG8_SCHED
}
}

constexpr int D = 1024, NB = 4, SEQ = 8192, CTXL = 256, ML = NB * SEQ, MC = NB * CTXL, MALL = ML + MC;
constexpr int FF = 2816, MI = 2048, NH = 4, DH = 512, HROWS = 2 * SEQ;
constexpr float EPS = 1e-6f, ML_NORM_EPS = 1e-5f;
constexpr float HY_MAX_DECAY = -15.350567286626973f, HY_MIN_DECAY = -3.0701134573253945f;
constexpr int NWAVES = 8, NTHR = 512;
constexpr int LDS_BYTES = 147456;

constexpr size_t MiB = 1u << 20;
constexpr size_t WS_MOD = 1 * MiB;
constexpr size_t WS_CTXX = 2 * MiB;
constexpr size_t WS_H3 = 6 * MiB;
constexpr size_t WS_KTC = 9 * MiB;
constexpr size_t WS_GWT = 11 * MiB;
constexpr size_t WS_WKQ = 11 * MiB + 256 * 1024;
constexpr size_t WS_NC = 12 * MiB;
constexpr size_t WS_WHIN = 16 * MiB, WS_WHOUT = 22 * MiB, WS_WMIN = 24 * MiB, WS_WMDN = 32 * MiB, WS_WUP0 = 36 * MiB, WS_WUP1 = 47 * MiB, WS_WDN0 = 58 * MiB, WS_WDN1 = 58 * MiB + 5767168;
constexpr size_t WS_GATES_L = 69 * MiB;
constexpr size_t WS_GATES_C = 70 * MiB;
constexpr size_t WS_GT_L = 71 * MiB;
constexpr size_t WS_GT_C = 73 * MiB;
constexpr size_t WS_GC = 73 * MiB + 512 * 1024;
constexpr size_t WS_DN = 74 * MiB;
constexpr size_t WS_RS = 79 * MiB;
constexpr size_t WS_INV = 79 * MiB + 512 * 1024;
constexpr size_t BIG = 80 * MiB;
constexpr size_t HY_H = BIG, HY_P = BIG + 66 * MiB, HY_KT = BIG + 264 * MiB, HY_ZT = BIG + 328 * MiB, HY_ZTC = BIG + 392 * MiB, HY_KS = BIG + 394 * MiB;
constexpr size_t FF_H = BIG, FF_A = BIG + 66 * MiB, FF_G = BIG + 248 * MiB;
constexpr size_t MS_H = BIG, MS_XM = BIG + 32 * MiB, MS_XC = BIG + 96 * MiB, MS_KT = BIG + 160 * MiB, MS_VT = BIG + 224 * MiB, MS_NF = BIG + 288 * MiB, MS_NB = BIG + 352 * MiB,
                 MS_KTC = BIG + 416 * MiB, MS_VTC = BIG + 420 * MiB;
constexpr size_t MS_S = MS_XM, MS_Z = MS_KT, MS_KN = MS_NF, MS_XCC = MS_NB, MS_XMC = MS_NB + 4 * MiB, MS_HC = MS_NB + 8 * MiB;
constexpr size_t WS_END = BIG + 424 * MiB;
static_assert(WS_END <= 512 * MiB, "workspace map");
static_assert(FF_G + (size_t)MALL * FF * 2 <= 512 * MiB && FF_A + (size_t)MALL * FF * 2 <= FF_G, "ffn map");
static_assert(HY_P + (size_t)MALL * 3072 * 2 <= HY_KT && HY_ZTC + (size_t)NB * D * CTXL * 2 <= HY_KS && HY_KS + 32 * MiB <= 512 * MiB, "hyena map");

__device__ __forceinline__ unsigned f2bf(float f) { unsigned u = __float_as_uint(f); return (u + 0x7fffu + ((u >> 16) & 1u)) >> 16; }
typedef __bf16 bf16x2_t __attribute__((ext_vector_type(2)));
__device__ __forceinline__ unsigned pk2(float lo, float hi) { const f32x2 v = {lo, hi}; const bf16x2_t b = __builtin_convertvector(v, bf16x2_t); return __builtin_bit_cast(unsigned, b); }
__device__ __forceinline__ float bf2f(unsigned short b) { return __uint_as_float(((unsigned)b) << 16); }
__device__ __forceinline__ float bflo(unsigned w) { return __uint_as_float(w << 16); }
__device__ __forceinline__ float bfhi(unsigned w) { return __uint_as_float(w & 0xffff0000u); }
__device__ __forceinline__ void unpack8(const u32x4 v, float (&o)[8]) { o[0] = bflo(v.x); o[1] = bfhi(v.x); o[2] = bflo(v.y); o[3] = bfhi(v.y); o[4] = bflo(v.z); o[5] = bfhi(v.z); o[6] = bflo(v.w); o[7] = bfhi(v.w); }
__device__ __forceinline__ u32x4 pack8(const float (&o)[8]) { u32x4 v; v.x = pk2(o[0], o[1]); v.y = pk2(o[2], o[3]); v.z = pk2(o[4], o[5]); v.w = pk2(o[6], o[7]); return v; }
__device__ __forceinline__ float wave_sum(float v) {
#pragma unroll
    for (int o = 1; o < 64; o <<= 1) v += __shfl_xor(v, o);
    return v;
}
__device__ __forceinline__ float silu_f(float x) { return x / (1.0f + __expf(-x)); }

typedef const float* cfptr_t;
struct Fr {
    LAS unsigned char* lds; int tid, lane, wave, gw, ngw, G, bid;
    const __attribute__((address_space(4))) cfptr_t* in; float* out; unsigned char* ws;
};
#define IN(i) (F.in[i])
enum { I_X = 0, I_C, I_CTX, I_CCTX, I_MODW, I_MODB, I_NORMG, I_FINALG, I_HWIN, I_HBIN, I_HSCW, I_HSCB, I_FW1, I_FB1, I_FW2, I_FB2, I_FW3, I_FB3, I_FWOUT, I_FREQ, I_HBIAS, I_HWOUT, I_HBOUT,
       I_MWIN, I_MCW, I_MCB, I_MWQ, I_MWK, I_MWV, I_MWG, I_MBG, I_MNW, I_MSKIP, I_MWDN, I_FWUP, I_FCW, I_FCB, I_FWDN };

__device__ __forceinline__ void transpose_item(const float* W, int K, int N, bf16* WT, LAS float* scr, int item, int lane) {
    const int nblk = N / 32, kb = item / nblk, nb = item % nblk, k0 = 64 * kb, n0 = 32 * nb;
    float tv[32];
#pragma unroll
    for (int i = 0; i < 32; ++i) tv[i] = W[(size_t)(k0 + 2 * i + (lane >> 5)) * N + n0 + (lane & 31)];
#pragma unroll
    for (int i = 0; i < 32; ++i) scr[(2 * i + (lane >> 5)) * 33 + (lane & 31)] = tv[i];
    asm volatile("s_waitcnt lgkmcnt(0)" ::: "memory");
    const int c = lane & 7;
#pragma unroll
    for (int j = 0; j < 4; ++j) { const int n = (lane >> 3) + 8 * j; const LAS float* s = scr + (8 * c) * 33 + n;
        u32x4 o; o.x = pk2(s[0 * 33], s[1 * 33]); o.y = pk2(s[2 * 33], s[3 * 33]); o.z = pk2(s[4 * 33], s[5 * 33]); o.w = pk2(s[6 * 33], s[7 * 33]);
        *(u32x4*)(WT + (size_t)(n0 + n) * K + k0 + 8 * c) = o; }
    asm volatile("s_waitcnt lgkmcnt(0)" ::: "memory");
}
__device__ __forceinline__ void transpose_matrix(Fr& F, const float* W, int K, int N, bf16* WT) {
    LAS float* scr = (LAS float*)(F.lds + F.wave * 16384);
    const int nitems = (K / 64) * (N / 32);
    for (int it = F.gw; it < nitems; it += F.ngw) transpose_item(W, K, N, WT, scr, it, F.lane);
}

__device__ __forceinline__ void transpose_group(Fr& F, int grp, int vb, int nvb) {
    unsigned char* ws = F.ws; LAS float* scr = (LAS float*)(F.lds + F.wave * 16384);
    constexpr int I0 = (D / 64) * (3 * D / 32), I1 = (D / 64) * (D / 32), I2 = (D / 64) * (2 * MI / 32), I3 = (MI / 64) * (D / 32), I4 = (D / 64) * (2 * FF / 32), I5 = (FF / 64) * (D / 32);
    const int nit = grp == 0 ? I0 : (grp == 1 ? I1 : I2 + I3 + 2 * I4 + 2 * I5);
    for (int it = vb * NWAVES + F.wave; it < nit; it += nvb * NWAVES) {
        int r = it;
        if (grp == 0) { transpose_item(IN(I_HWIN), D, 3 * D, (bf16*)(ws + WS_WHIN), scr, r, F.lane); continue; }
        if (grp == 1) { transpose_item(IN(I_HWOUT), D, D, (bf16*)(ws + WS_WHOUT), scr, r, F.lane); continue; }
        if (r < I4) { transpose_item(IN(I_FWUP), D, 2 * FF, (bf16*)(ws + WS_WUP0), scr, r, F.lane); continue; } r -= I4;
        if (r < I5) { transpose_item(IN(I_FWDN), FF, D, (bf16*)(ws + WS_WDN0), scr, r, F.lane); continue; } r -= I5;
        if (r < I2) { transpose_item(IN(I_MWIN), D, 2 * MI, (bf16*)(ws + WS_WMIN), scr, r, F.lane); continue; } r -= I2;
        if (r < I3) { transpose_item(IN(I_MWDN), MI, D, (bf16*)(ws + WS_WMDN), scr, r, F.lane); continue; } r -= I3;
        if (r < I4) { transpose_item(IN(I_FWUP) + (size_t)D * 2 * FF, D, 2 * FF, (bf16*)(ws + WS_WUP1), scr, r, F.lane); continue; } r -= I4;
        transpose_item(IN(I_FWDN) + (size_t)FF * D, FF, D, (bf16*)(ws + WS_WDN1), scr, r, F.lane);
    }
}
__device__ __forceinline__ void transpose_in_tail(Fr& F, int grp, int nunits) {
    const int busy = nunits % F.G;
    if (busy == 0) transpose_group(F, grp, F.bid, F.G);
    else if (F.bid >= busy) transpose_group(F, grp, F.bid - busy, F.G - busy);
}

__device__ __forceinline__ void mod_layer(Fr& F, int l, int vb, int nvb) {
    LAS float* sc = (LAS float*)F.lds;
    LAS float* red = (LAS float*)(F.lds + 32768);
    __syncthreads();
    for (int i = F.tid; i < 5 * 1024; i += NTHR) { const int r = i >> 10, k = i & 1023; const float v = r < 4 ? IN(I_C)[r * 1024 + k] : IN(I_CCTX)[k]; sc[i] = silu_f(v); }
    __syncthreads();
    float* mod = (float*)(F.ws + WS_MOD);
    for (int it = vb; it < 96; it += nvb) {
        const int n0 = it * 64;
        const float* w = IN(I_MODW) + (size_t)l * 1024 * 6144 + n0 + F.lane;
        float a0 = 0.f, a1 = 0.f, a2 = 0.f, a3 = 0.f, a4 = 0.f;
        const int kb = F.wave * 128;
#pragma unroll 16
        for (int k = 0; k < 128; ++k) { const float wv = w[(size_t)(kb + k) * 6144];
            a0 += sc[kb + k] * wv; a1 += sc[1024 + kb + k] * wv; a2 += sc[2048 + kb + k] * wv; a3 += sc[3072 + kb + k] * wv; a4 += sc[4096 + kb + k] * wv; }
        red[(F.wave * 5 + 0) * 64 + F.lane] = a0; red[(F.wave * 5 + 1) * 64 + F.lane] = a1; red[(F.wave * 5 + 2) * 64 + F.lane] = a2; red[(F.wave * 5 + 3) * 64 + F.lane] = a3; red[(F.wave * 5 + 4) * 64 + F.lane] = a4;
        __syncthreads();
        if (F.tid < 320) { const int r = F.tid >> 6, ln = F.tid & 63; float s = 0.f;
#pragma unroll
            for (int w8 = 0; w8 < 8; ++w8) s += red[(w8 * 5 + r) * 64 + ln];
            mod[((size_t)l * 5 + r) * 6144 + n0 + ln] = s + IN(I_MODB)[l * 6144 + n0 + ln]; }
        __syncthreads();
    }
}

__device__ __forceinline__ void ph_prologue(Fr& F) {
    unsigned char* ws = F.ws;
    transpose_group(F, 0, F.bid, F.G);
    __syncthreads();
    mod_layer(F, 0, F.bid, F.G);
    {
        float* h3 = (float*)(ws + WS_H3);
        const float* w1 = IN(I_FW1); const float* w2 = IN(I_FW2); const float* w3 = IN(I_FW3);
        const float fr = IN(I_FREQ)[F.lane], b1 = IN(I_FB1)[F.lane], b2 = IN(I_FB2)[F.lane], b3 = IN(I_FB3)[F.lane];
        for (int row = F.gw; row < SEQ + CTXL; row += F.ngw) {
            const int L = row < SEQ ? SEQ : CTXL, i = row < SEQ ? row : row - SEQ;
            const float tl = (float)i / (float)(L - 1), w = 6.283185307179586f * (float)i / (float)L;
            float pos = 0.f; const int k = F.lane;
            if (k == 0) pos = tl;
            else if (k <= 16) { const float band = 1e-4f + (float)(k - 1) * ((15.0f - 1e-4f) / 15.0f); pos = cosf(band * w); }
            else if (k <= 32) { const float band = 1e-4f + (float)(k - 17) * ((15.0f - 1e-4f) / 15.0f); pos = -sinf(band * w); }
            float s = b1;
#pragma unroll
            for (int kk = 0; kk < 33; ++kk) s += __shfl(pos, kk) * w1[kk * 64 + F.lane];
            float h = sinf(fr * s);
            s = b2;
#pragma unroll 16
            for (int kk = 0; kk < 64; ++kk) s += __shfl(h, kk) * w2[kk * 64 + F.lane];
            h = sinf(fr * s);
            s = b3;
#pragma unroll 16
            for (int kk = 0; kk < 64; ++kk) s += __shfl(h, kk) * w3[kk * 64 + F.lane];
            h = sinf(fr * s);
            h3[(size_t)row * 64 + F.lane] = h;
        }
    }
    {
        bf16* gwt = (bf16*)(ws + WS_GWT); float* wkq = (float*)(ws + WS_WKQ);
        const float* wq = IN(I_MWQ); const float* wk = IN(I_MWK); const float* wv = IN(I_MWV); const float* wg = IN(I_MWG);
        const int gt = F.bid * NTHR + F.tid, nt = F.G * NTHR;
        for (int i = gt; i < MI * 16; i += nt) { const int ch = i >> 4, g = i & 15, n = ch >> 2, c = ch & 3; float sa = 0.f, sb = 0.f;
#pragma unroll
            for (int e = 0; e < 4; ++e) { sa += wq[n * 16 + c * 4 + e] * wg[(size_t)(n * 4 + e) * 16 + g] + wk[n * 16 + c * 4 + e] * wg[(size_t)(MI + n * 4 + e) * 16 + g];
                sb += wv[n * 16 + c * 4 + e] * wg[(size_t)(2 * MI + n * 4 + e) * 16 + g]; }
            const size_t go = ((size_t)(ch >> 5) * 64 + g + 16 * ((ch & 31) >> 3)) * 8 + (ch & 7);
            gwt[go] = (bf16)f2bf(sa); gwt[go + 64 * 512] = (bf16)f2bf(sb); }
        const float sc = 0.044194173824159216f;
        for (int i = gt; i < 512 * 16; i += nt) { const int n = i >> 4, c = (i >> 2) & 3, c2 = i & 3; float s = 0.f;
#pragma unroll
            for (int e = 0; e < 4; ++e) s += wk[n * 16 + c * 4 + e] * wq[n * 16 + c2 * 4 + e];
            wkq[i] = s * sc; }
    }
}

__device__ __forceinline__ void kt_items(Fr& F, const float* h3rows, int L, float* KT, int vgw, int vngw) {
    const float* wout = IN(I_FWOUT);
    const int nitems = (L / 16) * 32, fr = F.lane & 15, fq = F.lane >> 4;
    for (int it = vgw; it < nitems; it += vngw) {
        const int t0 = (it >> 5) * 16, n0 = (it & 31) * 64;
        float a[16];
#pragma unroll
        for (int ks = 0; ks < 16; ++ks) a[ks] = h3rows[(size_t)(t0 + fr) * 64 + 4 * ks + fq];
#pragma unroll
        for (int nt = 0; nt < 4; ++nt) {
            f32x4 acc = (f32x4){0.f, 0.f, 0.f, 0.f};
#pragma unroll
            for (int ks = 0; ks < 16; ++ks) acc = __builtin_amdgcn_mfma_f32_16x16x4f32(a[ks], wout[(size_t)(4 * ks + fq) * 2048 + n0 + nt * 16 + fr], acc, 0, 0, 0);
            const int n = n0 + nt * 16 + fr, dirn = n >> 10, c = n & 1023;
            const float delta = fabsf(HY_MIN_DECAY + (float)c * ((HY_MAX_DECAY - HY_MIN_DECAY) / 1023.0f)), il = 1.0f / (float)(L - 1);
            f32x4 o;
#pragma unroll
            for (int r = 0; r < 4; ++r) o[r] = acc[r] * __expf(-(float)(t0 + 4 * fq + r) * il * delta);
            *(f32x4*)(KT + ((size_t)c * 2 + dirn) * L + t0 + 4 * fq) = o;
        }
    }
}

__device__ __forceinline__ void modnorm_row(const float* xrow, const float* g, const float* sh, const float* sc, bf16* orow, int lane) {
    const f32x4* xr = (const f32x4*)xrow + lane; f32x4 v[4]; float s = 0.f;
#pragma unroll
    for (int j = 0; j < 4; ++j) { v[j] = xr[64 * j]; s += (v[j][0] * v[j][0] + v[j][1] * v[j][1]) + (v[j][2] * v[j][2] + v[j][3] * v[j][3]); }
    const float rinv = 1.0f / sqrtf(wave_sum(s) * (1.0f / 1024.0f) + EPS);
    u32x2* o8 = (u32x2*)orow + lane;
#pragma unroll
    for (int j = 0; j < 4; ++j) { const int c = 4 * lane + 256 * j; const f32x4 gg = *(const f32x4*)(g + c), s1 = *(const f32x4*)(sc + c), s0 = *(const f32x4*)(sh + c);
        const f32x4 y = (v[j] * rinv * gg) * (1.0f + s1) + s0; u32x2 w; w.x = pk2(y[0], y[1]); w.y = pk2(y[2], y[3]); o8[64 * j] = w; }
}
__device__ __forceinline__ void ph_modnorm(Fr& F, const float* xlat, int nlat, int b0, const float* xctx, int nctx, const float* g, const float* modl, int shoff, bf16* H,
                                           const bf16* dl = nullptr, float* olat = nullptr, float* octx = nullptr) {
    const int nrows = nlat + nctx;
    for (int r = F.gw; r < nrows; r += 2 * F.ngw) {
        const int r2 = r + F.ngw; const bool has2 = r2 < nrows; const int rb = has2 ? r2 : r;
        const bool isl = r < nlat, isl2 = rb < nlat;
        const size_t oa_ = isl ? (size_t)r * 1024 : (size_t)(r - nlat) * 1024, ob_ = isl2 ? (size_t)rb * 1024 : (size_t)(rb - nlat) * 1024;
        const float* xa = (isl ? xlat : xctx) + oa_; const float* xb = (isl2 ? xlat : xctx) + ob_;
        const int ma = isl ? b0 + r / SEQ : 4, mb = isl2 ? b0 + rb / SEQ : 4;
        const f32x4* pa = (const f32x4*)xa + F.lane; const f32x4* pb = (const f32x4*)xb + F.lane; f32x4 va[4], vb[4]; float sa = 0.f, sb = 0.f;
#pragma unroll
        for (int j = 0; j < 4; ++j) { va[j] = pa[64 * j]; vb[j] = pb[64 * j]; }
        if (dl) {
            const u32x2* da = (const u32x2*)(dl + (size_t)r * 1024) + F.lane; const u32x2* db = (const u32x2*)(dl + (size_t)rb * 1024) + F.lane;
            f32x4* qa = (f32x4*)((isl ? olat : octx) + oa_) + F.lane; f32x4* qb = (f32x4*)((isl2 ? olat : octx) + ob_) + F.lane;
#pragma unroll
            for (int j = 0; j < 4; ++j) { const u32x2 a = da[64 * j], b = db[64 * j];
                va[j] = va[j] + (f32x4){bflo(a.x), bfhi(a.x), bflo(a.y), bfhi(a.y)}; vb[j] = vb[j] + (f32x4){bflo(b.x), bfhi(b.x), bflo(b.y), bfhi(b.y)};
                qa[64 * j] = va[j]; if (has2) qb[64 * j] = vb[j]; }
        }
#pragma unroll
        for (int j = 0; j < 4; ++j) { sa += (va[j][0] * va[j][0] + va[j][1] * va[j][1]) + (va[j][2] * va[j][2] + va[j][3] * va[j][3]); sb += (vb[j][0] * vb[j][0] + vb[j][1] * vb[j][1]) + (vb[j][2] * vb[j][2] + vb[j][3] * vb[j][3]); }
        const float ra = 1.0f / sqrtf(wave_sum(sa) * (1.0f / 1024.0f) + EPS), rbv = 1.0f / sqrtf(wave_sum(sb) * (1.0f / 1024.0f) + EPS);
        const float* sha = modl + (size_t)ma * 6144 + shoff; const float* shb = modl + (size_t)mb * 6144 + shoff;
        u32x2* oa = (u32x2*)(H + (size_t)r * 1024) + F.lane; u32x2* ob = (u32x2*)(H + (size_t)rb * 1024) + F.lane;
#pragma unroll
        for (int j = 0; j < 4; ++j) { const int c = 4 * F.lane + 256 * j; const f32x4 gg = *(const f32x4*)(g + c);
            const f32x4 ya = (va[j] * ra * gg) * (1.0f + *(const f32x4*)(sha + 1024 + c)) + *(const f32x4*)(sha + c);
            const f32x4 yb = (vb[j] * rbv * gg) * (1.0f + *(const f32x4*)(shb + 1024 + c)) + *(const f32x4*)(shb + c);
            oa[64 * j] = (u32x2){pk2(ya[0], ya[1]), pk2(ya[2], ya[3])};
            if (has2) ob[64 * j] = (u32x2){pk2(yb[0], yb[1]), pk2(yb[2], yb[3])}; }
    }
}
__device__ __forceinline__ void add_delta_rows(Fr& F, float* x, const bf16* dl, int r0, int n) {
    for (int r = r0 + F.gw; r < r0 + n; r += F.ngw) {
        f32x4* px = (f32x4*)(x + (size_t)r * 1024) + F.lane; const u32x2* pd = (const u32x2*)(dl + (size_t)r * 1024) + F.lane; f32x4 v[4]; u32x2 d[4];
#pragma unroll
        for (int j = 0; j < 4; ++j) { v[j] = px[64 * j]; d[j] = pd[64 * j]; }
#pragma unroll
        for (int j = 0; j < 4; ++j) px[64 * j] = v[j] + (f32x4){bflo(d[j].x), bfhi(d[j].x), bflo(d[j].y), bfhi(d[j].y)};
    }
}

__device__ __forceinline__ void zt_items(Fr& F, const bf16* P, int rowbase, int nb, int Ls, bf16* ZT) {
    LAS unsigned char* tile = F.lds + F.wave * 16384;
    const float* scw = IN(I_HSCW); const float* scb = IN(I_HSCB);
    const int ntt = Ls / 64, nitems = nb * ntt * 16, tl = F.lane >> 3, c8 = F.lane & 7;
    for (int it = F.gw; it < nitems; it += F.ngw) {
        const int ct = it & 15, tt = (it >> 4) % ntt, b = (it >> 4) / ntt, t0 = tt * 64, ch = ct * 64 + c8 * 8;
        float w1[3][8], w2[3][8], b1[8], b2[8];
#pragma unroll
        for (int k = 0; k < 3; ++k) { const f32x4 a0 = *(const f32x4*)(scw + k * 3072 + 1024 + ch), a1 = *(const f32x4*)(scw + k * 3072 + 1024 + ch + 4), d0 = *(const f32x4*)(scw + k * 3072 + 2048 + ch), d1 = *(const f32x4*)(scw + k * 3072 + 2048 + ch + 4);
#pragma unroll
            for (int e = 0; e < 4; ++e) { w1[k][e] = a0[e]; w1[k][4 + e] = a1[e]; w2[k][e] = d0[e]; w2[k][4 + e] = d1[e]; } }
        { const f32x4 a0 = *(const f32x4*)(scb + 1024 + ch), a1 = *(const f32x4*)(scb + 1024 + ch + 4), d0 = *(const f32x4*)(scb + 2048 + ch), d1 = *(const f32x4*)(scb + 2048 + ch + 4);
#pragma unroll
            for (int e = 0; e < 4; ++e) { b1[e] = a0[e]; b1[4 + e] = a1[e]; b2[e] = d0[e]; b2[4 + e] = d1[e]; } }
        const bf16* pb = P + (size_t)(rowbase + b * Ls) * 3072 + ch;
#pragma unroll 2
        for (int i8 = 0; i8 < 8; ++i8) {
            const int tloc = i8 * 8 + tl, t = t0 + tloc, tm = t > 0 ? t - 1 : t, tp = t + 1 < Ls ? t + 1 : t; const float mm = t > 0 ? 1.f : 0.f, mp = t + 1 < Ls ? 1.f : 0.f;
            const u32x4 r1m = *(const u32x4*)(pb + (size_t)tm * 3072 + 1024), r1c = *(const u32x4*)(pb + (size_t)t * 3072 + 1024), r1p = *(const u32x4*)(pb + (size_t)tp * 3072 + 1024);
            const u32x4 r2m = *(const u32x4*)(pb + (size_t)tm * 3072 + 2048), r2c = *(const u32x4*)(pb + (size_t)t * 3072 + 2048), r2p = *(const u32x4*)(pb + (size_t)tp * 3072 + 2048);
            float xm[8], xc[8], xp[8], vm[8], vc[8], vp[8];
            unpack8(r1m, xm); unpack8(r1c, xc); unpack8(r1p, xp); unpack8(r2m, vm); unpack8(r2c, vc); unpack8(r2p, vp);
#pragma unroll
            for (int e = 0; e < 8; ++e) { const float a = w1[0][e] * (xm[e] * mm) + w1[1][e] * xc[e] + w1[2][e] * (xp[e] * mp) + b1[e], d = w2[0][e] * (vm[e] * mm) + w2[1][e] * vc[e] + w2[2][e] * (vp[e] * mp) + b2[e];
                *(LAS bf16*)(tile + (c8 * 8 + e) * 136 + tloc * 2) = (bf16)f2bf(a * d); }
        }
#pragma unroll
        for (int q = 0; q < 8; ++q) { const int cc = q * 8 + (F.lane >> 3), chk = F.lane & 7;
            const u32x2 lo = *(const LAS u32x2*)(tile + cc * 136 + chk * 16), hi = *(const LAS u32x2*)(tile + cc * 136 + chk * 16 + 8);
            u32x4 o; o.x = lo.x; o.y = lo.y; o.z = hi.x; o.w = hi.y;
            *(u32x4*)(ZT + ((size_t)b * 1024 + ct * 64 + cc) * Ls + t0 + chk * 8) = o; }
    }
}

__device__ __forceinline__ f32x2 cmul(f32x2 a, f32x2 b) { return (f32x2){a.x * b.x - a.y * b.y, a.x * b.y + a.y * b.x}; }
__device__ __forceinline__ f32x2 cmulc(f32x2 a, f32x2 b) { return (f32x2){a.x * b.x + a.y * b.y, a.y * b.x - a.x * b.y}; }
__device__ __forceinline__ f32x2 twid(float f) { return (f32x2){__builtin_amdgcn_cosf(f), __builtin_amdgcn_sinf(f)}; }
#define PH(e) ((e) + ((e) >> 4))
__device__ __forceinline__ void fft_fwd(LAS f32x2* buf, int tid, int plo, int phi) {
#pragma unroll 1
    for (int p = plo; p < phi; ++p) {
        const int lq = 12 - 2 * p, q = 1 << lq; const float invN = 1.0f / (float)(4 * q);
#pragma unroll 2
        for (int m = 0; m < 8; ++m) {
            const int g = tid + 512 * m, i = g & (q - 1), i0 = ((g >> lq) << (lq + 2)) + i;
            const int e0 = PH(i0), e1 = PH(i0 + q), e2 = PH(i0 + 2 * q), e3 = PH(i0 + 3 * q);
            const f32x2 a0 = buf[e0], a1 = buf[e1], a2 = buf[e2], a3 = buf[e3];
            const f32x2 t0 = a0 + a2, t1 = a0 - a2, t2 = a1 + a3, d = a1 - a3, t3 = (f32x2){d.y, -d.x};
            const f32x2 w1 = twid(-(float)i * invN), w2 = cmul(w1, w1), w3 = cmul(w2, w1);
            buf[e0] = t0 + t2; buf[e1] = cmul(t1 + t3, w1); buf[e2] = cmul(t0 - t2, w2); buf[e3] = cmul(t1 - t3, w3);
        }
        __syncthreads();
    }
}
__device__ __forceinline__ void fft_inv(LAS f32x2* buf, int tid, int plo, int phi) {
#pragma unroll 1
    for (int p = phi - 1; p >= plo; --p) {
        const int lq = 12 - 2 * p, q = 1 << lq; const float invN = 1.0f / (float)(4 * q);
#pragma unroll 2
        for (int m = 0; m < 8; ++m) {
            const int g = tid + 512 * m, i = g & (q - 1), i0 = ((g >> lq) << (lq + 2)) + i;
            const int e0 = PH(i0), e1 = PH(i0 + q), e2 = PH(i0 + 2 * q), e3 = PH(i0 + 3 * q);
            const f32x2 w1 = twid((float)i * invN), w2 = cmul(w1, w1), w3 = cmul(w2, w1);
            const f32x2 b0 = buf[e0], b1 = cmul(buf[e1], w1), b2 = cmul(buf[e2], w2), b3 = cmul(buf[e3], w3);
            const f32x2 t0 = b0 + b2, t1 = b0 - b2, t2 = b1 + b3, d = b1 - b3, t3 = (f32x2){-d.y, d.x};
            buf[e0] = t0 + t2; buf[e1] = t1 + t3; buf[e2] = t0 - t2; buf[e3] = t1 - t3;
        }
        __syncthreads();
    }
}
__device__ __forceinline__ void fwd16_A(f32x2 (&x)[16]) {
    const float C1 = 0.92387953251128674f, S1 = 0.38268343236508977f, R2 = 0.70710678118654752f;
#pragma unroll
    for (int i = 0; i < 4; ++i) {
        const f32x2 a0 = x[i], a1 = x[i + 4], a2 = x[i + 8], a3 = x[i + 12];
        const f32x2 t0 = a0 + a2, t1 = a0 - a2, t2 = a1 + a3, d = a1 - a3, t3 = (f32x2){d.y, -d.x};
        const f32x2 y1 = t1 + t3, y2 = t0 - t2, y3 = t1 - t3;
        x[i] = t0 + t2;
        if (i == 0) { x[4] = y1; x[8] = y2; x[12] = y3; }
        else if (i == 1) { x[5] = cmul(y1, (f32x2){C1, -S1}); x[9] = cmul(y2, (f32x2){R2, -R2}); x[13] = cmul(y3, (f32x2){S1, -C1}); }
        else if (i == 2) { x[6] = cmul(y1, (f32x2){R2, -R2}); x[10] = (f32x2){y2.y, -y2.x}; x[14] = cmul(y3, (f32x2){-R2, -R2}); }
        else { x[7] = cmul(y1, (f32x2){S1, -C1}); x[11] = cmul(y2, (f32x2){-R2, -R2}); x[15] = cmul(y3, (f32x2){-C1, S1}); }
    }
}
__device__ __forceinline__ void fwd16_B(f32x2 (&x)[16]) {
#pragma unroll
    for (int g = 0; g < 4; ++g) {
        const f32x2 a0 = x[4 * g], a1 = x[4 * g + 1], a2 = x[4 * g + 2], a3 = x[4 * g + 3];
        const f32x2 t0 = a0 + a2, t1 = a0 - a2, t2 = a1 + a3, d = a1 - a3, t3 = (f32x2){d.y, -d.x};
        x[4 * g] = t0 + t2; x[4 * g + 1] = t1 + t3; x[4 * g + 2] = t0 - t2; x[4 * g + 3] = t1 - t3;
    }
}
__device__ __forceinline__ void inv16_B(f32x2 (&x)[16]) {
#pragma unroll
    for (int g = 0; g < 4; ++g) {
        const f32x2 b0 = x[4 * g], b1 = x[4 * g + 1], b2 = x[4 * g + 2], b3 = x[4 * g + 3];
        const f32x2 t0 = b0 + b2, t1 = b0 - b2, t2 = b1 + b3, d = b1 - b3, t3 = (f32x2){-d.y, d.x};
        x[4 * g] = t0 + t2; x[4 * g + 1] = t1 + t3; x[4 * g + 2] = t0 - t2; x[4 * g + 3] = t1 - t3;
    }
}
__device__ __forceinline__ void inv16_A(f32x2 (&x)[16]) {
    const float C1 = 0.92387953251128674f, S1 = 0.38268343236508977f, R2 = 0.70710678118654752f;
#pragma unroll
    for (int i = 0; i < 4; ++i) {
        f32x2 b0 = x[i], b1 = x[i + 4], b2 = x[i + 8], b3 = x[i + 12];
        if (i == 1) { b1 = cmul(b1, (f32x2){C1, S1}); b2 = cmul(b2, (f32x2){R2, R2}); b3 = cmul(b3, (f32x2){S1, C1}); }
        else if (i == 2) { b1 = cmul(b1, (f32x2){R2, R2}); b2 = (f32x2){-b2.y, b2.x}; b3 = cmul(b3, (f32x2){-R2, R2}); }
        else if (i == 3) { b1 = cmul(b1, (f32x2){S1, C1}); b2 = cmul(b2, (f32x2){-R2, R2}); b3 = cmul(b3, (f32x2){-C1, -S1}); }
        const f32x2 t0 = b0 + b2, t1 = b0 - b2, t2 = b1 + b3, d = b1 - b3, t3 = (f32x2){-d.y, d.x};
        x[i] = t0 + t2; x[i + 4] = t1 + t3; x[i + 8] = t0 - t2; x[i + 12] = t1 - t3;
    }
}
__device__ __forceinline__ void fwd16(f32x2 (&x)[16]) { fwd16_A(x); fwd16_B(x); }
__device__ __forceinline__ void inv16(f32x2 (&x)[16]) { inv16_B(x); inv16_A(x); }
__device__ __forceinline__ void r16_fwd2(LAS f32x2* buf, int tid) {
#pragma unroll 1
  for (int lqp = 8; lqp >= 4; lqp -= 4) {
    const int qp = 1 << lqp; const float inv = 1.0f / (float)(16 * qp);
#pragma unroll
    for (int m = 0; m < 2; ++m) {
        const int g = tid + 512 * m, i = g & (qp - 1), e0 = ((g >> lqp) << (lqp + 4)) + i; f32x2 x[16];
#pragma unroll
        for (int j = 0; j < 16; ++j) x[j] = buf[PH(e0 + (j << lqp))];
        const f32x2 w1 = twid(-(float)i * inv), w2 = cmul(w1, w1), w3 = cmul(w2, w1), v1 = cmul(w2, w2), v2 = cmul(v1, v1), v3 = cmul(v2, v1);
        fwd16_A(x);
#pragma unroll
        for (int l = 0; l < 4; ++l) { x[l + 4] = cmul(x[l + 4], w1); x[l + 8] = cmul(x[l + 8], w2); x[l + 12] = cmul(x[l + 12], w3); }
        fwd16_B(x);
#pragma unroll
        for (int k = 0; k < 4; ++k) { x[4 * k + 1] = cmul(x[4 * k + 1], v1); x[4 * k + 2] = cmul(x[4 * k + 2], v2); x[4 * k + 3] = cmul(x[4 * k + 3], v3); }
#pragma unroll
        for (int j = 0; j < 16; ++j) buf[PH(e0 + (j << lqp))] = x[j];
    }
    __syncthreads();
  }
}
__device__ __forceinline__ void r16_inv2(LAS f32x2* buf, int tid) {
#pragma unroll 1
  for (int lqp = 4; lqp <= 8; lqp += 4) {
    const int qp = 1 << lqp; const float inv = 1.0f / (float)(16 * qp);
#pragma unroll
    for (int m = 0; m < 2; ++m) {
        const int g = tid + 512 * m, i = g & (qp - 1), e0 = ((g >> lqp) << (lqp + 4)) + i; f32x2 x[16];
#pragma unroll
        for (int j = 0; j < 16; ++j) x[j] = buf[PH(e0 + (j << lqp))];
        const f32x2 w1 = twid((float)i * inv), w2 = cmul(w1, w1), w3 = cmul(w2, w1), v1 = cmul(w2, w2), v2 = cmul(v1, v1), v3 = cmul(v2, v1);
#pragma unroll
        for (int k = 0; k < 4; ++k) { x[4 * k + 1] = cmul(x[4 * k + 1], v1); x[4 * k + 2] = cmul(x[4 * k + 2], v2); x[4 * k + 3] = cmul(x[4 * k + 3], v3); }
        inv16_B(x);
#pragma unroll
        for (int l = 0; l < 4; ++l) { x[l + 4] = cmul(x[l + 4], w1); x[l + 8] = cmul(x[l + 8], w2); x[l + 12] = cmul(x[l + 12], w3); }
        inv16_A(x);
#pragma unroll
        for (int j = 0; j < 16; ++j) buf[PH(e0 + (j << lqp))] = x[j];
    }
    __syncthreads();
  }
}
__device__ __forceinline__ float block_sum(Fr& F, float v, LAS float* red) {
    v = wave_sum(v);
    __syncthreads();
    if (F.lane == 0) red[F.wave] = v;
    __syncthreads();
    float s = 0.f;
#pragma unroll
    for (int w = 0; w < 8; ++w) s += red[w];
    return s;
}
__device__ __forceinline__ void ph_fftconv(Fr& F) {
    LAS f32x2* buf = (LAS f32x2*)F.lds; LAS float* red = (LAS float*)(F.lds + 139392);
    const float* KT = (const float*)(F.ws + HY_KT); const float* KTC = (const float*)(F.ws + WS_KTC);
    bf16* ZT = (bf16*)(F.ws + HY_ZT); bf16* ZTC = (bf16*)(F.ws + HY_ZTC);
    const int tid = F.tid;
    for (int c = F.bid; c < 1024; c += F.G) {
        const float bias = IN(I_HBIAS)[c];
        __syncthreads();
        float asum = 0.f;
        const f32x4* kf = (const f32x4*)(KT + (size_t)c * 2 * SEQ); const f32x4* kb = kf + SEQ / 4;
#pragma unroll
        for (int q = 0; q < 4; ++q) { const int i4 = tid + 512 * q; const f32x4 v = kf[i4];
            asum += fabsf(v[0]) + fabsf(v[1]) + fabsf(v[2]) + fabsf(v[3]);
            buf[PH(4 * i4)] = (f32x2){v[0], 0.f}; buf[PH(4 * i4 + 1)] = (f32x2){v[1], 0.f}; buf[PH(4 * i4 + 2)] = (f32x2){v[2], 0.f}; buf[PH(4 * i4 + 3)] = (f32x2){v[3], 0.f};
            const f32x4 u = kb[i4]; const int m = 4 * i4;
            if (m > 0) { buf[PH(16384 - m)] = (f32x2){u[0], 0.f}; asum += fabsf(u[0]); } else buf[PH(8192)] = (f32x2){0.f, 0.f};
            buf[PH(16384 - m - 1)] = (f32x2){u[1], 0.f}; buf[PH(16384 - m - 2)] = (f32x2){u[2], 0.f}; buf[PH(16384 - m - 3)] = (f32x2){u[3], 0.f};
            asum += fabsf(u[1]) + fabsf(u[2]) + fabsf(u[3]); }
        const float S = block_sum(F, asum, red);
        __syncthreads();
        fft_fwd(buf, tid, 0, 1); r16_fwd2(buf, tid);
        f32x4* Ks = (f32x4*)(F.ws + HY_KS) + (size_t)(F.bid & 255) * 8192 + tid * 8; const float ksc = 1.0f / (S * 16384.0f);
#pragma unroll 1
        for (int m = 0; m < 2; ++m) { const int pb = 17 * (tid + 512 * m); f32x2 x[16];
#pragma unroll
            for (int n = 0; n < 16; ++n) x[n] = buf[pb + n];
            fwd16(x);
#pragma unroll
            for (int n = 0; n < 8; ++n) Ks[m * 4096 + n] = (f32x4){x[2 * n].x * ksc, x[2 * n].y * ksc, x[2 * n + 1].x * ksc, x[2 * n + 1].y * ksc}; }
        const f32x2 dl = twid(-1.0f / 16384.0f);
#pragma unroll 1
        for (int pr = 0; pr < 2; ++pr) {
            bf16* z0 = ZT + ((size_t)(2 * pr) * 1024 + c) * SEQ; bf16* z1 = ZT + ((size_t)(2 * pr + 1) * 1024 + c) * SEQ;
            const int i8 = tid * 8;
            __syncthreads();
            {
                float a[8], b[8], cx[8], dx[8];
                unpack8(*(const u32x4*)(z0 + i8), a); unpack8(*(const u32x4*)(z1 + i8), b); unpack8(*(const u32x4*)(z0 + 4096 + i8), cx); unpack8(*(const u32x4*)(z1 + 4096 + i8), dx);
                f32x2 w1 = twid(-(float)i8 * (1.0f / 16384.0f));
#pragma unroll
                for (int e = 0; e < 8; ++e) { const f32x2 a0 = (f32x2){a[e], b[e]}, a1 = (f32x2){cx[e], dx[e]}, t3 = (f32x2){a1.y, -a1.x}; const f32x2 w2 = cmul(w1, w1), w3 = cmul(w2, w1);
                    buf[PH(i8 + e)] = a0 + a1; buf[PH(4096 + i8 + e)] = cmul(a0 + t3, w1); buf[PH(8192 + i8 + e)] = cmul(a0 - a1, w2); buf[PH(12288 + i8 + e)] = cmul(a0 - t3, w3);
                    w1 = cmul(w1, dl); }
            }
            __syncthreads();
            r16_fwd2(buf, tid);
#pragma unroll 1
            for (int m = 0; m < 2; ++m) { const int pb = 17 * (tid + 512 * m); f32x2 x[16];
#pragma unroll
                for (int n = 0; n < 16; ++n) x[n] = buf[pb + n];
                fwd16(x);
#pragma unroll
                for (int n = 0; n < 8; ++n) { const f32x4 k = Ks[m * 4096 + n]; x[2 * n] = cmul(x[2 * n], (f32x2){k[0], k[1]}); x[2 * n + 1] = cmul(x[2 * n + 1], (f32x2){k[2], k[3]}); }
                inv16(x);
#pragma unroll
                for (int n = 0; n < 16; ++n) buf[pb + n] = x[n]; }
            __syncthreads();
            r16_inv2(buf, tid);
            {
                float a[8], b[8], cx[8], dx[8];
                unpack8(*(const u32x4*)(z0 + i8), a); unpack8(*(const u32x4*)(z1 + i8), b); unpack8(*(const u32x4*)(z0 + 4096 + i8), cx); unpack8(*(const u32x4*)(z1 + 4096 + i8), dx);
                f32x2 w1 = twid(-(float)i8 * (1.0f / 16384.0f));
#pragma unroll
                for (int e = 0; e < 8; ++e) { const f32x2 w2 = cmul(w1, w1), w3 = cmul(w2, w1);
                    const f32x2 b0 = buf[PH(i8 + e)], b1 = cmulc(buf[PH(4096 + i8 + e)], w1), b2 = cmulc(buf[PH(8192 + i8 + e)], w2), b3 = cmulc(buf[PH(12288 + i8 + e)], w3);
                    const f32x2 t0 = b0 + b2, t1 = b0 - b2, t2 = b1 + b3, d = b1 - b3, t3 = (f32x2){-d.y, d.x};
                    const f32x2 y0 = t0 + t2, y1 = t1 + t3;
                    a[e] = y0.x + a[e] * bias; b[e] = y0.y + b[e] * bias; cx[e] = y1.x + cx[e] * bias; dx[e] = y1.y + dx[e] * bias;
                    w1 = cmul(w1, dl); }
                *(u32x4*)(z0 + i8) = pack8(a); *(u32x4*)(z1 + i8) = pack8(b); *(u32x4*)(z0 + 4096 + i8) = pack8(cx); *(u32x4*)(z1 + 4096 + i8) = pack8(dx);
            }
        }
        __syncthreads();
        {
            LAS float* kc = (LAS float*)F.lds; LAS float* zc = kc + 512;
            const float* kfc = KTC + (size_t)c * 2 * CTXL; float v = 0.f;
            { const int n = tid; if (n < 256) v = kfc[n]; else if (n == 256) v = 0.f; else v = kfc[CTXL + (512 - n)]; kc[n] = v; }
            const float Sc = block_sum(F, fabsf(v), red);
            for (int i = tid; i < 1024; i += NTHR) { const int b = i >> 8, t = i & 255; zc[i] = bf2f(ZTC[((size_t)b * 1024 + c) * CTXL + t]); }
            __syncthreads();
            const int b = tid >> 7, t2 = tid & 127; const float isc = 1.0f / Sc;
#pragma unroll
            for (int hh = 0; hh < 2; ++hh) { const int t = t2 + 128 * hh; float acc = 0.f;
#pragma unroll 8
                for (int s = 0; s < 256; ++s) acc += zc[b * 256 + s] * kc[(t - s) & 511];
                ZTC[((size_t)b * 1024 + c) * CTXL + t] = (bf16)f2bf(acc * isc + zc[b * 256 + t] * bias); }
        }
    }
}

__device__ __forceinline__ void u2_items(Fr& F, const bf16* P, int rowbase, int nb, int Ls, const bf16* YT, bf16* U2) {
    LAS unsigned char* tile = F.lds + F.wave * 16384;
    const float* scw = IN(I_HSCW); const float* scb = IN(I_HSCB);
    const int ntt = Ls / 64, nitems = nb * ntt * 16, tl = F.lane >> 3, c8 = F.lane & 7;
    for (int it = F.gw; it < nitems; it += F.ngw) {
        const int ct = it & 15, tt = (it >> 4) % ntt, b = (it >> 4) / ntt, t0 = tt * 64, ch = ct * 64 + c8 * 8;
#pragma unroll
        for (int q = 0; q < 8; ++q) { const int cc = q * 8 + (F.lane >> 3), chk = F.lane & 7;
            const u32x4 v = *(const u32x4*)(YT + ((size_t)b * 1024 + ct * 64 + cc) * Ls + t0 + chk * 8);
            *(LAS u32x2*)(tile + cc * 136 + chk * 16) = (u32x2){v.x, v.y}; *(LAS u32x2*)(tile + cc * 136 + chk * 16 + 8) = (u32x2){v.z, v.w}; }
        float w0[3][8], bb[8];
#pragma unroll
        for (int k = 0; k < 3; ++k) { const f32x4 a0 = *(const f32x4*)(scw + k * 3072 + ch), a1 = *(const f32x4*)(scw + k * 3072 + ch + 4);
#pragma unroll
            for (int e = 0; e < 4; ++e) { w0[k][e] = a0[e]; w0[k][4 + e] = a1[e]; } }
        { const f32x4 a0 = *(const f32x4*)(scb + ch), a1 = *(const f32x4*)(scb + ch + 4);
#pragma unroll
            for (int e = 0; e < 4; ++e) { bb[e] = a0[e]; bb[4 + e] = a1[e]; } }
        const bf16* pb = P + (size_t)(rowbase + b * Ls) * 3072 + ch; bf16* ub = U2 + (size_t)(rowbase + b * Ls) * 1024 + ch;
#pragma unroll 2
        for (int i8 = 0; i8 < 8; ++i8) {
            const int tloc = i8 * 8 + tl, t = t0 + tloc, tm = t > 0 ? t - 1 : t, tp = t + 1 < Ls ? t + 1 : t; const float mm = t > 0 ? 1.f : 0.f, mp = t + 1 < Ls ? 1.f : 0.f;
            const u32x4 rm = *(const u32x4*)(pb + (size_t)tm * 3072), rc = *(const u32x4*)(pb + (size_t)t * 3072), rp = *(const u32x4*)(pb + (size_t)tp * 3072);
            float xm[8], xc[8], xp[8], o[8];
            unpack8(rm, xm); unpack8(rc, xc); unpack8(rp, xp);
#pragma unroll
            for (int e = 0; e < 8; ++e) { const float x0 = w0[0][e] * (xm[e] * mm) + w0[1][e] * xc[e] + w0[2][e] * (xp[e] * mp) + bb[e]; o[e] = x0 * bf2f(*(const LAS bf16*)(tile + (c8 * 8 + e) * 136 + tloc * 2)); }
            *(u32x4*)(ub + (size_t)t * 1024) = pack8(o);
        }
    }
}

__device__ __forceinline__ void dw_item(const bf16* G, bf16* A, const float* cw, const float* cb, int f8, int rowtok0, int nx, int x0, bool up_ok, bool down_ok) {
    float w[9][8], bias[8];
#pragma unroll
    for (int k = 0; k < 9; ++k) { const float m = (k < 3) ? (up_ok ? 1.f : 0.f) : ((k >= 6) ? (down_ok ? 1.f : 0.f) : 1.f);
        const f32x4 w0 = *(const f32x4*)(cw + (size_t)k * FF + f8) * m, w1 = *(const f32x4*)(cw + (size_t)k * FF + f8 + 4) * m;
        w[k][0] = w0[0]; w[k][1] = w0[1]; w[k][2] = w0[2]; w[k][3] = w0[3]; w[k][4] = w1[0]; w[k][5] = w1[1]; w[k][6] = w1[2]; w[k][7] = w1[3]; }
    { const f32x4 b0 = *(const f32x4*)(cb + f8), b1 = *(const f32x4*)(cb + f8 + 4); bias[0] = b0[0]; bias[1] = b0[1]; bias[2] = b0[2]; bias[3] = b0[3]; bias[4] = b1[0]; bias[5] = b1[1]; bias[6] = b1[2]; bias[7] = b1[3]; }
    const int upo = up_ok ? -nx : 0, dno = down_ok ? nx : 0;
    const bf16* g0 = G + (size_t)rowtok0 * FF + f8; bf16* a0 = A + (size_t)rowtok0 * FF + f8;
    const u32x4 zero4 = (u32x4){0u, 0u, 0u, 0u};
    u32x4 cm[3], cc[3], cp[3];
    { const int xm = x0 > 0 ? x0 - 1 : 0; const bool okm = x0 > 0;
        cm[0] = *(const u32x4*)(g0 + (size_t)(xm + upo) * FF); cm[1] = *(const u32x4*)(g0 + (size_t)xm * FF); cm[2] = *(const u32x4*)(g0 + (size_t)(xm + dno) * FF);
        if (!okm) { cm[0] = zero4; cm[1] = zero4; cm[2] = zero4; }
        cc[0] = *(const u32x4*)(g0 + (size_t)(x0 + upo) * FF); cc[1] = *(const u32x4*)(g0 + (size_t)x0 * FF); cc[2] = *(const u32x4*)(g0 + (size_t)(x0 + dno) * FF); }
#pragma unroll 4
    for (int j = 0; j < 32; ++j) {
        const int x = x0 + j, xp = x + 1 < nx ? x + 1 : nx - 1; const bool okp = x + 1 < nx;
        cp[0] = *(const u32x4*)(g0 + (size_t)(xp + upo) * FF); cp[1] = *(const u32x4*)(g0 + (size_t)xp * FF); cp[2] = *(const u32x4*)(g0 + (size_t)(xp + dno) * FF);
        const u32x4 av = *(const u32x4*)(a0 + (size_t)x * FF);
        if (!okp) { cp[0] = zero4; cp[1] = zero4; cp[2] = zero4; }
        float acc[8];
#pragma unroll
        for (int e = 0; e < 8; ++e) acc[e] = bias[e];
#pragma unroll
        for (int dy = 0; dy < 3; ++dy) { float v[8];
            unpack8(cm[dy], v);
#pragma unroll
            for (int e = 0; e < 8; ++e) acc[e] += v[e] * w[dy * 3 + 0][e];
            unpack8(cc[dy], v);
#pragma unroll
            for (int e = 0; e < 8; ++e) acc[e] += v[e] * w[dy * 3 + 1][e];
            unpack8(cp[dy], v);
#pragma unroll
            for (int e = 0; e < 8; ++e) acc[e] += v[e] * w[dy * 3 + 2][e]; }
        float a[8]; unpack8(av, a);
#pragma unroll
        for (int e = 0; e < 8; ++e) a[e] = silu_f(acc[e]) * a[e];
        *(u32x4*)(a0 + (size_t)x * FF) = pack8(a);
#pragma unroll
        for (int dy = 0; dy < 3; ++dy) { cm[dy] = cc[dy]; cc[dy] = cp[dy]; }
    }
}
__device__ __forceinline__ void ph_dwconv(Fr& F, int layer, int nlat, int nctx) {
    bf16* A = (bf16*)(F.ws + FF_A); const bf16* G = (const bf16*)(F.ws + FF_G);
    const float* cw = IN(I_FCW) + (size_t)layer * 9 * FF; const float* cb = IN(I_FCB) + (size_t)layer * FF;
    const int ngrp = (F.G % 8 == 0) ? 8 : 1, xg = F.bid % ngrp, lb = F.bid / ngrp, nlb = F.G / ngrp;
    const int nseg = nlat / 32, band = nseg / ngrp;
    for (int i = lb * NTHR + F.tid; i < band * 352; i += nlb * NTHR) {
        const int sl = i / 352, f8 = (i - sl * 352) * 8, seg = xg * band + sl, grow = seg >> 1, gy = grow & 127;
        dw_item(G, A, cw, cb, f8, grow * 64, 64, (seg & 1) * 32, gy > 0, gy < 127);
    }
    const int nsegc = nctx / 32;
    for (int i = F.bid * NTHR + F.tid; i < nsegc * 352; i += F.G * NTHR) {
        const int sl = i / 352, f8 = (i - sl * 352) * 8;
        dw_item(G, A, cw, cb, f8, nlat + (sl >> 3) * CTXL, CTXL, (sl & 7) * 32, false, false);
    }
}

__device__ __forceinline__ void prep_items(Fr& F, const bf16* XM, int nb, int Ls, bf16* XC, bf16* KN, bf16* KT, bf16* VT) {
    LAS unsigned char* tk = F.lds + F.wave * 17408; LAS unsigned char* tv = tk + 8704;
    const int ntt = Ls / 64, nitems = nb * ntt * 32;
    const int tl = F.lane >> 3, c8 = F.lane & 7;
    for (int it = F.gw; it < nitems; it += F.ngw) {
        const int cg = it & 31, tt = (it >> 5) % ntt, b = (it >> 5) / ntt, t0 = tt * 64, ch0 = cg * 64 + c8 * 8, h = cg >> 3;
        float cw0[8], cw1[8], cw2[8], cbb[8], wkq[32], wv[32];
        { const float* p = IN(I_MCW) + ch0; const float* pb = IN(I_MCB) + ch0;
#pragma unroll
            for (int e = 0; e < 8; ++e) { cw0[e] = p[e]; cw1[e] = p[MI + e]; cw2[e] = p[2 * MI + e]; cbb[e] = pb[e]; }
            const float* q = (const float*)(F.ws + WS_WKQ) + (ch0 >> 2) * 16; const float* v = IN(I_MWV) + (ch0 >> 2) * 16;
#pragma unroll
            for (int e = 0; e < 32; ++e) { wkq[e] = q[e]; wv[e] = v[e]; } }
#pragma unroll 2
        for (int i8 = 0; i8 < 8; ++i8) {
            const int tloc = i8 * 8 + tl, t = t0 + tloc; const size_t row = (size_t)b * Ls + t;
            float xp[8], xm[8], xn[8];
            const size_t rowp = row - (t > 0 ? 1 : 0), rown = row + (t + 1 < Ls ? 1 : 0); const size_t ctile = (size_t)(ch0 >> 5) * 512 + ((ch0 & 31) >> 3) * 128;
            const u32x4 rm = *(const u32x4*)(XM + (row >> 4) * 32768 + ctile + (row & 15) * 8), rp = *(const u32x4*)(XM + (rowp >> 4) * 32768 + ctile + (rowp & 15) * 8), rn = *(const u32x4*)(XM + (rown >> 4) * 32768 + ctile + (rown & 15) * 8);
            unpack8(rm, xm); unpack8(rp, xp); unpack8(rn, xn);
            { const float mp = t > 0 ? 1.f : 0.f, mn = t + 1 < Ls ? 1.f : 0.f;
#pragma unroll
                for (int e = 0; e < 8; ++e) { xp[e] *= mp; xn[e] *= mn; } }
            float xc[8], kp[8], vv[8];
#pragma unroll
            for (int e = 0; e < 8; ++e) xc[e] = silu_f(cw0[e] * xp[e] + cw1[e] * xm[e] + cw2[e] * xn[e] + cbb[e]);
#pragma unroll
            for (int n = 0; n < 2; ++n)
#pragma unroll
                for (int o = 0; o < 4; ++o) { float sk = 0.f, sv = 0.f;
#pragma unroll
                    for (int c = 0; c < 4; ++c) { sk += xc[n * 4 + c] * wkq[n * 16 + c * 4 + o]; sv += xm[n * 4 + c] * wv[n * 16 + c * 4 + o]; }
                    kp[n * 4 + o] = sk; vv[n * 4 + o] = sv; }
            { const size_t to = ((size_t)(row >> 4) * 64 + (ch0 >> 5)) * 512 + (((unsigned)row & 15u) + 16u * ((ch0 & 31) >> 3)) * 8u;
              *(u32x4*)(XC + to) = pack8(xc); *(u32x4*)(KN + to) = pack8(kp); }
#pragma unroll
            for (int e = 0; e < 8; ++e) { *(LAS bf16*)(tk + (c8 * 8 + e) * 136 + tloc * 2) = (bf16)f2bf(kp[e]); *(LAS bf16*)(tv + (c8 * 8 + e) * 136 + tloc * 2) = (bf16)f2bf(vv[e]); }
        }
#pragma unroll
        for (int q = 0; q < 8; ++q) { const int dt = q >> 1, kq = q & 1, r = F.lane & 15, q4 = F.lane >> 4;
            const size_t tile = ((size_t)(t0 >> 7) * 32 + (cg & 7) * 4 + dt) * 4 + ((t0 & 127) >> 5) + kq;
            const size_t o = (size_t)(b * 4 + h) * 512 * Ls + tile * 512 + F.lane * 8;
            { const u32x2 lo = *(const LAS u32x2*)(tk + (dt * 16 + r) * 136 + kq * 64 + q4 * 16), hi = *(const LAS u32x2*)(tk + (dt * 16 + r) * 136 + kq * 64 + q4 * 16 + 8); *(u32x4*)(KT + o) = (u32x4){lo.x, lo.y, hi.x, hi.y}; }
            { const u32x2 lo = *(const LAS u32x2*)(tv + (dt * 16 + r) * 136 + kq * 64 + q4 * 16), hi = *(const LAS u32x2*)(tv + (dt * 16 + r) * 136 + kq * 64 + q4 * 16 + 8); *(u32x4*)(VT + o) = (u32x4){lo.x, lo.y, hi.x, hi.y}; }
        }
    }
}

__device__ __forceinline__ void gate_items(Fr& F, const bf16* XC, const bf16* XM, int R, float* GATES) {
    const bf16* gwt = (const bf16*)(F.ws + WS_GWT);
    const int fr = F.lane & 15, fq = F.lane >> 4, half = F.wave & 1, pr = F.wave >> 1, ntiles = R / 16;
    LAS f32x4* xch = (LAS f32x4*)(F.lds + pr * 1024);
    for (int base = F.bid * 4; base < ntiles; base += F.G * 4) {
        const int tile = base + pr; const bool ok = tile < ntiles; const int tl = ok ? tile : 0;
        f32x4 acc = (f32x4){0.f, 0.f, 0.f, 0.f};
        const bf16* ap = (half ? XM : XC) + (size_t)tl * 32768 + F.lane * 8; const bf16* bp = gwt + (size_t)half * 64 * 512 + F.lane * 8;
#pragma unroll 16
        for (int ks = 0; ks < 64; ++ks) acc = __builtin_amdgcn_mfma_f32_16x16x32_bf16(*(const bf16x8*)(ap + ks * 512), *(const bf16x8*)(bp + ks * 512), acc, 0, 0, 0);
        __syncthreads();
        if (half) xch[F.lane] = acc;
        __syncthreads();
        if (!half && ok) { acc = acc + xch[F.lane];
            const int r0 = tile * 16; const float bg = IN(I_MBG)[fr]; const bool isf = (fr >> 2) & 1;
#pragma unroll
            for (int r = 0; r < 4; ++r) { float x = acc[r] + bg; if (isf) x = fminf(x, 0.f) - log1pf(__expf(-fabsf(x))); GATES[(size_t)(r0 + 4 * fq + r) * 16 + fr] = x; } }
    }
}

__device__ __forceinline__ void cum_items(Fr& F, const float* GATES, int nb, int Ls, int gb0, int ctau0, f32x4* GT, float* GC) {
    const int R = nb * Ls, nch = Ls / 128, nitems = 2 * nb * 4 * nch;
    for (int it = F.gw; it < nitems; it += F.ngw) {
        const int c = it % nch, h = (it / nch) & 3, b = (it / nch / 4) % nb, dir = it / nch / 4 / nb;
        const int row0 = b * Ls + c * 128 + 2 * F.lane;
        const float lf0 = GATES[(size_t)row0 * 16 + dir * 8 + 4 + h], lf1 = GATES[(size_t)(row0 + 1) * 16 + dir * 8 + 4 + h];
        const float ig0 = GATES[(size_t)row0 * 16 + dir * 8 + h], ig1 = GATES[(size_t)(row0 + 1) * 16 + dir * 8 + h];
        float inc = lf0 + lf1;
#pragma unroll
        for (int o = 1; o < 64; o <<= 1) { const float t = __shfl_up(inc, o); if (F.lane >= o) inc += t; }
        const float tot = __shfl(inc, 63), exc = inc - (lf0 + lf1);
        float b0, b1;
        if (dir == 0) { b0 = exc + lf0; b1 = inc; } else { b0 = tot - exc; b1 = tot - exc - lf0; }
        GT[(size_t)(dir * 4 + h) * R + row0] = (f32x4){b0, ig0 - b0, __expf(b0), __expf(tot - b0 + ig0)};
        GT[(size_t)(dir * 4 + h) * R + row0 + 1] = (f32x4){b1, ig1 - b1, __expf(b1), __expf(tot - b1 + ig1)};
        if (F.lane == 0) GC[((size_t)(dir * 4 + gb0 + b) * 4 + h) * 66 + ctau0 + c] = __expf(tot);
    }
}

__device__ __forceinline__ void cum_block(Fr& F, const float* GATES, int grow0, int h, f32x4* GT0, f32x4* GT1, float* GC0, float* GC1, LAS float* tab) {
    if (F.wave < 2) {
        const int dir = F.wave, j0 = 2 * F.lane;
        const float* gp = GATES + (size_t)(grow0 + j0) * 16 + dir * 8 + h;
        const float ig0 = gp[0], lf0 = gp[4], ig1 = gp[16], lf1 = gp[20];
        float inc = lf0 + lf1;
#pragma unroll
        for (int o = 1; o < 64; o <<= 1) { const float t = __shfl_up(inc, o); if (F.lane >= o) inc += t; }
        const float tot = __shfl(inc, 63), exc = inc - (lf0 + lf1);
        float b0, b1;
        if (dir == 0) { b0 = exc + lf0; b1 = inc; } else { b0 = tot - exc; b1 = tot - exc - lf0; }
        const float w0 = __expf(tot - b0 + ig0), w1 = __expf(tot - b1 + ig1);
        f32x4* gt = (dir ? GT1 : GT0) + grow0 + j0;
        gt[0] = (f32x4){b0, ig0 - b0, __expf(b0), w0}; gt[1] = (f32x4){b1, ig1 - b1, __expf(b1), w1};
        LAS float* t = tab + dir * 384;
        t[j0] = b0; t[j0 + 1] = b1; t[128 + j0] = ig0 - b0; t[128 + j0 + 1] = ig1 - b1; t[256 + j0] = w0; t[256 + j0 + 1] = w1;
        if (F.lane == 0) *(dir ? GC1 : GC0) = __expf(tot);
    }
}
__device__ __forceinline__ void dn_block(Fr& F, const bf16* KTchunk, const LAS float* tab, float* DN0, float* DN1) {
    const LAS float* w0 = tab + 256; const LAS float* w1 = tab + 384 + 256;
    const bf16* kr = KTchunk + (size_t)(F.tid >> 4) * 4 * 512 + (F.tid & 15) * 8; float s0 = 0.f, s1 = 0.f;
#pragma unroll 4
    for (int q = 0; q < 16; ++q) { const int ks = q >> 2, q4 = q & 3; float v[8]; unpack8(*(const u32x4*)(kr + ks * 512 + q4 * 128), v);
#pragma unroll
        for (int e = 0; e < 8; ++e) { s0 += v[e] * w0[q * 8 + e]; s1 += v[e] * w1[q * 8 + e]; } }
    DN0[F.tid] = s0; DN1[F.tid] = s1;
}
__device__ __forceinline__ void ph_sphase(Fr& F, int hb, bool with_ctx) {
    const bf16* XC = (const bf16*)(F.ws + MS_XC); const bf16* KN = (const bf16*)(F.ws + MS_KN); const bf16* KT = (const bf16*)(F.ws + MS_KT);
    f32x4* GT = (f32x4*)(F.ws + WS_GT_L); float* DN = (float*)(F.ws + WS_DN); float* RS = (float*)(F.ws + WS_RS); float* GC = (float*)(F.ws + WS_GC);
    const float* GATES = (const float*)(F.ws + WS_GATES_L);
    bf16* S = (bf16*)(F.ws + MS_S);
    LAS float* tab = (LAS float*)(F.lds + 1024);
    const int fr = F.lane & 15, fq = F.lane >> 4, w = F.wave;
    for (int it = F.bid; it < 512; it += F.G) {
        const int c = it & 63, h = (it >> 6) & 3, bl = it >> 8, gb = 2 * hb + bl;
        const int row0 = bl * SEQ + c * 128;
        __syncthreads();
        cum_block(F, GATES, row0, h, GT + (size_t)(0 * 4 + h) * HROWS, GT + (size_t)(1 * 4 + h) * HROWS,
                  GC + ((size_t)(0 * 4 + gb) * 4 + h) * 66 + 2 + c, GC + ((size_t)(1 * 4 + gb) * 4 + h) * 66 + 2 + c, tab);
        __syncthreads();
        dn_block(F, KT + (size_t)(bl * 4 + h) * 512 * SEQ + (size_t)c * 65536, tab,
                 DN + (((size_t)(0 * 4 + gb) * 4 + h) * 66 + 2 + c) * 512, DN + (((size_t)(1 * 4 + gb) * 4 + h) * 66 + 2 + c) * 512);
        const int irow = row0 + 16 * w + fr;
        bf16x8 bq[16];
        { const bf16* p = XC + ((size_t)((row0 >> 4) + w) * 64 + h * 16) * 512 + F.lane * 8;
#pragma unroll
            for (int ks = 0; ks < 16; ++ks) bq[ks] = *(const bf16x8*)(p + ks * 512); }
        const float bif = tab[16 * w + fr], bib = tab[384 + 16 * w + fr];
        float rsf = 0.f, rsb = 0.f;
        bf16* sf = S + ((size_t)(0 * 8 + bl * 4 + h) * 64 + c) * 16384; bf16* sb = S + ((size_t)(1 * 8 + bl * 4 + h) * 64 + c) * 16384;
#pragma unroll 1
        for (int jt = 0; jt < 8; ++jt) {
            f32x4 acc = (f32x4){0.f, 0.f, 0.f, 0.f};
            const bf16* ap = KN + ((size_t)((row0 >> 4) + jt) * 64 + h * 16) * 512 + F.lane * 8;
#pragma unroll
            for (int ks = 0; ks < 16; ++ks) acc = __builtin_amdgcn_mfma_f32_16x16x32_bf16(*(const bf16x8*)(ap + ks * 512), bq[ks], acc, 0, 0, 0);
            float vf[4], vb[4];
            const f32x4 af4 = *(const LAS f32x4*)(tab + 128 + jt * 16 + 4 * fq), ab4 = *(const LAS f32x4*)(tab + 384 + 128 + jt * 16 + 4 * fq);
#pragma unroll
            for (int r = 0; r < 4; ++r) { const int j = jt * 16 + 4 * fq + r, i = 16 * w + fr;
                vf[r] = (j <= i) ? acc[r] * __expf(bif + af4[r]) : 0.f; vb[r] = (j >= i) ? acc[r] * __expf(bib + ab4[r]) : 0.f;
                rsf += vf[r]; rsb += vb[r]; }
            const size_t so = (size_t)(w * 4 + (jt >> 1)) * 512 + (fr + 16 * ((jt & 1) * 2 + (fq >> 1))) * 8 + (fq & 1) * 4;
            *(u32x2*)(sf + so) = (u32x2){pk2(vf[0], vf[1]), pk2(vf[2], vf[3])};
            *(u32x2*)(sb + so) = (u32x2){pk2(vb[0], vb[1]), pk2(vb[2], vb[3])};
        }
        rsf += __shfl_xor(rsf, 16); rsf += __shfl_xor(rsf, 32); rsb += __shfl_xor(rsb, 16); rsb += __shfl_xor(rsb, 32);
        if (fq == 0) { RS[(size_t)(0 * 4 + h) * HROWS + irow] = rsf; RS[(size_t)(1 * 4 + h) * HROWS + irow] = rsb; }
    }
    if (with_ctx) {
        const bf16* KTC2 = (const bf16*)(F.ws + MS_KTC); f32x4* GTC = (f32x4*)(F.ws + WS_GT_C); const float* GATESC = (const float*)(F.ws + WS_GATES_C);
        for (int it = F.bid; it < 32; it += F.G) {
            const int cc = it & 1, h = (it >> 1) & 3, gb = it >> 3;
            __syncthreads();
            cum_block(F, GATESC, gb * CTXL + cc * 128, h, GTC + (size_t)(0 * 4 + h) * MC, GTC + (size_t)(1 * 4 + h) * MC,
                      GC + ((size_t)(0 * 4 + gb) * 4 + h) * 66 + cc, GC + ((size_t)(1 * 4 + gb) * 4 + h) * 66 + cc, tab);
            __syncthreads();
            dn_block(F, KTC2 + (size_t)(gb * 4 + h) * 512 * CTXL + (size_t)cc * 65536, tab,
                     DN + (((size_t)(0 * 4 + gb) * 4 + h) * 66 + cc) * 512, DN + (((size_t)(1 * 4 + gb) * 4 + h) * 66 + cc) * 512);
        }
    }
}

__device__ __forceinline__ bf16x8 ldg16(const char* ub, unsigned off) { return *(const bf16x8*)(ub + off); }
__device__ __forceinline__ void ph_scan(Fr& F, int hb) {
    const char* XC = (const char*)(F.ws + MS_XC); const char* KT = (const char*)(F.ws + MS_KT); const char* VT = (const char*)(F.ws + MS_VT);
    const char* KTC2 = (const char*)(F.ws + MS_KTC); const char* VTC2 = (const char*)(F.ws + MS_VTC);
    const char* S = (const char*)(F.ws + MS_S);
    const f32x4* GTL = (const f32x4*)(F.ws + WS_GT_L); const f32x4* GTC = (const f32x4*)(F.ws + WS_GT_C);
    const float* GC = (const float*)(F.ws + WS_GC); const float* DN = (const float*)(F.ws + WS_DN);
    float* NC = (float*)(F.ws + WS_NC);
    LAS unsigned char* cbf = F.lds;
    LAS float* wl = (LAS float*)(F.lds + 2 * 33280);
    LAS unsigned char* vtb = F.lds + 2 * 33280 + 1024;
    const int w = F.wave;
    for (int wi = F.bid; wi < 256; wi += F.G) {
        const int chain = wi & 15, slice = wi >> 4, dir = chain >> 3, bl = (chain >> 2) & 1, h = chain & 3, gb = 2 * hb + bl, e0 = slice * 32;
        char* NUM = (char*)(F.ws + (dir ? MS_NB : MS_NF));
        const bool nwriter = (slice == 0) && (w == 0);
        f32x4 acc[4][2];
#pragma unroll
        for (int a = 0; a < 4; ++a)
#pragma unroll
            for (int b = 0; b < 2; ++b) acc[a][b] = (f32x4){0.f, 0.f, 0.f, 0.f};
        float nreg[8];
#pragma unroll
        for (int e = 0; e < 8; ++e) nreg[e] = 0.f;
        const char* ktc = KTC2 + (size_t)(gb * 4 + h) * 512 * CTXL * 2; const char* vtc = VTC2 + (size_t)(gb * 4 + h) * 512 * CTXL * 2;
        const char* ktl = KT + (size_t)(bl * 4 + h) * 512 * SEQ * 2;    const char* vtl = VT + (size_t)(bl * 4 + h) * 512 * SEQ * 2;
        const f32x4* gtc = GTC + (size_t)(dir * 4 + h) * MC + gb * CTXL; const f32x4* gtl = GTL + (size_t)(dir * 4 + h) * HROWS + bl * SEQ;
        const float* gcb = GC + ((size_t)(dir * 4 + gb) * 4 + h) * 66; const float* dnb = DN + ((size_t)(dir * 4 + gb) * 4 + h) * 66 * 512;
#pragma unroll 1
        for (int s = 0; s < 2; ++s) {
            const int cc = dir == 0 ? s : 1 - s; const unsigned l16 = F.lane * 16u, fq = F.lane >> 4;
            __syncthreads();
            if (F.tid < 128) wl[F.tid] = gtc[cc * 128 + F.tid][3];
            __syncthreads();
            const float Gd = gcb[cc]; const char* ktu = ktc + (size_t)cc * 131072; const char* vtu = vtc + (size_t)cc * 131072 + (e0 >> 4) * 4096;
#pragma unroll
            for (int a = 0; a < 4; ++a)
#pragma unroll
                for (int b = 0; b < 2; ++b) acc[a][b] = acc[a][b] * Gd;
#pragma unroll
            for (int ks = 0; ks < 4; ++ks) {
                bf16x8 bv[2];
#pragma unroll
                for (int et = 0; et < 2; ++et) { float v[8]; unpack8(__builtin_bit_cast(u32x4, ldg16(vtu + et * 4096 + ks * 1024, l16)), v);
#pragma unroll
                    for (int e = 0; e < 8; ++e) v[e] *= wl[ks * 32 + 8 * fq + e];
                    const u32x4 pv = pack8(v); bv[et] = __builtin_bit_cast(bf16x8, pv); }
#pragma unroll
                for (int dt = 0; dt < 4; ++dt) { const bf16x8 kk = ldg16(ktu + (4 * w + dt) * 4096 + ks * 1024, l16);
#pragma unroll
                    for (int et = 0; et < 2; ++et) acc[dt][et] = __builtin_amdgcn_mfma_f32_16x16x32_bf16(kk, bv[et], acc[dt][et], 0, 0, 0); }
            }
            { const unsigned lo = F.lane * 32u; const f32x4 d0 = *(const f32x4*)((const char*)(dnb + cc * 512) + lo), d1 = *(const f32x4*)((const char*)(dnb + cc * 512) + lo + 16u);
                nreg[0] = Gd * nreg[0] + d0[0]; nreg[1] = Gd * nreg[1] + d0[1]; nreg[2] = Gd * nreg[2] + d0[2]; nreg[3] = Gd * nreg[3] + d0[3];
                nreg[4] = Gd * nreg[4] + d1[0]; nreg[5] = Gd * nreg[5] + d1[1]; nreg[6] = Gd * nreg[6] + d1[2]; nreg[7] = Gd * nreg[7] + d1[3]; }
        }
        const int cfirst = dir == 0 ? 0 : 63;
        bf16x8 xf[16];
        __syncthreads();
        { const int fr = F.lane & 15, fq = F.lane >> 4; const unsigned l16 = F.lane * 16u;
#pragma unroll
            for (int dt = 0; dt < 4; ++dt)
#pragma unroll
                for (int et = 0; et < 2; ++et) *(LAS u32x2*)(cbf + (16 * et + fr) * 1040 + (64 * w + 16 * dt + 4 * fq) * 2) = (u32x2){pk2(acc[dt][et][0], acc[dt][et][1]), pk2(acc[dt][et][2], acc[dt][et][3])};
            if (F.tid < 128) wl[F.tid] = gtl[cfirst * 128 + F.tid][3];
            *(LAS bf16x8*)(vtb + w * 1024 + l16) = ldg16(vtl + (size_t)cfirst * 131072 + (e0 >> 4) * 4096 + w * 1024, l16);
            const char* xc0 = XC + ((size_t)(((bl * SEQ + cfirst * 128) >> 4) + w) * 64 + h * 16) * 1024;
#pragma unroll
            for (int ks = 0; ks < 16; ++ks) xf[ks] = ldg16(xc0 + ks * 1024, l16); }
        __syncthreads();
#pragma unroll 1
        for (int q = 0; q < 64; ++q) {
            int tid_ = F.tid; asm volatile("" : "+v"(tid_));
            const int lane_ = tid_ & 63, fr = lane_ & 15, fq = lane_ >> 4; const unsigned l16 = lane_ * 16u;
            const int c = dir == 0 ? q : 63 - q;
            const int qn = q < 63 ? q + 1 : 63, cn = dir == 0 ? qn : 63 - qn;
            const int qp = q < 62 ? q + 2 : 63, cp = dir == 0 ? qp : 63 - qp;
            const char* ktu = ktl + (size_t)c * 131072;
            const int row0 = bl * SEQ + c * 128;
            const float Gd = gcb[2 + c];
            LAS unsigned char* cb_rd = cbf + (q & 1) * 33280; LAS unsigned char* cb_wr = cbf + ((q + 1) & 1) * 33280;
            const LAS float* wl_rd = wl + (q & 1) * 128; LAS float* wl_wr = wl + ((q + 1) & 1) * 128;
            const LAS unsigned char* vt_rd = vtb + (q & 1) * 8192; LAS unsigned char* vt_wr = vtb + ((q + 1) & 1) * 8192;
            const bf16x8 vnext = ldg16(vtl + (size_t)cn * 131072 + (e0 >> 4) * 4096 + w * 1024, l16);
            const float wnext = *(const float*)((const char*)(gtl + cn * 128) + (unsigned)(tid_ & 127) * 16u + 12u);
            const float Ei = *(const float*)((const char*)(gtl + c * 128 + 16 * w) + (unsigned)fr * 16u + 8u);
            const f32x4 dn0 = *(const f32x4*)((const char*)(dnb + (2 + c) * 512) + lane_ * 32u), dn1 = *(const f32x4*)((const char*)(dnb + (2 + c) * 512) + lane_ * 32u + 16u);
            bf16x8 kf[4][4], vf[2][4], sfr[4];
            { const char* su = S + ((size_t)(dir * 8 + bl * 4 + h) * 64 + c) * 32768 + w * 4096;
#pragma unroll
                for (int ks = 0; ks < 4; ++ks) sfr[ks] = ldg16(su + ks * 1024, l16); }
#pragma unroll
            for (int dt = 0; dt < 4; ++dt) kf[0][dt] = ldg16(ktu + (4 * w + dt) * 4096, l16);
            unsigned pf;
            {
                const char* kt3 = ktl + (size_t)cp * 131072; const char* vt3 = vtl + (size_t)cp * 131072;
                const char* xc3 = XC + ((size_t)((bl * SEQ + cp * 128) >> 4) * 64 + h * 16) * 1024; const char* s3p = S + ((size_t)(dir * 8 + bl * 4 + h) * 64 + cp) * 32768;
                const unsigned t = tid_ < 208 ? tid_ : tid_ - 208; const bool g0 = t < 64, g1 = t < 128, g2 = t < 192;
                const unsigned ln2 = slice * 64 + (t - 128);
                const char* ub = g0 ? kt3 : (g1 ? vt3 : (g2 ? xc3 : s3p));
                const unsigned off = g0 ? (slice * 64 + t) * 128u : (g1 ? (e0 >> 4) * 4096u + (t - 64) * 128u : (g2 ? (ln2 >> 7) * 65536u + (ln2 & 127) * 128u : (slice * 16 + ((t - 192) & 15)) * 128u));
                pf = *(const volatile unsigned*)(ub + off);
            }
#pragma unroll
            for (int et = 0; et < 2; ++et)
#pragma unroll
                for (int ks = 0; ks < 4; ++ks) vf[et][ks] = *(const LAS bf16x8*)(vt_rd + (et * 4 + ks) * 1024 + l16);
            if (nwriter) { char* np = (char*)(NC + (((size_t)(dir * 2 + bl) * 4 + h) * 64 + c) * 512); const unsigned lo = lane_ * 32u;
                *(f32x4*)(np + lo) = (f32x4){nreg[0], nreg[1], nreg[2], nreg[3]}; *(f32x4*)(np + lo + 16u) = (f32x4){nreg[4], nreg[5], nreg[6], nreg[7]}; }
            f32x4 a2[2] = {(f32x4){0.f, 0.f, 0.f, 0.f}, (f32x4){0.f, 0.f, 0.f, 0.f}};
#pragma unroll
            for (int ks = 0; ks < 16; ++ks)
#pragma unroll
                for (int et = 0; et < 2; ++et) a2[et] = __builtin_amdgcn_mfma_f32_16x16x32_bf16(*(const LAS bf16x8*)(cb_rd + (16 * et + fr) * 1040 + ks * 64 + fq * 16), xf[ks], a2[et], 0, 0, 0);
            asm volatile("" ::: "memory");
#pragma unroll
            for (int ks = 1; ks < 4; ++ks)
#pragma unroll
                for (int dt = 0; dt < 4; ++dt) kf[ks][dt] = ldg16(ktu + (4 * w + dt) * 4096 + ks * 1024, l16);
            a2[0] = a2[0] * Ei; a2[1] = a2[1] * Ei;
#pragma unroll
            for (int ks = 0; ks < 4; ++ks)
#pragma unroll
                for (int et = 0; et < 2; ++et) a2[et] = __builtin_amdgcn_mfma_f32_16x16x32_bf16(vf[et][ks], sfr[ks], a2[et], 0, 0, 0);
            { char* nu = NUM + ((size_t)row0 * MI + h * 512 + e0) * 2; const unsigned ln = ((16u * w + fr) * MI + 4u * fq) * 2u;
#pragma unroll
                for (int et = 0; et < 2; ++et) *(u32x2*)(nu + et * 32 + ln) = (u32x2){pk2(a2[et][0], a2[et][1]), pk2(a2[et][2], a2[et][3])}; }
#pragma unroll
            for (int a = 0; a < 4; ++a)
#pragma unroll
                for (int b = 0; b < 2; ++b) acc[a][b] = acc[a][b] * Gd;
#pragma unroll
            for (int ks = 0; ks < 4; ++ks) {
                bf16x8 bv[2];
#pragma unroll
                for (int et = 0; et < 2; ++et) { float v[8]; unpack8(__builtin_bit_cast(u32x4, vf[et][ks]), v);
                    const f32x4 wa = *(const LAS f32x4*)(wl_rd + ks * 32 + 8 * fq), wb = *(const LAS f32x4*)(wl_rd + ks * 32 + 8 * fq + 4);
                    v[0] *= wa[0]; v[1] *= wa[1]; v[2] *= wa[2]; v[3] *= wa[3]; v[4] *= wb[0]; v[5] *= wb[1]; v[6] *= wb[2]; v[7] *= wb[3];
                    const u32x4 pv = pack8(v); bv[et] = __builtin_bit_cast(bf16x8, pv); }
#pragma unroll
                for (int dt = 0; dt < 4; ++dt)
#pragma unroll
                    for (int et = 0; et < 2; ++et) acc[dt][et] = __builtin_amdgcn_mfma_f32_16x16x32_bf16(kf[ks][dt], bv[et], acc[dt][et], 0, 0, 0);
            }
            asm volatile("" ::: "memory");
            { const char* xc2 = XC + ((size_t)(((bl * SEQ + cn * 128) >> 4) + w) * 64 + h * 16) * 1024;
#pragma unroll
                for (int ks = 0; ks < 16; ++ks) xf[ks] = ldg16(xc2 + ks * 1024, l16); }
            nreg[0] = Gd * nreg[0] + dn0[0]; nreg[1] = Gd * nreg[1] + dn0[1]; nreg[2] = Gd * nreg[2] + dn0[2]; nreg[3] = Gd * nreg[3] + dn0[3];
            nreg[4] = Gd * nreg[4] + dn1[0]; nreg[5] = Gd * nreg[5] + dn1[1]; nreg[6] = Gd * nreg[6] + dn1[2]; nreg[7] = Gd * nreg[7] + dn1[3];
            *(LAS bf16x8*)(vt_wr + w * 1024 + l16) = vnext;
            wl_wr[tid_ & 127] = wnext;
#pragma unroll
            for (int dt = 0; dt < 4; ++dt)
#pragma unroll
                for (int et = 0; et < 2; ++et) *(LAS u32x2*)(cb_wr + (16 * et + fr) * 1040 + (64 * w + 16 * dt + 4 * fq) * 2) = (u32x2){pk2(acc[dt][et][0], acc[dt][et][1]), pk2(acc[dt][et][2], acc[dt][et][3])};
            asm volatile("" :: "v"(pf));
            __syncthreads();
        }
    }
}

__device__ __forceinline__ void ph_mout(Fr& F) {
    bf16* NF = (bf16*)(F.ws + MS_NF); const bf16* NBk = (const bf16*)(F.ws + MS_NB); const bf16* XC = (const bf16*)(F.ws + MS_XC); const bf16* Z = (const bf16*)(F.ws + MS_Z);
    const float* NC = (const float*)(F.ws + WS_NC); const float* RS = (const float*)(F.ws + WS_RS); const f32x4* GTL = (const f32x4*)(F.ws + WS_GT_L);
    LAS unsigned char* xt = F.lds + F.wave * 16640;
    for (int it = F.gw; it < (HROWS / 16) * 4; it += F.ngw) {
        const int rt = it >> 2, h = it & 3, bl = rt >> 9, c = (rt >> 3) & 63;
        { const bf16* xp = XC + ((size_t)rt * 64 + h * 16) * 512 + F.lane * 8; u32x4 t[16];
#pragma unroll
            for (int ks = 0; ks < 16; ++ks) t[ks] = *(const u32x4*)(xp + ks * 512);
#pragma unroll
            for (int ks = 0; ks < 16; ++ks) *(LAS u32x4*)(xt + ks * 1040 + F.lane * 16) = t[ks]; }
        const float* n0 = NC + (((size_t)(0 * 2 + bl) * 4 + h) * 64 + c) * 512 + 8 * F.lane; const float* n1 = NC + (((size_t)(1 * 2 + bl) * 4 + h) * 64 + c) * 512 + 8 * F.lane;
        const f32x4 n00 = *(const f32x4*)n0, n01 = *(const f32x4*)(n0 + 4), n10 = *(const f32x4*)n1, n11 = *(const f32x4*)(n1 + 4);
        float nw[8], sk[8];
        { const float* pw = IN(I_MNW) + h * 512 + 8 * F.lane; const float* ps = IN(I_MSKIP) + h * 512 + 8 * F.lane;
#pragma unroll
            for (int e = 0; e < 8; ++e) { nw[e] = pw[e]; sk[e] = ps[e]; } }
#pragma unroll 2
        for (int r = 0; r < 16; ++r) {
            const int row = rt * 16 + r; const size_t o = (size_t)row * MI + h * 512 + 8 * F.lane;
            float nf[8], nb[8], xc[8], z[8];
            unpack8(*(const u32x4*)(NF + o), nf); unpack8(*(const u32x4*)(NBk + o), nb); unpack8(*(const u32x4*)(Z + o), z);
            unpack8(*(const LAS u32x4*)(xt + (F.lane >> 2) * 1040 + (r + 16 * (F.lane & 3)) * 16), xc);
            float d0 = xc[0] * n00[0] + xc[1] * n00[1] + xc[2] * n00[2] + xc[3] * n00[3] + xc[4] * n01[0] + xc[5] * n01[1] + xc[6] * n01[2] + xc[7] * n01[3];
            float d1 = xc[0] * n10[0] + xc[1] * n10[1] + xc[2] * n10[2] + xc[3] * n10[3] + xc[4] * n11[0] + xc[5] * n11[1] + xc[6] * n11[2] + xc[7] * n11[3];
            d0 = wave_sum(d0); d1 = wave_sum(d1);
            const float den0 = GTL[(size_t)(0 * 4 + h) * HROWS + row][2] * d0 + RS[(size_t)(0 * 4 + h) * HROWS + row], den1 = GTL[(size_t)(1 * 4 + h) * HROWS + row][2] * d1 + RS[(size_t)(1 * 4 + h) * HROWS + row];
            const float i0 = 1.0f / fmaxf(fabsf(den0), 1.0f), i1 = 1.0f / fmaxf(fabsf(den1), 1.0f);
            float s = 0.f;
#pragma unroll
            for (int e = 0; e < 8; ++e) { nf[e] = nf[e] * i0 + nb[e] * i1; s += nf[e]; }
            const float mu = wave_sum(s) * (1.0f / 512.0f); float q = 0.f;
#pragma unroll
            for (int e = 0; e < 8; ++e) { nf[e] -= mu; q += nf[e] * nf[e]; }
            const float rstd = 1.0f / sqrtf(wave_sum(q) * (1.0f / 512.0f) + ML_NORM_EPS);
#pragma unroll
            for (int e = 0; e < 8; ++e) nf[e] = (nf[e] * rstd * nw[e] + sk[e] * xc[e]) * silu_f(z[e]);
            *(u32x4*)(NF + o) = pack8(nf);
        }
    }
}

__device__ __forceinline__ void ph_final(Fr& F, const bf16* dl) {
    const float* g = IN(I_FINALG);
    for (int r = F.gw; r < ML; r += 2 * F.ngw) {
        const int r2 = r + F.ngw < ML ? r + F.ngw : r;
        f32x4* xa = (f32x4*)(F.out + (size_t)r * 1024) + F.lane; f32x4* xb = (f32x4*)(F.out + (size_t)r2 * 1024) + F.lane; f32x4 va[4], vb[4]; float sa = 0.f, sb = 0.f;
        const u32x2* da = (const u32x2*)(dl + (size_t)r * 1024) + F.lane; const u32x2* db = (const u32x2*)(dl + (size_t)r2 * 1024) + F.lane;
#pragma unroll
        for (int j = 0; j < 4; ++j) { const u32x2 a = da[64 * j], b = db[64 * j];
            va[j] = xa[64 * j] + (f32x4){bflo(a.x), bfhi(a.x), bflo(a.y), bfhi(a.y)}; vb[j] = xb[64 * j] + (f32x4){bflo(b.x), bfhi(b.x), bflo(b.y), bfhi(b.y)}; }
#pragma unroll
        for (int j = 0; j < 4; ++j) { sa += (va[j][0] * va[j][0] + va[j][1] * va[j][1]) + (va[j][2] * va[j][2] + va[j][3] * va[j][3]); sb += (vb[j][0] * vb[j][0] + vb[j][1] * vb[j][1]) + (vb[j][2] * vb[j][2] + vb[j][3] * vb[j][3]); }
        const float ra = 1.0f / sqrtf(wave_sum(sa) * (1.0f / 1024.0f) + EPS), rb = 1.0f / sqrtf(wave_sum(sb) * (1.0f / 1024.0f) + EPS);
#pragma unroll
        for (int j = 0; j < 4; ++j) { const f32x4 gg = *(const f32x4*)(g + 4 * F.lane + 256 * j); xa[64 * j] = va[j] * ra * gg; if (r2 != r) xb[64 * j] = vb[j] * rb * gg; }
    }
}

template <class Epi>
__device__ __forceinline__ void run_gemm(Fr& F, const bf16* A, const bf16* Bt, int M, int N, int K, const Epi& E) {
    pg8::Gemm g{A, Bt, M, N, K}; pg8::StaticOrder S; S.init(M, N, F.G, F.bid);
    pg8::gemm_phase<Epi, pg8::StaticOrder, true, true>(F.lds, g, S, E, F.tid);
}

struct Args { const float* in[38]; float* out; unsigned char* ws; int ph_lo, ph_hi; };
static_assert(sizeof(Args) == 328 && offsetof(Args, out) == 304 && offsetof(Args, ws) == 312 && offsetof(Args, ph_lo) == 320, "Args layout");
constexpr int N_PHASES = 34;


#define XB_TMO      128
#define XB_XCNT(j)  (256  + 64 * (j))
#define XB_XSUB(j)  (1280 + 64 * (j))
#define XB_XGEN(j)  (2304 + 64 * (j))
#define XB_TOP      3328
#define XB_TOPGEN   3392
#define XCD_BAR_WORDS 3456
#define XB_SPIN_CAP (1u << 22)
__device__ __forceinline__ unsigned xb_ld(unsigned* p)              { return __hip_atomic_load(p, __ATOMIC_RELAXED, __HIP_MEMORY_SCOPE_AGENT); }
__device__ __forceinline__ unsigned xb_add(unsigned* p, unsigned v) { return __hip_atomic_fetch_add(p, v, __ATOMIC_RELAXED, __HIP_MEMORY_SCOPE_AGENT); }
__device__ __forceinline__ unsigned xb_xcc_id() { return (unsigned)__builtin_amdgcn_s_getreg((3 << 11) | 20) & 0xFu; }
#define XB_SPIN(cond, bar) do { unsigned _sp = 0; while (cond) { __builtin_amdgcn_s_sleep(1); \
    if ((++_sp & 255u) == 0u) { if (xb_ld(&(bar)[XB_TMO])) break; if (_sp > XB_SPIN_CAP) { atomicAdd(&(bar)[XB_TMO], 1u); break; } } } } while (0)
__device__ __forceinline__ void xcd_barrier_complete(unsigned* bar, unsigned x, unsigned& nloc, unsigned& nx) {
    const unsigned G = gridDim.x * gridDim.y * gridDim.z;
    unsigned sum, cnt, mine, sp = 0u;
    for (;;) {
        sum = 0u; cnt = 0u; mine = 0u;
#pragma unroll
        for (unsigned j = 0; j < 16; ++j) { const unsigned c = xb_ld(&bar[XB_XCNT(j)]); sum += c; cnt += (c > 0u) ? 1u : 0u; mine = (j == x) ? c : mine; }
        if (sum == G) break;
        __builtin_amdgcn_s_sleep(1);
        if ((++sp & 255u) == 0u) { if (xb_ld(&bar[XB_TMO])) break; if (sp > XB_SPIN_CAP) { atomicAdd(&bar[XB_TMO], 1u); break; } }
    }
    nloc = mine > 0u ? mine : 1u; nx = cnt > 0u ? cnt : 1u;
}
__device__ __forceinline__ void xcd_barrier(unsigned* bar, volatile LAS unsigned* st) {
    asm volatile("s_waitcnt vmcnt(0)" ::: "memory");
    __syncthreads();
    if (threadIdx.x == 0) {
        const unsigned x = xb_xcc_id();
        __builtin_amdgcn_s_waitcnt(0);
        unsigned nloc = st[0], nx = st[1];
        if (nloc == 0u) { xcd_barrier_complete(bar, x, nloc, nx); st[0] = nloc; st[1] = nx; }
        const unsigned old = xb_add(&bar[XB_XSUB(x)], 1u);
        const unsigned gen = old / nloc;
        if (old + 1u == (gen + 1u) * nloc) {
            __builtin_amdgcn_fence(__ATOMIC_RELEASE, "agent");
            asm volatile("s_waitcnt vmcnt(0)" ::: "memory");
            const unsigned og = xb_add(&bar[XB_TOP], 1u);
            const unsigned tg = og / nx;
            if (og + 1u == (tg + 1u) * nx) xb_add(&bar[XB_TOPGEN], 1u);
            else XB_SPIN(xb_ld(&bar[XB_TOPGEN]) == tg, bar);
            __builtin_amdgcn_fence(__ATOMIC_ACQUIRE, "agent");
            xb_add(&bar[XB_XGEN(x)], 1u);
            asm volatile("s_waitcnt vmcnt(0)" ::: "memory");
        } else {
            XB_SPIN(xb_ld(&bar[XB_XGEN(x)]) == gen, bar);
            __builtin_amdgcn_fence(__ATOMIC_ACQUIRE, "agent");
            asm volatile("s_waitcnt vmcnt(0)" ::: "memory");
        }
    }
    __syncthreads();
}
#ifndef PROBE_MASK
#define PROBE_MASK 0ull
#endif
constexpr int BAR_LDS_OFF = LDS_BYTES - 64;
constexpr size_t WS_BAR = 0;
constexpr size_t WS_TS = 64 * 1024;

template <int ph>
__device__ __forceinline__ void run_phase(Fr& F) {
    unsigned char* ws = F.ws;
    float* mod = (float*)(ws + WS_MOD); float* ctxx = (float*)(ws + WS_CTXX);
    if constexpr (ph == 0) ph_prologue(F);
    else if constexpr (ph == 1) ph_modnorm(F, IN(I_X), ML, 0, IN(I_CTX), MC, IN(I_NORMG), mod, 0, (bf16*)(ws + HY_H));
    else if constexpr (ph == 2) { pg8::EpiBf16 E{(bf16*)(ws + HY_P), 3072, IN(I_HBIN), 0, 0}; run_gemm(F, (const bf16*)(ws + HY_H), (const bf16*)(ws + WS_WHIN), MALL, 3072, 1024, E);
                                  { constexpr int nun = (MALL / 256) * (3072 / 256); const int busy = nun % F.G; const bool all = busy == 0; const int vb = all ? F.bid : F.bid - busy, nvb = all ? F.G : F.G - busy;
                                    if (all || F.bid >= busy) {
                                        kt_items(F, (const float*)(ws + WS_H3), SEQ, (float*)(ws + HY_KT), vb * NWAVES + F.wave, nvb * NWAVES);
                                        kt_items(F, (const float*)(ws + WS_H3) + (size_t)SEQ * 64, CTXL, (float*)(ws + WS_KTC), vb * NWAVES + F.wave, nvb * NWAVES);
                                        transpose_group(F, 1, vb, nvb); } } }
    else if constexpr (ph == 3) { zt_items(F, (const bf16*)(ws + HY_P), 0, NB, SEQ, (bf16*)(ws + HY_ZT)); zt_items(F, (const bf16*)(ws + HY_P), ML, NB, CTXL, (bf16*)(ws + HY_ZTC)); }
    else if constexpr (ph == 4) ph_fftconv(F);
    else if constexpr (ph == 5) { u2_items(F, (const bf16*)(ws + HY_P), 0, NB, SEQ, (const bf16*)(ws + HY_ZT), (bf16*)(ws + HY_H)); u2_items(F, (const bf16*)(ws + HY_P), ML, NB, CTXL, (const bf16*)(ws + HY_ZTC), (bf16*)(ws + HY_H)); }
    else if constexpr (ph == 6) { pg8::EpiDelta E{(bf16*)(ws + HY_P), ML, mod + 2048, 0, IN(I_HBOUT)}; run_gemm(F, (const bf16*)(ws + HY_H), (const bf16*)(ws + WS_WHOUT), MALL, 1024, 1024, E);
                                  transpose_in_tail(F, 2, (MALL / 256) * (1024 / 256)); }
    else if constexpr (ph == 7) ph_modnorm(F, IN(I_X), ML, 0, IN(I_CTX), MC, IN(I_NORMG) + 1024, mod, 3072, (bf16*)(ws + FF_H), (const bf16*)(ws + HY_P), F.out, ctxx);
    else if constexpr (ph == 8) { pg8::EpiBf16 E{(bf16*)(ws + FF_A), FF, nullptr, FF, (FF_G - FF_A) / 2}; run_gemm(F, (const bf16*)(ws + FF_H), (const bf16*)(ws + WS_WUP0), MALL, 2 * FF, 1024, E);
                                  { constexpr int nun = (MALL / 256) * (2 * FF / 256); const int busy = nun % F.G;
                                    if (busy == 0) mod_layer(F, 1, F.bid, F.G); else if (F.bid >= busy) mod_layer(F, 1, F.bid - busy, F.G - busy); } }
    else if constexpr (ph == 9) ph_dwconv(F, 0, ML, MC);
    else if constexpr (ph == 10) { pg8::EpiDelta E{(bf16*)(ws + FF_H), ML, mod + 5120, 0, nullptr}; run_gemm(F, (const bf16*)(ws + FF_A), (const bf16*)(ws + WS_WDN0), MALL, 1024, FF, E); }
    else if constexpr (ph < 29) {
            constexpr int hb = (ph - 11) / 9, k = (ph - 11) % 9; const float* mod1 = mod + 5 * 6144;
            float* xh = F.out + (size_t)hb * HROWS * 1024;
            if constexpr (k == 0) {
                if constexpr (hb == 0) {
                    const bf16* dl = (const bf16*)(ws + FF_H);
                    add_delta_rows(F, F.out, dl, HROWS, HROWS);
                    ph_modnorm(F, xh, 0, 0, ctxx, MC, IN(I_NORMG) + 2048, mod1, 0, (bf16*)(ws + MS_HC), dl + (size_t)ML * 1024, xh, ctxx);
                    ph_modnorm(F, xh, HROWS, 0, ctxx, 0, IN(I_NORMG) + 2048, mod1, 0, (bf16*)(ws + MS_H), dl, xh, ctxx);
                } else ph_modnorm(F, xh, HROWS, 2 * hb, ctxx, 0, IN(I_NORMG) + 2048, mod1, 0, (bf16*)(ws + MS_H)); }
            else if constexpr (k == 1) { { pg8::EpiBf16T E{(bf16*)(ws + MS_XM), MI / 32}; run_gemm(F, (const bf16*)(ws + MS_H), (const bf16*)(ws + WS_WMIN), HROWS, MI, 1024, E); }
                               if (hb == 0) { pg8::EpiBf16T E{(bf16*)(ws + MS_XMC), MI / 32}; run_gemm(F, (const bf16*)(ws + MS_HC), (const bf16*)(ws + WS_WMIN), MC, MI, 1024, E); } }
            else if constexpr (k == 2) { prep_items(F, (const bf16*)(ws + MS_XM), 2, SEQ, (bf16*)(ws + MS_XC), (bf16*)(ws + MS_KN), (bf16*)(ws + MS_KT), (bf16*)(ws + MS_VT));
                               if (hb == 0) prep_items(F, (const bf16*)(ws + MS_XMC), NB, CTXL, (bf16*)(ws + MS_XCC), (bf16*)(ws + MS_XCC + 16 * MiB), (bf16*)(ws + MS_KTC), (bf16*)(ws + MS_VTC)); }
            else if constexpr (k == 3) { gate_items(F, (const bf16*)(ws + MS_XC), (const bf16*)(ws + MS_XM), HROWS, (float*)(ws + WS_GATES_L));
                               if (hb == 0) gate_items(F, (const bf16*)(ws + MS_XCC), (const bf16*)(ws + MS_XMC), MC, (float*)(ws + WS_GATES_C)); }
            else if constexpr (k == 4) ph_sphase(F, hb, hb == 0);
            else if constexpr (k == 5) ph_scan(F, hb);
            else if constexpr (k == 6) { pg8::EpiBf16 E{(bf16*)(ws + MS_Z), MI, nullptr, 0, 0}; run_gemm(F, (const bf16*)(ws + MS_H), (const bf16*)(ws + WS_WMIN) + (size_t)MI * 1024, HROWS, MI, 1024, E); }
            else if constexpr (k == 7) ph_mout(F);
            else { pg8::EpiRes E{xh, xh, ctxx, ctxx, HROWS, mod1 + 2048, 2 * hb, nullptr}; run_gemm(F, (const bf16*)(ws + MS_NF), (const bf16*)(ws + WS_WMDN), HROWS, 1024, MI, E); }
        }
    else if constexpr (ph == 29) ph_modnorm(F, F.out, ML, 0, ctxx, 0, IN(I_NORMG) + 3072, mod + 5 * 6144, 3072, (bf16*)(ws + FF_H));
    else if constexpr (ph == 30) { pg8::EpiBf16 E{(bf16*)(ws + FF_A), FF, nullptr, FF, (FF_G - FF_A) / 2}; run_gemm(F, (const bf16*)(ws + FF_H), (const bf16*)(ws + WS_WUP1), ML, 2 * FF, 1024, E); }
    else if constexpr (ph == 31) ph_dwconv(F, 1, ML, 0);
    else if constexpr (ph == 32) { pg8::EpiDelta E{(bf16*)(ws + FF_H), ML, mod + 5 * 6144 + 5120, 0, nullptr}; run_gemm(F, (const bf16*)(ws + FF_A), (const bf16*)(ws + WS_WDN1), ML, 1024, FF, E); }
    else ph_final(F, (const bf16*)(ws + FF_H));
}

template <int ph>
__device__ __forceinline__ void phase_step(int ph_lo, int ph_hi, unsigned char* lds_raw) {
    if (ph_lo <= ph && ph < ph_hi) {
        const __attribute__((address_space(4))) unsigned char* kp = (const __attribute__((address_space(4))) unsigned char*)__builtin_amdgcn_kernarg_segment_ptr();
        asm volatile("" : "+s"(kp));
        Fr F;
        { int t_ = threadIdx.x, g_ = gridDim.x, b_ = blockIdx.x; asm volatile("" : "+v"(t_), "+s"(g_), "+s"(b_)); F.tid = t_; F.G = g_; F.bid = b_; }
        F.lds = (LAS unsigned char*)lds_raw; F.lane = F.tid & 63; F.wave = __builtin_amdgcn_readfirstlane(F.tid >> 6);
        F.gw = F.bid * NWAVES + F.wave; F.ngw = F.G * NWAVES;
        F.in = (const __attribute__((address_space(4))) cfptr_t*)kp;
        typedef float* fptr_t; typedef unsigned char* ucptr_t;
        F.out = *(const __attribute__((address_space(4))) fptr_t*)(kp + 304); F.ws = *(const __attribute__((address_space(4))) ucptr_t*)(kp + 312);
        if (PROBE_MASK != 0ull && F.bid == 0 && F.tid == 0) ((unsigned long long*)(F.ws + WS_TS))[ph] = __builtin_amdgcn_s_memrealtime();
        run_phase<ph>(F);
        if (ph + 1 < ph_hi) {
            if (ph == 0) {
                if (F.bid == 0) for (int i = F.tid; i < XCD_BAR_WORDS; i += NTHR) __hip_atomic_store((unsigned*)(F.ws + WS_BAR) + i, 0u, __ATOMIC_RELAXED, __HIP_MEMORY_SCOPE_AGENT);
                __syncthreads(); cg::this_grid().sync();
                if (F.tid == 0) (void)xb_add((unsigned*)(F.ws + WS_BAR) + XB_XCNT(xb_xcc_id()), 1u);
            }
            else xcd_barrier((unsigned*)(F.ws + WS_BAR), (volatile LAS unsigned*)(F.lds + BAR_LDS_OFF));
        }
        if (PROBE_MASK != 0ull && ph == N_PHASES - 1 && F.bid == 0) {
            if (F.tid == 0) { unsigned long long* ts = (unsigned long long*)(F.ws + WS_TS); const unsigned long long tend = __builtin_amdgcn_s_memrealtime(); unsigned long long tot = 0ull;
                for (int k = 0; k < N_PHASES; ++k) if ((PROBE_MASK >> k) & 1ull) tot += (k + 1 < N_PHASES ? ts[k + 1] : tend) - ts[k];
                while (__builtin_amdgcn_s_memrealtime() - tend < tot) __builtin_amdgcn_s_sleep(8); }
            __syncthreads();
        }
    }
}
template <int... I>
__device__ __forceinline__ void all_phases(int ph_lo, int ph_hi, unsigned char* lds_raw, std::integer_sequence<int, I...>) { (phase_step<I>(ph_lo, ph_hi, lds_raw), ...); }

__global__ void __launch_bounds__(NTHR, 2) fwd_kernel(Args args) {
    extern __shared__ __attribute__((aligned(16))) unsigned char lds_raw[];
    int ph_lo, ph_hi;
    { const __attribute__((address_space(4))) unsigned char* kp0 = (const __attribute__((address_space(4))) unsigned char*)__builtin_amdgcn_kernarg_segment_ptr();
      ph_lo = *(const __attribute__((address_space(4))) int*)(kp0 + 320); ph_hi = *(const __attribute__((address_space(4))) int*)(kp0 + 324); }
    if (threadIdx.x < 16) ((LAS unsigned*)((LAS unsigned char*)lds_raw + BAR_LDS_OFF))[threadIdx.x] = 0u;
    __syncthreads();
    all_phases(ph_lo, ph_hi, lds_raw, std::make_integer_sequence<int, N_PHASES>{});
}

extern "C" void kernel_launch(void* const* d_in, const int* in_sizes, int n_in, void* d_out, int out_size, void* d_ws, size_t ws_size, hipStream_t stream) {
    static int grid = 0;
    if (grid == 0) {
        int dev = 0, cus = 0, per_cu = 0;
        hipGetDevice(&dev);
        hipDeviceGetAttribute(&cus, hipDeviceAttributeMultiprocessorCount, dev);
        hipFuncSetAttribute((const void*)fwd_kernel, hipFuncAttributeMaxDynamicSharedMemorySize, LDS_BYTES);
        hipOccupancyMaxActiveBlocksPerMultiprocessor(&per_cu, (const void*)fwd_kernel, NTHR, LDS_BYTES);
        if (per_cu < 1) { fprintf(stderr, "kernel_launch: occupancy query says %d blocks per CU\n", per_cu); per_cu = 1; }
        grid = cus < 256 ? cus : 256;
        if (n_in != 38 || ws_size < WS_END) fprintf(stderr, "kernel_launch: unexpected n_in %d / ws_size %zu (need %zu)\n", n_in, ws_size, (size_t)WS_END);
        (void)hipGetLastError();
    }
    (void)hipMemsetAsync(d_ws, 0, 128 * 1024, stream);
    Args a{};
    for (int i = 0; i < 38; ++i) a.in[i] = (const float*)d_in[i];
    a.out = (float*)d_out; a.ws = (unsigned char*)d_ws; a.ph_lo = 0; a.ph_hi = N_PHASES;
    void* kargs[] = {&a};
    hipError_t e = hipLaunchCooperativeKernel((const void*)fwd_kernel, dim3(grid), dim3(NTHR), kargs, LDS_BYTES, stream);
    if (e != hipSuccess) fprintf(stderr, "cooperative launch failed: %s (grid %d)\n", hipGetErrorString(e), grid);
}
```

```cpp
#include <hip/hip_runtime.h>
#include <hip/hip_cooperative_groups.h>
#include <cstdio>
#include <cstdint>
#include <cstddef>
#include <utility>
namespace cg = cooperative_groups;

#define LAS __attribute__((address_space(3)))
typedef unsigned short bf16;
typedef short bf16x8 __attribute__((ext_vector_type(8)));
typedef float f32x4 __attribute__((ext_vector_type(4)));
typedef float f32x2 __attribute__((ext_vector_type(2)));
typedef unsigned u32x4 __attribute__((ext_vector_type(4)));
typedef unsigned u32x2 __attribute__((ext_vector_type(2)));

namespace pg8 {
#define PG8_LAS __attribute__((address_space(3)))
typedef unsigned short bf16_t;
constexpr int BM = 256, BK = 64, HALF = 128, HTB = HALF * BK * 2, STAGE_BYTES = 8 * HTB, NXCD = 8, WGM = 8;
__host__ __device__ __forceinline__ int lds_byte(int r, int c) { const int st = (r >> 4) * 2 + (c >> 5), rr = r & 15, cc = c & 31, ob = rr * 64 + cc * 2; return st * 1024 + (ob ^ (((ob >> 9) & 1) << 5)); }
__host__ __device__ __forceinline__ void stage_rc(int b, int& R, int& C) { const int st = b / 1024, sb = b % 1024, swz = sb ^ (((sb >> 9) & 1) << 5); R = (st >> 1) * 16 + swz / 64; C = (st & 1) * 32 + (swz % 64) / 2; }
__host__ __device__ __forceinline__ int perm32(int rho) { const int n = rho >> 4, i = rho & 15; return 8 * (i >> 2) + 4 * n + (i & 3); }
struct Unit { int pm, pn; };
struct Gemm { const bf16_t* A; const bf16_t* Bt; int M, N, K; };
struct StaticOrder {
    int nM, nN, nwg, G, c;
    __host__ __device__ void init(int M, int N, int G_, int c_) { nM = M / BM; nN = N / BM; nwg = nM * nN; G = G_; c = c_; }
    __host__ __device__ bool next(int i, Unit& u) const {
        const long L = (long)i * G + c; if (L >= nwg) return false;
        int wgid = (int)L; { const int q = nwg / NXCD, r = nwg % NXCD, xcd = wgid % NXCD, off = wgid / NXCD; wgid = (xcd < r ? xcd * (q + 1) : r * (q + 1) + (xcd - r) * q) + off; }
        const int nig = WGM * nN, gid = wgid / nig, fm = gid * WGM, gsz = (nM - fm) < WGM ? (nM - fm) : WGM;
        u.pm = fm + ((wgid % nig) % gsz); u.pn = (wgid % nig) / gsz; return true;
    }
    __device__ __forceinline__ void a_ready(const Unit&) const {}
    __device__ __forceinline__ void done(const Unit&) const {}
};
__device__ __forceinline__ unsigned cvt_pk_bf16(float lo, float hi) { unsigned r; asm volatile("v_cvt_pk_bf16_f32 %0, %1, %2" : "=v"(r) : "v"(lo), "v"(hi)); return r; }

struct EpiBf16 {
    static constexpr bool PERM = true, AFTER_DRAIN = false;
    bf16_t* O; int ldc; const float* bias; int split_cols; size_t split_stride;
    __device__ __forceinline__ void operator()(const f32x4 (&acc)[2][2][4][2], const Unit& u, int wr, int wc, int fr, int fq) const {
        const int row0 = u.pm * BM + wr * 64 + fr; int colt = u.pn * BM; bf16_t* base = O;
        if (split_cols) { const int t = colt / split_cols; base += (size_t)t * split_stride; colt -= t * split_cols; }
        const int col0 = colt + wc * 32 + 8 * fq, bcol0 = u.pn * BM + wc * 32 + 8 * fq;
        f32x4 bv[2][2];
#pragma unroll
        for (int bj = 0; bj < 2; ++bj)
#pragma unroll
            for (int n = 0; n < 2; ++n) bv[bj][n] = bias ? *(const f32x4*)(bias + bcol0 + bj * HALF + 4 * n) : (f32x4){0.f, 0.f, 0.f, 0.f};
#pragma unroll
        for (int ai = 0; ai < 2; ++ai)
#pragma unroll
            for (int m = 0; m < 4; ++m) { bf16_t* rowp = base + (size_t)(row0 + ai * HALF + m * 16) * ldc + col0;
#pragma unroll
                for (int bj = 0; bj < 2; ++bj) { f32x4 v0 = acc[ai][bj][m][0] + bv[bj][0], v1 = acc[ai][bj][m][1] + bv[bj][1];
                    u32x4 w; w.x = cvt_pk_bf16(v0[0], v0[1]); w.y = cvt_pk_bf16(v0[2], v0[3]); w.z = cvt_pk_bf16(v1[0], v1[1]); w.w = cvt_pk_bf16(v1[2], v1[3]);
                    *(u32x4*)(rowp + bj * HALF) = w; } }
    }
};
struct EpiBf16T {
    static constexpr bool PERM = true, AFTER_DRAIN = false;
    bf16_t* O; int ntc;
    __device__ __forceinline__ void operator()(const f32x4 (&acc)[2][2][4][2], const Unit& u, int wr, int wc, int fr, int fq) const {
        bf16_t* base = O + (size_t)(fr + 16 * fq) * 8;
#pragma unroll
        for (int ai = 0; ai < 2; ++ai)
#pragma unroll
            for (int m = 0; m < 4; ++m)
#pragma unroll
                for (int bj = 0; bj < 2; ++bj) { const f32x4 v0 = acc[ai][bj][m][0], v1 = acc[ai][bj][m][1];
                    u32x4 w; w.x = cvt_pk_bf16(v0[0], v0[1]); w.y = cvt_pk_bf16(v0[2], v0[3]); w.z = cvt_pk_bf16(v1[0], v1[1]); w.w = cvt_pk_bf16(v1[2], v1[3]);
                    *(u32x4*)(base + ((size_t)(u.pm * 16 + ai * 8 + wr * 4 + m) * ntc + u.pn * 8 + bj * 4 + wc) * 512) = w; }
    }
};
struct EpiDelta {
    static constexpr bool PERM = true, AFTER_DRAIN = false, HEAVY = false;
    bf16_t* Dl; int rows_lat; const float* gate; int b0; const float* bias;
    __device__ __forceinline__ void operator()(const f32x4 (&acc)[2][2][4][2], const Unit& u, int wr, int wc, int fr, int fq) const {
        const int trow = u.pm * BM, modrow = trow < rows_lat ? b0 + trow / 8192 : 4;
        const int col0 = u.pn * BM + wc * 32 + 8 * fq; const float* gp = gate + (size_t)modrow * 6144 + col0;
        bf16_t* base = Dl + (size_t)(trow + wr * 64 + fr) * 1024 + col0;
#pragma unroll
        for (int bj = 0; bj < 2; ++bj) {
            f32x4 bv[2], gv[2];
#pragma unroll
            for (int n = 0; n < 2; ++n) { bv[n] = bias ? *(const f32x4*)(bias + col0 + bj * HALF + 4 * n) : (f32x4){0.f, 0.f, 0.f, 0.f}; gv[n] = *(const f32x4*)(gp + bj * HALF + 4 * n); }
#pragma unroll
            for (int ai = 0; ai < 2; ++ai)
#pragma unroll
                for (int m = 0; m < 4; ++m) { const f32x4 v0 = gv[0] * (acc[ai][bj][m][0] + bv[0]), v1 = gv[1] * (acc[ai][bj][m][1] + bv[1]);
                    u32x4 w; w.x = cvt_pk_bf16(v0[0], v0[1]); w.y = cvt_pk_bf16(v0[2], v0[3]); w.z = cvt_pk_bf16(v1[0], v1[1]); w.w = cvt_pk_bf16(v1[2], v1[3]);
                    *(u32x4*)(base + (size_t)(ai * HALF + m * 16) * 1024 + bj * HALF) = w; }
        }
    }
};
struct EpiRes {
    static constexpr bool PERM = false, AFTER_DRAIN = false;
    const float* res_lat; float* out_lat; const float* res_ctx; float* out_ctx; int rows_lat; const float* gate; int b0; const float* bias;
    __device__ __forceinline__ void operator()(const f32x4 (&acc)[2][2][4][2], const Unit& u, int wr, int wc, int fr, int fq) const {
        const int trow = u.pm * BM; const float* res; float* out; int modrow;
        if (trow < rows_lat) { res = res_lat + (size_t)trow * 1024; out = out_lat + (size_t)trow * 1024; modrow = b0 + trow / 8192; }
        else { const int rc = trow - rows_lat; res = res_ctx + (size_t)rc * 1024; out = out_ctx + (size_t)rc * 1024; modrow = 4; }
        const int col0 = u.pn * BM + wc * 32 + 4 * fq; const float* gp = gate + (size_t)modrow * 6144 + col0;
#pragma unroll
        for (int bj = 0; bj < 2; ++bj) {
            f32x4 bv[2], gv[2];
#pragma unroll
            for (int n = 0; n < 2; ++n) { bv[n] = bias ? *(const f32x4*)(bias + col0 + bj * HALF + n * 16) : (f32x4){0.f, 0.f, 0.f, 0.f}; gv[n] = *(const f32x4*)(gp + bj * HALF + n * 16); }
#pragma unroll
            for (int ai = 0; ai < 2; ++ai) {
                f32x4 rs[4][2];
#pragma unroll
                for (int m = 0; m < 4; ++m)
#pragma unroll
                    for (int n = 0; n < 2; ++n) rs[m][n] = *(const f32x4*)(res + (size_t)(wr * 64 + fr + ai * HALF + m * 16) * 1024 + col0 + bj * HALF + n * 16);
#pragma unroll
                for (int m = 0; m < 4; ++m)
#pragma unroll
                    for (int n = 0; n < 2; ++n) *(f32x4*)(out + (size_t)(wr * 64 + fr + ai * HALF + m * 16) * 1024 + col0 + bj * HALF + n * 16) = rs[m][n] + gv[n] * (acc[ai][bj][m][n] + bv[n]);
                asm volatile("" ::: "memory");
            }
        }
    }
};

template <class Epi, class Sched, bool ALIGN_EPI = false, bool SP2 = false>
__device__ __forceinline__ void gemm_phase(PG8_LAS unsigned char* lds, const Gemm g, const Sched& S, const Epi& E, const int tid) {
    const int wid = __builtin_amdgcn_readfirstlane(tid >> 6), lane = tid & 63, wr = wid >> 2, wc = wid & 3, fr = lane & 15, fq = lane >> 4;
    const int K = g.K, nt = K / BK;
    unsigned voffA[2], voffB[2];
#pragma unroll
    for (int i = 0; i < 2; ++i) { int R, C; stage_rc(tid * 16 + i * 8192, R, C); const int Rb = Epi::PERM ? ((R & ~31) + perm32(R & 31)) : R;
        voffA[i] = (unsigned)(R * K + C) * 2u; voffB[i] = (unsigned)(Rb * K + C) * 2u; }
    const size_t kstep = (size_t)(BK * 2);
    const size_t hstep = (size_t)HALF * K * 2;
    const size_t tstep = 2 * hstep;
    const unsigned ldsw = (unsigned)wid * 1024u;
    const int aoff = lds_byte(wr * 64 + fr, fq * 8), boff = lds_byte(wc * 32 + fr, fq * 8);
#define PG8_SA(b, h) (((b) * 2 + (h)) * HTB)
#define PG8_SB(b, h) ((4 + (b) * 2 + (h)) * HTB)
#define PG8_STAGE(bufoff, gbase, voff) do { _Pragma("unroll") for (int _i = 0; _i < 2; ++_i) \
        __builtin_amdgcn_global_load_lds((const unsigned*)((const char*)(gbase) + (voff)[_i]), (PG8_LAS unsigned*)(lds + (bufoff) + ldsw + _i * 8192), 16, 0, 0); } while (0)
#define PG8_LDA(dst, b, h) do { _Pragma("unroll") for (int m = 0; m < 4; ++m) _Pragma("unroll") for (int k = 0; k < 2; ++k) dst[m][k] = *(const PG8_LAS bf16x8*)(lds + PG8_SA(b, h) + aoff + m * 2048 + k * 1024); } while (0)
#define PG8_LDB(dst, b, h) do { _Pragma("unroll") for (int n = 0; n < 2; ++n) _Pragma("unroll") for (int k = 0; k < 2; ++k) dst[n][k] = *(const PG8_LAS bf16x8*)(lds + PG8_SB(b, h) + boff + n * 2048 + k * 1024); } while (0)
#define PG8_MMA(ai, bj, At, Bt) do { __builtin_amdgcn_s_setprio(1); _Pragma("unroll") for (int m = 0; m < 4; ++m) _Pragma("unroll") for (int n = 0; n < 2; ++n) _Pragma("unroll") for (int k = 0; k < 2; ++k) \
        acc[ai][bj][m][n] = __builtin_amdgcn_mfma_f32_16x16x32_bf16(Bt[n][k], At[m][k], acc[ai][bj][m][n], 0, 0, 0); __builtin_amdgcn_s_setprio(0); } while (0)
#define PG8_WAIT_V(n) asm volatile("s_waitcnt vmcnt(" #n ")" ::: "memory")
#define PG8_WAIT_L(n) asm volatile("s_waitcnt lgkmcnt(" #n ")" ::: "memory")
#define PG8_BAR __builtin_amdgcn_s_barrier()
#define PG8_SCHED __builtin_amdgcn_sched_barrier(0)
    Unit cur, nxt; int ui = 0;
    if (!S.next(0, cur)) return;
    f32x4 acc[2][2][4][2];
#pragma unroll
    for (int a = 0; a < 2; ++a)
#pragma unroll
        for (int b = 0; b < 2; ++b)
#pragma unroll
            for (int m = 0; m < 4; ++m)
#pragma unroll
                for (int n = 0; n < 2; ++n) acc[a][b][m][n] = (f32x4){0.f, 0.f, 0.f, 0.f};
    bf16x8 At[4][2], B0[2][2], B1[2][2];
    const char* cA = (const char*)g.A + (size_t)cur.pm * tstep; const char* cB = (const char*)g.Bt + (size_t)cur.pn * tstep;
    S.a_ready(cur);
    if constexpr (SP2) {
        PG8_STAGE(PG8_SB(0, 0), cB, voffB); PG8_STAGE(PG8_SB(0, 1), cB + hstep, voffB); PG8_STAGE(PG8_SA(0, 0), cA, voffA); PG8_STAGE(PG8_SA(0, 1), cA + hstep, voffA);
        if (wr == 1) PG8_BAR;
        PG8_WAIT_V(2); PG8_BAR;
        PG8_STAGE(PG8_SB(1, 0), cB + kstep, voffB); PG8_STAGE(PG8_SA(1, 0), cA + kstep, voffA); PG8_STAGE(PG8_SB(1, 1), cB + hstep + kstep, voffB);
        PG8_WAIT_V(6); PG8_BAR;
    } else {
        PG8_STAGE(PG8_SB(0, 0), cB, voffB); PG8_STAGE(PG8_SA(0, 0), cA, voffA); PG8_STAGE(PG8_SB(0, 1), cB + hstep, voffB); PG8_STAGE(PG8_SA(0, 1), cA + hstep, voffA);
        if (wr == 1) PG8_BAR;
        PG8_WAIT_V(4); PG8_BAR;
        PG8_STAGE(PG8_SB(1, 0), cB + kstep, voffB); PG8_STAGE(PG8_SA(1, 0), cA + kstep, voffA); PG8_STAGE(PG8_SB(1, 1), cB + hstep + kstep, voffB);
        PG8_WAIT_V(6); PG8_BAR;
    }
    for (;;) {
        const bool has_next = S.next(ui + 1, nxt);
        const char* nA = has_next ? (const char*)g.A + (size_t)nxt.pm * tstep : cA; const char* nB = has_next ? (const char*)g.Bt + (size_t)nxt.pn * tstep : cB;
        for (int t = 0; t < nt; t += 2) {
            const bool last = (t == nt - 2);
            const char* a1 = cA + (size_t)(t + 1) * kstep;
            const char* a2 = last ? nA : cA + (size_t)(t + 2) * kstep; const char* b2 = last ? nB : cB + (size_t)(t + 2) * kstep;
            const char* a3 = a2 + kstep; const char* b3 = b2 + kstep;
            if (last && has_next) S.a_ready(nxt);
            if constexpr (SP2) {
            PG8_LDB(B0, 0, 0); PG8_LDB(B1, 0, 1); PG8_SCHED; PG8_LDA(At, 0, 0); PG8_STAGE(PG8_SA(1, 1), a1 + hstep, voffA);
            PG8_WAIT_V(8); PG8_WAIT_L(0); PG8_BAR; PG8_MMA(0, 0, At, B0); PG8_MMA(0, 1, At, B1); PG8_BAR; PG8_SCHED;
            PG8_LDA(At, 0, 1); PG8_STAGE(PG8_SB(0, 0), b2, voffB); PG8_STAGE(PG8_SB(0, 1), b2 + hstep, voffB); PG8_STAGE(PG8_SA(0, 0), a2, voffA);
            PG8_WAIT_V(8); PG8_WAIT_L(0); PG8_BAR; PG8_MMA(1, 0, At, B0); PG8_MMA(1, 1, At, B1); PG8_BAR; PG8_SCHED;
            PG8_LDB(B0, 1, 0); PG8_LDB(B1, 1, 1); PG8_SCHED; PG8_LDA(At, 1, 0); PG8_STAGE(PG8_SA(0, 1), a2 + hstep, voffA);
            PG8_WAIT_V(8); PG8_WAIT_L(0); PG8_BAR; PG8_MMA(0, 0, At, B0); PG8_MMA(0, 1, At, B1); PG8_BAR; PG8_SCHED;
            PG8_LDA(At, 1, 1); PG8_STAGE(PG8_SB(1, 0), b3, voffB); PG8_STAGE(PG8_SB(1, 1), b3 + hstep, voffB); PG8_STAGE(PG8_SA(1, 0), a3, voffA);
            PG8_WAIT_V(8); PG8_WAIT_L(0); PG8_BAR; PG8_MMA(1, 0, At, B0); PG8_MMA(1, 1, At, B1); PG8_BAR; PG8_SCHED;
            } else {
            PG8_LDB(B0, 0, 0); PG8_SCHED; PG8_LDA(At, 0, 0); PG8_STAGE(PG8_SA(1, 1), a1 + hstep, voffA);
            PG8_WAIT_L(8); PG8_BAR; PG8_WAIT_L(0); PG8_MMA(0, 0, At, B0); PG8_BAR; PG8_SCHED;
            PG8_LDB(B1, 0, 1); PG8_STAGE(PG8_SB(0, 0), b2, voffB);
            PG8_BAR; PG8_WAIT_L(0); PG8_MMA(0, 1, At, B1); PG8_BAR;
            PG8_LDA(At, 0, 1); PG8_STAGE(PG8_SA(0, 0), a2, voffA);
            PG8_BAR; PG8_WAIT_L(0); PG8_MMA(1, 0, At, B0); PG8_BAR; PG8_SCHED;
            PG8_STAGE(PG8_SB(0, 1), b2 + hstep, voffB);
            PG8_WAIT_V(6); PG8_BAR; PG8_MMA(1, 1, At, B1); PG8_BAR;
            PG8_LDB(B0, 1, 0); PG8_SCHED; PG8_LDA(At, 1, 0); PG8_STAGE(PG8_SA(0, 1), a2 + hstep, voffA);
            PG8_WAIT_L(8); PG8_BAR; PG8_WAIT_L(0); PG8_MMA(0, 0, At, B0); PG8_BAR; PG8_SCHED;
            PG8_LDB(B1, 1, 1); PG8_STAGE(PG8_SB(1, 0), b3, voffB);
            PG8_BAR; PG8_WAIT_L(0); PG8_MMA(0, 1, At, B1); PG8_BAR;
            PG8_LDA(At, 1, 1); PG8_STAGE(PG8_SA(1, 0), a3, voffA);
            PG8_BAR; PG8_WAIT_L(0); PG8_MMA(1, 0, At, B0); PG8_BAR; PG8_SCHED;
            PG8_STAGE(PG8_SB(1, 1), b3 + hstep, voffB);
            PG8_WAIT_V(6); PG8_BAR; PG8_MMA(1, 1, At, B1); PG8_BAR;
            }
        }
        if constexpr (ALIGN_EPI) { if (wr == 0) PG8_BAR; }
        if constexpr (!Epi::AFTER_DRAIN) { E(acc, cur, wr, wc, fr, fq); S.done(cur); }
        if (!has_next) break;
#pragma unroll
        for (int a = 0; a < 2; ++a)
#pragma unroll
            for (int b = 0; b < 2; ++b)
#pragma unroll
                for (int m = 0; m < 4; ++m)
#pragma unroll
                    for (int n = 0; n < 2; ++n) acc[a][b][m][n] = (f32x4){0.f, 0.f, 0.f, 0.f};
        cur = nxt; cA = nA; cB = nB; ++ui;
        if constexpr (ALIGN_EPI) { if (wr == 1) PG8_BAR; }
    }
    PG8_WAIT_V(0);
    if constexpr (!ALIGN_EPI) { if (wr == 0) PG8_BAR; }
    PG8_BAR;
#undef PG8_SA
#undef PG8_SB
#undef PG8_STAGE
#undef PG8_LDA
#undef PG8_LDB
#undef PG8_MMA
#undef PG8_WAIT_V
#undef PG8_WAIT_L
#undef PG8_BAR
#undef PG8_SCHED
}
}

constexpr int D = 1024, NB = 4, SEQ = 8192, CTXL = 256, ML = NB * SEQ, MC = NB * CTXL, MALL = ML + MC;
constexpr int FF = 2816, MI = 2048, NH = 4, DH = 512, HROWS = 2 * SEQ;
constexpr float EPS = 1e-6f, ML_NORM_EPS = 1e-5f;
constexpr float HY_MAX_DECAY = -15.350567286626973f, HY_MIN_DECAY = -3.0701134573253945f;
constexpr int NWAVES = 8, NTHR = 512;
constexpr int LDS_BYTES = 147456;

constexpr size_t MiB = 1u << 20;
constexpr size_t WS_MOD = 1 * MiB;
constexpr size_t WS_CTXX = 2 * MiB;
constexpr size_t WS_H3 = 6 * MiB;
constexpr size_t WS_KTC = 9 * MiB;
constexpr size_t WS_GWT = 11 * MiB;
constexpr size_t WS_WKQ = 11 * MiB + 256 * 1024;
constexpr size_t WS_NC = 12 * MiB;
constexpr size_t WS_WHIN = 16 * MiB, WS_WHOUT = 22 * MiB, WS_WMIN = 24 * MiB, WS_WMDN = 32 * MiB, WS_WUP0 = 36 * MiB, WS_WUP1 = 47 * MiB, WS_WDN0 = 58 * MiB, WS_WDN1 = 58 * MiB + 5767168;
constexpr size_t WS_GATES_L = 69 * MiB;
constexpr size_t WS_GATES_C = 70 * MiB;
constexpr size_t WS_GT_L = 71 * MiB;
constexpr size_t WS_GT_C = 73 * MiB;
constexpr size_t WS_GC = 73 * MiB + 512 * 1024;
constexpr size_t WS_DN = 74 * MiB;
constexpr size_t WS_RS = 79 * MiB;
constexpr size_t WS_INV = 79 * MiB + 512 * 1024;
constexpr size_t BIG = 80 * MiB;
constexpr size_t HY_H = BIG, HY_P = BIG + 66 * MiB, HY_KT = BIG + 264 * MiB, HY_ZT = BIG + 328 * MiB, HY_ZTC = BIG + 392 * MiB, HY_KS = BIG + 394 * MiB;
constexpr size_t FF_H = BIG, FF_A = BIG + 66 * MiB, FF_G = BIG + 248 * MiB;
constexpr size_t MS_H = BIG, MS_XM = BIG + 32 * MiB, MS_XC = BIG + 96 * MiB, MS_KT = BIG + 160 * MiB, MS_VT = BIG + 224 * MiB, MS_NF = BIG + 288 * MiB, MS_NB = BIG + 352 * MiB,
                 MS_KTC = BIG + 416 * MiB, MS_VTC = BIG + 420 * MiB;
constexpr size_t MS_S = MS_XM, MS_Z = MS_KT, MS_KN = MS_NF, MS_XCC = MS_NB, MS_XMC = MS_NB + 4 * MiB, MS_HC = MS_NB + 8 * MiB;
constexpr size_t WS_END = BIG + 424 * MiB;
static_assert(WS_END <= 512 * MiB, "workspace map");
static_assert(FF_G + (size_t)MALL * FF * 2 <= 512 * MiB && FF_A + (size_t)MALL * FF * 2 <= FF_G, "ffn map");
static_assert(HY_P + (size_t)MALL * 3072 * 2 <= HY_KT && HY_ZTC + (size_t)NB * D * CTXL * 2 <= HY_KS && HY_KS + 32 * MiB <= 512 * MiB, "hyena map");

__device__ __forceinline__ unsigned f2bf(float f) { unsigned u = __float_as_uint(f); return (u + 0x7fffu + ((u >> 16) & 1u)) >> 16; }
typedef __bf16 bf16x2_t __attribute__((ext_vector_type(2)));
__device__ __forceinline__ unsigned pk2(float lo, float hi) { const f32x2 v = {lo, hi}; const bf16x2_t b = __builtin_convertvector(v, bf16x2_t); return __builtin_bit_cast(unsigned, b); }
__device__ __forceinline__ float bf2f(unsigned short b) { return __uint_as_float(((unsigned)b) << 16); }
__device__ __forceinline__ float bflo(unsigned w) { return __uint_as_float(w << 16); }
__device__ __forceinline__ float bfhi(unsigned w) { return __uint_as_float(w & 0xffff0000u); }
__device__ __forceinline__ void unpack8(const u32x4 v, float (&o)[8]) { o[0] = bflo(v.x); o[1] = bfhi(v.x); o[2] = bflo(v.y); o[3] = bfhi(v.y); o[4] = bflo(v.z); o[5] = bfhi(v.z); o[6] = bflo(v.w); o[7] = bfhi(v.w); }
__device__ __forceinline__ u32x4 pack8(const float (&o)[8]) { u32x4 v; v.x = pk2(o[0], o[1]); v.y = pk2(o[2], o[3]); v.z = pk2(o[4], o[5]); v.w = pk2(o[6], o[7]); return v; }
__device__ __forceinline__ float wave_sum(float v) {
#pragma unroll
    for (int o = 1; o < 64; o <<= 1) v += __shfl_xor(v, o);
    return v;
}
__device__ __forceinline__ float silu_f(float x) { return x * __builtin_amdgcn_rcpf(1.0f + __expf(-x)); }

typedef const float* cfptr_t;
struct Fr {
    LAS unsigned char* lds; int tid, lane, wave, gw, ngw, G, bid;
    const __attribute__((address_space(4))) cfptr_t* in; float* out; unsigned char* ws;
};
#define IN(i) (F.in[i])
enum { I_X = 0, I_C, I_CTX, I_CCTX, I_MODW, I_MODB, I_NORMG, I_FINALG, I_HWIN, I_HBIN, I_HSCW, I_HSCB, I_FW1, I_FB1, I_FW2, I_FB2, I_FW3, I_FB3, I_FWOUT, I_FREQ, I_HBIAS, I_HWOUT, I_HBOUT,
       I_MWIN, I_MCW, I_MCB, I_MWQ, I_MWK, I_MWV, I_MWG, I_MBG, I_MNW, I_MSKIP, I_MWDN, I_FWUP, I_FCW, I_FCB, I_FWDN };

__device__ __forceinline__ void transpose_item(const float* W, int K, int N, bf16* WT, LAS float* scr, int item, int lane) {
    const int nblk = N / 32, kb = item / nblk, nb = item % nblk, k0 = 64 * kb, n0 = 32 * nb;
    float tv[32];
#pragma unroll
    for (int i = 0; i < 32; ++i) tv[i] = W[(size_t)(k0 + 2 * i + (lane >> 5)) * N + n0 + (lane & 31)];
#pragma unroll
    for (int i = 0; i < 32; ++i) scr[(2 * i + (lane >> 5)) * 33 + (lane & 31)] = tv[i];
    asm volatile("s_waitcnt lgkmcnt(0)" ::: "memory");
    const int c = lane & 7;
#pragma unroll
    for (int j = 0; j < 4; ++j) { const int n = (lane >> 3) + 8 * j; const LAS float* s = scr + (8 * c) * 33 + n;
        u32x4 o; o.x = pk2(s[0 * 33], s[1 * 33]); o.y = pk2(s[2 * 33], s[3 * 33]); o.z = pk2(s[4 * 33], s[5 * 33]); o.w = pk2(s[6 * 33], s[7 * 33]);
        *(u32x4*)(WT + (size_t)(n0 + n) * K + k0 + 8 * c) = o; }
    asm volatile("s_waitcnt lgkmcnt(0)" ::: "memory");
}
__device__ __forceinline__ void transpose_matrix(Fr& F, const float* W, int K, int N, bf16* WT) {
    LAS float* scr = (LAS float*)(F.lds + F.wave * 16384);
    const int nitems = (K / 64) * (N / 32);
    for (int it = F.gw; it < nitems; it += F.ngw) transpose_item(W, K, N, WT, scr, it, F.lane);
}

__device__ __forceinline__ void transpose_group(Fr& F, int grp, int vb, int nvb) {
    unsigned char* ws = F.ws; LAS float* scr = (LAS float*)(F.lds + F.wave * 16384);
    constexpr int I0 = (D / 64) * (3 * D / 32), I1 = (D / 64) * (D / 32), I2 = (D / 64) * (2 * MI / 32), I3 = (MI / 64) * (D / 32), I4 = (D / 64) * (2 * FF / 32), I5 = (FF / 64) * (D / 32);
    const int nit = grp == 0 ? I0 : (grp == 1 ? I1 : I2 + I3 + 2 * I4 + 2 * I5);
    for (int it = vb * NWAVES + F.wave; it < nit; it += nvb * NWAVES) {
        int r = it;
        if (grp == 0) { transpose_item(IN(I_HWIN), D, 3 * D, (bf16*)(ws + WS_WHIN), scr, r, F.lane); continue; }
        if (grp == 1) { transpose_item(IN(I_HWOUT), D, D, (bf16*)(ws + WS_WHOUT), scr, r, F.lane); continue; }
        if (r < I4) { transpose_item(IN(I_FWUP), D, 2 * FF, (bf16*)(ws + WS_WUP0), scr, r, F.lane); continue; } r -= I4;
        if (r < I5) { transpose_item(IN(I_FWDN), FF, D, (bf16*)(ws + WS_WDN0), scr, r, F.lane); continue; } r -= I5;
        if (r < I2) { transpose_item(IN(I_MWIN), D, 2 * MI, (bf16*)(ws + WS_WMIN), scr, r, F.lane); continue; } r -= I2;
        if (r < I3) { transpose_item(IN(I_MWDN), MI, D, (bf16*)(ws + WS_WMDN), scr, r, F.lane); continue; } r -= I3;
        if (r < I4) { transpose_item(IN(I_FWUP) + (size_t)D * 2 * FF, D, 2 * FF, (bf16*)(ws + WS_WUP1), scr, r, F.lane); continue; } r -= I4;
        transpose_item(IN(I_FWDN) + (size_t)FF * D, FF, D, (bf16*)(ws + WS_WDN1), scr, r, F.lane);
    }
}
__device__ __forceinline__ void transpose_in_tail(Fr& F, int grp, int nunits) {
    const int busy = nunits % F.G;
    if (busy == 0) transpose_group(F, grp, F.bid, F.G);
    else if (F.bid >= busy) transpose_group(F, grp, F.bid - busy, F.G - busy);
}

__device__ __forceinline__ void mod_layer(Fr& F, int l, int vb, int nvb) {
    LAS float* sc = (LAS float*)F.lds;
    LAS float* red = (LAS float*)(F.lds + 32768);
    __syncthreads();
    for (int i = F.tid; i < 5 * 1024; i += NTHR) { const int r = i >> 10, k = i & 1023; const float v = r < 4 ? IN(I_C)[r * 1024 + k] : IN(I_CCTX)[k]; sc[i] = silu_f(v); }
    __syncthreads();
    float* mod = (float*)(F.ws + WS_MOD);
    for (int it = vb; it < 96; it += nvb) {
        const int n0 = it * 64;
        const float* w = IN(I_MODW) + (size_t)l * 1024 * 6144 + n0 + F.lane;
        float a0 = 0.f, a1 = 0.f, a2 = 0.f, a3 = 0.f, a4 = 0.f;
        const int kb = F.wave * 128;
#pragma unroll 16
        for (int k = 0; k < 128; ++k) { const float wv = w[(size_t)(kb + k) * 6144];
            a0 += sc[kb + k] * wv; a1 += sc[1024 + kb + k] * wv; a2 += sc[2048 + kb + k] * wv; a3 += sc[3072 + kb + k] * wv; a4 += sc[4096 + kb + k] * wv; }
        red[(F.wave * 5 + 0) * 64 + F.lane] = a0; red[(F.wave * 5 + 1) * 64 + F.lane] = a1; red[(F.wave * 5 + 2) * 64 + F.lane] = a2; red[(F.wave * 5 + 3) * 64 + F.lane] = a3; red[(F.wave * 5 + 4) * 64 + F.lane] = a4;
        __syncthreads();
        if (F.tid < 320) { const int r = F.tid >> 6, ln = F.tid & 63; float s = 0.f;
#pragma unroll
            for (int w8 = 0; w8 < 8; ++w8) s += red[(w8 * 5 + r) * 64 + ln];
            mod[((size_t)l * 5 + r) * 6144 + n0 + ln] = s + IN(I_MODB)[l * 6144 + n0 + ln]; }
        __syncthreads();
    }
}

__device__ __forceinline__ void ph_prologue(Fr& F) {
    unsigned char* ws = F.ws;
    transpose_group(F, 0, F.bid, F.G);
    __syncthreads();
    mod_layer(F, 0, F.bid, F.G);
    {
        float* h3 = (float*)(ws + WS_H3);
        const float* w1 = IN(I_FW1); const float* w2 = IN(I_FW2); const float* w3 = IN(I_FW3);
        const float fr = IN(I_FREQ)[F.lane], b1 = IN(I_FB1)[F.lane], b2 = IN(I_FB2)[F.lane], b3 = IN(I_FB3)[F.lane];
        for (int row = F.gw; row < SEQ + CTXL; row += F.ngw) {
            const int L = row < SEQ ? SEQ : CTXL, i = row < SEQ ? row : row - SEQ;
            const float tl = (float)i / (float)(L - 1), w = 6.283185307179586f * (float)i / (float)L;
            float pos = 0.f; const int k = F.lane;
            if (k == 0) pos = tl;
            else if (k <= 16) { const float band = 1e-4f + (float)(k - 1) * ((15.0f - 1e-4f) / 15.0f); pos = cosf(band * w); }
            else if (k <= 32) { const float band = 1e-4f + (float)(k - 17) * ((15.0f - 1e-4f) / 15.0f); pos = -sinf(band * w); }
            float s = b1;
#pragma unroll
            for (int kk = 0; kk < 33; ++kk) s += __shfl(pos, kk) * w1[kk * 64 + F.lane];
            float h = sinf(fr * s);
            s = b2;
#pragma unroll 16
            for (int kk = 0; kk < 64; ++kk) s += __shfl(h, kk) * w2[kk * 64 + F.lane];
            h = sinf(fr * s);
            s = b3;
#pragma unroll 16
            for (int kk = 0; kk < 64; ++kk) s += __shfl(h, kk) * w3[kk * 64 + F.lane];
            h = sinf(fr * s);
            h3[(size_t)row * 64 + F.lane] = h;
        }
    }
    {
        bf16* gwt = (bf16*)(ws + WS_GWT); float* wkq = (float*)(ws + WS_WKQ);
        const float* wq = IN(I_MWQ); const float* wk = IN(I_MWK); const float* wv = IN(I_MWV); const float* wg = IN(I_MWG);
        const int gt = F.bid * NTHR + F.tid, nt = F.G * NTHR;
        for (int i = gt; i < MI * 16; i += nt) { const int ch = i >> 4, g = i & 15, n = ch >> 2, c = ch & 3; float sa = 0.f, sb = 0.f;
#pragma unroll
            for (int e = 0; e < 4; ++e) { sa += wq[n * 16 + c * 4 + e] * wg[(size_t)(n * 4 + e) * 16 + g] + wk[n * 16 + c * 4 + e] * wg[(size_t)(MI + n * 4 + e) * 16 + g];
                sb += wv[n * 16 + c * 4 + e] * wg[(size_t)(2 * MI + n * 4 + e) * 16 + g]; }
            const size_t go = ((size_t)(ch >> 5) * 64 + g + 16 * ((ch & 31) >> 3)) * 8 + (ch & 7);
            gwt[go] = (bf16)f2bf(sa); gwt[go + 64 * 512] = (bf16)f2bf(sb); }
        const float sc = 0.044194173824159216f;
        for (int i = gt; i < 512 * 16; i += nt) { const int n = i >> 4, c = (i >> 2) & 3, c2 = i & 3; float s = 0.f;
#pragma unroll
            for (int e = 0; e < 4; ++e) s += wk[n * 16 + c * 4 + e] * wq[n * 16 + c2 * 4 + e];
            wkq[i] = s * sc; }
    }
}

__device__ __forceinline__ void kt_items(Fr& F, const float* h3rows, int L, float* KT, int vgw, int vngw) {
    const float* wout = IN(I_FWOUT);
    const int nitems = (L / 16) * 32, fr = F.lane & 15, fq = F.lane >> 4;
    for (int it = vgw; it < nitems; it += vngw) {
        const int t0 = (it >> 5) * 16, n0 = (it & 31) * 64;
        float a[16];
#pragma unroll
        for (int ks = 0; ks < 16; ++ks) a[ks] = h3rows[(size_t)(t0 + fr) * 64 + 4 * ks + fq];
#pragma unroll
        for (int nt = 0; nt < 4; ++nt) {
            f32x4 acc = (f32x4){0.f, 0.f, 0.f, 0.f};
#pragma unroll
            for (int ks = 0; ks < 16; ++ks) acc = __builtin_amdgcn_mfma_f32_16x16x4f32(a[ks], wout[(size_t)(4 * ks + fq) * 2048 + n0 + nt * 16 + fr], acc, 0, 0, 0);
            const int n = n0 + nt * 16 + fr, dirn = n >> 10, c = n & 1023;
            const float delta = fabsf(HY_MIN_DECAY + (float)c * ((HY_MAX_DECAY - HY_MIN_DECAY) / 1023.0f)), il = 1.0f / (float)(L - 1);
            f32x4 o;
#pragma unroll
            for (int r = 0; r < 4; ++r) o[r] = acc[r] * __expf(-(float)(t0 + 4 * fq + r) * il * delta);
            *(f32x4*)(KT + ((size_t)c * 2 + dirn) * L + t0 + 4 * fq) = o;
        }
    }
}

__device__ __forceinline__ void modnorm_row(const float* xrow, const float* g, const float* sh, const float* sc, bf16* orow, int lane) {
    const f32x4* xr = (const f32x4*)xrow + lane; f32x4 v[4]; float s = 0.f;
#pragma unroll
    for (int j = 0; j < 4; ++j) { v[j] = xr[64 * j]; s += (v[j][0] * v[j][0] + v[j][1] * v[j][1]) + (v[j][2] * v[j][2] + v[j][3] * v[j][3]); }
    const float rinv = 1.0f / sqrtf(wave_sum(s) * (1.0f / 1024.0f) + EPS);
    u32x2* o8 = (u32x2*)orow + lane;
#pragma unroll
    for (int j = 0; j < 4; ++j) { const int c = 4 * lane + 256 * j; const f32x4 gg = *(const f32x4*)(g + c), s1 = *(const f32x4*)(sc + c), s0 = *(const f32x4*)(sh + c);
        const f32x4 y = (v[j] * rinv * gg) * (1.0f + s1) + s0; u32x2 w; w.x = pk2(y[0], y[1]); w.y = pk2(y[2], y[3]); o8[64 * j] = w; }
}
__device__ __forceinline__ void ph_modnorm(Fr& F, const float* xlat, int nlat, int b0, const float* xctx, int nctx, const float* g, const float* modl, int shoff, bf16* H,
                                           const bf16* dl = nullptr, float* olat = nullptr, float* octx = nullptr) {
    const int nrows = nlat + nctx;
    for (int r = F.gw; r < nrows; r += 2 * F.ngw) {
        const int r2 = r + F.ngw; const bool has2 = r2 < nrows; const int rb = has2 ? r2 : r;
        const bool isl = r < nlat, isl2 = rb < nlat;
        const size_t oa_ = isl ? (size_t)r * 1024 : (size_t)(r - nlat) * 1024, ob_ = isl2 ? (size_t)rb * 1024 : (size_t)(rb - nlat) * 1024;
        const float* xa = (isl ? xlat : xctx) + oa_; const float* xb = (isl2 ? xlat : xctx) + ob_;
        const int ma = isl ? b0 + r / SEQ : 4, mb = isl2 ? b0 + rb / SEQ : 4;
        const f32x4* pa = (const f32x4*)xa + F.lane; const f32x4* pb = (const f32x4*)xb + F.lane; f32x4 va[4], vb[4]; float sa = 0.f, sb = 0.f;
#pragma unroll
        for (int j = 0; j < 4; ++j) { va[j] = pa[64 * j]; vb[j] = pb[64 * j]; }
        if (dl) {
            const u32x2* da = (const u32x2*)(dl + (size_t)r * 1024) + F.lane; const u32x2* db = (const u32x2*)(dl + (size_t)rb * 1024) + F.lane;
            f32x4* qa = (f32x4*)((isl ? olat : octx) + oa_) + F.lane; f32x4* qb = (f32x4*)((isl2 ? olat : octx) + ob_) + F.lane;
#pragma unroll
            for (int j = 0; j < 4; ++j) { const u32x2 a = da[64 * j], b = db[64 * j];
                va[j] = va[j] + (f32x4){bflo(a.x), bfhi(a.x), bflo(a.y), bfhi(a.y)}; vb[j] = vb[j] + (f32x4){bflo(b.x), bfhi(b.x), bflo(b.y), bfhi(b.y)};
                qa[64 * j] = va[j]; if (has2) qb[64 * j] = vb[j]; }
        }
#pragma unroll
        for (int j = 0; j < 4; ++j) { sa += (va[j][0] * va[j][0] + va[j][1] * va[j][1]) + (va[j][2] * va[j][2] + va[j][3] * va[j][3]); sb += (vb[j][0] * vb[j][0] + vb[j][1] * vb[j][1]) + (vb[j][2] * vb[j][2] + vb[j][3] * vb[j][3]); }
        const float ra = __builtin_amdgcn_rsqf(wave_sum(sa) * (1.0f / 1024.0f) + EPS), rbv = __builtin_amdgcn_rsqf(wave_sum(sb) * (1.0f / 1024.0f) + EPS);
        const float* sha = modl + (size_t)ma * 6144 + shoff; const float* shb = modl + (size_t)mb * 6144 + shoff;
        u32x2* oa = (u32x2*)(H + (size_t)r * 1024) + F.lane; u32x2* ob = (u32x2*)(H + (size_t)rb * 1024) + F.lane;
#pragma unroll
        for (int j = 0; j < 4; ++j) { const int c = 4 * F.lane + 256 * j; const f32x4 gg = *(const f32x4*)(g + c);
            const f32x4 ya = (va[j] * ra * gg) * (1.0f + *(const f32x4*)(sha + 1024 + c)) + *(const f32x4*)(sha + c);
            const f32x4 yb = (vb[j] * rbv * gg) * (1.0f + *(const f32x4*)(shb + 1024 + c)) + *(const f32x4*)(shb + c);
            oa[64 * j] = (u32x2){pk2(ya[0], ya[1]), pk2(ya[2], ya[3])};
            if (has2) ob[64 * j] = (u32x2){pk2(yb[0], yb[1]), pk2(yb[2], yb[3])}; }
    }
}
__device__ __forceinline__ void add_delta_rows(Fr& F, float* x, const bf16* dl, int r0, int n) {
    for (int r = r0 + F.gw; r < r0 + n; r += F.ngw) {
        f32x4* px = (f32x4*)(x + (size_t)r * 1024) + F.lane; const u32x2* pd = (const u32x2*)(dl + (size_t)r * 1024) + F.lane; f32x4 v[4]; u32x2 d[4];
#pragma unroll
        for (int j = 0; j < 4; ++j) { v[j] = px[64 * j]; d[j] = pd[64 * j]; }
#pragma unroll
        for (int j = 0; j < 4; ++j) px[64 * j] = v[j] + (f32x4){bflo(d[j].x), bfhi(d[j].x), bflo(d[j].y), bfhi(d[j].y)};
    }
}

__device__ __forceinline__ void zt_items(Fr& F, const bf16* P, int rowbase, int nb, int Ls, bf16* ZT) {
    LAS unsigned char* tile = F.lds + F.wave * 16384;
    const float* scw = IN(I_HSCW); const float* scb = IN(I_HSCB);
    const int ntt = Ls / 64, nitems = nb * ntt * 16, tl = F.lane >> 3, c8 = F.lane & 7;
    for (int it = F.gw; it < nitems; it += F.ngw) {
        const int ct = it & 15, tt = (it >> 4) % ntt, b = (it >> 4) / ntt, t0 = tt * 64, ch = ct * 64 + c8 * 8;
        float w1[3][8], w2[3][8], b1[8], b2[8];
#pragma unroll
        for (int k = 0; k < 3; ++k) { const f32x4 a0 = *(const f32x4*)(scw + k * 3072 + 1024 + ch), a1 = *(const f32x4*)(scw + k * 3072 + 1024 + ch + 4), d0 = *(const f32x4*)(scw + k * 3072 + 2048 + ch), d1 = *(const f32x4*)(scw + k * 3072 + 2048 + ch + 4);
#pragma unroll
            for (int e = 0; e < 4; ++e) { w1[k][e] = a0[e]; w1[k][4 + e] = a1[e]; w2[k][e] = d0[e]; w2[k][4 + e] = d1[e]; } }
        { const f32x4 a0 = *(const f32x4*)(scb + 1024 + ch), a1 = *(const f32x4*)(scb + 1024 + ch + 4), d0 = *(const f32x4*)(scb + 2048 + ch), d1 = *(const f32x4*)(scb + 2048 + ch + 4);
#pragma unroll
            for (int e = 0; e < 4; ++e) { b1[e] = a0[e]; b1[4 + e] = a1[e]; b2[e] = d0[e]; b2[4 + e] = d1[e]; } }
        const bf16* pb = P + (size_t)(rowbase + b * Ls) * 3072 + ch;
#pragma unroll 2
        for (int i8 = 0; i8 < 8; ++i8) {
            const int tloc = i8 * 8 + tl, t = t0 + tloc, tm = t > 0 ? t - 1 : t, tp = t + 1 < Ls ? t + 1 : t; const float mm = t > 0 ? 1.f : 0.f, mp = t + 1 < Ls ? 1.f : 0.f;
            const u32x4 r1m = *(const u32x4*)(pb + (size_t)tm * 3072 + 1024), r1c = *(const u32x4*)(pb + (size_t)t * 3072 + 1024), r1p = *(const u32x4*)(pb + (size_t)tp * 3072 + 1024);
            const u32x4 r2m = *(const u32x4*)(pb + (size_t)tm * 3072 + 2048), r2c = *(const u32x4*)(pb + (size_t)t * 3072 + 2048), r2p = *(const u32x4*)(pb + (size_t)tp * 3072 + 2048);
            float xm[8], xc[8], xp[8], vm[8], vc[8], vp[8];
            unpack8(r1m, xm); unpack8(r1c, xc); unpack8(r1p, xp); unpack8(r2m, vm); unpack8(r2c, vc); unpack8(r2p, vp);
            float zz[8];
#pragma unroll
            for (int e = 0; e < 8; ++e) { const float a = w1[0][e] * (xm[e] * mm) + w1[1][e] * xc[e] + w1[2][e] * (xp[e] * mp) + b1[e], d = w2[0][e] * (vm[e] * mm) + w2[1][e] * vc[e] + w2[2][e] * (vp[e] * mp) + b2[e]; zz[e] = a * d; }
#pragma unroll
            for (int e = 0; e < 8; e += 2) { const unsigned p = pk2(zz[e], zz[e + 1]);
                *(LAS bf16*)(tile + (c8 * 8 + e) * 136 + tloc * 2) = (bf16)(p & 0xffffu); *(LAS bf16*)(tile + (c8 * 8 + e + 1) * 136 + tloc * 2) = (bf16)(p >> 16); }
        }
#pragma unroll
        for (int q = 0; q < 8; ++q) { const int cc = q * 8 + (F.lane >> 3), chk = F.lane & 7;
            const u32x2 lo = *(const LAS u32x2*)(tile + cc * 136 + chk * 16), hi = *(const LAS u32x2*)(tile + cc * 136 + chk * 16 + 8);
            u32x4 o; o.x = lo.x; o.y = lo.y; o.z = hi.x; o.w = hi.y;
            *(u32x4*)(ZT + ((size_t)b * 1024 + ct * 64 + cc) * Ls + t0 + chk * 8) = o; }
    }
}

__device__ __forceinline__ f32x2 cmul(f32x2 a, f32x2 b) { return (f32x2){a.x * b.x - a.y * b.y, a.x * b.y + a.y * b.x}; }
__device__ __forceinline__ f32x2 cmulc(f32x2 a, f32x2 b) { return (f32x2){a.x * b.x + a.y * b.y, a.y * b.x - a.x * b.y}; }
__device__ __forceinline__ f32x2 twid(float f) { return (f32x2){__builtin_amdgcn_cosf(f), __builtin_amdgcn_sinf(f)}; }
#define PH(e) ((e) + ((e) >> 4))
__device__ __forceinline__ void fft_fwd(LAS f32x2* buf, int tid, int plo, int phi) {
#pragma unroll 1
    for (int p = plo; p < phi; ++p) {
        const int lq = 12 - 2 * p, q = 1 << lq; const float invN = 1.0f / (float)(4 * q);
#pragma unroll 2
        for (int m = 0; m < 8; ++m) {
            const int g = tid + 512 * m, i = g & (q - 1), i0 = ((g >> lq) << (lq + 2)) + i;
            const int e0 = PH(i0), e1 = PH(i0 + q), e2 = PH(i0 + 2 * q), e3 = PH(i0 + 3 * q);
            const f32x2 a0 = buf[e0], a1 = buf[e1], a2 = buf[e2], a3 = buf[e3];
            const f32x2 t0 = a0 + a2, t1 = a0 - a2, t2 = a1 + a3, d = a1 - a3, t3 = (f32x2){d.y, -d.x};
            const f32x2 w1 = twid(-(float)i * invN), w2 = cmul(w1, w1), w3 = cmul(w2, w1);
            buf[e0] = t0 + t2; buf[e1] = cmul(t1 + t3, w1); buf[e2] = cmul(t0 - t2, w2); buf[e3] = cmul(t1 - t3, w3);
        }
        __syncthreads();
    }
}
__device__ __forceinline__ void fft_inv(LAS f32x2* buf, int tid, int plo, int phi) {
#pragma unroll 1
    for (int p = phi - 1; p >= plo; --p) {
        const int lq = 12 - 2 * p, q = 1 << lq; const float invN = 1.0f / (float)(4 * q);
#pragma unroll 2
        for (int m = 0; m < 8; ++m) {
            const int g = tid + 512 * m, i = g & (q - 1), i0 = ((g >> lq) << (lq + 2)) + i;
            const int e0 = PH(i0), e1 = PH(i0 + q), e2 = PH(i0 + 2 * q), e3 = PH(i0 + 3 * q);
            const f32x2 w1 = twid((float)i * invN), w2 = cmul(w1, w1), w3 = cmul(w2, w1);
            const f32x2 b0 = buf[e0], b1 = cmul(buf[e1], w1), b2 = cmul(buf[e2], w2), b3 = cmul(buf[e3], w3);
            const f32x2 t0 = b0 + b2, t1 = b0 - b2, t2 = b1 + b3, d = b1 - b3, t3 = (f32x2){-d.y, d.x};
            buf[e0] = t0 + t2; buf[e1] = t1 + t3; buf[e2] = t0 - t2; buf[e3] = t1 - t3;
        }
        __syncthreads();
    }
}
__device__ __forceinline__ void fwd16_A(f32x2 (&x)[16]) {
    const float C1 = 0.92387953251128674f, S1 = 0.38268343236508977f, R2 = 0.70710678118654752f;
#pragma unroll
    for (int i = 0; i < 4; ++i) {
        const f32x2 a0 = x[i], a1 = x[i + 4], a2 = x[i + 8], a3 = x[i + 12];
        const f32x2 t0 = a0 + a2, t1 = a0 - a2, t2 = a1 + a3, d = a1 - a3, t3 = (f32x2){d.y, -d.x};
        const f32x2 y1 = t1 + t3, y2 = t0 - t2, y3 = t1 - t3;
        x[i] = t0 + t2;
        if (i == 0) { x[4] = y1; x[8] = y2; x[12] = y3; }
        else if (i == 1) { x[5] = cmul(y1, (f32x2){C1, -S1}); x[9] = cmul(y2, (f32x2){R2, -R2}); x[13] = cmul(y3, (f32x2){S1, -C1}); }
        else if (i == 2) { x[6] = cmul(y1, (f32x2){R2, -R2}); x[10] = (f32x2){y2.y, -y2.x}; x[14] = cmul(y3, (f32x2){-R2, -R2}); }
        else { x[7] = cmul(y1, (f32x2){S1, -C1}); x[11] = cmul(y2, (f32x2){-R2, -R2}); x[15] = cmul(y3, (f32x2){-C1, S1}); }
    }
}
__device__ __forceinline__ void fwd16_B(f32x2 (&x)[16]) {
#pragma unroll
    for (int g = 0; g < 4; ++g) {
        const f32x2 a0 = x[4 * g], a1 = x[4 * g + 1], a2 = x[4 * g + 2], a3 = x[4 * g + 3];
        const f32x2 t0 = a0 + a2, t1 = a0 - a2, t2 = a1 + a3, d = a1 - a3, t3 = (f32x2){d.y, -d.x};
        x[4 * g] = t0 + t2; x[4 * g + 1] = t1 + t3; x[4 * g + 2] = t0 - t2; x[4 * g + 3] = t1 - t3;
    }
}
__device__ __forceinline__ void inv16_B(f32x2 (&x)[16]) {
#pragma unroll
    for (int g = 0; g < 4; ++g) {
        const f32x2 b0 = x[4 * g], b1 = x[4 * g + 1], b2 = x[4 * g + 2], b3 = x[4 * g + 3];
        const f32x2 t0 = b0 + b2, t1 = b0 - b2, t2 = b1 + b3, d = b1 - b3, t3 = (f32x2){-d.y, d.x};
        x[4 * g] = t0 + t2; x[4 * g + 1] = t1 + t3; x[4 * g + 2] = t0 - t2; x[4 * g + 3] = t1 - t3;
    }
}
__device__ __forceinline__ void inv16_A(f32x2 (&x)[16]) {
    const float C1 = 0.92387953251128674f, S1 = 0.38268343236508977f, R2 = 0.70710678118654752f;
#pragma unroll
    for (int i = 0; i < 4; ++i) {
        f32x2 b0 = x[i], b1 = x[i + 4], b2 = x[i + 8], b3 = x[i + 12];
        if (i == 1) { b1 = cmul(b1, (f32x2){C1, S1}); b2 = cmul(b2, (f32x2){R2, R2}); b3 = cmul(b3, (f32x2){S1, C1}); }
        else if (i == 2) { b1 = cmul(b1, (f32x2){R2, R2}); b2 = (f32x2){-b2.y, b2.x}; b3 = cmul(b3, (f32x2){-R2, R2}); }
        else if (i == 3) { b1 = cmul(b1, (f32x2){S1, C1}); b2 = cmul(b2, (f32x2){-R2, R2}); b3 = cmul(b3, (f32x2){-C1, -S1}); }
        const f32x2 t0 = b0 + b2, t1 = b0 - b2, t2 = b1 + b3, d = b1 - b3, t3 = (f32x2){-d.y, d.x};
        x[i] = t0 + t2; x[i + 4] = t1 + t3; x[i + 8] = t0 - t2; x[i + 12] = t1 - t3;
    }
}
__device__ __forceinline__ void fwd16(f32x2 (&x)[16]) { fwd16_A(x); fwd16_B(x); }
__device__ __forceinline__ void inv16(f32x2 (&x)[16]) { inv16_B(x); inv16_A(x); }
__device__ __forceinline__ void r16_fwd2(LAS f32x2* buf, int tid) {
#pragma unroll 1
  for (int lqp = 8; lqp >= 4; lqp -= 4) {
    const int qp = 1 << lqp; const float inv = 1.0f / (float)(16 * qp);
#pragma unroll
    for (int m = 0; m < 2; ++m) {
        const int g = tid + 512 * m, i = g & (qp - 1), e0 = ((g >> lqp) << (lqp + 4)) + i; f32x2 x[16];
#pragma unroll
        for (int j = 0; j < 16; ++j) x[j] = buf[PH(e0 + (j << lqp))];
        const f32x2 w1 = twid(-(float)i * inv), w2 = cmul(w1, w1), w3 = cmul(w2, w1), v1 = cmul(w2, w2), v2 = cmul(v1, v1), v3 = cmul(v2, v1);
        fwd16_A(x);
#pragma unroll
        for (int l = 0; l < 4; ++l) { x[l + 4] = cmul(x[l + 4], w1); x[l + 8] = cmul(x[l + 8], w2); x[l + 12] = cmul(x[l + 12], w3); }
        fwd16_B(x);
#pragma unroll
        for (int k = 0; k < 4; ++k) { x[4 * k + 1] = cmul(x[4 * k + 1], v1); x[4 * k + 2] = cmul(x[4 * k + 2], v2); x[4 * k + 3] = cmul(x[4 * k + 3], v3); }
#pragma unroll
        for (int j = 0; j < 16; ++j) buf[PH(e0 + (j << lqp))] = x[j];
    }
    __syncthreads();
  }
}
__device__ __forceinline__ void r16_inv2(LAS f32x2* buf, int tid) {
#pragma unroll 1
  for (int lqp = 4; lqp <= 8; lqp += 4) {
    const int qp = 1 << lqp; const float inv = 1.0f / (float)(16 * qp);
#pragma unroll
    for (int m = 0; m < 2; ++m) {
        const int g = tid + 512 * m, i = g & (qp - 1), e0 = ((g >> lqp) << (lqp + 4)) + i; f32x2 x[16];
#pragma unroll
        for (int j = 0; j < 16; ++j) x[j] = buf[PH(e0 + (j << lqp))];
        const f32x2 w1 = twid((float)i * inv), w2 = cmul(w1, w1), w3 = cmul(w2, w1), v1 = cmul(w2, w2), v2 = cmul(v1, v1), v3 = cmul(v2, v1);
#pragma unroll
        for (int k = 0; k < 4; ++k) { x[4 * k + 1] = cmul(x[4 * k + 1], v1); x[4 * k + 2] = cmul(x[4 * k + 2], v2); x[4 * k + 3] = cmul(x[4 * k + 3], v3); }
        inv16_B(x);
#pragma unroll
        for (int l = 0; l < 4; ++l) { x[l + 4] = cmul(x[l + 4], w1); x[l + 8] = cmul(x[l + 8], w2); x[l + 12] = cmul(x[l + 12], w3); }
        inv16_A(x);
#pragma unroll
        for (int j = 0; j < 16; ++j) buf[PH(e0 + (j << lqp))] = x[j];
    }
    __syncthreads();
  }
}
__device__ __forceinline__ float block_sum(Fr& F, float v, LAS float* red) {
    v = wave_sum(v);
    __syncthreads();
    if (F.lane == 0) red[F.wave] = v;
    __syncthreads();
    float s = 0.f;
#pragma unroll
    for (int w = 0; w < 8; ++w) s += red[w];
    return s;
}
__device__ __forceinline__ void ph_fftconv(Fr& F) {
    LAS f32x2* buf = (LAS f32x2*)F.lds; LAS float* red = (LAS float*)(F.lds + 139392);
    const float* KT = (const float*)(F.ws + HY_KT); const float* KTC = (const float*)(F.ws + WS_KTC);
    bf16* ZT = (bf16*)(F.ws + HY_ZT); bf16* ZTC = (bf16*)(F.ws + HY_ZTC);
    const int tid = F.tid;
    for (int c = F.bid; c < 1024; c += F.G) {
        const float bias = IN(I_HBIAS)[c];
        __syncthreads();
        float asum = 0.f;
        const f32x4* kf = (const f32x4*)(KT + (size_t)c * 2 * SEQ); const f32x4* kb = kf + SEQ / 4;
#pragma unroll
        for (int q = 0; q < 4; ++q) { const int i4 = tid + 512 * q; const f32x4 v = kf[i4];
            asum += fabsf(v[0]) + fabsf(v[1]) + fabsf(v[2]) + fabsf(v[3]);
            buf[PH(4 * i4)] = (f32x2){v[0], 0.f}; buf[PH(4 * i4 + 1)] = (f32x2){v[1], 0.f}; buf[PH(4 * i4 + 2)] = (f32x2){v[2], 0.f}; buf[PH(4 * i4 + 3)] = (f32x2){v[3], 0.f};
            const f32x4 u = kb[i4]; const int m = 4 * i4;
            if (m > 0) { buf[PH(16384 - m)] = (f32x2){u[0], 0.f}; asum += fabsf(u[0]); } else buf[PH(8192)] = (f32x2){0.f, 0.f};
            buf[PH(16384 - m - 1)] = (f32x2){u[1], 0.f}; buf[PH(16384 - m - 2)] = (f32x2){u[2], 0.f}; buf[PH(16384 - m - 3)] = (f32x2){u[3], 0.f};
            asum += fabsf(u[1]) + fabsf(u[2]) + fabsf(u[3]); }
        const float S = block_sum(F, asum, red);
        __syncthreads();
        fft_fwd(buf, tid, 0, 1); r16_fwd2(buf, tid);
        f32x4* Ks = (f32x4*)(F.ws + HY_KS) + (size_t)(F.bid & 255) * 8192 + tid * 8; const float ksc = 1.0f / (S * 16384.0f);
#pragma unroll 1
        for (int m = 0; m < 2; ++m) { const int pb = 17 * (tid + 512 * m); f32x2 x[16];
#pragma unroll
            for (int n = 0; n < 16; ++n) x[n] = buf[pb + n];
            fwd16(x);
#pragma unroll
            for (int n = 0; n < 8; ++n) Ks[m * 4096 + n] = (f32x4){x[2 * n].x * ksc, x[2 * n].y * ksc, x[2 * n + 1].x * ksc, x[2 * n + 1].y * ksc}; }
        const f32x2 dl = twid(-1.0f / 16384.0f);
#pragma unroll 1
        for (int pr = 0; pr < 2; ++pr) {
            bf16* z0 = ZT + ((size_t)(2 * pr) * 1024 + c) * SEQ; bf16* z1 = ZT + ((size_t)(2 * pr + 1) * 1024 + c) * SEQ;
            const int i8 = tid * 8;
            __syncthreads();
            {
                float a[8], b[8], cx[8], dx[8];
                unpack8(*(const u32x4*)(z0 + i8), a); unpack8(*(const u32x4*)(z1 + i8), b); unpack8(*(const u32x4*)(z0 + 4096 + i8), cx); unpack8(*(const u32x4*)(z1 + 4096 + i8), dx);
                f32x2 w1 = twid(-(float)i8 * (1.0f / 16384.0f));
#pragma unroll
                for (int e = 0; e < 8; ++e) { const f32x2 a0 = (f32x2){a[e], b[e]}, a1 = (f32x2){cx[e], dx[e]}, t3 = (f32x2){a1.y, -a1.x}; const f32x2 w2 = cmul(w1, w1), w3 = cmul(w2, w1);
                    buf[PH(i8 + e)] = a0 + a1; buf[PH(4096 + i8 + e)] = cmul(a0 + t3, w1); buf[PH(8192 + i8 + e)] = cmul(a0 - a1, w2); buf[PH(12288 + i8 + e)] = cmul(a0 - t3, w3);
                    w1 = cmul(w1, dl); }
            }
            __syncthreads();
            r16_fwd2(buf, tid);
#pragma unroll 1
            for (int m = 0; m < 2; ++m) { const int pb = 17 * (tid + 512 * m); f32x2 x[16];
#pragma unroll
                for (int n = 0; n < 16; ++n) x[n] = buf[pb + n];
                fwd16(x);
#pragma unroll
                for (int n = 0; n < 8; ++n) { const f32x4 k = Ks[m * 4096 + n]; x[2 * n] = cmul(x[2 * n], (f32x2){k[0], k[1]}); x[2 * n + 1] = cmul(x[2 * n + 1], (f32x2){k[2], k[3]}); }
                inv16(x);
#pragma unroll
                for (int n = 0; n < 16; ++n) buf[pb + n] = x[n]; }
            __syncthreads();
            r16_inv2(buf, tid);
            {
                float a[8], b[8], cx[8], dx[8];
                unpack8(*(const u32x4*)(z0 + i8), a); unpack8(*(const u32x4*)(z1 + i8), b); unpack8(*(const u32x4*)(z0 + 4096 + i8), cx); unpack8(*(const u32x4*)(z1 + 4096 + i8), dx);
                f32x2 w1 = twid(-(float)i8 * (1.0f / 16384.0f));
#pragma unroll
                for (int e = 0; e < 8; ++e) { const f32x2 w2 = cmul(w1, w1), w3 = cmul(w2, w1);
                    const f32x2 b0 = buf[PH(i8 + e)], b1 = cmulc(buf[PH(4096 + i8 + e)], w1), b2 = cmulc(buf[PH(8192 + i8 + e)], w2), b3 = cmulc(buf[PH(12288 + i8 + e)], w3);
                    const f32x2 t0 = b0 + b2, t1 = b0 - b2, t2 = b1 + b3, d = b1 - b3, t3 = (f32x2){-d.y, d.x};
                    const f32x2 y0 = t0 + t2, y1 = t1 + t3;
                    a[e] = y0.x + a[e] * bias; b[e] = y0.y + b[e] * bias; cx[e] = y1.x + cx[e] * bias; dx[e] = y1.y + dx[e] * bias;
                    w1 = cmul(w1, dl); }
                *(u32x4*)(z0 + i8) = pack8(a); *(u32x4*)(z1 + i8) = pack8(b); *(u32x4*)(z0 + 4096 + i8) = pack8(cx); *(u32x4*)(z1 + 4096 + i8) = pack8(dx);
            }
        }
        __syncthreads();
        {
            LAS float* kc = (LAS float*)F.lds; LAS float* zc = kc + 512;
            const float* kfc = KTC + (size_t)c * 2 * CTXL; float v = 0.f;
            { const int n = tid; if (n < 256) v = kfc[n]; else if (n == 256) v = 0.f; else v = kfc[CTXL + (512 - n)]; kc[n] = v; }
            const float Sc = block_sum(F, fabsf(v), red);
            for (int i = tid; i < 1024; i += NTHR) { const int b = i >> 8, t = i & 255; zc[i] = bf2f(ZTC[((size_t)b * 1024 + c) * CTXL + t]); }
            __syncthreads();
            const int b = tid >> 7, t2 = tid & 127; const float isc = 1.0f / Sc;
#pragma unroll
            for (int hh = 0; hh < 2; ++hh) { const int t = t2 + 128 * hh; float acc = 0.f;
#pragma unroll 8
                for (int s = 0; s < 256; ++s) acc += zc[b * 256 + s] * kc[(t - s) & 511];
                ZTC[((size_t)b * 1024 + c) * CTXL + t] = (bf16)f2bf(acc * isc + zc[b * 256 + t] * bias); }
        }
    }
}

__device__ __forceinline__ void u2_items(Fr& F, const bf16* P, int rowbase, int nb, int Ls, const bf16* YT, bf16* U2) {
    LAS unsigned char* tile = F.lds + F.wave * 16384;
    const float* scw = IN(I_HSCW); const float* scb = IN(I_HSCB);
    const int ntt = Ls / 64, nitems = nb * ntt * 16, tl = F.lane >> 3, c8 = F.lane & 7;
    for (int it = F.gw; it < nitems; it += F.ngw) {
        const int ct = it & 15, tt = (it >> 4) % ntt, b = (it >> 4) / ntt, t0 = tt * 64, ch = ct * 64 + c8 * 8;
#pragma unroll
        for (int q = 0; q < 8; ++q) { const int cc = q * 8 + (F.lane >> 3), chk = F.lane & 7;
            const u32x4 v = *(const u32x4*)(YT + ((size_t)b * 1024 + ct * 64 + cc) * Ls + t0 + chk * 8);
            *(LAS u32x2*)(tile + cc * 136 + chk * 16) = (u32x2){v.x, v.y}; *(LAS u32x2*)(tile + cc * 136 + chk * 16 + 8) = (u32x2){v.z, v.w}; }
        float w0[3][8], bb[8];
#pragma unroll
        for (int k = 0; k < 3; ++k) { const f32x4 a0 = *(const f32x4*)(scw + k * 3072 + ch), a1 = *(const f32x4*)(scw + k * 3072 + ch + 4);
#pragma unroll
            for (int e = 0; e < 4; ++e) { w0[k][e] = a0[e]; w0[k][4 + e] = a1[e]; } }
        { const f32x4 a0 = *(const f32x4*)(scb + ch), a1 = *(const f32x4*)(scb + ch + 4);
#pragma unroll
            for (int e = 0; e < 4; ++e) { bb[e] = a0[e]; bb[4 + e] = a1[e]; } }
        const bf16* pb = P + (size_t)(rowbase + b * Ls) * 3072 + ch; bf16* ub = U2 + (size_t)(rowbase + b * Ls) * 1024 + ch;
#pragma unroll 2
        for (int i8 = 0; i8 < 8; ++i8) {
            const int tloc = i8 * 8 + tl, t = t0 + tloc, tm = t > 0 ? t - 1 : t, tp = t + 1 < Ls ? t + 1 : t; const float mm = t > 0 ? 1.f : 0.f, mp = t + 1 < Ls ? 1.f : 0.f;
            const u32x4 rm = *(const u32x4*)(pb + (size_t)tm * 3072), rc = *(const u32x4*)(pb + (size_t)t * 3072), rp = *(const u32x4*)(pb + (size_t)tp * 3072);
            float xm[8], xc[8], xp[8], o[8];
            unpack8(rm, xm); unpack8(rc, xc); unpack8(rp, xp);
#pragma unroll
            for (int e = 0; e < 8; ++e) { const float x0 = w0[0][e] * (xm[e] * mm) + w0[1][e] * xc[e] + w0[2][e] * (xp[e] * mp) + bb[e]; o[e] = x0 * bf2f(*(const LAS bf16*)(tile + (c8 * 8 + e) * 136 + tloc * 2)); }
            *(u32x4*)(ub + (size_t)t * 1024) = pack8(o);
        }
    }
}

__device__ __forceinline__ void dw_item(const bf16* __restrict__ G, bf16* __restrict__ A, const float* __restrict__ cw, const float* __restrict__ cb, int f8, int rowtok0, int nx, int x0, bool up_ok, bool down_ok) {
    float w[9][8], bias[8];
#pragma unroll
    for (int k = 0; k < 9; ++k) { const float m = (k < 3) ? (up_ok ? 1.f : 0.f) : ((k >= 6) ? (down_ok ? 1.f : 0.f) : 1.f);
        const f32x4 w0 = *(const f32x4*)(cw + (size_t)k * FF + f8) * m, w1 = *(const f32x4*)(cw + (size_t)k * FF + f8 + 4) * m;
        w[k][0] = w0[0]; w[k][1] = w0[1]; w[k][2] = w0[2]; w[k][3] = w0[3]; w[k][4] = w1[0]; w[k][5] = w1[1]; w[k][6] = w1[2]; w[k][7] = w1[3]; }
    { const f32x4 b0 = *(const f32x4*)(cb + f8), b1 = *(const f32x4*)(cb + f8 + 4); bias[0] = b0[0]; bias[1] = b0[1]; bias[2] = b0[2]; bias[3] = b0[3]; bias[4] = b1[0]; bias[5] = b1[1]; bias[6] = b1[2]; bias[7] = b1[3]; }
    const int upo = up_ok ? -nx : 0, dno = down_ok ? nx : 0;
    const bf16* __restrict__ g0 = G + (size_t)rowtok0 * FF + f8; bf16* __restrict__ a0 = A + (size_t)rowtok0 * FF + f8;
    const u32x4 zero4 = (u32x4){0u, 0u, 0u, 0u};
    u32x4 cm[3], cc[3];
    { const int xm = x0 > 0 ? x0 - 1 : 0; const bool okm = x0 > 0;
        cm[0] = *(const u32x4*)(g0 + (size_t)(xm + upo) * FF); cm[1] = *(const u32x4*)(g0 + (size_t)xm * FF); cm[2] = *(const u32x4*)(g0 + (size_t)(xm + dno) * FF);
        if (!okm) { cm[0] = zero4; cm[1] = zero4; cm[2] = zero4; }
        cc[0] = *(const u32x4*)(g0 + (size_t)(x0 + upo) * FF); cc[1] = *(const u32x4*)(g0 + (size_t)x0 * FF); cc[2] = *(const u32x4*)(g0 + (size_t)(x0 + dno) * FF); }
    u32x4 pa[2][3], pav[2], pb[2][3], pbv[2];
#define DW_LOAD_GROUP(buf, bufv, jg) do { _Pragma("unroll") for (int u = 0; u < 2; ++u) { const int x_ = x0 + (jg) + u, xp_ = x_ + 1 < nx ? x_ + 1 : nx - 1; \
        buf[u][0] = *(const u32x4*)(g0 + (size_t)(xp_ + upo) * FF); buf[u][1] = *(const u32x4*)(g0 + (size_t)xp_ * FF); buf[u][2] = *(const u32x4*)(g0 + (size_t)(xp_ + dno) * FF); \
        bufv[u] = *(const u32x4*)(a0 + (size_t)x_ * FF); } } while (0)
#define DW_COMPUTE_GROUP(buf, bufv, jg) do { _Pragma("unroll") for (int u = 0; u < 2; ++u) { \
        const int x = x0 + (jg) + u; const bool okp = x + 1 < nx; \
        if (!okp) { buf[u][0] = zero4; buf[u][1] = zero4; buf[u][2] = zero4; } \
        float acc[8]; \
        _Pragma("unroll") for (int e = 0; e < 8; ++e) acc[e] = bias[e]; \
        _Pragma("unroll") for (int dy = 0; dy < 3; ++dy) { float v[8]; \
            unpack8(cm[dy], v); _Pragma("unroll") for (int e = 0; e < 8; ++e) acc[e] += v[e] * w[dy * 3 + 0][e]; \
            unpack8(cc[dy], v); _Pragma("unroll") for (int e = 0; e < 8; ++e) acc[e] += v[e] * w[dy * 3 + 1][e]; \
            unpack8(buf[u][dy], v); _Pragma("unroll") for (int e = 0; e < 8; ++e) acc[e] += v[e] * w[dy * 3 + 2][e]; } \
        float a[8]; unpack8(bufv[u], a); \
        _Pragma("unroll") for (int e = 0; e < 8; ++e) a[e] = silu_f(acc[e]) * a[e]; \
        *(u32x4*)(a0 + (size_t)x * FF) = pack8(a); \
        _Pragma("unroll") for (int dy = 0; dy < 3; ++dy) { cm[dy] = cc[dy]; cc[dy] = buf[u][dy]; } } } while (0)
    DW_LOAD_GROUP(pa, pav, 0);
#pragma unroll 1
    for (int jg = 0; jg < 32; jg += 4) {
        DW_LOAD_GROUP(pb, pbv, jg + 2);
        DW_COMPUTE_GROUP(pa, pav, jg);
        { const int jn = jg + 4 < 32 ? jg + 4 : jg; DW_LOAD_GROUP(pa, pav, jn); }
        DW_COMPUTE_GROUP(pb, pbv, jg + 2);
    }
#undef DW_COMPUTE_GROUP
#undef DW_LOAD_GROUP
}
__device__ __forceinline__ void ph_dwconv(Fr& F, int layer, int nlat, int nctx) {
    bf16* A = (bf16*)(F.ws + FF_A); const bf16* G = (const bf16*)(F.ws + FF_G);
    const float* cw = IN(I_FCW) + (size_t)layer * 9 * FF; const float* cb = IN(I_FCB) + (size_t)layer * FF;
    const int ngrp = (F.G % 8 == 0) ? 8 : 1, xg = F.bid % ngrp, lb = F.bid / ngrp, nlb = F.G / ngrp;
    const int nseg = nlat / 32, band = nseg / ngrp;
    for (int i = lb * NTHR + F.tid; i < band * 352; i += nlb * NTHR) {
        const int sl = i / 352, f8 = (i - sl * 352) * 8, seg = xg * band + sl, grow = seg >> 1, gy = grow & 127;
        dw_item(G, A, cw, cb, f8, grow * 64, 64, (seg & 1) * 32, gy > 0, gy < 127);
    }
    const int nsegc = nctx / 32;
    for (int i = F.bid * NTHR + F.tid; i < nsegc * 352; i += F.G * NTHR) {
        const int sl = i / 352, f8 = (i - sl * 352) * 8;
        dw_item(G, A, cw, cb, f8, nlat + (sl >> 3) * CTXL, CTXL, (sl & 7) * 32, false, false);
    }
}

__device__ __forceinline__ void prep_items(Fr& F, const bf16* XM, int nb, int Ls, bf16* XC, bf16* KN, bf16* KT, bf16* VT) {
    LAS unsigned char* tk = F.lds + F.wave * 17408; LAS unsigned char* tv = tk + 8704;
    const int ntt = Ls / 64, nitems = nb * ntt * 32;
    const int tl = F.lane >> 3, c8 = F.lane & 7;
    for (int it = F.gw; it < nitems; it += F.ngw) {
        const int cg = it & 31, tt = (it >> 5) % ntt, b = (it >> 5) / ntt, t0 = tt * 64, ch0 = cg * 64 + c8 * 8, h = cg >> 3;
        float cw0[8], cw1[8], cw2[8], cbb[8], wkq[32], wv[32];
        { const float* p = IN(I_MCW) + ch0; const float* pb = IN(I_MCB) + ch0;
#pragma unroll
            for (int e = 0; e < 8; ++e) { cw0[e] = p[e]; cw1[e] = p[MI + e]; cw2[e] = p[2 * MI + e]; cbb[e] = pb[e]; }
            const float* q = (const float*)(F.ws + WS_WKQ) + (ch0 >> 2) * 16; const float* v = IN(I_MWV) + (ch0 >> 2) * 16;
#pragma unroll
            for (int e = 0; e < 32; ++e) { wkq[e] = q[e]; wv[e] = v[e]; } }
#pragma unroll 2
        for (int i8 = 0; i8 < 8; ++i8) {
            const int tloc = i8 * 8 + tl, t = t0 + tloc; const size_t row = (size_t)b * Ls + t;
            float xp[8], xm[8], xn[8];
            const size_t rowp = row - (t > 0 ? 1 : 0), rown = row + (t + 1 < Ls ? 1 : 0); const size_t ctile = (size_t)(ch0 >> 5) * 512 + ((ch0 & 31) >> 3) * 128;
            const u32x4 rm = *(const u32x4*)(XM + (row >> 4) * 32768 + ctile + (row & 15) * 8), rp = *(const u32x4*)(XM + (rowp >> 4) * 32768 + ctile + (rowp & 15) * 8), rn = *(const u32x4*)(XM + (rown >> 4) * 32768 + ctile + (rown & 15) * 8);
            unpack8(rm, xm); unpack8(rp, xp); unpack8(rn, xn);
            { const float mp = t > 0 ? 1.f : 0.f, mn = t + 1 < Ls ? 1.f : 0.f;
#pragma unroll
                for (int e = 0; e < 8; ++e) { xp[e] *= mp; xn[e] *= mn; } }
            float xc[8], kp[8], vv[8];
#pragma unroll
            for (int e = 0; e < 8; ++e) xc[e] = silu_f(cw0[e] * xp[e] + cw1[e] * xm[e] + cw2[e] * xn[e] + cbb[e]);
#pragma unroll
            for (int n = 0; n < 2; ++n)
#pragma unroll
                for (int o = 0; o < 4; ++o) { float sk = 0.f, sv = 0.f;
#pragma unroll
                    for (int c = 0; c < 4; ++c) { sk += xc[n * 4 + c] * wkq[n * 16 + c * 4 + o]; sv += xm[n * 4 + c] * wv[n * 16 + c * 4 + o]; }
                    kp[n * 4 + o] = sk; vv[n * 4 + o] = sv; }
            { const size_t to = ((size_t)(row >> 4) * 64 + (ch0 >> 5)) * 512 + (((unsigned)row & 15u) + 16u * ((ch0 & 31) >> 3)) * 8u;
              *(u32x4*)(XC + to) = pack8(xc); *(u32x4*)(KN + to) = pack8(kp); }
#pragma unroll
            for (int e = 0; e < 8; e += 2) { const unsigned pk = pk2(kp[e], kp[e + 1]), pv = pk2(vv[e], vv[e + 1]);
                *(LAS bf16*)(tk + (c8 * 8 + e) * 136 + tloc * 2) = (bf16)(pk & 0xffffu); *(LAS bf16*)(tk + (c8 * 8 + e + 1) * 136 + tloc * 2) = (bf16)(pk >> 16);
                *(LAS bf16*)(tv + (c8 * 8 + e) * 136 + tloc * 2) = (bf16)(pv & 0xffffu); *(LAS bf16*)(tv + (c8 * 8 + e + 1) * 136 + tloc * 2) = (bf16)(pv >> 16); }
        }
#pragma unroll
        for (int q = 0; q < 8; ++q) { const int dt = q >> 1, kq = q & 1, r = F.lane & 15, q4 = F.lane >> 4;
            const size_t tile = ((size_t)(t0 >> 7) * 32 + (cg & 7) * 4 + dt) * 4 + ((t0 & 127) >> 5) + kq;
            const size_t o = (size_t)(b * 4 + h) * 512 * Ls + tile * 512 + F.lane * 8;
            { const u32x2 lo = *(const LAS u32x2*)(tk + (dt * 16 + r) * 136 + kq * 64 + q4 * 16), hi = *(const LAS u32x2*)(tk + (dt * 16 + r) * 136 + kq * 64 + q4 * 16 + 8); *(u32x4*)(KT + o) = (u32x4){lo.x, lo.y, hi.x, hi.y}; }
            { const u32x2 lo = *(const LAS u32x2*)(tv + (dt * 16 + r) * 136 + kq * 64 + q4 * 16), hi = *(const LAS u32x2*)(tv + (dt * 16 + r) * 136 + kq * 64 + q4 * 16 + 8); *(u32x4*)(VT + o) = (u32x4){lo.x, lo.y, hi.x, hi.y}; }
        }
    }
}

__device__ __forceinline__ void gate_items(Fr& F, const bf16* XC, const bf16* XM, int R, float* GATES) {
    const bf16* gwt = (const bf16*)(F.ws + WS_GWT);
    const int fr = F.lane & 15, fq = F.lane >> 4, half = F.wave & 1, pr = F.wave >> 1, ntiles = R / 16;
    LAS f32x4* xch = (LAS f32x4*)(F.lds + pr * 1024);
    for (int base = F.bid * 4; base < ntiles; base += F.G * 4) {
        const int tile = base + pr; const bool ok = tile < ntiles; const int tl = ok ? tile : 0;
        f32x4 acc = (f32x4){0.f, 0.f, 0.f, 0.f};
        const bf16* ap = (half ? XM : XC) + (size_t)tl * 32768 + F.lane * 8; const bf16* bp = gwt + (size_t)half * 64 * 512 + F.lane * 8;
#pragma unroll 16
        for (int ks = 0; ks < 64; ++ks) acc = __builtin_amdgcn_mfma_f32_16x16x32_bf16(*(const bf16x8*)(ap + ks * 512), *(const bf16x8*)(bp + ks * 512), acc, 0, 0, 0);
        __syncthreads();
        if (half) xch[F.lane] = acc;
        __syncthreads();
        if (!half && ok) { acc = acc + xch[F.lane];
            const int r0 = tile * 16; const float bg = IN(I_MBG)[fr]; const bool isf = (fr >> 2) & 1;
#pragma unroll
            for (int r = 0; r < 4; ++r) { float x = acc[r] + bg; if (isf) x = fminf(x, 0.f) - log1pf(__expf(-fabsf(x))); GATES[(size_t)(r0 + 4 * fq + r) * 16 + fr] = x; } }
    }
}

__device__ __forceinline__ void cum_items(Fr& F, const float* GATES, int nb, int Ls, int gb0, int ctau0, f32x4* GT, float* GC) {
    const int R = nb * Ls, nch = Ls / 128, nitems = 2 * nb * 4 * nch;
    for (int it = F.gw; it < nitems; it += F.ngw) {
        const int c = it % nch, h = (it / nch) & 3, b = (it / nch / 4) % nb, dir = it / nch / 4 / nb;
        const int row0 = b * Ls + c * 128 + 2 * F.lane;
        const float lf0 = GATES[(size_t)row0 * 16 + dir * 8 + 4 + h], lf1 = GATES[(size_t)(row0 + 1) * 16 + dir * 8 + 4 + h];
        const float ig0 = GATES[(size_t)row0 * 16 + dir * 8 + h], ig1 = GATES[(size_t)(row0 + 1) * 16 + dir * 8 + h];
        float inc = lf0 + lf1;
#pragma unroll
        for (int o = 1; o < 64; o <<= 1) { const float t = __shfl_up(inc, o); if (F.lane >= o) inc += t; }
        const float tot = __shfl(inc, 63), exc = inc - (lf0 + lf1);
        float b0, b1;
        if (dir == 0) { b0 = exc + lf0; b1 = inc; } else { b0 = tot - exc; b1 = tot - exc - lf0; }
        GT[(size_t)(dir * 4 + h) * R + row0] = (f32x4){b0, ig0 - b0, __expf(b0), __expf(tot - b0 + ig0)};
        GT[(size_t)(dir * 4 + h) * R + row0 + 1] = (f32x4){b1, ig1 - b1, __expf(b1), __expf(tot - b1 + ig1)};
        if (F.lane == 0) GC[((size_t)(dir * 4 + gb0 + b) * 4 + h) * 66 + ctau0 + c] = __expf(tot);
    }
}

__device__ __forceinline__ void cum_block(Fr& F, const float* GATES, int grow0, int h, f32x4* GT0, f32x4* GT1, float* GC0, float* GC1, LAS float* tab) {
    if (F.wave < 2) {
        const int dir = F.wave, j0 = 2 * F.lane;
        const float* gp = GATES + (size_t)(grow0 + j0) * 16 + dir * 8 + h;
        const float ig0 = gp[0], lf0 = gp[4], ig1 = gp[16], lf1 = gp[20];
        float inc = lf0 + lf1;
#pragma unroll
        for (int o = 1; o < 64; o <<= 1) { const float t = __shfl_up(inc, o); if (F.lane >= o) inc += t; }
        const float tot = __shfl(inc, 63), exc = inc - (lf0 + lf1);
        float b0, b1;
        if (dir == 0) { b0 = exc + lf0; b1 = inc; } else { b0 = tot - exc; b1 = tot - exc - lf0; }
        const float w0 = __expf(tot - b0 + ig0), w1 = __expf(tot - b1 + ig1);
        f32x4* gt = (dir ? GT1 : GT0) + grow0 + j0;
        gt[0] = (f32x4){b0, ig0 - b0, __expf(b0), w0}; gt[1] = (f32x4){b1, ig1 - b1, __expf(b1), w1};
        LAS float* t = tab + dir * 384;
        t[j0] = b0; t[j0 + 1] = b1; t[128 + j0] = ig0 - b0; t[128 + j0 + 1] = ig1 - b1; t[256 + j0] = w0; t[256 + j0 + 1] = w1;
        if (F.lane == 0) *(dir ? GC1 : GC0) = __expf(tot);
    }
}
__device__ __forceinline__ void dn_block(Fr& F, const bf16* KTchunk, const LAS float* tab, float* DN0, float* DN1) {
    const LAS float* w0 = tab + 256; const LAS float* w1 = tab + 384 + 256;
    const bf16* kr = KTchunk + (size_t)(F.tid >> 4) * 4 * 512 + (F.tid & 15) * 8; float s0 = 0.f, s1 = 0.f;
#pragma unroll 4
    for (int q = 0; q < 16; ++q) { const int ks = q >> 2, q4 = q & 3; float v[8]; unpack8(*(const u32x4*)(kr + ks * 512 + q4 * 128), v);
#pragma unroll
        for (int e = 0; e < 8; ++e) { s0 += v[e] * w0[q * 8 + e]; s1 += v[e] * w1[q * 8 + e]; } }
    DN0[F.tid] = s0; DN1[F.tid] = s1;
}
__device__ __forceinline__ void ph_sphase(Fr& F, int hb, bool with_ctx) {
    const bf16* XC = (const bf16*)(F.ws + MS_XC); const bf16* KN = (const bf16*)(F.ws + MS_KN); const bf16* KT = (const bf16*)(F.ws + MS_KT);
    f32x4* GT = (f32x4*)(F.ws + WS_GT_L); float* DN = (float*)(F.ws + WS_DN); float* RS = (float*)(F.ws + WS_RS); float* GC = (float*)(F.ws + WS_GC);
    const float* GATES = (const float*)(F.ws + WS_GATES_L);
    bf16* S = (bf16*)(F.ws + MS_S);
    LAS float* tab = (LAS float*)(F.lds + 1024);
    const int fr = F.lane & 15, fq = F.lane >> 4, w = F.wave;
    for (int it = F.bid; it < 512; it += F.G) {
        const int c = it & 63, h = (it >> 6) & 3, bl = it >> 8, gb = 2 * hb + bl;
        const int row0 = bl * SEQ + c * 128;
        __syncthreads();
        cum_block(F, GATES, row0, h, GT + (size_t)(0 * 4 + h) * HROWS, GT + (size_t)(1 * 4 + h) * HROWS,
                  GC + ((size_t)(0 * 4 + gb) * 4 + h) * 66 + 2 + c, GC + ((size_t)(1 * 4 + gb) * 4 + h) * 66 + 2 + c, tab);
        __syncthreads();
        dn_block(F, KT + (size_t)(bl * 4 + h) * 512 * SEQ + (size_t)c * 65536, tab,
                 DN + (((size_t)(0 * 4 + gb) * 4 + h) * 66 + 2 + c) * 512, DN + (((size_t)(1 * 4 + gb) * 4 + h) * 66 + 2 + c) * 512);
        const int irow = row0 + 16 * w + fr;
        bf16x8 bq[16];
        { const bf16* p = XC + ((size_t)((row0 >> 4) + w) * 64 + h * 16) * 512 + F.lane * 8;
#pragma unroll
            for (int ks = 0; ks < 16; ++ks) bq[ks] = *(const bf16x8*)(p + ks * 512); }
        const float bif = tab[16 * w + fr], bib = tab[384 + 16 * w + fr];
        float rsf = 0.f, rsb = 0.f;
        bf16* sf = S + ((size_t)(0 * 8 + bl * 4 + h) * 64 + c) * 16384; bf16* sb = S + ((size_t)(1 * 8 + bl * 4 + h) * 64 + c) * 16384;
#pragma unroll 1
        for (int jt = 0; jt < 8; ++jt) {
            f32x4 acc = (f32x4){0.f, 0.f, 0.f, 0.f};
            const bf16* ap = KN + ((size_t)((row0 >> 4) + jt) * 64 + h * 16) * 512 + F.lane * 8;
#pragma unroll
            for (int ks = 0; ks < 16; ++ks) acc = __builtin_amdgcn_mfma_f32_16x16x32_bf16(*(const bf16x8*)(ap + ks * 512), bq[ks], acc, 0, 0, 0);
            float vf[4], vb[4];
            const f32x4 af4 = *(const LAS f32x4*)(tab + 128 + jt * 16 + 4 * fq), ab4 = *(const LAS f32x4*)(tab + 384 + 128 + jt * 16 + 4 * fq);
#pragma unroll
            for (int r = 0; r < 4; ++r) { const int j = jt * 16 + 4 * fq + r, i = 16 * w + fr;
                vf[r] = (j <= i) ? acc[r] * __expf(bif + af4[r]) : 0.f; vb[r] = (j >= i) ? acc[r] * __expf(bib + ab4[r]) : 0.f;
                rsf += vf[r]; rsb += vb[r]; }
            const size_t so = (size_t)(w * 4 + (jt >> 1)) * 512 + (fr + 16 * ((jt & 1) * 2 + (fq >> 1))) * 8 + (fq & 1) * 4;
            *(u32x2*)(sf + so) = (u32x2){pk2(vf[0], vf[1]), pk2(vf[2], vf[3])};
            *(u32x2*)(sb + so) = (u32x2){pk2(vb[0], vb[1]), pk2(vb[2], vb[3])};
        }
        rsf += __shfl_xor(rsf, 16); rsf += __shfl_xor(rsf, 32); rsb += __shfl_xor(rsb, 16); rsb += __shfl_xor(rsb, 32);
        if (fq == 0) { RS[(size_t)(0 * 4 + h) * HROWS + irow] = rsf; RS[(size_t)(1 * 4 + h) * HROWS + irow] = rsb; }
    }
    if (with_ctx) {
        const bf16* KTC2 = (const bf16*)(F.ws + MS_KTC); f32x4* GTC = (f32x4*)(F.ws + WS_GT_C); const float* GATESC = (const float*)(F.ws + WS_GATES_C);
        for (int it = F.bid; it < 32; it += F.G) {
            const int cc = it & 1, h = (it >> 1) & 3, gb = it >> 3;
            __syncthreads();
            cum_block(F, GATESC, gb * CTXL + cc * 128, h, GTC + (size_t)(0 * 4 + h) * MC, GTC + (size_t)(1 * 4 + h) * MC,
                      GC + ((size_t)(0 * 4 + gb) * 4 + h) * 66 + cc, GC + ((size_t)(1 * 4 + gb) * 4 + h) * 66 + cc, tab);
            __syncthreads();
            dn_block(F, KTC2 + (size_t)(gb * 4 + h) * 512 * CTXL + (size_t)cc * 65536, tab,
                     DN + (((size_t)(0 * 4 + gb) * 4 + h) * 66 + cc) * 512, DN + (((size_t)(1 * 4 + gb) * 4 + h) * 66 + cc) * 512);
        }
    }
}

__device__ __forceinline__ bf16x8 ldg16(const char* ub, unsigned off) { return *(const bf16x8*)(ub + off); }
__device__ __forceinline__ void ph_scan(Fr& F, int hb) {
    const char* XC = (const char*)(F.ws + MS_XC); const char* KT = (const char*)(F.ws + MS_KT); const char* VT = (const char*)(F.ws + MS_VT);
    const char* KTC2 = (const char*)(F.ws + MS_KTC); const char* VTC2 = (const char*)(F.ws + MS_VTC);
    const char* S = (const char*)(F.ws + MS_S);
    const f32x4* GTL = (const f32x4*)(F.ws + WS_GT_L); const f32x4* GTC = (const f32x4*)(F.ws + WS_GT_C);
    const float* GC = (const float*)(F.ws + WS_GC); const float* DN = (const float*)(F.ws + WS_DN);
    float* NC = (float*)(F.ws + WS_NC);
    LAS unsigned char* cbf = F.lds;
    LAS float* wl = (LAS float*)(F.lds + 2 * 33280);
    LAS unsigned char* vtb = F.lds + 2 * 33280 + 1024;
    const int w = F.wave;
    for (int wi = F.bid; wi < 256; wi += F.G) {
        const int chain = wi & 15, slice = wi >> 4, dir = chain >> 3, bl = (chain >> 2) & 1, h = chain & 3, gb = 2 * hb + bl, e0 = slice * 32;
        char* NUM = (char*)(F.ws + (dir ? MS_NB : MS_NF));
        const bool nwriter = (slice == 0) && (w == 0);
        f32x4 acc[4][2];
#pragma unroll
        for (int a = 0; a < 4; ++a)
#pragma unroll
            for (int b = 0; b < 2; ++b) acc[a][b] = (f32x4){0.f, 0.f, 0.f, 0.f};
        float nreg[8];
#pragma unroll
        for (int e = 0; e < 8; ++e) nreg[e] = 0.f;
        const char* ktc = KTC2 + (size_t)(gb * 4 + h) * 512 * CTXL * 2; const char* vtc = VTC2 + (size_t)(gb * 4 + h) * 512 * CTXL * 2;
        const char* ktl = KT + (size_t)(bl * 4 + h) * 512 * SEQ * 2;    const char* vtl = VT + (size_t)(bl * 4 + h) * 512 * SEQ * 2;
        const f32x4* gtc = GTC + (size_t)(dir * 4 + h) * MC + gb * CTXL; const f32x4* gtl = GTL + (size_t)(dir * 4 + h) * HROWS + bl * SEQ;
        const float* gcb = GC + ((size_t)(dir * 4 + gb) * 4 + h) * 66; const float* dnb = DN + ((size_t)(dir * 4 + gb) * 4 + h) * 66 * 512;
#pragma unroll 1
        for (int s = 0; s < 2; ++s) {
            const int cc = dir == 0 ? s : 1 - s; const unsigned l16 = F.lane * 16u, fq = F.lane >> 4;
            __syncthreads();
            if (F.tid < 128) wl[F.tid] = gtc[cc * 128 + F.tid][3];
            __syncthreads();
            const float Gd = gcb[cc]; const char* ktu = ktc + (size_t)cc * 131072; const char* vtu = vtc + (size_t)cc * 131072 + (e0 >> 4) * 4096;
#pragma unroll
            for (int a = 0; a < 4; ++a)
#pragma unroll
                for (int b = 0; b < 2; ++b) acc[a][b] = acc[a][b] * Gd;
#pragma unroll
            for (int ks = 0; ks < 4; ++ks) {
                bf16x8 bv[2];
#pragma unroll
                for (int et = 0; et < 2; ++et) { float v[8]; unpack8(__builtin_bit_cast(u32x4, ldg16(vtu + et * 4096 + ks * 1024, l16)), v);
#pragma unroll
                    for (int e = 0; e < 8; ++e) v[e] *= wl[ks * 32 + 8 * fq + e];
                    const u32x4 pv = pack8(v); bv[et] = __builtin_bit_cast(bf16x8, pv); }
#pragma unroll
                for (int dt = 0; dt < 4; ++dt) { const bf16x8 kk = ldg16(ktu + (4 * w + dt) * 4096 + ks * 1024, l16);
#pragma unroll
                    for (int et = 0; et < 2; ++et) acc[dt][et] = __builtin_amdgcn_mfma_f32_16x16x32_bf16(kk, bv[et], acc[dt][et], 0, 0, 0); }
            }
            { const unsigned lo = F.lane * 32u; const f32x4 d0 = *(const f32x4*)((const char*)(dnb + cc * 512) + lo), d1 = *(const f32x4*)((const char*)(dnb + cc * 512) + lo + 16u);
                nreg[0] = Gd * nreg[0] + d0[0]; nreg[1] = Gd * nreg[1] + d0[1]; nreg[2] = Gd * nreg[2] + d0[2]; nreg[3] = Gd * nreg[3] + d0[3];
                nreg[4] = Gd * nreg[4] + d1[0]; nreg[5] = Gd * nreg[5] + d1[1]; nreg[6] = Gd * nreg[6] + d1[2]; nreg[7] = Gd * nreg[7] + d1[3]; }
        }
        const int cfirst = dir == 0 ? 0 : 63;
        bf16x8 xf[16];
        __syncthreads();
        { const int fr = F.lane & 15, fq = F.lane >> 4; const unsigned l16 = F.lane * 16u;
#pragma unroll
            for (int dt = 0; dt < 4; ++dt)
#pragma unroll
                for (int et = 0; et < 2; ++et) *(LAS u32x2*)(cbf + (16 * et + fr) * 1040 + (64 * w + 16 * dt + 4 * fq) * 2) = (u32x2){pk2(acc[dt][et][0], acc[dt][et][1]), pk2(acc[dt][et][2], acc[dt][et][3])};
            if (F.tid < 128) wl[F.tid] = gtl[cfirst * 128 + F.tid][3];
            *(LAS bf16x8*)(vtb + w * 1024 + l16) = ldg16(vtl + (size_t)cfirst * 131072 + (e0 >> 4) * 4096 + w * 1024, l16);
            const char* xc0 = XC + ((size_t)(((bl * SEQ + cfirst * 128) >> 4) + w) * 64 + h * 16) * 1024;
#pragma unroll
            for (int ks = 0; ks < 16; ++ks) xf[ks] = ldg16(xc0 + ks * 1024, l16); }
        __syncthreads();
#pragma unroll 1
        for (int q = 0; q < 64; ++q) {
            int tid_ = F.tid; asm volatile("" : "+v"(tid_));
            const int lane_ = tid_ & 63, fr = lane_ & 15, fq = lane_ >> 4; const unsigned l16 = lane_ * 16u;
            const int c = dir == 0 ? q : 63 - q;
            const int qn = q < 63 ? q + 1 : 63, cn = dir == 0 ? qn : 63 - qn;
            const int qp = q < 62 ? q + 2 : 63, cp = dir == 0 ? qp : 63 - qp;
            const char* ktu = ktl + (size_t)c * 131072;
            const int row0 = bl * SEQ + c * 128;
            const float Gd = gcb[2 + c];
            LAS unsigned char* cb_rd = cbf + (q & 1) * 33280; LAS unsigned char* cb_wr = cbf + ((q + 1) & 1) * 33280;
            const LAS float* wl_rd = wl + (q & 1) * 128; LAS float* wl_wr = wl + ((q + 1) & 1) * 128;
            const LAS unsigned char* vt_rd = vtb + (q & 1) * 8192; LAS unsigned char* vt_wr = vtb + ((q + 1) & 1) * 8192;
            const bf16x8 vnext = ldg16(vtl + (size_t)cn * 131072 + (e0 >> 4) * 4096 + w * 1024, l16);
            const float wnext = *(const float*)((const char*)(gtl + cn * 128) + (unsigned)(tid_ & 127) * 16u + 12u);
            const float Ei = *(const float*)((const char*)(gtl + c * 128 + 16 * w) + (unsigned)fr * 16u + 8u);
            const f32x4 dn0 = *(const f32x4*)((const char*)(dnb + (2 + c) * 512) + lane_ * 32u), dn1 = *(const f32x4*)((const char*)(dnb + (2 + c) * 512) + lane_ * 32u + 16u);
            bf16x8 kf[4][4], vf[2][4], sfr[4];
            { const char* su = S + ((size_t)(dir * 8 + bl * 4 + h) * 64 + c) * 32768 + w * 4096;
#pragma unroll
                for (int ks = 0; ks < 4; ++ks) sfr[ks] = ldg16(su + ks * 1024, l16); }
#pragma unroll
            for (int dt = 0; dt < 4; ++dt) kf[0][dt] = ldg16(ktu + (4 * w + dt) * 4096, l16);
            unsigned pf;
            {
                const char* kt3 = ktl + (size_t)cp * 131072; const char* vt3 = vtl + (size_t)cp * 131072;
                const char* xc3 = XC + ((size_t)((bl * SEQ + cp * 128) >> 4) * 64 + h * 16) * 1024; const char* s3p = S + ((size_t)(dir * 8 + bl * 4 + h) * 64 + cp) * 32768;
                const unsigned t = tid_ < 208 ? tid_ : tid_ - 208; const bool g0 = t < 64, g1 = t < 128, g2 = t < 192;
                const unsigned ln2 = slice * 64 + (t - 128);
                const char* ub = g0 ? kt3 : (g1 ? vt3 : (g2 ? xc3 : s3p));
                const unsigned off = g0 ? (slice * 64 + t) * 128u : (g1 ? (e0 >> 4) * 4096u + (t - 64) * 128u : (g2 ? (ln2 >> 7) * 65536u + (ln2 & 127) * 128u : (slice * 16 + ((t - 192) & 15)) * 128u));
                pf = *(const volatile unsigned*)(ub + off);
            }
#pragma unroll
            for (int et = 0; et < 2; ++et)
#pragma unroll
                for (int ks = 0; ks < 4; ++ks) vf[et][ks] = *(const LAS bf16x8*)(vt_rd + (et * 4 + ks) * 1024 + l16);
            if (nwriter) { char* np = (char*)(NC + (((size_t)(dir * 2 + bl) * 4 + h) * 64 + c) * 512); const unsigned lo = lane_ * 32u;
                *(f32x4*)(np + lo) = (f32x4){nreg[0], nreg[1], nreg[2], nreg[3]}; *(f32x4*)(np + lo + 16u) = (f32x4){nreg[4], nreg[5], nreg[6], nreg[7]}; }
            f32x4 a2[2] = {(f32x4){0.f, 0.f, 0.f, 0.f}, (f32x4){0.f, 0.f, 0.f, 0.f}};
#pragma unroll
            for (int ks = 0; ks < 16; ++ks)
#pragma unroll
                for (int et = 0; et < 2; ++et) a2[et] = __builtin_amdgcn_mfma_f32_16x16x32_bf16(*(const LAS bf16x8*)(cb_rd + (16 * et + fr) * 1040 + ks * 64 + fq * 16), xf[ks], a2[et], 0, 0, 0);
            asm volatile("" ::: "memory");
#pragma unroll
            for (int ks = 1; ks < 4; ++ks)
#pragma unroll
                for (int dt = 0; dt < 4; ++dt) kf[ks][dt] = ldg16(ktu + (4 * w + dt) * 4096 + ks * 1024, l16);
            a2[0] = a2[0] * Ei; a2[1] = a2[1] * Ei;
#pragma unroll
            for (int ks = 0; ks < 4; ++ks)
#pragma unroll
                for (int et = 0; et < 2; ++et) a2[et] = __builtin_amdgcn_mfma_f32_16x16x32_bf16(vf[et][ks], sfr[ks], a2[et], 0, 0, 0);
            { char* nu = NUM + ((size_t)row0 * MI + h * 512 + e0) * 2; const unsigned ln = ((16u * w + fr) * MI + 4u * fq) * 2u;
#pragma unroll
                for (int et = 0; et < 2; ++et) *(u32x2*)(nu + et * 32 + ln) = (u32x2){pk2(a2[et][0], a2[et][1]), pk2(a2[et][2], a2[et][3])}; }
#pragma unroll
            for (int a = 0; a < 4; ++a)
#pragma unroll
                for (int b = 0; b < 2; ++b) acc[a][b] = acc[a][b] * Gd;
#pragma unroll
            for (int ks = 0; ks < 4; ++ks) {
                bf16x8 bv[2];
#pragma unroll
                for (int et = 0; et < 2; ++et) { float v[8]; unpack8(__builtin_bit_cast(u32x4, vf[et][ks]), v);
                    const f32x4 wa = *(const LAS f32x4*)(wl_rd + ks * 32 + 8 * fq), wb = *(const LAS f32x4*)(wl_rd + ks * 32 + 8 * fq + 4);
                    v[0] *= wa[0]; v[1] *= wa[1]; v[2] *= wa[2]; v[3] *= wa[3]; v[4] *= wb[0]; v[5] *= wb[1]; v[6] *= wb[2]; v[7] *= wb[3];
                    const u32x4 pv = pack8(v); bv[et] = __builtin_bit_cast(bf16x8, pv); }
#pragma unroll
                for (int dt = 0; dt < 4; ++dt)
#pragma unroll
                    for (int et = 0; et < 2; ++et) acc[dt][et] = __builtin_amdgcn_mfma_f32_16x16x32_bf16(kf[ks][dt], bv[et], acc[dt][et], 0, 0, 0);
            }
            asm volatile("" ::: "memory");
            { const char* xc2 = XC + ((size_t)(((bl * SEQ + cn * 128) >> 4) + w) * 64 + h * 16) * 1024;
#pragma unroll
                for (int ks = 0; ks < 16; ++ks) xf[ks] = ldg16(xc2 + ks * 1024, l16); }
            nreg[0] = Gd * nreg[0] + dn0[0]; nreg[1] = Gd * nreg[1] + dn0[1]; nreg[2] = Gd * nreg[2] + dn0[2]; nreg[3] = Gd * nreg[3] + dn0[3];
            nreg[4] = Gd * nreg[4] + dn1[0]; nreg[5] = Gd * nreg[5] + dn1[1]; nreg[6] = Gd * nreg[6] + dn1[2]; nreg[7] = Gd * nreg[7] + dn1[3];
            *(LAS bf16x8*)(vt_wr + w * 1024 + l16) = vnext;
            wl_wr[tid_ & 127] = wnext;
#pragma unroll
            for (int dt = 0; dt < 4; ++dt)
#pragma unroll
                for (int et = 0; et < 2; ++et) *(LAS u32x2*)(cb_wr + (16 * et + fr) * 1040 + (64 * w + 16 * dt + 4 * fq) * 2) = (u32x2){pk2(acc[dt][et][0], acc[dt][et][1]), pk2(acc[dt][et][2], acc[dt][et][3])};
            asm volatile("" :: "v"(pf));
            __syncthreads();
        }
    }
}

__device__ __forceinline__ void ph_mout(Fr& F) {
    bf16* NF = (bf16*)(F.ws + MS_NF); const bf16* NBk = (const bf16*)(F.ws + MS_NB); const bf16* XC = (const bf16*)(F.ws + MS_XC); const bf16* Z = (const bf16*)(F.ws + MS_Z);
    const float* NC = (const float*)(F.ws + WS_NC); const float* RS = (const float*)(F.ws + WS_RS); const f32x4* GTL = (const f32x4*)(F.ws + WS_GT_L);
    LAS unsigned char* xt = F.lds + F.wave * 16640;
    for (int it = F.gw; it < (HROWS / 16) * 4; it += F.ngw) {
        const int rt = it >> 2, h = it & 3, bl = rt >> 9, c = (rt >> 3) & 63;
        { const bf16* xp = XC + ((size_t)rt * 64 + h * 16) * 512 + F.lane * 8; u32x4 t[16];
#pragma unroll
            for (int ks = 0; ks < 16; ++ks) t[ks] = *(const u32x4*)(xp + ks * 512);
#pragma unroll
            for (int ks = 0; ks < 16; ++ks) *(LAS u32x4*)(xt + ks * 1040 + F.lane * 16) = t[ks]; }
        const float* n0 = NC + (((size_t)(0 * 2 + bl) * 4 + h) * 64 + c) * 512 + 8 * F.lane; const float* n1 = NC + (((size_t)(1 * 2 + bl) * 4 + h) * 64 + c) * 512 + 8 * F.lane;
        const f32x4 n00 = *(const f32x4*)n0, n01 = *(const f32x4*)(n0 + 4), n10 = *(const f32x4*)n1, n11 = *(const f32x4*)(n1 + 4);
        float nw[8], sk[8];
        { const float* pw = IN(I_MNW) + h * 512 + 8 * F.lane; const float* ps = IN(I_MSKIP) + h * 512 + 8 * F.lane;
#pragma unroll
            for (int e = 0; e < 8; ++e) { nw[e] = pw[e]; sk[e] = ps[e]; } }
#pragma unroll 2
        for (int r = 0; r < 16; ++r) {
            const int row = rt * 16 + r; const size_t o = (size_t)row * MI + h * 512 + 8 * F.lane;
            float nf[8], nb[8], xc[8], z[8];
            unpack8(*(const u32x4*)(NF + o), nf); unpack8(*(const u32x4*)(NBk + o), nb); unpack8(*(const u32x4*)(Z + o), z);
            unpack8(*(const LAS u32x4*)(xt + (F.lane >> 2) * 1040 + (r + 16 * (F.lane & 3)) * 16), xc);
            float d0 = xc[0] * n00[0] + xc[1] * n00[1] + xc[2] * n00[2] + xc[3] * n00[3] + xc[4] * n01[0] + xc[5] * n01[1] + xc[6] * n01[2] + xc[7] * n01[3];
            float d1 = xc[0] * n10[0] + xc[1] * n10[1] + xc[2] * n10[2] + xc[3] * n10[3] + xc[4] * n11[0] + xc[5] * n11[1] + xc[6] * n11[2] + xc[7] * n11[3];
            d0 = wave_sum(d0); d1 = wave_sum(d1);
            const float den0 = GTL[(size_t)(0 * 4 + h) * HROWS + row][2] * d0 + RS[(size_t)(0 * 4 + h) * HROWS + row], den1 = GTL[(size_t)(1 * 4 + h) * HROWS + row][2] * d1 + RS[(size_t)(1 * 4 + h) * HROWS + row];
            const float i0 = 1.0f / fmaxf(fabsf(den0), 1.0f), i1 = 1.0f / fmaxf(fabsf(den1), 1.0f);
            float s = 0.f;
#pragma unroll
            for (int e = 0; e < 8; ++e) { nf[e] = nf[e] * i0 + nb[e] * i1; s += nf[e]; }
            const float mu = wave_sum(s) * (1.0f / 512.0f); float q = 0.f;
#pragma unroll
            for (int e = 0; e < 8; ++e) { nf[e] -= mu; q += nf[e] * nf[e]; }
            const float rstd = 1.0f / sqrtf(wave_sum(q) * (1.0f / 512.0f) + ML_NORM_EPS);
#pragma unroll
            for (int e = 0; e < 8; ++e) nf[e] = (nf[e] * rstd * nw[e] + sk[e] * xc[e]) * silu_f(z[e]);
            *(u32x4*)(NF + o) = pack8(nf);
        }
    }
}

__device__ __forceinline__ void ph_final(Fr& F, const bf16* dl) {
    const float* g = IN(I_FINALG);
    for (int r = F.gw; r < ML; r += 2 * F.ngw) {
        const int r2 = r + F.ngw < ML ? r + F.ngw : r;
        f32x4* xa = (f32x4*)(F.out + (size_t)r * 1024) + F.lane; f32x4* xb = (f32x4*)(F.out + (size_t)r2 * 1024) + F.lane; f32x4 va[4], vb[4]; float sa = 0.f, sb = 0.f;
        const u32x2* da = (const u32x2*)(dl + (size_t)r * 1024) + F.lane; const u32x2* db = (const u32x2*)(dl + (size_t)r2 * 1024) + F.lane;
#pragma unroll
        for (int j = 0; j < 4; ++j) { const u32x2 a = da[64 * j], b = db[64 * j];
            va[j] = xa[64 * j] + (f32x4){bflo(a.x), bfhi(a.x), bflo(a.y), bfhi(a.y)}; vb[j] = xb[64 * j] + (f32x4){bflo(b.x), bfhi(b.x), bflo(b.y), bfhi(b.y)}; }
#pragma unroll
        for (int j = 0; j < 4; ++j) { sa += (va[j][0] * va[j][0] + va[j][1] * va[j][1]) + (va[j][2] * va[j][2] + va[j][3] * va[j][3]); sb += (vb[j][0] * vb[j][0] + vb[j][1] * vb[j][1]) + (vb[j][2] * vb[j][2] + vb[j][3] * vb[j][3]); }
        const float ra = __builtin_amdgcn_rsqf(wave_sum(sa) * (1.0f / 1024.0f) + EPS), rb = __builtin_amdgcn_rsqf(wave_sum(sb) * (1.0f / 1024.0f) + EPS);
#pragma unroll
        for (int j = 0; j < 4; ++j) { const f32x4 gg = *(const f32x4*)(g + 4 * F.lane + 256 * j); xa[64 * j] = va[j] * ra * gg; if (r2 != r) xb[64 * j] = vb[j] * rb * gg; }
    }
}

template <class Epi>
__device__ __forceinline__ void run_gemm(Fr& F, const bf16* A, const bf16* Bt, int M, int N, int K, const Epi& E) {
    pg8::Gemm g{A, Bt, M, N, K}; pg8::StaticOrder S; S.init(M, N, F.G, F.bid);
    pg8::gemm_phase<Epi, pg8::StaticOrder, true, true>(F.lds, g, S, E, F.tid);
}

struct Args { const float* in[38]; float* out; unsigned char* ws; int ph_lo, ph_hi; };
static_assert(sizeof(Args) == 328 && offsetof(Args, out) == 304 && offsetof(Args, ws) == 312 && offsetof(Args, ph_lo) == 320, "Args layout");
constexpr int N_PHASES = 34;


#define XB_TMO      128
#define XB_XCNT(j)  (256  + 64 * (j))
#define XB_XSUB(j)  (1280 + 64 * (j))
#define XB_XGEN(j)  (2304 + 64 * (j))
#define XB_TOP      3328
#define XB_TOPGEN   3392
#define XCD_BAR_WORDS 3456
#define XB_SPIN_CAP (1u << 22)
__device__ __forceinline__ unsigned xb_ld(unsigned* p)              { return __hip_atomic_load(p, __ATOMIC_RELAXED, __HIP_MEMORY_SCOPE_AGENT); }
__device__ __forceinline__ unsigned xb_add(unsigned* p, unsigned v) { return __hip_atomic_fetch_add(p, v, __ATOMIC_RELAXED, __HIP_MEMORY_SCOPE_AGENT); }
__device__ __forceinline__ unsigned xb_xcc_id() { return (unsigned)__builtin_amdgcn_s_getreg((3 << 11) | 20) & 0xFu; }
#define XB_SPIN(cond, bar) do { unsigned _sp = 0; while (cond) { __builtin_amdgcn_s_sleep(1); \
    if ((++_sp & 255u) == 0u) { if (xb_ld(&(bar)[XB_TMO])) break; if (_sp > XB_SPIN_CAP) { atomicAdd(&(bar)[XB_TMO], 1u); break; } } } } while (0)
__device__ __forceinline__ void xcd_barrier_complete(unsigned* bar, unsigned x, unsigned& nloc, unsigned& nx) {
    const unsigned G = gridDim.x * gridDim.y * gridDim.z;
    unsigned sum, cnt, mine, sp = 0u;
    for (;;) {
        sum = 0u; cnt = 0u; mine = 0u;
#pragma unroll
        for (unsigned j = 0; j < 16; ++j) { const unsigned c = xb_ld(&bar[XB_XCNT(j)]); sum += c; cnt += (c > 0u) ? 1u : 0u; mine = (j == x) ? c : mine; }
        if (sum == G) break;
        __builtin_amdgcn_s_sleep(1);
        if ((++sp & 255u) == 0u) { if (xb_ld(&bar[XB_TMO])) break; if (sp > XB_SPIN_CAP) { atomicAdd(&bar[XB_TMO], 1u); break; } }
    }
    nloc = mine > 0u ? mine : 1u; nx = cnt > 0u ? cnt : 1u;
}
__device__ __forceinline__ void xcd_barrier(unsigned* bar, volatile LAS unsigned* st) {
    asm volatile("s_waitcnt vmcnt(0)" ::: "memory");
    __syncthreads();
    if (threadIdx.x == 0) {
        const unsigned x = xb_xcc_id();
        __builtin_amdgcn_s_waitcnt(0);
        unsigned nloc = st[0], nx = st[1];
        if (nloc == 0u) { xcd_barrier_complete(bar, x, nloc, nx); st[0] = nloc; st[1] = nx; }
        const unsigned old = xb_add(&bar[XB_XSUB(x)], 1u);
        const unsigned gen = old / nloc;
        if (old + 1u == (gen + 1u) * nloc) {
            __builtin_amdgcn_fence(__ATOMIC_RELEASE, "agent");
            asm volatile("s_waitcnt vmcnt(0)" ::: "memory");
            const unsigned og = xb_add(&bar[XB_TOP], 1u);
            const unsigned tg = og / nx;
            if (og + 1u == (tg + 1u) * nx) xb_add(&bar[XB_TOPGEN], 1u);
            else XB_SPIN(xb_ld(&bar[XB_TOPGEN]) == tg, bar);
            __builtin_amdgcn_fence(__ATOMIC_ACQUIRE, "agent");
            xb_add(&bar[XB_XGEN(x)], 1u);
            asm volatile("s_waitcnt vmcnt(0)" ::: "memory");
        } else {
            XB_SPIN(xb_ld(&bar[XB_XGEN(x)]) == gen, bar);
            __builtin_amdgcn_fence(__ATOMIC_ACQUIRE, "agent");
            asm volatile("s_waitcnt vmcnt(0)" ::: "memory");
        }
    }
    __syncthreads();
}
#ifndef PROBE_MASK
#define PROBE_MASK 0ull
#endif
constexpr int BAR_LDS_OFF = LDS_BYTES - 64;
constexpr size_t WS_BAR = 0;
constexpr size_t WS_TS = 64 * 1024;

template <int ph>
__device__ __forceinline__ void run_phase(Fr& F) {
    unsigned char* ws = F.ws;
    float* mod = (float*)(ws + WS_MOD); float* ctxx = (float*)(ws + WS_CTXX);
    if constexpr (ph == 0) ph_prologue(F);
    else if constexpr (ph == 1) ph_modnorm(F, IN(I_X), ML, 0, IN(I_CTX), MC, IN(I_NORMG), mod, 0, (bf16*)(ws + HY_H));
    else if constexpr (ph == 2) { pg8::EpiBf16 E{(bf16*)(ws + HY_P), 3072, IN(I_HBIN), 0, 0}; run_gemm(F, (const bf16*)(ws + HY_H), (const bf16*)(ws + WS_WHIN), MALL, 3072, 1024, E);
                                  { constexpr int nun = (MALL / 256) * (3072 / 256); const int busy = nun % F.G; const bool all = busy == 0; const int vb = all ? F.bid : F.bid - busy, nvb = all ? F.G : F.G - busy;
                                    if (all || F.bid >= busy) {
                                        kt_items(F, (const float*)(ws + WS_H3), SEQ, (float*)(ws + HY_KT), vb * NWAVES + F.wave, nvb * NWAVES);
                                        kt_items(F, (const float*)(ws + WS_H3) + (size_t)SEQ * 64, CTXL, (float*)(ws + WS_KTC), vb * NWAVES + F.wave, nvb * NWAVES);
                                        transpose_group(F, 1, vb, nvb); } } }
    else if constexpr (ph == 3) { zt_items(F, (const bf16*)(ws + HY_P), 0, NB, SEQ, (bf16*)(ws + HY_ZT)); zt_items(F, (const bf16*)(ws + HY_P), ML, NB, CTXL, (bf16*)(ws + HY_ZTC)); }
    else if constexpr (ph == 4) ph_fftconv(F);
    else if constexpr (ph == 5) { u2_items(F, (const bf16*)(ws + HY_P), 0, NB, SEQ, (const bf16*)(ws + HY_ZT), (bf16*)(ws + HY_H)); u2_items(F, (const bf16*)(ws + HY_P), ML, NB, CTXL, (const bf16*)(ws + HY_ZTC), (bf16*)(ws + HY_H)); }
    else if constexpr (ph == 6) { pg8::EpiDelta E{(bf16*)(ws + HY_P), ML, mod + 2048, 0, IN(I_HBOUT)}; run_gemm(F, (const bf16*)(ws + HY_H), (const bf16*)(ws + WS_WHOUT), MALL, 1024, 1024, E);
                                  transpose_in_tail(F, 2, (MALL / 256) * (1024 / 256)); }
    else if constexpr (ph == 7) ph_modnorm(F, IN(I_X), ML, 0, IN(I_CTX), MC, IN(I_NORMG) + 1024, mod, 3072, (bf16*)(ws + FF_H), (const bf16*)(ws + HY_P), F.out, ctxx);
    else if constexpr (ph == 8) { pg8::EpiBf16 E{(bf16*)(ws + FF_A), FF, nullptr, FF, (FF_G - FF_A) / 2}; run_gemm(F, (const bf16*)(ws + FF_H), (const bf16*)(ws + WS_WUP0), MALL, 2 * FF, 1024, E);
                                  { constexpr int nun = (MALL / 256) * (2 * FF / 256); const int busy = nun % F.G;
                                    if (busy == 0) mod_layer(F, 1, F.bid, F.G); else if (F.bid >= busy) mod_layer(F, 1, F.bid - busy, F.G - busy); } }
    else if constexpr (ph == 9) ph_dwconv(F, 0, ML, MC);
    else if constexpr (ph == 10) { pg8::EpiDelta E{(bf16*)(ws + FF_H), ML, mod + 5120, 0, nullptr}; run_gemm(F, (const bf16*)(ws + FF_A), (const bf16*)(ws + WS_WDN0), MALL, 1024, FF, E); }
    else if constexpr (ph < 29) {
            constexpr int hb = (ph - 11) / 9, k = (ph - 11) % 9; const float* mod1 = mod + 5 * 6144;
            float* xh = F.out + (size_t)hb * HROWS * 1024;
            if constexpr (k == 0) {
                if constexpr (hb == 0) {
                    const bf16* dl = (const bf16*)(ws + FF_H);
                    add_delta_rows(F, F.out, dl, HROWS, HROWS);
                    ph_modnorm(F, xh, 0, 0, ctxx, MC, IN(I_NORMG) + 2048, mod1, 0, (bf16*)(ws + MS_HC), dl + (size_t)ML * 1024, xh, ctxx);
                    ph_modnorm(F, xh, HROWS, 0, ctxx, 0, IN(I_NORMG) + 2048, mod1, 0, (bf16*)(ws + MS_H), dl, xh, ctxx);
                } else ph_modnorm(F, xh, HROWS, 2 * hb, ctxx, 0, IN(I_NORMG) + 2048, mod1, 0, (bf16*)(ws + MS_H)); }
            else if constexpr (k == 1) { { pg8::EpiBf16T E{(bf16*)(ws + MS_XM), MI / 32}; run_gemm(F, (const bf16*)(ws + MS_H), (const bf16*)(ws + WS_WMIN), HROWS, MI, 1024, E); }
                               if (hb == 0) { pg8::EpiBf16T E{(bf16*)(ws + MS_XMC), MI / 32}; run_gemm(F, (const bf16*)(ws + MS_HC), (const bf16*)(ws + WS_WMIN), MC, MI, 1024, E); } }
            else if constexpr (k == 2) { prep_items(F, (const bf16*)(ws + MS_XM), 2, SEQ, (bf16*)(ws + MS_XC), (bf16*)(ws + MS_KN), (bf16*)(ws + MS_KT), (bf16*)(ws + MS_VT));
                               if (hb == 0) prep_items(F, (const bf16*)(ws + MS_XMC), NB, CTXL, (bf16*)(ws + MS_XCC), (bf16*)(ws + MS_XCC + 16 * MiB), (bf16*)(ws + MS_KTC), (bf16*)(ws + MS_VTC)); }
            else if constexpr (k == 3) { gate_items(F, (const bf16*)(ws + MS_XC), (const bf16*)(ws + MS_XM), HROWS, (float*)(ws + WS_GATES_L));
                               if (hb == 0) gate_items(F, (const bf16*)(ws + MS_XCC), (const bf16*)(ws + MS_XMC), MC, (float*)(ws + WS_GATES_C)); }
            else if constexpr (k == 4) ph_sphase(F, hb, hb == 0);
            else if constexpr (k == 5) ph_scan(F, hb);
            else if constexpr (k == 6) { pg8::EpiBf16 E{(bf16*)(ws + MS_Z), MI, nullptr, 0, 0}; run_gemm(F, (const bf16*)(ws + MS_H), (const bf16*)(ws + WS_WMIN) + (size_t)MI * 1024, HROWS, MI, 1024, E); }
            else if constexpr (k == 7) ph_mout(F);
            else { pg8::EpiRes E{xh, xh, ctxx, ctxx, HROWS, mod1 + 2048, 2 * hb, nullptr}; run_gemm(F, (const bf16*)(ws + MS_NF), (const bf16*)(ws + WS_WMDN), HROWS, 1024, MI, E); }
        }
    else if constexpr (ph == 29) ph_modnorm(F, F.out, ML, 0, ctxx, 0, IN(I_NORMG) + 3072, mod + 5 * 6144, 3072, (bf16*)(ws + FF_H));
    else if constexpr (ph == 30) { pg8::EpiBf16 E{(bf16*)(ws + FF_A), FF, nullptr, FF, (FF_G - FF_A) / 2}; run_gemm(F, (const bf16*)(ws + FF_H), (const bf16*)(ws + WS_WUP1), ML, 2 * FF, 1024, E); }
    else if constexpr (ph == 31) ph_dwconv(F, 1, ML, 0);
    else if constexpr (ph == 32) { pg8::EpiDelta E{(bf16*)(ws + FF_H), ML, mod + 5 * 6144 + 5120, 0, nullptr}; run_gemm(F, (const bf16*)(ws + FF_A), (const bf16*)(ws + WS_WDN1), ML, 1024, FF, E); }
    else ph_final(F, (const bf16*)(ws + FF_H));
}

template <int ph>
__device__ __forceinline__ void phase_step(int ph_lo, int ph_hi, unsigned char* lds_raw) {
    if (ph_lo <= ph && ph < ph_hi) {
        const __attribute__((address_space(4))) unsigned char* kp = (const __attribute__((address_space(4))) unsigned char*)__builtin_amdgcn_kernarg_segment_ptr();
        asm volatile("" : "+s"(kp));
        Fr F;
        { int t_ = threadIdx.x, g_ = gridDim.x, b_ = blockIdx.x; asm volatile("" : "+v"(t_), "+s"(g_), "+s"(b_)); F.tid = t_; F.G = g_; F.bid = b_; }
        F.lds = (LAS unsigned char*)lds_raw; F.lane = F.tid & 63; F.wave = __builtin_amdgcn_readfirstlane(F.tid >> 6);
        F.gw = F.bid * NWAVES + F.wave; F.ngw = F.G * NWAVES;
        F.in = (const __attribute__((address_space(4))) cfptr_t*)kp;
        typedef float* fptr_t; typedef unsigned char* ucptr_t;
        F.out = *(const __attribute__((address_space(4))) fptr_t*)(kp + 304); F.ws = *(const __attribute__((address_space(4))) ucptr_t*)(kp + 312);
        if (PROBE_MASK != 0ull && F.bid == 0 && F.tid == 0) ((unsigned long long*)(F.ws + WS_TS))[ph] = __builtin_amdgcn_s_memrealtime();
        run_phase<ph>(F);
        if (ph + 1 < ph_hi) {
            if (ph == 0) {
                if (F.bid == 0) for (int i = F.tid; i < XCD_BAR_WORDS; i += NTHR) __hip_atomic_store((unsigned*)(F.ws + WS_BAR) + i, 0u, __ATOMIC_RELAXED, __HIP_MEMORY_SCOPE_AGENT);
                __syncthreads(); cg::this_grid().sync();
                if (F.tid == 0) (void)xb_add((unsigned*)(F.ws + WS_BAR) + XB_XCNT(xb_xcc_id()), 1u);
            }
            else xcd_barrier((unsigned*)(F.ws + WS_BAR), (volatile LAS unsigned*)(F.lds + BAR_LDS_OFF));
        }
        if (PROBE_MASK != 0ull && ph == N_PHASES - 1 && F.bid == 0) {
            if (F.tid == 0) { unsigned long long* ts = (unsigned long long*)(F.ws + WS_TS); const unsigned long long tend = __builtin_amdgcn_s_memrealtime(); unsigned long long tot = 0ull;
                for (int k = 0; k < N_PHASES; ++k) if ((PROBE_MASK >> k) & 1ull) tot += (k + 1 < N_PHASES ? ts[k + 1] : tend) - ts[k];
                while (__builtin_amdgcn_s_memrealtime() - tend < tot) __builtin_amdgcn_s_sleep(8); }
            __syncthreads();
        }
    }
}
template <int... I>
__device__ __forceinline__ void all_phases(int ph_lo, int ph_hi, unsigned char* lds_raw, std::integer_sequence<int, I...>) { (phase_step<I>(ph_lo, ph_hi, lds_raw), ...); }

__global__ void __launch_bounds__(NTHR, 2) fwd_kernel(Args args) {
    extern __shared__ __attribute__((aligned(16))) unsigned char lds_raw[];
    int ph_lo, ph_hi;
    { const __attribute__((address_space(4))) unsigned char* kp0 = (const __attribute__((address_space(4))) unsigned char*)__builtin_amdgcn_kernarg_segment_ptr();
      ph_lo = *(const __attribute__((address_space(4))) int*)(kp0 + 320); ph_hi = *(const __attribute__((address_space(4))) int*)(kp0 + 324); }
    if (threadIdx.x < 16) ((LAS unsigned*)((LAS unsigned char*)lds_raw + BAR_LDS_OFF))[threadIdx.x] = 0u;
    __syncthreads();
    all_phases(ph_lo, ph_hi, lds_raw, std::make_integer_sequence<int, N_PHASES>{});
}

extern "C" void kernel_launch(void* const* d_in, const int* in_sizes, int n_in, void* d_out, int out_size, void* d_ws, size_t ws_size, hipStream_t stream) {
    static int grid = 0;
    if (grid == 0) {
        int dev = 0, cus = 0, per_cu = 0;
        hipGetDevice(&dev);
        hipDeviceGetAttribute(&cus, hipDeviceAttributeMultiprocessorCount, dev);
        hipFuncSetAttribute((const void*)fwd_kernel, hipFuncAttributeMaxDynamicSharedMemorySize, LDS_BYTES);
        hipOccupancyMaxActiveBlocksPerMultiprocessor(&per_cu, (const void*)fwd_kernel, NTHR, LDS_BYTES);
        if (per_cu < 1) { fprintf(stderr, "kernel_launch: occupancy query says %d blocks per CU\n", per_cu); per_cu = 1; }
        grid = cus < 256 ? cus : 256;
        if (n_in != 38 || ws_size < WS_END) fprintf(stderr, "kernel_launch: unexpected n_in %d / ws_size %zu (need %zu)\n", n_in, ws_size, (size_t)WS_END);
        (void)hipGetLastError();
    }
    (void)hipMemsetAsync(d_ws, 0, 128 * 1024, stream);
    Args a{};
    for (int i = 0; i < 38; ++i) a.in[i] = (const float*)d_in[i];
    a.out = (float*)d_out; a.ws = (unsigned char*)d_ws; a.ph_lo = 0; a.ph_hi = N_PHASES;
    void* kargs[] = {&a};
    hipError_t e = hipLaunchCooperativeKernel((const void*)fwd_kernel, dim3(grid), dim3(NTHR), kargs, LDS_BYTES, stream);
    if (e != hipSuccess) fprintf(stderr, "cooperative launch failed: %s (grid %d)\n", hipGetErrorString(e), grid);
}
```

```cpp
#include <hip/hip_runtime.h>
#include <hip/hip_cooperative_groups.h>
#include <cstdio>
#include <cstdint>
#include <cstddef>
#include <utility>
namespace cg = cooperative_groups;

#define LAS __attribute__((address_space(3)))
typedef unsigned short bf16;
typedef short bf16x8 __attribute__((ext_vector_type(8)));
typedef float f32x4 __attribute__((ext_vector_type(4)));
typedef float f32x2 __attribute__((ext_vector_type(2)));
typedef unsigned u32x4 __attribute__((ext_vector_type(4)));
typedef unsigned u32x2 __attribute__((ext_vector_type(2)));

namespace pg8 {
#define PG8_LAS __attribute__((address_space(3)))
typedef unsigned short bf16_t;
constexpr int BM = 256, BK = 64, HALF = 128, HTB = HALF * BK * 2, STAGE_BYTES = 8 * HTB, NXCD = 8, WGM = 8;
__host__ __device__ __forceinline__ int lds_byte(int r, int c) { const int st = (r >> 4) * 2 + (c >> 5), rr = r & 15, cc = c & 31, ob = rr * 64 + cc * 2; return st * 1024 + (ob ^ (((ob >> 9) & 1) << 5)); }
__host__ __device__ __forceinline__ void stage_rc(int b, int& R, int& C) { const int st = b / 1024, sb = b % 1024, swz = sb ^ (((sb >> 9) & 1) << 5); R = (st >> 1) * 16 + swz / 64; C = (st & 1) * 32 + (swz % 64) / 2; }
__host__ __device__ __forceinline__ int perm32(int rho) { const int n = rho >> 4, i = rho & 15; return 8 * (i >> 2) + 4 * n + (i & 3); }
struct Unit { int pm, pn; };
struct Gemm { const bf16_t* A; const bf16_t* Bt; int M, N, K; };
struct StaticOrder {
    int nM, nN, nwg, G, c;
    __host__ __device__ void init(int M, int N, int G_, int c_) { nM = M / BM; nN = N / BM; nwg = nM * nN; G = G_; c = c_; }
    __host__ __device__ bool next(int i, Unit& u) const {
        const long L = (long)i * G + c; if (L >= nwg) return false;
        int wgid = (int)L; { const int q = nwg / NXCD, r = nwg % NXCD, xcd = wgid % NXCD, off = wgid / NXCD; wgid = (xcd < r ? xcd * (q + 1) : r * (q + 1) + (xcd - r) * q) + off; }
        const int nig = WGM * nN, gid = wgid / nig, fm = gid * WGM, gsz = (nM - fm) < WGM ? (nM - fm) : WGM;
        u.pm = fm + ((wgid % nig) % gsz); u.pn = (wgid % nig) / gsz; return true;
    }
    __device__ __forceinline__ void a_ready(const Unit&) const {}
    __device__ __forceinline__ void done(const Unit&) const {}
};
__device__ __forceinline__ unsigned cvt_pk_bf16(float lo, float hi) { unsigned r; asm volatile("v_cvt_pk_bf16_f32 %0, %1, %2" : "=v"(r) : "v"(lo), "v"(hi)); return r; }

struct EpiBf16 {
    static constexpr bool PERM = true, AFTER_DRAIN = false;
    bf16_t* O; int ldc; const float* bias; int split_cols; size_t split_stride;
    __device__ __forceinline__ void operator()(const f32x4 (&acc)[2][2][4][2], const Unit& u, int wr, int wc, int fr, int fq) const {
        const int row0 = u.pm * BM + wr * 64 + fr; int colt = u.pn * BM; bf16_t* base = O;
        if (split_cols) { const int t = colt / split_cols; base += (size_t)t * split_stride; colt -= t * split_cols; }
        const int col0 = colt + wc * 32 + 8 * fq, bcol0 = u.pn * BM + wc * 32 + 8 * fq;
        f32x4 bv[2][2];
#pragma unroll
        for (int bj = 0; bj < 2; ++bj)
#pragma unroll
            for (int n = 0; n < 2; ++n) bv[bj][n] = bias ? *(const f32x4*)(bias + bcol0 + bj * HALF + 4 * n) : (f32x4){0.f, 0.f, 0.f, 0.f};
#pragma unroll
        for (int ai = 0; ai < 2; ++ai)
#pragma unroll
            for (int m = 0; m < 4; ++m) { bf16_t* rowp = base + (size_t)(row0 + ai * HALF + m * 16) * ldc + col0;
#pragma unroll
                for (int bj = 0; bj < 2; ++bj) { f32x4 v0 = acc[ai][bj][m][0] + bv[bj][0], v1 = acc[ai][bj][m][1] + bv[bj][1];
                    u32x4 w; w.x = cvt_pk_bf16(v0[0], v0[1]); w.y = cvt_pk_bf16(v0[2], v0[3]); w.z = cvt_pk_bf16(v1[0], v1[1]); w.w = cvt_pk_bf16(v1[2], v1[3]);
                    *(u32x4*)(rowp + bj * HALF) = w; } }
    }
};
struct EpiBf16T {
    static constexpr bool PERM = true, AFTER_DRAIN = false;
    bf16_t* O; int ntc;
    __device__ __forceinline__ void operator()(const f32x4 (&acc)[2][2][4][2], const Unit& u, int wr, int wc, int fr, int fq) const {
        bf16_t* base = O + (size_t)(fr + 16 * fq) * 8;
#pragma unroll
        for (int ai = 0; ai < 2; ++ai)
#pragma unroll
            for (int m = 0; m < 4; ++m)
#pragma unroll
                for (int bj = 0; bj < 2; ++bj) { const f32x4 v0 = acc[ai][bj][m][0], v1 = acc[ai][bj][m][1];
                    u32x4 w; w.x = cvt_pk_bf16(v0[0], v0[1]); w.y = cvt_pk_bf16(v0[2], v0[3]); w.z = cvt_pk_bf16(v1[0], v1[1]); w.w = cvt_pk_bf16(v1[2], v1[3]);
                    *(u32x4*)(base + ((size_t)(u.pm * 16 + ai * 8 + wr * 4 + m) * ntc + u.pn * 8 + bj * 4 + wc) * 512) = w; }
    }
};
struct EpiDelta {
    static constexpr bool PERM = true, AFTER_DRAIN = false, HEAVY = false;
    bf16_t* Dl; int rows_lat; const float* gate; int b0; const float* bias;
    __device__ __forceinline__ void operator()(const f32x4 (&acc)[2][2][4][2], const Unit& u, int wr, int wc, int fr, int fq) const {
        const int trow = u.pm * BM, modrow = trow < rows_lat ? b0 + trow / 8192 : 4;
        const int col0 = u.pn * BM + wc * 32 + 8 * fq; const float* gp = gate + (size_t)modrow * 6144 + col0;
        bf16_t* base = Dl + (size_t)(trow + wr * 64 + fr) * 1024 + col0;
#pragma unroll
        for (int bj = 0; bj < 2; ++bj) {
            f32x4 bv[2], gv[2];
#pragma unroll
            for (int n = 0; n < 2; ++n) { bv[n] = bias ? *(const f32x4*)(bias + col0 + bj * HALF + 4 * n) : (f32x4){0.f, 0.f, 0.f, 0.f}; gv[n] = *(const f32x4*)(gp + bj * HALF + 4 * n); }
#pragma unroll
            for (int ai = 0; ai < 2; ++ai)
#pragma unroll
                for (int m = 0; m < 4; ++m) { const f32x4 v0 = gv[0] * (acc[ai][bj][m][0] + bv[0]), v1 = gv[1] * (acc[ai][bj][m][1] + bv[1]);
                    u32x4 w; w.x = cvt_pk_bf16(v0[0], v0[1]); w.y = cvt_pk_bf16(v0[2], v0[3]); w.z = cvt_pk_bf16(v1[0], v1[1]); w.w = cvt_pk_bf16(v1[2], v1[3]);
                    *(u32x4*)(base + (size_t)(ai * HALF + m * 16) * 1024 + bj * HALF) = w; }
        }
    }
};
struct EpiRes {
    static constexpr bool PERM = false, AFTER_DRAIN = false;
    const float* res_lat; float* out_lat; const float* res_ctx; float* out_ctx; int rows_lat; const float* gate; int b0; const float* bias;
    __device__ __forceinline__ void operator()(const f32x4 (&acc)[2][2][4][2], const Unit& u, int wr, int wc, int fr, int fq) const {
        const int trow = u.pm * BM; const float* res; float* out; int modrow;
        if (trow < rows_lat) { res = res_lat + (size_t)trow * 1024; out = out_lat + (size_t)trow * 1024; modrow = b0 + trow / 8192; }
        else { const int rc = trow - rows_lat; res = res_ctx + (size_t)rc * 1024; out = out_ctx + (size_t)rc * 1024; modrow = 4; }
        const int col0 = u.pn * BM + wc * 32 + 4 * fq; const float* gp = gate + (size_t)modrow * 6144 + col0;
#pragma unroll
        for (int bj = 0; bj < 2; ++bj) {
            f32x4 bv[2], gv[2];
#pragma unroll
            for (int n = 0; n < 2; ++n) { bv[n] = bias ? *(const f32x4*)(bias + col0 + bj * HALF + n * 16) : (f32x4){0.f, 0.f, 0.f, 0.f}; gv[n] = *(const f32x4*)(gp + bj * HALF + n * 16); }
#pragma unroll
            for (int ai = 0; ai < 2; ++ai) {
                f32x4 rs[4][2];
#pragma unroll
                for (int m = 0; m < 4; ++m)
#pragma unroll
                    for (int n = 0; n < 2; ++n) rs[m][n] = *(const f32x4*)(res + (size_t)(wr * 64 + fr + ai * HALF + m * 16) * 1024 + col0 + bj * HALF + n * 16);
#pragma unroll
                for (int m = 0; m < 4; ++m)
#pragma unroll
                    for (int n = 0; n < 2; ++n) *(f32x4*)(out + (size_t)(wr * 64 + fr + ai * HALF + m * 16) * 1024 + col0 + bj * HALF + n * 16) = rs[m][n] + gv[n] * (acc[ai][bj][m][n] + bv[n]);
                asm volatile("" ::: "memory");
            }
        }
    }
};

template <class Epi, class Sched, bool ALIGN_EPI = false, bool SP2 = false>
__device__ __forceinline__ void gemm_phase(PG8_LAS unsigned char* lds, const Gemm g, const Sched& S, const Epi& E, const int tid) {
    const int wid = __builtin_amdgcn_readfirstlane(tid >> 6), lane = tid & 63, wr = wid >> 2, wc = wid & 3, fr = lane & 15, fq = lane >> 4;
    const int K = g.K, nt = K / BK;
    unsigned voffA[2], voffB[2];
#pragma unroll
    for (int i = 0; i < 2; ++i) { int R, C; stage_rc(tid * 16 + i * 8192, R, C); const int Rb = Epi::PERM ? ((R & ~31) + perm32(R & 31)) : R;
        voffA[i] = (unsigned)(R * K + C) * 2u; voffB[i] = (unsigned)(Rb * K + C) * 2u; }
    const size_t kstep = (size_t)(BK * 2);
    const size_t hstep = (size_t)HALF * K * 2;
    const size_t tstep = 2 * hstep;
    const unsigned ldsw = (unsigned)wid * 1024u;
    const int aoff = lds_byte(wr * 64 + fr, fq * 8), boff = lds_byte(wc * 32 + fr, fq * 8);
#define PG8_SA(b, h) (((b) * 2 + (h)) * HTB)
#define PG8_SB(b, h) ((4 + (b) * 2 + (h)) * HTB)
#define PG8_STAGE(bufoff, gbase, voff) do { _Pragma("unroll") for (int _i = 0; _i < 2; ++_i) \
        __builtin_amdgcn_global_load_lds((const unsigned*)((const char*)(gbase) + (voff)[_i]), (PG8_LAS unsigned*)(lds + (bufoff) + ldsw + _i * 8192), 16, 0, 0); } while (0)
#define PG8_LDA(dst, b, h) do { _Pragma("unroll") for (int m = 0; m < 4; ++m) _Pragma("unroll") for (int k = 0; k < 2; ++k) dst[m][k] = *(const PG8_LAS bf16x8*)(lds + PG8_SA(b, h) + aoff + m * 2048 + k * 1024); } while (0)
#define PG8_LDB(dst, b, h) do { _Pragma("unroll") for (int n = 0; n < 2; ++n) _Pragma("unroll") for (int k = 0; k < 2; ++k) dst[n][k] = *(const PG8_LAS bf16x8*)(lds + PG8_SB(b, h) + boff + n * 2048 + k * 1024); } while (0)
#define PG8_MMA(ai, bj, At, Bt) do { __builtin_amdgcn_s_setprio(1); _Pragma("unroll") for (int m = 0; m < 4; ++m) _Pragma("unroll") for (int n = 0; n < 2; ++n) _Pragma("unroll") for (int k = 0; k < 2; ++k) \
        acc[ai][bj][m][n] = __builtin_amdgcn_mfma_f32_16x16x32_bf16(Bt[n][k], At[m][k], acc[ai][bj][m][n], 0, 0, 0); __builtin_amdgcn_s_setprio(0); } while (0)
#define PG8_WAIT_V(n) asm volatile("s_waitcnt vmcnt(" #n ")" ::: "memory")
#define PG8_WAIT_L(n) asm volatile("s_waitcnt lgkmcnt(" #n ")" ::: "memory")
#define PG8_BAR __builtin_amdgcn_s_barrier()
#define PG8_SCHED __builtin_amdgcn_sched_barrier(0)
    Unit cur, nxt; int ui = 0;
    if (!S.next(0, cur)) return;
    f32x4 acc[2][2][4][2];
#pragma unroll
    for (int a = 0; a < 2; ++a)
#pragma unroll
        for (int b = 0; b < 2; ++b)
#pragma unroll
            for (int m = 0; m < 4; ++m)
#pragma unroll
                for (int n = 0; n < 2; ++n) acc[a][b][m][n] = (f32x4){0.f, 0.f, 0.f, 0.f};
    bf16x8 At[4][2], B0[2][2], B1[2][2];
    const char* cA = (const char*)g.A + (size_t)cur.pm * tstep; const char* cB = (const char*)g.Bt + (size_t)cur.pn * tstep;
    S.a_ready(cur);
    if constexpr (SP2) {
        PG8_STAGE(PG8_SB(0, 0), cB, voffB); PG8_STAGE(PG8_SB(0, 1), cB + hstep, voffB); PG8_STAGE(PG8_SA(0, 0), cA, voffA); PG8_STAGE(PG8_SA(0, 1), cA + hstep, voffA);
        if (wr == 1) PG8_BAR;
        PG8_WAIT_V(2); PG8_BAR;
        PG8_STAGE(PG8_SB(1, 0), cB + kstep, voffB); PG8_STAGE(PG8_SA(1, 0), cA + kstep, voffA); PG8_STAGE(PG8_SB(1, 1), cB + hstep + kstep, voffB);
        PG8_WAIT_V(6); PG8_BAR;
    } else {
        PG8_STAGE(PG8_SB(0, 0), cB, voffB); PG8_STAGE(PG8_SA(0, 0), cA, voffA); PG8_STAGE(PG8_SB(0, 1), cB + hstep, voffB); PG8_STAGE(PG8_SA(0, 1), cA + hstep, voffA);
        if (wr == 1) PG8_BAR;
        PG8_WAIT_V(4); PG8_BAR;
        PG8_STAGE(PG8_SB(1, 0), cB + kstep, voffB); PG8_STAGE(PG8_SA(1, 0), cA + kstep, voffA); PG8_STAGE(PG8_SB(1, 1), cB + hstep + kstep, voffB);
        PG8_WAIT_V(6); PG8_BAR;
    }
    for (;;) {
        const bool has_next = S.next(ui + 1, nxt);
        const char* nA = has_next ? (const char*)g.A + (size_t)nxt.pm * tstep : cA; const char* nB = has_next ? (const char*)g.Bt + (size_t)nxt.pn * tstep : cB;
        for (int t = 0; t < nt; t += 2) {
            const bool last = (t == nt - 2);
            const char* a1 = cA + (size_t)(t + 1) * kstep;
            const char* a2 = last ? nA : cA + (size_t)(t + 2) * kstep; const char* b2 = last ? nB : cB + (size_t)(t + 2) * kstep;
            const char* a3 = a2 + kstep; const char* b3 = b2 + kstep;
            if (last && has_next) S.a_ready(nxt);
            if constexpr (SP2) {
            PG8_LDB(B0, 0, 0); PG8_LDB(B1, 0, 1); PG8_SCHED; PG8_LDA(At, 0, 0); PG8_STAGE(PG8_SA(1, 1), a1 + hstep, voffA);
            PG8_WAIT_V(8); PG8_WAIT_L(0); PG8_BAR; PG8_MMA(0, 0, At, B0); PG8_MMA(0, 1, At, B1); PG8_BAR; PG8_SCHED;
            PG8_LDA(At, 0, 1); PG8_STAGE(PG8_SB(0, 0), b2, voffB); PG8_STAGE(PG8_SB(0, 1), b2 + hstep, voffB); PG8_STAGE(PG8_SA(0, 0), a2, voffA);
            PG8_WAIT_V(8); PG8_WAIT_L(0); PG8_BAR; PG8_MMA(1, 0, At, B0); PG8_MMA(1, 1, At, B1); PG8_BAR; PG8_SCHED;
            PG8_LDB(B0, 1, 0); PG8_LDB(B1, 1, 1); PG8_SCHED; PG8_LDA(At, 1, 0); PG8_STAGE(PG8_SA(0, 1), a2 + hstep, voffA);
            PG8_WAIT_V(8); PG8_WAIT_L(0); PG8_BAR; PG8_MMA(0, 0, At, B0); PG8_MMA(0, 1, At, B1); PG8_BAR; PG8_SCHED;
            PG8_LDA(At, 1, 1); PG8_STAGE(PG8_SB(1, 0), b3, voffB); PG8_STAGE(PG8_SB(1, 1), b3 + hstep, voffB); PG8_STAGE(PG8_SA(1, 0), a3, voffA);
            PG8_WAIT_V(8); PG8_WAIT_L(0); PG8_BAR; PG8_MMA(1, 0, At, B0); PG8_MMA(1, 1, At, B1); PG8_BAR; PG8_SCHED;
            } else {
            PG8_LDB(B0, 0, 0); PG8_SCHED; PG8_LDA(At, 0, 0); PG8_STAGE(PG8_SA(1, 1), a1 + hstep, voffA);
            PG8_WAIT_L(8); PG8_BAR; PG8_WAIT_L(0); PG8_MMA(0, 0, At, B0); PG8_BAR; PG8_SCHED;
            PG8_LDB(B1, 0, 1); PG8_STAGE(PG8_SB(0, 0), b2, voffB);
            PG8_BAR; PG8_WAIT_L(0); PG8_MMA(0, 1, At, B1); PG8_BAR;
            PG8_LDA(At, 0, 1); PG8_STAGE(PG8_SA(0, 0), a2, voffA);
            PG8_BAR; PG8_WAIT_L(0); PG8_MMA(1, 0, At, B0); PG8_BAR; PG8_SCHED;
            PG8_STAGE(PG8_SB(0, 1), b2 + hstep, voffB);
            PG8_WAIT_V(6); PG8_BAR; PG8_MMA(1, 1, At, B1); PG8_BAR;
            PG8_LDB(B0, 1, 0); PG8_SCHED; PG8_LDA(At, 1, 0); PG8_STAGE(PG8_SA(0, 1), a2 + hstep, voffA);
            PG8_WAIT_L(8); PG8_BAR; PG8_WAIT_L(0); PG8_MMA(0, 0, At, B0); PG8_BAR; PG8_SCHED;
            PG8_LDB(B1, 1, 1); PG8_STAGE(PG8_SB(1, 0), b3, voffB);
            PG8_BAR; PG8_WAIT_L(0); PG8_MMA(0, 1, At, B1); PG8_BAR;
            PG8_LDA(At, 1, 1); PG8_STAGE(PG8_SA(1, 0), a3, voffA);
            PG8_BAR; PG8_WAIT_L(0); PG8_MMA(1, 0, At, B0); PG8_BAR; PG8_SCHED;
            PG8_STAGE(PG8_SB(1, 1), b3 + hstep, voffB);
            PG8_WAIT_V(6); PG8_BAR; PG8_MMA(1, 1, At, B1); PG8_BAR;
            }
        }
        if constexpr (ALIGN_EPI) { if (wr == 0) PG8_BAR; }
        if constexpr (!Epi::AFTER_DRAIN) { E(acc, cur, wr, wc, fr, fq); S.done(cur); }
        if (!has_next) break;
#pragma unroll
        for (int a = 0; a < 2; ++a)
#pragma unroll
            for (int b = 0; b < 2; ++b)
#pragma unroll
                for (int m = 0; m < 4; ++m)
#pragma unroll
                    for (int n = 0; n < 2; ++n) acc[a][b][m][n] = (f32x4){0.f, 0.f, 0.f, 0.f};
        cur = nxt; cA = nA; cB = nB; ++ui;
        if constexpr (ALIGN_EPI) { if (wr == 1) PG8_BAR; }
    }
    PG8_WAIT_V(0);
    if constexpr (!ALIGN_EPI) { if (wr == 0) PG8_BAR; }
    PG8_BAR;
#undef PG8_SA
#undef PG8_SB
#undef PG8_STAGE
#undef PG8_LDA
#undef PG8_LDB
#undef PG8_MMA
#undef PG8_WAIT_V
#undef PG8_WAIT_L
#undef PG8_BAR
#undef PG8_SCHED
}
}

constexpr int D = 1024, NB = 4, SEQ = 8192, CTXL = 256, ML = NB * SEQ, MC = NB * CTXL, MALL = ML + MC;
constexpr int FF = 2816, MI = 2048, NH = 4, DH = 512, HROWS = 2 * SEQ;
constexpr float EPS = 1e-6f, ML_NORM_EPS = 1e-5f;
constexpr float HY_MAX_DECAY = -15.350567286626973f, HY_MIN_DECAY = -3.0701134573253945f;
constexpr int NWAVES = 8, NTHR = 512;
constexpr int LDS_BYTES = 147456;

constexpr size_t MiB = 1u << 20;
constexpr size_t WS_MOD = 1 * MiB;
constexpr size_t WS_CTXX = 2 * MiB;
constexpr size_t WS_H3 = 6 * MiB;
constexpr size_t WS_KTC = 9 * MiB;
constexpr size_t WS_GWT = 11 * MiB;
constexpr size_t WS_WKQ = 11 * MiB + 256 * 1024;
constexpr size_t WS_NC = 12 * MiB;
constexpr size_t WS_WHIN = 16 * MiB, WS_WHOUT = 22 * MiB, WS_WMIN = 24 * MiB, WS_WMDN = 32 * MiB, WS_WUP0 = 36 * MiB, WS_WUP1 = 47 * MiB, WS_WDN0 = 58 * MiB, WS_WDN1 = 58 * MiB + 5767168;
constexpr size_t WS_GATES_L = 69 * MiB;
constexpr size_t WS_GATES_C = 70 * MiB;
constexpr size_t WS_GT_L = 71 * MiB;
constexpr size_t WS_GT_C = 73 * MiB;
constexpr size_t WS_GC = 73 * MiB + 512 * 1024;
constexpr size_t WS_DN = 74 * MiB;
constexpr size_t WS_RS = 79 * MiB;
constexpr size_t WS_INV = 79 * MiB + 512 * 1024;
constexpr size_t BIG = 80 * MiB;
constexpr size_t HY_H = BIG, HY_P = BIG + 66 * MiB, HY_KT = BIG + 264 * MiB, HY_ZT = BIG + 328 * MiB, HY_ZTC = BIG + 392 * MiB, HY_KS = BIG + 394 * MiB;
constexpr size_t FF_H = BIG, FF_A = BIG + 66 * MiB, FF_G = BIG + 248 * MiB;
constexpr size_t MS_H = BIG, MS_XM = BIG + 32 * MiB, MS_XC = BIG + 96 * MiB, MS_KT = BIG + 160 * MiB, MS_VT = BIG + 224 * MiB, MS_NF = BIG + 288 * MiB, MS_NB = BIG + 352 * MiB,
                 MS_KTC = BIG + 416 * MiB, MS_VTC = BIG + 420 * MiB;
constexpr size_t MS_S = MS_XM, MS_Z = MS_KT, MS_KN = MS_NF, MS_XCC = MS_NB, MS_XMC = MS_NB + 4 * MiB, MS_HC = MS_NB + 8 * MiB;
constexpr size_t WS_END = BIG + 424 * MiB;
static_assert(WS_END <= 512 * MiB, "workspace map");
static_assert(FF_G + (size_t)MALL * FF * 2 <= 512 * MiB && FF_A + (size_t)MALL * FF * 2 <= FF_G, "ffn map");
static_assert(HY_P + (size_t)MALL * 3072 * 2 <= HY_KT && HY_ZTC + (size_t)NB * D * CTXL * 2 <= HY_KS && HY_KS + 32 * MiB <= 512 * MiB, "hyena map");

__device__ __forceinline__ unsigned f2bf(float f) { unsigned u = __float_as_uint(f); return (u + 0x7fffu + ((u >> 16) & 1u)) >> 16; }
typedef __bf16 bf16x2_t __attribute__((ext_vector_type(2)));
__device__ __forceinline__ unsigned pk2(float lo, float hi) { const f32x2 v = {lo, hi}; const bf16x2_t b = __builtin_convertvector(v, bf16x2_t); return __builtin_bit_cast(unsigned, b); }
__device__ __forceinline__ float bf2f(unsigned short b) { return __uint_as_float(((unsigned)b) << 16); }
__device__ __forceinline__ float bflo(unsigned w) { return __uint_as_float(w << 16); }
__device__ __forceinline__ float bfhi(unsigned w) { return __uint_as_float(w & 0xffff0000u); }
__device__ __forceinline__ void unpack8(const u32x4 v, float (&o)[8]) { o[0] = bflo(v.x); o[1] = bfhi(v.x); o[2] = bflo(v.y); o[3] = bfhi(v.y); o[4] = bflo(v.z); o[5] = bfhi(v.z); o[6] = bflo(v.w); o[7] = bfhi(v.w); }
__device__ __forceinline__ u32x4 pack8(const float (&o)[8]) { u32x4 v; v.x = pk2(o[0], o[1]); v.y = pk2(o[2], o[3]); v.z = pk2(o[4], o[5]); v.w = pk2(o[6], o[7]); return v; }
__device__ __forceinline__ float wave_sum(float v) {
#pragma unroll
    for (int o = 1; o < 64; o <<= 1) v += __shfl_xor(v, o);
    return v;
}
__device__ __forceinline__ float silu_f(float x) { return x * __builtin_amdgcn_rcpf(1.0f + __expf(-x)); }

typedef const float* cfptr_t;
struct Fr {
    LAS unsigned char* lds; int tid, lane, wave, gw, ngw, G, bid;
    const __attribute__((address_space(4))) cfptr_t* in; float* out; unsigned char* ws;
};
#define IN(i) (F.in[i])
enum { I_X = 0, I_C, I_CTX, I_CCTX, I_MODW, I_MODB, I_NORMG, I_FINALG, I_HWIN, I_HBIN, I_HSCW, I_HSCB, I_FW1, I_FB1, I_FW2, I_FB2, I_FW3, I_FB3, I_FWOUT, I_FREQ, I_HBIAS, I_HWOUT, I_HBOUT,
       I_MWIN, I_MCW, I_MCB, I_MWQ, I_MWK, I_MWV, I_MWG, I_MBG, I_MNW, I_MSKIP, I_MWDN, I_FWUP, I_FCW, I_FCB, I_FWDN };

__device__ __forceinline__ void transpose_item(const float* W, int K, int N, bf16* WT, LAS float* scr, int item, int lane) {
    const int nblk = N / 32, kb = item / nblk, nb = item % nblk, k0 = 64 * kb, n0 = 32 * nb;
    float tv[32];
#pragma unroll
    for (int i = 0; i < 32; ++i) tv[i] = W[(size_t)(k0 + 2 * i + (lane >> 5)) * N + n0 + (lane & 31)];
#pragma unroll
    for (int i = 0; i < 32; ++i) scr[(2 * i + (lane >> 5)) * 33 + (lane & 31)] = tv[i];
    asm volatile("s_waitcnt lgkmcnt(0)" ::: "memory");
    const int c = lane & 7;
#pragma unroll
    for (int j = 0; j < 4; ++j) { const int n = (lane >> 3) + 8 * j; const LAS float* s = scr + (8 * c) * 33 + n;
        u32x4 o; o.x = pk2(s[0 * 33], s[1 * 33]); o.y = pk2(s[2 * 33], s[3 * 33]); o.z = pk2(s[4 * 33], s[5 * 33]); o.w = pk2(s[6 * 33], s[7 * 33]);
        *(u32x4*)(WT + (size_t)(n0 + n) * K + k0 + 8 * c) = o; }
    asm volatile("s_waitcnt lgkmcnt(0)" ::: "memory");
}
__device__ __forceinline__ void transpose_matrix(Fr& F, const float* W, int K, int N, bf16* WT) {
    LAS float* scr = (LAS float*)(F.lds + F.wave * 16384);
    const int nitems = (K / 64) * (N / 32);
    for (int it = F.gw; it < nitems; it += F.ngw) transpose_item(W, K, N, WT, scr, it, F.lane);
}

__device__ __forceinline__ void transpose_group(Fr& F, int grp, int vb, int nvb) {
    unsigned char* ws = F.ws; LAS float* scr = (LAS float*)(F.lds + F.wave * 16384);
    constexpr int I0 = (D / 64) * (3 * D / 32), I1 = (D / 64) * (D / 32), I2 = (D / 64) * (2 * MI / 32), I3 = (MI / 64) * (D / 32), I4 = (D / 64) * (2 * FF / 32), I5 = (FF / 64) * (D / 32);
    const int nit = grp == 0 ? I0 : (grp == 1 ? I1 : I2 + I3 + 2 * I4 + 2 * I5);
    for (int it = vb * NWAVES + F.wave; it < nit; it += nvb * NWAVES) {
        int r = it;
        if (grp == 0) { transpose_item(IN(I_HWIN), D, 3 * D, (bf16*)(ws + WS_WHIN), scr, r, F.lane); continue; }
        if (grp == 1) { transpose_item(IN(I_HWOUT), D, D, (bf16*)(ws + WS_WHOUT), scr, r, F.lane); continue; }
        if (r < I4) { transpose_item(IN(I_FWUP), D, 2 * FF, (bf16*)(ws + WS_WUP0), scr, r, F.lane); continue; } r -= I4;
        if (r < I5) { transpose_item(IN(I_FWDN), FF, D, (bf16*)(ws + WS_WDN0), scr, r, F.lane); continue; } r -= I5;
        if (r < I2) { transpose_item(IN(I_MWIN), D, 2 * MI, (bf16*)(ws + WS_WMIN), scr, r, F.lane); continue; } r -= I2;
        if (r < I3) { transpose_item(IN(I_MWDN), MI, D, (bf16*)(ws + WS_WMDN), scr, r, F.lane); continue; } r -= I3;
        if (r < I4) { transpose_item(IN(I_FWUP) + (size_t)D * 2 * FF, D, 2 * FF, (bf16*)(ws + WS_WUP1), scr, r, F.lane); continue; } r -= I4;
        transpose_item(IN(I_FWDN) + (size_t)FF * D, FF, D, (bf16*)(ws + WS_WDN1), scr, r, F.lane);
    }
}
__device__ __forceinline__ void transpose_in_tail(Fr& F, int grp, int nunits) {
    const int busy = nunits % F.G;
    if (busy == 0) transpose_group(F, grp, F.bid, F.G);
    else if (F.bid >= busy) transpose_group(F, grp, F.bid - busy, F.G - busy);
}

__device__ __forceinline__ void mod_layer(Fr& F, int l, int vb, int nvb) {
    LAS float* sc = (LAS float*)F.lds;
    LAS float* red = (LAS float*)(F.lds + 32768);
    __syncthreads();
    for (int i = F.tid; i < 5 * 1024; i += NTHR) { const int r = i >> 10, k = i & 1023; const float v = r < 4 ? IN(I_C)[r * 1024 + k] : IN(I_CCTX)[k]; sc[i] = silu_f(v); }
    __syncthreads();
    float* mod = (float*)(F.ws + WS_MOD);
    for (int it = vb; it < 96; it += nvb) {
        const int n0 = it * 64;
        const float* w = IN(I_MODW) + (size_t)l * 1024 * 6144 + n0 + F.lane;
        float a0 = 0.f, a1 = 0.f, a2 = 0.f, a3 = 0.f, a4 = 0.f;
        const int kb = F.wave * 128;
#pragma unroll 16
        for (int k = 0; k < 128; ++k) { const float wv = w[(size_t)(kb + k) * 6144];
            a0 += sc[kb + k] * wv; a1 += sc[1024 + kb + k] * wv; a2 += sc[2048 + kb + k] * wv; a3 += sc[3072 + kb + k] * wv; a4 += sc[4096 + kb + k] * wv; }
        red[(F.wave * 5 + 0) * 64 + F.lane] = a0; red[(F.wave * 5 + 1) * 64 + F.lane] = a1; red[(F.wave * 5 + 2) * 64 + F.lane] = a2; red[(F.wave * 5 + 3) * 64 + F.lane] = a3; red[(F.wave * 5 + 4) * 64 + F.lane] = a4;
        __syncthreads();
        if (F.tid < 320) { const int r = F.tid >> 6, ln = F.tid & 63; float s = 0.f;
#pragma unroll
            for (int w8 = 0; w8 < 8; ++w8) s += red[(w8 * 5 + r) * 64 + ln];
            mod[((size_t)l * 5 + r) * 6144 + n0 + ln] = s + IN(I_MODB)[l * 6144 + n0 + ln]; }
        __syncthreads();
    }
}

__device__ __forceinline__ void ph_prologue(Fr& F) {
    unsigned char* ws = F.ws;
    transpose_group(F, 0, F.bid, F.G);
    __syncthreads();
    mod_layer(F, 0, F.bid, F.G);
    {
        float* h3 = (float*)(ws + WS_H3);
        const float* w1 = IN(I_FW1); const float* w2 = IN(I_FW2); const float* w3 = IN(I_FW3);
        const float fr = IN(I_FREQ)[F.lane], b1 = IN(I_FB1)[F.lane], b2 = IN(I_FB2)[F.lane], b3 = IN(I_FB3)[F.lane];
        for (int row = F.gw; row < SEQ + CTXL; row += F.ngw) {
            const int L = row < SEQ ? SEQ : CTXL, i = row < SEQ ? row : row - SEQ;
            const float tl = (float)i / (float)(L - 1), w = 6.283185307179586f * (float)i / (float)L;
            float pos = 0.f; const int k = F.lane;
            if (k == 0) pos = tl;
            else if (k <= 16) { const float band = 1e-4f + (float)(k - 1) * ((15.0f - 1e-4f) / 15.0f); pos = cosf(band * w); }
            else if (k <= 32) { const float band = 1e-4f + (float)(k - 17) * ((15.0f - 1e-4f) / 15.0f); pos = -sinf(band * w); }
            float s = b1;
#pragma unroll
            for (int kk = 0; kk < 33; ++kk) s += __shfl(pos, kk) * w1[kk * 64 + F.lane];
            float h = sinf(fr * s);
            s = b2;
#pragma unroll 16
            for (int kk = 0; kk < 64; ++kk) s += __shfl(h, kk) * w2[kk * 64 + F.lane];
            h = sinf(fr * s);
            s = b3;
#pragma unroll 16
            for (int kk = 0; kk < 64; ++kk) s += __shfl(h, kk) * w3[kk * 64 + F.lane];
            h = sinf(fr * s);
            h3[(size_t)row * 64 + F.lane] = h;
        }
    }
    {
        bf16* gwt = (bf16*)(ws + WS_GWT); float* wkq = (float*)(ws + WS_WKQ);
        const float* wq = IN(I_MWQ); const float* wk = IN(I_MWK); const float* wv = IN(I_MWV); const float* wg = IN(I_MWG);
        const int gt = F.bid * NTHR + F.tid, nt = F.G * NTHR;
        for (int i = gt; i < MI * 16; i += nt) { const int ch = i >> 4, g = i & 15, n = ch >> 2, c = ch & 3; float sa = 0.f, sb = 0.f;
#pragma unroll
            for (int e = 0; e < 4; ++e) { sa += wq[n * 16 + c * 4 + e] * wg[(size_t)(n * 4 + e) * 16 + g] + wk[n * 16 + c * 4 + e] * wg[(size_t)(MI + n * 4 + e) * 16 + g];
                sb += wv[n * 16 + c * 4 + e] * wg[(size_t)(2 * MI + n * 4 + e) * 16 + g]; }
            const size_t go = ((size_t)(ch >> 5) * 64 + g + 16 * ((ch & 31) >> 3)) * 8 + (ch & 7);
            gwt[go] = (bf16)f2bf(sa); gwt[go + 64 * 512] = (bf16)f2bf(sb); }
        const float sc = 0.044194173824159216f;
        for (int i = gt; i < 512 * 16; i += nt) { const int n = i >> 4, c = (i >> 2) & 3, c2 = i & 3; float s = 0.f;
#pragma unroll
            for (int e = 0; e < 4; ++e) s += wk[n * 16 + c * 4 + e] * wq[n * 16 + c2 * 4 + e];
            wkq[i] = s * sc; }
    }
}

__device__ __forceinline__ void kt_items(Fr& F, const float* h3rows, int L, float* KT, int vgw, int vngw) {
    const float* wout = IN(I_FWOUT);
    const int nitems = (L / 16) * 32, fr = F.lane & 15, fq = F.lane >> 4;
    for (int it = vgw; it < nitems; it += vngw) {
        const int t0 = (it >> 5) * 16, n0 = (it & 31) * 64;
        float a[16];
#pragma unroll
        for (int ks = 0; ks < 16; ++ks) a[ks] = h3rows[(size_t)(t0 + fr) * 64 + 4 * ks + fq];
#pragma unroll
        for (int nt = 0; nt < 4; ++nt) {
            f32x4 acc = (f32x4){0.f, 0.f, 0.f, 0.f};
#pragma unroll
            for (int ks = 0; ks < 16; ++ks) acc = __builtin_amdgcn_mfma_f32_16x16x4f32(a[ks], wout[(size_t)(4 * ks + fq) * 2048 + n0 + nt * 16 + fr], acc, 0, 0, 0);
            const int n = n0 + nt * 16 + fr, dirn = n >> 10, c = n & 1023;
            const float delta = fabsf(HY_MIN_DECAY + (float)c * ((HY_MAX_DECAY - HY_MIN_DECAY) / 1023.0f)), il = 1.0f / (float)(L - 1);
            f32x4 o;
#pragma unroll
            for (int r = 0; r < 4; ++r) o[r] = acc[r] * __expf(-(float)(t0 + 4 * fq + r) * il * delta);
            *(f32x4*)(KT + ((size_t)c * 2 + dirn) * L + t0 + 4 * fq) = o;
        }
    }
}

__device__ __forceinline__ void modnorm_row(const float* xrow, const float* g, const float* sh, const float* sc, bf16* orow, int lane) {
    const f32x4* xr = (const f32x4*)xrow + lane; f32x4 v[4]; float s = 0.f;
#pragma unroll
    for (int j = 0; j < 4; ++j) { v[j] = xr[64 * j]; s += (v[j][0] * v[j][0] + v[j][1] * v[j][1]) + (v[j][2] * v[j][2] + v[j][3] * v[j][3]); }
    const float rinv = 1.0f / sqrtf(wave_sum(s) * (1.0f / 1024.0f) + EPS);
    u32x2* o8 = (u32x2*)orow + lane;
#pragma unroll
    for (int j = 0; j < 4; ++j) { const int c = 4 * lane + 256 * j; const f32x4 gg = *(const f32x4*)(g + c), s1 = *(const f32x4*)(sc + c), s0 = *(const f32x4*)(sh + c);
        const f32x4 y = (v[j] * rinv * gg) * (1.0f + s1) + s0; u32x2 w; w.x = pk2(y[0], y[1]); w.y = pk2(y[2], y[3]); o8[64 * j] = w; }
}
__device__ __forceinline__ void ph_modnorm(Fr& F, const float* xlat, int nlat, int b0, const float* xctx, int nctx, const float* g, const float* modl, int shoff, bf16* H,
                                           const bf16* dl = nullptr, float* olat = nullptr, float* octx = nullptr) {
    const int nrows = nlat + nctx;
    for (int r = F.gw; r < nrows; r += 2 * F.ngw) {
        const int r2 = r + F.ngw; const bool has2 = r2 < nrows; const int rb = has2 ? r2 : r;
        const bool isl = r < nlat, isl2 = rb < nlat;
        const size_t oa_ = isl ? (size_t)r * 1024 : (size_t)(r - nlat) * 1024, ob_ = isl2 ? (size_t)rb * 1024 : (size_t)(rb - nlat) * 1024;
        const float* xa = (isl ? xlat : xctx) + oa_; const float* xb = (isl2 ? xlat : xctx) + ob_;
        const int ma = isl ? b0 + r / SEQ : 4, mb = isl2 ? b0 + rb / SEQ : 4;
        const f32x4* pa = (const f32x4*)xa + F.lane; const f32x4* pb = (const f32x4*)xb + F.lane; f32x4 va[4], vb[4]; float sa = 0.f, sb = 0.f;
#pragma unroll
        for (int j = 0; j < 4; ++j) { va[j] = pa[64 * j]; vb[j] = pb[64 * j]; }
        if (dl) {
            const u32x2* da = (const u32x2*)(dl + (size_t)r * 1024) + F.lane; const u32x2* db = (const u32x2*)(dl + (size_t)rb * 1024) + F.lane;
            f32x4* qa = (f32x4*)((isl ? olat : octx) + oa_) + F.lane; f32x4* qb = (f32x4*)((isl2 ? olat : octx) + ob_) + F.lane;
#pragma unroll
            for (int j = 0; j < 4; ++j) { const u32x2 a = da[64 * j], b = db[64 * j];
                va[j] = va[j] + (f32x4){bflo(a.x), bfhi(a.x), bflo(a.y), bfhi(a.y)}; vb[j] = vb[j] + (f32x4){bflo(b.x), bfhi(b.x), bflo(b.y), bfhi(b.y)};
                qa[64 * j] = va[j]; if (has2) qb[64 * j] = vb[j]; }
        }
#pragma unroll
        for (int j = 0; j < 4; ++j) { sa += (va[j][0] * va[j][0] + va[j][1] * va[j][1]) + (va[j][2] * va[j][2] + va[j][3] * va[j][3]); sb += (vb[j][0] * vb[j][0] + vb[j][1] * vb[j][1]) + (vb[j][2] * vb[j][2] + vb[j][3] * vb[j][3]); }
        const float ra = __builtin_amdgcn_rsqf(wave_sum(sa) * (1.0f / 1024.0f) + EPS), rbv = __builtin_amdgcn_rsqf(wave_sum(sb) * (1.0f / 1024.0f) + EPS);
        const float* sha = modl + (size_t)ma * 6144 + shoff; const float* shb = modl + (size_t)mb * 6144 + shoff;
        u32x2* oa = (u32x2*)(H + (size_t)r * 1024) + F.lane; u32x2* ob = (u32x2*)(H + (size_t)rb * 1024) + F.lane;
#pragma unroll
        for (int j = 0; j < 4; ++j) { const int c = 4 * F.lane + 256 * j; const f32x4 gg = *(const f32x4*)(g + c);
            const f32x4 ya = (va[j] * ra * gg) * (1.0f + *(const f32x4*)(sha + 1024 + c)) + *(const f32x4*)(sha + c);
            const f32x4 yb = (vb[j] * rbv * gg) * (1.0f + *(const f32x4*)(shb + 1024 + c)) + *(const f32x4*)(shb + c);
            oa[64 * j] = (u32x2){pk2(ya[0], ya[1]), pk2(ya[2], ya[3])};
            if (has2) ob[64 * j] = (u32x2){pk2(yb[0], yb[1]), pk2(yb[2], yb[3])}; }
    }
}
__device__ __forceinline__ void add_delta_rows(Fr& F, float* x, const bf16* dl, int r0, int n) {
    for (int r = r0 + F.gw; r < r0 + n; r += F.ngw) {
        f32x4* px = (f32x4*)(x + (size_t)r * 1024) + F.lane; const u32x2* pd = (const u32x2*)(dl + (size_t)r * 1024) + F.lane; f32x4 v[4]; u32x2 d[4];
#pragma unroll
        for (int j = 0; j < 4; ++j) { v[j] = px[64 * j]; d[j] = pd[64 * j]; }
#pragma unroll
        for (int j = 0; j < 4; ++j) px[64 * j] = v[j] + (f32x4){bflo(d[j].x), bfhi(d[j].x), bflo(d[j].y), bfhi(d[j].y)};
    }
}

__device__ __forceinline__ void zt_items(Fr& F, const bf16* P, int rowbase, int nb, int Ls, bf16* ZT) {
    LAS unsigned char* tile = F.lds + F.wave * 16384;
    const float* scw = IN(I_HSCW); const float* scb = IN(I_HSCB);
    const int ntt = Ls / 64, nitems = nb * ntt * 16, tl = F.lane >> 3, c8 = F.lane & 7;
    for (int it = F.gw; it < nitems; it += F.ngw) {
        const int ct = it & 15, tt = (it >> 4) % ntt, b = (it >> 4) / ntt, t0 = tt * 64, ch = ct * 64 + c8 * 8;
        float w1[3][8], w2[3][8], b1[8], b2[8];
#pragma unroll
        for (int k = 0; k < 3; ++k) { const f32x4 a0 = *(const f32x4*)(scw + k * 3072 + 1024 + ch), a1 = *(const f32x4*)(scw + k * 3072 + 1024 + ch + 4), d0 = *(const f32x4*)(scw + k * 3072 + 2048 + ch), d1 = *(const f32x4*)(scw + k * 3072 + 2048 + ch + 4);
#pragma unroll
            for (int e = 0; e < 4; ++e) { w1[k][e] = a0[e]; w1[k][4 + e] = a1[e]; w2[k][e] = d0[e]; w2[k][4 + e] = d1[e]; } }
        { const f32x4 a0 = *(const f32x4*)(scb + 1024 + ch), a1 = *(const f32x4*)(scb + 1024 + ch + 4), d0 = *(const f32x4*)(scb + 2048 + ch), d1 = *(const f32x4*)(scb + 2048 + ch + 4);
#pragma unroll
            for (int e = 0; e < 4; ++e) { b1[e] = a0[e]; b1[4 + e] = a1[e]; b2[e] = d0[e]; b2[4 + e] = d1[e]; } }
        const bf16* pb = P + (size_t)(rowbase + b * Ls) * 3072 + ch;
#pragma unroll 2
        for (int i8 = 0; i8 < 8; ++i8) {
            const int tloc = i8 * 8 + tl, t = t0 + tloc, tm = t > 0 ? t - 1 : t, tp = t + 1 < Ls ? t + 1 : t; const float mm = t > 0 ? 1.f : 0.f, mp = t + 1 < Ls ? 1.f : 0.f;
            const u32x4 r1m = *(const u32x4*)(pb + (size_t)tm * 3072 + 1024), r1c = *(const u32x4*)(pb + (size_t)t * 3072 + 1024), r1p = *(const u32x4*)(pb + (size_t)tp * 3072 + 1024);
            const u32x4 r2m = *(const u32x4*)(pb + (size_t)tm * 3072 + 2048), r2c = *(const u32x4*)(pb + (size_t)t * 3072 + 2048), r2p = *(const u32x4*)(pb + (size_t)tp * 3072 + 2048);
            float xm[8], xc[8], xp[8], vm[8], vc[8], vp[8];
            unpack8(r1m, xm); unpack8(r1c, xc); unpack8(r1p, xp); unpack8(r2m, vm); unpack8(r2c, vc); unpack8(r2p, vp);
            float zz[8];
#pragma unroll
            for (int e = 0; e < 8; ++e) { const float a = w1[0][e] * (xm[e] * mm) + w1[1][e] * xc[e] + w1[2][e] * (xp[e] * mp) + b1[e], d = w2[0][e] * (vm[e] * mm) + w2[1][e] * vc[e] + w2[2][e] * (vp[e] * mp) + b2[e]; zz[e] = a * d; }
#pragma unroll
            for (int e = 0; e < 8; e += 2) { const unsigned p = pk2(zz[e], zz[e + 1]);
                *(LAS bf16*)(tile + (c8 * 8 + e) * 136 + tloc * 2) = (bf16)(p & 0xffffu); *(LAS bf16*)(tile + (c8 * 8 + e + 1) * 136 + tloc * 2) = (bf16)(p >> 16); }
        }
#pragma unroll
        for (int q = 0; q < 8; ++q) { const int cc = q * 8 + (F.lane >> 3), chk = F.lane & 7;
            const u32x2 lo = *(const LAS u32x2*)(tile + cc * 136 + chk * 16), hi = *(const LAS u32x2*)(tile + cc * 136 + chk * 16 + 8);
            u32x4 o; o.x = lo.x; o.y = lo.y; o.z = hi.x; o.w = hi.y;
            *(u32x4*)(ZT + ((size_t)b * 1024 + ct * 64 + cc) * Ls + t0 + chk * 8) = o; }
    }
}

__device__ __forceinline__ f32x2 cmul(f32x2 a, f32x2 b) { return (f32x2){a.x * b.x - a.y * b.y, a.x * b.y + a.y * b.x}; }
__device__ __forceinline__ f32x2 cmulc(f32x2 a, f32x2 b) { return (f32x2){a.x * b.x + a.y * b.y, a.y * b.x - a.x * b.y}; }
__device__ __forceinline__ f32x2 twid(float f) { return (f32x2){__builtin_amdgcn_cosf(f), __builtin_amdgcn_sinf(f)}; }
#define PH(e) ((e) + ((e) >> 4))
__device__ __forceinline__ void fft_fwd(LAS f32x2* buf, int tid, int plo, int phi) {
#pragma unroll 1
    for (int p = plo; p < phi; ++p) {
        const int lq = 12 - 2 * p, q = 1 << lq; const float invN = 1.0f / (float)(4 * q);
#pragma unroll 2
        for (int m = 0; m < 8; ++m) {
            const int g = tid + 512 * m, i = g & (q - 1), i0 = ((g >> lq) << (lq + 2)) + i;
            const int e0 = PH(i0), e1 = PH(i0 + q), e2 = PH(i0 + 2 * q), e3 = PH(i0 + 3 * q);
            const f32x2 a0 = buf[e0], a1 = buf[e1], a2 = buf[e2], a3 = buf[e3];
            const f32x2 t0 = a0 + a2, t1 = a0 - a2, t2 = a1 + a3, d = a1 - a3, t3 = (f32x2){d.y, -d.x};
            const f32x2 w1 = twid(-(float)i * invN), w2 = cmul(w1, w1), w3 = cmul(w2, w1);
            buf[e0] = t0 + t2; buf[e1] = cmul(t1 + t3, w1); buf[e2] = cmul(t0 - t2, w2); buf[e3] = cmul(t1 - t3, w3);
        }
        __syncthreads();
    }
}
__device__ __forceinline__ void fft_inv(LAS f32x2* buf, int tid, int plo, int phi) {
#pragma unroll 1
    for (int p = phi - 1; p >= plo; --p) {
        const int lq = 12 - 2 * p, q = 1 << lq; const float invN = 1.0f / (float)(4 * q);
#pragma unroll 2
        for (int m = 0; m < 8; ++m) {
            const int g = tid + 512 * m, i = g & (q - 1), i0 = ((g >> lq) << (lq + 2)) + i;
            const int e0 = PH(i0), e1 = PH(i0 + q), e2 = PH(i0 + 2 * q), e3 = PH(i0 + 3 * q);
            const f32x2 w1 = twid((float)i * invN), w2 = cmul(w1, w1), w3 = cmul(w2, w1);
            const f32x2 b0 = buf[e0], b1 = cmul(buf[e1], w1), b2 = cmul(buf[e2], w2), b3 = cmul(buf[e3], w3);
            const f32x2 t0 = b0 + b2, t1 = b0 - b2, t2 = b1 + b3, d = b1 - b3, t3 = (f32x2){-d.y, d.x};
            buf[e0] = t0 + t2; buf[e1] = t1 + t3; buf[e2] = t0 - t2; buf[e3] = t1 - t3;
        }
        __syncthreads();
    }
}
__device__ __forceinline__ void fwd16_A(f32x2 (&x)[16]) {
    const float C1 = 0.92387953251128674f, S1 = 0.38268343236508977f, R2 = 0.70710678118654752f;
#pragma unroll
    for (int i = 0; i < 4; ++i) {
        const f32x2 a0 = x[i], a1 = x[i + 4], a2 = x[i + 8], a3 = x[i + 12];
        const f32x2 t0 = a0 + a2, t1 = a0 - a2, t2 = a1 + a3, d = a1 - a3, t3 = (f32x2){d.y, -d.x};
        const f32x2 y1 = t1 + t3, y2 = t0 - t2, y3 = t1 - t3;
        x[i] = t0 + t2;
        if (i == 0) { x[4] = y1; x[8] = y2; x[12] = y3; }
        else if (i == 1) { x[5] = cmul(y1, (f32x2){C1, -S1}); x[9] = cmul(y2, (f32x2){R2, -R2}); x[13] = cmul(y3, (f32x2){S1, -C1}); }
        else if (i == 2) { x[6] = cmul(y1, (f32x2){R2, -R2}); x[10] = (f32x2){y2.y, -y2.x}; x[14] = cmul(y3, (f32x2){-R2, -R2}); }
        else { x[7] = cmul(y1, (f32x2){S1, -C1}); x[11] = cmul(y2, (f32x2){-R2, -R2}); x[15] = cmul(y3, (f32x2){-C1, S1}); }
    }
}
__device__ __forceinline__ void fwd16_B(f32x2 (&x)[16]) {
#pragma unroll
    for (int g = 0; g < 4; ++g) {
        const f32x2 a0 = x[4 * g], a1 = x[4 * g + 1], a2 = x[4 * g + 2], a3 = x[4 * g + 3];
        const f32x2 t0 = a0 + a2, t1 = a0 - a2, t2 = a1 + a3, d = a1 - a3, t3 = (f32x2){d.y, -d.x};
        x[4 * g] = t0 + t2; x[4 * g + 1] = t1 + t3; x[4 * g + 2] = t0 - t2; x[4 * g + 3] = t1 - t3;
    }
}
__device__ __forceinline__ void inv16_B(f32x2 (&x)[16]) {
#pragma unroll
    for (int g = 0; g < 4; ++g) {
        const f32x2 b0 = x[4 * g], b1 = x[4 * g + 1], b2 = x[4 * g + 2], b3 = x[4 * g + 3];
        const f32x2 t0 = b0 + b2, t1 = b0 - b2, t2 = b1 + b3, d = b1 - b3, t3 = (f32x2){-d.y, d.x};
        x[4 * g] = t0 + t2; x[4 * g + 1] = t1 + t3; x[4 * g + 2] = t0 - t2; x[4 * g + 3] = t1 - t3;
    }
}
__device__ __forceinline__ void inv16_A(f32x2 (&x)[16]) {
    const float C1 = 0.92387953251128674f, S1 = 0.38268343236508977f, R2 = 0.70710678118654752f;
#pragma unroll
    for (int i = 0; i < 4; ++i) {
        f32x2 b0 = x[i], b1 = x[i + 4], b2 = x[i + 8], b3 = x[i + 12];
        if (i == 1) { b1 = cmul(b1, (f32x2){C1, S1}); b2 = cmul(b2, (f32x2){R2, R2}); b3 = cmul(b3, (f32x2){S1, C1}); }
        else if (i == 2) { b1 = cmul(b1, (f32x2){R2, R2}); b2 = (f32x2){-b2.y, b2.x}; b3 = cmul(b3, (f32x2){-R2, R2}); }
        else if (i == 3) { b1 = cmul(b1, (f32x2){S1, C1}); b2 = cmul(b2, (f32x2){-R2, R2}); b3 = cmul(b3, (f32x2){-C1, -S1}); }
        const f32x2 t0 = b0 + b2, t1 = b0 - b2, t2 = b1 + b3, d = b1 - b3, t3 = (f32x2){-d.y, d.x};
        x[i] = t0 + t2; x[i + 4] = t1 + t3; x[i + 8] = t0 - t2; x[i + 12] = t1 - t3;
    }
}
__device__ __forceinline__ void fwd16(f32x2 (&x)[16]) { fwd16_A(x); fwd16_B(x); }
__device__ __forceinline__ void inv16(f32x2 (&x)[16]) { inv16_B(x); inv16_A(x); }
__device__ __forceinline__ void r16_fwd2(LAS f32x2* buf, int tid) {
#pragma unroll 1
  for (int lqp = 8; lqp >= 4; lqp -= 4) {
    const int qp = 1 << lqp; const float inv = 1.0f / (float)(16 * qp);
#pragma unroll
    for (int m = 0; m < 2; ++m) {
        const int g = tid + 512 * m, i = g & (qp - 1), e0 = ((g >> lqp) << (lqp + 4)) + i; f32x2 x[16];
#pragma unroll
        for (int j = 0; j < 16; ++j) x[j] = buf[PH(e0 + (j << lqp))];
        const f32x2 w1 = twid(-(float)i * inv), w2 = cmul(w1, w1), w3 = cmul(w2, w1), v1 = cmul(w2, w2), v2 = cmul(v1, v1), v3 = cmul(v2, v1);
        fwd16_A(x);
#pragma unroll
        for (int l = 0; l < 4; ++l) { x[l + 4] = cmul(x[l + 4], w1); x[l + 8] = cmul(x[l + 8], w2); x[l + 12] = cmul(x[l + 12], w3); }
        fwd16_B(x);
#pragma unroll
        for (int k = 0; k < 4; ++k) { x[4 * k + 1] = cmul(x[4 * k + 1], v1); x[4 * k + 2] = cmul(x[4 * k + 2], v2); x[4 * k + 3] = cmul(x[4 * k + 3], v3); }
#pragma unroll
        for (int j = 0; j < 16; ++j) buf[PH(e0 + (j << lqp))] = x[j];
    }
    __syncthreads();
  }
}
__device__ __forceinline__ void r16_inv2(LAS f32x2* buf, int tid) {
#pragma unroll 1
  for (int lqp = 4; lqp <= 8; lqp += 4) {
    const int qp = 1 << lqp; const float inv = 1.0f / (float)(16 * qp);
#pragma unroll
    for (int m = 0; m < 2; ++m) {
        const int g = tid + 512 * m, i = g & (qp - 1), e0 = ((g >> lqp) << (lqp + 4)) + i; f32x2 x[16];
#pragma unroll
        for (int j = 0; j < 16; ++j) x[j] = buf[PH(e0 + (j << lqp))];
        const f32x2 w1 = twid((float)i * inv), w2 = cmul(w1, w1), w3 = cmul(w2, w1), v1 = cmul(w2, w2), v2 = cmul(v1, v1), v3 = cmul(v2, v1);
#pragma unroll
        for (int k = 0; k < 4; ++k) { x[4 * k + 1] = cmul(x[4 * k + 1], v1); x[4 * k + 2] = cmul(x[4 * k + 2], v2); x[4 * k + 3] = cmul(x[4 * k + 3], v3); }
        inv16_B(x);
#pragma unroll
        for (int l = 0; l < 4; ++l) { x[l + 4] = cmul(x[l + 4], w1); x[l + 8] = cmul(x[l + 8], w2); x[l + 12] = cmul(x[l + 12], w3); }
        inv16_A(x);
#pragma unroll
        for (int j = 0; j < 16; ++j) buf[PH(e0 + (j << lqp))] = x[j];
    }
    __syncthreads();
  }
}
__device__ __forceinline__ float block_sum(Fr& F, float v, LAS float* red) {
    v = wave_sum(v);
    __syncthreads();
    if (F.lane == 0) red[F.wave] = v;
    __syncthreads();
    float s = 0.f;
#pragma unroll
    for (int w = 0; w < 8; ++w) s += red[w];
    return s;
}
__device__ __forceinline__ void ph_fftconv(Fr& F) {
    LAS f32x2* buf = (LAS f32x2*)F.lds; LAS float* red = (LAS float*)(F.lds + 139392);
    const float* KT = (const float*)(F.ws + HY_KT); const float* KTC = (const float*)(F.ws + WS_KTC);
    bf16* ZT = (bf16*)(F.ws + HY_ZT); bf16* ZTC = (bf16*)(F.ws + HY_ZTC);
    const int tid = F.tid;
    for (int c = F.bid; c < 1024; c += F.G) {
        const float bias = IN(I_HBIAS)[c];
        __syncthreads();
        float asum = 0.f;
        const f32x4* kf = (const f32x4*)(KT + (size_t)c * 2 * SEQ); const f32x4* kb = kf + SEQ / 4;
#pragma unroll
        for (int q = 0; q < 4; ++q) { const int i4 = tid + 512 * q; const f32x4 v = kf[i4];
            asum += fabsf(v[0]) + fabsf(v[1]) + fabsf(v[2]) + fabsf(v[3]);
            buf[PH(4 * i4)] = (f32x2){v[0], 0.f}; buf[PH(4 * i4 + 1)] = (f32x2){v[1], 0.f}; buf[PH(4 * i4 + 2)] = (f32x2){v[2], 0.f}; buf[PH(4 * i4 + 3)] = (f32x2){v[3], 0.f};
            const f32x4 u = kb[i4]; const int m = 4 * i4;
            if (m > 0) { buf[PH(16384 - m)] = (f32x2){u[0], 0.f}; asum += fabsf(u[0]); } else buf[PH(8192)] = (f32x2){0.f, 0.f};
            buf[PH(16384 - m - 1)] = (f32x2){u[1], 0.f}; buf[PH(16384 - m - 2)] = (f32x2){u[2], 0.f}; buf[PH(16384 - m - 3)] = (f32x2){u[3], 0.f};
            asum += fabsf(u[1]) + fabsf(u[2]) + fabsf(u[3]); }
        const float S = block_sum(F, asum, red);
        __syncthreads();
        fft_fwd(buf, tid, 0, 1); r16_fwd2(buf, tid);
        f32x4* Ks = (f32x4*)(F.ws + HY_KS) + (size_t)(F.bid & 255) * 8192 + tid * 8; const float ksc = 1.0f / (S * 16384.0f);
#pragma unroll 1
        for (int m = 0; m < 2; ++m) { const int pb = 17 * (tid + 512 * m); f32x2 x[16];
#pragma unroll
            for (int n = 0; n < 16; ++n) x[n] = buf[pb + n];
            fwd16(x);
#pragma unroll
            for (int n = 0; n < 8; ++n) Ks[m * 4096 + n] = (f32x4){x[2 * n].x * ksc, x[2 * n].y * ksc, x[2 * n + 1].x * ksc, x[2 * n + 1].y * ksc}; }
        const f32x2 dl = twid(-1.0f / 16384.0f);
#pragma unroll 1
        for (int pr = 0; pr < 2; ++pr) {
            bf16* z0 = ZT + ((size_t)(2 * pr) * 1024 + c) * SEQ; bf16* z1 = ZT + ((size_t)(2 * pr + 1) * 1024 + c) * SEQ;
            const int i8 = tid * 8;
            __syncthreads();
            {
                float a[8], b[8], cx[8], dx[8];
                unpack8(*(const u32x4*)(z0 + i8), a); unpack8(*(const u32x4*)(z1 + i8), b); unpack8(*(const u32x4*)(z0 + 4096 + i8), cx); unpack8(*(const u32x4*)(z1 + 4096 + i8), dx);
                f32x2 w1 = twid(-(float)i8 * (1.0f / 16384.0f));
#pragma unroll
                for (int e = 0; e < 8; ++e) { const f32x2 a0 = (f32x2){a[e], b[e]}, a1 = (f32x2){cx[e], dx[e]}, t3 = (f32x2){a1.y, -a1.x}; const f32x2 w2 = cmul(w1, w1), w3 = cmul(w2, w1);
                    buf[PH(i8 + e)] = a0 + a1; buf[PH(4096 + i8 + e)] = cmul(a0 + t3, w1); buf[PH(8192 + i8 + e)] = cmul(a0 - a1, w2); buf[PH(12288 + i8 + e)] = cmul(a0 - t3, w3);
                    w1 = cmul(w1, dl); }
            }
            __syncthreads();
            r16_fwd2(buf, tid);
#pragma unroll 1
            for (int m = 0; m < 2; ++m) { const int pb = 17 * (tid + 512 * m); f32x2 x[16];
#pragma unroll
                for (int n = 0; n < 16; ++n) x[n] = buf[pb + n];
                fwd16(x);
#pragma unroll
                for (int n = 0; n < 8; ++n) { const f32x4 k = Ks[m * 4096 + n]; x[2 * n] = cmul(x[2 * n], (f32x2){k[0], k[1]}); x[2 * n + 1] = cmul(x[2 * n + 1], (f32x2){k[2], k[3]}); }
                inv16(x);
#pragma unroll
                for (int n = 0; n < 16; ++n) buf[pb + n] = x[n]; }
            __syncthreads();
            r16_inv2(buf, tid);
            {
                float a[8], b[8], cx[8], dx[8];
                unpack8(*(const u32x4*)(z0 + i8), a); unpack8(*(const u32x4*)(z1 + i8), b); unpack8(*(const u32x4*)(z0 + 4096 + i8), cx); unpack8(*(const u32x4*)(z1 + 4096 + i8), dx);
                f32x2 w1 = twid(-(float)i8 * (1.0f / 16384.0f));
#pragma unroll
                for (int e = 0; e < 8; ++e) { const f32x2 w2 = cmul(w1, w1), w3 = cmul(w2, w1);
                    const f32x2 b0 = buf[PH(i8 + e)], b1 = cmulc(buf[PH(4096 + i8 + e)], w1), b2 = cmulc(buf[PH(8192 + i8 + e)], w2), b3 = cmulc(buf[PH(12288 + i8 + e)], w3);
                    const f32x2 t0 = b0 + b2, t1 = b0 - b2, t2 = b1 + b3, d = b1 - b3, t3 = (f32x2){-d.y, d.x};
                    const f32x2 y0 = t0 + t2, y1 = t1 + t3;
                    a[e] = y0.x + a[e] * bias; b[e] = y0.y + b[e] * bias; cx[e] = y1.x + cx[e] * bias; dx[e] = y1.y + dx[e] * bias;
                    w1 = cmul(w1, dl); }
                *(u32x4*)(z0 + i8) = pack8(a); *(u32x4*)(z1 + i8) = pack8(b); *(u32x4*)(z0 + 4096 + i8) = pack8(cx); *(u32x4*)(z1 + 4096 + i8) = pack8(dx);
            }
        }
        __syncthreads();
        {
            LAS float* kc = (LAS float*)F.lds; LAS float* zc = kc + 512;
            const float* kfc = KTC + (size_t)c * 2 * CTXL; float v = 0.f;
            { const int n = tid; if (n < 256) v = kfc[n]; else if (n == 256) v = 0.f; else v = kfc[CTXL + (512 - n)]; kc[n] = v; }
            const float Sc = block_sum(F, fabsf(v), red);
            for (int i = tid; i < 1024; i += NTHR) { const int b = i >> 8, t = i & 255; zc[i] = bf2f(ZTC[((size_t)b * 1024 + c) * CTXL + t]); }
            __syncthreads();
            const int b = tid >> 7, t2 = tid & 127; const float isc = 1.0f / Sc;
#pragma unroll
            for (int hh = 0; hh < 2; ++hh) { const int t = t2 + 128 * hh; float acc = 0.f;
#pragma unroll 8
                for (int s = 0; s < 256; ++s) acc += zc[b * 256 + s] * kc[(t - s) & 511];
                ZTC[((size_t)b * 1024 + c) * CTXL + t] = (bf16)f2bf(acc * isc + zc[b * 256 + t] * bias); }
        }
    }
}

__device__ __forceinline__ void u2_items(Fr& F, const bf16* P, int rowbase, int nb, int Ls, const bf16* YT, bf16* U2) {
    LAS unsigned char* tile = F.lds + F.wave * 16384;
    const float* scw = IN(I_HSCW); const float* scb = IN(I_HSCB);
    const int ntt = Ls / 64, nitems = nb * ntt * 16, tl = F.lane >> 3, c8 = F.lane & 7;
    for (int it = F.gw; it < nitems; it += F.ngw) {
        const int ct = it & 15, tt = (it >> 4) % ntt, b = (it >> 4) / ntt, t0 = tt * 64, ch = ct * 64 + c8 * 8;
#pragma unroll
        for (int q = 0; q < 8; ++q) { const int cc = q * 8 + (F.lane >> 3), chk = F.lane & 7;
            const u32x4 v = *(const u32x4*)(YT + ((size_t)b * 1024 + ct * 64 + cc) * Ls + t0 + chk * 8);
            *(LAS u32x2*)(tile + cc * 136 + chk * 16) = (u32x2){v.x, v.y}; *(LAS u32x2*)(tile + cc * 136 + chk * 16 + 8) = (u32x2){v.z, v.w}; }
        float w0[3][8], bb[8];
#pragma unroll
        for (int k = 0; k < 3; ++k) { const f32x4 a0 = *(const f32x4*)(scw + k * 3072 + ch), a1 = *(const f32x4*)(scw + k * 3072 + ch + 4);
#pragma unroll
            for (int e = 0; e < 4; ++e) { w0[k][e] = a0[e]; w0[k][4 + e] = a1[e]; } }
        { const f32x4 a0 = *(const f32x4*)(scb + ch), a1 = *(const f32x4*)(scb + ch + 4);
#pragma unroll
            for (int e = 0; e < 4; ++e) { bb[e] = a0[e]; bb[4 + e] = a1[e]; } }
        const bf16* pb = P + (size_t)(rowbase + b * Ls) * 3072 + ch; bf16* ub = U2 + (size_t)(rowbase + b * Ls) * 1024 + ch;
#pragma unroll 2
        for (int i8 = 0; i8 < 8; ++i8) {
            const int tloc = i8 * 8 + tl, t = t0 + tloc, tm = t > 0 ? t - 1 : t, tp = t + 1 < Ls ? t + 1 : t; const float mm = t > 0 ? 1.f : 0.f, mp = t + 1 < Ls ? 1.f : 0.f;
            const u32x4 rm = *(const u32x4*)(pb + (size_t)tm * 3072), rc = *(const u32x4*)(pb + (size_t)t * 3072), rp = *(const u32x4*)(pb + (size_t)tp * 3072);
            float xm[8], xc[8], xp[8], o[8];
            unpack8(rm, xm); unpack8(rc, xc); unpack8(rp, xp);
#pragma unroll
            for (int e = 0; e < 8; ++e) { const float x0 = w0[0][e] * (xm[e] * mm) + w0[1][e] * xc[e] + w0[2][e] * (xp[e] * mp) + bb[e]; o[e] = x0 * bf2f(*(const LAS bf16*)(tile + (c8 * 8 + e) * 136 + tloc * 2)); }
            *(u32x4*)(ub + (size_t)t * 1024) = pack8(o);
        }
    }
}

__device__ __forceinline__ void dw_item(const bf16* __restrict__ G, bf16* __restrict__ A, const float* __restrict__ cw, const float* __restrict__ cb, int f8, int rowtok0, int nx, int x0, bool up_ok, bool down_ok) {
    float w[9][8], bias[8];
#pragma unroll
    for (int k = 0; k < 9; ++k) { const float m = (k < 3) ? (up_ok ? 1.f : 0.f) : ((k >= 6) ? (down_ok ? 1.f : 0.f) : 1.f);
        const f32x4 w0 = *(const f32x4*)(cw + (size_t)k * FF + f8) * m, w1 = *(const f32x4*)(cw + (size_t)k * FF + f8 + 4) * m;
        w[k][0] = w0[0]; w[k][1] = w0[1]; w[k][2] = w0[2]; w[k][3] = w0[3]; w[k][4] = w1[0]; w[k][5] = w1[1]; w[k][6] = w1[2]; w[k][7] = w1[3]; }
    { const f32x4 b0 = *(const f32x4*)(cb + f8), b1 = *(const f32x4*)(cb + f8 + 4); bias[0] = b0[0]; bias[1] = b0[1]; bias[2] = b0[2]; bias[3] = b0[3]; bias[4] = b1[0]; bias[5] = b1[1]; bias[6] = b1[2]; bias[7] = b1[3]; }
    const int upo = up_ok ? -nx : 0, dno = down_ok ? nx : 0;
    const bf16* __restrict__ g0 = G + (size_t)rowtok0 * FF + f8; bf16* __restrict__ a0 = A + (size_t)rowtok0 * FF + f8;
    const u32x4 zero4 = (u32x4){0u, 0u, 0u, 0u};
    u32x4 cm[3], cc[3];
    { const int xm = x0 > 0 ? x0 - 1 : 0; const bool okm = x0 > 0;
        cm[0] = *(const u32x4*)(g0 + (size_t)(xm + upo) * FF); cm[1] = *(const u32x4*)(g0 + (size_t)xm * FF); cm[2] = *(const u32x4*)(g0 + (size_t)(xm + dno) * FF);
        if (!okm) { cm[0] = zero4; cm[1] = zero4; cm[2] = zero4; }
        cc[0] = *(const u32x4*)(g0 + (size_t)(x0 + upo) * FF); cc[1] = *(const u32x4*)(g0 + (size_t)x0 * FF); cc[2] = *(const u32x4*)(g0 + (size_t)(x0 + dno) * FF); }
    u32x4 pa[2][3], pav[2], pb[2][3], pbv[2];
#define DW_LOAD_GROUP(buf, bufv, jg) do { _Pragma("unroll") for (int u = 0; u < 2; ++u) { const int x_ = x0 + (jg) + u, xp_ = x_ + 1 < nx ? x_ + 1 : nx - 1; \
        buf[u][0] = *(const u32x4*)(g0 + (size_t)(xp_ + upo) * FF); buf[u][1] = *(const u32x4*)(g0 + (size_t)xp_ * FF); buf[u][2] = *(const u32x4*)(g0 + (size_t)(xp_ + dno) * FF); \
        bufv[u] = *(const u32x4*)(a0 + (size_t)x_ * FF); } } while (0)
#define DW_COMPUTE_GROUP(buf, bufv, jg) do { _Pragma("unroll") for (int u = 0; u < 2; ++u) { \
        const int x = x0 + (jg) + u; const bool okp = x + 1 < nx; \
        if (!okp) { buf[u][0] = zero4; buf[u][1] = zero4; buf[u][2] = zero4; } \
        float acc[8]; \
        _Pragma("unroll") for (int e = 0; e < 8; ++e) acc[e] = bias[e]; \
        _Pragma("unroll") for (int dy = 0; dy < 3; ++dy) { float v[8]; \
            unpack8(cm[dy], v); _Pragma("unroll") for (int e = 0; e < 8; ++e) acc[e] += v[e] * w[dy * 3 + 0][e]; \
            unpack8(cc[dy], v); _Pragma("unroll") for (int e = 0; e < 8; ++e) acc[e] += v[e] * w[dy * 3 + 1][e]; \
            unpack8(buf[u][dy], v); _Pragma("unroll") for (int e = 0; e < 8; ++e) acc[e] += v[e] * w[dy * 3 + 2][e]; } \
        float a[8]; unpack8(bufv[u], a); \
        _Pragma("unroll") for (int e = 0; e < 8; ++e) a[e] = silu_f(acc[e]) * a[e]; \
        *(u32x4*)(a0 + (size_t)x * FF) = pack8(a); \
        _Pragma("unroll") for (int dy = 0; dy < 3; ++dy) { cm[dy] = cc[dy]; cc[dy] = buf[u][dy]; } } } while (0)
    DW_LOAD_GROUP(pa, pav, 0);
#pragma unroll 1
    for (int jg = 0; jg < 32; jg += 4) {
        DW_LOAD_GROUP(pb, pbv, jg + 2);
        DW_COMPUTE_GROUP(pa, pav, jg);
        { const int jn = jg + 4 < 32 ? jg + 4 : jg; DW_LOAD_GROUP(pa, pav, jn); }
        DW_COMPUTE_GROUP(pb, pbv, jg + 2);
    }
#undef DW_COMPUTE_GROUP
#undef DW_LOAD_GROUP
}
__device__ __forceinline__ void ph_dwconv(Fr& F, int layer, int nlat, int nctx) {
    bf16* A = (bf16*)(F.ws + FF_A); const bf16* G = (const bf16*)(F.ws + FF_G);
    const float* cw = IN(I_FCW) + (size_t)layer * 9 * FF; const float* cb = IN(I_FCB) + (size_t)layer * FF;
    const int ngrp = (F.G % 8 == 0) ? 8 : 1, xg = F.bid % ngrp, lb = F.bid / ngrp, nlb = F.G / ngrp;
    const int nseg = nlat / 32, band = nseg / ngrp;
    for (int i = lb * NTHR + F.tid; i < band * 352; i += nlb * NTHR) {
        const int sl = i / 352, f8 = (i - sl * 352) * 8, seg = xg * band + sl, grow = seg >> 1, gy = grow & 127;
        dw_item(G, A, cw, cb, f8, grow * 64, 64, (seg & 1) * 32, gy > 0, gy < 127);
    }
    const int nsegc = nctx / 32;
    for (int i = F.bid * NTHR + F.tid; i < nsegc * 352; i += F.G * NTHR) {
        const int sl = i / 352, f8 = (i - sl * 352) * 8;
        dw_item(G, A, cw, cb, f8, nlat + (sl >> 3) * CTXL, CTXL, (sl & 7) * 32, false, false);
    }
}

__device__ __forceinline__ void prep_items(Fr& F, const bf16* XM, int nb, int Ls, bf16* XC, bf16* KN, bf16* KT, bf16* VT) {
    LAS unsigned char* tk = F.lds + F.wave * 17408; LAS unsigned char* tv = tk + 8704;
    const int ntt = Ls / 64, nitems = nb * ntt * 32;
    const int tl = F.lane >> 3, c8 = F.lane & 7;
    for (int it = F.gw; it < nitems; it += F.ngw) {
        const int cg = it & 31, tt = (it >> 5) % ntt, b = (it >> 5) / ntt, t0 = tt * 64, ch0 = cg * 64 + c8 * 8, h = cg >> 3;
        float cw0[8], cw1[8], cw2[8], cbb[8], wkq[32], wv[32];
        { const float* p = IN(I_MCW) + ch0; const float* pb = IN(I_MCB) + ch0;
#pragma unroll
            for (int e = 0; e < 8; ++e) { cw0[e] = p[e]; cw1[e] = p[MI + e]; cw2[e] = p[2 * MI + e]; cbb[e] = pb[e]; }
            const float* q = (const float*)(F.ws + WS_WKQ) + (ch0 >> 2) * 16; const float* v = IN(I_MWV) + (ch0 >> 2) * 16;
#pragma unroll
            for (int e = 0; e < 32; ++e) { wkq[e] = q[e]; wv[e] = v[e]; } }
#pragma unroll 2
        for (int i8 = 0; i8 < 8; ++i8) {
            const int tloc = i8 * 8 + tl, t = t0 + tloc; const size_t row = (size_t)b * Ls + t;
            float xp[8], xm[8], xn[8];
            const size_t rowp = row - (t > 0 ? 1 : 0), rown = row + (t + 1 < Ls ? 1 : 0); const size_t ctile = (size_t)(ch0 >> 5) * 512 + ((ch0 & 31) >> 3) * 128;
            const u32x4 rm = *(const u32x4*)(XM + (row >> 4) * 32768 + ctile + (row & 15) * 8), rp = *(const u32x4*)(XM + (rowp >> 4) * 32768 + ctile + (rowp & 15) * 8), rn = *(const u32x4*)(XM + (rown >> 4) * 32768 + ctile + (rown & 15) * 8);
            unpack8(rm, xm); unpack8(rp, xp); unpack8(rn, xn);
            { const float mp = t > 0 ? 1.f : 0.f, mn = t + 1 < Ls ? 1.f : 0.f;
#pragma unroll
                for (int e = 0; e < 8; ++e) { xp[e] *= mp; xn[e] *= mn; } }
            float xc[8], kp[8], vv[8];
#pragma unroll
            for (int e = 0; e < 8; ++e) xc[e] = silu_f(cw0[e] * xp[e] + cw1[e] * xm[e] + cw2[e] * xn[e] + cbb[e]);
#pragma unroll
            for (int n = 0; n < 2; ++n)
#pragma unroll
                for (int o = 0; o < 4; ++o) { float sk = 0.f, sv = 0.f;
#pragma unroll
                    for (int c = 0; c < 4; ++c) { sk += xc[n * 4 + c] * wkq[n * 16 + c * 4 + o]; sv += xm[n * 4 + c] * wv[n * 16 + c * 4 + o]; }
                    kp[n * 4 + o] = sk; vv[n * 4 + o] = sv; }
            { const size_t to = ((size_t)(row >> 4) * 64 + (ch0 >> 5)) * 512 + (((unsigned)row & 15u) + 16u * ((ch0 & 31) >> 3)) * 8u;
              *(u32x4*)(XC + to) = pack8(xc); }
#pragma unroll
            for (int e = 0; e < 8; e += 2) { const unsigned pk = pk2(kp[e], kp[e + 1]), pv = pk2(vv[e], vv[e + 1]);
                *(LAS bf16*)(tk + (c8 * 8 + e) * 136 + tloc * 2) = (bf16)(pk & 0xffffu); *(LAS bf16*)(tk + (c8 * 8 + e + 1) * 136 + tloc * 2) = (bf16)(pk >> 16);
                *(LAS bf16*)(tv + (c8 * 8 + e) * 136 + tloc * 2) = (bf16)(pv & 0xffffu); *(LAS bf16*)(tv + (c8 * 8 + e + 1) * 136 + tloc * 2) = (bf16)(pv >> 16); }
        }
#pragma unroll
        for (int q = 0; q < 8; ++q) { const int dt = q >> 1, kq = q & 1, r = F.lane & 15, q4 = F.lane >> 4;
            const size_t tile = ((size_t)(t0 >> 7) * 32 + (cg & 7) * 4 + dt) * 4 + ((t0 & 127) >> 5) + kq;
            const size_t o = (size_t)(b * 4 + h) * 512 * Ls + tile * 512 + F.lane * 8;
            { const u32x2 lo = *(const LAS u32x2*)(tk + (dt * 16 + r) * 136 + kq * 64 + q4 * 16), hi = *(const LAS u32x2*)(tk + (dt * 16 + r) * 136 + kq * 64 + q4 * 16 + 8); *(u32x4*)(KT + o) = (u32x4){lo.x, lo.y, hi.x, hi.y}; }
            { const u32x2 lo = *(const LAS u32x2*)(tv + (dt * 16 + r) * 136 + kq * 64 + q4 * 16), hi = *(const LAS u32x2*)(tv + (dt * 16 + r) * 136 + kq * 64 + q4 * 16 + 8); *(u32x4*)(VT + o) = (u32x4){lo.x, lo.y, hi.x, hi.y}; }
        }
    }
}

__device__ __forceinline__ void gate_items(Fr& F, const bf16* XC, const bf16* XM, int R, float* GATES) {
    const bf16* gwt = (const bf16*)(F.ws + WS_GWT);
    const int fr = F.lane & 15, fq = F.lane >> 4, half = F.wave & 1, pr = F.wave >> 1, ntiles = R / 16;
    LAS f32x4* xch = (LAS f32x4*)(F.lds + pr * 1024);
    for (int base = F.bid * 4; base < ntiles; base += F.G * 4) {
        const int tile = base + pr; const bool ok = tile < ntiles; const int tl = ok ? tile : 0;
        f32x4 acc = (f32x4){0.f, 0.f, 0.f, 0.f};
        const bf16* ap = (half ? XM : XC) + (size_t)tl * 32768 + F.lane * 8; const bf16* bp = gwt + (size_t)half * 64 * 512 + F.lane * 8;
#pragma unroll 16
        for (int ks = 0; ks < 64; ++ks) acc = __builtin_amdgcn_mfma_f32_16x16x32_bf16(*(const bf16x8*)(ap + ks * 512), *(const bf16x8*)(bp + ks * 512), acc, 0, 0, 0);
        __syncthreads();
        if (half) xch[F.lane] = acc;
        __syncthreads();
        if (!half && ok) { acc = acc + xch[F.lane];
            const int r0 = tile * 16; const float bg = IN(I_MBG)[fr]; const bool isf = (fr >> 2) & 1;
#pragma unroll
            for (int r = 0; r < 4; ++r) { float x = acc[r] + bg; if (isf) x = fminf(x, 0.f) - log1pf(__expf(-fabsf(x))); GATES[(size_t)(r0 + 4 * fq + r) * 16 + fr] = x; } }
    }
}

__device__ __forceinline__ void cum_items(Fr& F, const float* GATES, int nb, int Ls, int gb0, int ctau0, f32x4* GT, float* GC) {
    const int R = nb * Ls, nch = Ls / 128, nitems = 2 * nb * 4 * nch;
    for (int it = F.gw; it < nitems; it += F.ngw) {
        const int c = it % nch, h = (it / nch) & 3, b = (it / nch / 4) % nb, dir = it / nch / 4 / nb;
        const int row0 = b * Ls + c * 128 + 2 * F.lane;
        const float lf0 = GATES[(size_t)row0 * 16 + dir * 8 + 4 + h], lf1 = GATES[(size_t)(row0 + 1) * 16 + dir * 8 + 4 + h];
        const float ig0 = GATES[(size_t)row0 * 16 + dir * 8 + h], ig1 = GATES[(size_t)(row0 + 1) * 16 + dir * 8 + h];
        float inc = lf0 + lf1;
#pragma unroll
        for (int o = 1; o < 64; o <<= 1) { const float t = __shfl_up(inc, o); if (F.lane >= o) inc += t; }
        const float tot = __shfl(inc, 63), exc = inc - (lf0 + lf1);
        float b0, b1;
        if (dir == 0) { b0 = exc + lf0; b1 = inc; } else { b0 = tot - exc; b1 = tot - exc - lf0; }
        GT[(size_t)(dir * 4 + h) * R + row0] = (f32x4){b0, ig0 - b0, __expf(b0), __expf(tot - b0 + ig0)};
        GT[(size_t)(dir * 4 + h) * R + row0 + 1] = (f32x4){b1, ig1 - b1, __expf(b1), __expf(tot - b1 + ig1)};
        if (F.lane == 0) GC[((size_t)(dir * 4 + gb0 + b) * 4 + h) * 66 + ctau0 + c] = __expf(tot);
    }
}

__device__ __forceinline__ void cum_block(Fr& F, const float* GATES, int grow0, int h, f32x4* GT0, f32x4* GT1, float* GC0, float* GC1, LAS float* tab) {
    if (F.wave < 2) {
        const int dir = F.wave, j0 = 2 * F.lane;
        const float* gp = GATES + (size_t)(grow0 + j0) * 16 + dir * 8 + h;
        const float ig0 = gp[0], lf0 = gp[4], ig1 = gp[16], lf1 = gp[20];
        float inc = lf0 + lf1;
#pragma unroll
        for (int o = 1; o < 64; o <<= 1) { const float t = __shfl_up(inc, o); if (F.lane >= o) inc += t; }
        const float tot = __shfl(inc, 63), exc = inc - (lf0 + lf1);
        float b0, b1;
        if (dir == 0) { b0 = exc + lf0; b1 = inc; } else { b0 = tot - exc; b1 = tot - exc - lf0; }
        const float w0 = __expf(tot - b0 + ig0), w1 = __expf(tot - b1 + ig1);
        f32x4* gt = (dir ? GT1 : GT0) + grow0 + j0;
        gt[0] = (f32x4){b0, ig0 - b0, __expf(b0), w0}; gt[1] = (f32x4){b1, ig1 - b1, __expf(b1), w1};
        LAS float* t = tab + dir * 384;
        t[j0] = b0; t[j0 + 1] = b1; t[128 + j0] = ig0 - b0; t[128 + j0 + 1] = ig1 - b1; t[256 + j0] = w0; t[256 + j0 + 1] = w1;
        if (F.lane == 0) *(dir ? GC1 : GC0) = __expf(tot);
    }
}
__device__ __forceinline__ void dn_block(Fr& F, const bf16* KTchunk, const LAS float* tab, float* DN0, float* DN1) {
    const LAS float* w0 = tab + 256; const LAS float* w1 = tab + 384 + 256;
    const bf16* kr = KTchunk + (size_t)(F.tid >> 4) * 4 * 512 + (F.tid & 15) * 8; float s0 = 0.f, s1 = 0.f;
#pragma unroll 4
    for (int q = 0; q < 16; ++q) { const int ks = q >> 2, q4 = q & 3; float v[8]; unpack8(*(const u32x4*)(kr + ks * 512 + q4 * 128), v);
#pragma unroll
        for (int e = 0; e < 8; ++e) { s0 += v[e] * w0[q * 8 + e]; s1 += v[e] * w1[q * 8 + e]; } }
    DN0[F.tid] = s0; DN1[F.tid] = s1;
}
typedef short v4i16_t __attribute__((ext_vector_type(4)));
__device__ __forceinline__ v4i16_t lds_tr16(const LAS unsigned char* p) { return __builtin_amdgcn_ds_read_tr16_b64_v4i16((LAS v4i16_t*)p); }
__device__ __forceinline__ void ph_sphase(Fr& F, int hb, bool with_ctx) {
    const bf16* XC = (const bf16*)(F.ws + MS_XC); const bf16* KT = (const bf16*)(F.ws + MS_KT);
    f32x4* GT = (f32x4*)(F.ws + WS_GT_L); float* DN = (float*)(F.ws + WS_DN); float* RS = (float*)(F.ws + WS_RS); float* GC = (float*)(F.ws + WS_GC);
    const float* GATES = (const float*)(F.ws + WS_GATES_L);
    bf16* S = (bf16*)(F.ws + MS_S);
    LAS unsigned char* kl = F.lds;
    LAS float* tab = (LAS float*)(F.lds + 131072 + 256);
    const int fr = F.lane & 15, fq = F.lane >> 4, w = F.wave;
    const unsigned q_ = (F.lane & 15) >> 2, p_ = F.lane & 3;
    const unsigned trb = ((unsigned)(fq >> 1) * 4u) * 1024u + (8u * (fq & 1) + q_ + 16u * (p_ >> 1)) * 16u + 8u * (p_ & 1);
    for (int it = F.bid; it < 512; it += F.G) {
        const int c = it & 63, h = (it >> 6) & 3, bl = it >> 8, gb = 2 * hb + bl;
        const int row0 = bl * SEQ + c * 128;
        __syncthreads();
        { const char* kc = (const char*)(KT + (size_t)(bl * 4 + h) * 512 * SEQ + (size_t)c * 65536); u32x4 t[16];
#pragma unroll
            for (int i = 0; i < 16; ++i) t[i] = *(const u32x4*)(kc + i * 8192 + F.tid * 16);
#pragma unroll
            for (int i = 0; i < 16; ++i) *(LAS u32x4*)(kl + i * 8192 + F.tid * 16) = t[i]; }
        cum_block(F, GATES, row0, h, GT + (size_t)(0 * 4 + h) * HROWS, GT + (size_t)(1 * 4 + h) * HROWS,
                  GC + ((size_t)(0 * 4 + gb) * 4 + h) * 66 + 2 + c, GC + ((size_t)(1 * 4 + gb) * 4 + h) * 66 + 2 + c, tab);
        __syncthreads();
        {
            const LAS float* w0 = tab + 256; const LAS float* w1 = tab + 384 + 256;
            const LAS unsigned char* kr = kl + (F.tid >> 4) * 4096 + (F.tid & 15) * 16; float s0 = 0.f, s1 = 0.f;
#pragma unroll 4
            for (int q = 0; q < 16; ++q) { const int ks = q >> 2, q4 = q & 3; float v[8]; unpack8(*(const LAS u32x4*)(kr + ks * 1024 + q4 * 256), v);
#pragma unroll
                for (int e = 0; e < 8; ++e) { s0 += v[e] * w0[q * 8 + e]; s1 += v[e] * w1[q * 8 + e]; } }
            DN[(((size_t)(0 * 4 + gb) * 4 + h) * 66 + 2 + c) * 512 + F.tid] = s0; DN[(((size_t)(1 * 4 + gb) * 4 + h) * 66 + 2 + c) * 512 + F.tid] = s1;
        }
        const int irow = row0 + 16 * w + fr;
        bf16x8 bq[16];
        { const bf16* p = XC + ((size_t)((row0 >> 4) + w) * 64 + h * 16) * 512 + F.lane * 8;
#pragma unroll
            for (int ks = 0; ks < 16; ++ks) bq[ks] = *(const bf16x8*)(p + ks * 512); }
        const float bif = tab[16 * w + fr], bib = tab[384 + 16 * w + fr];
        float rsf = 0.f, rsb = 0.f;
        bf16* sf = S + ((size_t)(0 * 8 + bl * 4 + h) * 64 + c) * 16384; bf16* sb = S + ((size_t)(1 * 8 + bl * 4 + h) * 64 + c) * 16384;
#pragma unroll 1
        for (int jt = 0; jt < 8; ++jt) {
            f32x4 acc = (f32x4){0.f, 0.f, 0.f, 0.f};
            const LAS unsigned char* ap = kl + trb + (jt >> 1) * 1024 + (jt & 1) * 512;
#pragma unroll
            for (int ks = 0; ks < 16; ++ks) { const v4i16_t lo = lds_tr16(ap + ks * 8192), hi = lds_tr16(ap + ks * 8192 + 64);
                const bf16x8 a = (bf16x8){lo[0], lo[1], lo[2], lo[3], hi[0], hi[1], hi[2], hi[3]};
                acc = __builtin_amdgcn_mfma_f32_16x16x32_bf16(a, bq[ks], acc, 0, 0, 0); }
            float vf[4], vb[4];
            const f32x4 af4 = *(const LAS f32x4*)(tab + 128 + jt * 16 + 4 * fq), ab4 = *(const LAS f32x4*)(tab + 384 + 128 + jt * 16 + 4 * fq);
#pragma unroll
            for (int r = 0; r < 4; ++r) { const int j = jt * 16 + 4 * fq + r, i = 16 * w + fr;
                vf[r] = (j <= i) ? acc[r] * __expf(bif + af4[r]) : 0.f; vb[r] = (j >= i) ? acc[r] * __expf(bib + ab4[r]) : 0.f;
                rsf += vf[r]; rsb += vb[r]; }
            const size_t so = (size_t)(w * 4 + (jt >> 1)) * 512 + (fr + 16 * ((jt & 1) * 2 + (fq >> 1))) * 8 + (fq & 1) * 4;
            *(u32x2*)(sf + so) = (u32x2){pk2(vf[0], vf[1]), pk2(vf[2], vf[3])};
            *(u32x2*)(sb + so) = (u32x2){pk2(vb[0], vb[1]), pk2(vb[2], vb[3])};
        }
        rsf += __shfl_xor(rsf, 16); rsf += __shfl_xor(rsf, 32); rsb += __shfl_xor(rsb, 16); rsb += __shfl_xor(rsb, 32);
        if (fq == 0) { RS[(size_t)(0 * 4 + h) * HROWS + irow] = rsf; RS[(size_t)(1 * 4 + h) * HROWS + irow] = rsb; }
    }
    if (with_ctx) {
        const bf16* KTC2 = (const bf16*)(F.ws + MS_KTC); f32x4* GTC = (f32x4*)(F.ws + WS_GT_C); const float* GATESC = (const float*)(F.ws + WS_GATES_C);
        for (int it = F.bid; it < 32; it += F.G) {
            const int cc = it & 1, h = (it >> 1) & 3, gb = it >> 3;
            __syncthreads();
            cum_block(F, GATESC, gb * CTXL + cc * 128, h, GTC + (size_t)(0 * 4 + h) * MC, GTC + (size_t)(1 * 4 + h) * MC,
                      GC + ((size_t)(0 * 4 + gb) * 4 + h) * 66 + cc, GC + ((size_t)(1 * 4 + gb) * 4 + h) * 66 + cc, tab);
            __syncthreads();
            dn_block(F, KTC2 + (size_t)(gb * 4 + h) * 512 * CTXL + (size_t)cc * 65536, tab,
                     DN + (((size_t)(0 * 4 + gb) * 4 + h) * 66 + cc) * 512, DN + (((size_t)(1 * 4 + gb) * 4 + h) * 66 + cc) * 512);
        }
    }
}

__device__ __forceinline__ bf16x8 ldg16(const char* ub, unsigned off) { return *(const bf16x8*)(ub + off); }
__device__ __forceinline__ void ph_scan(Fr& F, int hb) {
    const char* XC = (const char*)(F.ws + MS_XC); const char* KT = (const char*)(F.ws + MS_KT); const char* VT = (const char*)(F.ws + MS_VT);
    const char* KTC2 = (const char*)(F.ws + MS_KTC); const char* VTC2 = (const char*)(F.ws + MS_VTC);
    const char* S = (const char*)(F.ws + MS_S);
    const f32x4* GTL = (const f32x4*)(F.ws + WS_GT_L); const f32x4* GTC = (const f32x4*)(F.ws + WS_GT_C);
    const float* GC = (const float*)(F.ws + WS_GC); const float* DN = (const float*)(F.ws + WS_DN);
    float* NC = (float*)(F.ws + WS_NC);
    LAS unsigned char* cbf = F.lds;
    LAS float* wl = (LAS float*)(F.lds + 2 * 33280);
    LAS unsigned char* vtb = F.lds + 2 * 33280 + 1024;
    const int w = F.wave;
    for (int wi = F.bid; wi < 256; wi += F.G) {
        const int chain = wi & 15, slice = wi >> 4, dir = chain >> 3, bl = (chain >> 2) & 1, h = chain & 3, gb = 2 * hb + bl, e0 = slice * 32;
        char* NUM = (char*)(F.ws + (dir ? MS_NB : MS_NF));
        const bool nwriter = (slice == 0) && (w == 0);
        f32x4 acc[4][2];
#pragma unroll
        for (int a = 0; a < 4; ++a)
#pragma unroll
            for (int b = 0; b < 2; ++b) acc[a][b] = (f32x4){0.f, 0.f, 0.f, 0.f};
        float nreg[8];
#pragma unroll
        for (int e = 0; e < 8; ++e) nreg[e] = 0.f;
        const char* ktc = KTC2 + (size_t)(gb * 4 + h) * 512 * CTXL * 2; const char* vtc = VTC2 + (size_t)(gb * 4 + h) * 512 * CTXL * 2;
        const char* ktl = KT + (size_t)(bl * 4 + h) * 512 * SEQ * 2;    const char* vtl = VT + (size_t)(bl * 4 + h) * 512 * SEQ * 2;
        const f32x4* gtc = GTC + (size_t)(dir * 4 + h) * MC + gb * CTXL; const f32x4* gtl = GTL + (size_t)(dir * 4 + h) * HROWS + bl * SEQ;
        const float* gcb = GC + ((size_t)(dir * 4 + gb) * 4 + h) * 66; const float* dnb = DN + ((size_t)(dir * 4 + gb) * 4 + h) * 66 * 512;
#pragma unroll 1
        for (int s = 0; s < 2; ++s) {
            const int cc = dir == 0 ? s : 1 - s; const unsigned l16 = F.lane * 16u, fq = F.lane >> 4;
            __syncthreads();
            if (F.tid < 128) wl[F.tid] = gtc[cc * 128 + F.tid][3];
            __syncthreads();
            const float Gd = gcb[cc]; const char* ktu = ktc + (size_t)cc * 131072; const char* vtu = vtc + (size_t)cc * 131072 + (e0 >> 4) * 4096;
#pragma unroll
            for (int a = 0; a < 4; ++a)
#pragma unroll
                for (int b = 0; b < 2; ++b) acc[a][b] = acc[a][b] * Gd;
#pragma unroll
            for (int ks = 0; ks < 4; ++ks) {
                bf16x8 bv[2];
#pragma unroll
                for (int et = 0; et < 2; ++et) { float v[8]; unpack8(__builtin_bit_cast(u32x4, ldg16(vtu + et * 4096 + ks * 1024, l16)), v);
#pragma unroll
                    for (int e = 0; e < 8; ++e) v[e] *= wl[ks * 32 + 8 * fq + e];
                    const u32x4 pv = pack8(v); bv[et] = __builtin_bit_cast(bf16x8, pv); }
#pragma unroll
                for (int dt = 0; dt < 4; ++dt) { const bf16x8 kk = ldg16(ktu + (4 * w + dt) * 4096 + ks * 1024, l16);
#pragma unroll
                    for (int et = 0; et < 2; ++et) acc[dt][et] = __builtin_amdgcn_mfma_f32_16x16x32_bf16(kk, bv[et], acc[dt][et], 0, 0, 0); }
            }
            { const unsigned lo = F.lane * 32u; const f32x4 d0 = *(const f32x4*)((const char*)(dnb + cc * 512) + lo), d1 = *(const f32x4*)((const char*)(dnb + cc * 512) + lo + 16u);
                nreg[0] = Gd * nreg[0] + d0[0]; nreg[1] = Gd * nreg[1] + d0[1]; nreg[2] = Gd * nreg[2] + d0[2]; nreg[3] = Gd * nreg[3] + d0[3];
                nreg[4] = Gd * nreg[4] + d1[0]; nreg[5] = Gd * nreg[5] + d1[1]; nreg[6] = Gd * nreg[6] + d1[2]; nreg[7] = Gd * nreg[7] + d1[3]; }
        }
        const int cfirst = dir == 0 ? 0 : 63;
        bf16x8 xf[16];
        __syncthreads();
        { const int fr = F.lane & 15, fq = F.lane >> 4; const unsigned l16 = F.lane * 16u;
#pragma unroll
            for (int dt = 0; dt < 4; ++dt)
#pragma unroll
                for (int et = 0; et < 2; ++et) *(LAS u32x2*)(cbf + (16 * et + fr) * 1040 + (64 * w + 16 * dt + 4 * fq) * 2) = (u32x2){pk2(acc[dt][et][0], acc[dt][et][1]), pk2(acc[dt][et][2], acc[dt][et][3])};
            if (F.tid < 128) wl[F.tid] = gtl[cfirst * 128 + F.tid][3];
            *(LAS bf16x8*)(vtb + w * 1024 + l16) = ldg16(vtl + (size_t)cfirst * 131072 + (e0 >> 4) * 4096 + w * 1024, l16);
            const char* xc0 = XC + ((size_t)(((bl * SEQ + cfirst * 128) >> 4) + w) * 64 + h * 16) * 1024;
#pragma unroll
            for (int ks = 0; ks < 16; ++ks) xf[ks] = ldg16(xc0 + ks * 1024, l16); }
        __syncthreads();
#pragma unroll 1
        for (int q = 0; q < 64; ++q) {
            int tid_ = F.tid; asm volatile("" : "+v"(tid_));
            const int lane_ = tid_ & 63, fr = lane_ & 15, fq = lane_ >> 4; const unsigned l16 = lane_ * 16u;
            const int c = dir == 0 ? q : 63 - q;
            const int qn = q < 63 ? q + 1 : 63, cn = dir == 0 ? qn : 63 - qn;
            const int qp = q < 62 ? q + 2 : 63, cp = dir == 0 ? qp : 63 - qp;
            const char* ktu = ktl + (size_t)c * 131072;
            const int row0 = bl * SEQ + c * 128;
            const float Gd = gcb[2 + c];
            LAS unsigned char* cb_rd = cbf + (q & 1) * 33280; LAS unsigned char* cb_wr = cbf + ((q + 1) & 1) * 33280;
            const LAS float* wl_rd = wl + (q & 1) * 128; LAS float* wl_wr = wl + ((q + 1) & 1) * 128;
            const LAS unsigned char* vt_rd = vtb + (q & 1) * 8192; LAS unsigned char* vt_wr = vtb + ((q + 1) & 1) * 8192;
            const bf16x8 vnext = ldg16(vtl + (size_t)cn * 131072 + (e0 >> 4) * 4096 + w * 1024, l16);
            const float wnext = *(const float*)((const char*)(gtl + cn * 128) + (unsigned)(tid_ & 127) * 16u + 12u);
            const float Ei = *(const float*)((const char*)(gtl + c * 128 + 16 * w) + (unsigned)fr * 16u + 8u);
            const f32x4 dn0 = *(const f32x4*)((const char*)(dnb + (2 + c) * 512) + lane_ * 32u), dn1 = *(const f32x4*)((const char*)(dnb + (2 + c) * 512) + lane_ * 32u + 16u);
            bf16x8 kf[4][4], vf[2][4], sfr[4];
            { const char* su = S + ((size_t)(dir * 8 + bl * 4 + h) * 64 + c) * 32768 + w * 4096;
#pragma unroll
                for (int ks = 0; ks < 4; ++ks) sfr[ks] = ldg16(su + ks * 1024, l16); }
#pragma unroll
            for (int dt = 0; dt < 4; ++dt) kf[0][dt] = ldg16(ktu + (4 * w + dt) * 4096, l16);
            unsigned pf;
            {
                const char* kt3 = ktl + (size_t)cp * 131072; const char* vt3 = vtl + (size_t)cp * 131072;
                const char* xc3 = XC + ((size_t)((bl * SEQ + cp * 128) >> 4) * 64 + h * 16) * 1024; const char* s3p = S + ((size_t)(dir * 8 + bl * 4 + h) * 64 + cp) * 32768;
                const unsigned t = tid_ < 208 ? tid_ : tid_ - 208; const bool g0 = t < 64, g1 = t < 128, g2 = t < 192;
                const unsigned ln2 = slice * 64 + (t - 128);
                const char* ub = g0 ? kt3 : (g1 ? vt3 : (g2 ? xc3 : s3p));
                const unsigned off = g0 ? (slice * 64 + t) * 128u : (g1 ? (e0 >> 4) * 4096u + (t - 64) * 128u : (g2 ? (ln2 >> 7) * 65536u + (ln2 & 127) * 128u : (slice * 16 + ((t - 192) & 15)) * 128u));
                pf = *(const volatile unsigned*)(ub + off);
            }
#pragma unroll
            for (int et = 0; et < 2; ++et)
#pragma unroll
                for (int ks = 0; ks < 4; ++ks) vf[et][ks] = *(const LAS bf16x8*)(vt_rd + (et * 4 + ks) * 1024 + l16);
            if (nwriter) { char* np = (char*)(NC + (((size_t)(dir * 2 + bl) * 4 + h) * 64 + c) * 512); const unsigned lo = lane_ * 32u;
                *(f32x4*)(np + lo) = (f32x4){nreg[0], nreg[1], nreg[2], nreg[3]}; *(f32x4*)(np + lo + 16u) = (f32x4){nreg[4], nreg[5], nreg[6], nreg[7]}; }
            f32x4 a2[2] = {(f32x4){0.f, 0.f, 0.f, 0.f}, (f32x4){0.f, 0.f, 0.f, 0.f}};
#pragma unroll
            for (int ks = 0; ks < 16; ++ks)
#pragma unroll
                for (int et = 0; et < 2; ++et) a2[et] = __builtin_amdgcn_mfma_f32_16x16x32_bf16(*(const LAS bf16x8*)(cb_rd + (16 * et + fr) * 1040 + ks * 64 + fq * 16), xf[ks], a2[et], 0, 0, 0);
            asm volatile("" ::: "memory");
#pragma unroll
            for (int ks = 1; ks < 4; ++ks)
#pragma unroll
                for (int dt = 0; dt < 4; ++dt) kf[ks][dt] = ldg16(ktu + (4 * w + dt) * 4096 + ks * 1024, l16);
            a2[0] = a2[0] * Ei; a2[1] = a2[1] * Ei;
#pragma unroll
            for (int ks = 0; ks < 4; ++ks)
#pragma unroll
                for (int et = 0; et < 2; ++et) a2[et] = __builtin_amdgcn_mfma_f32_16x16x32_bf16(vf[et][ks], sfr[ks], a2[et], 0, 0, 0);
            { char* nu = NUM + ((size_t)row0 * MI + h * 512 + e0) * 2; const unsigned ln = ((16u * w + fr) * MI + 4u * fq) * 2u;
#pragma unroll
                for (int et = 0; et < 2; ++et) *(u32x2*)(nu + et * 32 + ln) = (u32x2){pk2(a2[et][0], a2[et][1]), pk2(a2[et][2], a2[et][3])}; }
#pragma unroll
            for (int a = 0; a < 4; ++a)
#pragma unroll
                for (int b = 0; b < 2; ++b) acc[a][b] = acc[a][b] * Gd;
#pragma unroll
            for (int ks = 0; ks < 4; ++ks) {
                bf16x8 bv[2];
#pragma unroll
                for (int et = 0; et < 2; ++et) { float v[8]; unpack8(__builtin_bit_cast(u32x4, vf[et][ks]), v);
                    const f32x4 wa = *(const LAS f32x4*)(wl_rd + ks * 32 + 8 * fq), wb = *(const LAS f32x4*)(wl_rd + ks * 32 + 8 * fq + 4);
                    v[0] *= wa[0]; v[1] *= wa[1]; v[2] *= wa[2]; v[3] *= wa[3]; v[4] *= wb[0]; v[5] *= wb[1]; v[6] *= wb[2]; v[7] *= wb[3];
                    const u32x4 pv = pack8(v); bv[et] = __builtin_bit_cast(bf16x8, pv); }
#pragma unroll
                for (int dt = 0; dt < 4; ++dt)
#pragma unroll
                    for (int et = 0; et < 2; ++et) acc[dt][et] = __builtin_amdgcn_mfma_f32_16x16x32_bf16(kf[ks][dt], bv[et], acc[dt][et], 0, 0, 0);
            }
            asm volatile("" ::: "memory");
            { const char* xc2 = XC + ((size_t)(((bl * SEQ + cn * 128) >> 4) + w) * 64 + h * 16) * 1024;
#pragma unroll
                for (int ks = 0; ks < 16; ++ks) xf[ks] = ldg16(xc2 + ks * 1024, l16); }
            nreg[0] = Gd * nreg[0] + dn0[0]; nreg[1] = Gd * nreg[1] + dn0[1]; nreg[2] = Gd * nreg[2] + dn0[2]; nreg[3] = Gd * nreg[3] + dn0[3];
            nreg[4] = Gd * nreg[4] + dn1[0]; nreg[5] = Gd * nreg[5] + dn1[1]; nreg[6] = Gd * nreg[6] + dn1[2]; nreg[7] = Gd * nreg[7] + dn1[3];
            *(LAS bf16x8*)(vt_wr + w * 1024 + l16) = vnext;
            wl_wr[tid_ & 127] = wnext;
#pragma unroll
            for (int dt = 0; dt < 4; ++dt)
#pragma unroll
                for (int et = 0; et < 2; ++et) *(LAS u32x2*)(cb_wr + (16 * et + fr) * 1040 + (64 * w + 16 * dt + 4 * fq) * 2) = (u32x2){pk2(acc[dt][et][0], acc[dt][et][1]), pk2(acc[dt][et][2], acc[dt][et][3])};
            asm volatile("" :: "v"(pf));
            __syncthreads();
        }
    }
}

__device__ __forceinline__ void ph_mout(Fr& F) {
    bf16* NF = (bf16*)(F.ws + MS_NF); const bf16* NBk = (const bf16*)(F.ws + MS_NB); const bf16* XC = (const bf16*)(F.ws + MS_XC); const bf16* Z = (const bf16*)(F.ws + MS_Z);
    const float* NC = (const float*)(F.ws + WS_NC); const float* RS = (const float*)(F.ws + WS_RS); const f32x4* GTL = (const f32x4*)(F.ws + WS_GT_L);
    LAS unsigned char* xt = F.lds + F.wave * 16640;
    for (int it = F.gw; it < (HROWS / 16) * 4; it += F.ngw) {
        const int rt = it >> 2, h = it & 3, bl = rt >> 9, c = (rt >> 3) & 63;
        { const bf16* xp = XC + ((size_t)rt * 64 + h * 16) * 512 + F.lane * 8; u32x4 t[16];
#pragma unroll
            for (int ks = 0; ks < 16; ++ks) t[ks] = *(const u32x4*)(xp + ks * 512);
#pragma unroll
            for (int ks = 0; ks < 16; ++ks) *(LAS u32x4*)(xt + ks * 1040 + F.lane * 16) = t[ks]; }
        const float* n0 = NC + (((size_t)(0 * 2 + bl) * 4 + h) * 64 + c) * 512 + 8 * F.lane; const float* n1 = NC + (((size_t)(1 * 2 + bl) * 4 + h) * 64 + c) * 512 + 8 * F.lane;
        const f32x4 n00 = *(const f32x4*)n0, n01 = *(const f32x4*)(n0 + 4), n10 = *(const f32x4*)n1, n11 = *(const f32x4*)(n1 + 4);
        float nw[8], sk[8];
        { const float* pw = IN(I_MNW) + h * 512 + 8 * F.lane; const float* ps = IN(I_MSKIP) + h * 512 + 8 * F.lane;
#pragma unroll
            for (int e = 0; e < 8; ++e) { nw[e] = pw[e]; sk[e] = ps[e]; } }
#pragma unroll 2
        for (int r = 0; r < 16; ++r) {
            const int row = rt * 16 + r; const size_t o = (size_t)row * MI + h * 512 + 8 * F.lane;
            float nf[8], nb[8], xc[8], z[8];
            unpack8(*(const u32x4*)(NF + o), nf); unpack8(*(const u32x4*)(NBk + o), nb); unpack8(*(const u32x4*)(Z + o), z);
            unpack8(*(const LAS u32x4*)(xt + (F.lane >> 2) * 1040 + (r + 16 * (F.lane & 3)) * 16), xc);
            float d0 = xc[0] * n00[0] + xc[1] * n00[1] + xc[2] * n00[2] + xc[3] * n00[3] + xc[4] * n01[0] + xc[5] * n01[1] + xc[6] * n01[2] + xc[7] * n01[3];
            float d1 = xc[0] * n10[0] + xc[1] * n10[1] + xc[2] * n10[2] + xc[3] * n10[3] + xc[4] * n11[0] + xc[5] * n11[1] + xc[6] * n11[2] + xc[7] * n11[3];
            d0 = wave_sum(d0); d1 = wave_sum(d1);
            const float den0 = GTL[(size_t)(0 * 4 + h) * HROWS + row][2] * d0 + RS[(size_t)(0 * 4 + h) * HROWS + row], den1 = GTL[(size_t)(1 * 4 + h) * HROWS + row][2] * d1 + RS[(size_t)(1 * 4 + h) * HROWS + row];
            const float i0 = 1.0f / fmaxf(fabsf(den0), 1.0f), i1 = 1.0f / fmaxf(fabsf(den1), 1.0f);
            float s = 0.f;
#pragma unroll
            for (int e = 0; e < 8; ++e) { nf[e] = nf[e] * i0 + nb[e] * i1; s += nf[e]; }
            const float mu = wave_sum(s) * (1.0f / 512.0f); float q = 0.f;
#pragma unroll
            for (int e = 0; e < 8; ++e) { nf[e] -= mu; q += nf[e] * nf[e]; }
            const float rstd = 1.0f / sqrtf(wave_sum(q) * (1.0f / 512.0f) + ML_NORM_EPS);
#pragma unroll
            for (int e = 0; e < 8; ++e) nf[e] = (nf[e] * rstd * nw[e] + sk[e] * xc[e]) * silu_f(z[e]);
            *(u32x4*)(NF + o) = pack8(nf);
        }
    }
}

__device__ __forceinline__ void ph_final(Fr& F, const bf16* dl) {
    const float* g = IN(I_FINALG);
    for (int r = F.gw; r < ML; r += 2 * F.ngw) {
        const int r2 = r + F.ngw < ML ? r + F.ngw : r;
        f32x4* xa = (f32x4*)(F.out + (size_t)r * 1024) + F.lane; f32x4* xb = (f32x4*)(F.out + (size_t)r2 * 1024) + F.lane; f32x4 va[4], vb[4]; float sa = 0.f, sb = 0.f;
        const u32x2* da = (const u32x2*)(dl + (size_t)r * 1024) + F.lane; const u32x2* db = (const u32x2*)(dl + (size_t)r2 * 1024) + F.lane;
#pragma unroll
        for (int j = 0; j < 4; ++j) { const u32x2 a = da[64 * j], b = db[64 * j];
            va[j] = xa[64 * j] + (f32x4){bflo(a.x), bfhi(a.x), bflo(a.y), bfhi(a.y)}; vb[j] = xb[64 * j] + (f32x4){bflo(b.x), bfhi(b.x), bflo(b.y), bfhi(b.y)}; }
#pragma unroll
        for (int j = 0; j < 4; ++j) { sa += (va[j][0] * va[j][0] + va[j][1] * va[j][1]) + (va[j][2] * va[j][2] + va[j][3] * va[j][3]); sb += (vb[j][0] * vb[j][0] + vb[j][1] * vb[j][1]) + (vb[j][2] * vb[j][2] + vb[j][3] * vb[j][3]); }
        const float ra = __builtin_amdgcn_rsqf(wave_sum(sa) * (1.0f / 1024.0f) + EPS), rb = __builtin_amdgcn_rsqf(wave_sum(sb) * (1.0f / 1024.0f) + EPS);
#pragma unroll
        for (int j = 0; j < 4; ++j) { const f32x4 gg = *(const f32x4*)(g + 4 * F.lane + 256 * j); xa[64 * j] = va[j] * ra * gg; if (r2 != r) xb[64 * j] = vb[j] * rb * gg; }
    }
}

template <class Epi>
__device__ __forceinline__ void run_gemm(Fr& F, const bf16* A, const bf16* Bt, int M, int N, int K, const Epi& E) {
    pg8::Gemm g{A, Bt, M, N, K}; pg8::StaticOrder S; S.init(M, N, F.G, F.bid);
    pg8::gemm_phase<Epi, pg8::StaticOrder, true, true>(F.lds, g, S, E, F.tid);
}

struct Args { const float* in[38]; float* out; unsigned char* ws; int ph_lo, ph_hi; };
static_assert(sizeof(Args) == 328 && offsetof(Args, out) == 304 && offsetof(Args, ws) == 312 && offsetof(Args, ph_lo) == 320, "Args layout");
constexpr int N_PHASES = 34;


#define XB_TMO      128
#define XB_XCNT(j)  (256  + 64 * (j))
#define XB_XSUB(j)  (1280 + 64 * (j))
#define XB_XGEN(j)  (2304 + 64 * (j))
#define XB_TOP      3328
#define XB_TOPGEN   3392
#define XCD_BAR_WORDS 3456
#define XB_SPIN_CAP (1u << 22)
__device__ __forceinline__ unsigned xb_ld(unsigned* p)              { return __hip_atomic_load(p, __ATOMIC_RELAXED, __HIP_MEMORY_SCOPE_AGENT); }
__device__ __forceinline__ unsigned xb_add(unsigned* p, unsigned v) { return __hip_atomic_fetch_add(p, v, __ATOMIC_RELAXED, __HIP_MEMORY_SCOPE_AGENT); }
__device__ __forceinline__ unsigned xb_xcc_id() { return (unsigned)__builtin_amdgcn_s_getreg((3 << 11) | 20) & 0xFu; }
#define XB_SPIN(cond, bar) do { unsigned _sp = 0; while (cond) { __builtin_amdgcn_s_sleep(1); \
    if ((++_sp & 255u) == 0u) { if (xb_ld(&(bar)[XB_TMO])) break; if (_sp > XB_SPIN_CAP) { atomicAdd(&(bar)[XB_TMO], 1u); break; } } } } while (0)
__device__ __forceinline__ void xcd_barrier_complete(unsigned* bar, unsigned x, unsigned& nloc, unsigned& nx) {
    const unsigned G = gridDim.x * gridDim.y * gridDim.z;
    unsigned sum, cnt, mine, sp = 0u;
    for (;;) {
        sum = 0u; cnt = 0u; mine = 0u;
#pragma unroll
        for (unsigned j = 0; j < 16; ++j) { const unsigned c = xb_ld(&bar[XB_XCNT(j)]); sum += c; cnt += (c > 0u) ? 1u : 0u; mine = (j == x) ? c : mine; }
        if (sum == G) break;
        __builtin_amdgcn_s_sleep(1);
        if ((++sp & 255u) == 0u) { if (xb_ld(&bar[XB_TMO])) break; if (sp > XB_SPIN_CAP) { atomicAdd(&bar[XB_TMO], 1u); break; } }
    }
    nloc = mine > 0u ? mine : 1u; nx = cnt > 0u ? cnt : 1u;
}
__device__ __forceinline__ void xcd_barrier(unsigned* bar, volatile LAS unsigned* st) {
    asm volatile("s_waitcnt vmcnt(0)" ::: "memory");
    __syncthreads();
    if (threadIdx.x == 0) {
        const unsigned x = xb_xcc_id();
        __builtin_amdgcn_s_waitcnt(0);
        unsigned nloc = st[0], nx = st[1];
        if (nloc == 0u) { xcd_barrier_complete(bar, x, nloc, nx); st[0] = nloc; st[1] = nx; }
        const unsigned old = xb_add(&bar[XB_XSUB(x)], 1u);
        const unsigned gen = old / nloc;
        if (old + 1u == (gen + 1u) * nloc) {
            __builtin_amdgcn_fence(__ATOMIC_RELEASE, "agent");
            asm volatile("s_waitcnt vmcnt(0)" ::: "memory");
            const unsigned og = xb_add(&bar[XB_TOP], 1u);
            const unsigned tg = og / nx;
            if (og + 1u == (tg + 1u) * nx) xb_add(&bar[XB_TOPGEN], 1u);
            else XB_SPIN(xb_ld(&bar[XB_TOPGEN]) == tg, bar);
            __builtin_amdgcn_fence(__ATOMIC_ACQUIRE, "agent");
            xb_add(&bar[XB_XGEN(x)], 1u);
            asm volatile("s_waitcnt vmcnt(0)" ::: "memory");
        } else {
            XB_SPIN(xb_ld(&bar[XB_XGEN(x)]) == gen, bar);
            __builtin_amdgcn_fence(__ATOMIC_ACQUIRE, "agent");
            asm volatile("s_waitcnt vmcnt(0)" ::: "memory");
        }
    }
    __syncthreads();
}
#ifndef PROBE_MASK
#define PROBE_MASK 0ull
#endif
constexpr int BAR_LDS_OFF = LDS_BYTES - 64;
constexpr size_t WS_BAR = 0;
constexpr size_t WS_TS = 64 * 1024;

template <int ph>
__device__ __forceinline__ void run_phase(Fr& F) {
    unsigned char* ws = F.ws;
    float* mod = (float*)(ws + WS_MOD); float* ctxx = (float*)(ws + WS_CTXX);
    if constexpr (ph == 0) ph_prologue(F);
    else if constexpr (ph == 1) ph_modnorm(F, IN(I_X), ML, 0, IN(I_CTX), MC, IN(I_NORMG), mod, 0, (bf16*)(ws + HY_H));
    else if constexpr (ph == 2) { pg8::EpiBf16 E{(bf16*)(ws + HY_P), 3072, IN(I_HBIN), 0, 0}; run_gemm(F, (const bf16*)(ws + HY_H), (const bf16*)(ws + WS_WHIN), MALL, 3072, 1024, E);
                                  { constexpr int nun = (MALL / 256) * (3072 / 256); const int busy = nun % F.G; const bool all = busy == 0; const int vb = all ? F.bid : F.bid - busy, nvb = all ? F.G : F.G - busy;
                                    if (all || F.bid >= busy) {
                                        kt_items(F, (const float*)(ws + WS_H3), SEQ, (float*)(ws + HY_KT), vb * NWAVES + F.wave, nvb * NWAVES);
                                        kt_items(F, (const float*)(ws + WS_H3) + (size_t)SEQ * 64, CTXL, (float*)(ws + WS_KTC), vb * NWAVES + F.wave, nvb * NWAVES);
                                        transpose_group(F, 1, vb, nvb); } } }
    else if constexpr (ph == 3) { zt_items(F, (const bf16*)(ws + HY_P), 0, NB, SEQ, (bf16*)(ws + HY_ZT)); zt_items(F, (const bf16*)(ws + HY_P), ML, NB, CTXL, (bf16*)(ws + HY_ZTC)); }
    else if constexpr (ph == 4) ph_fftconv(F);
    else if constexpr (ph == 5) { u2_items(F, (const bf16*)(ws + HY_P), 0, NB, SEQ, (const bf16*)(ws + HY_ZT), (bf16*)(ws + HY_H)); u2_items(F, (const bf16*)(ws + HY_P), ML, NB, CTXL, (const bf16*)(ws + HY_ZTC), (bf16*)(ws + HY_H)); }
    else if constexpr (ph == 6) { pg8::EpiDelta E{(bf16*)(ws + HY_P), ML, mod + 2048, 0, IN(I_HBOUT)}; run_gemm(F, (const bf16*)(ws + HY_H), (const bf16*)(ws + WS_WHOUT), MALL, 1024, 1024, E);
                                  transpose_in_tail(F, 2, (MALL / 256) * (1024 / 256)); }
    else if constexpr (ph == 7) ph_modnorm(F, IN(I_X), ML, 0, IN(I_CTX), MC, IN(I_NORMG) + 1024, mod, 3072, (bf16*)(ws + FF_H), (const bf16*)(ws + HY_P), F.out, ctxx);
    else if constexpr (ph == 8) { pg8::EpiBf16 E{(bf16*)(ws + FF_A), FF, nullptr, FF, (FF_G - FF_A) / 2}; run_gemm(F, (const bf16*)(ws + FF_H), (const bf16*)(ws + WS_WUP0), MALL, 2 * FF, 1024, E);
                                  { constexpr int nun = (MALL / 256) * (2 * FF / 256); const int busy = nun % F.G;
                                    if (busy == 0) mod_layer(F, 1, F.bid, F.G); else if (F.bid >= busy) mod_layer(F, 1, F.bid - busy, F.G - busy); } }
    else if constexpr (ph == 9) ph_dwconv(F, 0, ML, MC);
    else if constexpr (ph == 10) { pg8::EpiDelta E{(bf16*)(ws + FF_H), ML, mod + 5120, 0, nullptr}; run_gemm(F, (const bf16*)(ws + FF_A), (const bf16*)(ws + WS_WDN0), MALL, 1024, FF, E); }
    else if constexpr (ph < 29) {
            constexpr int hb = (ph - 11) / 9, k = (ph - 11) % 9; const float* mod1 = mod + 5 * 6144;
            float* xh = F.out + (size_t)hb * HROWS * 1024;
            if constexpr (k == 0) {
                if constexpr (hb == 0) {
                    const bf16* dl = (const bf16*)(ws + FF_H);
                    add_delta_rows(F, F.out, dl, HROWS, HROWS);
                    ph_modnorm(F, xh, 0, 0, ctxx, MC, IN(I_NORMG) + 2048, mod1, 0, (bf16*)(ws + MS_HC), dl + (size_t)ML * 1024, xh, ctxx);
                    ph_modnorm(F, xh, HROWS, 0, ctxx, 0, IN(I_NORMG) + 2048, mod1, 0, (bf16*)(ws + MS_H), dl, xh, ctxx);
                } else ph_modnorm(F, xh, HROWS, 2 * hb, ctxx, 0, IN(I_NORMG) + 2048, mod1, 0, (bf16*)(ws + MS_H)); }
            else if constexpr (k == 1) { { pg8::EpiBf16T E{(bf16*)(ws + MS_XM), MI / 32}; run_gemm(F, (const bf16*)(ws + MS_H), (const bf16*)(ws + WS_WMIN), HROWS, MI, 1024, E); }
                               if (hb == 0) { pg8::EpiBf16T E{(bf16*)(ws + MS_XMC), MI / 32}; run_gemm(F, (const bf16*)(ws + MS_HC), (const bf16*)(ws + WS_WMIN), MC, MI, 1024, E); } }
            else if constexpr (k == 2) { prep_items(F, (const bf16*)(ws + MS_XM), 2, SEQ, (bf16*)(ws + MS_XC), (bf16*)(ws + MS_KN), (bf16*)(ws + MS_KT), (bf16*)(ws + MS_VT));
                               if (hb == 0) prep_items(F, (const bf16*)(ws + MS_XMC), NB, CTXL, (bf16*)(ws + MS_XCC), (bf16*)(ws + MS_XCC + 16 * MiB), (bf16*)(ws + MS_KTC), (bf16*)(ws + MS_VTC)); }
            else if constexpr (k == 3) { gate_items(F, (const bf16*)(ws + MS_XC), (const bf16*)(ws + MS_XM), HROWS, (float*)(ws + WS_GATES_L));
                               if (hb == 0) gate_items(F, (const bf16*)(ws + MS_XCC), (const bf16*)(ws + MS_XMC), MC, (float*)(ws + WS_GATES_C)); }
            else if constexpr (k == 4) ph_sphase(F, hb, hb == 0);
            else if constexpr (k == 5) ph_scan(F, hb);
            else if constexpr (k == 6) { pg8::EpiBf16 E{(bf16*)(ws + MS_Z), MI, nullptr, 0, 0}; run_gemm(F, (const bf16*)(ws + MS_H), (const bf16*)(ws + WS_WMIN) + (size_t)MI * 1024, HROWS, MI, 1024, E); }
            else if constexpr (k == 7) ph_mout(F);
            else { pg8::EpiRes E{xh, xh, ctxx, ctxx, HROWS, mod1 + 2048, 2 * hb, nullptr}; run_gemm(F, (const bf16*)(ws + MS_NF), (const bf16*)(ws + WS_WMDN), HROWS, 1024, MI, E); }
        }
    else if constexpr (ph == 29) ph_modnorm(F, F.out, ML, 0, ctxx, 0, IN(I_NORMG) + 3072, mod + 5 * 6144, 3072, (bf16*)(ws + FF_H));
    else if constexpr (ph == 30) { pg8::EpiBf16 E{(bf16*)(ws + FF_A), FF, nullptr, FF, (FF_G - FF_A) / 2}; run_gemm(F, (const bf16*)(ws + FF_H), (const bf16*)(ws + WS_WUP1), ML, 2 * FF, 1024, E); }
    else if constexpr (ph == 31) ph_dwconv(F, 1, ML, 0);
    else if constexpr (ph == 32) { pg8::EpiDelta E{(bf16*)(ws + FF_H), ML, mod + 5 * 6144 + 5120, 0, nullptr}; run_gemm(F, (const bf16*)(ws + FF_A), (const bf16*)(ws + WS_WDN1), ML, 1024, FF, E); }
    else ph_final(F, (const bf16*)(ws + FF_H));
}

template <int ph>
__device__ __forceinline__ void phase_step(int ph_lo, int ph_hi, unsigned char* lds_raw) {
    if (ph_lo <= ph && ph < ph_hi) {
        const __attribute__((address_space(4))) unsigned char* kp = (const __attribute__((address_space(4))) unsigned char*)__builtin_amdgcn_kernarg_segment_ptr();
        asm volatile("" : "+s"(kp));
        Fr F;
        { int t_ = threadIdx.x, g_ = gridDim.x, b_ = blockIdx.x; asm volatile("" : "+v"(t_), "+s"(g_), "+s"(b_)); F.tid = t_; F.G = g_; F.bid = b_; }
        F.lds = (LAS unsigned char*)lds_raw; F.lane = F.tid & 63; F.wave = __builtin_amdgcn_readfirstlane(F.tid >> 6);
        F.gw = F.bid * NWAVES + F.wave; F.ngw = F.G * NWAVES;
        F.in = (const __attribute__((address_space(4))) cfptr_t*)kp;
        typedef float* fptr_t; typedef unsigned char* ucptr_t;
        F.out = *(const __attribute__((address_space(4))) fptr_t*)(kp + 304); F.ws = *(const __attribute__((address_space(4))) ucptr_t*)(kp + 312);
        if (PROBE_MASK != 0ull && F.bid == 0 && F.tid == 0) ((unsigned long long*)(F.ws + WS_TS))[ph] = __builtin_amdgcn_s_memrealtime();
        run_phase<ph>(F);
        if (ph + 1 < ph_hi) {
            if (ph == 0) {
                if (F.bid == 0) for (int i = F.tid; i < XCD_BAR_WORDS; i += NTHR) __hip_atomic_store((unsigned*)(F.ws + WS_BAR) + i, 0u, __ATOMIC_RELAXED, __HIP_MEMORY_SCOPE_AGENT);
                __syncthreads(); cg::this_grid().sync();
                if (F.tid == 0) (void)xb_add((unsigned*)(F.ws + WS_BAR) + XB_XCNT(xb_xcc_id()), 1u);
            }
            else xcd_barrier((unsigned*)(F.ws + WS_BAR), (volatile LAS unsigned*)(F.lds + BAR_LDS_OFF));
        }
        if (PROBE_MASK != 0ull && ph == N_PHASES - 1 && F.bid == 0) {
            if (F.tid == 0) { unsigned long long* ts = (unsigned long long*)(F.ws + WS_TS); const unsigned long long tend = __builtin_amdgcn_s_memrealtime(); unsigned long long tot = 0ull;
                for (int k = 0; k < N_PHASES; ++k) if ((PROBE_MASK >> k) & 1ull) tot += (k + 1 < N_PHASES ? ts[k + 1] : tend) - ts[k];
                while (__builtin_amdgcn_s_memrealtime() - tend < tot) __builtin_amdgcn_s_sleep(8); }
            __syncthreads();
        }
    }
}
template <int... I>
__device__ __forceinline__ void all_phases(int ph_lo, int ph_hi, unsigned char* lds_raw, std::integer_sequence<int, I...>) { (phase_step<I>(ph_lo, ph_hi, lds_raw), ...); }

__global__ void __launch_bounds__(NTHR, 2) fwd_kernel(Args args) {
    extern __shared__ __attribute__((aligned(16))) unsigned char lds_raw[];
    int ph_lo, ph_hi;
    { const __attribute__((address_space(4))) unsigned char* kp0 = (const __attribute__((address_space(4))) unsigned char*)__builtin_amdgcn_kernarg_segment_ptr();
      ph_lo = *(const __attribute__((address_space(4))) int*)(kp0 + 320); ph_hi = *(const __attribute__((address_space(4))) int*)(kp0 + 324); }
    if (threadIdx.x < 16) ((LAS unsigned*)((LAS unsigned char*)lds_raw + BAR_LDS_OFF))[threadIdx.x] = 0u;
    __syncthreads();
    all_phases(ph_lo, ph_hi, lds_raw, std::make_integer_sequence<int, N_PHASES>{});
}

extern "C" void kernel_launch(void* const* d_in, const int* in_sizes, int n_in, void* d_out, int out_size, void* d_ws, size_t ws_size, hipStream_t stream) {
    static int grid = 0;
    if (grid == 0) {
        int dev = 0, cus = 0, per_cu = 0;
        hipGetDevice(&dev);
        hipDeviceGetAttribute(&cus, hipDeviceAttributeMultiprocessorCount, dev);
        hipFuncSetAttribute((const void*)fwd_kernel, hipFuncAttributeMaxDynamicSharedMemorySize, LDS_BYTES);
        hipOccupancyMaxActiveBlocksPerMultiprocessor(&per_cu, (const void*)fwd_kernel, NTHR, LDS_BYTES);
        if (per_cu < 1) { fprintf(stderr, "kernel_launch: occupancy query says %d blocks per CU\n", per_cu); per_cu = 1; }
        grid = cus < 256 ? cus : 256;
        if (n_in != 38 || ws_size < WS_END) fprintf(stderr, "kernel_launch: unexpected n_in %d / ws_size %zu (need %zu)\n", n_in, ws_size, (size_t)WS_END);
        (void)hipGetLastError();
    }
    (void)hipMemsetAsync(d_ws, 0, 128 * 1024, stream);
    Args a{};
    for (int i = 0; i < 38; ++i) a.in[i] = (const float*)d_in[i];
    a.out = (float*)d_out; a.ws = (unsigned char*)d_ws; a.ph_lo = 0; a.ph_hi = N_PHASES;
    void* kargs[] = {&a};
    hipError_t e = hipLaunchCooperativeKernel((const void*)fwd_kernel, dim3(grid), dim3(NTHR), kargs, LDS_BYTES, stream);
    if (e != hipSuccess) fprintf(stderr, "cooperative launch failed: %s (grid %d)\n", hipGetErrorString(e), grid);
}
```

```cpp
#include <hip/hip_runtime.h>
#include <hip/hip_cooperative_groups.h>
#include <cstdio>
#include <cstdint>
#include <cstddef>
#include <utility>
namespace cg = cooperative_groups;

#define LAS __attribute__((address_space(3)))
typedef unsigned short bf16;
typedef short bf16x8 __attribute__((ext_vector_type(8)));
typedef float f32x4 __attribute__((ext_vector_type(4)));
typedef float f32x2 __attribute__((ext_vector_type(2)));
typedef unsigned u32x4 __attribute__((ext_vector_type(4)));
typedef unsigned u32x2 __attribute__((ext_vector_type(2)));

namespace pg8 {
#define PG8_LAS __attribute__((address_space(3)))
typedef unsigned short bf16_t;
constexpr int BM = 256, BK = 64, HALF = 128, HTB = HALF * BK * 2, STAGE_BYTES = 8 * HTB, NXCD = 8, WGM = 8;
__host__ __device__ __forceinline__ int lds_byte(int r, int c) { const int st = (r >> 4) * 2 + (c >> 5), rr = r & 15, cc = c & 31, ob = rr * 64 + cc * 2; return st * 1024 + (ob ^ (((ob >> 9) & 1) << 5)); }
__host__ __device__ __forceinline__ void stage_rc(int b, int& R, int& C) { const int st = b / 1024, sb = b % 1024, swz = sb ^ (((sb >> 9) & 1) << 5); R = (st >> 1) * 16 + swz / 64; C = (st & 1) * 32 + (swz % 64) / 2; }
__host__ __device__ __forceinline__ int perm32(int rho) { const int n = rho >> 4, i = rho & 15; return 8 * (i >> 2) + 4 * n + (i & 3); }
struct Unit { int pm, pn; };
struct Gemm { const bf16_t* A; const bf16_t* Bt; int M, N, K; };
struct StaticOrder {
    int nM, nN, nwg, G, c;
    __host__ __device__ void init(int M, int N, int G_, int c_) { nM = M / BM; nN = N / BM; nwg = nM * nN; G = G_; c = c_; }
    __host__ __device__ bool next(int i, Unit& u) const {
        const long L = (long)i * G + c; if (L >= nwg) return false;
        int wgid = (int)L; { const int q = nwg / NXCD, r = nwg % NXCD, xcd = wgid % NXCD, off = wgid / NXCD; wgid = (xcd < r ? xcd * (q + 1) : r * (q + 1) + (xcd - r) * q) + off; }
        const int nig = WGM * nN, gid = wgid / nig, fm = gid * WGM, gsz = (nM - fm) < WGM ? (nM - fm) : WGM;
        u.pm = fm + ((wgid % nig) % gsz); u.pn = (wgid % nig) / gsz; return true;
    }
    __device__ __forceinline__ void a_ready(const Unit&) const {}
    __device__ __forceinline__ void done(const Unit&) const {}
};
__device__ __forceinline__ unsigned cvt_pk_bf16(float lo, float hi) { unsigned r; asm volatile("v_cvt_pk_bf16_f32 %0, %1, %2" : "=v"(r) : "v"(lo), "v"(hi)); return r; }

struct EpiBf16 {
    static constexpr bool PERM = true, AFTER_DRAIN = false;
    bf16_t* O; int ldc; const float* bias; int split_cols; size_t split_stride;
    __device__ __forceinline__ void operator()(const f32x4 (&acc)[2][2][4][2], const Unit& u, int wr, int wc, int fr, int fq) const {
        const int row0 = u.pm * BM + wr * 64 + fr; int colt = u.pn * BM; bf16_t* base = O;
        if (split_cols) { const int t = colt / split_cols; base += (size_t)t * split_stride; colt -= t * split_cols; }
        const int col0 = colt + wc * 32 + 8 * fq, bcol0 = u.pn * BM + wc * 32 + 8 * fq;
        f32x4 bv[2][2];
#pragma unroll
        for (int bj = 0; bj < 2; ++bj)
#pragma unroll
            for (int n = 0; n < 2; ++n) bv[bj][n] = bias ? *(const f32x4*)(bias + bcol0 + bj * HALF + 4 * n) : (f32x4){0.f, 0.f, 0.f, 0.f};
#pragma unroll
        for (int ai = 0; ai < 2; ++ai)
#pragma unroll
            for (int m = 0; m < 4; ++m) { bf16_t* rowp = base + (size_t)(row0 + ai * HALF + m * 16) * ldc + col0;
#pragma unroll
                for (int bj = 0; bj < 2; ++bj) { f32x4 v0 = acc[ai][bj][m][0] + bv[bj][0], v1 = acc[ai][bj][m][1] + bv[bj][1];
                    u32x4 w; w.x = cvt_pk_bf16(v0[0], v0[1]); w.y = cvt_pk_bf16(v0[2], v0[3]); w.z = cvt_pk_bf16(v1[0], v1[1]); w.w = cvt_pk_bf16(v1[2], v1[3]);
                    *(u32x4*)(rowp + bj * HALF) = w; } }
    }
};
struct EpiBf16T {
    static constexpr bool PERM = true, AFTER_DRAIN = false;
    bf16_t* O; int ntc;
    __device__ __forceinline__ void operator()(const f32x4 (&acc)[2][2][4][2], const Unit& u, int wr, int wc, int fr, int fq) const {
        bf16_t* base = O + (size_t)(fr + 16 * fq) * 8;
#pragma unroll
        for (int ai = 0; ai < 2; ++ai)
#pragma unroll
            for (int m = 0; m < 4; ++m)
#pragma unroll
                for (int bj = 0; bj < 2; ++bj) { const f32x4 v0 = acc[ai][bj][m][0], v1 = acc[ai][bj][m][1];
                    u32x4 w; w.x = cvt_pk_bf16(v0[0], v0[1]); w.y = cvt_pk_bf16(v0[2], v0[3]); w.z = cvt_pk_bf16(v1[0], v1[1]); w.w = cvt_pk_bf16(v1[2], v1[3]);
                    *(u32x4*)(base + ((size_t)(u.pm * 16 + ai * 8 + wr * 4 + m) * ntc + u.pn * 8 + bj * 4 + wc) * 512) = w; }
    }
};
struct EpiDelta {
    static constexpr bool PERM = true, AFTER_DRAIN = false, HEAVY = false;
    bf16_t* Dl; int rows_lat; const float* gate; int b0; const float* bias;
    __device__ __forceinline__ void operator()(const f32x4 (&acc)[2][2][4][2], const Unit& u, int wr, int wc, int fr, int fq) const {
        const int trow = u.pm * BM, modrow = trow < rows_lat ? b0 + trow / 8192 : 4;
        const int col0 = u.pn * BM + wc * 32 + 8 * fq; const float* gp = gate + (size_t)modrow * 6144 + col0;
        bf16_t* base = Dl + (size_t)(trow + wr * 64 + fr) * 1024 + col0;
#pragma unroll
        for (int bj = 0; bj < 2; ++bj) {
            f32x4 bv[2], gv[2];
#pragma unroll
            for (int n = 0; n < 2; ++n) { bv[n] = bias ? *(const f32x4*)(bias + col0 + bj * HALF + 4 * n) : (f32x4){0.f, 0.f, 0.f, 0.f}; gv[n] = *(const f32x4*)(gp + bj * HALF + 4 * n); }
#pragma unroll
            for (int ai = 0; ai < 2; ++ai)
#pragma unroll
                for (int m = 0; m < 4; ++m) { const f32x4 v0 = gv[0] * (acc[ai][bj][m][0] + bv[0]), v1 = gv[1] * (acc[ai][bj][m][1] + bv[1]);
                    u32x4 w; w.x = cvt_pk_bf16(v0[0], v0[1]); w.y = cvt_pk_bf16(v0[2], v0[3]); w.z = cvt_pk_bf16(v1[0], v1[1]); w.w = cvt_pk_bf16(v1[2], v1[3]);
                    *(u32x4*)(base + (size_t)(ai * HALF + m * 16) * 1024 + bj * HALF) = w; }
        }
    }
};
struct EpiRes {
    static constexpr bool PERM = false, AFTER_DRAIN = false;
    const float* res_lat; float* out_lat; const float* res_ctx; float* out_ctx; int rows_lat; const float* gate; int b0; const float* bias;
    __device__ __forceinline__ void operator()(const f32x4 (&acc)[2][2][4][2], const Unit& u, int wr, int wc, int fr, int fq) const {
        const int trow = u.pm * BM; const float* res; float* out; int modrow;
        if (trow < rows_lat) { res = res_lat + (size_t)trow * 1024; out = out_lat + (size_t)trow * 1024; modrow = b0 + trow / 8192; }
        else { const int rc = trow - rows_lat; res = res_ctx + (size_t)rc * 1024; out = out_ctx + (size_t)rc * 1024; modrow = 4; }
        const int col0 = u.pn * BM + wc * 32 + 4 * fq; const float* gp = gate + (size_t)modrow * 6144 + col0;
#pragma unroll
        for (int bj = 0; bj < 2; ++bj) {
            f32x4 bv[2], gv[2];
#pragma unroll
            for (int n = 0; n < 2; ++n) { bv[n] = bias ? *(const f32x4*)(bias + col0 + bj * HALF + n * 16) : (f32x4){0.f, 0.f, 0.f, 0.f}; gv[n] = *(const f32x4*)(gp + bj * HALF + n * 16); }
#pragma unroll
            for (int ai = 0; ai < 2; ++ai) {
                f32x4 rs[4][2];
#pragma unroll
                for (int m = 0; m < 4; ++m)
#pragma unroll
                    for (int n = 0; n < 2; ++n) rs[m][n] = *(const f32x4*)(res + (size_t)(wr * 64 + fr + ai * HALF + m * 16) * 1024 + col0 + bj * HALF + n * 16);
#pragma unroll
                for (int m = 0; m < 4; ++m)
#pragma unroll
                    for (int n = 0; n < 2; ++n) *(f32x4*)(out + (size_t)(wr * 64 + fr + ai * HALF + m * 16) * 1024 + col0 + bj * HALF + n * 16) = rs[m][n] + gv[n] * (acc[ai][bj][m][n] + bv[n]);
                asm volatile("" ::: "memory");
            }
        }
    }
};

template <class Epi, class Sched, bool ALIGN_EPI = false, bool SP2 = false>
__device__ __forceinline__ void gemm_phase(PG8_LAS unsigned char* lds, const Gemm g, const Sched& S, const Epi& E, const int tid) {
    const int wid = __builtin_amdgcn_readfirstlane(tid >> 6), lane = tid & 63, wr = wid >> 2, wc = wid & 3, fr = lane & 15, fq = lane >> 4;
    const int K = g.K, nt = K / BK;
    unsigned voffA[2], voffB[2];
#pragma unroll
    for (int i = 0; i < 2; ++i) { int R, C; stage_rc(tid * 16 + i * 8192, R, C); const int Rb = Epi::PERM ? ((R & ~31) + perm32(R & 31)) : R;
        voffA[i] = (unsigned)(R * K + C) * 2u; voffB[i] = (unsigned)(Rb * K + C) * 2u; }
    const size_t kstep = (size_t)(BK * 2);
    const size_t hstep = (size_t)HALF * K * 2;
    const size_t tstep = 2 * hstep;
    const unsigned ldsw = (unsigned)wid * 1024u;
    const int aoff = lds_byte(wr * 64 + fr, fq * 8), boff = lds_byte(wc * 32 + fr, fq * 8);
#define PG8_SA(b, h) (((b) * 2 + (h)) * HTB)
#define PG8_SB(b, h) ((4 + (b) * 2 + (h)) * HTB)
#define PG8_STAGE(bufoff, gbase, voff) do { _Pragma("unroll") for (int _i = 0; _i < 2; ++_i) \
        __builtin_amdgcn_global_load_lds((const unsigned*)((const char*)(gbase) + (voff)[_i]), (PG8_LAS unsigned*)(lds + (bufoff) + ldsw + _i * 8192), 16, 0, 0); } while (0)
#define PG8_LDA(dst, b, h) do { _Pragma("unroll") for (int m = 0; m < 4; ++m) _Pragma("unroll") for (int k = 0; k < 2; ++k) dst[m][k] = *(const PG8_LAS bf16x8*)(lds + PG8_SA(b, h) + aoff + m * 2048 + k * 1024); } while (0)
#define PG8_LDB(dst, b, h) do { _Pragma("unroll") for (int n = 0; n < 2; ++n) _Pragma("unroll") for (int k = 0; k < 2; ++k) dst[n][k] = *(const PG8_LAS bf16x8*)(lds + PG8_SB(b, h) + boff + n * 2048 + k * 1024); } while (0)
#define PG8_MMA(ai, bj, At, Bt) do { __builtin_amdgcn_s_setprio(1); _Pragma("unroll") for (int m = 0; m < 4; ++m) _Pragma("unroll") for (int n = 0; n < 2; ++n) _Pragma("unroll") for (int k = 0; k < 2; ++k) \
        acc[ai][bj][m][n] = __builtin_amdgcn_mfma_f32_16x16x32_bf16(Bt[n][k], At[m][k], acc[ai][bj][m][n], 0, 0, 0); __builtin_amdgcn_s_setprio(0); } while (0)
#define PG8_WAIT_V(n) asm volatile("s_waitcnt vmcnt(" #n ")" ::: "memory")
#define PG8_WAIT_L(n) asm volatile("s_waitcnt lgkmcnt(" #n ")" ::: "memory")
#define PG8_BAR __builtin_amdgcn_s_barrier()
#define PG8_SCHED __builtin_amdgcn_sched_barrier(0)
    Unit cur, nxt; int ui = 0;
    if (!S.next(0, cur)) return;
    f32x4 acc[2][2][4][2];
#pragma unroll
    for (int a = 0; a < 2; ++a)
#pragma unroll
        for (int b = 0; b < 2; ++b)
#pragma unroll
            for (int m = 0; m < 4; ++m)
#pragma unroll
                for (int n = 0; n < 2; ++n) acc[a][b][m][n] = (f32x4){0.f, 0.f, 0.f, 0.f};
    bf16x8 At[4][2], B0[2][2], B1[2][2];
    const char* cA = (const char*)g.A + (size_t)cur.pm * tstep; const char* cB = (const char*)g.Bt + (size_t)cur.pn * tstep;
    S.a_ready(cur);
    if constexpr (SP2) {
        PG8_STAGE(PG8_SB(0, 0), cB, voffB); PG8_STAGE(PG8_SB(0, 1), cB + hstep, voffB); PG8_STAGE(PG8_SA(0, 0), cA, voffA); PG8_STAGE(PG8_SA(0, 1), cA + hstep, voffA);
        if (wr == 1) PG8_BAR;
        PG8_WAIT_V(2); PG8_BAR;
        PG8_STAGE(PG8_SB(1, 0), cB + kstep, voffB); PG8_STAGE(PG8_SA(1, 0), cA + kstep, voffA); PG8_STAGE(PG8_SB(1, 1), cB + hstep + kstep, voffB);
        PG8_WAIT_V(6); PG8_BAR;
    } else {
        PG8_STAGE(PG8_SB(0, 0), cB, voffB); PG8_STAGE(PG8_SA(0, 0), cA, voffA); PG8_STAGE(PG8_SB(0, 1), cB + hstep, voffB); PG8_STAGE(PG8_SA(0, 1), cA + hstep, voffA);
        if (wr == 1) PG8_BAR;
        PG8_WAIT_V(4); PG8_BAR;
        PG8_STAGE(PG8_SB(1, 0), cB + kstep, voffB); PG8_STAGE(PG8_SA(1, 0), cA + kstep, voffA); PG8_STAGE(PG8_SB(1, 1), cB + hstep + kstep, voffB);
        PG8_WAIT_V(6); PG8_BAR;
    }
    for (;;) {
        const bool has_next = S.next(ui + 1, nxt);
        const char* nA = has_next ? (const char*)g.A + (size_t)nxt.pm * tstep : cA; const char* nB = has_next ? (const char*)g.Bt + (size_t)nxt.pn * tstep : cB;
        for (int t = 0; t < nt; t += 2) {
            const bool last = (t == nt - 2);
            const char* a1 = cA + (size_t)(t + 1) * kstep;
            const char* a2 = last ? nA : cA + (size_t)(t + 2) * kstep; const char* b2 = last ? nB : cB + (size_t)(t + 2) * kstep;
            const char* a3 = a2 + kstep; const char* b3 = b2 + kstep;
            if (last && has_next) S.a_ready(nxt);
            if constexpr (SP2) {
            PG8_LDB(B0, 0, 0); PG8_LDB(B1, 0, 1); PG8_SCHED; PG8_LDA(At, 0, 0); PG8_STAGE(PG8_SA(1, 1), a1 + hstep, voffA);
            PG8_WAIT_V(8); PG8_WAIT_L(0); PG8_BAR; PG8_MMA(0, 0, At, B0); PG8_MMA(0, 1, At, B1); PG8_BAR; PG8_SCHED;
            PG8_LDA(At, 0, 1); PG8_STAGE(PG8_SB(0, 0), b2, voffB); PG8_STAGE(PG8_SB(0, 1), b2 + hstep, voffB); PG8_STAGE(PG8_SA(0, 0), a2, voffA);
            PG8_WAIT_V(8); PG8_WAIT_L(0); PG8_BAR; PG8_MMA(1, 0, At, B0); PG8_MMA(1, 1, At, B1); PG8_BAR; PG8_SCHED;
            PG8_LDB(B0, 1, 0); PG8_LDB(B1, 1, 1); PG8_SCHED; PG8_LDA(At, 1, 0); PG8_STAGE(PG8_SA(0, 1), a2 + hstep, voffA);
            PG8_WAIT_V(8); PG8_WAIT_L(0); PG8_BAR; PG8_MMA(0, 0, At, B0); PG8_MMA(0, 1, At, B1); PG8_BAR; PG8_SCHED;
            PG8_LDA(At, 1, 1); PG8_STAGE(PG8_SB(1, 0), b3, voffB); PG8_STAGE(PG8_SB(1, 1), b3 + hstep, voffB); PG8_STAGE(PG8_SA(1, 0), a3, voffA);
            PG8_WAIT_V(8); PG8_WAIT_L(0); PG8_BAR; PG8_MMA(1, 0, At, B0); PG8_MMA(1, 1, At, B1); PG8_BAR; PG8_SCHED;
            } else {
            PG8_LDB(B0, 0, 0); PG8_SCHED; PG8_LDA(At, 0, 0); PG8_STAGE(PG8_SA(1, 1), a1 + hstep, voffA);
            PG8_WAIT_L(8); PG8_BAR; PG8_WAIT_L(0); PG8_MMA(0, 0, At, B0); PG8_BAR; PG8_SCHED;
            PG8_LDB(B1, 0, 1); PG8_STAGE(PG8_SB(0, 0), b2, voffB);
            PG8_BAR; PG8_WAIT_L(0); PG8_MMA(0, 1, At, B1); PG8_BAR;
            PG8_LDA(At, 0, 1); PG8_STAGE(PG8_SA(0, 0), a2, voffA);
            PG8_BAR; PG8_WAIT_L(0); PG8_MMA(1, 0, At, B0); PG8_BAR; PG8_SCHED;
            PG8_STAGE(PG8_SB(0, 1), b2 + hstep, voffB);
            PG8_WAIT_V(6); PG8_BAR; PG8_MMA(1, 1, At, B1); PG8_BAR;
            PG8_LDB(B0, 1, 0); PG8_SCHED; PG8_LDA(At, 1, 0); PG8_STAGE(PG8_SA(0, 1), a2 + hstep, voffA);
            PG8_WAIT_L(8); PG8_BAR; PG8_WAIT_L(0); PG8_MMA(0, 0, At, B0); PG8_BAR; PG8_SCHED;
            PG8_LDB(B1, 1, 1); PG8_STAGE(PG8_SB(1, 0), b3, voffB);
            PG8_BAR; PG8_WAIT_L(0); PG8_MMA(0, 1, At, B1); PG8_BAR;
            PG8_LDA(At, 1, 1); PG8_STAGE(PG8_SA(1, 0), a3, voffA);
            PG8_BAR; PG8_WAIT_L(0); PG8_MMA(1, 0, At, B0); PG8_BAR; PG8_SCHED;
            PG8_STAGE(PG8_SB(1, 1), b3 + hstep, voffB);
            PG8_WAIT_V(6); PG8_BAR; PG8_MMA(1, 1, At, B1); PG8_BAR;
            }
        }
        if constexpr (ALIGN_EPI) { if (wr == 0) PG8_BAR; }
        if constexpr (!Epi::AFTER_DRAIN) { E(acc, cur, wr, wc, fr, fq); S.done(cur); }
        if (!has_next) break;
#pragma unroll
        for (int a = 0; a < 2; ++a)
#pragma unroll
            for (int b = 0; b < 2; ++b)
#pragma unroll
                for (int m = 0; m < 4; ++m)
#pragma unroll
                    for (int n = 0; n < 2; ++n) acc[a][b][m][n] = (f32x4){0.f, 0.f, 0.f, 0.f};
        cur = nxt; cA = nA; cB = nB; ++ui;
        if constexpr (ALIGN_EPI) { if (wr == 1) PG8_BAR; }
    }
    PG8_WAIT_V(0);
    if constexpr (!ALIGN_EPI) { if (wr == 0) PG8_BAR; }
    PG8_BAR;
#undef PG8_SA
#undef PG8_SB
#undef PG8_STAGE
#undef PG8_LDA
#undef PG8_LDB
#undef PG8_MMA
#undef PG8_WAIT_V
#undef PG8_WAIT_L
#undef PG8_BAR
#undef PG8_SCHED
}
}

constexpr int D = 1024, NB = 4, SEQ = 8192, CTXL = 256, ML = NB * SEQ, MC = NB * CTXL, MALL = ML + MC;
constexpr int FF = 2816, MI = 2048, NH = 4, DH = 512, HROWS = 2 * SEQ;
constexpr float EPS = 1e-6f, ML_NORM_EPS = 1e-5f;
constexpr float HY_MAX_DECAY = -15.350567286626973f, HY_MIN_DECAY = -3.0701134573253945f;
constexpr int NWAVES = 8, NTHR = 512;
constexpr int LDS_BYTES = 147456;

constexpr size_t MiB = 1u << 20;
constexpr size_t WS_MOD = 1 * MiB;
constexpr size_t WS_CTXX = 2 * MiB;
constexpr size_t WS_H3 = 6 * MiB;
constexpr size_t WS_KTC = 9 * MiB;
constexpr size_t WS_GWT = 11 * MiB;
constexpr size_t WS_WKQ = 11 * MiB + 256 * 1024;
constexpr size_t WS_NC = 12 * MiB;
constexpr size_t WS_WHIN = 16 * MiB, WS_WHOUT = 22 * MiB, WS_WMIN = 24 * MiB, WS_WMDN = 32 * MiB, WS_WUP0 = 36 * MiB, WS_WUP1 = 47 * MiB, WS_WDN0 = 58 * MiB, WS_WDN1 = 58 * MiB + 5767168;
constexpr size_t WS_GATES_L = 69 * MiB;
constexpr size_t WS_GATES_C = 70 * MiB;
constexpr size_t WS_GT_L = 71 * MiB;
constexpr size_t WS_GT_C = 73 * MiB;
constexpr size_t WS_GC = 73 * MiB + 512 * 1024;
constexpr size_t WS_DN = 74 * MiB;
constexpr size_t WS_RS = 79 * MiB;
constexpr size_t WS_INV = 79 * MiB + 512 * 1024;
constexpr size_t BIG = 80 * MiB;
constexpr size_t HY_H = BIG, HY_P = BIG + 66 * MiB, HY_KT = BIG + 264 * MiB, HY_ZT = BIG + 328 * MiB, HY_ZTC = BIG + 392 * MiB, HY_KS = BIG + 394 * MiB;
constexpr size_t FF_H = BIG, FF_A = BIG + 66 * MiB, FF_G = BIG + 248 * MiB;
constexpr size_t MS_H = BIG, MS_XM = BIG + 32 * MiB, MS_XC = BIG + 96 * MiB, MS_KT = BIG + 160 * MiB, MS_VT = BIG + 224 * MiB, MS_NF = BIG + 288 * MiB, MS_NB = BIG + 352 * MiB,
                 MS_KTC = BIG + 416 * MiB, MS_VTC = BIG + 420 * MiB;
constexpr size_t MS_S = MS_XM, MS_Z = MS_KT, MS_KN = MS_NF, MS_XCC = MS_NB, MS_XMC = MS_NB + 4 * MiB, MS_HC = MS_NB + 8 * MiB;
constexpr size_t WS_END = BIG + 424 * MiB;
static_assert(WS_END <= 512 * MiB, "workspace map");
static_assert(FF_G + (size_t)MALL * FF * 2 <= 512 * MiB && FF_A + (size_t)MALL * FF * 2 <= FF_G, "ffn map");
static_assert(HY_P + (size_t)MALL * 3072 * 2 <= HY_KT && HY_ZTC + (size_t)NB * D * CTXL * 2 <= HY_KS && HY_KS + 32 * MiB <= 512 * MiB, "hyena map");

__device__ __forceinline__ unsigned f2bf(float f) { unsigned u = __float_as_uint(f); return (u + 0x7fffu + ((u >> 16) & 1u)) >> 16; }
typedef __bf16 bf16x2_t __attribute__((ext_vector_type(2)));
__device__ __forceinline__ unsigned pk2(float lo, float hi) { const f32x2 v = {lo, hi}; const bf16x2_t b = __builtin_convertvector(v, bf16x2_t); return __builtin_bit_cast(unsigned, b); }
__device__ __forceinline__ float bf2f(unsigned short b) { return __uint_as_float(((unsigned)b) << 16); }
__device__ __forceinline__ float bflo(unsigned w) { return __uint_as_float(w << 16); }
__device__ __forceinline__ float bfhi(unsigned w) { return __uint_as_float(w & 0xffff0000u); }
__device__ __forceinline__ void unpack8(const u32x4 v, float (&o)[8]) { o[0] = bflo(v.x); o[1] = bfhi(v.x); o[2] = bflo(v.y); o[3] = bfhi(v.y); o[4] = bflo(v.z); o[5] = bfhi(v.z); o[6] = bflo(v.w); o[7] = bfhi(v.w); }
__device__ __forceinline__ u32x4 pack8(const float (&o)[8]) { u32x4 v; v.x = pk2(o[0], o[1]); v.y = pk2(o[2], o[3]); v.z = pk2(o[4], o[5]); v.w = pk2(o[6], o[7]); return v; }
__device__ __forceinline__ float wave_sum(float v) {
#pragma unroll
    for (int o = 1; o < 64; o <<= 1) v += __shfl_xor(v, o);
    return v;
}
__device__ __forceinline__ float silu_f(float x) { return x * __builtin_amdgcn_rcpf(1.0f + __expf(-x)); }

typedef const float* cfptr_t;
struct Fr {
    LAS unsigned char* lds; int tid, lane, wave, gw, ngw, G, bid;
    const __attribute__((address_space(4))) cfptr_t* in; float* out; unsigned char* ws;
};
#define IN(i) (F.in[i])
enum { I_X = 0, I_C, I_CTX, I_CCTX, I_MODW, I_MODB, I_NORMG, I_FINALG, I_HWIN, I_HBIN, I_HSCW, I_HSCB, I_FW1, I_FB1, I_FW2, I_FB2, I_FW3, I_FB3, I_FWOUT, I_FREQ, I_HBIAS, I_HWOUT, I_HBOUT,
       I_MWIN, I_MCW, I_MCB, I_MWQ, I_MWK, I_MWV, I_MWG, I_MBG, I_MNW, I_MSKIP, I_MWDN, I_FWUP, I_FCW, I_FCB, I_FWDN };

__device__ __forceinline__ void transpose_item(const float* W, int K, int N, bf16* WT, LAS float* scr, int item, int lane) {
    const int nblk = N / 32, kb = item / nblk, nb = item % nblk, k0 = 64 * kb, n0 = 32 * nb;
    float tv[32];
#pragma unroll
    for (int i = 0; i < 32; ++i) tv[i] = W[(size_t)(k0 + 2 * i + (lane >> 5)) * N + n0 + (lane & 31)];
#pragma unroll
    for (int i = 0; i < 32; ++i) scr[(2 * i + (lane >> 5)) * 33 + (lane & 31)] = tv[i];
    asm volatile("s_waitcnt lgkmcnt(0)" ::: "memory");
    const int c = lane & 7;
#pragma unroll
    for (int j = 0; j < 4; ++j) { const int n = (lane >> 3) + 8 * j; const LAS float* s = scr + (8 * c) * 33 + n;
        u32x4 o; o.x = pk2(s[0 * 33], s[1 * 33]); o.y = pk2(s[2 * 33], s[3 * 33]); o.z = pk2(s[4 * 33], s[5 * 33]); o.w = pk2(s[6 * 33], s[7 * 33]);
        *(u32x4*)(WT + (size_t)(n0 + n) * K + k0 + 8 * c) = o; }
    asm volatile("s_waitcnt lgkmcnt(0)" ::: "memory");
}
__device__ __forceinline__ void transpose_matrix(Fr& F, const float* W, int K, int N, bf16* WT) {
    LAS float* scr = (LAS float*)(F.lds + F.wave * 16384);
    const int nitems = (K / 64) * (N / 32);
    for (int it = F.gw; it < nitems; it += F.ngw) transpose_item(W, K, N, WT, scr, it, F.lane);
}

__device__ __forceinline__ void transpose_group(Fr& F, int grp, int vb, int nvb) {
    unsigned char* ws = F.ws; LAS float* scr = (LAS float*)(F.lds + F.wave * 16384);
    constexpr int I0 = (D / 64) * (3 * D / 32), I1 = (D / 64) * (D / 32), I2 = (D / 64) * (2 * MI / 32), I3 = (MI / 64) * (D / 32), I4 = (D / 64) * (2 * FF / 32), I5 = (FF / 64) * (D / 32);
    const int nit = grp == 0 ? I0 : (grp == 1 ? I1 : I2 + I3 + 2 * I4 + 2 * I5);
    for (int it = vb * NWAVES + F.wave; it < nit; it += nvb * NWAVES) {
        int r = it;
        if (grp == 0) { transpose_item(IN(I_HWIN), D, 3 * D, (bf16*)(ws + WS_WHIN), scr, r, F.lane); continue; }
        if (grp == 1) { transpose_item(IN(I_HWOUT), D, D, (bf16*)(ws + WS_WHOUT), scr, r, F.lane); continue; }
        if (r < I4) { transpose_item(IN(I_FWUP), D, 2 * FF, (bf16*)(ws + WS_WUP0), scr, r, F.lane); continue; } r -= I4;
        if (r < I5) { transpose_item(IN(I_FWDN), FF, D, (bf16*)(ws + WS_WDN0), scr, r, F.lane); continue; } r -= I5;
        if (r < I2) { transpose_item(IN(I_MWIN), D, 2 * MI, (bf16*)(ws + WS_WMIN), scr, r, F.lane); continue; } r -= I2;
        if (r < I3) { transpose_item(IN(I_MWDN), MI, D, (bf16*)(ws + WS_WMDN), scr, r, F.lane); continue; } r -= I3;
        if (r < I4) { transpose_item(IN(I_FWUP) + (size_t)D * 2 * FF, D, 2 * FF, (bf16*)(ws + WS_WUP1), scr, r, F.lane); continue; } r -= I4;
        transpose_item(IN(I_FWDN) + (size_t)FF * D, FF, D, (bf16*)(ws + WS_WDN1), scr, r, F.lane);
    }
}
__device__ __forceinline__ void transpose_in_tail(Fr& F, int grp, int nunits) {
    const int busy = nunits % F.G;
    if (busy == 0) transpose_group(F, grp, F.bid, F.G);
    else if (F.bid >= busy) transpose_group(F, grp, F.bid - busy, F.G - busy);
}

__device__ __forceinline__ void mod_layer(Fr& F, int l, int vb, int nvb) {
    LAS float* sc = (LAS float*)F.lds;
    LAS float* red = (LAS float*)(F.lds + 32768);
    __syncthreads();
    for (int i = F.tid; i < 5 * 1024; i += NTHR) { const int r = i >> 10, k = i & 1023; const float v = r < 4 ? IN(I_C)[r * 1024 + k] : IN(I_CCTX)[k]; sc[i] = silu_f(v); }
    __syncthreads();
    float* mod = (float*)(F.ws + WS_MOD);
    for (int it = vb; it < 96; it += nvb) {
        const int n0 = it * 64;
        const float* w = IN(I_MODW) + (size_t)l * 1024 * 6144 + n0 + F.lane;
        float a0 = 0.f, a1 = 0.f, a2 = 0.f, a3 = 0.f, a4 = 0.f;
        const int kb = F.wave * 128;
#pragma unroll 16
        for (int k = 0; k < 128; ++k) { const float wv = w[(size_t)(kb + k) * 6144];
            a0 += sc[kb + k] * wv; a1 += sc[1024 + kb + k] * wv; a2 += sc[2048 + kb + k] * wv; a3 += sc[3072 + kb + k] * wv; a4 += sc[4096 + kb + k] * wv; }
        red[(F.wave * 5 + 0) * 64 + F.lane] = a0; red[(F.wave * 5 + 1) * 64 + F.lane] = a1; red[(F.wave * 5 + 2) * 64 + F.lane] = a2; red[(F.wave * 5 + 3) * 64 + F.lane] = a3; red[(F.wave * 5 + 4) * 64 + F.lane] = a4;
        __syncthreads();
        if (F.tid < 320) { const int r = F.tid >> 6, ln = F.tid & 63; float s = 0.f;
#pragma unroll
            for (int w8 = 0; w8 < 8; ++w8) s += red[(w8 * 5 + r) * 64 + ln];
            mod[((size_t)l * 5 + r) * 6144 + n0 + ln] = s + IN(I_MODB)[l * 6144 + n0 + ln]; }
        __syncthreads();
    }
}

__device__ __forceinline__ void ph_prologue(Fr& F) {
    unsigned char* ws = F.ws;
    transpose_group(F, 0, F.bid, F.G);
    __syncthreads();
    mod_layer(F, 0, F.bid, F.G);
    {
        float* h3 = (float*)(ws + WS_H3);
        float w1c[33], w2c[64], w3c[64];
        { const float* w1 = IN(I_FW1) + F.lane; const float* w2 = IN(I_FW2) + F.lane; const float* w3 = IN(I_FW3) + F.lane;
#pragma unroll
            for (int kk = 0; kk < 33; ++kk) w1c[kk] = w1[kk * 64];
#pragma unroll
            for (int kk = 0; kk < 64; ++kk) { w2c[kk] = w2[kk * 64]; w3c[kk] = w3[kk * 64]; } }
        const float fr = IN(I_FREQ)[F.lane], b1 = IN(I_FB1)[F.lane], b2 = IN(I_FB2)[F.lane], b3 = IN(I_FB3)[F.lane];
#pragma unroll 1
        for (int row = F.gw; row < SEQ + CTXL; row += F.ngw) {
            const int L = row < SEQ ? SEQ : CTXL, i = row < SEQ ? row : row - SEQ;
            const float tl = (float)i / (float)(L - 1), w = 6.283185307179586f * (float)i / (float)L;
            float pos = 0.f; const int k = F.lane;
            if (k == 0) pos = tl;
            else if (k <= 16) { const float band = 1e-4f + (float)(k - 1) * ((15.0f - 1e-4f) / 15.0f); pos = cosf(band * w); }
            else if (k <= 32) { const float band = 1e-4f + (float)(k - 17) * ((15.0f - 1e-4f) / 15.0f); pos = -sinf(band * w); }
            float s = b1;
#pragma unroll
            for (int kk = 0; kk < 33; ++kk) s += __builtin_bit_cast(float, __builtin_amdgcn_readlane(__builtin_bit_cast(int, pos), kk)) * w1c[kk];
            float h = sinf(fr * s);
            s = b2;
#pragma unroll
            for (int kk = 0; kk < 64; ++kk) s += __builtin_bit_cast(float, __builtin_amdgcn_readlane(__builtin_bit_cast(int, h), kk)) * w2c[kk];
            h = sinf(fr * s);
            s = b3;
#pragma unroll
            for (int kk = 0; kk < 64; ++kk) s += __builtin_bit_cast(float, __builtin_amdgcn_readlane(__builtin_bit_cast(int, h), kk)) * w3c[kk];
            h = sinf(fr * s);
            h3[(size_t)row * 64 + F.lane] = h;
        }
    }
    {
        bf16* gwt = (bf16*)(ws + WS_GWT); float* wkq = (float*)(ws + WS_WKQ);
        const float* wq = IN(I_MWQ); const float* wk = IN(I_MWK); const float* wv = IN(I_MWV); const float* wg = IN(I_MWG);
        const int gt = F.bid * NTHR + F.tid, nt = F.G * NTHR;
        for (int i = gt; i < MI * 16; i += nt) { const int ch = i >> 4, g = i & 15, n = ch >> 2, c = ch & 3; float sa = 0.f, sb = 0.f;
#pragma unroll
            for (int e = 0; e < 4; ++e) { sa += wq[n * 16 + c * 4 + e] * wg[(size_t)(n * 4 + e) * 16 + g] + wk[n * 16 + c * 4 + e] * wg[(size_t)(MI + n * 4 + e) * 16 + g];
                sb += wv[n * 16 + c * 4 + e] * wg[(size_t)(2 * MI + n * 4 + e) * 16 + g]; }
            const size_t go = ((size_t)(ch >> 5) * 64 + g + 16 * ((ch & 31) >> 3)) * 8 + (ch & 7);
            gwt[go] = (bf16)f2bf(sa); gwt[go + 64 * 512] = (bf16)f2bf(sb); }
        const float sc = 0.044194173824159216f;
        for (int i = gt; i < 512 * 16; i += nt) { const int n = i >> 4, c = (i >> 2) & 3, c2 = i & 3; float s = 0.f;
#pragma unroll
            for (int e = 0; e < 4; ++e) s += wk[n * 16 + c * 4 + e] * wq[n * 16 + c2 * 4 + e];
            wkq[i] = s * sc; }
    }
}

__device__ __forceinline__ void kt_items(Fr& F, const float* h3rows, int L, float* KT, int vgw, int vngw) {
    const float* wout = IN(I_FWOUT);
    const int nitems = (L / 16) * 32, fr = F.lane & 15, fq = F.lane >> 4;
    for (int it = vgw; it < nitems; it += vngw) {
        const int t0 = (it >> 5) * 16, n0 = (it & 31) * 64;
        float a[16];
#pragma unroll
        for (int ks = 0; ks < 16; ++ks) a[ks] = h3rows[(size_t)(t0 + fr) * 64 + 4 * ks + fq];
#pragma unroll
        for (int nt = 0; nt < 4; ++nt) {
            f32x4 acc = (f32x4){0.f, 0.f, 0.f, 0.f};
#pragma unroll
            for (int ks = 0; ks < 16; ++ks) acc = __builtin_amdgcn_mfma_f32_16x16x4f32(a[ks], wout[(size_t)(4 * ks + fq) * 2048 + n0 + nt * 16 + fr], acc, 0, 0, 0);
            const int n = n0 + nt * 16 + fr, dirn = n >> 10, c = n & 1023;
            const float delta = fabsf(HY_MIN_DECAY + (float)c * ((HY_MAX_DECAY - HY_MIN_DECAY) / 1023.0f)), il = 1.0f / (float)(L - 1);
            f32x4 o;
#pragma unroll
            for (int r = 0; r < 4; ++r) o[r] = acc[r] * __expf(-(float)(t0 + 4 * fq + r) * il * delta);
            *(f32x4*)(KT + ((size_t)c * 2 + dirn) * L + t0 + 4 * fq) = o;
        }
    }
}

__device__ __forceinline__ void modnorm_row(const float* xrow, const float* g, const float* sh, const float* sc, bf16* orow, int lane) {
    const f32x4* xr = (const f32x4*)xrow + lane; f32x4 v[4]; float s = 0.f;
#pragma unroll
    for (int j = 0; j < 4; ++j) { v[j] = xr[64 * j]; s += (v[j][0] * v[j][0] + v[j][1] * v[j][1]) + (v[j][2] * v[j][2] + v[j][3] * v[j][3]); }
    const float rinv = 1.0f / sqrtf(wave_sum(s) * (1.0f / 1024.0f) + EPS);
    u32x2* o8 = (u32x2*)orow + lane;
#pragma unroll
    for (int j = 0; j < 4; ++j) { const int c = 4 * lane + 256 * j; const f32x4 gg = *(const f32x4*)(g + c), s1 = *(const f32x4*)(sc + c), s0 = *(const f32x4*)(sh + c);
        const f32x4 y = (v[j] * rinv * gg) * (1.0f + s1) + s0; u32x2 w; w.x = pk2(y[0], y[1]); w.y = pk2(y[2], y[3]); o8[64 * j] = w; }
}
__device__ __forceinline__ void ph_modnorm(Fr& F, const float* xlat, int nlat, int b0, const float* xctx, int nctx, const float* g, const float* modl, int shoff, bf16* H,
                                           const bf16* dl = nullptr, float* olat = nullptr, float* octx = nullptr) {
    const int nrows = nlat + nctx;
    for (int r = F.gw; r < nrows; r += 2 * F.ngw) {
        const int r2 = r + F.ngw; const bool has2 = r2 < nrows; const int rb = has2 ? r2 : r;
        const bool isl = r < nlat, isl2 = rb < nlat;
        const size_t oa_ = isl ? (size_t)r * 1024 : (size_t)(r - nlat) * 1024, ob_ = isl2 ? (size_t)rb * 1024 : (size_t)(rb - nlat) * 1024;
        const float* xa = (isl ? xlat : xctx) + oa_; const float* xb = (isl2 ? xlat : xctx) + ob_;
        const int ma = isl ? b0 + r / SEQ : 4, mb = isl2 ? b0 + rb / SEQ : 4;
        const f32x4* pa = (const f32x4*)xa + F.lane; const f32x4* pb = (const f32x4*)xb + F.lane; f32x4 va[4], vb[4]; float sa = 0.f, sb = 0.f;
#pragma unroll
        for (int j = 0; j < 4; ++j) { va[j] = pa[64 * j]; vb[j] = pb[64 * j]; }
        if (dl) {
            const u32x2* da = (const u32x2*)(dl + (size_t)r * 1024) + F.lane; const u32x2* db = (const u32x2*)(dl + (size_t)rb * 1024) + F.lane;
            f32x4* qa = (f32x4*)((isl ? olat : octx) + oa_) + F.lane; f32x4* qb = (f32x4*)((isl2 ? olat : octx) + ob_) + F.lane;
#pragma unroll
            for (int j = 0; j < 4; ++j) { const u32x2 a = da[64 * j], b = db[64 * j];
                va[j] = va[j] + (f32x4){bflo(a.x), bfhi(a.x), bflo(a.y), bfhi(a.y)}; vb[j] = vb[j] + (f32x4){bflo(b.x), bfhi(b.x), bflo(b.y), bfhi(b.y)};
                qa[64 * j] = va[j]; if (has2) qb[64 * j] = vb[j]; }
        }
#pragma unroll
        for (int j = 0; j < 4; ++j) { sa += (va[j][0] * va[j][0] + va[j][1] * va[j][1]) + (va[j][2] * va[j][2] + va[j][3] * va[j][3]); sb += (vb[j][0] * vb[j][0] + vb[j][1] * vb[j][1]) + (vb[j][2] * vb[j][2] + vb[j][3] * vb[j][3]); }
        const float ra = __builtin_amdgcn_rsqf(wave_sum(sa) * (1.0f / 1024.0f) + EPS), rbv = __builtin_amdgcn_rsqf(wave_sum(sb) * (1.0f / 1024.0f) + EPS);
        const float* sha = modl + (size_t)ma * 6144 + shoff; const float* shb = modl + (size_t)mb * 6144 + shoff;
        u32x2* oa = (u32x2*)(H + (size_t)r * 1024) + F.lane; u32x2* ob = (u32x2*)(H + (size_t)rb * 1024) + F.lane;
#pragma unroll
        for (int j = 0; j < 4; ++j) { const int c = 4 * F.lane + 256 * j; const f32x4 gg = *(const f32x4*)(g + c);
            const f32x4 ya = (va[j] * ra * gg) * (1.0f + *(const f32x4*)(sha + 1024 + c)) + *(const f32x4*)(sha + c);
            const f32x4 yb = (vb[j] * rbv * gg) * (1.0f + *(const f32x4*)(shb + 1024 + c)) + *(const f32x4*)(shb + c);
            oa[64 * j] = (u32x2){pk2(ya[0], ya[1]), pk2(ya[2], ya[3])};
            if (has2) ob[64 * j] = (u32x2){pk2(yb[0], yb[1]), pk2(yb[2], yb[3])}; }
    }
}
__device__ __forceinline__ void add_delta_rows(Fr& F, float* x, const bf16* dl, int r0, int n) {
    for (int r = r0 + F.gw; r < r0 + n; r += F.ngw) {
        f32x4* px = (f32x4*)(x + (size_t)r * 1024) + F.lane; const u32x2* pd = (const u32x2*)(dl + (size_t)r * 1024) + F.lane; f32x4 v[4]; u32x2 d[4];
#pragma unroll
        for (int j = 0; j < 4; ++j) { v[j] = px[64 * j]; d[j] = pd[64 * j]; }
#pragma unroll
        for (int j = 0; j < 4; ++j) px[64 * j] = v[j] + (f32x4){bflo(d[j].x), bfhi(d[j].x), bflo(d[j].y), bfhi(d[j].y)};
    }
}

__device__ __forceinline__ void zt_items(Fr& F, const bf16* __restrict__ P, int rowbase, int nb, int Ls, bf16* __restrict__ ZT) {
    LAS unsigned char* tile = F.lds + F.wave * 16384;
    const float* scw = IN(I_HSCW); const float* scb = IN(I_HSCB);
    const int ntt = Ls / 64, nitems = nb * ntt * 16, tl = F.lane >> 3, c8 = F.lane & 7;
    for (int it = F.gw; it < nitems; it += F.ngw) {
        const int ct = it & 15, tt = (it >> 4) % ntt, b = (it >> 4) / ntt, t0 = tt * 64, ch = ct * 64 + c8 * 8;
        float w1[3][8], w2[3][8], b1[8], b2[8];
#pragma unroll
        for (int k = 0; k < 3; ++k) { const f32x4 a0 = *(const f32x4*)(scw + k * 3072 + 1024 + ch), a1 = *(const f32x4*)(scw + k * 3072 + 1024 + ch + 4), d0 = *(const f32x4*)(scw + k * 3072 + 2048 + ch), d1 = *(const f32x4*)(scw + k * 3072 + 2048 + ch + 4);
#pragma unroll
            for (int e = 0; e < 4; ++e) { w1[k][e] = a0[e]; w1[k][4 + e] = a1[e]; w2[k][e] = d0[e]; w2[k][4 + e] = d1[e]; } }
        { const f32x4 a0 = *(const f32x4*)(scb + 1024 + ch), a1 = *(const f32x4*)(scb + 1024 + ch + 4), d0 = *(const f32x4*)(scb + 2048 + ch), d1 = *(const f32x4*)(scb + 2048 + ch + 4);
#pragma unroll
            for (int e = 0; e < 4; ++e) { b1[e] = a0[e]; b1[4 + e] = a1[e]; b2[e] = d0[e]; b2[4 + e] = d1[e]; } }
        const bf16* pb = P + (size_t)(rowbase + b * Ls) * 3072 + ch;
#pragma unroll 4
        for (int i8 = 0; i8 < 8; ++i8) {
            const int tloc = i8 * 8 + tl, t = t0 + tloc, tm = t > 0 ? t - 1 : t, tp = t + 1 < Ls ? t + 1 : t; const float mm = t > 0 ? 1.f : 0.f, mp = t + 1 < Ls ? 1.f : 0.f;
            const u32x4 r1m = *(const u32x4*)(pb + (size_t)tm * 3072 + 1024), r1c = *(const u32x4*)(pb + (size_t)t * 3072 + 1024), r1p = *(const u32x4*)(pb + (size_t)tp * 3072 + 1024);
            const u32x4 r2m = *(const u32x4*)(pb + (size_t)tm * 3072 + 2048), r2c = *(const u32x4*)(pb + (size_t)t * 3072 + 2048), r2p = *(const u32x4*)(pb + (size_t)tp * 3072 + 2048);
            float xm[8], xc[8], xp[8], vm[8], vc[8], vp[8];
            unpack8(r1m, xm); unpack8(r1c, xc); unpack8(r1p, xp); unpack8(r2m, vm); unpack8(r2c, vc); unpack8(r2p, vp);
            float zz[8];
#pragma unroll
            for (int e = 0; e < 8; ++e) { const float a = w1[0][e] * (xm[e] * mm) + w1[1][e] * xc[e] + w1[2][e] * (xp[e] * mp) + b1[e], d = w2[0][e] * (vm[e] * mm) + w2[1][e] * vc[e] + w2[2][e] * (vp[e] * mp) + b2[e]; zz[e] = a * d; }
#pragma unroll
            for (int e = 0; e < 8; e += 2) { const unsigned p = pk2(zz[e], zz[e + 1]);
                *(LAS bf16*)(tile + (c8 * 8 + e) * 136 + tloc * 2) = (bf16)(p & 0xffffu); *(LAS bf16*)(tile + (c8 * 8 + e + 1) * 136 + tloc * 2) = (bf16)(p >> 16); }
        }
#pragma unroll
        for (int q = 0; q < 8; ++q) { const int cc = q * 8 + (F.lane >> 3), chk = F.lane & 7;
            const u32x2 lo = *(const LAS u32x2*)(tile + cc * 136 + chk * 16), hi = *(const LAS u32x2*)(tile + cc * 136 + chk * 16 + 8);
            u32x4 o; o.x = lo.x; o.y = lo.y; o.z = hi.x; o.w = hi.y;
            *(u32x4*)(ZT + ((size_t)b * 1024 + ct * 64 + cc) * Ls + t0 + chk * 8) = o; }
    }
}

__device__ __forceinline__ f32x2 cmul(f32x2 a, f32x2 b) { return (f32x2){a.x * b.x - a.y * b.y, a.x * b.y + a.y * b.x}; }
__device__ __forceinline__ f32x2 cmulc(f32x2 a, f32x2 b) { return (f32x2){a.x * b.x + a.y * b.y, a.y * b.x - a.x * b.y}; }
__device__ __forceinline__ f32x2 twid(float f) { return (f32x2){__builtin_amdgcn_cosf(f), __builtin_amdgcn_sinf(f)}; }
#define PH(e) ((e) + ((e) >> 4))
__device__ __forceinline__ void fft_fwd(LAS f32x2* buf, int tid, int plo, int phi) {
#pragma unroll 1
    for (int p = plo; p < phi; ++p) {
        const int lq = 12 - 2 * p, q = 1 << lq; const float invN = 1.0f / (float)(4 * q);
#pragma unroll 2
        for (int m = 0; m < 8; ++m) {
            const int g = tid + 512 * m, i = g & (q - 1), i0 = ((g >> lq) << (lq + 2)) + i;
            const int e0 = PH(i0), e1 = PH(i0 + q), e2 = PH(i0 + 2 * q), e3 = PH(i0 + 3 * q);
            const f32x2 a0 = buf[e0], a1 = buf[e1], a2 = buf[e2], a3 = buf[e3];
            const f32x2 t0 = a0 + a2, t1 = a0 - a2, t2 = a1 + a3, d = a1 - a3, t3 = (f32x2){d.y, -d.x};
            const f32x2 w1 = twid(-(float)i * invN), w2 = cmul(w1, w1), w3 = cmul(w2, w1);
            buf[e0] = t0 + t2; buf[e1] = cmul(t1 + t3, w1); buf[e2] = cmul(t0 - t2, w2); buf[e3] = cmul(t1 - t3, w3);
        }
        __syncthreads();
    }
}
__device__ __forceinline__ void fft_inv(LAS f32x2* buf, int tid, int plo, int phi) {
#pragma unroll 1
    for (int p = phi - 1; p >= plo; --p) {
        const int lq = 12 - 2 * p, q = 1 << lq; const float invN = 1.0f / (float)(4 * q);
#pragma unroll 2
        for (int m = 0; m < 8; ++m) {
            const int g = tid + 512 * m, i = g & (q - 1), i0 = ((g >> lq) << (lq + 2)) + i;
            const int e0 = PH(i0), e1 = PH(i0 + q), e2 = PH(i0 + 2 * q), e3 = PH(i0 + 3 * q);
            const f32x2 w1 = twid((float)i * invN), w2 = cmul(w1, w1), w3 = cmul(w2, w1);
            const f32x2 b0 = buf[e0], b1 = cmul(buf[e1], w1), b2 = cmul(buf[e2], w2), b3 = cmul(buf[e3], w3);
            const f32x2 t0 = b0 + b2, t1 = b0 - b2, t2 = b1 + b3, d = b1 - b3, t3 = (f32x2){-d.y, d.x};
            buf[e0] = t0 + t2; buf[e1] = t1 + t3; buf[e2] = t0 - t2; buf[e3] = t1 - t3;
        }
        __syncthreads();
    }
}
__device__ __forceinline__ void fwd16_A(f32x2 (&x)[16]) {
    const float C1 = 0.92387953251128674f, S1 = 0.38268343236508977f, R2 = 0.70710678118654752f;
#pragma unroll
    for (int i = 0; i < 4; ++i) {
        const f32x2 a0 = x[i], a1 = x[i + 4], a2 = x[i + 8], a3 = x[i + 12];
        const f32x2 t0 = a0 + a2, t1 = a0 - a2, t2 = a1 + a3, d = a1 - a3, t3 = (f32x2){d.y, -d.x};
        const f32x2 y1 = t1 + t3, y2 = t0 - t2, y3 = t1 - t3;
        x[i] = t0 + t2;
        if (i == 0) { x[4] = y1; x[8] = y2; x[12] = y3; }
        else if (i == 1) { x[5] = cmul(y1, (f32x2){C1, -S1}); x[9] = cmul(y2, (f32x2){R2, -R2}); x[13] = cmul(y3, (f32x2){S1, -C1}); }
        else if (i == 2) { x[6] = cmul(y1, (f32x2){R2, -R2}); x[10] = (f32x2){y2.y, -y2.x}; x[14] = cmul(y3, (f32x2){-R2, -R2}); }
        else { x[7] = cmul(y1, (f32x2){S1, -C1}); x[11] = cmul(y2, (f32x2){-R2, -R2}); x[15] = cmul(y3, (f32x2){-C1, S1}); }
    }
}
__device__ __forceinline__ void fwd16_B(f32x2 (&x)[16]) {
#pragma unroll
    for (int g = 0; g < 4; ++g) {
        const f32x2 a0 = x[4 * g], a1 = x[4 * g + 1], a2 = x[4 * g + 2], a3 = x[4 * g + 3];
        const f32x2 t0 = a0 + a2, t1 = a0 - a2, t2 = a1 + a3, d = a1 - a3, t3 = (f32x2){d.y, -d.x};
        x[4 * g] = t0 + t2; x[4 * g + 1] = t1 + t3; x[4 * g + 2] = t0 - t2; x[4 * g + 3] = t1 - t3;
    }
}
__device__ __forceinline__ void inv16_B(f32x2 (&x)[16]) {
#pragma unroll
    for (int g = 0; g < 4; ++g) {
        const f32x2 b0 = x[4 * g], b1 = x[4 * g + 1], b2 = x[4 * g + 2], b3 = x[4 * g + 3];
        const f32x2 t0 = b0 + b2, t1 = b0 - b2, t2 = b1 + b3, d = b1 - b3, t3 = (f32x2){-d.y, d.x};
        x[4 * g] = t0 + t2; x[4 * g + 1] = t1 + t3; x[4 * g + 2] = t0 - t2; x[4 * g + 3] = t1 - t3;
    }
}
__device__ __forceinline__ void inv16_A(f32x2 (&x)[16]) {
    const float C1 = 0.92387953251128674f, S1 = 0.38268343236508977f, R2 = 0.70710678118654752f;
#pragma unroll
    for (int i = 0; i < 4; ++i) {
        f32x2 b0 = x[i], b1 = x[i + 4], b2 = x[i + 8], b3 = x[i + 12];
        if (i == 1) { b1 = cmul(b1, (f32x2){C1, S1}); b2 = cmul(b2, (f32x2){R2, R2}); b3 = cmul(b3, (f32x2){S1, C1}); }
        else if (i == 2) { b1 = cmul(b1, (f32x2){R2, R2}); b2 = (f32x2){-b2.y, b2.x}; b3 = cmul(b3, (f32x2){-R2, R2}); }
        else if (i == 3) { b1 = cmul(b1, (f32x2){S1, C1}); b2 = cmul(b2, (f32x2){-R2, R2}); b3 = cmul(b3, (f32x2){-C1, -S1}); }
        const f32x2 t0 = b0 + b2, t1 = b0 - b2, t2 = b1 + b3, d = b1 - b3, t3 = (f32x2){-d.y, d.x};
        x[i] = t0 + t2; x[i + 4] = t1 + t3; x[i + 8] = t0 - t2; x[i + 12] = t1 - t3;
    }
}
__device__ __forceinline__ void fwd16(f32x2 (&x)[16]) { fwd16_A(x); fwd16_B(x); }
__device__ __forceinline__ void inv16(f32x2 (&x)[16]) { inv16_B(x); inv16_A(x); }
__device__ __forceinline__ void r16_fwd2(LAS f32x2* buf, int tid) {
#pragma unroll 1
  for (int lqp = 8; lqp >= 4; lqp -= 4) {
    const int qp = 1 << lqp; const float inv = 1.0f / (float)(16 * qp);
#pragma unroll
    for (int m = 0; m < 2; ++m) {
        const int g = tid + 512 * m, i = g & (qp - 1), e0 = ((g >> lqp) << (lqp + 4)) + i; f32x2 x[16];
#pragma unroll
        for (int j = 0; j < 16; ++j) x[j] = buf[PH(e0 + (j << lqp))];
        const f32x2 w1 = twid(-(float)i * inv), w2 = cmul(w1, w1), w3 = cmul(w2, w1), v1 = cmul(w2, w2), v2 = cmul(v1, v1), v3 = cmul(v2, v1);
        fwd16_A(x);
#pragma unroll
        for (int l = 0; l < 4; ++l) { x[l + 4] = cmul(x[l + 4], w1); x[l + 8] = cmul(x[l + 8], w2); x[l + 12] = cmul(x[l + 12], w3); }
        fwd16_B(x);
#pragma unroll
        for (int k = 0; k < 4; ++k) { x[4 * k + 1] = cmul(x[4 * k + 1], v1); x[4 * k + 2] = cmul(x[4 * k + 2], v2); x[4 * k + 3] = cmul(x[4 * k + 3], v3); }
#pragma unroll
        for (int j = 0; j < 16; ++j) buf[PH(e0 + (j << lqp))] = x[j];
    }
    __syncthreads();
  }
}
__device__ __forceinline__ void r16_inv2(LAS f32x2* buf, int tid) {
#pragma unroll 1
  for (int lqp = 4; lqp <= 8; lqp += 4) {
    const int qp = 1 << lqp; const float inv = 1.0f / (float)(16 * qp);
#pragma unroll
    for (int m = 0; m < 2; ++m) {
        const int g = tid + 512 * m, i = g & (qp - 1), e0 = ((g >> lqp) << (lqp + 4)) + i; f32x2 x[16];
#pragma unroll
        for (int j = 0; j < 16; ++j) x[j] = buf[PH(e0 + (j << lqp))];
        const f32x2 w1 = twid((float)i * inv), w2 = cmul(w1, w1), w3 = cmul(w2, w1), v1 = cmul(w2, w2), v2 = cmul(v1, v1), v3 = cmul(v2, v1);
#pragma unroll
        for (int k = 0; k < 4; ++k) { x[4 * k + 1] = cmul(x[4 * k + 1], v1); x[4 * k + 2] = cmul(x[4 * k + 2], v2); x[4 * k + 3] = cmul(x[4 * k + 3], v3); }
        inv16_B(x);
#pragma unroll
        for (int l = 0; l < 4; ++l) { x[l + 4] = cmul(x[l + 4], w1); x[l + 8] = cmul(x[l + 8], w2); x[l + 12] = cmul(x[l + 12], w3); }
        inv16_A(x);
#pragma unroll
        for (int j = 0; j < 16; ++j) buf[PH(e0 + (j << lqp))] = x[j];
    }
    __syncthreads();
  }
}
__device__ __forceinline__ float block_sum(Fr& F, float v, LAS float* red) {
    v = wave_sum(v);
    __syncthreads();
    if (F.lane == 0) red[F.wave] = v;
    __syncthreads();
    float s = 0.f;
#pragma unroll
    for (int w = 0; w < 8; ++w) s += red[w];
    return s;
}
__device__ __forceinline__ void ph_fftconv(Fr& F) {
    LAS f32x2* buf = (LAS f32x2*)F.lds; LAS float* red = (LAS float*)(F.lds + 139392);
    const float* KT = (const float*)(F.ws + HY_KT); const float* KTC = (const float*)(F.ws + WS_KTC);
    bf16* ZT = (bf16*)(F.ws + HY_ZT); bf16* ZTC = (bf16*)(F.ws + HY_ZTC);
    const int tid = F.tid;
    for (int c = F.bid; c < 1024; c += F.G) {
        const float bias = IN(I_HBIAS)[c];
        __syncthreads();
        float asum = 0.f;
        const f32x4* kf = (const f32x4*)(KT + (size_t)c * 2 * SEQ); const f32x4* kb = kf + SEQ / 4;
#pragma unroll
        for (int q = 0; q < 4; ++q) { const int i4 = tid + 512 * q; const f32x4 v = kf[i4];
            asum += fabsf(v[0]) + fabsf(v[1]) + fabsf(v[2]) + fabsf(v[3]);
            buf[PH(4 * i4)] = (f32x2){v[0], 0.f}; buf[PH(4 * i4 + 1)] = (f32x2){v[1], 0.f}; buf[PH(4 * i4 + 2)] = (f32x2){v[2], 0.f}; buf[PH(4 * i4 + 3)] = (f32x2){v[3], 0.f};
            const f32x4 u = kb[i4]; const int m = 4 * i4;
            if (m > 0) { buf[PH(16384 - m)] = (f32x2){u[0], 0.f}; asum += fabsf(u[0]); } else buf[PH(8192)] = (f32x2){0.f, 0.f};
            buf[PH(16384 - m - 1)] = (f32x2){u[1], 0.f}; buf[PH(16384 - m - 2)] = (f32x2){u[2], 0.f}; buf[PH(16384 - m - 3)] = (f32x2){u[3], 0.f};
            asum += fabsf(u[1]) + fabsf(u[2]) + fabsf(u[3]); }
        const float S = block_sum(F, asum, red);
        __syncthreads();
        fft_fwd(buf, tid, 0, 1); r16_fwd2(buf, tid);
        f32x4* Ks = (f32x4*)(F.ws + HY_KS) + (size_t)(F.bid & 255) * 8192 + tid * 8; const float ksc = 1.0f / (S * 16384.0f);
#pragma unroll 1
        for (int m = 0; m < 2; ++m) { const int pb = 17 * (tid + 512 * m); f32x2 x[16];
#pragma unroll
            for (int n = 0; n < 16; ++n) x[n] = buf[pb + n];
            fwd16(x);
#pragma unroll
            for (int n = 0; n < 8; ++n) Ks[m * 4096 + n] = (f32x4){x[2 * n].x * ksc, x[2 * n].y * ksc, x[2 * n + 1].x * ksc, x[2 * n + 1].y * ksc}; }
        const f32x2 dl = twid(-1.0f / 16384.0f);
#pragma unroll 1
        for (int pr = 0; pr < 2; ++pr) {
            bf16* z0 = ZT + ((size_t)(2 * pr) * 1024 + c) * SEQ; bf16* z1 = ZT + ((size_t)(2 * pr + 1) * 1024 + c) * SEQ;
            const int i8 = tid * 8;
            __syncthreads();
            {
                float a[8], b[8], cx[8], dx[8];
                unpack8(*(const u32x4*)(z0 + i8), a); unpack8(*(const u32x4*)(z1 + i8), b); unpack8(*(const u32x4*)(z0 + 4096 + i8), cx); unpack8(*(const u32x4*)(z1 + 4096 + i8), dx);
                f32x2 w1 = twid(-(float)i8 * (1.0f / 16384.0f));
#pragma unroll
                for (int e = 0; e < 8; ++e) { const f32x2 a0 = (f32x2){a[e], b[e]}, a1 = (f32x2){cx[e], dx[e]}, t3 = (f32x2){a1.y, -a1.x}; const f32x2 w2 = cmul(w1, w1), w3 = cmul(w2, w1);
                    buf[PH(i8 + e)] = a0 + a1; buf[PH(4096 + i8 + e)] = cmul(a0 + t3, w1); buf[PH(8192 + i8 + e)] = cmul(a0 - a1, w2); buf[PH(12288 + i8 + e)] = cmul(a0 - t3, w3);
                    w1 = cmul(w1, dl); }
            }
            __syncthreads();
            r16_fwd2(buf, tid);
#pragma unroll 1
            for (int m = 0; m < 2; ++m) { const int pb = 17 * (tid + 512 * m); f32x2 x[16];
#pragma unroll
                for (int n = 0; n < 16; ++n) x[n] = buf[pb + n];
                fwd16(x);
#pragma unroll
                for (int n = 0; n < 8; ++n) { const f32x4 k = Ks[m * 4096 + n]; x[2 * n] = cmul(x[2 * n], (f32x2){k[0], k[1]}); x[2 * n + 1] = cmul(x[2 * n + 1], (f32x2){k[2], k[3]}); }
                inv16(x);
#pragma unroll
                for (int n = 0; n < 16; ++n) buf[pb + n] = x[n]; }
            __syncthreads();
            r16_inv2(buf, tid);
            {
                float a[8], b[8], cx[8], dx[8];
                unpack8(*(const u32x4*)(z0 + i8), a); unpack8(*(const u32x4*)(z1 + i8), b); unpack8(*(const u32x4*)(z0 + 4096 + i8), cx); unpack8(*(const u32x4*)(z1 + 4096 + i8), dx);
                f32x2 w1 = twid(-(float)i8 * (1.0f / 16384.0f));
#pragma unroll
                for (int e = 0; e < 8; ++e) { const f32x2 w2 = cmul(w1, w1), w3 = cmul(w2, w1);
                    const f32x2 b0 = buf[PH(i8 + e)], b1 = cmulc(buf[PH(4096 + i8 + e)], w1), b2 = cmulc(buf[PH(8192 + i8 + e)], w2), b3 = cmulc(buf[PH(12288 + i8 + e)], w3);
                    const f32x2 t0 = b0 + b2, t1 = b0 - b2, t2 = b1 + b3, d = b1 - b3, t3 = (f32x2){-d.y, d.x};
                    const f32x2 y0 = t0 + t2, y1 = t1 + t3;
                    a[e] = y0.x + a[e] * bias; b[e] = y0.y + b[e] * bias; cx[e] = y1.x + cx[e] * bias; dx[e] = y1.y + dx[e] * bias;
                    w1 = cmul(w1, dl); }
                *(u32x4*)(z0 + i8) = pack8(a); *(u32x4*)(z1 + i8) = pack8(b); *(u32x4*)(z0 + 4096 + i8) = pack8(cx); *(u32x4*)(z1 + 4096 + i8) = pack8(dx);
            }
        }
        __syncthreads();
        {
            LAS float* kc = (LAS float*)F.lds; LAS float* zc = kc + 512;
            const float* kfc = KTC + (size_t)c * 2 * CTXL; float v = 0.f;
            { const int n = tid; if (n < 256) v = kfc[n]; else if (n == 256) v = 0.f; else v = kfc[CTXL + (512 - n)]; kc[n] = v; }
            const float Sc = block_sum(F, fabsf(v), red);
            for (int i = tid; i < 1024; i += NTHR) { const int b = i >> 8, t = i & 255; zc[i] = bf2f(ZTC[((size_t)b * 1024 + c) * CTXL + t]); }
            __syncthreads();
            const int b = tid >> 7, t2 = tid & 127; const float isc = 1.0f / Sc;
#pragma unroll
            for (int hh = 0; hh < 2; ++hh) { const int t = t2 + 128 * hh; float acc = 0.f;
#pragma unroll 8
                for (int s = 0; s < 256; ++s) acc += zc[b * 256 + s] * kc[(t - s) & 511];
                ZTC[((size_t)b * 1024 + c) * CTXL + t] = (bf16)f2bf(acc * isc + zc[b * 256 + t] * bias); }
        }
    }
}

__device__ __forceinline__ void u2_items(Fr& F, const bf16* __restrict__ P, int rowbase, int nb, int Ls, const bf16* __restrict__ YT, bf16* __restrict__ U2) {
    LAS unsigned char* tile = F.lds + F.wave * 16384;
    const float* scw = IN(I_HSCW); const float* scb = IN(I_HSCB);
    const int ntt = Ls / 64, nitems = nb * ntt * 16, tl = F.lane >> 3, c8 = F.lane & 7;
    for (int it = F.gw; it < nitems; it += F.ngw) {
        const int ct = it & 15, tt = (it >> 4) % ntt, b = (it >> 4) / ntt, t0 = tt * 64, ch = ct * 64 + c8 * 8;
#pragma unroll
        for (int q = 0; q < 8; ++q) { const int cc = q * 8 + (F.lane >> 3), chk = F.lane & 7;
            const u32x4 v = *(const u32x4*)(YT + ((size_t)b * 1024 + ct * 64 + cc) * Ls + t0 + chk * 8);
            *(LAS u32x2*)(tile + cc * 136 + chk * 16) = (u32x2){v.x, v.y}; *(LAS u32x2*)(tile + cc * 136 + chk * 16 + 8) = (u32x2){v.z, v.w}; }
        float w0[3][8], bb[8];
#pragma unroll
        for (int k = 0; k < 3; ++k) { const f32x4 a0 = *(const f32x4*)(scw + k * 3072 + ch), a1 = *(const f32x4*)(scw + k * 3072 + ch + 4);
#pragma unroll
            for (int e = 0; e < 4; ++e) { w0[k][e] = a0[e]; w0[k][4 + e] = a1[e]; } }
        { const f32x4 a0 = *(const f32x4*)(scb + ch), a1 = *(const f32x4*)(scb + ch + 4);
#pragma unroll
            for (int e = 0; e < 4; ++e) { bb[e] = a0[e]; bb[4 + e] = a1[e]; } }
        const bf16* pb = P + (size_t)(rowbase + b * Ls) * 3072 + ch; bf16* ub = U2 + (size_t)(rowbase + b * Ls) * 1024 + ch;
#pragma unroll 4
        for (int i8 = 0; i8 < 8; ++i8) {
            const int tloc = i8 * 8 + tl, t = t0 + tloc, tm = t > 0 ? t - 1 : t, tp = t + 1 < Ls ? t + 1 : t; const float mm = t > 0 ? 1.f : 0.f, mp = t + 1 < Ls ? 1.f : 0.f;
            const u32x4 rm = *(const u32x4*)(pb + (size_t)tm * 3072), rc = *(const u32x4*)(pb + (size_t)t * 3072), rp = *(const u32x4*)(pb + (size_t)tp * 3072);
            float xm[8], xc[8], xp[8], o[8];
            unpack8(rm, xm); unpack8(rc, xc); unpack8(rp, xp);
#pragma unroll
            for (int e = 0; e < 8; ++e) { const float x0 = w0[0][e] * (xm[e] * mm) + w0[1][e] * xc[e] + w0[2][e] * (xp[e] * mp) + bb[e]; o[e] = x0 * bf2f(*(const LAS bf16*)(tile + (c8 * 8 + e) * 136 + tloc * 2)); }
            *(u32x4*)(ub + (size_t)t * 1024) = pack8(o);
        }
    }
}

__device__ __forceinline__ void dw_item(const bf16* __restrict__ G, bf16* __restrict__ A, const float* __restrict__ cw, const float* __restrict__ cb, int f8, int rowtok0, int nx, int x0, bool up_ok, bool down_ok) {
    float w[9][8], bias[8];
#pragma unroll
    for (int k = 0; k < 9; ++k) { const float m = (k < 3) ? (up_ok ? 1.f : 0.f) : ((k >= 6) ? (down_ok ? 1.f : 0.f) : 1.f);
        const f32x4 w0 = *(const f32x4*)(cw + (size_t)k * FF + f8) * m, w1 = *(const f32x4*)(cw + (size_t)k * FF + f8 + 4) * m;
        w[k][0] = w0[0]; w[k][1] = w0[1]; w[k][2] = w0[2]; w[k][3] = w0[3]; w[k][4] = w1[0]; w[k][5] = w1[1]; w[k][6] = w1[2]; w[k][7] = w1[3]; }
    { const f32x4 b0 = *(const f32x4*)(cb + f8), b1 = *(const f32x4*)(cb + f8 + 4); bias[0] = b0[0]; bias[1] = b0[1]; bias[2] = b0[2]; bias[3] = b0[3]; bias[4] = b1[0]; bias[5] = b1[1]; bias[6] = b1[2]; bias[7] = b1[3]; }
    const int upo = up_ok ? -nx : 0, dno = down_ok ? nx : 0;
    const bf16* __restrict__ g0 = G + (size_t)rowtok0 * FF + f8; bf16* __restrict__ a0 = A + (size_t)rowtok0 * FF + f8;
    const u32x4 zero4 = (u32x4){0u, 0u, 0u, 0u};
    u32x4 cm[3], cc[3];
    { const int xm = x0 > 0 ? x0 - 1 : 0; const bool okm = x0 > 0;
        cm[0] = *(const u32x4*)(g0 + (size_t)(xm + upo) * FF); cm[1] = *(const u32x4*)(g0 + (size_t)xm * FF); cm[2] = *(const u32x4*)(g0 + (size_t)(xm + dno) * FF);
        if (!okm) { cm[0] = zero4; cm[1] = zero4; cm[2] = zero4; }
        cc[0] = *(const u32x4*)(g0 + (size_t)(x0 + upo) * FF); cc[1] = *(const u32x4*)(g0 + (size_t)x0 * FF); cc[2] = *(const u32x4*)(g0 + (size_t)(x0 + dno) * FF); }
    u32x4 pa[2][3], pav[2], pb[2][3], pbv[2];
#define DW_LOAD_GROUP(buf, bufv, jg) do { _Pragma("unroll") for (int u = 0; u < 2; ++u) { const int x_ = x0 + (jg) + u, xp_ = x_ + 1 < nx ? x_ + 1 : nx - 1; \
        buf[u][0] = *(const u32x4*)(g0 + (size_t)(xp_ + upo) * FF); buf[u][1] = *(const u32x4*)(g0 + (size_t)xp_ * FF); buf[u][2] = *(const u32x4*)(g0 + (size_t)(xp_ + dno) * FF); \
        bufv[u] = *(const u32x4*)(a0 + (size_t)x_ * FF); } } while (0)
#define DW_COMPUTE_GROUP(buf, bufv, jg) do { _Pragma("unroll") for (int u = 0; u < 2; ++u) { \
        const int x = x0 + (jg) + u; const bool okp = x + 1 < nx; \
        if (!okp) { buf[u][0] = zero4; buf[u][1] = zero4; buf[u][2] = zero4; } \
        float acc[8]; \
        _Pragma("unroll") for (int e = 0; e < 8; ++e) acc[e] = bias[e]; \
        _Pragma("unroll") for (int dy = 0; dy < 3; ++dy) { float v[8]; \
            unpack8(cm[dy], v); _Pragma("unroll") for (int e = 0; e < 8; ++e) acc[e] += v[e] * w[dy * 3 + 0][e]; \
            unpack8(cc[dy], v); _Pragma("unroll") for (int e = 0; e < 8; ++e) acc[e] += v[e] * w[dy * 3 + 1][e]; \
            unpack8(buf[u][dy], v); _Pragma("unroll") for (int e = 0; e < 8; ++e) acc[e] += v[e] * w[dy * 3 + 2][e]; } \
        float a[8]; unpack8(bufv[u], a); \
        _Pragma("unroll") for (int e = 0; e < 8; ++e) a[e] = silu_f(acc[e]) * a[e]; \
        *(u32x4*)(a0 + (size_t)x * FF) = pack8(a); \
        _Pragma("unroll") for (int dy = 0; dy < 3; ++dy) { cm[dy] = cc[dy]; cc[dy] = buf[u][dy]; } } } while (0)
    DW_LOAD_GROUP(pa, pav, 0);
#pragma unroll 1
    for (int jg = 0; jg < 32; jg += 4) {
        DW_LOAD_GROUP(pb, pbv, jg + 2);
        DW_COMPUTE_GROUP(pa, pav, jg);
        { const int jn = jg + 4 < 32 ? jg + 4 : jg; DW_LOAD_GROUP(pa, pav, jn); }
        DW_COMPUTE_GROUP(pb, pbv, jg + 2);
    }
#undef DW_COMPUTE_GROUP
#undef DW_LOAD_GROUP
}
__device__ __forceinline__ void ph_dwconv(Fr& F, int layer, int nlat, int nctx) {
    bf16* A = (bf16*)(F.ws + FF_A); const bf16* G = (const bf16*)(F.ws + FF_G);
    const float* cw = IN(I_FCW) + (size_t)layer * 9 * FF; const float* cb = IN(I_FCB) + (size_t)layer * FF;
    const int ngrp = (F.G % 8 == 0) ? 8 : 1, xg = F.bid % ngrp, lb = F.bid / ngrp, nlb = F.G / ngrp;
    const int nseg = nlat / 32, band = nseg / ngrp;
    for (int i = lb * NTHR + F.tid; i < band * 352; i += nlb * NTHR) {
        const int sl = i / 352, f8 = (i - sl * 352) * 8, seg = xg * band + sl, grow = seg >> 1, gy = grow & 127;
        dw_item(G, A, cw, cb, f8, grow * 64, 64, (seg & 1) * 32, gy > 0, gy < 127);
    }
    const int nsegc = nctx / 32;
    for (int i = F.bid * NTHR + F.tid; i < nsegc * 352; i += F.G * NTHR) {
        const int sl = i / 352, f8 = (i - sl * 352) * 8;
        dw_item(G, A, cw, cb, f8, nlat + (sl >> 3) * CTXL, CTXL, (sl & 7) * 32, false, false);
    }
}

__device__ __forceinline__ void prep_items(Fr& F, const bf16* __restrict__ XM, int nb, int Ls, bf16* __restrict__ XC, bf16* __restrict__ KN, bf16* __restrict__ KT, bf16* __restrict__ VT) {
    LAS unsigned char* tk = F.lds + F.wave * 17408; LAS unsigned char* tv = tk + 8704;
    const int ntt = Ls / 64, nitems = nb * ntt * 32;
    const int tl = F.lane >> 3, c8 = F.lane & 7;
    for (int it = F.gw; it < nitems; it += F.ngw) {
        const int cg = it & 31, tt = (it >> 5) % ntt, b = (it >> 5) / ntt, t0 = tt * 64, ch0 = cg * 64 + c8 * 8, h = cg >> 3;
        float cw0[8], cw1[8], cw2[8], cbb[8], wkq[32], wv[32];
        { const float* p = IN(I_MCW) + ch0; const float* pb = IN(I_MCB) + ch0;
#pragma unroll
            for (int e = 0; e < 8; ++e) { cw0[e] = p[e]; cw1[e] = p[MI + e]; cw2[e] = p[2 * MI + e]; cbb[e] = pb[e]; }
            const float* q = (const float*)(F.ws + WS_WKQ) + (ch0 >> 2) * 16; const float* v = IN(I_MWV) + (ch0 >> 2) * 16;
#pragma unroll
            for (int e = 0; e < 32; ++e) { wkq[e] = q[e]; wv[e] = v[e]; } }
#pragma unroll 4
        for (int i8 = 0; i8 < 8; ++i8) {
            const int tloc = i8 * 8 + tl, t = t0 + tloc; const size_t row = (size_t)b * Ls + t;
            float xp[8], xm[8], xn[8];
            const size_t rowp = row - (t > 0 ? 1 : 0), rown = row + (t + 1 < Ls ? 1 : 0); const size_t ctile = (size_t)(ch0 >> 5) * 512 + ((ch0 & 31) >> 3) * 128;
            const u32x4 rm = *(const u32x4*)(XM + (row >> 4) * 32768 + ctile + (row & 15) * 8), rp = *(const u32x4*)(XM + (rowp >> 4) * 32768 + ctile + (rowp & 15) * 8), rn = *(const u32x4*)(XM + (rown >> 4) * 32768 + ctile + (rown & 15) * 8);
            unpack8(rm, xm); unpack8(rp, xp); unpack8(rn, xn);
            { const float mp = t > 0 ? 1.f : 0.f, mn = t + 1 < Ls ? 1.f : 0.f;
#pragma unroll
                for (int e = 0; e < 8; ++e) { xp[e] *= mp; xn[e] *= mn; } }
            float xc[8], kp[8], vv[8];
#pragma unroll
            for (int e = 0; e < 8; ++e) xc[e] = silu_f(cw0[e] * xp[e] + cw1[e] * xm[e] + cw2[e] * xn[e] + cbb[e]);
#pragma unroll
            for (int n = 0; n < 2; ++n)
#pragma unroll
                for (int o = 0; o < 4; ++o) { float sk = 0.f, sv = 0.f;
#pragma unroll
                    for (int c = 0; c < 4; ++c) { sk += xc[n * 4 + c] * wkq[n * 16 + c * 4 + o]; sv += xm[n * 4 + c] * wv[n * 16 + c * 4 + o]; }
                    kp[n * 4 + o] = sk; vv[n * 4 + o] = sv; }
            { const size_t to = ((size_t)(row >> 4) * 64 + (ch0 >> 5)) * 512 + (((unsigned)row & 15u) + 16u * ((ch0 & 31) >> 3)) * 8u;
              *(u32x4*)(XC + to) = pack8(xc); }
#pragma unroll
            for (int e = 0; e < 8; e += 2) { const unsigned pk = pk2(kp[e], kp[e + 1]), pv = pk2(vv[e], vv[e + 1]);
                *(LAS bf16*)(tk + (c8 * 8 + e) * 136 + tloc * 2) = (bf16)(pk & 0xffffu); *(LAS bf16*)(tk + (c8 * 8 + e + 1) * 136 + tloc * 2) = (bf16)(pk >> 16);
                *(LAS bf16*)(tv + (c8 * 8 + e) * 136 + tloc * 2) = (bf16)(pv & 0xffffu); *(LAS bf16*)(tv + (c8 * 8 + e + 1) * 136 + tloc * 2) = (bf16)(pv >> 16); }
        }
#pragma unroll
        for (int q = 0; q < 8; ++q) { const int dt = q >> 1, kq = q & 1, r = F.lane & 15, q4 = F.lane >> 4;
            const size_t tile = ((size_t)(t0 >> 7) * 32 + (cg & 7) * 4 + dt) * 4 + ((t0 & 127) >> 5) + kq;
            const size_t o = (size_t)(b * 4 + h) * 512 * Ls + tile * 512 + F.lane * 8;
            { const u32x2 lo = *(const LAS u32x2*)(tk + (dt * 16 + r) * 136 + kq * 64 + q4 * 16), hi = *(const LAS u32x2*)(tk + (dt * 16 + r) * 136 + kq * 64 + q4 * 16 + 8); *(u32x4*)(KT + o) = (u32x4){lo.x, lo.y, hi.x, hi.y}; }
            { const u32x2 lo = *(const LAS u32x2*)(tv + (dt * 16 + r) * 136 + kq * 64 + q4 * 16), hi = *(const LAS u32x2*)(tv + (dt * 16 + r) * 136 + kq * 64 + q4 * 16 + 8); *(u32x4*)(VT + o) = (u32x4){lo.x, lo.y, hi.x, hi.y}; }
        }
    }
}

__device__ __forceinline__ void gate_items(Fr& F, const bf16* XC, const bf16* XM, int R, float* GATES) {
    const bf16* gwt = (const bf16*)(F.ws + WS_GWT);
    const int fr = F.lane & 15, fq = F.lane >> 4, half = F.wave & 1, pr = F.wave >> 1, ntiles = R / 16;
    LAS f32x4* xch = (LAS f32x4*)(F.lds + pr * 1024);
    for (int base = F.bid * 4; base < ntiles; base += F.G * 4) {
        const int tile = base + pr; const bool ok = tile < ntiles; const int tl = ok ? tile : 0;
        f32x4 acc = (f32x4){0.f, 0.f, 0.f, 0.f};
        const bf16* ap = (half ? XM : XC) + (size_t)tl * 32768 + F.lane * 8; const bf16* bp = gwt + (size_t)half * 64 * 512 + F.lane * 8;
#pragma unroll 16
        for (int ks = 0; ks < 64; ++ks) acc = __builtin_amdgcn_mfma_f32_16x16x32_bf16(*(const bf16x8*)(ap + ks * 512), *(const bf16x8*)(bp + ks * 512), acc, 0, 0, 0);
        __syncthreads();
        if (half) xch[F.lane] = acc;
        __syncthreads();
        if (!half && ok) { acc = acc + xch[F.lane];
            const int r0 = tile * 16; const float bg = IN(I_MBG)[fr]; const bool isf = (fr >> 2) & 1;
#pragma unroll
            for (int r = 0; r < 4; ++r) { float x = acc[r] + bg; if (isf) x = fminf(x, 0.f) - log1pf(__expf(-fabsf(x))); GATES[(size_t)(r0 + 4 * fq + r) * 16 + fr] = x; } }
    }
}

__device__ __forceinline__ void cum_items(Fr& F, const float* GATES, int nb, int Ls, int gb0, int ctau0, f32x4* GT, float* GC) {
    const int R = nb * Ls, nch = Ls / 128, nitems = 2 * nb * 4 * nch;
    for (int it = F.gw; it < nitems; it += F.ngw) {
        const int c = it % nch, h = (it / nch) & 3, b = (it / nch / 4) % nb, dir = it / nch / 4 / nb;
        const int row0 = b * Ls + c * 128 + 2 * F.lane;
        const float lf0 = GATES[(size_t)row0 * 16 + dir * 8 + 4 + h], lf1 = GATES[(size_t)(row0 + 1) * 16 + dir * 8 + 4 + h];
        const float ig0 = GATES[(size_t)row0 * 16 + dir * 8 + h], ig1 = GATES[(size_t)(row0 + 1) * 16 + dir * 8 + h];
        float inc = lf0 + lf1;
#pragma unroll
        for (int o = 1; o < 64; o <<= 1) { const float t = __shfl_up(inc, o); if (F.lane >= o) inc += t; }
        const float tot = __shfl(inc, 63), exc = inc - (lf0 + lf1);
        float b0, b1;
        if (dir == 0) { b0 = exc + lf0; b1 = inc; } else { b0 = tot - exc; b1 = tot - exc - lf0; }
        GT[(size_t)(dir * 4 + h) * R + row0] = (f32x4){b0, ig0 - b0, __expf(b0), __expf(tot - b0 + ig0)};
        GT[(size_t)(dir * 4 + h) * R + row0 + 1] = (f32x4){b1, ig1 - b1, __expf(b1), __expf(tot - b1 + ig1)};
        if (F.lane == 0) GC[((size_t)(dir * 4 + gb0 + b) * 4 + h) * 66 + ctau0 + c] = __expf(tot);
    }
}

__device__ __forceinline__ void cum_block(Fr& F, const float* GATES, int grow0, int h, f32x4* GT0, f32x4* GT1, float* GC0, float* GC1, LAS float* tab) {
    if (F.wave < 2) {
        const int dir = F.wave, j0 = 2 * F.lane;
        const float* gp = GATES + (size_t)(grow0 + j0) * 16 + dir * 8 + h;
        const float ig0 = gp[0], lf0 = gp[4], ig1 = gp[16], lf1 = gp[20];
        float inc = lf0 + lf1;
#pragma unroll
        for (int o = 1; o < 64; o <<= 1) { const float t = __shfl_up(inc, o); if (F.lane >= o) inc += t; }
        const float tot = __shfl(inc, 63), exc = inc - (lf0 + lf1);
        float b0, b1;
        if (dir == 0) { b0 = exc + lf0; b1 = inc; } else { b0 = tot - exc; b1 = tot - exc - lf0; }
        const float w0 = __expf(tot - b0 + ig0), w1 = __expf(tot - b1 + ig1);
        f32x4* gt = (dir ? GT1 : GT0) + grow0 + j0;
        gt[0] = (f32x4){b0, ig0 - b0, __expf(b0), w0}; gt[1] = (f32x4){b1, ig1 - b1, __expf(b1), w1};
        LAS float* t = tab + dir * 384;
        t[j0] = b0; t[j0 + 1] = b1; t[128 + j0] = ig0 - b0; t[128 + j0 + 1] = ig1 - b1; t[256 + j0] = w0; t[256 + j0 + 1] = w1;
        if (F.lane == 0) *(dir ? GC1 : GC0) = __expf(tot);
    }
}
__device__ __forceinline__ void dn_block(Fr& F, const bf16* KTchunk, const LAS float* tab, float* DN0, float* DN1) {
    const LAS float* w0 = tab + 256; const LAS float* w1 = tab + 384 + 256;
    const bf16* kr = KTchunk + (size_t)(F.tid >> 4) * 4 * 512 + (F.tid & 15) * 8; float s0 = 0.f, s1 = 0.f;
#pragma unroll 4
    for (int q = 0; q < 16; ++q) { const int ks = q >> 2, q4 = q & 3; float v[8]; unpack8(*(const u32x4*)(kr + ks * 512 + q4 * 128), v);
#pragma unroll
        for (int e = 0; e < 8; ++e) { s0 += v[e] * w0[q * 8 + e]; s1 += v[e] * w1[q * 8 + e]; } }
    DN0[F.tid] = s0; DN1[F.tid] = s1;
}
typedef short v4i16_t __attribute__((ext_vector_type(4)));
__device__ __forceinline__ v4i16_t lds_tr16(const LAS unsigned char* p) { return __builtin_amdgcn_ds_read_tr16_b64_v4i16((LAS v4i16_t*)p); }
__device__ __forceinline__ void ph_sphase(Fr& F, int hb, bool with_ctx) {
    const bf16* XC = (const bf16*)(F.ws + MS_XC); const bf16* KT = (const bf16*)(F.ws + MS_KT);
    f32x4* GT = (f32x4*)(F.ws + WS_GT_L); float* DN = (float*)(F.ws + WS_DN); float* RS = (float*)(F.ws + WS_RS); float* GC = (float*)(F.ws + WS_GC);
    const float* GATES = (const float*)(F.ws + WS_GATES_L);
    bf16* S = (bf16*)(F.ws + MS_S);
    LAS unsigned char* kl = F.lds;
    LAS float* tab = (LAS float*)(F.lds + 131072 + 256);
    const int fr = F.lane & 15, fq = F.lane >> 4, w = F.wave;
    const unsigned q_ = (F.lane & 15) >> 2, p_ = F.lane & 3;
    const unsigned trb = ((unsigned)(fq >> 1) * 4u) * 1024u + (8u * (fq & 1) + q_ + 16u * (p_ >> 1)) * 16u + 8u * (p_ & 1);
    for (int it = F.bid; it < 512; it += F.G) {
        const int c = it & 63, h = (it >> 6) & 3, bl = it >> 8, gb = 2 * hb + bl;
        const int row0 = bl * SEQ + c * 128;
        __syncthreads();
        { const char* kc = (const char*)(KT + (size_t)(bl * 4 + h) * 512 * SEQ + (size_t)c * 65536); u32x4 t[16];
#pragma unroll
            for (int i = 0; i < 16; ++i) t[i] = *(const u32x4*)(kc + i * 8192 + F.tid * 16);
#pragma unroll
            for (int i = 0; i < 16; ++i) *(LAS u32x4*)(kl + i * 8192 + F.tid * 16) = t[i]; }
        cum_block(F, GATES, row0, h, GT + (size_t)(0 * 4 + h) * HROWS, GT + (size_t)(1 * 4 + h) * HROWS,
                  GC + ((size_t)(0 * 4 + gb) * 4 + h) * 66 + 2 + c, GC + ((size_t)(1 * 4 + gb) * 4 + h) * 66 + 2 + c, tab);
        __syncthreads();
        {
            const LAS float* w0 = tab + 256; const LAS float* w1 = tab + 384 + 256;
            const LAS unsigned char* kr = kl + (F.tid >> 4) * 4096 + (F.tid & 15) * 16; float s0 = 0.f, s1 = 0.f;
#pragma unroll 4
            for (int q = 0; q < 16; ++q) { const int ks = q >> 2, q4 = q & 3; float v[8]; unpack8(*(const LAS u32x4*)(kr + ks * 1024 + q4 * 256), v);
#pragma unroll
                for (int e = 0; e < 8; ++e) { s0 += v[e] * w0[q * 8 + e]; s1 += v[e] * w1[q * 8 + e]; } }
            DN[(((size_t)(0 * 4 + gb) * 4 + h) * 66 + 2 + c) * 512 + F.tid] = s0; DN[(((size_t)(1 * 4 + gb) * 4 + h) * 66 + 2 + c) * 512 + F.tid] = s1;
        }
        const int irow = row0 + 16 * w + fr;
        bf16x8 bq[16];
        { const bf16* p = XC + ((size_t)((row0 >> 4) + w) * 64 + h * 16) * 512 + F.lane * 8;
#pragma unroll
            for (int ks = 0; ks < 16; ++ks) bq[ks] = *(const bf16x8*)(p + ks * 512); }
        const float bif = tab[16 * w + fr], bib = tab[384 + 16 * w + fr];
        float rsf = 0.f, rsb = 0.f;
        bf16* sf = S + ((size_t)(0 * 8 + bl * 4 + h) * 64 + c) * 16384; bf16* sb = S + ((size_t)(1 * 8 + bl * 4 + h) * 64 + c) * 16384;
#pragma unroll 1
        for (int jt = 0; jt < 8; ++jt) {
            f32x4 acc = (f32x4){0.f, 0.f, 0.f, 0.f};
            const LAS unsigned char* ap = kl + trb + (jt >> 1) * 1024 + (jt & 1) * 512;
#pragma unroll
            for (int ks = 0; ks < 16; ++ks) { const v4i16_t lo = lds_tr16(ap + ks * 8192), hi = lds_tr16(ap + ks * 8192 + 64);
                const bf16x8 a = (bf16x8){lo[0], lo[1], lo[2], lo[3], hi[0], hi[1], hi[2], hi[3]};
                acc = __builtin_amdgcn_mfma_f32_16x16x32_bf16(a, bq[ks], acc, 0, 0, 0); }
            float vf[4], vb[4];
            const f32x4 af4 = *(const LAS f32x4*)(tab + 128 + jt * 16 + 4 * fq), ab4 = *(const LAS f32x4*)(tab + 384 + 128 + jt * 16 + 4 * fq);
#pragma unroll
            for (int r = 0; r < 4; ++r) { const int j = jt * 16 + 4 * fq + r, i = 16 * w + fr;
                vf[r] = (j <= i) ? acc[r] * __expf(bif + af4[r]) : 0.f; vb[r] = (j >= i) ? acc[r] * __expf(bib + ab4[r]) : 0.f;
                rsf += vf[r]; rsb += vb[r]; }
            const size_t so = (size_t)(w * 4 + (jt >> 1)) * 512 + (fr + 16 * ((jt & 1) * 2 + (fq >> 1))) * 8 + (fq & 1) * 4;
            *(u32x2*)(sf + so) = (u32x2){pk2(vf[0], vf[1]), pk2(vf[2], vf[3])};
            *(u32x2*)(sb + so) = (u32x2){pk2(vb[0], vb[1]), pk2(vb[2], vb[3])};
        }
        rsf += __shfl_xor(rsf, 16); rsf += __shfl_xor(rsf, 32); rsb += __shfl_xor(rsb, 16); rsb += __shfl_xor(rsb, 32);
        if (fq == 0) { RS[(size_t)(0 * 4 + h) * HROWS + irow] = rsf; RS[(size_t)(1 * 4 + h) * HROWS + irow] = rsb; }
    }
    if (with_ctx) {
        const bf16* KTC2 = (const bf16*)(F.ws + MS_KTC); f32x4* GTC = (f32x4*)(F.ws + WS_GT_C); const float* GATESC = (const float*)(F.ws + WS_GATES_C);
        for (int it = F.bid; it < 32; it += F.G) {
            const int cc = it & 1, h = (it >> 1) & 3, gb = it >> 3;
            __syncthreads();
            cum_block(F, GATESC, gb * CTXL + cc * 128, h, GTC + (size_t)(0 * 4 + h) * MC, GTC + (size_t)(1 * 4 + h) * MC,
                      GC + ((size_t)(0 * 4 + gb) * 4 + h) * 66 + cc, GC + ((size_t)(1 * 4 + gb) * 4 + h) * 66 + cc, tab);
            __syncthreads();
            dn_block(F, KTC2 + (size_t)(gb * 4 + h) * 512 * CTXL + (size_t)cc * 65536, tab,
                     DN + (((size_t)(0 * 4 + gb) * 4 + h) * 66 + cc) * 512, DN + (((size_t)(1 * 4 + gb) * 4 + h) * 66 + cc) * 512);
        }
    }
}

__device__ __forceinline__ bf16x8 ldg16(const char* ub, unsigned off) { return *(const bf16x8*)(ub + off); }
__device__ __forceinline__ void ph_scan(Fr& F, int hb) {
    const char* XC = (const char*)(F.ws + MS_XC); const char* KT = (const char*)(F.ws + MS_KT); const char* VT = (const char*)(F.ws + MS_VT);
    const char* KTC2 = (const char*)(F.ws + MS_KTC); const char* VTC2 = (const char*)(F.ws + MS_VTC);
    const char* S = (const char*)(F.ws + MS_S);
    const f32x4* GTL = (const f32x4*)(F.ws + WS_GT_L); const f32x4* GTC = (const f32x4*)(F.ws + WS_GT_C);
    const float* GC = (const float*)(F.ws + WS_GC); const float* DN = (const float*)(F.ws + WS_DN);
    float* NC = (float*)(F.ws + WS_NC);
    LAS unsigned char* cbf = F.lds;
    LAS float* wl = (LAS float*)(F.lds + 2 * 33280);
    LAS unsigned char* vtb = F.lds + 2 * 33280 + 1024;
    const int w = F.wave;
    for (int wi = F.bid; wi < 256; wi += F.G) {
        const int chain = wi & 15, slice = wi >> 4, dir = chain >> 3, bl = (chain >> 2) & 1, h = chain & 3, gb = 2 * hb + bl, e0 = slice * 32;
        char* NUM = (char*)(F.ws + (dir ? MS_NB : MS_NF));
        const bool nwriter = (slice == 0) && (w == 0);
        f32x4 acc[4][2];
#pragma unroll
        for (int a = 0; a < 4; ++a)
#pragma unroll
            for (int b = 0; b < 2; ++b) acc[a][b] = (f32x4){0.f, 0.f, 0.f, 0.f};
        float nreg[8];
#pragma unroll
        for (int e = 0; e < 8; ++e) nreg[e] = 0.f;
        const char* ktc = KTC2 + (size_t)(gb * 4 + h) * 512 * CTXL * 2; const char* vtc = VTC2 + (size_t)(gb * 4 + h) * 512 * CTXL * 2;
        const char* ktl = KT + (size_t)(bl * 4 + h) * 512 * SEQ * 2;    const char* vtl = VT + (size_t)(bl * 4 + h) * 512 * SEQ * 2;
        const f32x4* gtc = GTC + (size_t)(dir * 4 + h) * MC + gb * CTXL; const f32x4* gtl = GTL + (size_t)(dir * 4 + h) * HROWS + bl * SEQ;
        const float* gcb = GC + ((size_t)(dir * 4 + gb) * 4 + h) * 66; const float* dnb = DN + ((size_t)(dir * 4 + gb) * 4 + h) * 66 * 512;
#pragma unroll 1
        for (int s = 0; s < 2; ++s) {
            const int cc = dir == 0 ? s : 1 - s; const unsigned l16 = F.lane * 16u, fq = F.lane >> 4;
            __syncthreads();
            if (F.tid < 128) wl[F.tid] = gtc[cc * 128 + F.tid][3];
            __syncthreads();
            const float Gd = gcb[cc]; const char* ktu = ktc + (size_t)cc * 131072; const char* vtu = vtc + (size_t)cc * 131072 + (e0 >> 4) * 4096;
#pragma unroll
            for (int a = 0; a < 4; ++a)
#pragma unroll
                for (int b = 0; b < 2; ++b) acc[a][b] = acc[a][b] * Gd;
#pragma unroll
            for (int ks = 0; ks < 4; ++ks) {
                bf16x8 bv[2];
#pragma unroll
                for (int et = 0; et < 2; ++et) { float v[8]; unpack8(__builtin_bit_cast(u32x4, ldg16(vtu + et * 4096 + ks * 1024, l16)), v);
#pragma unroll
                    for (int e = 0; e < 8; ++e) v[e] *= wl[ks * 32 + 8 * fq + e];
                    const u32x4 pv = pack8(v); bv[et] = __builtin_bit_cast(bf16x8, pv); }
#pragma unroll
                for (int dt = 0; dt < 4; ++dt) { const bf16x8 kk = ldg16(ktu + (4 * w + dt) * 4096 + ks * 1024, l16);
#pragma unroll
                    for (int et = 0; et < 2; ++et) acc[dt][et] = __builtin_amdgcn_mfma_f32_16x16x32_bf16(kk, bv[et], acc[dt][et], 0, 0, 0); }
            }
            { const unsigned lo = F.lane * 32u; const f32x4 d0 = *(const f32x4*)((const char*)(dnb + cc * 512) + lo), d1 = *(const f32x4*)((const char*)(dnb + cc * 512) + lo + 16u);
                nreg[0] = Gd * nreg[0] + d0[0]; nreg[1] = Gd * nreg[1] + d0[1]; nreg[2] = Gd * nreg[2] + d0[2]; nreg[3] = Gd * nreg[3] + d0[3];
                nreg[4] = Gd * nreg[4] + d1[0]; nreg[5] = Gd * nreg[5] + d1[1]; nreg[6] = Gd * nreg[6] + d1[2]; nreg[7] = Gd * nreg[7] + d1[3]; }
        }
        const int cfirst = dir == 0 ? 0 : 63;
        bf16x8 xf[16];
        __syncthreads();
        { const int fr = F.lane & 15, fq = F.lane >> 4; const unsigned l16 = F.lane * 16u;
#pragma unroll
            for (int dt = 0; dt < 4; ++dt)
#pragma unroll
                for (int et = 0; et < 2; ++et) *(LAS u32x2*)(cbf + (16 * et + fr) * 1040 + (64 * w + 16 * dt + 4 * fq) * 2) = (u32x2){pk2(acc[dt][et][0], acc[dt][et][1]), pk2(acc[dt][et][2], acc[dt][et][3])};
            if (F.tid < 128) wl[F.tid] = gtl[cfirst * 128 + F.tid][3];
            *(LAS bf16x8*)(vtb + w * 1024 + l16) = ldg16(vtl + (size_t)cfirst * 131072 + (e0 >> 4) * 4096 + w * 1024, l16);
            const char* xc0 = XC + ((size_t)(((bl * SEQ + cfirst * 128) >> 4) + w) * 64 + h * 16) * 1024;
#pragma unroll
            for (int ks = 0; ks < 16; ++ks) xf[ks] = ldg16(xc0 + ks * 1024, l16); }
        __syncthreads();
#pragma unroll 1
        for (int q = 0; q < 64; ++q) {
            int tid_ = F.tid; asm volatile("" : "+v"(tid_));
            const int lane_ = tid_ & 63, fr = lane_ & 15, fq = lane_ >> 4; const unsigned l16 = lane_ * 16u;
            const int c = dir == 0 ? q : 63 - q;
            const int qn = q < 63 ? q + 1 : 63, cn = dir == 0 ? qn : 63 - qn;
            const int qp = q < 62 ? q + 2 : 63, cp = dir == 0 ? qp : 63 - qp;
            const char* ktu = ktl + (size_t)c * 131072;
            const int row0 = bl * SEQ + c * 128;
            const float Gd = gcb[2 + c];
            LAS unsigned char* cb_rd = cbf + (q & 1) * 33280; LAS unsigned char* cb_wr = cbf + ((q + 1) & 1) * 33280;
            const LAS float* wl_rd = wl + (q & 1) * 128; LAS float* wl_wr = wl + ((q + 1) & 1) * 128;
            const LAS unsigned char* vt_rd = vtb + (q & 1) * 8192; LAS unsigned char* vt_wr = vtb + ((q + 1) & 1) * 8192;
            const bf16x8 vnext = ldg16(vtl + (size_t)cn * 131072 + (e0 >> 4) * 4096 + w * 1024, l16);
            const float wnext = *(const float*)((const char*)(gtl + cn * 128) + (unsigned)(tid_ & 127) * 16u + 12u);
            const float Ei = *(const float*)((const char*)(gtl + c * 128 + 16 * w) + (unsigned)fr * 16u + 8u);
            const f32x4 dn0 = *(const f32x4*)((const char*)(dnb + (2 + c) * 512) + lane_ * 32u), dn1 = *(const f32x4*)((const char*)(dnb + (2 + c) * 512) + lane_ * 32u + 16u);
            bf16x8 kf[4][4], vf[2][4], sfr[4];
            { const char* su = S + ((size_t)(dir * 8 + bl * 4 + h) * 64 + c) * 32768 + w * 4096;
#pragma unroll
                for (int ks = 0; ks < 4; ++ks) sfr[ks] = ldg16(su + ks * 1024, l16); }
#pragma unroll
            for (int dt = 0; dt < 4; ++dt) kf[0][dt] = ldg16(ktu + (4 * w + dt) * 4096, l16);
            unsigned pf;
            {
                const char* kt3 = ktl + (size_t)cp * 131072; const char* vt3 = vtl + (size_t)cp * 131072;
                const char* xc3 = XC + ((size_t)((bl * SEQ + cp * 128) >> 4) * 64 + h * 16) * 1024; const char* s3p = S + ((size_t)(dir * 8 + bl * 4 + h) * 64 + cp) * 32768;
                const unsigned t = tid_ < 208 ? tid_ : tid_ - 208; const bool g0 = t < 64, g1 = t < 128, g2 = t < 192;
                const unsigned ln2 = slice * 64 + (t - 128);
                const char* ub = g0 ? kt3 : (g1 ? vt3 : (g2 ? xc3 : s3p));
                const unsigned off = g0 ? (slice * 64 + t) * 128u : (g1 ? (e0 >> 4) * 4096u + (t - 64) * 128u : (g2 ? (ln2 >> 7) * 65536u + (ln2 & 127) * 128u : (slice * 16 + ((t - 192) & 15)) * 128u));
                pf = *(const volatile unsigned*)(ub + off);
            }
#pragma unroll
            for (int et = 0; et < 2; ++et)
#pragma unroll
                for (int ks = 0; ks < 4; ++ks) vf[et][ks] = *(const LAS bf16x8*)(vt_rd + (et * 4 + ks) * 1024 + l16);
            if (nwriter) { char* np = (char*)(NC + (((size_t)(dir * 2 + bl) * 4 + h) * 64 + c) * 512); const unsigned lo = lane_ * 32u;
                *(f32x4*)(np + lo) = (f32x4){nreg[0], nreg[1], nreg[2], nreg[3]}; *(f32x4*)(np + lo + 16u) = (f32x4){nreg[4], nreg[5], nreg[6], nreg[7]}; }
            f32x4 a2[2] = {(f32x4){0.f, 0.f, 0.f, 0.f}, (f32x4){0.f, 0.f, 0.f, 0.f}};
#pragma unroll
            for (int ks = 0; ks < 16; ++ks)
#pragma unroll
                for (int et = 0; et < 2; ++et) a2[et] = __builtin_amdgcn_mfma_f32_16x16x32_bf16(*(const LAS bf16x8*)(cb_rd + (16 * et + fr) * 1040 + ks * 64 + fq * 16), xf[ks], a2[et], 0, 0, 0);
            asm volatile("" ::: "memory");
#pragma unroll
            for (int ks = 1; ks < 4; ++ks)
#pragma unroll
                for (int dt = 0; dt < 4; ++dt) kf[ks][dt] = ldg16(ktu + (4 * w + dt) * 4096 + ks * 1024, l16);
            a2[0] = a2[0] * Ei; a2[1] = a2[1] * Ei;
#pragma unroll
            for (int ks = 0; ks < 4; ++ks)
#pragma unroll
                for (int et = 0; et < 2; ++et) a2[et] = __builtin_amdgcn_mfma_f32_16x16x32_bf16(vf[et][ks], sfr[ks], a2[et], 0, 0, 0);
            { char* nu = NUM + ((size_t)row0 * MI + h * 512 + e0) * 2; const unsigned ln = ((16u * w + fr) * MI + 4u * fq) * 2u;
#pragma unroll
                for (int et = 0; et < 2; ++et) *(u32x2*)(nu + et * 32 + ln) = (u32x2){pk2(a2[et][0], a2[et][1]), pk2(a2[et][2], a2[et][3])}; }
#pragma unroll
            for (int a = 0; a < 4; ++a)
#pragma unroll
                for (int b = 0; b < 2; ++b) acc[a][b] = acc[a][b] * Gd;
#pragma unroll
            for (int ks = 0; ks < 4; ++ks) {
                bf16x8 bv[2];
#pragma unroll
                for (int et = 0; et < 2; ++et) { float v[8]; unpack8(__builtin_bit_cast(u32x4, vf[et][ks]), v);
                    const f32x4 wa = *(const LAS f32x4*)(wl_rd + ks * 32 + 8 * fq), wb = *(const LAS f32x4*)(wl_rd + ks * 32 + 8 * fq + 4);
                    v[0] *= wa[0]; v[1] *= wa[1]; v[2] *= wa[2]; v[3] *= wa[3]; v[4] *= wb[0]; v[5] *= wb[1]; v[6] *= wb[2]; v[7] *= wb[3];
                    const u32x4 pv = pack8(v); bv[et] = __builtin_bit_cast(bf16x8, pv); }
#pragma unroll
                for (int dt = 0; dt < 4; ++dt)
#pragma unroll
                    for (int et = 0; et < 2; ++et) acc[dt][et] = __builtin_amdgcn_mfma_f32_16x16x32_bf16(kf[ks][dt], bv[et], acc[dt][et], 0, 0, 0);
            }
            asm volatile("" ::: "memory");
            { const char* xc2 = XC + ((size_t)(((bl * SEQ + cn * 128) >> 4) + w) * 64 + h * 16) * 1024;
#pragma unroll
                for (int ks = 0; ks < 16; ++ks) xf[ks] = ldg16(xc2 + ks * 1024, l16); }
            nreg[0] = Gd * nreg[0] + dn0[0]; nreg[1] = Gd * nreg[1] + dn0[1]; nreg[2] = Gd * nreg[2] + dn0[2]; nreg[3] = Gd * nreg[3] + dn0[3];
            nreg[4] = Gd * nreg[4] + dn1[0]; nreg[5] = Gd * nreg[5] + dn1[1]; nreg[6] = Gd * nreg[6] + dn1[2]; nreg[7] = Gd * nreg[7] + dn1[3];
            *(LAS bf16x8*)(vt_wr + w * 1024 + l16) = vnext;
            wl_wr[tid_ & 127] = wnext;
#pragma unroll
            for (int dt = 0; dt < 4; ++dt)
#pragma unroll
                for (int et = 0; et < 2; ++et) *(LAS u32x2*)(cb_wr + (16 * et + fr) * 1040 + (64 * w + 16 * dt + 4 * fq) * 2) = (u32x2){pk2(acc[dt][et][0], acc[dt][et][1]), pk2(acc[dt][et][2], acc[dt][et][3])};
            asm volatile("" :: "v"(pf));
            __syncthreads();
        }
    }
}

__device__ __forceinline__ void ph_mout(Fr& F) {
    bf16* NF = (bf16*)(F.ws + MS_NF); const bf16* NBk = (const bf16*)(F.ws + MS_NB); const bf16* XC = (const bf16*)(F.ws + MS_XC); const bf16* Z = (const bf16*)(F.ws + MS_Z);
    const float* NC = (const float*)(F.ws + WS_NC); const float* RS = (const float*)(F.ws + WS_RS); const f32x4* GTL = (const f32x4*)(F.ws + WS_GT_L);
    LAS unsigned char* xt = F.lds + F.wave * 16640;
    for (int it = F.gw; it < (HROWS / 16) * 4; it += F.ngw) {
        const int rt = it >> 2, h = it & 3, bl = rt >> 9, c = (rt >> 3) & 63;
        { const bf16* xp = XC + ((size_t)rt * 64 + h * 16) * 512 + F.lane * 8; u32x4 t[16];
#pragma unroll
            for (int ks = 0; ks < 16; ++ks) t[ks] = *(const u32x4*)(xp + ks * 512);
#pragma unroll
            for (int ks = 0; ks < 16; ++ks) *(LAS u32x4*)(xt + ks * 1040 + F.lane * 16) = t[ks]; }
        const float* n0 = NC + (((size_t)(0 * 2 + bl) * 4 + h) * 64 + c) * 512 + 8 * F.lane; const float* n1 = NC + (((size_t)(1 * 2 + bl) * 4 + h) * 64 + c) * 512 + 8 * F.lane;
        const f32x4 n00 = *(const f32x4*)n0, n01 = *(const f32x4*)(n0 + 4), n10 = *(const f32x4*)n1, n11 = *(const f32x4*)(n1 + 4);
        float nw[8], sk[8];
        { const float* pw = IN(I_MNW) + h * 512 + 8 * F.lane; const float* ps = IN(I_MSKIP) + h * 512 + 8 * F.lane;
#pragma unroll
            for (int e = 0; e < 8; ++e) { nw[e] = pw[e]; sk[e] = ps[e]; } }
#pragma unroll 2
        for (int r = 0; r < 16; ++r) {
            const int row = rt * 16 + r; const size_t o = (size_t)row * MI + h * 512 + 8 * F.lane;
            float nf[8], nb[8], xc[8], z[8];
            unpack8(*(const u32x4*)(NF + o), nf); unpack8(*(const u32x4*)(NBk + o), nb); unpack8(*(const u32x4*)(Z + o), z);
            unpack8(*(const LAS u32x4*)(xt + (F.lane >> 2) * 1040 + (r + 16 * (F.lane & 3)) * 16), xc);
            float d0 = xc[0] * n00[0] + xc[1] * n00[1] + xc[2] * n00[2] + xc[3] * n00[3] + xc[4] * n01[0] + xc[5] * n01[1] + xc[6] * n01[2] + xc[7] * n01[3];
            float d1 = xc[0] * n10[0] + xc[1] * n10[1] + xc[2] * n10[2] + xc[3] * n10[3] + xc[4] * n11[0] + xc[5] * n11[1] + xc[6] * n11[2] + xc[7] * n11[3];
            d0 = wave_sum(d0); d1 = wave_sum(d1);
            const float den0 = GTL[(size_t)(0 * 4 + h) * HROWS + row][2] * d0 + RS[(size_t)(0 * 4 + h) * HROWS + row], den1 = GTL[(size_t)(1 * 4 + h) * HROWS + row][2] * d1 + RS[(size_t)(1 * 4 + h) * HROWS + row];
            const float i0 = 1.0f / fmaxf(fabsf(den0), 1.0f), i1 = 1.0f / fmaxf(fabsf(den1), 1.0f);
            float s = 0.f;
#pragma unroll
            for (int e = 0; e < 8; ++e) { nf[e] = nf[e] * i0 + nb[e] * i1; s += nf[e]; }
            const float mu = wave_sum(s) * (1.0f / 512.0f); float q = 0.f;
#pragma unroll
            for (int e = 0; e < 8; ++e) { nf[e] -= mu; q += nf[e] * nf[e]; }
            const float rstd = 1.0f / sqrtf(wave_sum(q) * (1.0f / 512.0f) + ML_NORM_EPS);
#pragma unroll
            for (int e = 0; e < 8; ++e) nf[e] = (nf[e] * rstd * nw[e] + sk[e] * xc[e]) * silu_f(z[e]);
            *(u32x4*)(NF + o) = pack8(nf);
        }
    }
}

__device__ __forceinline__ void ph_final(Fr& F, const bf16* dl) {
    const float* g = IN(I_FINALG);
    for (int r = F.gw; r < ML; r += 2 * F.ngw) {
        const int r2 = r + F.ngw < ML ? r + F.ngw : r;
        f32x4* xa = (f32x4*)(F.out + (size_t)r * 1024) + F.lane; f32x4* xb = (f32x4*)(F.out + (size_t)r2 * 1024) + F.lane; f32x4 va[4], vb[4]; float sa = 0.f, sb = 0.f;
        const u32x2* da = (const u32x2*)(dl + (size_t)r * 1024) + F.lane; const u32x2* db = (const u32x2*)(dl + (size_t)r2 * 1024) + F.lane;
#pragma unroll
        for (int j = 0; j < 4; ++j) { const u32x2 a = da[64 * j], b = db[64 * j];
            va[j] = xa[64 * j] + (f32x4){bflo(a.x), bfhi(a.x), bflo(a.y), bfhi(a.y)}; vb[j] = xb[64 * j] + (f32x4){bflo(b.x), bfhi(b.x), bflo(b.y), bfhi(b.y)}; }
#pragma unroll
        for (int j = 0; j < 4; ++j) { sa += (va[j][0] * va[j][0] + va[j][1] * va[j][1]) + (va[j][2] * va[j][2] + va[j][3] * va[j][3]); sb += (vb[j][0] * vb[j][0] + vb[j][1] * vb[j][1]) + (vb[j][2] * vb[j][2] + vb[j][3] * vb[j][3]); }
        const float ra = __builtin_amdgcn_rsqf(wave_sum(sa) * (1.0f / 1024.0f) + EPS), rb = __builtin_amdgcn_rsqf(wave_sum(sb) * (1.0f / 1024.0f) + EPS);
#pragma unroll
        for (int j = 0; j < 4; ++j) { const f32x4 gg = *(const f32x4*)(g + 4 * F.lane + 256 * j); xa[64 * j] = va[j] * ra * gg; if (r2 != r) xb[64 * j] = vb[j] * rb * gg; }
    }
}

template <class Epi>
__device__ __forceinline__ void run_gemm(Fr& F, const bf16* A, const bf16* Bt, int M, int N, int K, const Epi& E) {
    pg8::Gemm g{A, Bt, M, N, K}; pg8::StaticOrder S; S.init(M, N, F.G, F.bid);
    pg8::gemm_phase<Epi, pg8::StaticOrder, true, true>(F.lds, g, S, E, F.tid);
}

struct Args { const float* in[38]; float* out; unsigned char* ws; int ph_lo, ph_hi; };
static_assert(sizeof(Args) == 328 && offsetof(Args, out) == 304 && offsetof(Args, ws) == 312 && offsetof(Args, ph_lo) == 320, "Args layout");
constexpr int N_PHASES = 34;


#define XB_TMO      128
#define XB_XCNT(j)  (256  + 64 * (j))
#define XB_XSUB(j)  (1280 + 64 * (j))
#define XB_XGEN(j)  (2304 + 64 * (j))
#define XB_TOP      3328
#define XB_TOPGEN   3392
#define XCD_BAR_WORDS 3456
#define XB_SPIN_CAP (1u << 22)
__device__ __forceinline__ unsigned xb_ld(unsigned* p)              { return __hip_atomic_load(p, __ATOMIC_RELAXED, __HIP_MEMORY_SCOPE_AGENT); }
__device__ __forceinline__ unsigned xb_add(unsigned* p, unsigned v) { return __hip_atomic_fetch_add(p, v, __ATOMIC_RELAXED, __HIP_MEMORY_SCOPE_AGENT); }
__device__ __forceinline__ unsigned xb_xcc_id() { return (unsigned)__builtin_amdgcn_s_getreg((3 << 11) | 20) & 0xFu; }
#define XB_SPIN(cond, bar) do { unsigned _sp = 0; while (cond) { __builtin_amdgcn_s_sleep(1); \
    if ((++_sp & 255u) == 0u) { if (xb_ld(&(bar)[XB_TMO])) break; if (_sp > XB_SPIN_CAP) { atomicAdd(&(bar)[XB_TMO], 1u); break; } } } } while (0)
__device__ __forceinline__ void xcd_barrier_complete(unsigned* bar, unsigned x, unsigned& nloc, unsigned& nx) {
    const unsigned G = gridDim.x * gridDim.y * gridDim.z;
    unsigned sum, cnt, mine, sp = 0u;
    for (;;) {
        sum = 0u; cnt = 0u; mine = 0u;
#pragma unroll
        for (unsigned j = 0; j < 16; ++j) { const unsigned c = xb_ld(&bar[XB_XCNT(j)]); sum += c; cnt += (c > 0u) ? 1u : 0u; mine = (j == x) ? c : mine; }
        if (sum == G) break;
        __builtin_amdgcn_s_sleep(1);
        if ((++sp & 255u) == 0u) { if (xb_ld(&bar[XB_TMO])) break; if (sp > XB_SPIN_CAP) { atomicAdd(&bar[XB_TMO], 1u); break; } }
    }
    nloc = mine > 0u ? mine : 1u; nx = cnt > 0u ? cnt : 1u;
}
__device__ __forceinline__ void xcd_barrier(unsigned* bar, volatile LAS unsigned* st) {
    asm volatile("s_waitcnt vmcnt(0)" ::: "memory");
    __syncthreads();
    if (threadIdx.x == 0) {
        const unsigned x = xb_xcc_id();
        __builtin_amdgcn_s_waitcnt(0);
        unsigned nloc = st[0], nx = st[1];
        if (nloc == 0u) { xcd_barrier_complete(bar, x, nloc, nx); st[0] = nloc; st[1] = nx; }
        const unsigned old = xb_add(&bar[XB_XSUB(x)], 1u);
        const unsigned gen = old / nloc;
        if (old + 1u == (gen + 1u) * nloc) {
            __builtin_amdgcn_fence(__ATOMIC_RELEASE, "agent");
            asm volatile("s_waitcnt vmcnt(0)" ::: "memory");
            const unsigned og = xb_add(&bar[XB_TOP], 1u);
            const unsigned tg = og / nx;
            if (og + 1u == (tg + 1u) * nx) xb_add(&bar[XB_TOPGEN], 1u);
            else XB_SPIN(xb_ld(&bar[XB_TOPGEN]) == tg, bar);
            __builtin_amdgcn_fence(__ATOMIC_ACQUIRE, "agent");
            xb_add(&bar[XB_XGEN(x)], 1u);
            asm volatile("s_waitcnt vmcnt(0)" ::: "memory");
        } else {
            XB_SPIN(xb_ld(&bar[XB_XGEN(x)]) == gen, bar);
            __builtin_amdgcn_fence(__ATOMIC_ACQUIRE, "agent");
            asm volatile("s_waitcnt vmcnt(0)" ::: "memory");
        }
    }
    __syncthreads();
}
#ifndef PROBE_MASK
#define PROBE_MASK 0ull
#endif
constexpr int BAR_LDS_OFF = LDS_BYTES - 64;
constexpr size_t WS_BAR = 0;
constexpr size_t WS_TS = 64 * 1024;

template <int ph>
__device__ __forceinline__ void run_phase(Fr& F) {
    unsigned char* ws = F.ws;
    float* mod = (float*)(ws + WS_MOD); float* ctxx = (float*)(ws + WS_CTXX);
    if constexpr (ph == 0) ph_prologue(F);
    else if constexpr (ph == 1) ph_modnorm(F, IN(I_X), ML, 0, IN(I_CTX), MC, IN(I_NORMG), mod, 0, (bf16*)(ws + HY_H));
    else if constexpr (ph == 2) { pg8::EpiBf16 E{(bf16*)(ws + HY_P), 3072, IN(I_HBIN), 0, 0}; run_gemm(F, (const bf16*)(ws + HY_H), (const bf16*)(ws + WS_WHIN), MALL, 3072, 1024, E);
                                  { constexpr int nun = (MALL / 256) * (3072 / 256); const int busy = nun % F.G; const bool all = busy == 0; const int vb = all ? F.bid : F.bid - busy, nvb = all ? F.G : F.G - busy;
                                    if (all || F.bid >= busy) {
                                        kt_items(F, (const float*)(ws + WS_H3), SEQ, (float*)(ws + HY_KT), vb * NWAVES + F.wave, nvb * NWAVES);
                                        kt_items(F, (const float*)(ws + WS_H3) + (size_t)SEQ * 64, CTXL, (float*)(ws + WS_KTC), vb * NWAVES + F.wave, nvb * NWAVES);
                                        transpose_group(F, 1, vb, nvb); } } }
    else if constexpr (ph == 3) { zt_items(F, (const bf16*)(ws + HY_P), 0, NB, SEQ, (bf16*)(ws + HY_ZT)); zt_items(F, (const bf16*)(ws + HY_P), ML, NB, CTXL, (bf16*)(ws + HY_ZTC)); }
    else if constexpr (ph == 4) ph_fftconv(F);
    else if constexpr (ph == 5) { u2_items(F, (const bf16*)(ws + HY_P), 0, NB, SEQ, (const bf16*)(ws + HY_ZT), (bf16*)(ws + HY_H)); u2_items(F, (const bf16*)(ws + HY_P), ML, NB, CTXL, (const bf16*)(ws + HY_ZTC), (bf16*)(ws + HY_H)); }
    else if constexpr (ph == 6) { pg8::EpiDelta E{(bf16*)(ws + HY_P), ML, mod + 2048, 0, IN(I_HBOUT)}; run_gemm(F, (const bf16*)(ws + HY_H), (const bf16*)(ws + WS_WHOUT), MALL, 1024, 1024, E);
                                  transpose_in_tail(F, 2, (MALL / 256) * (1024 / 256)); }
    else if constexpr (ph == 7) ph_modnorm(F, IN(I_X), ML, 0, IN(I_CTX), MC, IN(I_NORMG) + 1024, mod, 3072, (bf16*)(ws + FF_H), (const bf16*)(ws + HY_P), F.out, ctxx);
    else if constexpr (ph == 8) { pg8::EpiBf16 E{(bf16*)(ws + FF_A), FF, nullptr, FF, (FF_G - FF_A) / 2}; run_gemm(F, (const bf16*)(ws + FF_H), (const bf16*)(ws + WS_WUP0), MALL, 2 * FF, 1024, E);
                                  { constexpr int nun = (MALL / 256) * (2 * FF / 256); const int busy = nun % F.G;
                                    if (busy == 0) mod_layer(F, 1, F.bid, F.G); else if (F.bid >= busy) mod_layer(F, 1, F.bid - busy, F.G - busy); } }
    else if constexpr (ph == 9) ph_dwconv(F, 0, ML, MC);
    else if constexpr (ph == 10) { pg8::EpiDelta E{(bf16*)(ws + FF_H), ML, mod + 5120, 0, nullptr}; run_gemm(F, (const bf16*)(ws + FF_A), (const bf16*)(ws + WS_WDN0), MALL, 1024, FF, E); }
    else if constexpr (ph < 29) {
            constexpr int hb = (ph - 11) / 9, k = (ph - 11) % 9; const float* mod1 = mod + 5 * 6144;
            float* xh = F.out + (size_t)hb * HROWS * 1024;
            if constexpr (k == 0) {
                if constexpr (hb == 0) {
                    const bf16* dl = (const bf16*)(ws + FF_H);
                    add_delta_rows(F, F.out, dl, HROWS, HROWS);
                    ph_modnorm(F, xh, 0, 0, ctxx, MC, IN(I_NORMG) + 2048, mod1, 0, (bf16*)(ws + MS_HC), dl + (size_t)ML * 1024, xh, ctxx);
                    ph_modnorm(F, xh, HROWS, 0, ctxx, 0, IN(I_NORMG) + 2048, mod1, 0, (bf16*)(ws + MS_H), dl, xh, ctxx);
                } else ph_modnorm(F, xh, HROWS, 2 * hb, ctxx, 0, IN(I_NORMG) + 2048, mod1, 0, (bf16*)(ws + MS_H)); }
            else if constexpr (k == 1) { { pg8::EpiBf16T E{(bf16*)(ws + MS_XM), MI / 32}; run_gemm(F, (const bf16*)(ws + MS_H), (const bf16*)(ws + WS_WMIN), HROWS, MI, 1024, E); }
                               if (hb == 0) { pg8::EpiBf16T E{(bf16*)(ws + MS_XMC), MI / 32}; run_gemm(F, (const bf16*)(ws + MS_HC), (const bf16*)(ws + WS_WMIN), MC, MI, 1024, E); } }
            else if constexpr (k == 2) { prep_items(F, (const bf16*)(ws + MS_XM), 2, SEQ, (bf16*)(ws + MS_XC), (bf16*)(ws + MS_KN), (bf16*)(ws + MS_KT), (bf16*)(ws + MS_VT));
                               if (hb == 0) prep_items(F, (const bf16*)(ws + MS_XMC), NB, CTXL, (bf16*)(ws + MS_XCC), (bf16*)(ws + MS_XCC + 16 * MiB), (bf16*)(ws + MS_KTC), (bf16*)(ws + MS_VTC)); }
            else if constexpr (k == 3) { gate_items(F, (const bf16*)(ws + MS_XC), (const bf16*)(ws + MS_XM), HROWS, (float*)(ws + WS_GATES_L));
                               if (hb == 0) gate_items(F, (const bf16*)(ws + MS_XCC), (const bf16*)(ws + MS_XMC), MC, (float*)(ws + WS_GATES_C)); }
            else if constexpr (k == 4) ph_sphase(F, hb, hb == 0);
            else if constexpr (k == 5) ph_scan(F, hb);
            else if constexpr (k == 6) { pg8::EpiBf16 E{(bf16*)(ws + MS_Z), MI, nullptr, 0, 0}; run_gemm(F, (const bf16*)(ws + MS_H), (const bf16*)(ws + WS_WMIN) + (size_t)MI * 1024, HROWS, MI, 1024, E); }
            else if constexpr (k == 7) ph_mout(F);
            else { pg8::EpiRes E{xh, xh, ctxx, ctxx, HROWS, mod1 + 2048, 2 * hb, nullptr}; run_gemm(F, (const bf16*)(ws + MS_NF), (const bf16*)(ws + WS_WMDN), HROWS, 1024, MI, E); }
        }
    else if constexpr (ph == 29) ph_modnorm(F, F.out, ML, 0, ctxx, 0, IN(I_NORMG) + 3072, mod + 5 * 6144, 3072, (bf16*)(ws + FF_H));
    else if constexpr (ph == 30) { pg8::EpiBf16 E{(bf16*)(ws + FF_A), FF, nullptr, FF, (FF_G - FF_A) / 2}; run_gemm(F, (const bf16*)(ws + FF_H), (const bf16*)(ws + WS_WUP1), ML, 2 * FF, 1024, E); }
    else if constexpr (ph == 31) ph_dwconv(F, 1, ML, 0);
    else if constexpr (ph == 32) { pg8::EpiDelta E{(bf16*)(ws + FF_H), ML, mod + 5 * 6144 + 5120, 0, nullptr}; run_gemm(F, (const bf16*)(ws + FF_A), (const bf16*)(ws + WS_WDN1), ML, 1024, FF, E); }
    else ph_final(F, (const bf16*)(ws + FF_H));
}

template <int ph>
__device__ __forceinline__ void phase_step(int ph_lo, int ph_hi, unsigned char* lds_raw) {
    if (ph_lo <= ph && ph < ph_hi) {
        const __attribute__((address_space(4))) unsigned char* kp = (const __attribute__((address_space(4))) unsigned char*)__builtin_amdgcn_kernarg_segment_ptr();
        asm volatile("" : "+s"(kp));
        Fr F;
        { int t_ = threadIdx.x, g_ = gridDim.x, b_ = blockIdx.x; asm volatile("" : "+v"(t_), "+s"(g_), "+s"(b_)); F.tid = t_; F.G = g_; F.bid = b_; }
        F.lds = (LAS unsigned char*)lds_raw; F.lane = F.tid & 63; F.wave = __builtin_amdgcn_readfirstlane(F.tid >> 6);
        F.gw = F.bid * NWAVES + F.wave; F.ngw = F.G * NWAVES;
        F.in = (const __attribute__((address_space(4))) cfptr_t*)kp;
        typedef float* fptr_t; typedef unsigned char* ucptr_t;
        F.out = *(const __attribute__((address_space(4))) fptr_t*)(kp + 304); F.ws = *(const __attribute__((address_space(4))) ucptr_t*)(kp + 312);
        if (PROBE_MASK != 0ull && F.bid == 0 && F.tid == 0) ((unsigned long long*)(F.ws + WS_TS))[ph] = __builtin_amdgcn_s_memrealtime();
        run_phase<ph>(F);
        if (ph + 1 < ph_hi) {
            if (ph == 0) {
                if (F.bid == 0) for (int i = F.tid; i < XCD_BAR_WORDS; i += NTHR) __hip_atomic_store((unsigned*)(F.ws + WS_BAR) + i, 0u, __ATOMIC_RELAXED, __HIP_MEMORY_SCOPE_AGENT);
                __syncthreads(); cg::this_grid().sync();
                if (F.tid == 0) (void)xb_add((unsigned*)(F.ws + WS_BAR) + XB_XCNT(xb_xcc_id()), 1u);
            }
            else xcd_barrier((unsigned*)(F.ws + WS_BAR), (volatile LAS unsigned*)(F.lds + BAR_LDS_OFF));
        }
        if (PROBE_MASK != 0ull && ph == N_PHASES - 1 && F.bid == 0) {
            if (F.tid == 0) { unsigned long long* ts = (unsigned long long*)(F.ws + WS_TS); const unsigned long long tend = __builtin_amdgcn_s_memrealtime(); unsigned long long tot = 0ull;
                for (int k = 0; k < N_PHASES; ++k) if ((PROBE_MASK >> k) & 1ull) tot += (k + 1 < N_PHASES ? ts[k + 1] : tend) - ts[k];
                while (__builtin_amdgcn_s_memrealtime() - tend < tot) __builtin_amdgcn_s_sleep(8); }
            __syncthreads();
        }
    }
}
template <int... I>
__device__ __forceinline__ void all_phases(int ph_lo, int ph_hi, unsigned char* lds_raw, std::integer_sequence<int, I...>) { (phase_step<I>(ph_lo, ph_hi, lds_raw), ...); }

__global__ void __launch_bounds__(NTHR, 2) fwd_kernel(Args args) {
    extern __shared__ __attribute__((aligned(16))) unsigned char lds_raw[];
    int ph_lo, ph_hi;
    { const __attribute__((address_space(4))) unsigned char* kp0 = (const __attribute__((address_space(4))) unsigned char*)__builtin_amdgcn_kernarg_segment_ptr();
      ph_lo = *(const __attribute__((address_space(4))) int*)(kp0 + 320); ph_hi = *(const __attribute__((address_space(4))) int*)(kp0 + 324); }
    if (threadIdx.x < 16) ((LAS unsigned*)((LAS unsigned char*)lds_raw + BAR_LDS_OFF))[threadIdx.x] = 0u;
    __syncthreads();
    all_phases(ph_lo, ph_hi, lds_raw, std::make_integer_sequence<int, N_PHASES>{});
}

extern "C" void kernel_launch(void* const* d_in, const int* in_sizes, int n_in, void* d_out, int out_size, void* d_ws, size_t ws_size, hipStream_t stream) {
    static int grid = 0;
    if (grid == 0) {
        int dev = 0, cus = 0, per_cu = 0;
        hipGetDevice(&dev);
        hipDeviceGetAttribute(&cus, hipDeviceAttributeMultiprocessorCount, dev);
        hipFuncSetAttribute((const void*)fwd_kernel, hipFuncAttributeMaxDynamicSharedMemorySize, LDS_BYTES);
        hipOccupancyMaxActiveBlocksPerMultiprocessor(&per_cu, (const void*)fwd_kernel, NTHR, LDS_BYTES);
        if (per_cu < 1) { fprintf(stderr, "kernel_launch: occupancy query says %d blocks per CU\n", per_cu); per_cu = 1; }
        grid = cus < 256 ? cus : 256;
        if (n_in != 38 || ws_size < WS_END) fprintf(stderr, "kernel_launch: unexpected n_in %d / ws_size %zu (need %zu)\n", n_in, ws_size, (size_t)WS_END);
        (void)hipGetLastError();
    }
    (void)hipMemsetAsync(d_ws, 0, 128 * 1024, stream);
    Args a{};
    for (int i = 0; i < 38; ++i) a.in[i] = (const float*)d_in[i];
    a.out = (float*)d_out; a.ws = (unsigned char*)d_ws; a.ph_lo = 0; a.ph_hi = N_PHASES;
    void* kargs[] = {&a};
    hipError_t e = hipLaunchCooperativeKernel((const void*)fwd_kernel, dim3(grid), dim3(NTHR), kargs, LDS_BYTES, stream);
    if (e != hipSuccess) fprintf(stderr, "cooperative launch failed: %s (grid %d)\n", hipGetErrorString(e), grid);
}
```

```cpp
#include <hip/hip_runtime.h>
#include <hip/hip_cooperative_groups.h>
#include <cstdio>
#include <cstdint>
#include <cstddef>
#include <utility>
namespace cg = cooperative_groups;

#define LAS __attribute__((address_space(3)))
typedef unsigned short bf16;
typedef short bf16x8 __attribute__((ext_vector_type(8)));
typedef float f32x4 __attribute__((ext_vector_type(4)));
typedef float f32x2 __attribute__((ext_vector_type(2)));
typedef unsigned u32x4 __attribute__((ext_vector_type(4)));
typedef unsigned u32x2 __attribute__((ext_vector_type(2)));

namespace pg8 {
#define PG8_LAS __attribute__((address_space(3)))
typedef unsigned short bf16_t;
constexpr int BM = 256, BK = 64, HALF = 128, HTB = HALF * BK * 2, STAGE_BYTES = 8 * HTB, NXCD = 8, WGM = 8;
__host__ __device__ __forceinline__ int lds_byte(int r, int c) { const int st = (r >> 4) * 2 + (c >> 5), rr = r & 15, cc = c & 31, ob = rr * 64 + cc * 2; return st * 1024 + (ob ^ (((ob >> 9) & 1) << 5)); }
__host__ __device__ __forceinline__ void stage_rc(int b, int& R, int& C) { const int st = b / 1024, sb = b % 1024, swz = sb ^ (((sb >> 9) & 1) << 5); R = (st >> 1) * 16 + swz / 64; C = (st & 1) * 32 + (swz % 64) / 2; }
__host__ __device__ __forceinline__ int perm32(int rho) { const int n = rho >> 4, i = rho & 15; return 8 * (i >> 2) + 4 * n + (i & 3); }
struct Unit { int pm, pn; };
struct Gemm { const bf16_t* A; const bf16_t* Bt; int M, N, K; };
struct StaticOrder {
    int nM, nN, nwg, G, c;
    __host__ __device__ void init(int M, int N, int G_, int c_) { nM = M / BM; nN = N / BM; nwg = nM * nN; G = G_; c = c_; }
    __host__ __device__ bool next(int i, Unit& u) const {
        const long L = (long)i * G + c; if (L >= nwg) return false;
        int wgid = (int)L; { const int q = nwg / NXCD, r = nwg % NXCD, xcd = wgid % NXCD, off = wgid / NXCD; wgid = (xcd < r ? xcd * (q + 1) : r * (q + 1) + (xcd - r) * q) + off; }
        const int nig = WGM * nN, gid = wgid / nig, fm = gid * WGM, gsz = (nM - fm) < WGM ? (nM - fm) : WGM;
        u.pm = fm + ((wgid % nig) % gsz); u.pn = (wgid % nig) / gsz; return true;
    }
    __device__ __forceinline__ void a_ready(const Unit&) const {}
    __device__ __forceinline__ void done(const Unit&) const {}
};
__device__ __forceinline__ unsigned cvt_pk_bf16(float lo, float hi) { unsigned r; asm volatile("v_cvt_pk_bf16_f32 %0, %1, %2" : "=v"(r) : "v"(lo), "v"(hi)); return r; }

struct EpiBf16 {
    static constexpr bool PERM = true, AFTER_DRAIN = false;
    bf16_t* O; int ldc; const float* bias; int split_cols; size_t split_stride;
    __device__ __forceinline__ void operator()(const f32x4 (&acc)[2][2][4][2], const Unit& u, int wr, int wc, int fr, int fq) const {
        const int row0 = u.pm * BM + wr * 64 + fr; int colt = u.pn * BM; bf16_t* base = O;
        if (split_cols) { const int t = colt / split_cols; base += (size_t)t * split_stride; colt -= t * split_cols; }
        const int col0 = colt + wc * 32 + 8 * fq, bcol0 = u.pn * BM + wc * 32 + 8 * fq;
        f32x4 bv[2][2];
#pragma unroll
        for (int bj = 0; bj < 2; ++bj)
#pragma unroll
            for (int n = 0; n < 2; ++n) bv[bj][n] = bias ? *(const f32x4*)(bias + bcol0 + bj * HALF + 4 * n) : (f32x4){0.f, 0.f, 0.f, 0.f};
#pragma unroll
        for (int ai = 0; ai < 2; ++ai)
#pragma unroll
            for (int m = 0; m < 4; ++m) { bf16_t* rowp = base + (size_t)(row0 + ai * HALF + m * 16) * ldc + col0;
#pragma unroll
                for (int bj = 0; bj < 2; ++bj) { f32x4 v0 = acc[ai][bj][m][0] + bv[bj][0], v1 = acc[ai][bj][m][1] + bv[bj][1];
                    u32x4 w; w.x = cvt_pk_bf16(v0[0], v0[1]); w.y = cvt_pk_bf16(v0[2], v0[3]); w.z = cvt_pk_bf16(v1[0], v1[1]); w.w = cvt_pk_bf16(v1[2], v1[3]);
                    *(u32x4*)(rowp + bj * HALF) = w; } }
    }
};
struct EpiBf16T {
    static constexpr bool PERM = true, AFTER_DRAIN = false;
    bf16_t* O; int ntc;
    __device__ __forceinline__ void operator()(const f32x4 (&acc)[2][2][4][2], const Unit& u, int wr, int wc, int fr, int fq) const {
        bf16_t* base = O + (size_t)(fr + 16 * fq) * 8;
#pragma unroll
        for (int ai = 0; ai < 2; ++ai)
#pragma unroll
            for (int m = 0; m < 4; ++m)
#pragma unroll
                for (int bj = 0; bj < 2; ++bj) { const f32x4 v0 = acc[ai][bj][m][0], v1 = acc[ai][bj][m][1];
                    u32x4 w; w.x = cvt_pk_bf16(v0[0], v0[1]); w.y = cvt_pk_bf16(v0[2], v0[3]); w.z = cvt_pk_bf16(v1[0], v1[1]); w.w = cvt_pk_bf16(v1[2], v1[3]);
                    *(u32x4*)(base + ((size_t)(u.pm * 16 + ai * 8 + wr * 4 + m) * ntc + u.pn * 8 + bj * 4 + wc) * 512) = w; }
    }
};
struct EpiDelta {
    static constexpr bool PERM = true, AFTER_DRAIN = false, HEAVY = false;
    bf16_t* Dl; int rows_lat; const float* gate; int b0; const float* bias;
    __device__ __forceinline__ void operator()(const f32x4 (&acc)[2][2][4][2], const Unit& u, int wr, int wc, int fr, int fq) const {
        const int trow = u.pm * BM, modrow = trow < rows_lat ? b0 + trow / 8192 : 4;
        const int col0 = u.pn * BM + wc * 32 + 8 * fq; const float* gp = gate + (size_t)modrow * 6144 + col0;
        bf16_t* base = Dl + (size_t)(trow + wr * 64 + fr) * 1024 + col0;
#pragma unroll
        for (int bj = 0; bj < 2; ++bj) {
            f32x4 bv[2], gv[2];
#pragma unroll
            for (int n = 0; n < 2; ++n) { bv[n] = bias ? *(const f32x4*)(bias + col0 + bj * HALF + 4 * n) : (f32x4){0.f, 0.f, 0.f, 0.f}; gv[n] = *(const f32x4*)(gp + bj * HALF + 4 * n); }
#pragma unroll
            for (int ai = 0; ai < 2; ++ai)
#pragma unroll
                for (int m = 0; m < 4; ++m) { const f32x4 v0 = gv[0] * (acc[ai][bj][m][0] + bv[0]), v1 = gv[1] * (acc[ai][bj][m][1] + bv[1]);
                    u32x4 w; w.x = cvt_pk_bf16(v0[0], v0[1]); w.y = cvt_pk_bf16(v0[2], v0[3]); w.z = cvt_pk_bf16(v1[0], v1[1]); w.w = cvt_pk_bf16(v1[2], v1[3]);
                    *(u32x4*)(base + (size_t)(ai * HALF + m * 16) * 1024 + bj * HALF) = w; }
        }
    }
};
struct EpiRes {
    static constexpr bool PERM = false, AFTER_DRAIN = false;
    const float* res_lat; float* out_lat; const float* res_ctx; float* out_ctx; int rows_lat; const float* gate; int b0; const float* bias;
    __device__ __forceinline__ void operator()(const f32x4 (&acc)[2][2][4][2], const Unit& u, int wr, int wc, int fr, int fq) const {
        const int trow = u.pm * BM; const float* res; float* out; int modrow;
        if (trow < rows_lat) { res = res_lat + (size_t)trow * 1024; out = out_lat + (size_t)trow * 1024; modrow = b0 + trow / 8192; }
        else { const int rc = trow - rows_lat; res = res_ctx + (size_t)rc * 1024; out = out_ctx + (size_t)rc * 1024; modrow = 4; }
        const int col0 = u.pn * BM + wc * 32 + 4 * fq; const float* gp = gate + (size_t)modrow * 6144 + col0;
#pragma unroll
        for (int bj = 0; bj < 2; ++bj) {
            f32x4 bv[2], gv[2];
#pragma unroll
            for (int n = 0; n < 2; ++n) { bv[n] = bias ? *(const f32x4*)(bias + col0 + bj * HALF + n * 16) : (f32x4){0.f, 0.f, 0.f, 0.f}; gv[n] = *(const f32x4*)(gp + bj * HALF + n * 16); }
#pragma unroll
            for (int ai = 0; ai < 2; ++ai) {
                f32x4 rs[4][2];
#pragma unroll
                for (int m = 0; m < 4; ++m)
#pragma unroll
                    for (int n = 0; n < 2; ++n) rs[m][n] = *(const f32x4*)(res + (size_t)(wr * 64 + fr + ai * HALF + m * 16) * 1024 + col0 + bj * HALF + n * 16);
#pragma unroll
                for (int m = 0; m < 4; ++m)
#pragma unroll
                    for (int n = 0; n < 2; ++n) *(f32x4*)(out + (size_t)(wr * 64 + fr + ai * HALF + m * 16) * 1024 + col0 + bj * HALF + n * 16) = rs[m][n] + gv[n] * (acc[ai][bj][m][n] + bv[n]);
                asm volatile("" ::: "memory");
            }
        }
    }
};

template <class Epi, class Sched, bool ALIGN_EPI = false, bool SP2 = false>
__device__ __forceinline__ void gemm_phase(PG8_LAS unsigned char* lds, const Gemm g, const Sched& S, const Epi& E, const int tid) {
    const int wid = __builtin_amdgcn_readfirstlane(tid >> 6), lane = tid & 63, wr = wid >> 2, wc = wid & 3, fr = lane & 15, fq = lane >> 4;
    const int K = g.K, nt = K / BK;
    unsigned voffA[2], voffB[2];
#pragma unroll
    for (int i = 0; i < 2; ++i) { int R, C; stage_rc(tid * 16 + i * 8192, R, C); const int Rb = Epi::PERM ? ((R & ~31) + perm32(R & 31)) : R;
        voffA[i] = (unsigned)(R * K + C) * 2u; voffB[i] = (unsigned)(Rb * K + C) * 2u; }
    const size_t kstep = (size_t)(BK * 2);
    const size_t hstep = (size_t)HALF * K * 2;
    const size_t tstep = 2 * hstep;
    const unsigned ldsw = (unsigned)wid * 1024u;
    const int aoff = lds_byte(wr * 64 + fr, fq * 8), boff = lds_byte(wc * 32 + fr, fq * 8);
#define PG8_SA(b, h) (((b) * 2 + (h)) * HTB)
#define PG8_SB(b, h) ((4 + (b) * 2 + (h)) * HTB)
#define PG8_STAGE(bufoff, gbase, voff) do { _Pragma("unroll") for (int _i = 0; _i < 2; ++_i) \
        __builtin_amdgcn_global_load_lds((const unsigned*)((const char*)(gbase) + (voff)[_i]), (PG8_LAS unsigned*)(lds + (bufoff) + ldsw + _i * 8192), 16, 0, 0); } while (0)
#define PG8_LDA(dst, b, h) do { _Pragma("unroll") for (int m = 0; m < 4; ++m) _Pragma("unroll") for (int k = 0; k < 2; ++k) dst[m][k] = *(const PG8_LAS bf16x8*)(lds + PG8_SA(b, h) + aoff + m * 2048 + k * 1024); } while (0)
#define PG8_LDB(dst, b, h) do { _Pragma("unroll") for (int n = 0; n < 2; ++n) _Pragma("unroll") for (int k = 0; k < 2; ++k) dst[n][k] = *(const PG8_LAS bf16x8*)(lds + PG8_SB(b, h) + boff + n * 2048 + k * 1024); } while (0)
#define PG8_MMA(ai, bj, At, Bt) do { __builtin_amdgcn_s_setprio(1); _Pragma("unroll") for (int m = 0; m < 4; ++m) _Pragma("unroll") for (int n = 0; n < 2; ++n) _Pragma("unroll") for (int k = 0; k < 2; ++k) \
        acc[ai][bj][m][n] = __builtin_amdgcn_mfma_f32_16x16x32_bf16(Bt[n][k], At[m][k], acc[ai][bj][m][n], 0, 0, 0); __builtin_amdgcn_s_setprio(0); } while (0)
#define PG8_WAIT_V(n) asm volatile("s_waitcnt vmcnt(" #n ")" ::: "memory")
#define PG8_WAIT_L(n) asm volatile("s_waitcnt lgkmcnt(" #n ")" ::: "memory")
#define PG8_BAR __builtin_amdgcn_s_barrier()
#define PG8_SCHED __builtin_amdgcn_sched_barrier(0)
    Unit cur, nxt; int ui = 0;
    if (!S.next(0, cur)) return;
    f32x4 acc[2][2][4][2];
#pragma unroll
    for (int a = 0; a < 2; ++a)
#pragma unroll
        for (int b = 0; b < 2; ++b)
#pragma unroll
            for (int m = 0; m < 4; ++m)
#pragma unroll
                for (int n = 0; n < 2; ++n) acc[a][b][m][n] = (f32x4){0.f, 0.f, 0.f, 0.f};
    bf16x8 At[4][2], B0[2][2], B1[2][2];
    const char* cA = (const char*)g.A + (size_t)cur.pm * tstep; const char* cB = (const char*)g.Bt + (size_t)cur.pn * tstep;
    S.a_ready(cur);
    if constexpr (SP2) {
        PG8_STAGE(PG8_SB(0, 0), cB, voffB); PG8_STAGE(PG8_SB(0, 1), cB + hstep, voffB); PG8_STAGE(PG8_SA(0, 0), cA, voffA); PG8_STAGE(PG8_SA(0, 1), cA + hstep, voffA);
        if (wr == 1) PG8_BAR;
        PG8_WAIT_V(2); PG8_BAR;
        PG8_STAGE(PG8_SB(1, 0), cB + kstep, voffB); PG8_STAGE(PG8_SA(1, 0), cA + kstep, voffA); PG8_STAGE(PG8_SB(1, 1), cB + hstep + kstep, voffB);
        PG8_WAIT_V(6); PG8_BAR;
    } else {
        PG8_STAGE(PG8_SB(0, 0), cB, voffB); PG8_STAGE(PG8_SA(0, 0), cA, voffA); PG8_STAGE(PG8_SB(0, 1), cB + hstep, voffB); PG8_STAGE(PG8_SA(0, 1), cA + hstep, voffA);
        if (wr == 1) PG8_BAR;
        PG8_WAIT_V(4); PG8_BAR;
        PG8_STAGE(PG8_SB(1, 0), cB + kstep, voffB); PG8_STAGE(PG8_SA(1, 0), cA + kstep, voffA); PG8_STAGE(PG8_SB(1, 1), cB + hstep + kstep, voffB);
        PG8_WAIT_V(6); PG8_BAR;
    }
    for (;;) {
        const bool has_next = S.next(ui + 1, nxt);
        const char* nA = has_next ? (const char*)g.A + (size_t)nxt.pm * tstep : cA; const char* nB = has_next ? (const char*)g.Bt + (size_t)nxt.pn * tstep : cB;
        for (int t = 0; t < nt; t += 2) {
            const bool last = (t == nt - 2);
            const char* a1 = cA + (size_t)(t + 1) * kstep;
            const char* a2 = last ? nA : cA + (size_t)(t + 2) * kstep; const char* b2 = last ? nB : cB + (size_t)(t + 2) * kstep;
            const char* a3 = a2 + kstep; const char* b3 = b2 + kstep;
            if (last && has_next) S.a_ready(nxt);
            if constexpr (SP2) {
            PG8_LDB(B0, 0, 0); PG8_LDB(B1, 0, 1); PG8_SCHED; PG8_LDA(At, 0, 0); PG8_STAGE(PG8_SA(1, 1), a1 + hstep, voffA);
            PG8_WAIT_V(8); PG8_WAIT_L(0); PG8_BAR; PG8_MMA(0, 0, At, B0); PG8_MMA(0, 1, At, B1); PG8_BAR; PG8_SCHED;
            PG8_LDA(At, 0, 1); PG8_STAGE(PG8_SB(0, 0), b2, voffB); PG8_STAGE(PG8_SB(0, 1), b2 + hstep, voffB); PG8_STAGE(PG8_SA(0, 0), a2, voffA);
            PG8_WAIT_V(8); PG8_WAIT_L(0); PG8_BAR; PG8_MMA(1, 0, At, B0); PG8_MMA(1, 1, At, B1); PG8_BAR; PG8_SCHED;
            PG8_LDB(B0, 1, 0); PG8_LDB(B1, 1, 1); PG8_SCHED; PG8_LDA(At, 1, 0); PG8_STAGE(PG8_SA(0, 1), a2 + hstep, voffA);
            PG8_WAIT_V(8); PG8_WAIT_L(0); PG8_BAR; PG8_MMA(0, 0, At, B0); PG8_MMA(0, 1, At, B1); PG8_BAR; PG8_SCHED;
            PG8_LDA(At, 1, 1); PG8_STAGE(PG8_SB(1, 0), b3, voffB); PG8_STAGE(PG8_SB(1, 1), b3 + hstep, voffB); PG8_STAGE(PG8_SA(1, 0), a3, voffA);
            PG8_WAIT_V(8); PG8_WAIT_L(0); PG8_BAR; PG8_MMA(1, 0, At, B0); PG8_MMA(1, 1, At, B1); PG8_BAR; PG8_SCHED;
            } else {
            PG8_LDB(B0, 0, 0); PG8_SCHED; PG8_LDA(At, 0, 0); PG8_STAGE(PG8_SA(1, 1), a1 + hstep, voffA);
            PG8_WAIT_L(8); PG8_BAR; PG8_WAIT_L(0); PG8_MMA(0, 0, At, B0); PG8_BAR; PG8_SCHED;
            PG8_LDB(B1, 0, 1); PG8_STAGE(PG8_SB(0, 0), b2, voffB);
            PG8_BAR; PG8_WAIT_L(0); PG8_MMA(0, 1, At, B1); PG8_BAR;
            PG8_LDA(At, 0, 1); PG8_STAGE(PG8_SA(0, 0), a2, voffA);
            PG8_BAR; PG8_WAIT_L(0); PG8_MMA(1, 0, At, B0); PG8_BAR; PG8_SCHED;
            PG8_STAGE(PG8_SB(0, 1), b2 + hstep, voffB);
            PG8_WAIT_V(6); PG8_BAR; PG8_MMA(1, 1, At, B1); PG8_BAR;
            PG8_LDB(B0, 1, 0); PG8_SCHED; PG8_LDA(At, 1, 0); PG8_STAGE(PG8_SA(0, 1), a2 + hstep, voffA);
            PG8_WAIT_L(8); PG8_BAR; PG8_WAIT_L(0); PG8_MMA(0, 0, At, B0); PG8_BAR; PG8_SCHED;
            PG8_LDB(B1, 1, 1); PG8_STAGE(PG8_SB(1, 0), b3, voffB);
            PG8_BAR; PG8_WAIT_L(0); PG8_MMA(0, 1, At, B1); PG8_BAR;
            PG8_LDA(At, 1, 1); PG8_STAGE(PG8_SA(1, 0), a3, voffA);
            PG8_BAR; PG8_WAIT_L(0); PG8_MMA(1, 0, At, B0); PG8_BAR; PG8_SCHED;
            PG8_STAGE(PG8_SB(1, 1), b3 + hstep, voffB);
            PG8_WAIT_V(6); PG8_BAR; PG8_MMA(1, 1, At, B1); PG8_BAR;
            }
        }
        if constexpr (ALIGN_EPI) { if (wr == 0) PG8_BAR; }
        if constexpr (!Epi::AFTER_DRAIN) { E(acc, cur, wr, wc, fr, fq); S.done(cur); }
        if (!has_next) break;
#pragma unroll
        for (int a = 0; a < 2; ++a)
#pragma unroll
            for (int b = 0; b < 2; ++b)
#pragma unroll
                for (int m = 0; m < 4; ++m)
#pragma unroll
                    for (int n = 0; n < 2; ++n) acc[a][b][m][n] = (f32x4){0.f, 0.f, 0.f, 0.f};
        cur = nxt; cA = nA; cB = nB; ++ui;
        if constexpr (ALIGN_EPI) { if (wr == 1) PG8_BAR; }
    }
    PG8_WAIT_V(0);
    if constexpr (!ALIGN_EPI) { if (wr == 0) PG8_BAR; }
    PG8_BAR;
#undef PG8_SA
#undef PG8_SB
#undef PG8_STAGE
#undef PG8_LDA
#undef PG8_LDB
#undef PG8_MMA
#undef PG8_WAIT_V
#undef PG8_WAIT_L
#undef PG8_BAR
#undef PG8_SCHED
}
}

constexpr int D = 1024, NB = 4, SEQ = 8192, CTXL = 256, ML = NB * SEQ, MC = NB * CTXL, MALL = ML + MC;
constexpr int FF = 2816, MI = 2048, NH = 4, DH = 512, HROWS = 2 * SEQ;
constexpr float EPS = 1e-6f, ML_NORM_EPS = 1e-5f;
constexpr float HY_MAX_DECAY = -15.350567286626973f, HY_MIN_DECAY = -3.0701134573253945f;
constexpr int NWAVES = 8, NTHR = 512;
constexpr int LDS_BYTES = 147456;

constexpr size_t MiB = 1u << 20;
constexpr size_t WS_MOD = 1 * MiB;
constexpr size_t WS_CTXX = 2 * MiB;
constexpr size_t WS_H3 = 6 * MiB;
constexpr size_t WS_KTC = 9 * MiB;
constexpr size_t WS_GWT = 11 * MiB;
constexpr size_t WS_WKQ = 11 * MiB + 256 * 1024;
constexpr size_t WS_NC = 12 * MiB;
constexpr size_t WS_WHIN = 16 * MiB, WS_WHOUT = 22 * MiB, WS_WMIN = 24 * MiB, WS_WMDN = 32 * MiB, WS_WUP0 = 36 * MiB, WS_WUP1 = 47 * MiB, WS_WDN0 = 58 * MiB, WS_WDN1 = 58 * MiB + 5767168;
constexpr size_t WS_GATES_L = 69 * MiB;
constexpr size_t WS_GATES_C = 70 * MiB;
constexpr size_t WS_GT_L = 71 * MiB;
constexpr size_t WS_GT_C = 73 * MiB;
constexpr size_t WS_GC = 73 * MiB + 512 * 1024;
constexpr size_t WS_DN = 74 * MiB;
constexpr size_t WS_RS = 79 * MiB;
constexpr size_t WS_INV = 79 * MiB + 512 * 1024;
constexpr size_t BIG = 80 * MiB;
constexpr size_t HY_H = BIG, HY_P = BIG + 66 * MiB, HY_KT = BIG + 264 * MiB, HY_ZT = BIG + 328 * MiB, HY_ZTC = BIG + 392 * MiB, HY_KS = BIG + 394 * MiB;
constexpr size_t FF_H = BIG, FF_A = BIG + 66 * MiB, FF_G = BIG + 248 * MiB;
constexpr size_t MS_H = BIG, MS_XM = BIG + 32 * MiB, MS_XC = BIG + 96 * MiB, MS_KT = BIG + 160 * MiB, MS_VT = BIG + 224 * MiB, MS_NF = BIG + 288 * MiB, MS_NB = BIG + 352 * MiB,
                 MS_KTC = BIG + 416 * MiB, MS_VTC = BIG + 420 * MiB;
constexpr size_t MS_S = MS_XM, MS_Z = MS_KT, MS_KN = MS_NF, MS_XCC = MS_NB, MS_XMC = MS_NB + 4 * MiB, MS_HC = MS_NB + 8 * MiB;
constexpr size_t WS_END = BIG + 424 * MiB;
static_assert(WS_END <= 512 * MiB, "workspace map");
static_assert(FF_G + (size_t)MALL * FF * 2 <= 512 * MiB && FF_A + (size_t)MALL * FF * 2 <= FF_G, "ffn map");
static_assert(HY_P + (size_t)MALL * 3072 * 2 <= HY_KT && HY_ZTC + (size_t)NB * D * CTXL * 2 <= HY_KS && HY_KS + 32 * MiB <= 512 * MiB, "hyena map");

__device__ __forceinline__ unsigned f2bf(float f) { unsigned u = __float_as_uint(f); return (u + 0x7fffu + ((u >> 16) & 1u)) >> 16; }
typedef __bf16 bf16x2_t __attribute__((ext_vector_type(2)));
__device__ __forceinline__ unsigned pk2(float lo, float hi) { const f32x2 v = {lo, hi}; const bf16x2_t b = __builtin_convertvector(v, bf16x2_t); return __builtin_bit_cast(unsigned, b); }
__device__ __forceinline__ float bf2f(unsigned short b) { return __uint_as_float(((unsigned)b) << 16); }
__device__ __forceinline__ float bflo(unsigned w) { return __uint_as_float(w << 16); }
__device__ __forceinline__ float bfhi(unsigned w) { return __uint_as_float(w & 0xffff0000u); }
__device__ __forceinline__ void unpack8(const u32x4 v, float (&o)[8]) { o[0] = bflo(v.x); o[1] = bfhi(v.x); o[2] = bflo(v.y); o[3] = bfhi(v.y); o[4] = bflo(v.z); o[5] = bfhi(v.z); o[6] = bflo(v.w); o[7] = bfhi(v.w); }
__device__ __forceinline__ u32x4 pack8(const float (&o)[8]) { u32x4 v; v.x = pk2(o[0], o[1]); v.y = pk2(o[2], o[3]); v.z = pk2(o[4], o[5]); v.w = pk2(o[6], o[7]); return v; }
__device__ __forceinline__ float wave_sum(float v) {
#pragma unroll
    for (int o = 1; o < 64; o <<= 1) v += __shfl_xor(v, o);
    return v;
}
__device__ __forceinline__ float silu_f(float x) { return x * __builtin_amdgcn_rcpf(1.0f + __expf(-x)); }

typedef const float* cfptr_t;
struct Fr {
    LAS unsigned char* lds; int tid, lane, wave, gw, ngw, G, bid;
    const __attribute__((address_space(4))) cfptr_t* in; float* out; unsigned char* ws;
};
#define IN(i) (F.in[i])
enum { I_X = 0, I_C, I_CTX, I_CCTX, I_MODW, I_MODB, I_NORMG, I_FINALG, I_HWIN, I_HBIN, I_HSCW, I_HSCB, I_FW1, I_FB1, I_FW2, I_FB2, I_FW3, I_FB3, I_FWOUT, I_FREQ, I_HBIAS, I_HWOUT, I_HBOUT,
       I_MWIN, I_MCW, I_MCB, I_MWQ, I_MWK, I_MWV, I_MWG, I_MBG, I_MNW, I_MSKIP, I_MWDN, I_FWUP, I_FCW, I_FCB, I_FWDN };

__device__ __forceinline__ void transpose_item(const float* W, int K, int N, bf16* WT, LAS float* scr, int item, int lane) {
    const int nblk = N / 32, kb = item / nblk, nb = item % nblk, k0 = 64 * kb, n0 = 32 * nb;
    float tv[32];
#pragma unroll
    for (int i = 0; i < 32; ++i) tv[i] = W[(size_t)(k0 + 2 * i + (lane >> 5)) * N + n0 + (lane & 31)];
#pragma unroll
    for (int i = 0; i < 32; ++i) scr[(2 * i + (lane >> 5)) * 33 + (lane & 31)] = tv[i];
    asm volatile("s_waitcnt lgkmcnt(0)" ::: "memory");
    const int c = lane & 7;
#pragma unroll
    for (int j = 0; j < 4; ++j) { const int n = (lane >> 3) + 8 * j; const LAS float* s = scr + (8 * c) * 33 + n;
        u32x4 o; o.x = pk2(s[0 * 33], s[1 * 33]); o.y = pk2(s[2 * 33], s[3 * 33]); o.z = pk2(s[4 * 33], s[5 * 33]); o.w = pk2(s[6 * 33], s[7 * 33]);
        *(u32x4*)(WT + (size_t)(n0 + n) * K + k0 + 8 * c) = o; }
    asm volatile("s_waitcnt lgkmcnt(0)" ::: "memory");
}
__device__ __forceinline__ void transpose_matrix(Fr& F, const float* W, int K, int N, bf16* WT) {
    LAS float* scr = (LAS float*)(F.lds + F.wave * 16384);
    const int nitems = (K / 64) * (N / 32);
    for (int it = F.gw; it < nitems; it += F.ngw) transpose_item(W, K, N, WT, scr, it, F.lane);
}

__device__ __forceinline__ void transpose_group(Fr& F, int grp, int vb, int nvb) {
    unsigned char* ws = F.ws; LAS float* scr = (LAS float*)(F.lds + F.wave * 16384);
    constexpr int I0 = (D / 64) * (3 * D / 32), I1 = (D / 64) * (D / 32), I2 = (D / 64) * (2 * MI / 32), I3 = (MI / 64) * (D / 32), I4 = (D / 64) * (2 * FF / 32), I5 = (FF / 64) * (D / 32);
    const int nit = grp == 0 ? I0 : (grp == 1 ? I1 : I2 + I3 + 2 * I4 + 2 * I5);
    for (int it = vb * NWAVES + F.wave; it < nit; it += nvb * NWAVES) {
        int r = it;
        if (grp == 0) { transpose_item(IN(I_HWIN), D, 3 * D, (bf16*)(ws + WS_WHIN), scr, r, F.lane); continue; }
        if (grp == 1) { transpose_item(IN(I_HWOUT), D, D, (bf16*)(ws + WS_WHOUT), scr, r, F.lane); continue; }
        if (r < I4) { transpose_item(IN(I_FWUP), D, 2 * FF, (bf16*)(ws + WS_WUP0), scr, r, F.lane); continue; } r -= I4;
        if (r < I5) { transpose_item(IN(I_FWDN), FF, D, (bf16*)(ws + WS_WDN0), scr, r, F.lane); continue; } r -= I5;
        if (r < I2) { transpose_item(IN(I_MWIN), D, 2 * MI, (bf16*)(ws + WS_WMIN), scr, r, F.lane); continue; } r -= I2;
        if (r < I3) { transpose_item(IN(I_MWDN), MI, D, (bf16*)(ws + WS_WMDN), scr, r, F.lane); continue; } r -= I3;
        if (r < I4) { transpose_item(IN(I_FWUP) + (size_t)D * 2 * FF, D, 2 * FF, (bf16*)(ws + WS_WUP1), scr, r, F.lane); continue; } r -= I4;
        transpose_item(IN(I_FWDN) + (size_t)FF * D, FF, D, (bf16*)(ws + WS_WDN1), scr, r, F.lane);
    }
}
__device__ __forceinline__ void transpose_in_tail(Fr& F, int grp, int nunits) {
    const int busy = nunits % F.G;
    if (busy == 0) transpose_group(F, grp, F.bid, F.G);
    else if (F.bid >= busy) transpose_group(F, grp, F.bid - busy, F.G - busy);
}

__device__ __forceinline__ void mod_layer(Fr& F, int l, int vb, int nvb) {
    LAS float* sc = (LAS float*)F.lds;
    LAS float* red = (LAS float*)(F.lds + 32768);
    __syncthreads();
    for (int i = F.tid; i < 5 * 1024; i += NTHR) { const int r = i >> 10, k = i & 1023; const float v = r < 4 ? IN(I_C)[r * 1024 + k] : IN(I_CCTX)[k]; sc[i] = silu_f(v); }
    __syncthreads();
    float* mod = (float*)(F.ws + WS_MOD);
    for (int it = vb; it < 96; it += nvb) {
        const int n0 = it * 64;
        const float* w = IN(I_MODW) + (size_t)l * 1024 * 6144 + n0 + F.lane;
        float a0 = 0.f, a1 = 0.f, a2 = 0.f, a3 = 0.f, a4 = 0.f;
        const int kb = F.wave * 128;
#pragma unroll 16
        for (int k = 0; k < 128; ++k) { const float wv = w[(size_t)(kb + k) * 6144];
            a0 += sc[kb + k] * wv; a1 += sc[1024 + kb + k] * wv; a2 += sc[2048 + kb + k] * wv; a3 += sc[3072 + kb + k] * wv; a4 += sc[4096 + kb + k] * wv; }
        red[(F.wave * 5 + 0) * 64 + F.lane] = a0; red[(F.wave * 5 + 1) * 64 + F.lane] = a1; red[(F.wave * 5 + 2) * 64 + F.lane] = a2; red[(F.wave * 5 + 3) * 64 + F.lane] = a3; red[(F.wave * 5 + 4) * 64 + F.lane] = a4;
        __syncthreads();
        if (F.tid < 320) { const int r = F.tid >> 6, ln = F.tid & 63; float s = 0.f;
#pragma unroll
            for (int w8 = 0; w8 < 8; ++w8) s += red[(w8 * 5 + r) * 64 + ln];
            mod[((size_t)l * 5 + r) * 6144 + n0 + ln] = s + IN(I_MODB)[l * 6144 + n0 + ln]; }
        __syncthreads();
    }
}

__device__ __forceinline__ void ph_prologue(Fr& F) {
    unsigned char* ws = F.ws;
    transpose_group(F, 0, F.bid, F.G);
    __syncthreads();
    mod_layer(F, 0, F.bid, F.G);
    {
        float* h3 = (float*)(ws + WS_H3);
        float w1c[33], w2c[64], w3c[64];
        { const float* w1 = IN(I_FW1) + F.lane; const float* w2 = IN(I_FW2) + F.lane; const float* w3 = IN(I_FW3) + F.lane;
#pragma unroll
            for (int kk = 0; kk < 33; ++kk) w1c[kk] = w1[kk * 64];
#pragma unroll
            for (int kk = 0; kk < 64; ++kk) { w2c[kk] = w2[kk * 64]; w3c[kk] = w3[kk * 64]; } }
        const float fr = IN(I_FREQ)[F.lane], b1 = IN(I_FB1)[F.lane], b2 = IN(I_FB2)[F.lane], b3 = IN(I_FB3)[F.lane];
#pragma unroll 1
        for (int row = F.gw; row < SEQ + CTXL; row += F.ngw) {
            const int L = row < SEQ ? SEQ : CTXL, i = row < SEQ ? row : row - SEQ;
            const float tl = (float)i / (float)(L - 1), w = 6.283185307179586f * (float)i / (float)L;
            float pos = 0.f; const int k = F.lane;
            if (k == 0) pos = tl;
            else if (k <= 16) { const float band = 1e-4f + (float)(k - 1) * ((15.0f - 1e-4f) / 15.0f); pos = cosf(band * w); }
            else if (k <= 32) { const float band = 1e-4f + (float)(k - 17) * ((15.0f - 1e-4f) / 15.0f); pos = -sinf(band * w); }
            float s = b1;
#pragma unroll
            for (int kk = 0; kk < 33; ++kk) s += __builtin_bit_cast(float, __builtin_amdgcn_readlane(__builtin_bit_cast(int, pos), kk)) * w1c[kk];
            float h = sinf(fr * s);
            s = b2;
#pragma unroll
            for (int kk = 0; kk < 64; ++kk) s += __builtin_bit_cast(float, __builtin_amdgcn_readlane(__builtin_bit_cast(int, h), kk)) * w2c[kk];
            h = sinf(fr * s);
            s = b3;
#pragma unroll
            for (int kk = 0; kk < 64; ++kk) s += __builtin_bit_cast(float, __builtin_amdgcn_readlane(__builtin_bit_cast(int, h), kk)) * w3c[kk];
            h = sinf(fr * s);
            h3[(size_t)row * 64 + F.lane] = h;
        }
    }
    {
        bf16* gwt = (bf16*)(ws + WS_GWT); float* wkq = (float*)(ws + WS_WKQ);
        const float* wq = IN(I_MWQ); const float* wk = IN(I_MWK); const float* wv = IN(I_MWV); const float* wg = IN(I_MWG);
        const int gt = F.bid * NTHR + F.tid, nt = F.G * NTHR;
        for (int i = gt; i < MI * 16; i += nt) { const int ch = i >> 4, g = i & 15, n = ch >> 2, c = ch & 3; float sa = 0.f, sb = 0.f;
#pragma unroll
            for (int e = 0; e < 4; ++e) { sa += wq[n * 16 + c * 4 + e] * wg[(size_t)(n * 4 + e) * 16 + g] + wk[n * 16 + c * 4 + e] * wg[(size_t)(MI + n * 4 + e) * 16 + g];
                sb += wv[n * 16 + c * 4 + e] * wg[(size_t)(2 * MI + n * 4 + e) * 16 + g]; }
            const size_t go = ((size_t)(ch >> 5) * 64 + g + 16 * ((ch & 31) >> 3)) * 8 + (ch & 7);
            gwt[go] = (bf16)f2bf(sa); gwt[go + 64 * 512] = (bf16)f2bf(sb); }
        const float sc = 0.044194173824159216f;
        for (int i = gt; i < 512 * 16; i += nt) { const int n = i >> 4, c = (i >> 2) & 3, c2 = i & 3; float s = 0.f;
#pragma unroll
            for (int e = 0; e < 4; ++e) s += wk[n * 16 + c * 4 + e] * wq[n * 16 + c2 * 4 + e];
            wkq[i] = s * sc; }
    }
}

__device__ __forceinline__ void kt_items(Fr& F, const float* h3rows, int L, float* KT, int vgw, int vngw) {
    const float* wout = IN(I_FWOUT);
    const int nitems = (L / 16) * 32, fr = F.lane & 15, fq = F.lane >> 4;
    for (int it = vgw; it < nitems; it += vngw) {
        const int t0 = (it >> 5) * 16, n0 = (it & 31) * 64;
        float a[16];
#pragma unroll
        for (int ks = 0; ks < 16; ++ks) a[ks] = h3rows[(size_t)(t0 + fr) * 64 + 4 * ks + fq];
#pragma unroll
        for (int nt = 0; nt < 4; ++nt) {
            f32x4 acc = (f32x4){0.f, 0.f, 0.f, 0.f};
#pragma unroll
            for (int ks = 0; ks < 16; ++ks) acc = __builtin_amdgcn_mfma_f32_16x16x4f32(a[ks], wout[(size_t)(4 * ks + fq) * 2048 + n0 + nt * 16 + fr], acc, 0, 0, 0);
            const int n = n0 + nt * 16 + fr, dirn = n >> 10, c = n & 1023;
            const float delta = fabsf(HY_MIN_DECAY + (float)c * ((HY_MAX_DECAY - HY_MIN_DECAY) / 1023.0f)), il = 1.0f / (float)(L - 1);
            f32x4 o;
#pragma unroll
            for (int r = 0; r < 4; ++r) o[r] = acc[r] * __expf(-(float)(t0 + 4 * fq + r) * il * delta);
            *(f32x4*)(KT + ((size_t)c * 2 + dirn) * L + t0 + 4 * fq) = o;
        }
    }
}

__device__ __forceinline__ void modnorm_row(const float* xrow, const float* g, const float* sh, const float* sc, bf16* orow, int lane) {
    const f32x4* xr = (const f32x4*)xrow + lane; f32x4 v[4]; float s = 0.f;
#pragma unroll
    for (int j = 0; j < 4; ++j) { v[j] = xr[64 * j]; s += (v[j][0] * v[j][0] + v[j][1] * v[j][1]) + (v[j][2] * v[j][2] + v[j][3] * v[j][3]); }
    const float rinv = 1.0f / sqrtf(wave_sum(s) * (1.0f / 1024.0f) + EPS);
    u32x2* o8 = (u32x2*)orow + lane;
#pragma unroll
    for (int j = 0; j < 4; ++j) { const int c = 4 * lane + 256 * j; const f32x4 gg = *(const f32x4*)(g + c), s1 = *(const f32x4*)(sc + c), s0 = *(const f32x4*)(sh + c);
        const f32x4 y = (v[j] * rinv * gg) * (1.0f + s1) + s0; u32x2 w; w.x = pk2(y[0], y[1]); w.y = pk2(y[2], y[3]); o8[64 * j] = w; }
}
__device__ __forceinline__ void ph_modnorm(Fr& F, const float* xlat, int nlat, int b0, const float* xctx, int nctx, const float* g, const float* modl, int shoff, bf16* H,
                                           const bf16* dl = nullptr, float* olat = nullptr, float* octx = nullptr) {
    const int nrows = nlat + nctx;
    for (int r = F.gw; r < nrows; r += 2 * F.ngw) {
        const int r2 = r + F.ngw; const bool has2 = r2 < nrows; const int rb = has2 ? r2 : r;
        const bool isl = r < nlat, isl2 = rb < nlat;
        const size_t oa_ = isl ? (size_t)r * 1024 : (size_t)(r - nlat) * 1024, ob_ = isl2 ? (size_t)rb * 1024 : (size_t)(rb - nlat) * 1024;
        const float* xa = (isl ? xlat : xctx) + oa_; const float* xb = (isl2 ? xlat : xctx) + ob_;
        const int ma = isl ? b0 + r / SEQ : 4, mb = isl2 ? b0 + rb / SEQ : 4;
        const f32x4* pa = (const f32x4*)xa + F.lane; const f32x4* pb = (const f32x4*)xb + F.lane; f32x4 va[4], vb[4]; float sa = 0.f, sb = 0.f;
#pragma unroll
        for (int j = 0; j < 4; ++j) { va[j] = pa[64 * j]; vb[j] = pb[64 * j]; }
        if (dl) {
            const u32x2* da = (const u32x2*)(dl + (size_t)r * 1024) + F.lane; const u32x2* db = (const u32x2*)(dl + (size_t)rb * 1024) + F.lane;
            f32x4* qa = (f32x4*)((isl ? olat : octx) + oa_) + F.lane; f32x4* qb = (f32x4*)((isl2 ? olat : octx) + ob_) + F.lane;
#pragma unroll
            for (int j = 0; j < 4; ++j) { const u32x2 a = da[64 * j], b = db[64 * j];
                va[j] = va[j] + (f32x4){bflo(a.x), bfhi(a.x), bflo(a.y), bfhi(a.y)}; vb[j] = vb[j] + (f32x4){bflo(b.x), bfhi(b.x), bflo(b.y), bfhi(b.y)};
                qa[64 * j] = va[j]; if (has2) qb[64 * j] = vb[j]; }
        }
#pragma unroll
        for (int j = 0; j < 4; ++j) { sa += (va[j][0] * va[j][0] + va[j][1] * va[j][1]) + (va[j][2] * va[j][2] + va[j][3] * va[j][3]); sb += (vb[j][0] * vb[j][0] + vb[j][1] * vb[j][1]) + (vb[j][2] * vb[j][2] + vb[j][3] * vb[j][3]); }
        const float ra = __builtin_amdgcn_rsqf(wave_sum(sa) * (1.0f / 1024.0f) + EPS), rbv = __builtin_amdgcn_rsqf(wave_sum(sb) * (1.0f / 1024.0f) + EPS);
        const float* sha = modl + (size_t)ma * 6144 + shoff; const float* shb = modl + (size_t)mb * 6144 + shoff;
        u32x2* oa = (u32x2*)(H + (size_t)r * 1024) + F.lane; u32x2* ob = (u32x2*)(H + (size_t)rb * 1024) + F.lane;
#pragma unroll
        for (int j = 0; j < 4; ++j) { const int c = 4 * F.lane + 256 * j; const f32x4 gg = *(const f32x4*)(g + c);
            const f32x4 ya = (va[j] * ra * gg) * (1.0f + *(const f32x4*)(sha + 1024 + c)) + *(const f32x4*)(sha + c);
            const f32x4 yb = (vb[j] * rbv * gg) * (1.0f + *(const f32x4*)(shb + 1024 + c)) + *(const f32x4*)(shb + c);
            oa[64 * j] = (u32x2){pk2(ya[0], ya[1]), pk2(ya[2], ya[3])};
            if (has2) ob[64 * j] = (u32x2){pk2(yb[0], yb[1]), pk2(yb[2], yb[3])}; }
    }
}
__device__ __forceinline__ void add_delta_rows(Fr& F, float* x, const bf16* dl, int r0, int n) {
    for (int r = r0 + F.gw; r < r0 + n; r += F.ngw) {
        f32x4* px = (f32x4*)(x + (size_t)r * 1024) + F.lane; const u32x2* pd = (const u32x2*)(dl + (size_t)r * 1024) + F.lane; f32x4 v[4]; u32x2 d[4];
#pragma unroll
        for (int j = 0; j < 4; ++j) { v[j] = px[64 * j]; d[j] = pd[64 * j]; }
#pragma unroll
        for (int j = 0; j < 4; ++j) px[64 * j] = v[j] + (f32x4){bflo(d[j].x), bfhi(d[j].x), bflo(d[j].y), bfhi(d[j].y)};
    }
}

__device__ __forceinline__ void zt_items(Fr& F, const bf16* __restrict__ P, int rowbase, int nb, int Ls, bf16* __restrict__ ZT) {
    LAS unsigned char* tile = F.lds + F.wave * 16384;
    const float* scw = IN(I_HSCW); const float* scb = IN(I_HSCB);
    const int ntt = Ls / 64, nitems = nb * ntt * 16, tl = F.lane >> 3, c8 = F.lane & 7;
    for (int it = F.gw; it < nitems; it += F.ngw) {
        const int ct = it & 15, tt = (it >> 4) % ntt, b = (it >> 4) / ntt, t0 = tt * 64, ch = ct * 64 + c8 * 8;
        float w1[3][8], w2[3][8], b1[8], b2[8];
#pragma unroll
        for (int k = 0; k < 3; ++k) { const f32x4 a0 = *(const f32x4*)(scw + k * 3072 + 1024 + ch), a1 = *(const f32x4*)(scw + k * 3072 + 1024 + ch + 4), d0 = *(const f32x4*)(scw + k * 3072 + 2048 + ch), d1 = *(const f32x4*)(scw + k * 3072 + 2048 + ch + 4);
#pragma unroll
            for (int e = 0; e < 4; ++e) { w1[k][e] = a0[e]; w1[k][4 + e] = a1[e]; w2[k][e] = d0[e]; w2[k][4 + e] = d1[e]; } }
        { const f32x4 a0 = *(const f32x4*)(scb + 1024 + ch), a1 = *(const f32x4*)(scb + 1024 + ch + 4), d0 = *(const f32x4*)(scb + 2048 + ch), d1 = *(const f32x4*)(scb + 2048 + ch + 4);
#pragma unroll
            for (int e = 0; e < 4; ++e) { b1[e] = a0[e]; b1[4 + e] = a1[e]; b2[e] = d0[e]; b2[4 + e] = d1[e]; } }
        const bf16* pb = P + (size_t)(rowbase + b * Ls) * 3072 + ch;
#pragma unroll 4
        for (int i8 = 0; i8 < 8; ++i8) {
            const int tloc = i8 * 8 + tl, t = t0 + tloc, tm = t > 0 ? t - 1 : t, tp = t + 1 < Ls ? t + 1 : t; const float mm = t > 0 ? 1.f : 0.f, mp = t + 1 < Ls ? 1.f : 0.f;
            const u32x4 r1m = *(const u32x4*)(pb + (size_t)tm * 3072 + 1024), r1c = *(const u32x4*)(pb + (size_t)t * 3072 + 1024), r1p = *(const u32x4*)(pb + (size_t)tp * 3072 + 1024);
            const u32x4 r2m = *(const u32x4*)(pb + (size_t)tm * 3072 + 2048), r2c = *(const u32x4*)(pb + (size_t)t * 3072 + 2048), r2p = *(const u32x4*)(pb + (size_t)tp * 3072 + 2048);
            float xm[8], xc[8], xp[8], vm[8], vc[8], vp[8];
            unpack8(r1m, xm); unpack8(r1c, xc); unpack8(r1p, xp); unpack8(r2m, vm); unpack8(r2c, vc); unpack8(r2p, vp);
            float zz[8];
#pragma unroll
            for (int e = 0; e < 8; ++e) { const float a = w1[0][e] * (xm[e] * mm) + w1[1][e] * xc[e] + w1[2][e] * (xp[e] * mp) + b1[e], d = w2[0][e] * (vm[e] * mm) + w2[1][e] * vc[e] + w2[2][e] * (vp[e] * mp) + b2[e]; zz[e] = a * d; }
#pragma unroll
            for (int e = 0; e < 8; e += 2) { const unsigned p = pk2(zz[e], zz[e + 1]);
                *(LAS bf16*)(tile + (c8 * 8 + e) * 136 + tloc * 2) = (bf16)(p & 0xffffu); *(LAS bf16*)(tile + (c8 * 8 + e + 1) * 136 + tloc * 2) = (bf16)(p >> 16); }
        }
#pragma unroll
        for (int q = 0; q < 8; ++q) { const int cc = q * 8 + (F.lane >> 3), chk = F.lane & 7;
            const u32x2 lo = *(const LAS u32x2*)(tile + cc * 136 + chk * 16), hi = *(const LAS u32x2*)(tile + cc * 136 + chk * 16 + 8);
            u32x4 o; o.x = lo.x; o.y = lo.y; o.z = hi.x; o.w = hi.y;
            *(u32x4*)(ZT + ((size_t)b * 1024 + ct * 64 + cc) * Ls + t0 + chk * 8) = o; }
    }
}

__device__ __forceinline__ f32x2 cmul(f32x2 a, f32x2 b) { return (f32x2){a.x * b.x - a.y * b.y, a.x * b.y + a.y * b.x}; }
__device__ __forceinline__ f32x2 cmulc(f32x2 a, f32x2 b) { return (f32x2){a.x * b.x + a.y * b.y, a.y * b.x - a.x * b.y}; }
__device__ __forceinline__ f32x2 twid(float f) { return (f32x2){__builtin_amdgcn_cosf(f), __builtin_amdgcn_sinf(f)}; }
#define PH(e) ((e) + ((e) >> 4))
__device__ __forceinline__ void fft_fwd(LAS f32x2* buf, int tid, int plo, int phi) {
#pragma unroll 1
    for (int p = plo; p < phi; ++p) {
        const int lq = 12 - 2 * p, q = 1 << lq; const float invN = 1.0f / (float)(4 * q);
#pragma unroll 2
        for (int m = 0; m < 8; ++m) {
            const int g = tid + 512 * m, i = g & (q - 1), i0 = ((g >> lq) << (lq + 2)) + i;
            const int e0 = PH(i0), e1 = PH(i0 + q), e2 = PH(i0 + 2 * q), e3 = PH(i0 + 3 * q);
            const f32x2 a0 = buf[e0], a1 = buf[e1], a2 = buf[e2], a3 = buf[e3];
            const f32x2 t0 = a0 + a2, t1 = a0 - a2, t2 = a1 + a3, d = a1 - a3, t3 = (f32x2){d.y, -d.x};
            const f32x2 w1 = twid(-(float)i * invN), w2 = cmul(w1, w1), w3 = cmul(w2, w1);
            buf[e0] = t0 + t2; buf[e1] = cmul(t1 + t3, w1); buf[e2] = cmul(t0 - t2, w2); buf[e3] = cmul(t1 - t3, w3);
        }
        __syncthreads();
    }
}
__device__ __forceinline__ void fft_inv(LAS f32x2* buf, int tid, int plo, int phi) {
#pragma unroll 1
    for (int p = phi - 1; p >= plo; --p) {
        const int lq = 12 - 2 * p, q = 1 << lq; const float invN = 1.0f / (float)(4 * q);
#pragma unroll 2
        for (int m = 0; m < 8; ++m) {
            const int g = tid + 512 * m, i = g & (q - 1), i0 = ((g >> lq) << (lq + 2)) + i;
            const int e0 = PH(i0), e1 = PH(i0 + q), e2 = PH(i0 + 2 * q), e3 = PH(i0 + 3 * q);
            const f32x2 w1 = twid((float)i * invN), w2 = cmul(w1, w1), w3 = cmul(w2, w1);
            const f32x2 b0 = buf[e0], b1 = cmul(buf[e1], w1), b2 = cmul(buf[e2], w2), b3 = cmul(buf[e3], w3);
            const f32x2 t0 = b0 + b2, t1 = b0 - b2, t2 = b1 + b3, d = b1 - b3, t3 = (f32x2){-d.y, d.x};
            buf[e0] = t0 + t2; buf[e1] = t1 + t3; buf[e2] = t0 - t2; buf[e3] = t1 - t3;
        }
        __syncthreads();
    }
}
__device__ __forceinline__ void fwd16_A(f32x2 (&x)[16]) {
    const float C1 = 0.92387953251128674f, S1 = 0.38268343236508977f, R2 = 0.70710678118654752f;
#pragma unroll
    for (int i = 0; i < 4; ++i) {
        const f32x2 a0 = x[i], a1 = x[i + 4], a2 = x[i + 8], a3 = x[i + 12];
        const f32x2 t0 = a0 + a2, t1 = a0 - a2, t2 = a1 + a3, d = a1 - a3, t3 = (f32x2){d.y, -d.x};
        const f32x2 y1 = t1 + t3, y2 = t0 - t2, y3 = t1 - t3;
        x[i] = t0 + t2;
        if (i == 0) { x[4] = y1; x[8] = y2; x[12] = y3; }
        else if (i == 1) { x[5] = cmul(y1, (f32x2){C1, -S1}); x[9] = cmul(y2, (f32x2){R2, -R2}); x[13] = cmul(y3, (f32x2){S1, -C1}); }
        else if (i == 2) { x[6] = cmul(y1, (f32x2){R2, -R2}); x[10] = (f32x2){y2.y, -y2.x}; x[14] = cmul(y3, (f32x2){-R2, -R2}); }
        else { x[7] = cmul(y1, (f32x2){S1, -C1}); x[11] = cmul(y2, (f32x2){-R2, -R2}); x[15] = cmul(y3, (f32x2){-C1, S1}); }
    }
}
__device__ __forceinline__ void fwd16_B(f32x2 (&x)[16]) {
#pragma unroll
    for (int g = 0; g < 4; ++g) {
        const f32x2 a0 = x[4 * g], a1 = x[4 * g + 1], a2 = x[4 * g + 2], a3 = x[4 * g + 3];
        const f32x2 t0 = a0 + a2, t1 = a0 - a2, t2 = a1 + a3, d = a1 - a3, t3 = (f32x2){d.y, -d.x};
        x[4 * g] = t0 + t2; x[4 * g + 1] = t1 + t3; x[4 * g + 2] = t0 - t2; x[4 * g + 3] = t1 - t3;
    }
}
__device__ __forceinline__ void inv16_B(f32x2 (&x)[16]) {
#pragma unroll
    for (int g = 0; g < 4; ++g) {
        const f32x2 b0 = x[4 * g], b1 = x[4 * g + 1], b2 = x[4 * g + 2], b3 = x[4 * g + 3];
        const f32x2 t0 = b0 + b2, t1 = b0 - b2, t2 = b1 + b3, d = b1 - b3, t3 = (f32x2){-d.y, d.x};
        x[4 * g] = t0 + t2; x[4 * g + 1] = t1 + t3; x[4 * g + 2] = t0 - t2; x[4 * g + 3] = t1 - t3;
    }
}
__device__ __forceinline__ void inv16_A(f32x2 (&x)[16]) {
    const float C1 = 0.92387953251128674f, S1 = 0.38268343236508977f, R2 = 0.70710678118654752f;
#pragma unroll
    for (int i = 0; i < 4; ++i) {
        f32x2 b0 = x[i], b1 = x[i + 4], b2 = x[i + 8], b3 = x[i + 12];
        if (i == 1) { b1 = cmul(b1, (f32x2){C1, S1}); b2 = cmul(b2, (f32x2){R2, R2}); b3 = cmul(b3, (f32x2){S1, C1}); }
        else if (i == 2) { b1 = cmul(b1, (f32x2){R2, R2}); b2 = (f32x2){-b2.y, b2.x}; b3 = cmul(b3, (f32x2){-R2, R2}); }
        else if (i == 3) { b1 = cmul(b1, (f32x2){S1, C1}); b2 = cmul(b2, (f32x2){-R2, R2}); b3 = cmul(b3, (f32x2){-C1, -S1}); }
        const f32x2 t0 = b0 + b2, t1 = b0 - b2, t2 = b1 + b3, d = b1 - b3, t3 = (f32x2){-d.y, d.x};
        x[i] = t0 + t2; x[i + 4] = t1 + t3; x[i + 8] = t0 - t2; x[i + 12] = t1 - t3;
    }
}
__device__ __forceinline__ void fwd16(f32x2 (&x)[16]) { fwd16_A(x); fwd16_B(x); }
__device__ __forceinline__ void inv16(f32x2 (&x)[16]) { inv16_B(x); inv16_A(x); }
__device__ __forceinline__ void r16_fwd2(LAS f32x2* buf, int tid) {
#pragma unroll 1
  for (int lqp = 8; lqp >= 4; lqp -= 4) {
    const int qp = 1 << lqp; const float inv = 1.0f / (float)(16 * qp);
#pragma unroll
    for (int m = 0; m < 2; ++m) {
        const int g = tid + 512 * m, i = g & (qp - 1), e0 = ((g >> lqp) << (lqp + 4)) + i; f32x2 x[16];
#pragma unroll
        for (int j = 0; j < 16; ++j) x[j] = buf[PH(e0 + (j << lqp))];
        const f32x2 w1 = twid(-(float)i * inv), w2 = cmul(w1, w1), w3 = cmul(w2, w1), v1 = cmul(w2, w2), v2 = cmul(v1, v1), v3 = cmul(v2, v1);
        fwd16_A(x);
#pragma unroll
        for (int l = 0; l < 4; ++l) { x[l + 4] = cmul(x[l + 4], w1); x[l + 8] = cmul(x[l + 8], w2); x[l + 12] = cmul(x[l + 12], w3); }
        fwd16_B(x);
#pragma unroll
        for (int k = 0; k < 4; ++k) { x[4 * k + 1] = cmul(x[4 * k + 1], v1); x[4 * k + 2] = cmul(x[4 * k + 2], v2); x[4 * k + 3] = cmul(x[4 * k + 3], v3); }
#pragma unroll
        for (int j = 0; j < 16; ++j) buf[PH(e0 + (j << lqp))] = x[j];
    }
    __syncthreads();
  }
}
__device__ __forceinline__ void r16_inv2(LAS f32x2* buf, int tid) {
#pragma unroll 1
  for (int lqp = 4; lqp <= 8; lqp += 4) {
    const int qp = 1 << lqp; const float inv = 1.0f / (float)(16 * qp);
#pragma unroll
    for (int m = 0; m < 2; ++m) {
        const int g = tid + 512 * m, i = g & (qp - 1), e0 = ((g >> lqp) << (lqp + 4)) + i; f32x2 x[16];
#pragma unroll
        for (int j = 0; j < 16; ++j) x[j] = buf[PH(e0 + (j << lqp))];
        const f32x2 w1 = twid((float)i * inv), w2 = cmul(w1, w1), w3 = cmul(w2, w1), v1 = cmul(w2, w2), v2 = cmul(v1, v1), v3 = cmul(v2, v1);
#pragma unroll
        for (int k = 0; k < 4; ++k) { x[4 * k + 1] = cmul(x[4 * k + 1], v1); x[4 * k + 2] = cmul(x[4 * k + 2], v2); x[4 * k + 3] = cmul(x[4 * k + 3], v3); }
        inv16_B(x);
#pragma unroll
        for (int l = 0; l < 4; ++l) { x[l + 4] = cmul(x[l + 4], w1); x[l + 8] = cmul(x[l + 8], w2); x[l + 12] = cmul(x[l + 12], w3); }
        inv16_A(x);
#pragma unroll
        for (int j = 0; j < 16; ++j) buf[PH(e0 + (j << lqp))] = x[j];
    }
    __syncthreads();
  }
}
__device__ __forceinline__ float block_sum(Fr& F, float v, LAS float* red) {
    v = wave_sum(v);
    __syncthreads();
    if (F.lane == 0) red[F.wave] = v;
    __syncthreads();
    float s = 0.f;
#pragma unroll
    for (int w = 0; w < 8; ++w) s += red[w];
    return s;
}
__device__ __forceinline__ void ph_fftconv(Fr& F) {
    LAS f32x2* buf = (LAS f32x2*)F.lds; LAS float* red = (LAS float*)(F.lds + 139392);
    const float* KT = (const float*)(F.ws + HY_KT); const float* KTC = (const float*)(F.ws + WS_KTC);
    bf16* ZT = (bf16*)(F.ws + HY_ZT); bf16* ZTC = (bf16*)(F.ws + HY_ZTC);
    const int tid = F.tid;
    for (int c = F.bid; c < 1024; c += F.G) {
        const float bias = IN(I_HBIAS)[c];
        __syncthreads();
        float asum = 0.f;
        const f32x4* kf = (const f32x4*)(KT + (size_t)c * 2 * SEQ); const f32x4* kb = kf + SEQ / 4;
#pragma unroll
        for (int q = 0; q < 4; ++q) { const int i4 = tid + 512 * q; const f32x4 v = kf[i4];
            asum += fabsf(v[0]) + fabsf(v[1]) + fabsf(v[2]) + fabsf(v[3]);
            buf[PH(4 * i4)] = (f32x2){v[0], 0.f}; buf[PH(4 * i4 + 1)] = (f32x2){v[1], 0.f}; buf[PH(4 * i4 + 2)] = (f32x2){v[2], 0.f}; buf[PH(4 * i4 + 3)] = (f32x2){v[3], 0.f};
            const f32x4 u = kb[i4]; const int m = 4 * i4;
            if (m > 0) { buf[PH(16384 - m)] = (f32x2){u[0], 0.f}; asum += fabsf(u[0]); } else buf[PH(8192)] = (f32x2){0.f, 0.f};
            buf[PH(16384 - m - 1)] = (f32x2){u[1], 0.f}; buf[PH(16384 - m - 2)] = (f32x2){u[2], 0.f}; buf[PH(16384 - m - 3)] = (f32x2){u[3], 0.f};
            asum += fabsf(u[1]) + fabsf(u[2]) + fabsf(u[3]); }
        const float S = block_sum(F, asum, red);
        __syncthreads();
        fft_fwd(buf, tid, 0, 1); r16_fwd2(buf, tid);
        f32x4* Ks = (f32x4*)(F.ws + HY_KS) + (size_t)(F.bid & 255) * 8192 + tid * 8; const float ksc = 1.0f / (S * 16384.0f);
#pragma unroll 1
        for (int m = 0; m < 2; ++m) { const int pb = 17 * (tid + 512 * m); f32x2 x[16];
#pragma unroll
            for (int n = 0; n < 16; ++n) x[n] = buf[pb + n];
            fwd16(x);
#pragma unroll
            for (int n = 0; n < 8; ++n) Ks[m * 4096 + n] = (f32x4){x[2 * n].x * ksc, x[2 * n].y * ksc, x[2 * n + 1].x * ksc, x[2 * n + 1].y * ksc}; }
        const f32x2 dl = twid(-1.0f / 16384.0f);
#pragma unroll 1
        for (int pr = 0; pr < 2; ++pr) {
            bf16* z0 = ZT + ((size_t)(2 * pr) * 1024 + c) * SEQ; bf16* z1 = ZT + ((size_t)(2 * pr + 1) * 1024 + c) * SEQ;
            const int i8 = tid * 8;
            __syncthreads();
            {
                float a[8], b[8], cx[8], dx[8];
                unpack8(*(const u32x4*)(z0 + i8), a); unpack8(*(const u32x4*)(z1 + i8), b); unpack8(*(const u32x4*)(z0 + 4096 + i8), cx); unpack8(*(const u32x4*)(z1 + 4096 + i8), dx);
                f32x2 w1 = twid(-(float)i8 * (1.0f / 16384.0f));
#pragma unroll
                for (int e = 0; e < 8; ++e) { const f32x2 a0 = (f32x2){a[e], b[e]}, a1 = (f32x2){cx[e], dx[e]}, t3 = (f32x2){a1.y, -a1.x}; const f32x2 w2 = cmul(w1, w1), w3 = cmul(w2, w1);
                    buf[PH(i8 + e)] = a0 + a1; buf[PH(4096 + i8 + e)] = cmul(a0 + t3, w1); buf[PH(8192 + i8 + e)] = cmul(a0 - a1, w2); buf[PH(12288 + i8 + e)] = cmul(a0 - t3, w3);
                    w1 = cmul(w1, dl); }
            }
            __syncthreads();
            r16_fwd2(buf, tid);
#pragma unroll 1
            for (int m = 0; m < 2; ++m) { const int pb = 17 * (tid + 512 * m); f32x2 x[16];
#pragma unroll
                for (int n = 0; n < 16; ++n) x[n] = buf[pb + n];
                fwd16(x);
#pragma unroll
                for (int n = 0; n < 8; ++n) { const f32x4 k = Ks[m * 4096 + n]; x[2 * n] = cmul(x[2 * n], (f32x2){k[0], k[1]}); x[2 * n + 1] = cmul(x[2 * n + 1], (f32x2){k[2], k[3]}); }
                inv16(x);
#pragma unroll
                for (int n = 0; n < 16; ++n) buf[pb + n] = x[n]; }
            __syncthreads();
            r16_inv2(buf, tid);
            {
                float a[8], b[8], cx[8], dx[8];
                unpack8(*(const u32x4*)(z0 + i8), a); unpack8(*(const u32x4*)(z1 + i8), b); unpack8(*(const u32x4*)(z0 + 4096 + i8), cx); unpack8(*(const u32x4*)(z1 + 4096 + i8), dx);
                f32x2 w1 = twid(-(float)i8 * (1.0f / 16384.0f));
#pragma unroll
                for (int e = 0; e < 8; ++e) { const f32x2 w2 = cmul(w1, w1), w3 = cmul(w2, w1);
                    const f32x2 b0 = buf[PH(i8 + e)], b1 = cmulc(buf[PH(4096 + i8 + e)], w1), b2 = cmulc(buf[PH(8192 + i8 + e)], w2), b3 = cmulc(buf[PH(12288 + i8 + e)], w3);
                    const f32x2 t0 = b0 + b2, t1 = b0 - b2, t2 = b1 + b3, d = b1 - b3, t3 = (f32x2){-d.y, d.x};
                    const f32x2 y0 = t0 + t2, y1 = t1 + t3;
                    a[e] = y0.x + a[e] * bias; b[e] = y0.y + b[e] * bias; cx[e] = y1.x + cx[e] * bias; dx[e] = y1.y + dx[e] * bias;
                    w1 = cmul(w1, dl); }
                *(u32x4*)(z0 + i8) = pack8(a); *(u32x4*)(z1 + i8) = pack8(b); *(u32x4*)(z0 + 4096 + i8) = pack8(cx); *(u32x4*)(z1 + 4096 + i8) = pack8(dx);
            }
        }
        __syncthreads();
        {
            LAS float* kc = (LAS float*)F.lds; LAS float* zc = kc + 512;
            const float* kfc = KTC + (size_t)c * 2 * CTXL; float v = 0.f;
            { const int n = tid; if (n < 256) v = kfc[n]; else if (n == 256) v = 0.f; else v = kfc[CTXL + (512 - n)]; kc[n] = v; }
            const float Sc = block_sum(F, fabsf(v), red);
            for (int i = tid; i < 1024; i += NTHR) { const int b = i >> 8, t = i & 255; zc[i] = bf2f(ZTC[((size_t)b * 1024 + c) * CTXL + t]); }
            __syncthreads();
            const int b = tid >> 7, t2 = tid & 127; const float isc = 1.0f / Sc;
#pragma unroll
            for (int hh = 0; hh < 2; ++hh) { const int t = t2 + 128 * hh; float acc = 0.f;
#pragma unroll 8
                for (int s = 0; s < 256; ++s) acc += zc[b * 256 + s] * kc[(t - s) & 511];
                ZTC[((size_t)b * 1024 + c) * CTXL + t] = (bf16)f2bf(acc * isc + zc[b * 256 + t] * bias); }
        }
    }
}

__device__ __forceinline__ void u2_items(Fr& F, const bf16* __restrict__ P, int rowbase, int nb, int Ls, const bf16* __restrict__ YT, bf16* __restrict__ U2) {
    LAS unsigned char* tile = F.lds + F.wave * 16384;
    const float* scw = IN(I_HSCW); const float* scb = IN(I_HSCB);
    const int ntt = Ls / 64, nitems = nb * ntt * 16, tl = F.lane >> 3, c8 = F.lane & 7;
    for (int it = F.gw; it < nitems; it += F.ngw) {
        const int ct = it & 15, tt = (it >> 4) % ntt, b = (it >> 4) / ntt, t0 = tt * 64, ch = ct * 64 + c8 * 8;
#pragma unroll
        for (int q = 0; q < 8; ++q) { const int cc = q * 8 + (F.lane >> 3), chk = F.lane & 7;
            const u32x4 v = *(const u32x4*)(YT + ((size_t)b * 1024 + ct * 64 + cc) * Ls + t0 + chk * 8);
            *(LAS u32x2*)(tile + cc * 136 + chk * 16) = (u32x2){v.x, v.y}; *(LAS u32x2*)(tile + cc * 136 + chk * 16 + 8) = (u32x2){v.z, v.w}; }
        float w0[3][8], bb[8];
#pragma unroll
        for (int k = 0; k < 3; ++k) { const f32x4 a0 = *(const f32x4*)(scw + k * 3072 + ch), a1 = *(const f32x4*)(scw + k * 3072 + ch + 4);
#pragma unroll
            for (int e = 0; e < 4; ++e) { w0[k][e] = a0[e]; w0[k][4 + e] = a1[e]; } }
        { const f32x4 a0 = *(const f32x4*)(scb + ch), a1 = *(const f32x4*)(scb + ch + 4);
#pragma unroll
            for (int e = 0; e < 4; ++e) { bb[e] = a0[e]; bb[4 + e] = a1[e]; } }
        const bf16* pb = P + (size_t)(rowbase + b * Ls) * 3072 + ch; bf16* ub = U2 + (size_t)(rowbase + b * Ls) * 1024 + ch;
#pragma unroll 4
        for (int i8 = 0; i8 < 8; ++i8) {
            const int tloc = i8 * 8 + tl, t = t0 + tloc, tm = t > 0 ? t - 1 : t, tp = t + 1 < Ls ? t + 1 : t; const float mm = t > 0 ? 1.f : 0.f, mp = t + 1 < Ls ? 1.f : 0.f;
            const u32x4 rm = *(const u32x4*)(pb + (size_t)tm * 3072), rc = *(const u32x4*)(pb + (size_t)t * 3072), rp = *(const u32x4*)(pb + (size_t)tp * 3072);
            float xm[8], xc[8], xp[8], o[8];
            unpack8(rm, xm); unpack8(rc, xc); unpack8(rp, xp);
#pragma unroll
            for (int e = 0; e < 8; ++e) { const float x0 = w0[0][e] * (xm[e] * mm) + w0[1][e] * xc[e] + w0[2][e] * (xp[e] * mp) + bb[e]; o[e] = x0 * bf2f(*(const LAS bf16*)(tile + (c8 * 8 + e) * 136 + tloc * 2)); }
            *(u32x4*)(ub + (size_t)t * 1024) = pack8(o);
        }
    }
}

__device__ __forceinline__ void dw_item(const bf16* __restrict__ G, bf16* __restrict__ A, const float* __restrict__ cw, const float* __restrict__ cb, int f8, int rowtok0, int nx, int x0, bool up_ok, bool down_ok) {
    float w[9][8], bias[8];
#pragma unroll
    for (int k = 0; k < 9; ++k) { const float m = (k < 3) ? (up_ok ? 1.f : 0.f) : ((k >= 6) ? (down_ok ? 1.f : 0.f) : 1.f);
        const f32x4 w0 = *(const f32x4*)(cw + (size_t)k * FF + f8) * m, w1 = *(const f32x4*)(cw + (size_t)k * FF + f8 + 4) * m;
        w[k][0] = w0[0]; w[k][1] = w0[1]; w[k][2] = w0[2]; w[k][3] = w0[3]; w[k][4] = w1[0]; w[k][5] = w1[1]; w[k][6] = w1[2]; w[k][7] = w1[3]; }
    { const f32x4 b0 = *(const f32x4*)(cb + f8), b1 = *(const f32x4*)(cb + f8 + 4); bias[0] = b0[0]; bias[1] = b0[1]; bias[2] = b0[2]; bias[3] = b0[3]; bias[4] = b1[0]; bias[5] = b1[1]; bias[6] = b1[2]; bias[7] = b1[3]; }
    const int upo = up_ok ? -nx : 0, dno = down_ok ? nx : 0;
    const bf16* __restrict__ g0 = G + (size_t)rowtok0 * FF + f8; bf16* __restrict__ a0 = A + (size_t)rowtok0 * FF + f8;
    const u32x4 zero4 = (u32x4){0u, 0u, 0u, 0u};
    u32x4 cm[3], cc[3];
    { const int xm = x0 > 0 ? x0 - 1 : 0; const bool okm = x0 > 0;
        cm[0] = *(const u32x4*)(g0 + (size_t)(xm + upo) * FF); cm[1] = *(const u32x4*)(g0 + (size_t)xm * FF); cm[2] = *(const u32x4*)(g0 + (size_t)(xm + dno) * FF);
        if (!okm) { cm[0] = zero4; cm[1] = zero4; cm[2] = zero4; }
        cc[0] = *(const u32x4*)(g0 + (size_t)(x0 + upo) * FF); cc[1] = *(const u32x4*)(g0 + (size_t)x0 * FF); cc[2] = *(const u32x4*)(g0 + (size_t)(x0 + dno) * FF); }
    u32x4 pa[2][3], pav[2], pb[2][3], pbv[2];
#define DW_LOAD_GROUP(buf, bufv, jg) do { _Pragma("unroll") for (int u = 0; u < 2; ++u) { const int x_ = x0 + (jg) + u, xp_ = x_ + 1 < nx ? x_ + 1 : nx - 1; \
        buf[u][0] = *(const u32x4*)(g0 + (size_t)(xp_ + upo) * FF); buf[u][1] = *(const u32x4*)(g0 + (size_t)xp_ * FF); buf[u][2] = *(const u32x4*)(g0 + (size_t)(xp_ + dno) * FF); \
        bufv[u] = *(const u32x4*)(a0 + (size_t)x_ * FF); } } while (0)
#define DW_COMPUTE_GROUP(buf, bufv, jg) do { _Pragma("unroll") for (int u = 0; u < 2; ++u) { \
        const int x = x0 + (jg) + u; const bool okp = x + 1 < nx; \
        if (!okp) { buf[u][0] = zero4; buf[u][1] = zero4; buf[u][2] = zero4; } \
        float acc[8]; \
        _Pragma("unroll") for (int e = 0; e < 8; ++e) acc[e] = bias[e]; \
        _Pragma("unroll") for (int dy = 0; dy < 3; ++dy) { float v[8]; \
            unpack8(cm[dy], v); _Pragma("unroll") for (int e = 0; e < 8; ++e) acc[e] += v[e] * w[dy * 3 + 0][e]; \
            unpack8(cc[dy], v); _Pragma("unroll") for (int e = 0; e < 8; ++e) acc[e] += v[e] * w[dy * 3 + 1][e]; \
            unpack8(buf[u][dy], v); _Pragma("unroll") for (int e = 0; e < 8; ++e) acc[e] += v[e] * w[dy * 3 + 2][e]; } \
        float a[8]; unpack8(bufv[u], a); \
        _Pragma("unroll") for (int e = 0; e < 8; ++e) a[e] = silu_f(acc[e]) * a[e]; \
        *(u32x4*)(a0 + (size_t)x * FF) = pack8(a); \
        _Pragma("unroll") for (int dy = 0; dy < 3; ++dy) { cm[dy] = cc[dy]; cc[dy] = buf[u][dy]; } } } while (0)
    DW_LOAD_GROUP(pa, pav, 0);
#pragma unroll 1
    for (int jg = 0; jg < 32; jg += 4) {
        DW_LOAD_GROUP(pb, pbv, jg + 2);
        DW_COMPUTE_GROUP(pa, pav, jg);
        { const int jn = jg + 4 < 32 ? jg + 4 : jg; DW_LOAD_GROUP(pa, pav, jn); }
        DW_COMPUTE_GROUP(pb, pbv, jg + 2);
    }
#undef DW_COMPUTE_GROUP
#undef DW_LOAD_GROUP
}
__device__ __forceinline__ void ph_dwconv(Fr& F, int layer, int nlat, int nctx) {
    bf16* A = (bf16*)(F.ws + FF_A); const bf16* G = (const bf16*)(F.ws + FF_G);
    const float* cw = IN(I_FCW) + (size_t)layer * 9 * FF; const float* cb = IN(I_FCB) + (size_t)layer * FF;
    const int ngrp = (F.G % 8 == 0) ? 8 : 1, xg = F.bid % ngrp, lb = F.bid / ngrp, nlb = F.G / ngrp;
    const int nseg = nlat / 32, band = nseg / ngrp;
    for (int i = lb * NTHR + F.tid; i < band * 352; i += nlb * NTHR) {
        const int sl = i / 352, f8 = (i - sl * 352) * 8, seg = xg * band + sl, grow = seg >> 1, gy = grow & 127;
        dw_item(G, A, cw, cb, f8, grow * 64, 64, (seg & 1) * 32, gy > 0, gy < 127);
    }
    const int nsegc = nctx / 32;
    for (int i = F.bid * NTHR + F.tid; i < nsegc * 352; i += F.G * NTHR) {
        const int sl = i / 352, f8 = (i - sl * 352) * 8;
        dw_item(G, A, cw, cb, f8, nlat + (sl >> 3) * CTXL, CTXL, (sl & 7) * 32, false, false);
    }
}

__device__ __forceinline__ void prep_items(Fr& F, const bf16* __restrict__ XM, int nb, int Ls, bf16* __restrict__ XC, bf16* __restrict__ KN, bf16* __restrict__ KT, bf16* __restrict__ VT) {
    LAS unsigned char* tk = F.lds + F.wave * 17408; LAS unsigned char* tv = tk + 8704;
    const int ntt = Ls / 64, nitems = nb * ntt * 32;
    const int tl = F.lane >> 3, c8 = F.lane & 7;
    for (int it = F.gw; it < nitems; it += F.ngw) {
        const int cg = it & 31, tt = (it >> 5) % ntt, b = (it >> 5) / ntt, t0 = tt * 64, ch0 = cg * 64 + c8 * 8, h = cg >> 3;
        float cw0[8], cw1[8], cw2[8], cbb[8], wkq[32], wv[32];
        { const float* p = IN(I_MCW) + ch0; const float* pb = IN(I_MCB) + ch0;
#pragma unroll
            for (int e = 0; e < 8; ++e) { cw0[e] = p[e]; cw1[e] = p[MI + e]; cw2[e] = p[2 * MI + e]; cbb[e] = pb[e]; }
            const float* q = (const float*)(F.ws + WS_WKQ) + (ch0 >> 2) * 16; const float* v = IN(I_MWV) + (ch0 >> 2) * 16;
#pragma unroll
            for (int e = 0; e < 32; ++e) { wkq[e] = q[e]; wv[e] = v[e]; } }
#pragma unroll 4
        for (int i8 = 0; i8 < 8; ++i8) {
            const int tloc = i8 * 8 + tl, t = t0 + tloc; const size_t row = (size_t)b * Ls + t;
            float xp[8], xm[8], xn[8];
            const size_t rowp = row - (t > 0 ? 1 : 0), rown = row + (t + 1 < Ls ? 1 : 0); const size_t ctile = (size_t)(ch0 >> 5) * 512 + ((ch0 & 31) >> 3) * 128;
            const u32x4 rm = *(const u32x4*)(XM + (row >> 4) * 32768 + ctile + (row & 15) * 8), rp = *(const u32x4*)(XM + (rowp >> 4) * 32768 + ctile + (rowp & 15) * 8), rn = *(const u32x4*)(XM + (rown >> 4) * 32768 + ctile + (rown & 15) * 8);
            unpack8(rm, xm); unpack8(rp, xp); unpack8(rn, xn);
            { const float mp = t > 0 ? 1.f : 0.f, mn = t + 1 < Ls ? 1.f : 0.f;
#pragma unroll
                for (int e = 0; e < 8; ++e) { xp[e] *= mp; xn[e] *= mn; } }
            float xc[8], kp[8], vv[8];
#pragma unroll
            for (int e = 0; e < 8; ++e) xc[e] = silu_f(cw0[e] * xp[e] + cw1[e] * xm[e] + cw2[e] * xn[e] + cbb[e]);
#pragma unroll
            for (int n = 0; n < 2; ++n)
#pragma unroll
                for (int o = 0; o < 4; ++o) { float sk = 0.f, sv = 0.f;
#pragma unroll
                    for (int c = 0; c < 4; ++c) { sk += xc[n * 4 + c] * wkq[n * 16 + c * 4 + o]; sv += xm[n * 4 + c] * wv[n * 16 + c * 4 + o]; }
                    kp[n * 4 + o] = sk; vv[n * 4 + o] = sv; }
            { const size_t to = ((size_t)(row >> 4) * 64 + (ch0 >> 5)) * 512 + (((unsigned)row & 15u) + 16u * ((ch0 & 31) >> 3)) * 8u;
              *(u32x4*)(XC + to) = pack8(xc); }
#pragma unroll
            for (int e = 0; e < 8; e += 2) { const unsigned pk = pk2(kp[e], kp[e + 1]), pv = pk2(vv[e], vv[e + 1]);
                *(LAS bf16*)(tk + (c8 * 8 + e) * 136 + tloc * 2) = (bf16)(pk & 0xffffu); *(LAS bf16*)(tk + (c8 * 8 + e + 1) * 136 + tloc * 2) = (bf16)(pk >> 16);
                *(LAS bf16*)(tv + (c8 * 8 + e) * 136 + tloc * 2) = (bf16)(pv & 0xffffu); *(LAS bf16*)(tv + (c8 * 8 + e + 1) * 136 + tloc * 2) = (bf16)(pv >> 16); }
        }
#pragma unroll
        for (int q = 0; q < 8; ++q) { const int dt = q >> 1, kq = q & 1, r = F.lane & 15, q4 = F.lane >> 4;
            const size_t tile = ((size_t)(t0 >> 7) * 32 + (cg & 7) * 4 + dt) * 4 + ((t0 & 127) >> 5) + kq;
            const size_t o = (size_t)(b * 4 + h) * 512 * Ls + tile * 512 + F.lane * 8;
            { const u32x2 lo = *(const LAS u32x2*)(tk + (dt * 16 + r) * 136 + kq * 64 + q4 * 16), hi = *(const LAS u32x2*)(tk + (dt * 16 + r) * 136 + kq * 64 + q4 * 16 + 8); *(u32x4*)(KT + o) = (u32x4){lo.x, lo.y, hi.x, hi.y}; }
            { const u32x2 lo = *(const LAS u32x2*)(tv + (dt * 16 + r) * 136 + kq * 64 + q4 * 16), hi = *(const LAS u32x2*)(tv + (dt * 16 + r) * 136 + kq * 64 + q4 * 16 + 8); *(u32x4*)(VT + o) = (u32x4){lo.x, lo.y, hi.x, hi.y}; }
        }
    }
}

__device__ __forceinline__ void gate_items(Fr& F, const bf16* XC, const bf16* XM, int R, float* GATES) {
    const bf16* gwt = (const bf16*)(F.ws + WS_GWT);
    const int fr = F.lane & 15, fq = F.lane >> 4, half = F.wave & 1, pr = F.wave >> 1, ntiles = R / 16;
    LAS f32x4* xch = (LAS f32x4*)(F.lds + pr * 1024);
    for (int base = F.bid * 4; base < ntiles; base += F.G * 4) {
        const int tile = base + pr; const bool ok = tile < ntiles; const int tl = ok ? tile : 0;
        f32x4 acc = (f32x4){0.f, 0.f, 0.f, 0.f};
        const bf16* ap = (half ? XM : XC) + (size_t)tl * 32768 + F.lane * 8; const bf16* bp = gwt + (size_t)half * 64 * 512 + F.lane * 8;
#pragma unroll 16
        for (int ks = 0; ks < 64; ++ks) acc = __builtin_amdgcn_mfma_f32_16x16x32_bf16(*(const bf16x8*)(ap + ks * 512), *(const bf16x8*)(bp + ks * 512), acc, 0, 0, 0);
        __syncthreads();
        if (half) xch[F.lane] = acc;
        __syncthreads();
        if (!half && ok) { acc = acc + xch[F.lane];
            const int r0 = tile * 16; const float bg = IN(I_MBG)[fr]; const bool isf = (fr >> 2) & 1;
#pragma unroll
            for (int r = 0; r < 4; ++r) { float x = acc[r] + bg; if (isf) x = fminf(x, 0.f) - log1pf(__expf(-fabsf(x))); GATES[(size_t)(r0 + 4 * fq + r) * 16 + fr] = x; } }
    }
}

__device__ __forceinline__ void cum_items(Fr& F, const float* GATES, int nb, int Ls, int gb0, int ctau0, f32x4* GT, float* GC) {
    const int R = nb * Ls, nch = Ls / 128, nitems = 2 * nb * 4 * nch;
    for (int it = F.gw; it < nitems; it += F.ngw) {
        const int c = it % nch, h = (it / nch) & 3, b = (it / nch / 4) % nb, dir = it / nch / 4 / nb;
        const int row0 = b * Ls + c * 128 + 2 * F.lane;
        const float lf0 = GATES[(size_t)row0 * 16 + dir * 8 + 4 + h], lf1 = GATES[(size_t)(row0 + 1) * 16 + dir * 8 + 4 + h];
        const float ig0 = GATES[(size_t)row0 * 16 + dir * 8 + h], ig1 = GATES[(size_t)(row0 + 1) * 16 + dir * 8 + h];
        float inc = lf0 + lf1;
#pragma unroll
        for (int o = 1; o < 64; o <<= 1) { const float t = __shfl_up(inc, o); if (F.lane >= o) inc += t; }
        const float tot = __shfl(inc, 63), exc = inc - (lf0 + lf1);
        float b0, b1;
        if (dir == 0) { b0 = exc + lf0; b1 = inc; } else { b0 = tot - exc; b1 = tot - exc - lf0; }
        GT[(size_t)(dir * 4 + h) * R + row0] = (f32x4){b0, ig0 - b0, __expf(b0), __expf(tot - b0 + ig0)};
        GT[(size_t)(dir * 4 + h) * R + row0 + 1] = (f32x4){b1, ig1 - b1, __expf(b1), __expf(tot - b1 + ig1)};
        if (F.lane == 0) GC[((size_t)(dir * 4 + gb0 + b) * 4 + h) * 66 + ctau0 + c] = __expf(tot);
    }
}

__device__ __forceinline__ void cum_block(Fr& F, const float* GATES, int grow0, int h, f32x4* GT0, f32x4* GT1, float* GC0, float* GC1, LAS float* tab) {
    if (F.wave < 2) {
        const int dir = F.wave, j0 = 2 * F.lane;
        const float* gp = GATES + (size_t)(grow0 + j0) * 16 + dir * 8 + h;
        const float ig0 = gp[0], lf0 = gp[4], ig1 = gp[16], lf1 = gp[20];
        float inc = lf0 + lf1;
#pragma unroll
        for (int o = 1; o < 64; o <<= 1) { const float t = __shfl_up(inc, o); if (F.lane >= o) inc += t; }
        const float tot = __shfl(inc, 63), exc = inc - (lf0 + lf1);
        float b0, b1;
        if (dir == 0) { b0 = exc + lf0; b1 = inc; } else { b0 = tot - exc; b1 = tot - exc - lf0; }
        const float w0 = __expf(tot - b0 + ig0), w1 = __expf(tot - b1 + ig1);
        f32x4* gt = (dir ? GT1 : GT0) + grow0 + j0;
        gt[0] = (f32x4){b0, ig0 - b0, __expf(b0), w0}; gt[1] = (f32x4){b1, ig1 - b1, __expf(b1), w1};
        LAS float* t = tab + dir * 384;
        t[j0] = b0; t[j0 + 1] = b1; t[128 + j0] = ig0 - b0; t[128 + j0 + 1] = ig1 - b1; t[256 + j0] = w0; t[256 + j0 + 1] = w1;
        if (F.lane == 0) *(dir ? GC1 : GC0) = __expf(tot);
    }
}
__device__ __forceinline__ void dn_block(Fr& F, const bf16* KTchunk, const LAS float* tab, float* DN0, float* DN1) {
    const LAS float* w0 = tab + 256; const LAS float* w1 = tab + 384 + 256;
    const bf16* kr = KTchunk + (size_t)(F.tid >> 4) * 4 * 512 + (F.tid & 15) * 8; float s0 = 0.f, s1 = 0.f;
#pragma unroll 4
    for (int q = 0; q < 16; ++q) { const int ks = q >> 2, q4 = q & 3; float v[8]; unpack8(*(const u32x4*)(kr + ks * 512 + q4 * 128), v);
#pragma unroll
        for (int e = 0; e < 8; ++e) { s0 += v[e] * w0[q * 8 + e]; s1 += v[e] * w1[q * 8 + e]; } }
    DN0[F.tid] = s0; DN1[F.tid] = s1;
}
typedef short v4i16_t __attribute__((ext_vector_type(4)));
__device__ __forceinline__ v4i16_t lds_tr16(const LAS unsigned char* p) { return __builtin_amdgcn_ds_read_tr16_b64_v4i16((LAS v4i16_t*)p); }
__device__ __forceinline__ void ph_sphase(Fr& F, int hb, bool with_ctx) {
    const bf16* XC = (const bf16*)(F.ws + MS_XC); const bf16* KT = (const bf16*)(F.ws + MS_KT);
    f32x4* GT = (f32x4*)(F.ws + WS_GT_L); float* DN = (float*)(F.ws + WS_DN); float* RS = (float*)(F.ws + WS_RS); float* GC = (float*)(F.ws + WS_GC);
    const float* GATES = (const float*)(F.ws + WS_GATES_L);
    bf16* S = (bf16*)(F.ws + MS_S);
    LAS unsigned char* kl = F.lds;
    LAS float* tab = (LAS float*)(F.lds + 131072 + 256);
    const int fr = F.lane & 15, fq = F.lane >> 4, w = F.wave;
    const unsigned q_ = (F.lane & 15) >> 2, p_ = F.lane & 3;
    const unsigned trb = ((unsigned)(fq >> 1) * 4u) * 1024u + (8u * (fq & 1) + q_ + 16u * (p_ >> 1)) * 16u + 8u * (p_ & 1);
    for (int it = F.bid; it < 512; it += F.G) {
        const int c = it & 63, h = (it >> 6) & 3, bl = it >> 8, gb = 2 * hb + bl;
        const int row0 = bl * SEQ + c * 128;
        __syncthreads();
        { const char* kc = (const char*)(KT + (size_t)(bl * 4 + h) * 512 * SEQ + (size_t)c * 65536); u32x4 t[16];
#pragma unroll
            for (int i = 0; i < 16; ++i) t[i] = *(const u32x4*)(kc + i * 8192 + F.tid * 16);
#pragma unroll
            for (int i = 0; i < 16; ++i) *(LAS u32x4*)(kl + i * 8192 + F.tid * 16) = t[i]; }
        cum_block(F, GATES, row0, h, GT + (size_t)(0 * 4 + h) * HROWS, GT + (size_t)(1 * 4 + h) * HROWS,
                  GC + ((size_t)(0 * 4 + gb) * 4 + h) * 66 + 2 + c, GC + ((size_t)(1 * 4 + gb) * 4 + h) * 66 + 2 + c, tab);
        __syncthreads();
        {
            const LAS float* w0 = tab + 256; const LAS float* w1 = tab + 384 + 256;
            const LAS unsigned char* kr = kl + (F.tid >> 4) * 4096 + (F.tid & 15) * 16; float s0 = 0.f, s1 = 0.f;
#pragma unroll 4
            for (int q = 0; q < 16; ++q) { const int ks = q >> 2, q4 = q & 3; float v[8]; unpack8(*(const LAS u32x4*)(kr + ks * 1024 + q4 * 256), v);
#pragma unroll
                for (int e = 0; e < 8; ++e) { s0 += v[e] * w0[q * 8 + e]; s1 += v[e] * w1[q * 8 + e]; } }
            DN[(((size_t)(0 * 4 + gb) * 4 + h) * 66 + 2 + c) * 512 + F.tid] = s0; DN[(((size_t)(1 * 4 + gb) * 4 + h) * 66 + 2 + c) * 512 + F.tid] = s1;
        }
        const int irow = row0 + 16 * w + fr;
        bf16x8 bq[16];
        { const bf16* p = XC + ((size_t)((row0 >> 4) + w) * 64 + h * 16) * 512 + F.lane * 8;
#pragma unroll
            for (int ks = 0; ks < 16; ++ks) bq[ks] = *(const bf16x8*)(p + ks * 512); }
        const float bif = tab[16 * w + fr], bib = tab[384 + 16 * w + fr];
        float rsf = 0.f, rsb = 0.f;
        bf16* sf = S + ((size_t)(0 * 8 + bl * 4 + h) * 64 + c) * 16384; bf16* sb = S + ((size_t)(1 * 8 + bl * 4 + h) * 64 + c) * 16384;
#pragma unroll 1
        for (int jt = 0; jt < 8; ++jt) {
            f32x4 acc = (f32x4){0.f, 0.f, 0.f, 0.f};
            const LAS unsigned char* ap = kl + trb + (jt >> 1) * 1024 + (jt & 1) * 512;
#pragma unroll
            for (int ks = 0; ks < 16; ++ks) { const v4i16_t lo = lds_tr16(ap + ks * 8192), hi = lds_tr16(ap + ks * 8192 + 64);
                const bf16x8 a = (bf16x8){lo[0], lo[1], lo[2], lo[3], hi[0], hi[1], hi[2], hi[3]};
                acc = __builtin_amdgcn_mfma_f32_16x16x32_bf16(a, bq[ks], acc, 0, 0, 0); }
            float vf[4], vb[4];
            const f32x4 af4 = *(const LAS f32x4*)(tab + 128 + jt * 16 + 4 * fq), ab4 = *(const LAS f32x4*)(tab + 384 + 128 + jt * 16 + 4 * fq);
#pragma unroll
            for (int r = 0; r < 4; ++r) { const int j = jt * 16 + 4 * fq + r, i = 16 * w + fr;
                vf[r] = (j <= i) ? acc[r] * __expf(bif + af4[r]) : 0.f; vb[r] = (j >= i) ? acc[r] * __expf(bib + ab4[r]) : 0.f;
                rsf += vf[r]; rsb += vb[r]; }
            const size_t so = (size_t)(w * 4 + (jt >> 1)) * 512 + (fr + 16 * ((jt & 1) * 2 + (fq >> 1))) * 8 + (fq & 1) * 4;
            *(u32x2*)(sf + so) = (u32x2){pk2(vf[0], vf[1]), pk2(vf[2], vf[3])};
            *(u32x2*)(sb + so) = (u32x2){pk2(vb[0], vb[1]), pk2(vb[2], vb[3])};
        }
        rsf += __shfl_xor(rsf, 16); rsf += __shfl_xor(rsf, 32); rsb += __shfl_xor(rsb, 16); rsb += __shfl_xor(rsb, 32);
        if (fq == 0) { RS[(size_t)(0 * 4 + h) * HROWS + irow] = rsf; RS[(size_t)(1 * 4 + h) * HROWS + irow] = rsb; }
    }
    if (with_ctx) {
        const bf16* KTC2 = (const bf16*)(F.ws + MS_KTC); f32x4* GTC = (f32x4*)(F.ws + WS_GT_C); const float* GATESC = (const float*)(F.ws + WS_GATES_C);
        for (int it = F.bid; it < 32; it += F.G) {
            const int cc = it & 1, h = (it >> 1) & 3, gb = it >> 3;
            __syncthreads();
            cum_block(F, GATESC, gb * CTXL + cc * 128, h, GTC + (size_t)(0 * 4 + h) * MC, GTC + (size_t)(1 * 4 + h) * MC,
                      GC + ((size_t)(0 * 4 + gb) * 4 + h) * 66 + cc, GC + ((size_t)(1 * 4 + gb) * 4 + h) * 66 + cc, tab);
            __syncthreads();
            dn_block(F, KTC2 + (size_t)(gb * 4 + h) * 512 * CTXL + (size_t)cc * 65536, tab,
                     DN + (((size_t)(0 * 4 + gb) * 4 + h) * 66 + cc) * 512, DN + (((size_t)(1 * 4 + gb) * 4 + h) * 66 + cc) * 512);
        }
    }
}

__device__ __forceinline__ bf16x8 ldg16(const char* ub, unsigned off) { return *(const bf16x8*)(ub + off); }
__device__ __forceinline__ void ph_scan(Fr& F, int hb) {
    const char* XC = (const char*)(F.ws + MS_XC); const char* KT = (const char*)(F.ws + MS_KT); const char* VT = (const char*)(F.ws + MS_VT);
    const char* KTC2 = (const char*)(F.ws + MS_KTC); const char* VTC2 = (const char*)(F.ws + MS_VTC);
    const char* S = (const char*)(F.ws + MS_S);
    const f32x4* GTL = (const f32x4*)(F.ws + WS_GT_L); const f32x4* GTC = (const f32x4*)(F.ws + WS_GT_C);
    const float* GC = (const float*)(F.ws + WS_GC); const float* DN = (const float*)(F.ws + WS_DN);
    float* NC = (float*)(F.ws + WS_NC);
    LAS unsigned char* cbf = F.lds;
    LAS float* wl = (LAS float*)(F.lds + 2 * 33280);
    LAS unsigned char* vtb = F.lds + 2 * 33280 + 1024;
    const int w = F.wave;
    for (int wi = F.bid; wi < 256; wi += F.G) {
        const int chain = wi & 15, slice = wi >> 4, dir = chain >> 3, bl = (chain >> 2) & 1, h = chain & 3, gb = 2 * hb + bl, e0 = slice * 32;
        char* NUM = (char*)(F.ws + (dir ? MS_NB : MS_NF));
        const bool nwriter = (slice == 0) && (w == 0);
        f32x4 acc[4][2];
#pragma unroll
        for (int a = 0; a < 4; ++a)
#pragma unroll
            for (int b = 0; b < 2; ++b) acc[a][b] = (f32x4){0.f, 0.f, 0.f, 0.f};
        float nreg[8];
#pragma unroll
        for (int e = 0; e < 8; ++e) nreg[e] = 0.f;
        const char* ktc = KTC2 + (size_t)(gb * 4 + h) * 512 * CTXL * 2; const char* vtc = VTC2 + (size_t)(gb * 4 + h) * 512 * CTXL * 2;
        const char* ktl = KT + (size_t)(bl * 4 + h) * 512 * SEQ * 2;    const char* vtl = VT + (size_t)(bl * 4 + h) * 512 * SEQ * 2;
        const f32x4* gtc = GTC + (size_t)(dir * 4 + h) * MC + gb * CTXL; const f32x4* gtl = GTL + (size_t)(dir * 4 + h) * HROWS + bl * SEQ;
        const float* gcb = GC + ((size_t)(dir * 4 + gb) * 4 + h) * 66; const float* dnb = DN + ((size_t)(dir * 4 + gb) * 4 + h) * 66 * 512;
#pragma unroll 1
        for (int s = 0; s < 2; ++s) {
            const int cc = dir == 0 ? s : 1 - s; const unsigned l16 = F.lane * 16u, fq = F.lane >> 4;
            __syncthreads();
            if (F.tid < 128) wl[F.tid] = gtc[cc * 128 + F.tid][3];
            __syncthreads();
            const float Gd = gcb[cc]; const char* ktu = ktc + (size_t)cc * 131072; const char* vtu = vtc + (size_t)cc * 131072 + (e0 >> 4) * 4096;
#pragma unroll
            for (int a = 0; a < 4; ++a)
#pragma unroll
                for (int b = 0; b < 2; ++b) acc[a][b] = acc[a][b] * Gd;
#pragma unroll
            for (int ks = 0; ks < 4; ++ks) {
                bf16x8 bv[2];
#pragma unroll
                for (int et = 0; et < 2; ++et) { float v[8]; unpack8(__builtin_bit_cast(u32x4, ldg16(vtu + et * 4096 + ks * 1024, l16)), v);
#pragma unroll
                    for (int e = 0; e < 8; ++e) v[e] *= wl[ks * 32 + 8 * fq + e];
                    const u32x4 pv = pack8(v); bv[et] = __builtin_bit_cast(bf16x8, pv); }
#pragma unroll
                for (int dt = 0; dt < 4; ++dt) { const bf16x8 kk = ldg16(ktu + (4 * w + dt) * 4096 + ks * 1024, l16);
#pragma unroll
                    for (int et = 0; et < 2; ++et) acc[dt][et] = __builtin_amdgcn_mfma_f32_16x16x32_bf16(kk, bv[et], acc[dt][et], 0, 0, 0); }
            }
            { const unsigned lo = F.lane * 32u; const f32x4 d0 = *(const f32x4*)((const char*)(dnb + cc * 512) + lo), d1 = *(const f32x4*)((const char*)(dnb + cc * 512) + lo + 16u);
                nreg[0] = Gd * nreg[0] + d0[0]; nreg[1] = Gd * nreg[1] + d0[1]; nreg[2] = Gd * nreg[2] + d0[2]; nreg[3] = Gd * nreg[3] + d0[3];
                nreg[4] = Gd * nreg[4] + d1[0]; nreg[5] = Gd * nreg[5] + d1[1]; nreg[6] = Gd * nreg[6] + d1[2]; nreg[7] = Gd * nreg[7] + d1[3]; }
        }
        const int cfirst = dir == 0 ? 0 : 63;
        bf16x8 xf[16];
        __syncthreads();
        { const int fr = F.lane & 15, fq = F.lane >> 4; const unsigned l16 = F.lane * 16u;
#pragma unroll
            for (int dt = 0; dt < 4; ++dt)
#pragma unroll
                for (int et = 0; et < 2; ++et) *(LAS u32x2*)(cbf + (16 * et + fr) * 1040 + (64 * w + 16 * dt + 4 * fq) * 2) = (u32x2){pk2(acc[dt][et][0], acc[dt][et][1]), pk2(acc[dt][et][2], acc[dt][et][3])};
            if (F.tid < 128) wl[F.tid] = gtl[cfirst * 128 + F.tid][3];
            *(LAS bf16x8*)(vtb + w * 1024 + l16) = ldg16(vtl + (size_t)cfirst * 131072 + (e0 >> 4) * 4096 + w * 1024, l16);
            const char* xc0 = XC + ((size_t)(((bl * SEQ + cfirst * 128) >> 4) + w) * 64 + h * 16) * 1024;
#pragma unroll
            for (int ks = 0; ks < 16; ++ks) xf[ks] = ldg16(xc0 + ks * 1024, l16); }
        __syncthreads();
#pragma unroll 1
        for (int q = 0; q < 64; ++q) {
            int tid_ = F.tid; asm volatile("" : "+v"(tid_));
            const int lane_ = tid_ & 63, fr = lane_ & 15, fq = lane_ >> 4; const unsigned l16 = lane_ * 16u;
            const int c = dir == 0 ? q : 63 - q;
            const int qn = q < 63 ? q + 1 : 63, cn = dir == 0 ? qn : 63 - qn;
            const int qp = q < 62 ? q + 2 : 63, cp = dir == 0 ? qp : 63 - qp;
            const char* ktu = ktl + (size_t)c * 131072;
            const int row0 = bl * SEQ + c * 128;
            const float Gd = gcb[2 + c];
            LAS unsigned char* cb_rd = cbf + (q & 1) * 33280; LAS unsigned char* cb_wr = cbf + ((q + 1) & 1) * 33280;
            const LAS float* wl_rd = wl + (q & 1) * 128; LAS float* wl_wr = wl + ((q + 1) & 1) * 128;
            const LAS unsigned char* vt_rd = vtb + (q & 1) * 8192; LAS unsigned char* vt_wr = vtb + ((q + 1) & 1) * 8192;
            const bf16x8 vnext = ldg16(vtl + (size_t)cn * 131072 + (e0 >> 4) * 4096 + w * 1024, l16);
            const float wnext = *(const float*)((const char*)(gtl + cn * 128) + (unsigned)(tid_ & 127) * 16u + 12u);
            const float Ei = *(const float*)((const char*)(gtl + c * 128 + 16 * w) + (unsigned)fr * 16u + 8u);
            const f32x4 dn0 = *(const f32x4*)((const char*)(dnb + (2 + c) * 512) + lane_ * 32u), dn1 = *(const f32x4*)((const char*)(dnb + (2 + c) * 512) + lane_ * 32u + 16u);
            bf16x8 kf[4][4], vf[2][4], sfr[4];
            { const char* su = S + ((size_t)(dir * 8 + bl * 4 + h) * 64 + c) * 32768 + w * 4096;
#pragma unroll
                for (int ks = 0; ks < 4; ++ks) sfr[ks] = ldg16(su + ks * 1024, l16); }
#pragma unroll
            for (int dt = 0; dt < 4; ++dt) kf[0][dt] = ldg16(ktu + (4 * w + dt) * 4096, l16);
            unsigned pf;
            {
                const char* kt3 = ktl + (size_t)cp * 131072; const char* vt3 = vtl + (size_t)cp * 131072;
                const char* xc3 = XC + ((size_t)((bl * SEQ + cp * 128) >> 4) * 64 + h * 16) * 1024; const char* s3p = S + ((size_t)(dir * 8 + bl * 4 + h) * 64 + cp) * 32768;
                const unsigned t = tid_ < 208 ? tid_ : tid_ - 208; const bool g0 = t < 64, g1 = t < 128, g2 = t < 192;
                const unsigned ln2 = slice * 64 + (t - 128);
                const char* ub = g0 ? kt3 : (g1 ? vt3 : (g2 ? xc3 : s3p));
                const unsigned off = g0 ? (slice * 64 + t) * 128u : (g1 ? (e0 >> 4) * 4096u + (t - 64) * 128u : (g2 ? (ln2 >> 7) * 65536u + (ln2 & 127) * 128u : (slice * 16 + ((t - 192) & 15)) * 128u));
                pf = *(const volatile unsigned*)(ub + off);
            }
#pragma unroll
            for (int et = 0; et < 2; ++et)
#pragma unroll
                for (int ks = 0; ks < 4; ++ks) vf[et][ks] = *(const LAS bf16x8*)(vt_rd + (et * 4 + ks) * 1024 + l16);
            if (nwriter) { char* np = (char*)(NC + (((size_t)(dir * 2 + bl) * 4 + h) * 64 + c) * 512); const unsigned lo = lane_ * 32u;
                *(f32x4*)(np + lo) = (f32x4){nreg[0], nreg[1], nreg[2], nreg[3]}; *(f32x4*)(np + lo + 16u) = (f32x4){nreg[4], nreg[5], nreg[6], nreg[7]}; }
            f32x4 a2[2] = {(f32x4){0.f, 0.f, 0.f, 0.f}, (f32x4){0.f, 0.f, 0.f, 0.f}};
#pragma unroll
            for (int ks = 0; ks < 16; ++ks)
#pragma unroll
                for (int et = 0; et < 2; ++et) a2[et] = __builtin_amdgcn_mfma_f32_16x16x32_bf16(*(const LAS bf16x8*)(cb_rd + (16 * et + fr) * 1040 + ks * 64 + fq * 16), xf[ks], a2[et], 0, 0, 0);
            asm volatile("" ::: "memory");
#pragma unroll
            for (int ks = 1; ks < 4; ++ks)
#pragma unroll
                for (int dt = 0; dt < 4; ++dt) kf[ks][dt] = ldg16(ktu + (4 * w + dt) * 4096 + ks * 1024, l16);
            { const char* xc2 = XC + ((size_t)(((bl * SEQ + cn * 128) >> 4) + w) * 64 + h * 16) * 1024;
#pragma unroll
                for (int ks = 0; ks < 16; ++ks) xf[ks] = ldg16(xc2 + ks * 1024, l16); }
            a2[0] = a2[0] * Ei; a2[1] = a2[1] * Ei;
#pragma unroll
            for (int ks = 0; ks < 4; ++ks)
#pragma unroll
                for (int et = 0; et < 2; ++et) a2[et] = __builtin_amdgcn_mfma_f32_16x16x32_bf16(vf[et][ks], sfr[ks], a2[et], 0, 0, 0);
            { char* nu = NUM + ((size_t)row0 * MI + h * 512 + e0) * 2; const unsigned ln = ((16u * w + fr) * MI + 4u * fq) * 2u;
#pragma unroll
                for (int et = 0; et < 2; ++et) *(u32x2*)(nu + et * 32 + ln) = (u32x2){pk2(a2[et][0], a2[et][1]), pk2(a2[et][2], a2[et][3])}; }
#pragma unroll
            for (int a = 0; a < 4; ++a)
#pragma unroll
                for (int b = 0; b < 2; ++b) acc[a][b] = acc[a][b] * Gd;
#pragma unroll
            for (int ks = 0; ks < 4; ++ks) {
                bf16x8 bv[2];
#pragma unroll
                for (int et = 0; et < 2; ++et) { float v[8]; unpack8(__builtin_bit_cast(u32x4, vf[et][ks]), v);
                    const f32x4 wa = *(const LAS f32x4*)(wl_rd + ks * 32 + 8 * fq), wb = *(const LAS f32x4*)(wl_rd + ks * 32 + 8 * fq + 4);
                    v[0] *= wa[0]; v[1] *= wa[1]; v[2] *= wa[2]; v[3] *= wa[3]; v[4] *= wb[0]; v[5] *= wb[1]; v[6] *= wb[2]; v[7] *= wb[3];
                    const u32x4 pv = pack8(v); bv[et] = __builtin_bit_cast(bf16x8, pv); }
#pragma unroll
                for (int dt = 0; dt < 4; ++dt)
#pragma unroll
                    for (int et = 0; et < 2; ++et) acc[dt][et] = __builtin_amdgcn_mfma_f32_16x16x32_bf16(kf[ks][dt], bv[et], acc[dt][et], 0, 0, 0);
            }
            nreg[0] = Gd * nreg[0] + dn0[0]; nreg[1] = Gd * nreg[1] + dn0[1]; nreg[2] = Gd * nreg[2] + dn0[2]; nreg[3] = Gd * nreg[3] + dn0[3];
            nreg[4] = Gd * nreg[4] + dn1[0]; nreg[5] = Gd * nreg[5] + dn1[1]; nreg[6] = Gd * nreg[6] + dn1[2]; nreg[7] = Gd * nreg[7] + dn1[3];
            *(LAS bf16x8*)(vt_wr + w * 1024 + l16) = vnext;
            wl_wr[tid_ & 127] = wnext;
#pragma unroll
            for (int dt = 0; dt < 4; ++dt)
#pragma unroll
                for (int et = 0; et < 2; ++et) *(LAS u32x2*)(cb_wr + (16 * et + fr) * 1040 + (64 * w + 16 * dt + 4 * fq) * 2) = (u32x2){pk2(acc[dt][et][0], acc[dt][et][1]), pk2(acc[dt][et][2], acc[dt][et][3])};
            asm volatile("" :: "v"(pf));
            __syncthreads();
        }
    }
}

__device__ __forceinline__ void ph_mout(Fr& F) {
    bf16* NF = (bf16*)(F.ws + MS_NF); const bf16* NBk = (const bf16*)(F.ws + MS_NB); const bf16* XC = (const bf16*)(F.ws + MS_XC); const bf16* Z = (const bf16*)(F.ws + MS_Z);
    const float* NC = (const float*)(F.ws + WS_NC); const float* RS = (const float*)(F.ws + WS_RS); const f32x4* GTL = (const f32x4*)(F.ws + WS_GT_L);
    LAS unsigned char* xt = F.lds + F.wave * 16640;
    for (int it = F.gw; it < (HROWS / 16) * 4; it += F.ngw) {
        const int rt = it >> 2, h = it & 3, bl = rt >> 9, c = (rt >> 3) & 63;
        { const bf16* xp = XC + ((size_t)rt * 64 + h * 16) * 512 + F.lane * 8; u32x4 t[16];
#pragma unroll
            for (int ks = 0; ks < 16; ++ks) t[ks] = *(const u32x4*)(xp + ks * 512);
#pragma unroll
            for (int ks = 0; ks < 16; ++ks) *(LAS u32x4*)(xt + ks * 1040 + F.lane * 16) = t[ks]; }
        const float* n0 = NC + (((size_t)(0 * 2 + bl) * 4 + h) * 64 + c) * 512 + 8 * F.lane; const float* n1 = NC + (((size_t)(1 * 2 + bl) * 4 + h) * 64 + c) * 512 + 8 * F.lane;
        const f32x4 n00 = *(const f32x4*)n0, n01 = *(const f32x4*)(n0 + 4), n10 = *(const f32x4*)n1, n11 = *(const f32x4*)(n1 + 4);
        float nw[8], sk[8];
        { const float* pw = IN(I_MNW) + h * 512 + 8 * F.lane; const float* ps = IN(I_MSKIP) + h * 512 + 8 * F.lane;
#pragma unroll
            for (int e = 0; e < 8; ++e) { nw[e] = pw[e]; sk[e] = ps[e]; } }
#pragma unroll 2
        for (int r = 0; r < 16; ++r) {
            const int row = rt * 16 + r; const size_t o = (size_t)row * MI + h * 512 + 8 * F.lane;
            float nf[8], nb[8], xc[8], z[8];
            unpack8(*(const u32x4*)(NF + o), nf); unpack8(*(const u32x4*)(NBk + o), nb); unpack8(*(const u32x4*)(Z + o), z);
            unpack8(*(const LAS u32x4*)(xt + (F.lane >> 2) * 1040 + (r + 16 * (F.lane & 3)) * 16), xc);
            float d0 = xc[0] * n00[0] + xc[1] * n00[1] + xc[2] * n00[2] + xc[3] * n00[3] + xc[4] * n01[0] + xc[5] * n01[1] + xc[6] * n01[2] + xc[7] * n01[3];
            float d1 = xc[0] * n10[0] + xc[1] * n10[1] + xc[2] * n10[2] + xc[3] * n10[3] + xc[4] * n11[0] + xc[5] * n11[1] + xc[6] * n11[2] + xc[7] * n11[3];
            d0 = wave_sum(d0); d1 = wave_sum(d1);
            const float den0 = GTL[(size_t)(0 * 4 + h) * HROWS + row][2] * d0 + RS[(size_t)(0 * 4 + h) * HROWS + row], den1 = GTL[(size_t)(1 * 4 + h) * HROWS + row][2] * d1 + RS[(size_t)(1 * 4 + h) * HROWS + row];
            const float i0 = 1.0f / fmaxf(fabsf(den0), 1.0f), i1 = 1.0f / fmaxf(fabsf(den1), 1.0f);
            float s = 0.f;
#pragma unroll
            for (int e = 0; e < 8; ++e) { nf[e] = nf[e] * i0 + nb[e] * i1; s += nf[e]; }
            const float mu = wave_sum(s) * (1.0f / 512.0f); float q = 0.f;
#pragma unroll
            for (int e = 0; e < 8; ++e) { nf[e] -= mu; q += nf[e] * nf[e]; }
            const float rstd = 1.0f / sqrtf(wave_sum(q) * (1.0f / 512.0f) + ML_NORM_EPS);
#pragma unroll
            for (int e = 0; e < 8; ++e) nf[e] = (nf[e] * rstd * nw[e] + sk[e] * xc[e]) * silu_f(z[e]);
            *(u32x4*)(NF + o) = pack8(nf);
        }
    }
}

__device__ __forceinline__ void ph_final(Fr& F, const bf16* dl) {
    const float* g = IN(I_FINALG);
    for (int r = F.gw; r < ML; r += 2 * F.ngw) {
        const int r2 = r + F.ngw < ML ? r + F.ngw : r;
        f32x4* xa = (f32x4*)(F.out + (size_t)r * 1024) + F.lane; f32x4* xb = (f32x4*)(F.out + (size_t)r2 * 1024) + F.lane; f32x4 va[4], vb[4]; float sa = 0.f, sb = 0.f;
        const u32x2* da = (const u32x2*)(dl + (size_t)r * 1024) + F.lane; const u32x2* db = (const u32x2*)(dl + (size_t)r2 * 1024) + F.lane;
#pragma unroll
        for (int j = 0; j < 4; ++j) { const u32x2 a = da[64 * j], b = db[64 * j];
            va[j] = xa[64 * j] + (f32x4){bflo(a.x), bfhi(a.x), bflo(a.y), bfhi(a.y)}; vb[j] = xb[64 * j] + (f32x4){bflo(b.x), bfhi(b.x), bflo(b.y), bfhi(b.y)}; }
#pragma unroll
        for (int j = 0; j < 4; ++j) { sa += (va[j][0] * va[j][0] + va[j][1] * va[j][1]) + (va[j][2] * va[j][2] + va[j][3] * va[j][3]); sb += (vb[j][0] * vb[j][0] + vb[j][1] * vb[j][1]) + (vb[j][2] * vb[j][2] + vb[j][3] * vb[j][3]); }
        const float ra = __builtin_amdgcn_rsqf(wave_sum(sa) * (1.0f / 1024.0f) + EPS), rb = __builtin_amdgcn_rsqf(wave_sum(sb) * (1.0f / 1024.0f) + EPS);
#pragma unroll
        for (int j = 0; j < 4; ++j) { const f32x4 gg = *(const f32x4*)(g + 4 * F.lane + 256 * j); xa[64 * j] = va[j] * ra * gg; if (r2 != r) xb[64 * j] = vb[j] * rb * gg; }
    }
}

template <class Epi>
__device__ __forceinline__ void run_gemm(Fr& F, const bf16* A, const bf16* Bt, int M, int N, int K, const Epi& E) {
    pg8::Gemm g{A, Bt, M, N, K}; pg8::StaticOrder S; S.init(M, N, F.G, F.bid);
    pg8::gemm_phase<Epi, pg8::StaticOrder, true, true>(F.lds, g, S, E, F.tid);
}

struct Args { const float* in[38]; float* out; unsigned char* ws; int ph_lo, ph_hi; };
static_assert(sizeof(Args) == 328 && offsetof(Args, out) == 304 && offsetof(Args, ws) == 312 && offsetof(Args, ph_lo) == 320, "Args layout");
constexpr int N_PHASES = 34;


#define XB_TMO      128
#define XB_XCNT(j)  (256  + 64 * (j))
#define XB_XSUB(j)  (1280 + 64 * (j))
#define XB_XGEN(j)  (2304 + 64 * (j))
#define XB_TOP      3328
#define XB_TOPGEN   3392
#define XCD_BAR_WORDS 3456
#define XB_SPIN_CAP (1u << 22)
__device__ __forceinline__ unsigned xb_ld(unsigned* p)              { return __hip_atomic_load(p, __ATOMIC_RELAXED, __HIP_MEMORY_SCOPE_AGENT); }
__device__ __forceinline__ unsigned xb_add(unsigned* p, unsigned v) { return __hip_atomic_fetch_add(p, v, __ATOMIC_RELAXED, __HIP_MEMORY_SCOPE_AGENT); }
__device__ __forceinline__ unsigned xb_xcc_id() { return (unsigned)__builtin_amdgcn_s_getreg((3 << 11) | 20) & 0xFu; }
#define XB_SPIN(cond, bar) do { unsigned _sp = 0; while (cond) { __builtin_amdgcn_s_sleep(1); \
    if ((++_sp & 255u) == 0u) { if (xb_ld(&(bar)[XB_TMO])) break; if (_sp > XB_SPIN_CAP) { atomicAdd(&(bar)[XB_TMO], 1u); break; } } } } while (0)
__device__ __forceinline__ void xcd_barrier_complete(unsigned* bar, unsigned x, unsigned& nloc, unsigned& nx) {
    const unsigned G = gridDim.x * gridDim.y * gridDim.z;
    unsigned sum, cnt, mine, sp = 0u;
    for (;;) {
        sum = 0u; cnt = 0u; mine = 0u;
#pragma unroll
        for (unsigned j = 0; j < 16; ++j) { const unsigned c = xb_ld(&bar[XB_XCNT(j)]); sum += c; cnt += (c > 0u) ? 1u : 0u; mine = (j == x) ? c : mine; }
        if (sum == G) break;
        __builtin_amdgcn_s_sleep(1);
        if ((++sp & 255u) == 0u) { if (xb_ld(&bar[XB_TMO])) break; if (sp > XB_SPIN_CAP) { atomicAdd(&bar[XB_TMO], 1u); break; } }
    }
    nloc = mine > 0u ? mine : 1u; nx = cnt > 0u ? cnt : 1u;
}
__device__ __forceinline__ void xcd_barrier(unsigned* bar, volatile LAS unsigned* st) {
    asm volatile("s_waitcnt vmcnt(0)" ::: "memory");
    __syncthreads();
    if (threadIdx.x == 0) {
        const unsigned x = xb_xcc_id();
        __builtin_amdgcn_s_waitcnt(0);
        unsigned nloc = st[0], nx = st[1];
        if (nloc == 0u) { xcd_barrier_complete(bar, x, nloc, nx); st[0] = nloc; st[1] = nx; }
        const unsigned old = xb_add(&bar[XB_XSUB(x)], 1u);
        const unsigned gen = old / nloc;
        if (old + 1u == (gen + 1u) * nloc) {
            __builtin_amdgcn_fence(__ATOMIC_RELEASE, "agent");
            asm volatile("s_waitcnt vmcnt(0)" ::: "memory");
            const unsigned og = xb_add(&bar[XB_TOP], 1u);
            const unsigned tg = og / nx;
            if (og + 1u == (tg + 1u) * nx) xb_add(&bar[XB_TOPGEN], 1u);
            else XB_SPIN(xb_ld(&bar[XB_TOPGEN]) == tg, bar);
            __builtin_amdgcn_fence(__ATOMIC_ACQUIRE, "agent");
            xb_add(&bar[XB_XGEN(x)], 1u);
            asm volatile("s_waitcnt vmcnt(0)" ::: "memory");
        } else {
            XB_SPIN(xb_ld(&bar[XB_XGEN(x)]) == gen, bar);
            __builtin_amdgcn_fence(__ATOMIC_ACQUIRE, "agent");
            asm volatile("s_waitcnt vmcnt(0)" ::: "memory");
        }
    }
    __syncthreads();
}
#ifndef PROBE_MASK
#define PROBE_MASK 0ull
#endif
constexpr int BAR_LDS_OFF = LDS_BYTES - 64;
constexpr size_t WS_BAR = 0;
constexpr size_t WS_TS = 64 * 1024;

template <int ph>
__device__ __forceinline__ void run_phase(Fr& F) {
    unsigned char* ws = F.ws;
    float* mod = (float*)(ws + WS_MOD); float* ctxx = (float*)(ws + WS_CTXX);
    if constexpr (ph == 0) ph_prologue(F);
    else if constexpr (ph == 1) ph_modnorm(F, IN(I_X), ML, 0, IN(I_CTX), MC, IN(I_NORMG), mod, 0, (bf16*)(ws + HY_H));
    else if constexpr (ph == 2) { pg8::EpiBf16 E{(bf16*)(ws + HY_P), 3072, IN(I_HBIN), 0, 0}; run_gemm(F, (const bf16*)(ws + HY_H), (const bf16*)(ws + WS_WHIN), MALL, 3072, 1024, E);
                                  { constexpr int nun = (MALL / 256) * (3072 / 256); const int busy = nun % F.G; const bool all = busy == 0; const int vb = all ? F.bid : F.bid - busy, nvb = all ? F.G : F.G - busy;
                                    if (all || F.bid >= busy) {
                                        kt_items(F, (const float*)(ws + WS_H3), SEQ, (float*)(ws + HY_KT), vb * NWAVES + F.wave, nvb * NWAVES);
                                        kt_items(F, (const float*)(ws + WS_H3) + (size_t)SEQ * 64, CTXL, (float*)(ws + WS_KTC), vb * NWAVES + F.wave, nvb * NWAVES);
                                        transpose_group(F, 1, vb, nvb); } } }
    else if constexpr (ph == 3) { zt_items(F, (const bf16*)(ws + HY_P), 0, NB, SEQ, (bf16*)(ws + HY_ZT)); zt_items(F, (const bf16*)(ws + HY_P), ML, NB, CTXL, (bf16*)(ws + HY_ZTC)); }
    else if constexpr (ph == 4) ph_fftconv(F);
    else if constexpr (ph == 5) { u2_items(F, (const bf16*)(ws + HY_P), 0, NB, SEQ, (const bf16*)(ws + HY_ZT), (bf16*)(ws + HY_H)); u2_items(F, (const bf16*)(ws + HY_P), ML, NB, CTXL, (const bf16*)(ws + HY_ZTC), (bf16*)(ws + HY_H)); }
    else if constexpr (ph == 6) { pg8::EpiDelta E{(bf16*)(ws + HY_P), ML, mod + 2048, 0, IN(I_HBOUT)}; run_gemm(F, (const bf16*)(ws + HY_H), (const bf16*)(ws + WS_WHOUT), MALL, 1024, 1024, E);
                                  transpose_in_tail(F, 2, (MALL / 256) * (1024 / 256)); }
    else if constexpr (ph == 7) ph_modnorm(F, IN(I_X), ML, 0, IN(I_CTX), MC, IN(I_NORMG) + 1024, mod, 3072, (bf16*)(ws + FF_H), (const bf16*)(ws + HY_P), F.out, ctxx);
    else if constexpr (ph == 8) { pg8::EpiBf16 E{(bf16*)(ws + FF_A), FF, nullptr, FF, (FF_G - FF_A) / 2}; run_gemm(F, (const bf16*)(ws + FF_H), (const bf16*)(ws + WS_WUP0), MALL, 2 * FF, 1024, E);
                                  { constexpr int nun = (MALL / 256) * (2 * FF / 256); const int busy = nun % F.G;
                                    if (busy == 0) mod_layer(F, 1, F.bid, F.G); else if (F.bid >= busy) mod_layer(F, 1, F.bid - busy, F.G - busy); } }
    else if constexpr (ph == 9) ph_dwconv(F, 0, ML, MC);
    else if constexpr (ph == 10) { pg8::EpiDelta E{(bf16*)(ws + FF_H), ML, mod + 5120, 0, nullptr}; run_gemm(F, (const bf16*)(ws + FF_A), (const bf16*)(ws + WS_WDN0), MALL, 1024, FF, E); }
    else if constexpr (ph < 29) {
            constexpr int hb = (ph - 11) / 9, k = (ph - 11) % 9; const float* mod1 = mod + 5 * 6144;
            float* xh = F.out + (size_t)hb * HROWS * 1024;
            if constexpr (k == 0) {
                if constexpr (hb == 0) {
                    const bf16* dl = (const bf16*)(ws + FF_H);
                    add_delta_rows(F, F.out, dl, HROWS, HROWS);
                    ph_modnorm(F, xh, 0, 0, ctxx, MC, IN(I_NORMG) + 2048, mod1, 0, (bf16*)(ws + MS_HC), dl + (size_t)ML * 1024, xh, ctxx);
                    ph_modnorm(F, xh, HROWS, 0, ctxx, 0, IN(I_NORMG) + 2048, mod1, 0, (bf16*)(ws + MS_H), dl, xh, ctxx);
                } else ph_modnorm(F, xh, HROWS, 2 * hb, ctxx, 0, IN(I_NORMG) + 2048, mod1, 0, (bf16*)(ws + MS_H)); }
            else if constexpr (k == 1) { { pg8::EpiBf16T E{(bf16*)(ws + MS_XM), MI / 32}; run_gemm(F, (const bf16*)(ws + MS_H), (const bf16*)(ws + WS_WMIN), HROWS, MI, 1024, E); }
                               if (hb == 0) { pg8::EpiBf16T E{(bf16*)(ws + MS_XMC), MI / 32}; run_gemm(F, (const bf16*)(ws + MS_HC), (const bf16*)(ws + WS_WMIN), MC, MI, 1024, E); } }
            else if constexpr (k == 2) { prep_items(F, (const bf16*)(ws + MS_XM), 2, SEQ, (bf16*)(ws + MS_XC), (bf16*)(ws + MS_KN), (bf16*)(ws + MS_KT), (bf16*)(ws + MS_VT));
                               if (hb == 0) prep_items(F, (const bf16*)(ws + MS_XMC), NB, CTXL, (bf16*)(ws + MS_XCC), (bf16*)(ws + MS_XCC + 16 * MiB), (bf16*)(ws + MS_KTC), (bf16*)(ws + MS_VTC)); }
            else if constexpr (k == 3) { gate_items(F, (const bf16*)(ws + MS_XC), (const bf16*)(ws + MS_XM), HROWS, (float*)(ws + WS_GATES_L));
                               if (hb == 0) gate_items(F, (const bf16*)(ws + MS_XCC), (const bf16*)(ws + MS_XMC), MC, (float*)(ws + WS_GATES_C)); }
            else if constexpr (k == 4) ph_sphase(F, hb, hb == 0);
            else if constexpr (k == 5) ph_scan(F, hb);
            else if constexpr (k == 6) { pg8::EpiBf16 E{(bf16*)(ws + MS_Z), MI, nullptr, 0, 0}; run_gemm(F, (const bf16*)(ws + MS_H), (const bf16*)(ws + WS_WMIN) + (size_t)MI * 1024, HROWS, MI, 1024, E); }
            else if constexpr (k == 7) ph_mout(F);
            else { pg8::EpiRes E{xh, xh, ctxx, ctxx, HROWS, mod1 + 2048, 2 * hb, nullptr}; run_gemm(F, (const bf16*)(ws + MS_NF), (const bf16*)(ws + WS_WMDN), HROWS, 1024, MI, E); }
        }
    else if constexpr (ph == 29) ph_modnorm(F, F.out, ML, 0, ctxx, 0, IN(I_NORMG) + 3072, mod + 5 * 6144, 3072, (bf16*)(ws + FF_H));
    else if constexpr (ph == 30) { pg8::EpiBf16 E{(bf16*)(ws + FF_A), FF, nullptr, FF, (FF_G - FF_A) / 2}; run_gemm(F, (const bf16*)(ws + FF_H), (const bf16*)(ws + WS_WUP1), ML, 2 * FF, 1024, E); }
    else if constexpr (ph == 31) ph_dwconv(F, 1, ML, 0);
    else if constexpr (ph == 32) { pg8::EpiDelta E{(bf16*)(ws + FF_H), ML, mod + 5 * 6144 + 5120, 0, nullptr}; run_gemm(F, (const bf16*)(ws + FF_A), (const bf16*)(ws + WS_WDN1), ML, 1024, FF, E); }
    else ph_final(F, (const bf16*)(ws + FF_H));
}

template <int ph>
__device__ __forceinline__ void phase_step(int ph_lo, int ph_hi, unsigned char* lds_raw) {
    if (ph_lo <= ph && ph < ph_hi) {
        const __attribute__((address_space(4))) unsigned char* kp = (const __attribute__((address_space(4))) unsigned char*)__builtin_amdgcn_kernarg_segment_ptr();
        asm volatile("" : "+s"(kp));
        Fr F;
        { int t_ = threadIdx.x, g_ = gridDim.x, b_ = blockIdx.x; asm volatile("" : "+v"(t_), "+s"(g_), "+s"(b_)); F.tid = t_; F.G = g_; F.bid = b_; }
        F.lds = (LAS unsigned char*)lds_raw; F.lane = F.tid & 63; F.wave = __builtin_amdgcn_readfirstlane(F.tid >> 6);
        F.gw = F.bid * NWAVES + F.wave; F.ngw = F.G * NWAVES;
        F.in = (const __attribute__((address_space(4))) cfptr_t*)kp;
        typedef float* fptr_t; typedef unsigned char* ucptr_t;
        F.out = *(const __attribute__((address_space(4))) fptr_t*)(kp + 304); F.ws = *(const __attribute__((address_space(4))) ucptr_t*)(kp + 312);
        if (PROBE_MASK != 0ull && F.bid == 0 && F.tid == 0) ((unsigned long long*)(F.ws + WS_TS))[ph] = __builtin_amdgcn_s_memrealtime();
        run_phase<ph>(F);
        if (ph + 1 < ph_hi) {
            if (ph == 0) {
                if (F.bid == 0) for (int i = F.tid; i < XCD_BAR_WORDS; i += NTHR) __hip_atomic_store((unsigned*)(F.ws + WS_BAR) + i, 0u, __ATOMIC_RELAXED, __HIP_MEMORY_SCOPE_AGENT);
                __syncthreads(); cg::this_grid().sync();
                if (F.tid == 0) (void)xb_add((unsigned*)(F.ws + WS_BAR) + XB_XCNT(xb_xcc_id()), 1u);
            }
            else xcd_barrier((unsigned*)(F.ws + WS_BAR), (volatile LAS unsigned*)(F.lds + BAR_LDS_OFF));
        }
        if (PROBE_MASK != 0ull && ph == N_PHASES - 1 && F.bid == 0) {
            if (F.tid == 0) { unsigned long long* ts = (unsigned long long*)(F.ws + WS_TS); const unsigned long long tend = __builtin_amdgcn_s_memrealtime(); unsigned long long tot = 0ull;
                for (int k = 0; k < N_PHASES; ++k) if ((PROBE_MASK >> k) & 1ull) tot += (k + 1 < N_PHASES ? ts[k + 1] : tend) - ts[k];
                while (__builtin_amdgcn_s_memrealtime() - tend < tot) __builtin_amdgcn_s_sleep(8); }
            __syncthreads();
        }
    }
}
template <int... I>
__device__ __forceinline__ void all_phases(int ph_lo, int ph_hi, unsigned char* lds_raw, std::integer_sequence<int, I...>) { (phase_step<I>(ph_lo, ph_hi, lds_raw), ...); }

__global__ void __launch_bounds__(NTHR, 2) fwd_kernel(Args args) {
    extern __shared__ __attribute__((aligned(16))) unsigned char lds_raw[];
    int ph_lo, ph_hi;
    { const __attribute__((address_space(4))) unsigned char* kp0 = (const __attribute__((address_space(4))) unsigned char*)__builtin_amdgcn_kernarg_segment_ptr();
      ph_lo = *(const __attribute__((address_space(4))) int*)(kp0 + 320); ph_hi = *(const __attribute__((address_space(4))) int*)(kp0 + 324); }
    if (threadIdx.x < 16) ((LAS unsigned*)((LAS unsigned char*)lds_raw + BAR_LDS_OFF))[threadIdx.x] = 0u;
    __syncthreads();
    all_phases(ph_lo, ph_hi, lds_raw, std::make_integer_sequence<int, N_PHASES>{});
}

extern "C" void kernel_launch(void* const* d_in, const int* in_sizes, int n_in, void* d_out, int out_size, void* d_ws, size_t ws_size, hipStream_t stream) {
    static int grid = 0;
    if (grid == 0) {
        int dev = 0, cus = 0, per_cu = 0;
        hipGetDevice(&dev);
        hipDeviceGetAttribute(&cus, hipDeviceAttributeMultiprocessorCount, dev);
        hipFuncSetAttribute((const void*)fwd_kernel, hipFuncAttributeMaxDynamicSharedMemorySize, LDS_BYTES);
        hipOccupancyMaxActiveBlocksPerMultiprocessor(&per_cu, (const void*)fwd_kernel, NTHR, LDS_BYTES);
        if (per_cu < 1) { fprintf(stderr, "kernel_launch: occupancy query says %d blocks per CU\n", per_cu); per_cu = 1; }
        grid = cus < 256 ? cus : 256;
        if (n_in != 38 || ws_size < WS_END) fprintf(stderr, "kernel_launch: unexpected n_in %d / ws_size %zu (need %zu)\n", n_in, ws_size, (size_t)WS_END);
        (void)hipGetLastError();
    }
    (void)hipMemsetAsync(d_ws, 0, 128 * 1024, stream);
    Args a{};
    for (int i = 0; i < 38; ++i) a.in[i] = (const float*)d_in[i];
    a.out = (float*)d_out; a.ws = (unsigned char*)d_ws; a.ph_lo = 0; a.ph_hi = N_PHASES;
    void* kargs[] = {&a};
    hipError_t e = hipLaunchCooperativeKernel((const void*)fwd_kernel, dim3(grid), dim3(NTHR), kargs, LDS_BYTES, stream);
    if (e != hipSuccess) fprintf(stderr, "cooperative launch failed: %s (grid %d)\n", hipGetErrorString(e), grid);
}
```
